# Optimizing an MI355X kernel written in HIP

```python
import jax
import jax.numpy as jnp
from jax import lax
import numpy as np

D_MODEL = 1024
BATCH = 8
SEQ = 2048
DEPTH = 4

ATTN_HEADS = 8
HEAD_DIM = 64
ATTN_WIDTH = ATTN_HEADS * HEAD_DIM
IDX_HEADS = 8
IDX_DIM = 64
INDEX_TOPK = 256
Q_BLOCK = 128
ROPE_THETA = 10000.0
CONV_WIDTH = D_MODEL - ATTN_WIDTH
CONV_K = 3
HYB_SIZES = (ATTN_WIDTH, HEAD_DIM, HEAD_DIM, IDX_HEADS * IDX_DIM, IDX_DIM, IDX_HEADS, CONV_WIDTH, CONV_WIDTH, CONV_WIDTH)
HYB_IN = sum(HYB_SIZES)

ML_HEADS = 8
ML_QK_DIM = D_MODEL // (2 * ML_HEADS)
ML_V_DIM = D_MODEL // ML_HEADS
ML_CHUNK = 64
ML_SIZES = (ML_HEADS * ML_QK_DIM, ML_HEADS * ML_QK_DIM, ML_HEADS * ML_V_DIM, ML_HEADS, ML_HEADS, ML_HEADS * ML_V_DIM)
ML_IN = sum(ML_SIZES)

N_GROUPS = 4
EXPERTS_PER_GROUP = 8
N_EXPERTS = N_GROUPS * EXPERTS_PER_GROUP
TOP_K = 2
D_EXPERT = 512
MOE_BLOCK = 256
NORM_EPS = 1e-6

kernel_name = 'hybrid_dsa_conv_mlstm_hmoe'


def _split(a, sizes):
    return jnp.split(a, [int(i) for i in np.cumsum(sizes)[:-1]], axis=-1)


def rms_norm(x, g):
    xf = x.astype(jnp.float32)
    y = xf * lax.rsqrt(jnp.mean(xf * xf, axis=-1, keepdims=True) + NORM_EPS)
    return (y * g.astype(jnp.float32)).astype(x.dtype)


def rope_tables(seq, dim):
    inv = 1.0 / (ROPE_THETA ** (jnp.arange(0, dim, 2, dtype=jnp.float32) / dim))
    ang = jnp.arange(seq, dtype=jnp.float32)[:, None] * inv[None, :]
    return jnp.cos(ang), jnp.sin(ang)


def apply_rope(x, cos, sin):
    half = x.shape[-1] // 2
    xf = x.astype(jnp.float32)
    x1, x2 = xf[..., :half], xf[..., half:]
    c = cos[None, :, None, :]
    s = sin[None, :, None, :]
    return jnp.concatenate([x1 * c - x2 * s, x2 * c + x1 * s], axis=-1).astype(x.dtype)


def dsa_attention(q, k, v, iq, ik, iw):
    B, S, H, d = q.shape
    nb = S // Q_BLOCK
    k_sel = min(INDEX_TOPK, S // 4)
    pos = jnp.arange(S, dtype=jnp.int32)
    ikf = ik.astype(jnp.float32)
    gather = jax.vmap(lambda a, i: a[i])

    def to_blocks(a):
        return jnp.moveaxis(a.reshape((B, nb, Q_BLOCK) + a.shape[2:]), 1, 0)

    def block(args):
        qb, iqb, iwb, pb = args
        s = jnp.einsum('bqhd,bsd->bqhs', iqb.astype(jnp.float32), ikf) * (IDX_DIM ** -0.5)
        score = jnp.einsum('bqhs,bqh->bqs', jax.nn.relu(s), iwb.astype(jnp.float32) * (IDX_HEADS ** -0.5))
        score = jnp.where((pos[None, :] <= pb[:, None])[None], score, -jnp.inf)
        top_val, top_idx = lax.top_k(score, k_sel)
        valid = jnp.isfinite(top_val)
        kg = gather(k, top_idx)
        vg = gather(v, top_idx)
        logits = jnp.einsum('bqhd,bqkd->bqhk', qb, kg).astype(jnp.float32) * (d ** -0.5)
        logits = jnp.where(valid[:, :, None, :], logits, -jnp.inf)
        p = jax.nn.softmax(logits, axis=-1).astype(vg.dtype)
        return jnp.einsum('bqhk,bqkd->bqhd', p, vg)

    out = lax.map(block, (to_blocks(q), to_blocks(iq), to_blocks(iw), pos.reshape(nb, Q_BLOCK)))
    return jnp.moveaxis(out, 0, 1).reshape(B, S, H * d)


def short_gated_conv(bg, cg, u, conv_w):
    S = u.shape[1]
    z = cg * u
    zp = jnp.pad(z, ((0, 0), (CONV_K - 1, 0), (0, 0)))
    y = zp[:, 0:S] * conv_w[0]
    for j in range(1, CONV_K):
        y = y + zp[:, j:j + S] * conv_w[j]
    return bg * y


def hybrid_mixer(h, w_in, q_norm, k_norm, conv_w, w_out, cos, sin):
    B, S, _ = h.shape
    q, k, v, iq, ik, iw, bg, cg, u = _split(h @ w_in, HYB_SIZES)
    q = apply_rope(rms_norm(q.reshape(B, S, ATTN_HEADS, HEAD_DIM), q_norm), cos, sin)
    k = apply_rope(rms_norm(k.reshape(B, S, 1, HEAD_DIM), k_norm), cos, sin)[:, :, 0]
    iq = apply_rope(iq.reshape(B, S, IDX_HEADS, IDX_DIM), cos, sin)
    ik = apply_rope(ik.reshape(B, S, 1, IDX_DIM), cos, sin)[:, :, 0]
    y_attn = dsa_attention(q, k, v, iq, ik, iw)
    y_conv = short_gated_conv(bg, cg, u, conv_w)
    return jnp.concatenate([y_attn, y_conv], axis=-1) @ w_out


def mlstm_chunkwise(q, k, v, i_pre, f_pre):
    B, H, S, dk = q.shape
    dv = v.shape[-1]
    nc = S // ML_CHUNK
    log_f = jax.nn.log_sigmoid(f_pre)
    tril = jnp.tril(jnp.ones((ML_CHUNK, ML_CHUNK), dtype=bool))

    def chunks(a):
        return jnp.moveaxis(a.reshape(a.shape[:2] + (nc, ML_CHUNK) + a.shape[3:]), 2, 0)

    def step(carry, inp):
        C, n, m = carry
        qc, kc, vc, ic, lfc = inp
        b = jnp.cumsum(lfc, axis=-1)
        dmat = b[..., :, None] - b[..., None, :] + ic[..., None, :]
        dmat = jnp.where(tril, dmat, -jnp.inf)
        inter = b + m[..., None]
        m_t = jnp.maximum(inter, jnp.max(dmat, axis=-1))
        w_intra = jnp.exp(dmat - m_t[..., None])
        w_inter = jnp.exp(inter - m_t)
        intra = w_intra * jnp.einsum('bhtd,bhsd->bhts', qc, kc)
        num = w_inter[..., None] * jnp.einsum('bhvd,bhtd->bhtv', C, qc) + jnp.einsum('bhts,bhsv->bhtv', intra, vc)
        den = w_inter * jnp.einsum('bhd,bhtd->bht', n, qc) + jnp.sum(intra, axis=-1)
        hc = num / jnp.maximum(jnp.abs(den), jnp.exp(-m_t))[..., None]
        b_last = b[..., -1]
        g = b_last[..., None] - b + ic
        m_new = jnp.maximum(b_last + m, jnp.max(g, axis=-1))
        decay = jnp.exp(b_last + m - m_new)
        ws = jnp.exp(g - m_new[..., None])
        C_new = decay[..., None, None] * C + jnp.einsum('bhsv,bhsd->bhvd', vc * ws[..., None], kc)
        n_new = decay[..., None] * n + jnp.einsum('bhs,bhsd->bhd', ws, kc)
        return (C_new, n_new, m_new), hc

    init = (jnp.zeros((B, H, dv, dk), jnp.float32), jnp.zeros((B, H, dk), jnp.float32), jnp.zeros((B, H), jnp.float32))
    _, hs = lax.scan(step, init, (chunks(q), chunks(k), chunks(v), chunks(i_pre), chunks(log_f)))
    return jnp.moveaxis(hs, 0, 2).reshape(B, H, S, dv)


def mlstm_mixer(h, w_in, b_gates, out_norm, w_out):
    B, S, _ = h.shape
    q, k, v, ig, fg, og = _split(h @ w_in, ML_SIZES)

    def heads(a, d):
        return jnp.transpose(a.reshape(B, S, ML_HEADS, d), (0, 2, 1, 3)).astype(jnp.float32)

    qh = heads(q, ML_QK_DIM) * (ML_QK_DIM ** -0.5)
    kh = heads(k, ML_QK_DIM)
    vh = heads(v, ML_V_DIM)
    i_pre = jnp.transpose((ig + b_gates[:ML_HEADS]).astype(jnp.float32), (0, 2, 1))
    f_pre = jnp.transpose((fg + b_gates[ML_HEADS:]).astype(jnp.float32), (0, 2, 1))
    hh = jnp.transpose(mlstm_chunkwise(qh, kh, vh, i_pre, f_pre), (0, 2, 1, 3))
    hh = rms_norm(hh, out_norm.reshape(ML_HEADS, ML_V_DIM)).astype(h.dtype).reshape(B, S, ML_HEADS * ML_V_DIM)
    return (jax.nn.sigmoid(og) * hh) @ w_out


def hier_moe(h, w_group, b_group, w_expert, b_expert, w_gate, w_up, w_down):
    B, S, D = h.shape
    T = B * S
    xt = h.reshape(T, D)
    p_group = jax.nn.softmax((xt @ w_group + b_group).astype(jnp.float32), axis=-1)
    g_sel = jnp.argmax(p_group, axis=-1)
    pg = jnp.take_along_axis(p_group, g_sel[:, None], axis=-1)
    e_logits = (xt @ w_expert + b_expert).astype(jnp.float32).reshape(T, N_GROUPS, EXPERTS_PER_GROUP)
    in_group = jnp.take_along_axis(e_logits, g_sel[:, None, None], axis=1)[:, 0]
    top_val, top_idx = lax.top_k(in_group, TOP_K)
    weight = pg * jax.nn.softmax(top_val, axis=-1)
    expert_id = g_sel[:, None].astype(jnp.int32) * EXPERTS_PER_GROUP + top_idx.astype(jnp.int32)
    A = T * TOP_K
    flat_e = expert_id.reshape(A)
    flat_tok = jnp.repeat(jnp.arange(T, dtype=jnp.int32), TOP_K)
    flat_w = weight.reshape(A)
    order = jnp.argsort(flat_e)
    sorted_e = flat_e[order]
    counts = jnp.bincount(flat_e, length=N_EXPERTS)
    blocks_per = (counts + MOE_BLOCK - 1) // MOE_BLOCK
    block_end = jnp.cumsum(blocks_per)
    block_start = block_end - blocks_per
    seg_start = jnp.cumsum(counts) - counts
    rank = jnp.arange(A, dtype=jnp.int32) - seg_start[sorted_e]
    dest = block_start[sorted_e] * MOE_BLOCK + rank
    n_blk = -(-A // MOE_BLOCK) + N_EXPERTS
    R = n_blk * MOE_BLOCK
    row_tok = jnp.zeros((R,), jnp.int32).at[dest].set(flat_tok[order])
    row_w = jnp.zeros((R,), h.dtype).at[dest].set(flat_w[order].astype(h.dtype))
    blk_e = jnp.clip(jnp.searchsorted(block_end, jnp.arange(n_blk), side='right'), 0, N_EXPERTS - 1)
    xs = xt[row_tok].reshape(n_blk, MOE_BLOCK, D)

    def run(args):
        xb, e = args
        return (jax.nn.silu(xb @ w_gate[e]) * (xb @ w_up[e])) @ w_down[e]

    ys = lax.map(run, (xs, blk_e)).reshape(R, D) * row_w[:, None]
    out = jnp.zeros((T, D), h.dtype).at[row_tok].add(ys)
    return out.reshape(B, S, D)


def setup_inputs(seed: int = 0) -> dict:
    key = jax.random.key(seed)
    ks = jax.random.split(key, 24)
    n_even = (DEPTH + 1) // 2
    n_odd = DEPTH // 2
    D = D_MODEL

    def nrm(k, shape, scale):
        return jax.random.normal(k, shape, jnp.float32) * scale

    f_bias = jnp.linspace(3.0, 6.0, ML_HEADS, dtype=jnp.float32)[None, :] + nrm(ks[12], (n_odd, ML_HEADS), 0.1)
    return {
        'x': nrm(ks[0], (BATCH, SEQ, D), 1.0),
        'c': nrm(ks[1], (BATCH, D), 1.0),
        'ada_w': nrm(ks[2], (DEPTH, D, 6 * D), 0.5 * D ** -0.5),
        'ada_b': nrm(ks[3], (DEPTH, 6 * D), 0.02),
        'norm_mix': 1.0 + nrm(ks[4], (DEPTH, D), 0.05),
        'norm_ffn': 1.0 + nrm(ks[5], (DEPTH, D), 0.05),
        'hy_w_in': nrm(ks[6], (n_even, D, HYB_IN), D ** -0.5),
        'hy_q_norm': 1.0 + nrm(ks[7], (n_even, HEAD_DIM), 0.05),
        'hy_k_norm': 1.0 + nrm(ks[8], (n_even, HEAD_DIM), 0.05),
        'hy_conv_w': nrm(ks[9], (n_even, CONV_K, CONV_WIDTH), CONV_K ** -0.5),
        'hy_w_out': nrm(ks[10], (n_even, D, D), D ** -0.5),
        'ml_w_in': nrm(ks[11], (n_odd, D, ML_IN), D ** -0.5),
        'ml_b_gates': jnp.concatenate([nrm(ks[13], (n_odd, ML_HEADS), 0.1), f_bias], axis=-1),
        'ml_out_norm': 1.0 + nrm(ks[14], (n_odd, ML_HEADS * ML_V_DIM), 0.05),
        'ml_w_out': nrm(ks[15], (n_odd, ML_HEADS * ML_V_DIM, D), (ML_HEADS * ML_V_DIM) ** -0.5),
        'moe_w_group': nrm(ks[16], (DEPTH, D, N_GROUPS), D ** -0.5),
        'moe_b_group': nrm(ks[17], (DEPTH, N_GROUPS), 0.01),
        'moe_w_expert': nrm(ks[18], (DEPTH, D, N_EXPERTS), D ** -0.5),
        'moe_b_expert': nrm(ks[19], (DEPTH, N_EXPERTS), 0.01),
        'moe_w_gate': nrm(ks[20], (DEPTH, N_EXPERTS, D, D_EXPERT), D ** -0.5),
        'moe_w_up': nrm(ks[21], (DEPTH, N_EXPERTS, D, D_EXPERT), D ** -0.5),
        'moe_w_down': nrm(ks[22], (DEPTH, N_EXPERTS, D_EXPERT, D), D_EXPERT ** -0.5),
    }


def reference(x, c, ada_w, ada_b, norm_mix, norm_ffn, hy_w_in, hy_q_norm, hy_k_norm, hy_conv_w, hy_w_out,
              ml_w_in, ml_b_gates, ml_out_norm, ml_w_out, moe_w_group, moe_b_group, moe_w_expert, moe_b_expert,
              moe_w_gate, moe_w_up, moe_w_down):
    S = x.shape[1]
    cos, sin = rope_tables(S, HEAD_DIM)
    c_act = jax.nn.silu(c)
    for l in range(DEPTH):
        mod = c_act @ ada_w[l] + ada_b[l]
        sh1, sc1, g1, sh2, sc2, g2 = [m[:, None, :] for m in jnp.split(mod, 6, axis=-1)]
        h = rms_norm(x, norm_mix[l]) * (1 + sc1) + sh1
        j = l // 2
        if l % 2 == 0:
            y = hybrid_mixer(h, hy_w_in[j], hy_q_norm[j], hy_k_norm[j], hy_conv_w[j], hy_w_out[j], cos, sin)
        else:
            y = mlstm_mixer(h, ml_w_in[j], ml_b_gates[j], ml_out_norm[j], ml_w_out[j])
        x = x + g1 * y
        h = rms_norm(x, norm_ffn[l]) * (1 + sc2) + sh2
        x = x + g2 * hier_moe(h, moe_w_group[l], moe_b_group[l], moe_w_expert[l], moe_b_expert[l],
                              moe_w_gate[l], moe_w_up[l], moe_w_down[l])
    return x
```

```cpp
#include <hip/hip_runtime.h>
#include <hip/hip_cooperative_groups.h>
#include <stdint.h>
#include <cstdio>

#define DI __device__ __forceinline__
typedef unsigned short bf16_t;
typedef short bf16x8 __attribute__((ext_vector_type(8)));
typedef float f32x16 __attribute__((ext_vector_type(16)));
typedef float f32x4 __attribute__((ext_vector_type(4)));
typedef float f32x2 __attribute__((ext_vector_type(2)));
typedef unsigned u32x4 __attribute__((ext_vector_type(4)));
typedef unsigned u32x2 __attribute__((ext_vector_type(2)));
typedef __bf16 bf16x2_t __attribute__((ext_vector_type(2)));

constexpr int D = 1024, NB = 8, S = 2048, T = NB * S, DEPTH = 4;
constexpr int HYB_IN = 2760, ML_IN = 3088;
constexpr int NEXP = 32, DEXP = 512, NASG = T * 2;
constexpr float EPS = 1e-6f;

constexpr size_t al256(size_t x) { return (x + 255) & ~(size_t)255; }
constexpr size_t WS_MOD = 0;
constexpr size_t WS_ROPEC = WS_MOD + al256((size_t)4 * 8 * 6144 * 4);
constexpr size_t WS_ROPES = WS_ROPEC + al256((size_t)2048 * 32 * 4);
constexpr size_t WS_ECNT = WS_ROPES + al256((size_t)2048 * 32 * 4);
constexpr size_t WS_H = WS_ECNT + al256(4 * 32 * 4);
constexpr size_t WS_YMIX = WS_H + al256((size_t)T * 1024 * 2);
constexpr size_t WS_Q = WS_YMIX + al256((size_t)T * 1024 * 2);
constexpr size_t WS_K = WS_Q + al256((size_t)T * 512 * 2);
constexpr size_t WS_V = WS_K + al256((size_t)T * 64 * 2);
constexpr size_t WS_IQ = WS_V + al256((size_t)T * 64 * 2);
constexpr size_t WS_IK = WS_IQ + al256((size_t)T * 512 * 2);
constexpr size_t WS_IW = WS_IK + al256((size_t)T * 64 * 2);
constexpr size_t WS_BG = WS_IW + al256((size_t)T * 8 * 4);
constexpr size_t WS_Z = WS_BG + al256((size_t)T * 512 * 2);
constexpr size_t WS_MASK = WS_Z + al256((size_t)T * 512 * 2);
constexpr size_t WS_MQ = WS_MASK + al256((size_t)T * 64 * 4);
constexpr size_t WS_MK = WS_MQ + al256((size_t)T * 512 * 2);
constexpr size_t WS_MV = WS_MK + al256((size_t)T * 512 * 2);
constexpr size_t WS_MIG = WS_MV + al256((size_t)T * 1024 * 2);
constexpr size_t WS_MFG = WS_MIG + al256((size_t)T * 8 * 4);
constexpr size_t WS_MOG = WS_MFG + al256((size_t)T * 8 * 4);
constexpr size_t WS_EW = WS_MOG + al256((size_t)T * 1024 * 2);
constexpr size_t WS_ELIST = WS_EW + al256((size_t)NASG * 4);
constexpr size_t WS_H1 = WS_ELIST + al256((size_t)NEXP * NASG * 4);
constexpr size_t WS_Y = WS_H1 + al256((size_t)NASG * 512 * 2);
constexpr size_t WS_SCORE = WS_Y + al256((size_t)NASG * 1024 * 2);
constexpr size_t WS_END = WS_SCORE + al256((size_t)NB * S * S * 4);

struct Params {
    const float *x, *c, *ada_w, *ada_b, *norm_mix, *norm_ffn, *hy_w_in, *hy_q_norm, *hy_k_norm, *hy_conv_w, *hy_w_out;
    const float *ml_w_in, *ml_b_gates, *ml_out_norm, *ml_w_out, *moe_w_group, *moe_b_group, *moe_w_expert, *moe_b_expert;
    const float *moe_w_gate, *moe_w_up, *moe_w_down;
    float* out;
    unsigned char* ws;
};

DI unsigned pk2(float lo, float hi) { f32x2 v = {lo, hi}; bf16x2_t b = __builtin_convertvector(v, bf16x2_t); return __builtin_bit_cast(unsigned, b); }
DI bf16_t f2bf(float x) { return (bf16_t)(pk2(x, 0.f) & 0xffffu); }
DI float bf2f(bf16_t h) { return __uint_as_float(((unsigned)h) << 16); }
DI float bflo(unsigned u) { return __uint_as_float(u << 16); }
DI float bfhi(unsigned u) { return __uint_as_float(u & 0xffff0000u); }
DI float wave_sum(float v) { for (int m = 32; m >= 1; m >>= 1) v += __shfl_xor(v, m); return v; }
DI float wave_max(float v) { for (int m = 32; m >= 1; m >>= 1) v = fmaxf(v, __shfl_xor(v, m)); return v; }
DI float half_sum(float v) { for (int m = 16; m >= 1; m >>= 1) v += __shfl_xor(v, m); return v; }
DI float sigmoidf_(float x) { return 1.f / (1.f + __expf(-x)); }

DI int swz(int row, int slot) { return row * 128 + ((slot ^ ((row >> 1) & 7)) << 4); }
DI int crow(int reg, int lane) { return (reg & 3) + 8 * (reg >> 2) + 4 * (lane >> 5); }

template <class P>
DI void gemm_tile(const P& pr, unsigned char* smem, int tid) {
    unsigned char* As = smem;
    unsigned char* Bs = smem + 16384;
    const int lane = tid & 63, wid = tid >> 6, wr = wid >> 1, wc = wid & 1;
    const bf16_t* ap[4];
#pragma unroll
    for (int i = 0; i < 4; ++i) { const bf16_t* r = pr.a_row((tid >> 3) + 32 * i); ap[i] = r ? r + (tid & 7) * 8 : nullptr; }
    const int ng = tid & 31, kg = tid >> 5;
    int width = 0;
    const float* bp = pr.b_col(ng >> 3, width);
    const int cig = (ng & 7) * 4;
    const bool bvalid = cig < width;
    const int ldb = pr.ldb();
    bp += cig + (size_t)(kg * 8) * ldb;
    u32x4 ra[4]; f32x4 rb[8];
    auto gload = [&](int kt) {
#pragma unroll
        for (int i = 0; i < 4; ++i) ra[i] = ap[i] ? *(const u32x4*)(ap[i] + kt * 64) : (u32x4){0u, 0u, 0u, 0u};
#pragma unroll
        for (int kk = 0; kk < 8; ++kk) rb[kk] = bvalid ? *(const f32x4*)(bp + (size_t)(kt * 64 + kk) * ldb) : (f32x4){0.f, 0.f, 0.f, 0.f};
    };
    auto lstore = [&]() {
#pragma unroll
        for (int i = 0; i < 4; ++i) *(u32x4*)(As + swz((tid >> 3) + 32 * i, tid & 7)) = ra[i];
#pragma unroll
        for (int j = 0; j < 4; ++j) {
            u32x4 v = {pk2(rb[0][j], rb[1][j]), pk2(rb[2][j], rb[3][j]), pk2(rb[4][j], rb[5][j]), pk2(rb[6][j], rb[7][j])};
            *(u32x4*)(Bs + swz(ng * 4 + j, kg)) = v;
        }
    };
    f32x16 acc[2][2];
#pragma unroll
    for (int a = 0; a < 2; ++a)
#pragma unroll
        for (int b = 0; b < 2; ++b)
#pragma unroll
            for (int r = 0; r < 16; ++r) acc[a][b][r] = 0.f;
    const int KT = pr.kt();
    __syncthreads();
    gload(0);
    lstore();
    __syncthreads();
    for (int kt = 0; kt < KT; ++kt) {
        if (kt + 1 < KT) gload(kt + 1);
#pragma unroll
        for (int ks = 0; ks < 4; ++ks) {
            const int slot = ks * 2 + (lane >> 5);
            bf16x8 a0 = *(const bf16x8*)(As + swz(wr * 64 + (lane & 31), slot));
            bf16x8 a1 = *(const bf16x8*)(As + swz(wr * 64 + 32 + (lane & 31), slot));
            bf16x8 b0 = *(const bf16x8*)(Bs + swz(wc * 64 + (lane & 31), slot));
            bf16x8 b1 = *(const bf16x8*)(Bs + swz(wc * 64 + 32 + (lane & 31), slot));
            acc[0][0] = __builtin_amdgcn_mfma_f32_32x32x16_bf16(a0, b0, acc[0][0], 0, 0, 0);
            acc[0][1] = __builtin_amdgcn_mfma_f32_32x32x16_bf16(a0, b1, acc[0][1], 0, 0, 0);
            acc[1][0] = __builtin_amdgcn_mfma_f32_32x32x16_bf16(a1, b0, acc[1][0], 0, 0, 0);
            acc[1][1] = __builtin_amdgcn_mfma_f32_32x32x16_bf16(a1, b1, acc[1][1], 0, 0, 0);
        }
        __syncthreads();
        if (kt + 1 < KT) { lstore(); __syncthreads(); }
    }
    pr.epi(acc, wr, wc, lane);
}

struct HybIn {
    const Params* p; int j, tm, tn;
    DI int kt() const { return 16; }
    DI int ldb() const { return HYB_IN; }
    DI const bf16_t* a_row(int r) const { return (const bf16_t*)(p->ws + WS_H) + (size_t)(tm * 128 + r) * 1024; }
    DI static void pair_cols(int pr, int ni, int& base, int& width) {
        width = 32;
        if (pr < 8) base = 64 * pr + 32 * ni;
        else if (pr == 8) base = 512 + 32 * ni;
        else if (pr == 9) base = 576 + 32 * ni;
        else if (pr < 18) base = 640 + 64 * (pr - 10) + 32 * ni;
        else if (pr == 18) base = 1152 + 32 * ni;
        else if (pr == 19) { base = 1216; width = ni == 0 ? 8 : 0; }
        else if (pr < 28) base = 1224 + 64 * (pr - 20) + 32 * ni;
        else base = (ni == 0 ? 1736 : 2248) + 32 * (pr - 28);
    }
    DI const float* b_col(int g, int& width) const { int base; pair_cols(tn * 2 + (g >> 1), g & 1, base, width); return p->hy_w_in + (size_t)j * 1024 * HYB_IN + base; }
    DI void epi(f32x16 (&acc)[2][2], int wr, int wc, int lane) const {
        const int pr = tn * 2 + wc, c = lane & 31;
        const int t0 = tm * 128 + wr * 64;
        unsigned char* ws = p->ws;
        const float* ropec = (const float*)(ws + WS_ROPEC);
        const float* ropes = (const float*)(ws + WS_ROPES);
        if (pr < 9 || (pr >= 10 && pr < 19)) {
            const bool donorm = pr < 9;
            const float* gam = pr < 8 ? p->hy_q_norm + j * 64 : p->hy_k_norm + j * 64;
            bf16_t* ob; int ld, cb;
            if (pr < 8) { ob = (bf16_t*)(ws + WS_Q); ld = 512; cb = 64 * pr; }
            else if (pr == 8) { ob = (bf16_t*)(ws + WS_K); ld = 64; cb = 0; }
            else if (pr < 18) { ob = (bf16_t*)(ws + WS_IQ); ld = 512; cb = 64 * (pr - 10); }
            else { ob = (bf16_t*)(ws + WS_IK); ld = 64; cb = 0; }
            float g1 = 1.f, g2 = 1.f;
            if (donorm) { g1 = gam[c]; g2 = gam[c + 32]; }
#pragma unroll
            for (int mi = 0; mi < 2; ++mi)
#pragma unroll
                for (int r = 0; r < 16; ++r) {
                    float x1 = acc[mi][0][r], x2 = acc[mi][1][r];
                    const int t = t0 + mi * 32 + crow(r, lane), pos = t & (S - 1);
                    if (donorm) { float ss = half_sum(x1 * x1 + x2 * x2); float rstd = rsqrtf(ss * (1.f / 64.f) + EPS); x1 *= rstd * g1; x2 *= rstd * g2; }
                    const float cs = ropec[pos * 32 + c], sn = ropes[pos * 32 + c];
                    ob[(size_t)t * ld + cb + c] = f2bf(x1 * cs - x2 * sn);
                    ob[(size_t)t * ld + cb + 32 + c] = f2bf(x2 * cs + x1 * sn);
                }
        } else if (pr == 9) {
            bf16_t* ob = (bf16_t*)(ws + WS_V);
#pragma unroll
            for (int mi = 0; mi < 2; ++mi)
#pragma unroll
                for (int r = 0; r < 16; ++r) { const int t = t0 + mi * 32 + crow(r, lane); ob[(size_t)t * 64 + c] = f2bf(acc[mi][0][r]); ob[(size_t)t * 64 + 32 + c] = f2bf(acc[mi][1][r]); }
        } else if (pr == 19) {
            float* ob = (float*)(ws + WS_IW);
            if (c < 8) {
#pragma unroll
                for (int mi = 0; mi < 2; ++mi)
#pragma unroll
                    for (int r = 0; r < 16; ++r) { const int t = t0 + mi * 32 + crow(r, lane); ob[(size_t)t * 8 + c] = acc[mi][0][r] * (0.125f * 0.35355339059327373f); }
            }
        } else if (pr < 28) {
            bf16_t* ob = (bf16_t*)(ws + WS_BG); const int cb = 64 * (pr - 20);
#pragma unroll
            for (int mi = 0; mi < 2; ++mi)
#pragma unroll
                for (int r = 0; r < 16; ++r) { const int t = t0 + mi * 32 + crow(r, lane); ob[(size_t)t * 512 + cb + c] = f2bf(acc[mi][0][r]); ob[(size_t)t * 512 + cb + 32 + c] = f2bf(acc[mi][1][r]); }
        } else {
            bf16_t* ob = (bf16_t*)(ws + WS_Z); const int cb = 32 * (pr - 28);
#pragma unroll
            for (int mi = 0; mi < 2; ++mi)
#pragma unroll
                for (int r = 0; r < 16; ++r) { const int t = t0 + mi * 32 + crow(r, lane); ob[(size_t)t * 512 + cb + c] = f2bf(acc[mi][0][r] * acc[mi][1][r]); }
        }
    }
};

struct MlIn {
    const Params* p; int j, tm, tn;
    DI int kt() const { return 16; }
    DI int ldb() const { return ML_IN; }
    DI const bf16_t* a_row(int r) const { return (const bf16_t*)(p->ws + WS_H) + (size_t)(tm * 128 + r) * 1024; }
    DI const float* b_col(int g, int& width) const {
        const int pr = tn * 2 + (g >> 1), ni = g & 1; int base; width = 32;
        if (pr < 32) base = 64 * pr + 32 * ni;
        else if (pr == 32) { base = 2048 + 8 * ni; width = 8; }
        else if (pr < 49) base = 2064 + 64 * (pr - 33) + 32 * ni;
        else { base = 0; width = 0; }
        return p->ml_w_in + (size_t)j * 1024 * ML_IN + base;
    }
    DI void epi(f32x16 (&acc)[2][2], int wr, int wc, int lane) const {
        const int pr = tn * 2 + wc, c = lane & 31;
        const int t0 = tm * 128 + wr * 64;
        unsigned char* ws = p->ws;
        if (pr < 32) {
            bf16_t* ob; int ld, cb; float sc = 1.f;
            if (pr < 8) { ob = (bf16_t*)(ws + WS_MQ); ld = 512; cb = 64 * pr; sc = 0.125f; }
            else if (pr < 16) { ob = (bf16_t*)(ws + WS_MK); ld = 512; cb = 64 * (pr - 8); }
            else { ob = (bf16_t*)(ws + WS_MV); ld = 1024; cb = 64 * (pr - 16); }
#pragma unroll
            for (int mi = 0; mi < 2; ++mi)
#pragma unroll
                for (int r = 0; r < 16; ++r) { const int t = t0 + mi * 32 + crow(r, lane); ob[(size_t)t * ld + cb + c] = f2bf(acc[mi][0][r] * sc); ob[(size_t)t * ld + cb + 32 + c] = f2bf(acc[mi][1][r] * sc); }
        } else if (pr == 32) {
            if (c < 8) {
                float* oi = (float*)(ws + WS_MIG); float* of = (float*)(ws + WS_MFG);
                const float bi = p->ml_b_gates[j * 16 + c], bfg = p->ml_b_gates[j * 16 + 8 + c];
#pragma unroll
                for (int mi = 0; mi < 2; ++mi)
#pragma unroll
                    for (int r = 0; r < 16; ++r) {
                        const int t = t0 + mi * 32 + crow(r, lane);
                        oi[(size_t)t * 8 + c] = acc[mi][0][r] + bi;
                        const float f = acc[mi][1][r] + bfg;
                        of[(size_t)t * 8 + c] = fminf(f, 0.f) - log1pf(__expf(-fabsf(f)));
                    }
            }
        } else if (pr < 49) {
            bf16_t* ob = (bf16_t*)(ws + WS_MOG); const int cb = 64 * (pr - 33);
#pragma unroll
            for (int mi = 0; mi < 2; ++mi)
#pragma unroll
                for (int r = 0; r < 16; ++r) { const int t = t0 + mi * 32 + crow(r, lane); ob[(size_t)t * 1024 + cb + c] = f2bf(sigmoidf_(acc[mi][0][r])); ob[(size_t)t * 1024 + cb + 32 + c] = f2bf(sigmoidf_(acc[mi][1][r])); }
        }
    }
};

struct OutProj {
    const Params* p; const float* W; const float* src; int layer, tm, tn;
    DI int kt() const { return 16; }
    DI int ldb() const { return 1024; }
    DI const bf16_t* a_row(int r) const { return (const bf16_t*)(p->ws + WS_YMIX) + (size_t)(tm * 128 + r) * 1024; }
    DI const float* b_col(int g, int& width) const { width = 32; return W + tn * 128 + g * 32; }
    DI void epi(f32x16 (&acc)[2][2], int wr, int wc, int lane) const {
        const int c = lane & 31, t0 = tm * 128 + wr * 64;
        const float* mod = (const float*)(p->ws + WS_MOD) + (size_t)layer * 8 * 6144;
#pragma unroll
        for (int mi = 0; mi < 2; ++mi)
#pragma unroll
            for (int ni = 0; ni < 2; ++ni) {
                const int n = tn * 128 + wc * 64 + ni * 32 + c;
#pragma unroll
                for (int r = 0; r < 16; ++r) {
                    const int t = t0 + mi * 32 + crow(r, lane);
                    const float g = mod[(t >> 11) * 6144 + 2048 + n];
                    p->out[(size_t)t * 1024 + n] = src[(size_t)t * 1024 + n] + g * acc[mi][ni][r];
                }
            }
    }
};

struct Moe1 {
    const Params* p; int layer, e, mt, nt, cnt, roff;
    DI int kt() const { return 16; }
    DI int ldb() const { return DEXP; }
    DI const bf16_t* a_row(int r) const {
        const int rr = mt * 128 + r; if (rr >= cnt) return nullptr;
        const int a = ((const int*)(p->ws + WS_ELIST))[(size_t)e * NASG + rr];
        return (const bf16_t*)(p->ws + WS_H) + (size_t)(a >> 1) * 1024;
    }
    DI const float* b_col(int g, int& width) const {
        width = 32; const int pr = nt * 2 + (g >> 1);
        const float* base = (g & 1) ? p->moe_w_up : p->moe_w_gate;
        return base + ((size_t)layer * NEXP + e) * (size_t)(D * DEXP) + 32 * pr;
    }
    DI void epi(f32x16 (&acc)[2][2], int wr, int wc, int lane) const {
        const int c = lane & 31, pr = nt * 2 + wc;
        bf16_t* ob = (bf16_t*)(p->ws + WS_H1);
#pragma unroll
        for (int mi = 0; mi < 2; ++mi)
#pragma unroll
            for (int r = 0; r < 16; ++r) {
                const int rr = mt * 128 + wr * 64 + mi * 32 + crow(r, lane);
                if (rr < cnt) { const float g = acc[mi][0][r], u = acc[mi][1][r]; ob[(size_t)(roff + rr) * 512 + 32 * pr + c] = f2bf(g / (1.f + __expf(-g)) * u); }
            }
    }
};

struct Moe2 {
    const Params* p; int layer, e, mt, nt, cnt, roff;
    DI int kt() const { return 8; }
    DI int ldb() const { return D; }
    DI const bf16_t* a_row(int r) const { const int rr = mt * 128 + r; if (rr >= cnt) return nullptr; return (const bf16_t*)(p->ws + WS_H1) + (size_t)(roff + rr) * 512; }
    DI const float* b_col(int g, int& width) const { width = 32; return p->moe_w_down + ((size_t)layer * NEXP + e) * (size_t)(DEXP * D) + nt * 128 + g * 32; }
    DI void epi(f32x16 (&acc)[2][2], int wr, int wc, int lane) const {
        const int c = lane & 31;
        bf16_t* ob = (bf16_t*)(p->ws + WS_Y);
        const int* el = (const int*)(p->ws + WS_ELIST) + (size_t)e * NASG;
        const float* ew = (const float*)(p->ws + WS_EW);
#pragma unroll
        for (int mi = 0; mi < 2; ++mi)
#pragma unroll
            for (int r = 0; r < 16; ++r) {
                const int rr = mt * 128 + wr * 64 + mi * 32 + crow(r, lane);
                if (rr < cnt) {
                    const int a = el[rr]; const float w = ew[a];
#pragma unroll
                    for (int ni = 0; ni < 2; ++ni) ob[(size_t)a * 1024 + nt * 128 + wc * 64 + ni * 32 + c] = f2bf(acc[mi][ni][r] * w);
                }
            }
    }
};

DI void phase_init(const Params& p, unsigned char* smem, int bid, int nb, int tid) {
    float* sc = (float*)smem;
    float* red = (float*)(smem + 32768);
    const int NMOD = DEPTH * 96, NROPE = 256, NITEM = NMOD + NROPE + 1;
    for (int item = bid; item < NITEM; item += nb) {
        if (item < NMOD) {
            __syncthreads();
            for (int i = tid; i < 8 * 1024; i += 256) { const float v = p.c[i]; sc[i] = v / (1.f + __expf(-v)); }
            __syncthreads();
            const int l = item / 96, jb = item % 96, cq = tid & 15, ksl = tid >> 4;
            const float* w = p.ada_w + (size_t)l * 1024 * 6144 + jb * 64 + cq * 4;
            f32x4 acc[8];
#pragma unroll
            for (int b = 0; b < 8; ++b) acc[b] = (f32x4){0.f, 0.f, 0.f, 0.f};
            for (int ii = 0; ii < 64; ++ii) {
                const int i = ksl * 64 + ii;
                const f32x4 wv = *(const f32x4*)(w + (size_t)i * 6144);
#pragma unroll
                for (int b = 0; b < 8; ++b) acc[b] += wv * sc[b * 1024 + i];
            }
#pragma unroll
            for (int b = 0; b < 8; ++b) *(f32x4*)(red + (ksl * 8 + b) * 64 + cq * 4) = acc[b];
            __syncthreads();
            for (int o = tid; o < 512; o += 256) {
                const int b = o >> 6, cc = o & 63; float s = 0.f;
                for (int k = 0; k < 16; ++k) s += red[(k * 8 + b) * 64 + cc];
                ((float*)(p.ws + WS_MOD))[((size_t)l * 8 + b) * 6144 + jb * 64 + cc] = s + p.ada_b[l * 6144 + jb * 64 + cc];
            }
        } else if (item < NMOD + NROPE) {
            const int idx = (item - NMOD) * 256 + tid;
            const int pos = idx >> 5, i = idx & 31;
            const float inv = 1.0f / powf(10000.0f, (float)(2 * i) / 64.0f);
            const float ang = (float)pos * inv;
            ((float*)(p.ws + WS_ROPEC))[idx] = cosf(ang);
            ((float*)(p.ws + WS_ROPES))[idx] = sinf(ang);
        } else {
            if (tid < DEPTH * 32) ((int*)(p.ws + WS_ECNT))[tid] = 0;
        }
    }
}

DI void phase_norm(const Params& p, int layer, const float* src, int bid, int nb, int tid) {
    const int lane = tid & 63, wid = tid >> 6;
    const float* mod = (const float*)(p.ws + WS_MOD) + (size_t)layer * 8 * 6144;
    const float* gam = p.norm_mix + layer * 1024;
    bf16_t* H = (bf16_t*)(p.ws + WS_H);
    for (int item = bid; item < T / 4; item += nb) {
        const int t = item * 4 + wid, b = t >> 11;
        const float* xr = src + (size_t)t * 1024;
        f32x4 v[4]; float ss = 0.f;
#pragma unroll
        for (int i = 0; i < 4; ++i) { v[i] = *(const f32x4*)(xr + (lane + 64 * i) * 4); ss += v[i][0] * v[i][0] + v[i][1] * v[i][1] + v[i][2] * v[i][2] + v[i][3] * v[i][3]; }
        ss = wave_sum(ss);
        const float rstd = rsqrtf(ss * (1.f / 1024.f) + EPS);
#pragma unroll
        for (int i = 0; i < 4; ++i) {
            const int c0 = (lane + 64 * i) * 4;
            const f32x4 g = *(const f32x4*)(gam + c0), sh = *(const f32x4*)(mod + b * 6144 + c0), sc = *(const f32x4*)(mod + b * 6144 + 1024 + c0);
            f32x4 h = v[i] * rstd * g * (sc + 1.f) + sh;
            u32x2 o = {pk2(h[0], h[1]), pk2(h[2], h[3])};
            *(u32x2*)(H + (size_t)t * 1024 + c0) = o;
        }
    }
}

DI void phase_ffn_norm_router(const Params& p, int layer, unsigned char* smem, int bid, int nb, int tid) {
    float* rstd_s = (float*)smem;
    float* Wc = (float*)(smem + 256);
    float* hs = (float*)(smem + 256 + 64 * 40 * 4);
    float* lg = (float*)(smem + 256 + 64 * 40 * 4 + 32 * 65 * 4);
    const int lane = tid & 63, wid = tid >> 6;
    const float* mod = (const float*)(p.ws + WS_MOD) + (size_t)layer * 8 * 6144;
    const float* gam = p.norm_ffn + layer * 1024;
    const float* wg = p.moe_w_group + (size_t)layer * 1024 * 4;
    const float* we = p.moe_w_expert + (size_t)layer * 1024 * 32;
    bf16_t* H = (bf16_t*)(p.ws + WS_H);
    int* ecnt = (int*)(p.ws + WS_ECNT) + layer * 32;
    int* elist = (int*)(p.ws + WS_ELIST);
    float* ew = (float*)(p.ws + WS_EW);
    for (int item = bid; item < T / 32; item += nb) {
        const int t0 = item * 32, b = t0 >> 11;
        __syncthreads();
        for (int rr = 0; rr < 8; ++rr) {
            const float* xr = p.out + (size_t)(t0 + wid * 8 + rr) * 1024; float ss = 0.f;
#pragma unroll
            for (int i = 0; i < 4; ++i) { const f32x4 v = *(const f32x4*)(xr + (lane + 64 * i) * 4); ss += v[0] * v[0] + v[1] * v[1] + v[2] * v[2] + v[3] * v[3]; }
            ss = wave_sum(ss);
            if (lane == 0) rstd_s[wid * 8 + rr] = rsqrtf(ss * (1.f / 1024.f) + EPS);
        }
        float acc[5] = {0.f, 0.f, 0.f, 0.f, 0.f};
        const int tok = tid & 31, og = tid >> 5;
        for (int kc = 0; kc < 16; ++kc) {
            const int k0 = kc * 64;
            __syncthreads();
            for (int idx = tid; idx < 64 * 36; idx += 256) { const int kk = idx / 36, o = idx % 36; Wc[kk * 40 + o] = o < 4 ? wg[(k0 + kk) * 4 + o] : we[(k0 + kk) * 32 + o - 4]; }
            if (tid < 64) { Wc[tid * 40 + 36] = 0.f; Wc[tid * 40 + 37] = 0.f; Wc[tid * 40 + 38] = 0.f; Wc[tid * 40 + 39] = 0.f; }
#pragma unroll
            for (int i = 0; i < 2; ++i) {
                const int tk = tid >> 3, c0 = ((tid & 7) * 2 + i) * 4, col = k0 + c0, t = t0 + tk;
                const f32x4 v = *(const f32x4*)(p.out + (size_t)t * 1024 + col);
                const f32x4 g = *(const f32x4*)(gam + col), sh = *(const f32x4*)(mod + b * 6144 + 3072 + col), sc = *(const f32x4*)(mod + b * 6144 + 4096 + col);
                const f32x4 h = v * rstd_s[tk] * g * (sc + 1.f) + sh;
                u32x2 o = {pk2(h[0], h[1]), pk2(h[2], h[3])};
                *(u32x2*)(H + (size_t)t * 1024 + col) = o;
                hs[tk * 65 + c0] = h[0]; hs[tk * 65 + c0 + 1] = h[1]; hs[tk * 65 + c0 + 2] = h[2]; hs[tk * 65 + c0 + 3] = h[3];
            }
            __syncthreads();
            for (int kk = 0; kk < 64; ++kk) {
                const float hv = hs[tok * 65 + kk];
#pragma unroll
                for (int j = 0; j < 5; ++j) acc[j] += hv * Wc[kk * 40 + og * 5 + j];
            }
        }
#pragma unroll
        for (int j = 0; j < 5; ++j) lg[tok * 40 + og * 5 + j] = acc[j];
        __syncthreads();
        if (tid < 32) {
            const int t = t0 + tid;
            float gl[4]; float gmax = -INFINITY; int gsel = 0;
#pragma unroll
            for (int g = 0; g < 4; ++g) { gl[g] = lg[tid * 40 + g] + p.moe_b_group[layer * 4 + g]; if (gl[g] > gmax) { gmax = gl[g]; gsel = g; } }
            float gsum = 0.f;
#pragma unroll
            for (int g = 0; g < 4; ++g) gsum += __expf(gl[g] - gmax);
            const float pg = 1.f / gsum;
            float v1 = -INFINITY, v2 = -INFINITY; int i1 = 0, i2 = 0;
            for (int jx = 0; jx < 8; ++jx) {
                const float v = lg[tid * 40 + 4 + gsel * 8 + jx] + p.moe_b_expert[layer * 32 + gsel * 8 + jx];
                if (v > v1) { v2 = v1; i2 = i1; v1 = v; i1 = jx; } else if (v > v2) { v2 = v; i2 = jx; }
            }
            const float e2 = __expf(v2 - v1), den = 1.f / (1.f + e2);
            const float w1 = pg * den, w2 = pg * e2 * den;
            const int ea = gsel * 8 + i1, eb = gsel * 8 + i2;
            const int ra = atomicAdd(&ecnt[ea], 1); elist[(size_t)ea * NASG + ra] = t * 2; ew[t * 2] = w1;
            const int rb = atomicAdd(&ecnt[eb], 1); elist[(size_t)eb * NASG + rb] = t * 2 + 1; ew[t * 2 + 1] = w2;
        }
    }
}

template <class PR> DI void phase_hyb_in(const Params& p, int j, unsigned char* smem, int bid, int nb, int tid) {
    const int NT = 22, NI = (T / 128) * NT;
    for (int item = bid; item < NI; item += nb) { HybIn pr{&p, j, item / NT, item % NT}; gemm_tile(pr, smem, tid); }
}
DI void phase_ml_in(const Params& p, int j, unsigned char* smem, int bid, int nb, int tid) {
    const int NT = 25, NI = (T / 128) * NT;
    for (int item = bid; item < NI; item += nb) { MlIn pr{&p, j, item / NT, item % NT}; gemm_tile(pr, smem, tid); }
}
DI void phase_out_proj(const Params& p, int layer, const float* W, const float* src, unsigned char* smem, int bid, int nb, int tid) {
    const int NT = 8, NI = (T / 128) * NT;
    for (int item = bid; item < NI; item += nb) { OutProj pr{&p, W, src, layer, item / NT, item % NT}; gemm_tile(pr, smem, tid); }
}
template <int WHICH> DI void phase_moe(const Params& p, int layer, unsigned char* smem, int bid, int nb, int tid) {
    int* toff = (int*)(smem + 40960);
    int* roffs = toff + 40;
    __syncthreads();
    if (tid == 0) {
        const int* ecnt = (const int*)(p.ws + WS_ECNT) + layer * 32;
        int ta = 0, ra = 0;
        for (int e = 0; e < 32; ++e) { const int c = ecnt[e]; toff[e] = ta; roffs[e] = ra; ta += (c + 127) >> 7; ra += c; }
        toff[32] = ta; roffs[32] = ra;
    }
    __syncthreads();
    const int total = toff[32] * 8;
    for (int item = bid; item < total; item += nb) {
        const int mg = item >> 3, nt = item & 7;
        int e = 0;
        while (e < 31 && toff[e + 1] <= mg) ++e;
        const int cnt = roffs[e + 1] - roffs[e];
        if (WHICH == 1) { Moe1 pr{&p, layer, e, mg - toff[e], nt, cnt, roffs[e]}; gemm_tile(pr, smem, tid); }
        else { Moe2 pr{&p, layer, e, mg - toff[e], nt, cnt, roffs[e]}; gemm_tile(pr, smem, tid); }
    }
}

DI void phase_combine(const Params& p, int layer, int bid, int nb, int tid) {
    const float* mod = (const float*)(p.ws + WS_MOD) + (size_t)layer * 8 * 6144;
    const bf16_t* Y = (const bf16_t*)(p.ws + WS_Y);
    for (int item = bid; item < T; item += nb) {
        const int t = item, b = t >> 11, c0 = tid * 4;
        f32x4 v = *(const f32x4*)(p.out + (size_t)t * 1024 + c0);
        const f32x4 g = *(const f32x4*)(mod + b * 6144 + 5120 + c0);
        const u32x2 y0 = *(const u32x2*)(Y + (size_t)(2 * t) * 1024 + c0), y1 = *(const u32x2*)(Y + (size_t)(2 * t + 1) * 1024 + c0);
        v[0] += g[0] * (bflo(y0[0]) + bflo(y1[0])); v[1] += g[1] * (bfhi(y0[0]) + bfhi(y1[0]));
        v[2] += g[2] * (bflo(y0[1]) + bflo(y1[1])); v[3] += g[3] * (bfhi(y0[1]) + bfhi(y1[1]));
        *(f32x4*)(p.out + (size_t)t * 1024 + c0) = v;
    }
}

DI void phase_scores(const Params& p, unsigned char* smem, int bid, int nb, int tid) {
    float* iqs = (float*)smem;
    float* iws = iqs + 512;
    const bf16_t* IQ = (const bf16_t*)(p.ws + WS_IQ);
    const bf16_t* IK = (const bf16_t*)(p.ws + WS_IK);
    const float* IW = (const float*)(p.ws + WS_IW);
    float* SC = (float*)(p.ws + WS_SCORE);
    for (int item = bid; item < T; item += nb) {
        const int t = item, b = t >> 11, pos = t & (S - 1);
        __syncthreads();
        for (int i = tid; i < 512; i += 256) iqs[i] = bf2f(IQ[(size_t)t * 512 + i]);
        if (tid < 8) iws[tid] = IW[(size_t)t * 8 + tid];
        __syncthreads();
        for (int s = tid; s <= pos; s += 256) {
            const u32x4* kr = (const u32x4*)(IK + (size_t)(b * S + s) * 64);
            u32x4 ku[8];
#pragma unroll
            for (int q = 0; q < 8; ++q) ku[q] = kr[q];
            float sc = 0.f;
#pragma unroll 1
            for (int h = 0; h < 8; ++h) { float d = 0.f;
#pragma unroll
                for (int q = 0; q < 8; ++q)
#pragma unroll
                    for (int e = 0; e < 4; ++e) d += iqs[h * 64 + q * 8 + e * 2] * bflo(ku[q][e]) + iqs[h * 64 + q * 8 + e * 2 + 1] * bfhi(ku[q][e]);
                sc += fmaxf(d, 0.f) * iws[h]; }
            SC[((size_t)t) * S + s] = sc;
        }
    }
}

DI void phase_select(const Params& p, int bid, int nb, int tid) {
    const int lane = tid & 63, wid = tid >> 6;
    const float* SC = (const float*)(p.ws + WS_SCORE);
    unsigned* MASK = (unsigned*)(p.ws + WS_MASK);
    for (int item = bid; item < T / 4; item += nb) {
        const int t = item * 4 + wid, pos = t & (S - 1);
        unsigned* mrow = MASK + (size_t)t * 64;
        if (pos < 256) {
            const int w = lane;
            unsigned m;
            if (32 * w + 31 <= pos) m = 0xffffffffu; else if (32 * w > pos) m = 0u; else m = (2u << (pos - 32 * w)) - 1u;
            mrow[w] = m;
            continue;
        }
        unsigned key[32];
#pragma unroll
        for (int i = 0; i < 32; ++i) {
            const int s = lane + 64 * i;
            unsigned k = 0u;
            if (s <= pos) { const unsigned u = __float_as_uint(SC[(size_t)t * S + s]); k = (u & 0x80000000u) ? ~u : (u | 0x80000000u); }
            key[i] = k;
        }
        unsigned v = 0u;
        for (int bit = 31; bit >= 0; --bit) {
            const unsigned cand = v | (1u << bit);
            int cnt = 0;
#pragma unroll
            for (int i = 0; i < 32; ++i) cnt += __popcll(__ballot(key[i] >= cand));
            if (cnt >= 256) v = cand;
        }
        int cgt = 0;
#pragma unroll
        for (int i = 0; i < 32; ++i) cgt += __popcll(__ballot(key[i] > v));
        const int need = 256 - cgt;
        int run = 0;
        const unsigned long long lt = (1ull << lane) - 1ull;
#pragma unroll
        for (int i = 0; i < 32; ++i) {
            const unsigned long long tie = __ballot(key[i] == v);
            const int pre = run + __popcll(tie & lt);
            const bool sel = key[i] > v || (key[i] == v && pre < need);
            run += __popcll(tie);
            const unsigned long long sm = __ballot(sel);
            if (lane == 0) { mrow[2 * i] = (unsigned)sm; mrow[2 * i + 1] = (unsigned)(sm >> 32); }
        }
    }
}

DI void phase_attn(const Params& p, unsigned char* smem, int bid, int nb, int tid) {
    int* list = (int*)smem;
    int* pre = list + 256;
    float* qs = (float*)(pre + 72);
    float* pb = qs + 512;
    const int lane = tid & 63, wid = tid >> 6;
    const unsigned* MASK = (const unsigned*)(p.ws + WS_MASK);
    const bf16_t* Q = (const bf16_t*)(p.ws + WS_Q);
    const bf16_t* K = (const bf16_t*)(p.ws + WS_K);
    const bf16_t* V = (const bf16_t*)(p.ws + WS_V);
    bf16_t* Y = (bf16_t*)(p.ws + WS_YMIX);
    for (int item = bid; item < T; item += nb) {
        const int t = item, b = t >> 11;
        __syncthreads();
        unsigned mw = 0;
        if (tid < 64) { mw = MASK[(size_t)t * 64 + tid]; pre[tid + 1] = __popc(mw); }
        for (int i = tid; i < 512; i += 256) qs[i] = bf2f(Q[(size_t)t * 512 + i]);
        __syncthreads();
        if (tid == 0) { pre[0] = 0; for (int i = 1; i <= 64; ++i) pre[i] += pre[i - 1]; }
        __syncthreads();
        if (tid < 64) { int o = pre[tid]; unsigned m = mw; while (m) { const int bpos = __ffs(m) - 1; m &= m - 1; list[o++] = 32 * tid + bpos; } }
        __syncthreads();
        const int nsel = pre[64];
        for (int hh = 0; hh < 2; ++hh) {
            const int h = wid + 4 * hh;
            float lgt[4]; float mx = -INFINITY;
#pragma unroll
            for (int jj = 0; jj < 4; ++jj) {
                const int jx = lane + 64 * jj; float l = -INFINITY;
                if (jx < nsel) {
                    const u32x4* kr = (const u32x4*)(K + (size_t)(b * S + list[jx]) * 64);
                    float d = 0.f;
#pragma unroll
                    for (int q = 0; q < 8; ++q) { const u32x4 u = kr[q];
#pragma unroll
                        for (int e = 0; e < 4; ++e) d += qs[h * 64 + q * 8 + e * 2] * bflo(u[e]) + qs[h * 64 + q * 8 + e * 2 + 1] * bfhi(u[e]); }
                    l = d * 0.125f;
                }
                lgt[jj] = l; mx = fmaxf(mx, l);
            }
            mx = wave_max(mx);
            float sum = 0.f;
#pragma unroll
            for (int jj = 0; jj < 4; ++jj) { const int jx = lane + 64 * jj; const float e = jx < nsel ? __expf(lgt[jj] - mx) : 0.f; sum += e; pb[wid * 256 + jx] = e; }
            sum = wave_sum(sum);
            float o = 0.f;
            for (int jx = 0; jx < nsel; ++jx) o += pb[wid * 256 + jx] * bf2f(V[(size_t)(b * S + list[jx]) * 64 + lane]);
            Y[(size_t)t * 1024 + h * 64 + lane] = f2bf(o / sum);
        }
    }
}

DI void phase_conv(const Params& p, int j, int bid, int nb, int tid) {
    const bf16_t* Z = (const bf16_t*)(p.ws + WS_Z);
    const bf16_t* BG = (const bf16_t*)(p.ws + WS_BG);
    bf16_t* Y = (bf16_t*)(p.ws + WS_YMIX);
    const float* cw = p.hy_conv_w + (size_t)j * 3 * 512;
    for (int item = bid; item < T / 4; item += nb) {
        const int t = item * 4 + (tid >> 6), c0 = (tid & 63) * 8, pos = t & (S - 1);
        float acc[8];
#pragma unroll
        for (int e = 0; e < 8; ++e) acc[e] = 0.f;
#pragma unroll
        for (int jj = 0; jj < 3; ++jj) {
            const int dp = jj - 2;
            if (pos + dp >= 0) {
                const u32x4 z = *(const u32x4*)(Z + (size_t)(t + dp) * 512 + c0);
#pragma unroll
                for (int e = 0; e < 4; ++e) { acc[2 * e] += cw[jj * 512 + c0 + 2 * e] * bflo(z[e]); acc[2 * e + 1] += cw[jj * 512 + c0 + 2 * e + 1] * bfhi(z[e]); }
            }
        }
        const u32x4 g = *(const u32x4*)(BG + (size_t)t * 512 + c0);
        u32x4 o;
#pragma unroll
        for (int e = 0; e < 4; ++e) o[e] = pk2(acc[2 * e] * bflo(g[e]), acc[2 * e + 1] * bfhi(g[e]));
        *(u32x4*)(Y + (size_t)t * 1024 + 512 + c0) = o;
    }
}

DI void phase_mlstm_naive(const Params& p, int j, unsigned char* smem, int bid, int nb, int tid) {
    float* C = (float*)smem;
    float* qs = C + 128 * 65;
    float* ks = qs + 64 * 65;
    float* vs = ks + 64 * 65;
    float* Sm = vs + 64 * 129;
    float* hb = Sm + 64 * 65;
    float* nv = hb + 64 * 129;
    float* bc = nv + 64;
    float* iv = bc + 64;
    float* mt = iv + 64;
    float* wi = mt + 64;
    float* wsv = wi + 64;
    float* den = wsv + 64;
    float* scal = den + 64;
    const bf16_t* MQ = (const bf16_t*)(p.ws + WS_MQ);
    const bf16_t* MK = (const bf16_t*)(p.ws + WS_MK);
    const bf16_t* MV = (const bf16_t*)(p.ws + WS_MV);
    const float* MIG = (const float*)(p.ws + WS_MIG);
    const float* MFG = (const float*)(p.ws + WS_MFG);
    const bf16_t* MOG = (const bf16_t*)(p.ws + WS_MOG);
    bf16_t* Y = (bf16_t*)(p.ws + WS_YMIX);
    const int lane = tid & 63, wid = tid >> 6;
    for (int item = bid; item < 64; item += nb) {
        const int b = item >> 3, h = item & 7;
        __syncthreads();
        for (int i = tid; i < 128 * 65; i += 256) C[i] = 0.f;
        if (tid < 64) nv[tid] = 0.f;
        if (tid == 0) scal[0] = 0.f;
        for (int ch = 0; ch < 32; ++ch) {
            const int tb = b * S + ch * 64;
            __syncthreads();
            for (int i = tid; i < 64 * 64; i += 256) { const int r = i >> 6, d = i & 63; qs[r * 65 + d] = bf2f(MQ[(size_t)(tb + r) * 512 + h * 64 + d]); ks[r * 65 + d] = bf2f(MK[(size_t)(tb + r) * 512 + h * 64 + d]); }
            for (int i = tid; i < 64 * 128; i += 256) { const int r = i >> 7, d = i & 127; vs[r * 129 + d] = bf2f(MV[(size_t)(tb + r) * 1024 + h * 128 + d]); }
            if (tid < 64) { iv[tid] = MIG[(size_t)(tb + tid) * 8 + h]; bc[tid] = MFG[(size_t)(tb + tid) * 8 + h]; }
            __syncthreads();
            if (tid == 0) { float a = 0.f; for (int i = 0; i < 64; ++i) { a += bc[i]; bc[i] = a; } }
            __syncthreads();
            const float m = scal[0], blast = bc[63];
            if (tid < 64) {
                const int tt = tid; float mi = -INFINITY;
                for (int s2 = 0; s2 <= tt; ++s2) mi = fmaxf(mi, bc[tt] - bc[s2] + iv[s2]);
                const float inter = bc[tt] + m, mtt = fmaxf(inter, mi);
                mt[tt] = mtt; wi[tt] = __expf(inter - mtt);
                float gmax = wave_max(blast - bc[tt] + iv[tt]);
                const float mnew = fmaxf(blast + m, gmax);
                wsv[tt] = __expf(blast - bc[tt] + iv[tt] - mnew);
                if (tt == 0) { scal[1] = mnew; scal[2] = __expf(blast + m - mnew); }
            }
            __syncthreads();
            for (int i = tid; i < 64 * 64; i += 256) {
                const int tt = i >> 6, s2 = i & 63; float v = 0.f;
                if (s2 <= tt) { float d = 0.f; for (int e = 0; e < 64; ++e) d += qs[tt * 65 + e] * ks[s2 * 65 + e]; v = __expf(bc[tt] - bc[s2] + iv[s2] - mt[tt]) * d; }
                Sm[tt * 65 + s2] = v;
            }
            __syncthreads();
            if (tid < 64) { const int tt = tid; float a = 0.f, r = 0.f; for (int e = 0; e < 64; ++e) { a += nv[e] * qs[tt * 65 + e]; r += Sm[tt * 65 + e]; } den[tt] = wi[tt] * a + r; }
            __syncthreads();
            {
                const int vv = tid & 127, th = tid >> 7;
                for (int ii = 0; ii < 32; ++ii) {
                    const int tt = th * 32 + ii; float a = 0.f, r = 0.f;
                    for (int e = 0; e < 64; ++e) { a += C[vv * 65 + e] * qs[tt * 65 + e]; r += Sm[tt * 65 + e] * vs[e * 129 + vv]; }
                    const float num = wi[tt] * a + r;
                    hb[tt * 129 + vv] = num / fmaxf(fabsf(den[tt]), __expf(-mt[tt]));
                }
            }
            __syncthreads();
            {
                const float decay = scal[2];
                const int vv = tid & 127, dh = tid >> 7;
                for (int ii = 0; ii < 32; ++ii) {
                    const int d = dh * 32 + ii; float a = 0.f;
                    for (int s2 = 0; s2 < 64; ++s2) a += wsv[s2] * vs[s2 * 129 + vv] * ks[s2 * 65 + d];
                    C[vv * 65 + d] = decay * C[vv * 65 + d] + a;
                }
                if (tid < 64) { float a = 0.f; for (int s2 = 0; s2 < 64; ++s2) a += wsv[s2] * ks[s2 * 65 + tid]; nv[tid] = decay * nv[tid] + a; }
                if (tid == 255) scal[0] = scal[1];
            }
            for (int rr = 0; rr < 16; ++rr) {
                const int tt = wid * 16 + rr;
                const float a0 = hb[tt * 129 + lane], a1 = hb[tt * 129 + 64 + lane];
                const float ss = wave_sum(a0 * a0 + a1 * a1);
                const float rstd = rsqrtf(ss * (1.f / 128.f) + EPS);
                const size_t o = (size_t)(tb + tt) * 1024 + h * 128;
                Y[o + lane] = f2bf(a0 * rstd * p.ml_out_norm[j * 1024 + h * 128 + lane] * bf2f(MOG[o + lane]));
                Y[o + 64 + lane] = f2bf(a1 * rstd * p.ml_out_norm[j * 1024 + h * 128 + 64 + lane] * bf2f(MOG[o + 64 + lane]));
            }
        }
    }
}

enum { PH_INIT, PH_NORM, PH_HYB_IN, PH_SCORES, PH_SELECT, PH_ATTN, PH_CONV, PH_OUT, PH_ML_IN, PH_MLSTM, PH_FFN_NORM, PH_MOE1, PH_MOE2, PH_COMBINE };

template <int PH, int LDSB>
__global__ void __launch_bounds__(256) k_phase(Params p, int layer) {
    __shared__ __attribute__((aligned(16))) unsigned char smem[LDSB];
    const int bid = blockIdx.x, nb = gridDim.x, tid = threadIdx.x;
    const int j = layer >> 1;
    const float* src = layer == 0 ? p.x : p.out;
    if (PH == PH_INIT) phase_init(p, smem, bid, nb, tid);
    else if (PH == PH_NORM) phase_norm(p, layer, src, bid, nb, tid);
    else if (PH == PH_HYB_IN) phase_hyb_in<HybIn>(p, j, smem, bid, nb, tid);
    else if (PH == PH_SCORES) phase_scores(p, smem, bid, nb, tid);
    else if (PH == PH_SELECT) phase_select(p, bid, nb, tid);
    else if (PH == PH_ATTN) phase_attn(p, smem, bid, nb, tid);
    else if (PH == PH_CONV) phase_conv(p, j, bid, nb, tid);
    else if (PH == PH_OUT) phase_out_proj(p, layer, (layer & 1) ? p.ml_w_out + (size_t)j * 1024 * 1024 : p.hy_w_out + (size_t)j * 1024 * 1024, src, smem, bid, nb, tid);
    else if (PH == PH_ML_IN) phase_ml_in(p, j, smem, bid, nb, tid);
    else if (PH == PH_MLSTM) phase_mlstm_naive(p, j, smem, bid, nb, tid);
    else if (PH == PH_FFN_NORM) phase_ffn_norm_router(p, layer, smem, bid, nb, tid);
    else if (PH == PH_MOE1) phase_moe<1>(p, layer, smem, bid, nb, tid);
    else if (PH == PH_MOE2) phase_moe<2>(p, layer, smem, bid, nb, tid);
    else if (PH == PH_COMBINE) phase_combine(p, layer, bid, nb, tid);
}

extern "C" void kernel_launch(void* const* d_in, const int* in_sizes, int n_in, void* d_out, int out_size, void* d_ws, size_t ws_size, hipStream_t stream) {
    Params p{};
    const float** f = (const float**)&p;
    for (int i = 0; i < 22; ++i) f[i] = (const float*)d_in[i];
    p.out = (float*)d_out;
    p.ws = (unsigned char*)d_ws;
    if (ws_size < WS_END) { fprintf(stderr, "workspace too small: %zu < %zu\n", ws_size, (size_t)WS_END); return; }
    const int G = 2048;
    k_phase<PH_INIT, 65536><<<641, 256, 0, stream>>>(p, 0);
    for (int l = 0; l < DEPTH; ++l) {
        k_phase<PH_NORM, 16><<<G, 256, 0, stream>>>(p, l);
        if ((l & 1) == 0) {
            k_phase<PH_HYB_IN, 32768><<<G, 256, 0, stream>>>(p, l);
            k_phase<PH_SCORES, 4096><<<G * 2, 256, 0, stream>>>(p, l);
            k_phase<PH_SELECT, 16><<<G, 256, 0, stream>>>(p, l);
            k_phase<PH_ATTN, 8192><<<G * 2, 256, 0, stream>>>(p, l);
            k_phase<PH_CONV, 16><<<G, 256, 0, stream>>>(p, l);
        } else {
            k_phase<PH_ML_IN, 32768><<<G, 256, 0, stream>>>(p, l);
            k_phase<PH_MLSTM, 160000><<<64, 256, 0, stream>>>(p, l);
        }
        k_phase<PH_OUT, 32768><<<1024, 256, 0, stream>>>(p, l);
        k_phase<PH_FFN_NORM, 32768><<<512, 256, 0, stream>>>(p, l);
        k_phase<PH_MOE1, 45056><<<G, 256, 0, stream>>>(p, l);
        k_phase<PH_MOE2, 45056><<<G, 256, 0, stream>>>(p, l);
        k_phase<PH_COMBINE, 16><<<G * 2, 256, 0, stream>>>(p, l);
    }
}
```

```cpp
#include <hip/hip_runtime.h>
#include <hip/hip_cooperative_groups.h>
#include <stdint.h>
#include <cstdio>

#define DI __device__ __forceinline__
typedef unsigned short bf16_t;
typedef short bf16x8 __attribute__((ext_vector_type(8)));
typedef float f32x16 __attribute__((ext_vector_type(16)));
typedef float f32x4 __attribute__((ext_vector_type(4)));
typedef float f32x2 __attribute__((ext_vector_type(2)));
typedef unsigned u32x4 __attribute__((ext_vector_type(4)));
typedef unsigned u32x2 __attribute__((ext_vector_type(2)));
typedef __bf16 bf16x2_t __attribute__((ext_vector_type(2)));

constexpr int D = 1024, NB = 8, S = 2048, T = NB * S, DEPTH = 4;
constexpr int HYB_IN = 2760, ML_IN = 3088;
constexpr int NEXP = 32, DEXP = 512, NASG = T * 2;
constexpr float EPS = 1e-6f;
constexpr int XCD_BAR_WORDS_C = 3456;

constexpr size_t al256(size_t x) { return (x + 255) & ~(size_t)255; }
constexpr size_t WS_MOD = 0;
constexpr size_t WS_ROPEC = WS_MOD + al256((size_t)4 * 8 * 6144 * 4);
constexpr size_t WS_ROPES = WS_ROPEC + al256((size_t)2048 * 32 * 4);
constexpr size_t WS_ECNT = WS_ROPES + al256((size_t)2048 * 32 * 4);
constexpr int ECS = 64;
constexpr size_t WS_H = WS_ECNT + al256(4 * 32 * ECS * 4);
constexpr size_t WS_YMIX = WS_H + al256((size_t)T * 1024 * 2);
constexpr size_t WS_Q = WS_YMIX + al256((size_t)T * 1024 * 2);
constexpr size_t WS_K = WS_Q + al256((size_t)T * 512 * 2);
constexpr size_t WS_V = WS_K + al256((size_t)T * 64 * 2);
constexpr size_t WS_IQ = WS_V + al256((size_t)T * 64 * 2);
constexpr size_t WS_IK = WS_IQ + al256((size_t)T * 512 * 2);
constexpr size_t WS_IW = WS_IK + al256((size_t)T * 64 * 2);
constexpr size_t WS_BG = WS_IW + al256((size_t)T * 8 * 4);
constexpr size_t WS_Z = WS_BG + al256((size_t)T * 512 * 2);
constexpr size_t WS_MASK = WS_Z + al256((size_t)T * 512 * 2);
constexpr size_t WS_MQ = WS_MASK + al256((size_t)T * 64 * 4);
constexpr size_t WS_MK = WS_MQ + al256((size_t)T * 512 * 2);
constexpr size_t WS_MV = WS_MK + al256((size_t)T * 512 * 2);
constexpr size_t WS_MIG = WS_MV + al256((size_t)T * 1024 * 2);
constexpr size_t WS_MFG = WS_MIG + al256((size_t)T * 8 * 4);
constexpr size_t WS_MOG = WS_MFG + al256((size_t)T * 8 * 4);
constexpr size_t WS_EW = WS_MOG + al256((size_t)T * 1024 * 2);
constexpr size_t WS_ELIST = WS_EW + al256((size_t)NASG * 4);
constexpr size_t WS_H1 = WS_ELIST + al256((size_t)NEXP * NASG * 4);
constexpr size_t WS_Y = WS_H1 + al256((size_t)NASG * 512 * 2);
constexpr size_t WS_MKT = WS_Y + al256((size_t)NASG * 1024 * 2);
constexpr size_t WS_UBUF = WS_MKT + al256((size_t)64 * 64 * S * 2);
constexpr size_t WS_UNBUF = WS_UBUF + al256((size_t)64 * 32 * 8192 * 4);
constexpr size_t WS_MLOC = WS_UNBUF + al256((size_t)64 * 32 * 64 * 4);
constexpr size_t WS_CBUF = WS_MLOC + al256((size_t)64 * 32 * 2 * 4);
constexpr size_t WS_NBUF = WS_CBUF + al256((size_t)64 * 32 * 8192 * 2);
constexpr size_t WS_MST = WS_NBUF + al256((size_t)64 * 32 * 64 * 4);
constexpr size_t WS_PART = WS_MST + al256((size_t)64 * 32 * 4);
constexpr size_t WS_WHYB = WS_PART + al256((size_t)T * 16 * 4);
constexpr size_t WS_WML = WS_WHYB + al256((size_t)2 * 2816 * 1024 * 2);
constexpr size_t WS_WOUT = WS_WML + al256((size_t)2 * 3200 * 1024 * 2);
constexpr size_t WS_WM1 = WS_WOUT + al256((size_t)4 * 1024 * 1024 * 2);
constexpr size_t WS_WM2 = WS_WM1 + al256((size_t)4 * 32 * 1024 * 1024 * 2);
constexpr size_t WS_BAR = WS_WM2 + al256((size_t)4 * 32 * 1024 * 512 * 2);
constexpr size_t WS_END = WS_BAR + al256((size_t)XCD_BAR_WORDS_C * 4);

struct Params {
    const float *x, *c, *ada_w, *ada_b, *norm_mix, *norm_ffn, *hy_w_in, *hy_q_norm, *hy_k_norm, *hy_conv_w, *hy_w_out;
    const float *ml_w_in, *ml_b_gates, *ml_out_norm, *ml_w_out, *moe_w_group, *moe_b_group, *moe_w_expert, *moe_b_expert;
    const float *moe_w_gate, *moe_w_up, *moe_w_down;
    float* out;
    unsigned char* ws;
    unsigned long long use_cg_sync;
};

DI unsigned pk2(float lo, float hi) { f32x2 v = {lo, hi}; bf16x2_t b = __builtin_convertvector(v, bf16x2_t); return __builtin_bit_cast(unsigned, b); }
DI bf16_t f2bf(float x) { return (bf16_t)(pk2(x, 0.f) & 0xffffu); }
DI float bf2f(bf16_t h) { return __uint_as_float(((unsigned)h) << 16); }
DI float bflo(unsigned u) { return __uint_as_float(u << 16); }
DI float bfhi(unsigned u) { return __uint_as_float(u & 0xffff0000u); }
DI float wave_sum(float v) { for (int m = 32; m >= 1; m >>= 1) v += __shfl_xor(v, m); return v; }
DI float wave_max(float v) { for (int m = 32; m >= 1; m >>= 1) v = fmaxf(v, __shfl_xor(v, m)); return v; }
DI float half_sum(float v) { for (int m = 16; m >= 1; m >>= 1) v += __shfl_xor(v, m); return v; }
DI float sigmoidf_(float x) { return 1.f / (1.f + __expf(-x)); }
DI int opq(int x) { asm volatile("" : "+v"(x)); return x; }

DI int swz(int row, int slot) { return row * 128 + ((slot ^ ((row >> 1) & 7)) << 4); }
DI int crow(int reg, int lane) { return (reg & 3) + 8 * (reg >> 2) + 4 * (lane >> 5); }

template <class P>
DI void gemm_tile(const P& pr, unsigned char* smem, int tid) {
    const int lane = tid & 63, wid = tid >> 6, wr = wid >> 1, wc = wid & 1;
    const bf16_t* abase = pr.a_base();
    const bf16_t* bbase = pr.b_base();
    const int kdim = pr.kt() * 64;
    int gao[4], gbo[4];
#pragma unroll
    for (int i = 0; i < 4; ++i) {
        const int row = (tid >> 3) + 32 * i, sl = (tid & 7) ^ ((row >> 1) & 7);
        const int o = pr.a_off(row);
        gao[i] = (o >= 0 ? o : 0) + sl * 8; gbo[i] = row * kdim + sl * 8;
    }
#define GLDS(buf, kt) do { _Pragma("unroll") for (int i = 0; i < 4; ++i) { \
        __builtin_amdgcn_global_load_lds((const unsigned*)(abase + gao[i] + (kt) * 64), (__attribute__((address_space(3))) unsigned*)(smem + (buf) * 32768 + (i * 256 + wid * 64) * 16), 16, 0, 0); \
        __builtin_amdgcn_global_load_lds((const unsigned*)(bbase + gbo[i] + (kt) * 64), (__attribute__((address_space(3))) unsigned*)(smem + (buf) * 32768 + 16384 + (i * 256 + wid * 64) * 16), 16, 0, 0); } } while (0)
#define DMA_WAIT_SYNC() do { asm volatile("s_waitcnt vmcnt(0)" ::: "memory"); __syncthreads(); } while (0)
#define COMPUTE(buf) do { const unsigned char* As = smem + (buf) * 32768; const unsigned char* Bs = As + 16384; \
        _Pragma("unroll") for (int ks = 0; ks < 4; ++ks) { const int slot = ks * 2 + (lane >> 5); \
            const bf16x8 a0 = *(const bf16x8*)(As + swz(wr * 64 + (lane & 31), slot)); const bf16x8 a1 = *(const bf16x8*)(As + swz(wr * 64 + 32 + (lane & 31), slot)); \
            const bf16x8 b0 = *(const bf16x8*)(Bs + swz(wc * 64 + (lane & 31), slot)); const bf16x8 b1 = *(const bf16x8*)(Bs + swz(wc * 64 + 32 + (lane & 31), slot)); \
            acc[0][0] = __builtin_amdgcn_mfma_f32_32x32x16_bf16(a0, b0, acc[0][0], 0, 0, 0); acc[0][1] = __builtin_amdgcn_mfma_f32_32x32x16_bf16(a0, b1, acc[0][1], 0, 0, 0); \
            acc[1][0] = __builtin_amdgcn_mfma_f32_32x32x16_bf16(a1, b0, acc[1][0], 0, 0, 0); acc[1][1] = __builtin_amdgcn_mfma_f32_32x32x16_bf16(a1, b1, acc[1][1], 0, 0, 0); } } while (0)
    f32x16 acc[2][2];
#pragma unroll
    for (int a = 0; a < 2; ++a)
#pragma unroll
        for (int b = 0; b < 2; ++b)
#pragma unroll
            for (int r = 0; r < 16; ++r) acc[a][b][r] = 0.f;
    const int KT = pr.kt();
    __syncthreads();
    GLDS(0, 0);
    DMA_WAIT_SYNC();
    for (int kt = 0; kt < KT; kt += 2) {
        GLDS(1, kt + 1);
        COMPUTE(0);
        DMA_WAIT_SYNC();
        if (kt + 2 < KT) GLDS(0, kt + 2);
        COMPUTE(1);
        DMA_WAIT_SYNC();
    }
#undef GLDS
#undef DMA_WAIT_SYNC
#undef COMPUTE
    pr.epi(acc, wr, wc, lane, smem + wid * 8192);
}

template <class P>
DI void convert_tile(const P& pr, bf16_t* dst, int kdim, int kt, unsigned char* smem, int tid) {
    unsigned char* Bs = smem;
    const int ng = tid & 31, kg = tid >> 5;
    int width = 0;
    const float* bp = pr.b_col(ng >> 3, width);
    const int cig = (ng & 7) * 4;
    const bool bvalid = cig < width;
    const int ldb = pr.ldb();
    bp += cig + (size_t)(kt * 64 + kg * 8) * ldb;
    f32x4 rb[8];
#pragma unroll
    for (int kk = 0; kk < 8; ++kk) rb[kk] = bvalid ? *(const f32x4*)(bp + (size_t)kk * ldb) : (f32x4){0.f, 0.f, 0.f, 0.f};
    __syncthreads();
#pragma unroll
    for (int j = 0; j < 4; ++j) {
        u32x4 v = {pk2(rb[0][j], rb[1][j]), pk2(rb[2][j], rb[3][j]), pk2(rb[4][j], rb[5][j]), pk2(rb[6][j], rb[7][j])};
        *(u32x4*)(Bs + swz(ng * 4 + j, kg)) = v;
    }
    __syncthreads();
#pragma unroll
    for (int i = 0; i < 4; ++i) {
        const int n = (tid >> 3) + 32 * i;
        *(u32x4*)(dst + (size_t)n * kdim + kt * 64 + (tid & 7) * 8) = *(const u32x4*)(Bs + swz(n, tid & 7));
    }
}

template <int NC> DI void stage_put(unsigned char* wl, int mi, int ni, int r, int lane, float v) { *(bf16_t*)(wl + ((mi * 32 + crow(r, lane)) * NC + ni * 32 + (lane & 31)) * 2) = f2bf(v); }
template <int NC, class RowPtr> DI void stage_flush(unsigned char* wl, int lane, RowPtr rp) {
    constexpr int CH = NC / 8, RPI = 64 / CH, NIT = 64 / RPI;
#pragma unroll
    for (int i = 0; i < NIT; ++i) {
        const int row = lane / CH + RPI * i, ch = lane % CH;
        const u32x4 d = *(const u32x4*)(wl + (row * NC + ch * 8) * 2);
        bf16_t* dst = rp(row);
        if (dst) *(u32x4*)(dst + ch * 8) = d;
    }
}

struct HybIn {
    const Params* p; int j, tm, tn;
    DI int kt() const { return 16; }
    DI int ldb() const { return HYB_IN; }
    DI const bf16_t* a_base() const { return (const bf16_t*)(p->ws + WS_H); }
    DI int a_off(int r) const { return (tm * 128 + r) * 1024; }
    DI static void pair_cols(int pr, int ni, int& base, int& width) {
        width = 32;
        if (pr < 8) base = 64 * pr + 32 * ni;
        else if (pr == 8) base = 512 + 32 * ni;
        else if (pr == 9) base = 576 + 32 * ni;
        else if (pr < 18) base = 640 + 64 * (pr - 10) + 32 * ni;
        else if (pr == 18) base = 1152 + 32 * ni;
        else if (pr == 19) { base = 1216; width = ni == 0 ? 8 : 0; }
        else if (pr < 28) base = 1224 + 64 * (pr - 20) + 32 * ni;
        else base = (ni == 0 ? 1736 : 2248) + 32 * (pr - 28);
    }
    DI const float* b_col(int g, int& width) const { int base; pair_cols(tn * 2 + (g >> 1), g & 1, base, width); return p->hy_w_in + (size_t)j * 1024 * HYB_IN + base; }
    DI const bf16_t* b_base() const { return (const bf16_t*)(p->ws + WS_WHYB) + (size_t)(j * 22 + tn) * 128 * 1024; }
    DI void epi(f32x16 (&acc)[2][2], int wr, int wc, int lane, unsigned char* wl) const {
        const int pr = tn * 2 + wc, c = lane & 31;
        const int t0 = tm * 128 + wr * 64;
        unsigned char* ws = p->ws;
        const float* ropec = (const float*)(ws + WS_ROPEC);
        const float* ropes = (const float*)(ws + WS_ROPES);
        if (pr < 9 || (pr >= 10 && pr < 19)) {
            const bool donorm = pr < 9;
            const float* gam = pr < 8 ? p->hy_q_norm + j * 64 : p->hy_k_norm + j * 64;
            bf16_t* ob; int ld, cb;
            if (pr < 8) { ob = (bf16_t*)(ws + WS_Q); ld = 512; cb = 64 * pr; }
            else if (pr == 8) { ob = (bf16_t*)(ws + WS_K); ld = 64; cb = 0; }
            else if (pr < 18) { ob = (bf16_t*)(ws + WS_IQ); ld = 512; cb = 64 * (pr - 10); }
            else { ob = (bf16_t*)(ws + WS_IK); ld = 64; cb = 0; }
            float g1 = 1.f, g2 = 1.f;
            if (donorm) { g1 = gam[c]; g2 = gam[c + 32]; }
#pragma unroll
            for (int mi = 0; mi < 2; ++mi)
#pragma unroll
                for (int r = 0; r < 16; ++r) {
                    float x1 = acc[mi][0][r], x2 = acc[mi][1][r];
                    const int t = t0 + mi * 32 + crow(r, lane), pos = t & (S - 1);
                    if (donorm) { float ss = half_sum(x1 * x1 + x2 * x2); float rstd = rsqrtf(ss * (1.f / 64.f) + EPS); x1 *= rstd * g1; x2 *= rstd * g2; }
                    const float cs = ropec[pos * 32 + c], sn = ropes[pos * 32 + c];
                    stage_put<64>(wl, mi, 0, r, lane, x1 * cs - x2 * sn);
                    stage_put<64>(wl, mi, 1, r, lane, x2 * cs + x1 * sn);
                }
            stage_flush<64>(wl, lane, [&](int row) { return ob + (size_t)(t0 + row) * ld + cb; });
        } else if (pr == 9) {
            bf16_t* ob = (bf16_t*)(ws + WS_V);
#pragma unroll
            for (int mi = 0; mi < 2; ++mi)
#pragma unroll
                for (int ni = 0; ni < 2; ++ni)
#pragma unroll
                    for (int g4 = 0; g4 < 4; ++g4) {
                        const int t = t0 + mi * 32 + 8 * g4 + 4 * (lane >> 5), pos = t & (S - 1), bb = t >> 11;
                        u32x2 o = {pk2(acc[mi][ni][4 * g4], acc[mi][ni][4 * g4 + 1]), pk2(acc[mi][ni][4 * g4 + 2], acc[mi][ni][4 * g4 + 3])};
                        *(u32x2*)(ob + ((size_t)(bb * 64 + ni * 32 + c)) * S + pos) = o;
                    }
        } else if (pr == 19) {
            float* ob = (float*)(ws + WS_IW);
            if (c < 8) {
#pragma unroll
                for (int mi = 0; mi < 2; ++mi)
#pragma unroll
                    for (int r = 0; r < 16; ++r) { const int t = t0 + mi * 32 + crow(r, lane); ob[(size_t)t * 8 + c] = acc[mi][0][r] * (0.125f * 0.35355339059327373f); }
            }
        } else if (pr < 28) {
            bf16_t* ob = (bf16_t*)(ws + WS_BG); const int cb = 64 * (pr - 20);
#pragma unroll
            for (int mi = 0; mi < 2; ++mi)
#pragma unroll
                for (int r = 0; r < 16; ++r) { stage_put<64>(wl, mi, 0, r, lane, acc[mi][0][r]); stage_put<64>(wl, mi, 1, r, lane, acc[mi][1][r]); }
            stage_flush<64>(wl, lane, [&](int row) { return ob + (size_t)(t0 + row) * 512 + cb; });
        } else {
            bf16_t* ob = (bf16_t*)(ws + WS_Z); const int cb = 32 * (pr - 28);
#pragma unroll
            for (int mi = 0; mi < 2; ++mi)
#pragma unroll
                for (int r = 0; r < 16; ++r) stage_put<32>(wl, mi, 0, r, lane, acc[mi][0][r] * acc[mi][1][r]);
            stage_flush<32>(wl, lane, [&](int row) { return ob + (size_t)(t0 + row) * 512 + cb; });
        }
    }
};

struct MlIn {
    const Params* p; int j, tm, tn;
    DI int kt() const { return 16; }
    DI int ldb() const { return ML_IN; }
    DI const bf16_t* a_base() const { return (const bf16_t*)(p->ws + WS_H); }
    DI int a_off(int r) const { return (tm * 128 + r) * 1024; }
    DI const float* b_col(int g, int& width) const {
        const int pr = tn * 2 + (g >> 1), ni = g & 1; int base; width = 32;
        if (pr < 32) base = 64 * pr + 32 * ni;
        else if (pr == 32) { base = 2048 + 8 * ni; width = 8; }
        else if (pr < 49) base = 2064 + 64 * (pr - 33) + 32 * ni;
        else { base = 0; width = 0; }
        return p->ml_w_in + (size_t)j * 1024 * ML_IN + base;
    }
    DI const bf16_t* b_base() const { return (const bf16_t*)(p->ws + WS_WML) + (size_t)(j * 25 + tn) * 128 * 1024; }
    DI void epi(f32x16 (&acc)[2][2], int wr, int wc, int lane, unsigned char* wl) const {
        const int pr = tn * 2 + wc, c = lane & 31;
        const int t0 = tm * 128 + wr * 64;
        unsigned char* ws = p->ws;
        if (pr < 16) {
            bf16_t* ob; int cb; float sc = 1.f;
            if (pr < 8) { ob = (bf16_t*)(ws + WS_MQ); cb = 64 * pr; sc = 0.125f; }
            else { ob = (bf16_t*)(ws + WS_MK); cb = 64 * (pr - 8); }
#pragma unroll
            for (int mi = 0; mi < 2; ++mi)
#pragma unroll
                for (int r = 0; r < 16; ++r) { stage_put<64>(wl, mi, 0, r, lane, acc[mi][0][r] * sc); stage_put<64>(wl, mi, 1, r, lane, acc[mi][1][r] * sc); }
            stage_flush<64>(wl, lane, [&](int row) { return ob + (size_t)(t0 + row) * 512 + cb; });
        }
        if (pr >= 8 && pr < 32) {
            bf16_t* ob; int nrow, hd, r0;
            if (pr < 16) { ob = (bf16_t*)(ws + WS_MKT); nrow = 64; hd = pr - 8; r0 = 0; }
            else { ob = (bf16_t*)(ws + WS_MV); nrow = 128; hd = (pr - 16) >> 1; r0 = 64 * ((pr - 16) & 1); }
#pragma unroll
            for (int mi = 0; mi < 2; ++mi)
#pragma unroll
                for (int ni = 0; ni < 2; ++ni)
#pragma unroll
                    for (int g4 = 0; g4 < 4; ++g4) {
                        const int t = t0 + mi * 32 + 8 * g4 + 4 * (lane >> 5), pos = t & (S - 1), bb = t >> 11;
                        u32x2 o = {pk2(acc[mi][ni][4 * g4], acc[mi][ni][4 * g4 + 1]), pk2(acc[mi][ni][4 * g4 + 2], acc[mi][ni][4 * g4 + 3])};
                        *(u32x2*)(ob + ((size_t)((bb * 8 + hd) * nrow + r0 + ni * 32 + c)) * S + pos) = o;
                    }
        } else if (pr == 32) {
            if (c < 8) {
                float* oi = (float*)(ws + WS_MIG); float* of = (float*)(ws + WS_MFG);
                const float bi = p->ml_b_gates[j * 16 + c], bfg = p->ml_b_gates[j * 16 + 8 + c];
#pragma unroll
                for (int mi = 0; mi < 2; ++mi)
#pragma unroll
                    for (int r = 0; r < 16; ++r) {
                        const int t = t0 + mi * 32 + crow(r, lane);
                        oi[(size_t)t * 8 + c] = acc[mi][0][r] + bi;
                        const float f = acc[mi][1][r] + bfg;
                        of[(size_t)t * 8 + c] = fminf(f, 0.f) - log1pf(__expf(-fabsf(f)));
                    }
            }
        } else if (pr >= 33 && pr < 49) {
            bf16_t* ob = (bf16_t*)(ws + WS_MOG); const int cb = 64 * (pr - 33);
#pragma unroll
            for (int mi = 0; mi < 2; ++mi)
#pragma unroll
                for (int r = 0; r < 16; ++r) { stage_put<64>(wl, mi, 0, r, lane, sigmoidf_(acc[mi][0][r])); stage_put<64>(wl, mi, 1, r, lane, sigmoidf_(acc[mi][1][r])); }
            stage_flush<64>(wl, lane, [&](int row) { return ob + (size_t)(t0 + row) * 1024 + cb; });
        }
    }
};

struct OutProj {
    const Params* p; const float* W; const float* src; int layer, tm, tn;
    DI int kt() const { return 16; }
    DI int ldb() const { return 1024; }
    DI const bf16_t* a_base() const { return (const bf16_t*)(p->ws + WS_YMIX); }
    DI int a_off(int r) const { return (tm * 128 + r) * 1024; }
    DI const float* b_col(int g, int& width) const { width = 32; return W + tn * 128 + g * 32; }
    DI const bf16_t* b_base() const { return (const bf16_t*)(p->ws + WS_WOUT) + (size_t)(layer * 8 + tn) * 128 * 1024; }
    DI void epi(f32x16 (&acc)[2][2], int wr, int wc, int lane, unsigned char* wl) const {
        const int c = lane & 31, t0 = tm * 128 + wr * 64, wid = wr * 2 + wc;
        float* fl = (float*)(wl + wid * 8192);
#pragma unroll
        for (int mi = 0; mi < 2; ++mi)
#pragma unroll
            for (int ni = 0; ni < 2; ++ni)
#pragma unroll
                for (int r = 0; r < 16; ++r) fl[(mi * 32 + crow(r, lane)) * 64 + ni * 32 + c] = acc[mi][ni][r];
        const float* mod = (const float*)(p->ws + WS_MOD) + (size_t)layer * 8 * 6144;
        const int ch = lane & 15, n = tn * 128 + wc * 64 + ch * 4;
        const f32x4 g = *(const f32x4*)(mod + (t0 >> 11) * 6144 + 2048 + n);
        float* part = (float*)(p->ws + WS_PART);
#pragma unroll 4
        for (int i = 0; i < 16; ++i) {
            const int row = (lane >> 4) + 4 * i, t = t0 + row;
            const f32x4 a = *(const f32x4*)(fl + row * 64 + ch * 4);
            const f32x4 o = *(const f32x4*)(src + (size_t)t * 1024 + n) + g * a;
            *(f32x4*)(p->out + (size_t)t * 1024 + n) = o;
            float ss = o[0] * o[0] + o[1] * o[1] + o[2] * o[2] + o[3] * o[3];
            ss += __shfl_xor(ss, 1); ss += __shfl_xor(ss, 2); ss += __shfl_xor(ss, 4); ss += __shfl_xor(ss, 8);
            if (ch == 0) part[(size_t)t * 16 + tn * 2 + wc] = ss;
        }
    }
};

struct Moe1 {
    const Params* p; int layer, e, mt, nt, cnt, roff;
    DI int kt() const { return 16; }
    DI int ldb() const { return DEXP; }
    DI const bf16_t* a_base() const { return (const bf16_t*)(p->ws + WS_H); }
    DI int a_off(int r) const {
        const int rr = mt * 128 + r; if (rr >= cnt) return -1;
        const int a = ((const int*)(p->ws + WS_ELIST))[(size_t)e * NASG + rr];
        return (a >> 1) * 1024;
    }
    DI const float* b_col(int g, int& width) const {
        width = 32; const int pr = nt * 2 + (g >> 1);
        const float* base = (g & 1) ? p->moe_w_up : p->moe_w_gate;
        return base + ((size_t)layer * NEXP + e) * (size_t)(D * DEXP) + 32 * pr;
    }
    DI const bf16_t* b_base() const { return (const bf16_t*)(p->ws + WS_WM1) + (size_t)((layer * NEXP + e) * 8 + nt) * 128 * 1024; }
    DI void epi(f32x16 (&acc)[2][2], int wr, int wc, int lane, unsigned char* wl) const {
        const int c = lane & 31, pr = nt * 2 + wc;
        bf16_t* ob = (bf16_t*)(p->ws + WS_H1);
#pragma unroll
        for (int mi = 0; mi < 2; ++mi)
#pragma unroll
            for (int r = 0; r < 16; ++r) {
                const float g = acc[mi][0][r], u = acc[mi][1][r];
                stage_put<32>(wl, mi, 0, r, lane, g / (1.f + __expf(-g)) * u);
            }
        const int rb = mt * 128 + wr * 64;
        stage_flush<32>(wl, lane, [&](int row) { return rb + row < cnt ? ob + (size_t)(roff + rb + row) * 512 + 32 * pr : (bf16_t*)nullptr; });
    }
};

struct Moe2 {
    const Params* p; int layer, e, mt, nt, cnt, roff;
    DI int kt() const { return 8; }
    DI int ldb() const { return D; }
    DI const bf16_t* a_base() const { return (const bf16_t*)(p->ws + WS_H1); }
    DI int a_off(int r) const { const int rr = mt * 128 + r; if (rr >= cnt) return -1; return (roff + rr) * 512; }
    DI const float* b_col(int g, int& width) const { width = 32; return p->moe_w_down + ((size_t)layer * NEXP + e) * (size_t)(DEXP * D) + nt * 128 + g * 32; }
    DI const bf16_t* b_base() const { return (const bf16_t*)(p->ws + WS_WM2) + (size_t)((layer * NEXP + e) * 8 + nt) * 128 * 512; }
    DI void epi(f32x16 (&acc)[2][2], int wr, int wc, int lane, unsigned char* wl) const {
        const int c = lane & 31;
        bf16_t* ob = (bf16_t*)(p->ws + WS_Y);
        const int* el = (const int*)(p->ws + WS_ELIST) + (size_t)e * NASG;
#pragma unroll
        for (int mi = 0; mi < 2; ++mi)
#pragma unroll
            for (int r = 0; r < 16; ++r) { stage_put<64>(wl, mi, 0, r, lane, acc[mi][0][r]); stage_put<64>(wl, mi, 1, r, lane, acc[mi][1][r]); }
        const int rb = mt * 128 + wr * 64;
        stage_flush<64>(wl, lane, [&](int row) { return rb + row < cnt ? ob + (size_t)el[rb + row] * 1024 + nt * 128 + wc * 64 : (bf16_t*)nullptr; });
    }
};

DI void convert_moe_layers(const Params& p, int l0, int l1, unsigned char* smem, int bid, int nb, int tid) {
    const int PER = 32 * 8 * 16 + 32 * 8 * 8, total = (l1 - l0) * PER;
    for (int item = bid; item < total; item += nb) {
        const int l = l0 + item / PER; int ci = item % PER;
        if (ci < 4096) { const int kt = ci & 15, nt = (ci >> 4) & 7, e = ci >> 7; Moe1 pr{&p, l, e, 0, nt, 0, 0}; convert_tile(pr, (bf16_t*)(p.ws + WS_WM1) + (size_t)((l * 32 + e) * 8 + nt) * 128 * 1024, 1024, kt, smem, tid); }
        else { ci -= 4096; const int kt = ci & 7, nt = (ci >> 3) & 7, e = ci >> 6; Moe2 pr{&p, l, e, 0, nt, 0, 0}; convert_tile(pr, (bf16_t*)(p.ws + WS_WM2) + (size_t)((l * 32 + e) * 8 + nt) * 128 * 512, 512, kt, smem, tid); }
    }
    __syncthreads();
}

DI void phase_init(const Params& p, unsigned char* smem, int bid, int nb, int tid) {
    float* sc = (float*)smem;
    float* red = (float*)(smem + 32768);
    const int NMOD = DEPTH * 96, NROPE = 256, NSMALL = NMOD + NROPE + 1;
    const int C_HYB = 2 * 22 * 16, C_ML = 2 * 25 * 16, C_OUT = 4 * 8 * 16;
    const int NITEM = NSMALL + C_HYB + C_ML + C_OUT;
    for (int item = bid; item < NITEM; item += nb) {
        if (item >= NSMALL) {
            int ci = item - NSMALL;
            if (ci < C_HYB) { const int kt = ci & 15, tn = (ci >> 4) % 22, j = (ci >> 4) / 22; HybIn pr{&p, j, 0, tn}; convert_tile(pr, (bf16_t*)(p.ws + WS_WHYB) + (size_t)(j * 22 + tn) * 128 * 1024, 1024, kt, smem, tid); continue; }
            ci -= C_HYB;
            if (ci < C_ML) { const int kt = ci & 15, tn = (ci >> 4) % 25, j = (ci >> 4) / 25; MlIn pr{&p, j, 0, tn}; convert_tile(pr, (bf16_t*)(p.ws + WS_WML) + (size_t)(j * 25 + tn) * 128 * 1024, 1024, kt, smem, tid); continue; }
            ci -= C_ML;
            { const int kt = ci & 15, tn = (ci >> 4) & 7, l = ci >> 7; const float* W = ((l & 1) ? p.ml_w_out : p.hy_w_out) + (size_t)(l >> 1) * 1024 * 1024;
                OutProj pr{&p, W, nullptr, l, 0, tn}; convert_tile(pr, (bf16_t*)(p.ws + WS_WOUT) + (size_t)(l * 8 + tn) * 128 * 1024, 1024, kt, smem, tid); continue; }
        }
        if (item < NMOD) {
            __syncthreads();
            for (int i = tid; i < 8 * 1024; i += 256) { const float v = p.c[i]; sc[i] = v / (1.f + __expf(-v)); }
            __syncthreads();
            const int l = item / 96, jb = item % 96, cq = tid & 15, ksl = tid >> 4;
            const float* w = p.ada_w + (size_t)l * 1024 * 6144 + jb * 64 + cq * 4;
            f32x4 acc[8];
#pragma unroll
            for (int b = 0; b < 8; ++b) acc[b] = (f32x4){0.f, 0.f, 0.f, 0.f};
            for (int ii = 0; ii < 64; ++ii) {
                const int i = ksl * 64 + ii;
                const f32x4 wv = *(const f32x4*)(w + (size_t)i * 6144);
#pragma unroll
                for (int b = 0; b < 8; ++b) acc[b] += wv * sc[b * 1024 + i];
            }
#pragma unroll
            for (int b = 0; b < 8; ++b) *(f32x4*)(red + (ksl * 8 + b) * 64 + cq * 4) = acc[b];
            __syncthreads();
            for (int o = tid; o < 512; o += 256) {
                const int b = o >> 6, cc = o & 63; float s = 0.f;
                for (int k = 0; k < 16; ++k) s += red[(k * 8 + b) * 64 + cc];
                ((float*)(p.ws + WS_MOD))[((size_t)l * 8 + b) * 6144 + jb * 64 + cc] = s + p.ada_b[l * 6144 + jb * 64 + cc];
            }
        } else if (item < NMOD + NROPE) {
            const int idx = (item - NMOD) * 256 + tid;
            const int pos = idx >> 5, i = idx & 31;
            const float inv = 1.0f / powf(10000.0f, (float)(2 * i) / 64.0f);
            const float ang = (float)pos * inv;
            ((float*)(p.ws + WS_ROPEC))[idx] = cosf(ang);
            ((float*)(p.ws + WS_ROPES))[idx] = sinf(ang);
        } else {
            if (tid < DEPTH * 32) ((int*)(p.ws + WS_ECNT))[tid * ECS] = 0;
        }
    }
    __syncthreads();
    convert_moe_layers(p, 0, 1, smem, bid, nb, tid);
}

DI void phase_norm(const Params& p, int layer, const float* src, int bid, int nb, int tid) {
    const int lane = tid & 63, wid = tid >> 6;
    const float* mod = (const float*)(p.ws + WS_MOD) + (size_t)layer * 8 * 6144;
    const float* gam = p.norm_mix + layer * 1024;
    bf16_t* H = (bf16_t*)(p.ws + WS_H);
    for (int item = bid; item < T / 4; item += nb) {
        const int t = item * 4 + wid, b = t >> 11;
        const float* xr = src + (size_t)t * 1024;
        f32x4 v[4]; float ss = 0.f;
#pragma unroll
        for (int i = 0; i < 4; ++i) { v[i] = *(const f32x4*)(xr + (lane + 64 * i) * 4); ss += v[i][0] * v[i][0] + v[i][1] * v[i][1] + v[i][2] * v[i][2] + v[i][3] * v[i][3]; }
        ss = wave_sum(ss);
        const float rstd = rsqrtf(ss * (1.f / 1024.f) + EPS);
#pragma unroll
        for (int i = 0; i < 4; ++i) {
            const int c0 = (lane + 64 * i) * 4;
            const f32x4 g = *(const f32x4*)(gam + c0), sh = *(const f32x4*)(mod + b * 6144 + c0), sc = *(const f32x4*)(mod + b * 6144 + 1024 + c0);
            f32x4 h = v[i] * rstd * g * (sc + 1.f) + sh;
            u32x2 o = {pk2(h[0], h[1]), pk2(h[2], h[3])};
            *(u32x2*)(H + (size_t)t * 1024 + c0) = o;
        }
    }
}

DI void phase_ffn_norm_router(const Params& p, int layer, unsigned char* smem, int bid, int nb, int tid) {
    float* rstd_s = (float*)smem;
    float* lg = (float*)(smem + 512);
    float* hs = (float*)(smem + 512 + 32 * 37 * 4);
    float* wcs = (float*)(smem + 5248 + 2 * 32 * 65 * 4);
    const int lane = tid & 63, og = __builtin_amdgcn_readfirstlane(tid >> 6), tok = lane & 31, kh = lane >> 5;
    const float* mod = (const float*)(p.ws + WS_MOD) + (size_t)layer * 8 * 6144;
    const float* gam = p.norm_ffn + layer * 1024;
    const float* wg = p.moe_w_group + (size_t)layer * 1024 * 4;
    const float* we = p.moe_w_expert + (size_t)layer * 1024 * 32;
    bf16_t* H = (bf16_t*)(p.ws + WS_H);
    int* ecnt = (int*)(p.ws + WS_ECNT) + layer * 32 * ECS;
    int* elist = (int*)(p.ws + WS_ELIST);
    float* ew = (float*)(p.ws + WS_EW);
    for (int item = bid; item < T / 32; item += nb) {
        const int t0 = item * 32, b = t0 >> 11;
        __syncthreads();
        if (tid < 32) {
            const f32x4* pp = (const f32x4*)((const float*)(p.ws + WS_PART) + (size_t)(t0 + tid) * 16);
            const f32x4 a = pp[0], b4 = pp[1], c4 = pp[2], d4 = pp[3];
            const float ss = ((a[0] + a[1]) + (a[2] + a[3])) + ((b4[0] + b4[1]) + (b4[2] + b4[3])) + ((c4[0] + c4[1]) + (c4[2] + c4[3])) + ((d4[0] + d4[1]) + (d4[2] + d4[3]));
            rstd_s[tid] = rsqrtf(ss * (1.f / 1024.f) + EPS);
        }
        const int stok = tid >> 3, sk0 = (tid & 7) * 8;
        const float* xrow = p.out + (size_t)(t0 + stok) * 1024 + sk0;
        const float* mrow = mod + b * 6144 + sk0;
        f32x4 xa[2], ga[2], sha[2], sca[2], wa[3], xb[2], gb2[2], shb[2], scb[2], wb2[3];
#define FFN_LOAD(xv, gv, shv, scv, wv, k0) do { _Pragma("unroll") for (int q = 0; q < 2; ++q) { xv[q] = *(const f32x4*)(xrow + (k0) + 4 * q); gv[q] = *(const f32x4*)(gam + sk0 + (k0) + 4 * q); \
            shv[q] = *(const f32x4*)(mrow + 3072 + (k0) + 4 * q); scv[q] = *(const f32x4*)(mrow + 4096 + (k0) + 4 * q); } \
            wv[0] = *(const f32x4*)(we + (k0) * 32 + tid * 4); wv[1] = *(const f32x4*)(we + (k0) * 32 + 1024 + tid * 4); wv[2] = *(const f32x4*)(wg + (k0) * 4 + (tid & 63) * 4); } while (0)
#define FFN_STEP(xv, gv, shv, scv, wv, kc) do { const int k0 = (kc) * 64; float* hb = hs + ((kc) & 1) * (32 * 65); float* wb = wcs + ((kc) & 1) * (64 * 40); u32x4 ho; \
            _Pragma("unroll") for (int q = 0; q < 2; ++q) { const f32x4 h = xv[q] * srstd * gv[q] * (scv[q] + 1.f) + shv[q]; ho[2 * q] = pk2(h[0], h[1]); ho[2 * q + 1] = pk2(h[2], h[3]); \
                float* hp = hb + stok * 65 + sk0 + 4 * q; hp[0] = h[0]; hp[1] = h[1]; hp[2] = h[2]; hp[3] = h[3]; } \
            *(u32x4*)(H + (size_t)(t0 + stok) * 1024 + k0 + sk0) = ho; \
            *(f32x4*)(wb + (tid >> 3) * 40 + 4 + (tid & 7) * 4) = wv[0]; *(f32x4*)(wb + (32 + (tid >> 3)) * 40 + 4 + (tid & 7) * 4) = wv[1]; if (tid < 64) *(f32x4*)(wb + tid * 40) = wv[2]; \
            if ((kc) + 2 < 16) FFN_LOAD(xv, gv, shv, scv, wv, k0 + 128); \
            __syncthreads(); \
            if (og < 3) { const float* hr = hb + tok * 65 + kh * 32; const float* wr_ = wb + kh * 32 * 40 + og * 12; \
                _Pragma("unroll 8") for (int kk = 0; kk < 32; ++kk) { const float hv = hr[kk]; \
                    acc[0] += *(const f32x4*)(wr_ + kk * 40) * hv; acc[1] += *(const f32x4*)(wr_ + kk * 40 + 4) * hv; acc[2] += *(const f32x4*)(wr_ + kk * 40 + 8) * hv; } } } while (0)
        FFN_LOAD(xa, ga, sha, sca, wa, 0);
        FFN_LOAD(xb, gb2, shb, scb, wb2, 64);
        __syncthreads();
        const float srstd = rstd_s[stok];
        f32x4 acc[3];
#pragma unroll
        for (int o = 0; o < 3; ++o) acc[o] = (f32x4){0.f, 0.f, 0.f, 0.f};
        for (int kc = 0; kc < 16; kc += 2) {
            FFN_STEP(xa, ga, sha, sca, wa, kc);
            FFN_STEP(xb, gb2, shb, scb, wb2, kc + 1);
        }
#undef FFN_STEP
#undef FFN_LOAD
        if (og < 3) {
#pragma unroll
            for (int o = 0; o < 3; ++o)
#pragma unroll
                for (int e = 0; e < 4; ++e) { const float v = acc[o][e] + __shfl_xor(acc[o][e], 32); if (kh == 0) lg[tok * 37 + og * 12 + 4 * o + e] = v; }
        }
        __syncthreads();
        if (tid < 32) {
            const int t = t0 + tid;
            float gl[4]; float gmax = -INFINITY; int gsel = 0;
#pragma unroll
            for (int g = 0; g < 4; ++g) { gl[g] = lg[tid * 37 + g] + p.moe_b_group[layer * 4 + g]; if (gl[g] > gmax) { gmax = gl[g]; gsel = g; } }
            float gsum = 0.f;
#pragma unroll
            for (int g = 0; g < 4; ++g) gsum += __expf(gl[g] - gmax);
            const float pg = 1.f / gsum;
            float v1 = -INFINITY, v2 = -INFINITY; int i1 = 0, i2 = 0;
            for (int jx = 0; jx < 8; ++jx) {
                const float v = lg[tid * 37 + 4 + gsel * 8 + jx] + p.moe_b_expert[layer * 32 + gsel * 8 + jx];
                if (v > v1) { v2 = v1; i2 = i1; v1 = v; i1 = jx; } else if (v > v2) { v2 = v; i2 = jx; }
            }
            const float e2 = __expf(v2 - v1), den = 1.f / (1.f + e2);
            const float w1 = pg * den, w2 = pg * e2 * den;
            const int ea = gsel * 8 + i1, eb = gsel * 8 + i2;
            int* cl = (int*)rstd_s + 32;
            cl[tid] = 0;
            const int la = atomicAdd(&cl[ea], 1);
            const int lb = atomicAdd(&cl[eb], 1);
            { const int n = cl[tid]; cl[32 + tid] = n > 0 ? atomicAdd(&ecnt[tid * ECS], n) : 0; }
            const int ra = cl[32 + ea] + la, rb = cl[32 + eb] + lb;
            elist[(size_t)ea * NASG + ra] = t * 2; ew[t * 2] = w1;
            elist[(size_t)eb * NASG + rb] = t * 2 + 1; ew[t * 2 + 1] = w2;
        }
    }
}

DI bool dense_item(int i, int NT, int xcd, int& tm, int& tn) {
    if (i >= 16 * NT) return false;
    const int mg = i / (8 * NT), r = i % (8 * NT);
    tn = r >> 3; tm = xcd * 16 + mg * 8 + (r & 7);
    return true;
}
template <class PR> DI void phase_hyb_in(const Params& p, int j, unsigned char* smem, int bid, int nb, int tid) {
    int tm, tn;
    for (int i = bid >> 3; dense_item(i, 22, bid & 7, tm, tn); i += nb >> 3) { HybIn pr{&p, j, tm, tn}; gemm_tile(pr, smem, opq(tid)); }
}
DI void phase_ml_in(const Params& p, int j, unsigned char* smem, int bid, int nb, int tid) {
    int tm, tn;
    for (int i = bid >> 3; dense_item(i, 25, bid & 7, tm, tn); i += nb >> 3) { MlIn pr{&p, j, tm, tn}; gemm_tile(pr, smem, opq(tid)); }
}
DI void phase_out_proj(const Params& p, int layer, const float* W, const float* src, unsigned char* smem, int bid, int nb, int tid) {
    int tm, tn;
    for (int i = bid >> 3; dense_item(i, 8, bid & 7, tm, tn); i += nb >> 3) { OutProj pr{&p, W, src, layer, tm, tn}; gemm_tile(pr, smem, opq(tid)); }
}
template <int WHICH> DI void phase_moe(const Params& p, int layer, unsigned char* smem, int bid, int nb, int tid) {
    int* toff = (int*)(smem + 65600);
    const int xcd = bid & 7;
    __syncthreads();
    if (tid == 0) {
        const int* ecnt = (const int*)(p.ws + WS_ECNT) + layer * 32 * ECS;
        int ta = 0, ra = 0;
        for (int e = 0; e < 32; ++e) {
            const int c = ecnt[e * ECS];
            if ((e & 7) == xcd) { const int q = e >> 3; toff[q] = ta; toff[8 + q] = ra; toff[16 + q] = c; ta += (c + 127) >> 7; }
            ra += c;
        }
        toff[4] = ta;
    }
    __syncthreads();
    const int total = toff[4] * 8;
    for (int item = bid >> 3; item < total; item += nb >> 3) {
        const int mg = item >> 3, nt = item & 7;
        int q = 0;
        while (q < 3 && toff[q + 1] <= mg) ++q;
        const int e = q * 8 + xcd, cnt = toff[16 + q], roff = toff[8 + q];
        if (WHICH == 1) { Moe1 pr{&p, layer, e, mg - toff[q], nt, cnt, roff}; gemm_tile(pr, smem, opq(tid)); }
        else { Moe2 pr{&p, layer, e, mg - toff[q], nt, cnt, roff}; gemm_tile(pr, smem, opq(tid)); }
    }
}

DI void phase_combine_norm(const Params& p, int layer, int bid, int nb, int tid) {
    const int lane = tid & 63, wid = tid >> 6;
    const float* mod = (const float*)(p.ws + WS_MOD) + (size_t)layer * 8 * 6144;
    const float* modn = mod + 8 * 6144;
    const float* gam = p.norm_mix + (layer + 1) * 1024;
    const bf16_t* Y = (const bf16_t*)(p.ws + WS_Y);
    const float* ew = (const float*)(p.ws + WS_EW);
    bf16_t* H = (bf16_t*)(p.ws + WS_H);
    const bool has_next = layer + 1 < DEPTH;
    for (int item = bid; item < T / 4; item += nb) {
        const int t = item * 4 + wid, b = t >> 11;
        const float w0 = ew[2 * t], w1 = ew[2 * t + 1];
        f32x4 v[4]; float ss = 0.f;
#pragma unroll
        for (int i = 0; i < 4; ++i) {
            const int c0 = (lane + 64 * i) * 4;
            v[i] = *(const f32x4*)(p.out + (size_t)t * 1024 + c0);
            const f32x4 g = *(const f32x4*)(mod + b * 6144 + 5120 + c0);
            const u32x2 y0 = *(const u32x2*)(Y + (size_t)(2 * t) * 1024 + c0), y1 = *(const u32x2*)(Y + (size_t)(2 * t + 1) * 1024 + c0);
            v[i][0] += g[0] * (w0 * bflo(y0[0]) + w1 * bflo(y1[0])); v[i][1] += g[1] * (w0 * bfhi(y0[0]) + w1 * bfhi(y1[0]));
            v[i][2] += g[2] * (w0 * bflo(y0[1]) + w1 * bflo(y1[1])); v[i][3] += g[3] * (w0 * bfhi(y0[1]) + w1 * bfhi(y1[1]));
            *(f32x4*)(p.out + (size_t)t * 1024 + c0) = v[i];
            ss += v[i][0] * v[i][0] + v[i][1] * v[i][1] + v[i][2] * v[i][2] + v[i][3] * v[i][3];
        }
        if (has_next) {
            ss = wave_sum(ss);
            const float rstd = rsqrtf(ss * (1.f / 1024.f) + EPS);
#pragma unroll
            for (int i = 0; i < 4; ++i) {
                const int c0 = (lane + 64 * i) * 4;
                const f32x4 g = *(const f32x4*)(gam + c0), sh = *(const f32x4*)(modn + b * 6144 + c0), sc = *(const f32x4*)(modn + b * 6144 + 1024 + c0);
                const f32x4 h = v[i] * rstd * g * (sc + 1.f) + sh;
                u32x2 o = {pk2(h[0], h[1]), pk2(h[2], h[3])};
                *(u32x2*)(H + (size_t)t * 1024 + c0) = o;
            }
        }
    }
}

DI unsigned sortable(float f) { const unsigned u = __float_as_uint(f); return (u & 0x80000000u) ? ~u : (u | 0x80000000u); }
DI int half_sum_i(int v) { for (int m = 16; m >= 1; m >>= 1) v += __shfl_xor(v, m); return v; }

DI void phase_dsa(const Params& p, int j, unsigned char* smem, int bid, int nb, int tid, int cv0 = 0, int cv1 = 0) {
    if (cv1 > cv0 && bid >= (nb >> 1)) convert_moe_layers(p, cv0, cv1, smem, bid, nb, tid);
    const int lane = tid & 63, wid = tid >> 6, c = lane & 31, hh = lane >> 5;
    unsigned* mw = (unsigned*)smem + wid * 256;
    const bf16_t* IQ = (const bf16_t*)(p.ws + WS_IQ);
    const bf16_t* IK = (const bf16_t*)(p.ws + WS_IK);
    const float* IW = (const float*)(p.ws + WS_IW);
    const bf16_t* Q = (const bf16_t*)(p.ws + WS_Q);
    const bf16_t* K = (const bf16_t*)(p.ws + WS_K);
    const bf16_t* VT = (const bf16_t*)(p.ws + WS_V);
    bf16_t* Y = (bf16_t*)(p.ws + WS_YMIX);
    const float gq = wave_max(fabsf(p.hy_q_norm[j * 64 + lane])), gk = wave_max(fabsf(p.hy_k_norm[j * 64 + lane]));
    const float LOG2E = 1.4426950408889634f;
    const float c1 = 0.125f * LOG2E, c2 = 8.f * gq * gk * LOG2E;
    const unsigned lt = (1u << c) - 1u;
    for (int it = bid, rnd = 0; it < 1024; it += nb, ++rnd) {
        const int item = (rnd & 1) ? (rnd + 1) * nb - 1 - bid : it;
        if (item >= 1024) continue;
        const int qt = 127 - (item >> 3), b = item & 7;
        const int pos0 = qt * 16 + 4 * wid;
        const size_t tb = (size_t)b * S, t0 = tb + pos0;
        const int tmax = (pos0 + 3) >> 5;
        if (pos0 >= 256) {
            bf16x8 iqf[4];
            {
                const int i = (c & 3) + 4 * (c >> 3), rh = (c >> 2) & 1, qq = 2 * rh + (i >> 3), hd = i & 7;
                const bf16_t* ip = IQ + (t0 + qq) * 512 + hd * 64 + 8 * hh;
#pragma unroll
                for (int ks = 0; ks < 4; ++ks) iqf[ks] = *(const bf16x8*)(ip + 16 * ks);
            }
            float* wl = (float*)(smem + 4096) + wid * 32 + hh * 16;
            if (c < 4) *(f32x4*)(wl + 4 * c) = *(const f32x4*)(IW + (t0 + 2 * hh) * 8 + 4 * c);
            unsigned sk[64][2];
            const bf16_t* kpi = IK + (tb + c) * 64 + 8 * hh;
            const int lim0 = pos0 + 2 * hh - c;
#pragma unroll
            for (int tile = 0; tile < 64; ++tile) {
                unsigned k0 = 0u, k1 = 0u;
                if (tile <= tmax) {
                    bf16x8 bk[4];
#pragma unroll
                    for (int ks = 0; ks < 4; ++ks) bk[ks] = *(const bf16x8*)(kpi + 16 * ks);
                    kpi += 32 * 64;
                    asm volatile("" : "+v"(kpi));
                    f32x16 acc;
#pragma unroll
                    for (int r = 0; r < 16; ++r) acc[r] = 0.f;
#pragma unroll
                    for (int ks = 0; ks < 4; ++ks) acc = __builtin_amdgcn_mfma_f32_32x32x16_bf16(iqf[ks], bk[ks], acc, 0, 0, 0);
                    float s0 = 0.f, s1 = 0.f;
#pragma unroll
                    for (int q4 = 0; q4 < 2; ++q4) {
                        const f32x4 wa = *(const f32x4*)(wl + 4 * q4), wb = *(const f32x4*)(wl + 8 + 4 * q4);
#pragma unroll
                        for (int e = 0; e < 4; ++e) { s0 += fmaxf(acc[4 * q4 + e], 0.f) * wa[e]; s1 += fmaxf(acc[8 + 4 * q4 + e], 0.f) * wb[e]; }
                    }
                    k0 = tile * 32 <= lim0 ? sortable(s0) : 0u;
                    k1 = tile * 32 <= lim0 + 1 ? sortable(s1) : 0u;
                }
                sk[tile][0] = k0; sk[tile][1] = k1;
            }
            unsigned v0 = 0u, v1 = 0u; bool d0 = false, d1 = false;
            const int tg = tmax >> 3;
            for (int bit = 31; bit >= 0; --bit) {
                const unsigned c0 = v0 | (1u << bit), c1b = v1 | (1u << bit);
                int n0 = 0, n1 = 0;
#pragma unroll
                for (int g = 0; g < 8; ++g) {
                    if (g <= tg) {
#pragma unroll
                        for (int u = 0; u < 8; ++u) { n0 += sk[g * 8 + u][0] >= c0 ? 1 : 0; n1 += sk[g * 8 + u][1] >= c1b ? 1 : 0; }
                    }
                }
                const int n01 = half_sum_i(n0 | (n1 << 16));
                n0 = n01 & 0xffff; n1 = n01 >> 16;
                if (!d0 && n0 >= 256) { v0 = c0; d0 = n0 == 256; }
                if (!d1 && n1 >= 256) { v1 = c1b; d1 = n1 == 256; }
                if (__all(d0 && d1)) break;
            }
            int g0 = 0, g1 = 0;
#pragma unroll
            for (int g = 0; g < 8; ++g) {
                if (g <= tg) {
#pragma unroll
                    for (int u = 0; u < 8; ++u) { g0 += sk[g * 8 + u][0] > v0 ? 1 : 0; g1 += sk[g * 8 + u][1] > v1 ? 1 : 0; }
                }
            }
            const int g01 = half_sum_i(g0 | (g1 << 16));
            const int need0 = 256 - (g01 & 0xffff), need1 = 256 - (g01 >> 16);
            int run0 = 0, run1 = 0;
#pragma unroll
            for (int tile = 0; tile < 64; ++tile) {
                if (tile <= tmax) {
                    const unsigned k0 = sk[tile][0], k1 = sk[tile][1];
                    const bool tie0 = k0 == v0, tie1 = k1 == v1;
                    const unsigned long long tb0 = __ballot(tie0), tb1 = __ballot(tie1);
                    const unsigned th0 = hh ? (unsigned)(tb0 >> 32) : (unsigned)tb0, th1 = hh ? (unsigned)(tb1 >> 32) : (unsigned)tb1;
                    const bool sel0 = k0 > v0 || (tie0 && run0 + __popc(th0 & lt) < need0);
                    const bool sel1 = k1 > v1 || (tie1 && run1 + __popc(th1 & lt) < need1);
                    run0 += __popc(th0); run1 += __popc(th1);
                    const unsigned long long sb0 = __ballot(sel0), sb1 = __ballot(sel1);
                    if (lane == 0) { u32x4 o = {(unsigned)sb0, (unsigned)sb1, (unsigned)(sb0 >> 32), (unsigned)(sb1 >> 32)}; *(u32x4*)(mw + tile * 4) = o; }
                }
            }
        } else {
            const int tile = lane >> 2, qq = lane & 3, pq = pos0 + qq;
            if (tile <= tmax) {
                unsigned m;
                if (32 * tile + 31 <= pq) m = 0xffffffffu; else if (32 * tile > pq) m = 0u; else m = (2u << (pq - 32 * tile)) - 1u;
                mw[tile * 4 + qq] = m;
            }
        }
        bf16x8 qf[4];
        {
            const bf16_t* qp = Q + (t0 + (c >> 3)) * 512 + (c & 7) * 64 + 8 * hh;
#pragma unroll
            for (int ks = 0; ks < 4; ++ks) qf[ks] = *(const bf16x8*)(qp + 16 * ks);
        }
        f32x16 o0, o1;
#pragma unroll
        for (int r = 0; r < 16; ++r) { o0[r] = 0.f; o1[r] = 0.f; }
        float lsum = 0.f;
        const int kperm = (c & ~12) | ((c & 4) << 1) | ((c & 8) >> 1);
        const bf16_t* kp = K + (tb + kperm) * 64 + 8 * hh;
        const bf16_t* vp = VT + ((size_t)(b * 64 + c)) * S + 8 * hh;
        bf16x8 kf[4], vf[4];
#pragma unroll
        for (int ks = 0; ks < 4; ++ks) kf[ks] = *(const bf16x8*)(kp + 16 * ks);
        vf[0] = *(const bf16x8*)(vp); vf[1] = *(const bf16x8*)(vp + (size_t)32 * S); vf[2] = *(const bf16x8*)(vp + 16); vf[3] = *(const bf16x8*)(vp + (size_t)32 * S + 16);
        for (int tile = 0; tile <= tmax; ++tile) {
            const unsigned mword = mw[tile * 4 + (c >> 3)];
            bf16x8 kc[4], vc[4];
#pragma unroll
            for (int ks = 0; ks < 4; ++ks) { kc[ks] = kf[ks]; vc[ks] = vf[ks]; }
            if (tile < tmax) {
                kp += 32 * 64; vp += 32;
#pragma unroll
                for (int ks = 0; ks < 4; ++ks) kf[ks] = *(const bf16x8*)(kp + 16 * ks);
                vf[0] = *(const bf16x8*)(vp); vf[1] = *(const bf16x8*)(vp + (size_t)32 * S); vf[2] = *(const bf16x8*)(vp + 16); vf[3] = *(const bf16x8*)(vp + (size_t)32 * S + 16);
            }
            f32x16 x;
#pragma unroll
            for (int r = 0; r < 16; ++r) x[r] = 0.f;
#pragma unroll
            for (int ks = 0; ks < 4; ++ks) x = __builtin_amdgcn_mfma_f32_32x32x16_bf16(kc[ks], qf[ks], x, 0, 0, 0);
#pragma unroll
            for (int s = 0; s < 2; ++s) {
                const unsigned bits = mword >> (16 * s + 8 * hh);
                float pr[8];
#pragma unroll
                for (int jx = 0; jx < 8; ++jx) {
                    const float e = __builtin_amdgcn_exp2f(x[8 * s + jx] * c1 - c2);
                    pr[jx] = __uint_as_float(__float_as_uint(e) & (unsigned)__builtin_amdgcn_sbfe((int)bits, jx, 1));
                    lsum += pr[jx];
                }
                u32x4 pk = {pk2(pr[0], pr[1]), pk2(pr[2], pr[3]), pk2(pr[4], pr[5]), pk2(pr[6], pr[7])};
                const bf16x8 pf = __builtin_bit_cast(bf16x8, pk);
                o0 = __builtin_amdgcn_mfma_f32_32x32x16_bf16(vc[2 * s], pf, o0, 0, 0, 0);
                o1 = __builtin_amdgcn_mfma_f32_32x32x16_bf16(vc[2 * s + 1], pf, o1, 0, 0, 0);
            }
        }
        lsum += __shfl_xor(lsum, 32);
        const float inv = 1.f / lsum;
        bf16_t* yp = Y + (t0 + (c >> 3)) * 1024 + (c & 7) * 64 + 4 * hh;
#pragma unroll
        for (int g4 = 0; g4 < 4; ++g4) {
            u32x2 a = {pk2(o0[4 * g4] * inv, o0[4 * g4 + 1] * inv), pk2(o0[4 * g4 + 2] * inv, o0[4 * g4 + 3] * inv)};
            u32x2 bq = {pk2(o1[4 * g4] * inv, o1[4 * g4 + 1] * inv), pk2(o1[4 * g4 + 2] * inv, o1[4 * g4 + 3] * inv)};
            *(u32x2*)(yp + 8 * g4) = a;
            *(u32x2*)(yp + 32 + 8 * g4) = bq;
        }
    }
    if (cv1 > cv0 && bid < (nb >> 1)) convert_moe_layers(p, cv0, cv1, smem, bid, nb, tid);
}

DI void phase_conv(const Params& p, int j, int bid, int nb, int tid) {
    const bf16_t* Z = (const bf16_t*)(p.ws + WS_Z);
    const bf16_t* BG = (const bf16_t*)(p.ws + WS_BG);
    bf16_t* Y = (bf16_t*)(p.ws + WS_YMIX);
    const float* cw = p.hy_conv_w + (size_t)j * 3 * 512;
    for (int item = bid; item < T / 4; item += nb) {
        const int t = item * 4 + (tid >> 6), c0 = (tid & 63) * 8, pos = t & (S - 1);
        float acc[8];
#pragma unroll
        for (int e = 0; e < 8; ++e) acc[e] = 0.f;
#pragma unroll
        for (int jj = 0; jj < 3; ++jj) {
            const int dp = jj - 2;
            if (pos + dp >= 0) {
                const u32x4 z = *(const u32x4*)(Z + (size_t)(t + dp) * 512 + c0);
#pragma unroll
                for (int e = 0; e < 4; ++e) { acc[2 * e] += cw[jj * 512 + c0 + 2 * e] * bflo(z[e]); acc[2 * e + 1] += cw[jj * 512 + c0 + 2 * e + 1] * bfhi(z[e]); }
            }
        }
        const u32x4 g = *(const u32x4*)(BG + (size_t)t * 512 + c0);
        u32x4 o;
#pragma unroll
        for (int e = 0; e < 4; ++e) o[e] = pk2(acc[2 * e] * bflo(g[e]), acc[2 * e + 1] * bfhi(g[e]));
        *(u32x4*)(Y + (size_t)t * 1024 + 512 + c0) = o;
    }
}

DI float wave_incl_sum(float x, int lane) { for (int d = 1; d < 64; d <<= 1) { const float t = __shfl_up(x, d); if (lane >= d) x += t; } return x; }
DI float wave_incl_max(float x, int lane) { for (int d = 1; d < 64; d <<= 1) { const float t = __shfl_up(x, d); if (lane >= d) x = fmaxf(x, t); } return x; }
DI bf16x8 scale_frag(bf16x8 f, const float* w8) {
    const u32x4 u = __builtin_bit_cast(u32x4, f);
    u32x4 o;
#pragma unroll
    for (int e = 0; e < 4; ++e) o[e] = pk2(bflo(u[e]) * w8[2 * e], bfhi(u[e]) * w8[2 * e + 1]);
    return __builtin_bit_cast(bf16x8, o);
}

DI void phase_ml1(const Params& p, unsigned char* smem, int bid, int nb, int tid) {
    const int lane = tid & 63, wid = tid >> 6, c = lane & 31, hh = lane >> 5;
    float* wsl = (float*)smem + wid * 64;
    const bf16_t* KT = (const bf16_t*)(p.ws + WS_MKT);
    const bf16_t* VT = (const bf16_t*)(p.ws + WS_MV);
    const float* MIG = (const float*)(p.ws + WS_MIG);
    const float* MFG = (const float*)(p.ws + WS_MFG);
    float* UB = (float*)(p.ws + WS_UBUF);
    float* UN = (float*)(p.ws + WS_UNBUF);
    float* ML = (float*)(p.ws + WS_MLOC);
    for (int item = bid; item < 2048; item += nb) {
        const int bh = item >> 5, ch = item & 31, b = bh >> 3, h = bh & 7;
        const size_t tb = (size_t)b * S + ch * 64;
        const float lf = MFG[(tb + lane) * 8 + h], ig = MIG[(tb + lane) * 8 + h];
        const float bc = wave_incl_sum(lf, lane);
        const float blast = __shfl(bc, 63);
        const float g = blast - bc + ig;
        const float gmax = wave_max(g);
        wsl[lane] = __expf(g - gmax);
        if (wid == 0 && lane == 0) { ML[item * 2] = blast; ML[item * 2 + 1] = gmax; }
        f32x16 u0, u1;
#pragma unroll
        for (int r = 0; r < 16; ++r) { u0[r] = 0.f; u1[r] = 0.f; }
        const bf16_t* vp = VT + ((size_t)(bh * 128 + wid * 32 + c)) * S + ch * 64 + 8 * hh;
        const bf16_t* kp = KT + ((size_t)(bh * 64 + c)) * S + ch * 64 + 8 * hh;
#pragma unroll
        for (int ks = 0; ks < 4; ++ks) {
            float w8[8];
            const f32x4 wa = *(const f32x4*)(wsl + 16 * ks + 8 * hh), wb = *(const f32x4*)(wsl + 16 * ks + 8 * hh + 4);
            w8[0] = wa[0]; w8[1] = wa[1]; w8[2] = wa[2]; w8[3] = wa[3]; w8[4] = wb[0]; w8[5] = wb[1]; w8[6] = wb[2]; w8[7] = wb[3];
            const bf16x8 va = *(const bf16x8*)(vp + 16 * ks);
            const bf16x8 k0 = scale_frag(*(const bf16x8*)(kp + 16 * ks), w8);
            const bf16x8 k1 = scale_frag(*(const bf16x8*)(kp + (size_t)32 * S + 16 * ks), w8);
            u0 = __builtin_amdgcn_mfma_f32_32x32x16_bf16(va, k0, u0, 0, 0, 0);
            u1 = __builtin_amdgcn_mfma_f32_32x32x16_bf16(va, k1, u1, 0, 0, 0);
        }
        float* up = UB + ((size_t)item * 128 + wid * 32) * 64 + c;
#pragma unroll
        for (int r = 0; r < 16; ++r) { const int v = crow(r, lane); up[v * 64] = u0[r]; up[v * 64 + 32] = u1[r]; }
        if (wid == 0) {
            const u32x4* kr = (const u32x4*)(KT + ((size_t)(bh * 64 + lane)) * S + ch * 64);
            float a = 0.f;
#pragma unroll
            for (int q = 0; q < 8; ++q) { const u32x4 u = kr[q];
#pragma unroll
                for (int e = 0; e < 4; ++e) a += wsl[q * 8 + 2 * e] * bflo(u[e]) + wsl[q * 8 + 2 * e + 1] * bfhi(u[e]); }
            UN[(size_t)item * 64 + lane] = a;
        }
    }
}

DI void phase_ml2(const Params& p, unsigned char* smem, int bid, int nb, int tid) {
    float* dec = (float*)smem;
    float* scl = dec + 32;
    const float* UB = (const float*)(p.ws + WS_UBUF);
    const float* UN = (const float*)(p.ws + WS_UNBUF);
    const float* ML = (const float*)(p.ws + WS_MLOC);
    bf16_t* CB = (bf16_t*)(p.ws + WS_CBUF);
    float* NBF = (float*)(p.ws + WS_NBUF);
    float* MST = (float*)(p.ws + WS_MST);
    for (int item = bid; item < 512; item += nb) {
        const int bh = item >> 3, sl = item & 7;
        __syncthreads();
        if (tid == 0) {
            float m = 0.f;
            for (int ch = 0; ch < 32; ++ch) {
                const float bl = ML[(bh * 32 + ch) * 2], gm = ML[(bh * 32 + ch) * 2 + 1];
                const float mn = fmaxf(bl + m, gm);
                dec[ch] = __expf(bl + m - mn); scl[ch] = __expf(gm - mn);
                if (sl == 0) MST[bh * 32 + ch] = m;
                m = mn;
            }
        }
        __syncthreads();
        f32x4 st = {0.f, 0.f, 0.f, 0.f};
        const size_t e0 = (size_t)sl * 1024 + tid * 4;
        f32x4 ub[32];
#pragma unroll
        for (int ch = 0; ch < 32; ++ch) ub[ch] = *(const f32x4*)(UB + ((size_t)(bh * 32 + ch)) * 8192 + e0);
#pragma unroll
        for (int ch = 0; ch < 32; ++ch) {
            st = st * dec[ch] + ub[ch] * scl[ch];
            u32x2 o = {pk2(st[0], st[1]), pk2(st[2], st[3])};
            *(u32x2*)(CB + ((size_t)(bh * 32 + ch)) * 8192 + e0) = o;
        }
        if (sl == 0 && tid < 64) {
            float nst = 0.f, un[32];
#pragma unroll
            for (int ch = 0; ch < 32; ++ch) un[ch] = UN[(size_t)(bh * 32 + ch) * 64 + tid];
#pragma unroll
            for (int ch = 0; ch < 32; ++ch) { nst = nst * dec[ch] + un[ch] * scl[ch]; NBF[(size_t)(bh * 32 + ch) * 64 + tid] = nst; }
        }
    }
}

DI void phase_ml3(const Params& p, int j, unsigned char* smem, int bid, int nb, int tid) {
    const int lane = tid & 63, wid = tid >> 6, c = lane & 31, hh = lane >> 5;
    float* al = (float*)smem + wid * 64;
    float* ssum = (float*)smem + 256;
    const bf16_t* MQ = (const bf16_t*)(p.ws + WS_MQ);
    const bf16_t* MK = (const bf16_t*)(p.ws + WS_MK);
    const bf16_t* VT = (const bf16_t*)(p.ws + WS_MV);
    const float* MIG = (const float*)(p.ws + WS_MIG);
    const float* MFG = (const float*)(p.ws + WS_MFG);
    const bf16_t* MOG = (const bf16_t*)(p.ws + WS_MOG);
    const bf16_t* CB = (const bf16_t*)(p.ws + WS_CBUF);
    const float* NBF = (const float*)(p.ws + WS_NBUF);
    const float* MST = (const float*)(p.ws + WS_MST);
    bf16_t* Y = (bf16_t*)(p.ws + WS_YMIX);
    const int kperm = (c & ~12) | ((c & 4) << 1) | ((c & 8) >> 1);
    for (int item = bid; item < 2048; item += nb) {
        const int bh = item >> 5, ch = item & 31, b = bh >> 3, h = bh & 7;
        const size_t tb = (size_t)b * S + ch * 64;
        const float lf = MFG[(tb + lane) * 8 + h], ig = MIG[(tb + lane) * 8 + h];
        const float bc = wave_incl_sum(lf, lane);
        const float av = ig - bc;
        const float mprev = MST[item];
        const float Mv = fmaxf(mprev, wave_incl_max(av, lane));
        __syncthreads();
        al[lane] = av;
        float Mt[2], wint[2], emt[2];
#pragma unroll
        for (int tt = 0; tt < 2; ++tt) { Mt[tt] = __shfl(Mv, 32 * tt + c); wint[tt] = __expf(mprev - Mt[tt]); emt[tt] = __expf(-(__shfl(bc, 32 * tt + c) + Mt[tt])); }
        bf16x8 qf[2][4], kf[2][4];
#pragma unroll
        for (int tt = 0; tt < 2; ++tt) {
            const bf16_t* qp = MQ + (tb + 32 * tt + c) * 512 + h * 64 + 8 * hh;
            const bf16_t* kp = MK + (tb + 32 * tt + kperm) * 512 + h * 64 + 8 * hh;
#pragma unroll
            for (int ks = 0; ks < 4; ++ks) { qf[tt][ks] = *(const bf16x8*)(qp + 16 * ks); kf[tt][ks] = *(const bf16x8*)(kp + 16 * ks); }
        }
        f32x16 o[2];
#pragma unroll
        for (int tt = 0; tt < 2; ++tt)
#pragma unroll
            for (int r = 0; r < 16; ++r) o[tt][r] = 0.f;
        float nq[2] = {0.f, 0.f};
        if (ch > 0) {
            const bf16_t* cp = CB + ((size_t)(item - 1) * 128 + wid * 32 + c) * 64 + 8 * hh;
            const float* np = NBF + (size_t)(item - 1) * 64 + 8 * hh;
#pragma unroll
            for (int ks = 0; ks < 4; ++ks) {
                const bf16x8 cf = *(const bf16x8*)(cp + 16 * ks);
                o[0] = __builtin_amdgcn_mfma_f32_32x32x16_bf16(cf, qf[0][ks], o[0], 0, 0, 0);
                o[1] = __builtin_amdgcn_mfma_f32_32x32x16_bf16(cf, qf[1][ks], o[1], 0, 0, 0);
                const f32x4 n0 = *(const f32x4*)(np + 16 * ks), n1 = *(const f32x4*)(np + 16 * ks + 4);
#pragma unroll
                for (int tt = 0; tt < 2; ++tt) {
                    const u32x4 u = __builtin_bit_cast(u32x4, qf[tt][ks]);
                    nq[tt] += n0[0] * bflo(u[0]) + n0[1] * bfhi(u[0]) + n0[2] * bflo(u[1]) + n0[3] * bfhi(u[1]) + n1[0] * bflo(u[2]) + n1[1] * bfhi(u[2]) + n1[2] * bflo(u[3]) + n1[3] * bfhi(u[3]);
                }
            }
#pragma unroll
            for (int tt = 0; tt < 2; ++tt) {
                nq[tt] += __shfl_xor(nq[tt], 32);
#pragma unroll
                for (int r = 0; r < 16; ++r) o[tt][r] *= wint[tt];
            }
        }
        float csum[2] = {0.f, 0.f};
        const bf16_t* vp = VT + ((size_t)(bh * 128 + wid * 32 + c)) * S + ch * 64 + 8 * hh;
#pragma unroll
        for (int tt = 0; tt < 2; ++tt) {
#pragma unroll
            for (int st = 0; st <= tt; ++st) {
                f32x16 x;
#pragma unroll
                for (int r = 0; r < 16; ++r) x[r] = 0.f;
#pragma unroll
                for (int ks = 0; ks < 4; ++ks) x = __builtin_amdgcn_mfma_f32_32x32x16_bf16(kf[st][ks], qf[tt][ks], x, 0, 0, 0);
#pragma unroll
                for (int k2 = 0; k2 < 2; ++k2) {
                    const int s0 = 32 * st + 16 * k2 + 8 * hh;
                    const f32x4 a0 = *(const f32x4*)(al + s0), a1 = *(const f32x4*)(al + s0 + 4);
                    const float a8[8] = {a0[0], a0[1], a0[2], a0[3], a1[0], a1[1], a1[2], a1[3]};
                    float pr[8];
#pragma unroll
                    for (int jx = 0; jx < 8; ++jx) {
                        const float e = __expf(a8[jx] - Mt[tt]) * x[8 * k2 + jx];
                        pr[jx] = (st < tt || s0 + jx <= 32 * tt + c) ? e : 0.f;
                        csum[tt] += pr[jx];
                    }
                    u32x4 pk = {pk2(pr[0], pr[1]), pk2(pr[2], pr[3]), pk2(pr[4], pr[5]), pk2(pr[6], pr[7])};
                    const bf16x8 vf = *(const bf16x8*)(vp + 32 * st + 16 * k2);
                    o[tt] = __builtin_amdgcn_mfma_f32_32x32x16_bf16(vf, __builtin_bit_cast(bf16x8, pk), o[tt], 0, 0, 0);
                }
            }
        }
        float ss[2];
#pragma unroll
        for (int tt = 0; tt < 2; ++tt) {
            csum[tt] += __shfl_xor(csum[tt], 32);
            const float den = wint[tt] * nq[tt] + csum[tt];
            const float rd = 1.f / fmaxf(fabsf(den), emt[tt]);
            float s2 = 0.f;
#pragma unroll
            for (int r = 0; r < 16; ++r) { o[tt][r] *= rd; s2 += o[tt][r] * o[tt][r]; }
            s2 += __shfl_xor(s2, 32);
            ss[tt] = s2;
            if (hh == 0) ssum[wid * 64 + 32 * tt + c] = s2;
        }
        __syncthreads();
#pragma unroll
        for (int tt = 0; tt < 2; ++tt) {
            const int tcol = 32 * tt + c;
            const float tot = ssum[tcol] + ssum[64 + tcol] + ssum[128 + tcol] + ssum[192 + tcol];
            const float rstd = rsqrtf(tot * (1.f / 128.f) + EPS);
            const size_t ro = (tb + tcol) * 1024 + h * 128 + wid * 32 + 4 * hh;
            const float* gp = p.ml_out_norm + j * 1024 + h * 128 + wid * 32 + 4 * hh;
#pragma unroll
            for (int g4 = 0; g4 < 4; ++g4) {
                const f32x4 gm = *(const f32x4*)(gp + 8 * g4);
                const u32x2 og = *(const u32x2*)(MOG + ro + 8 * g4);
                u32x2 ov = {pk2(o[tt][4 * g4] * rstd * gm[0] * bflo(og[0]), o[tt][4 * g4 + 1] * rstd * gm[1] * bfhi(og[0])),
                            pk2(o[tt][4 * g4 + 2] * rstd * gm[2] * bflo(og[1]), o[tt][4 * g4 + 3] * rstd * gm[3] * bfhi(og[1]))};
                *(u32x2*)(Y + ro + 8 * g4) = ov;
            }
        }
    }
}

#define XB_TMO      128
#define XB_XCNT(j)  (256  + 64 * (j))
#define XB_XSUB(j)  (1280 + 64 * (j))
#define XB_XGEN(j)  (2304 + 64 * (j))
#define XB_TOP      3328
#define XB_TOPGEN   3392
#define XCD_BAR_WORDS 3456
#define XB_SPIN_CAP (1u << 22)
#define LAS __attribute__((address_space(3)))
DI unsigned xb_ld(unsigned* p) { return __hip_atomic_load(p, __ATOMIC_RELAXED, __HIP_MEMORY_SCOPE_AGENT); }
DI unsigned xb_add(unsigned* p, unsigned v) { return __hip_atomic_fetch_add(p, v, __ATOMIC_RELAXED, __HIP_MEMORY_SCOPE_AGENT); }
DI unsigned xb_xcc_id() { return (unsigned)__builtin_amdgcn_s_getreg((3 << 11) | 20) & 0xFu; }
#define XB_SPIN(cond, bar) do { unsigned _sp = 0; while (cond) { __builtin_amdgcn_s_sleep(1); \
    if ((++_sp & 255u) == 0u) { if (xb_ld(&(bar)[XB_TMO])) break; if (_sp > XB_SPIN_CAP) { atomicAdd(&(bar)[XB_TMO], 1u); break; } } } } while (0)
struct XcdBarrier { unsigned* bar; unsigned x; volatile LAS unsigned* st; };
DI XcdBarrier xcd_barrier_post(unsigned* bar, volatile LAS unsigned* st) {
    XcdBarrier b; b.bar = bar; b.x = xb_xcc_id(); b.st = st;
    if (threadIdx.x == 0) (void)xb_add(&bar[XB_XCNT(b.x)], 1u);
    return b;
}
DI void xcd_barrier_complete(unsigned* bar, unsigned x, unsigned& nloc, unsigned& nx) {
    const unsigned G = gridDim.x * gridDim.y * gridDim.z;
    unsigned sum, cnt, mine, sp = 0u;
    for (;;) {
        sum = 0u; cnt = 0u; mine = 0u;
#pragma unroll
        for (unsigned j = 0; j < 16; ++j) { const unsigned c = xb_ld(&bar[XB_XCNT(j)]); sum += c; cnt += (c > 0u) ? 1u : 0u; mine = (j == x) ? c : mine; }
        if (sum == G) break;
        __builtin_amdgcn_s_sleep(1);
        if ((++sp & 255u) == 0u) { if (xb_ld(&bar[XB_TMO])) break; if (sp > XB_SPIN_CAP) { atomicAdd(&bar[XB_TMO], 1u); break; } }
    }
    nloc = mine > 0u ? mine : 1u; nx = cnt > 0u ? cnt : 1u;
}
DI void xcd_barrier(const XcdBarrier& b) {
    asm volatile("s_waitcnt vmcnt(0)" ::: "memory");
    __syncthreads();
    if (threadIdx.x == 0) {
        unsigned* bar = b.bar;
        __builtin_amdgcn_s_waitcnt(0);
        unsigned nloc = b.st[0], nx = b.st[1];
        if (nloc == 0u) { xcd_barrier_complete(bar, b.x, nloc, nx); b.st[0] = nloc; b.st[1] = nx; }
        const unsigned old = xb_add(&bar[XB_XSUB(b.x)], 1u);
        const unsigned gen = old / nloc;
        if (old + 1u == (gen + 1u) * nloc) {
            __builtin_amdgcn_fence(__ATOMIC_RELEASE, "agent");
            asm volatile("s_waitcnt vmcnt(0)" ::: "memory");
            const unsigned og = xb_add(&bar[XB_TOP], 1u);
            const unsigned tg = og / nx;
            if (og + 1u == (tg + 1u) * nx) xb_add(&bar[XB_TOPGEN], 1u);
            else XB_SPIN(xb_ld(&bar[XB_TOPGEN]) == tg, bar);
            __builtin_amdgcn_fence(__ATOMIC_ACQUIRE, "agent");
            xb_add(&bar[XB_XGEN(b.x)], 1u);
            asm volatile("s_waitcnt vmcnt(0)" ::: "memory");
        } else {
            XB_SPIN(xb_ld(&bar[XB_XGEN(b.x)]) == gen, bar);
            __builtin_amdgcn_fence(__ATOMIC_ACQUIRE, "agent");
            asm volatile("s_waitcnt vmcnt(0)" ::: "memory");
        }
    }
    __syncthreads();
}

namespace cg = cooperative_groups;
constexpr int MEGA_LDS = 65536 + 256;

DI const Params& fresh(const Params* kp) { asm volatile("" : "+s"(kp)); return *kp; }

#ifndef PROBE_MASK
#define PROBE_MASK 0
#endif
__global__ void __launch_bounds__(256, 2) hybrid_fwd_megakernel(Params p_arg) {
    __shared__ __attribute__((aligned(16))) unsigned char smem[MEGA_LDS];
    cg::grid_group grid = cg::this_grid();
    const Params* kp = (const Params*)__builtin_amdgcn_kernarg_segment_ptr();
    const int bid = blockIdx.x, nb = gridDim.x, tid0 = threadIdx.x;
#define tid opq(tid0)
    volatile LAS unsigned* xst = (volatile LAS unsigned*)(smem + 65536);
    if (tid0 == 0) { xst[0] = 0u; xst[1] = 0u; }
    __syncthreads();
    (void)xcd_barrier_post((unsigned*)(fresh(kp).ws + WS_BAR), xst);
    for (int rep = 0; rep < ((PROBE_MASK & 1) ? 2 : 1); ++rep) { phase_init(fresh(kp), smem, bid, nb, tid); }
#define GSYNC() do { XcdBarrier xb_; xb_.bar = (unsigned*)(fresh(kp).ws + WS_BAR); xb_.x = xb_xcc_id(); xb_.st = (volatile LAS unsigned*)(smem + 65536); xcd_barrier(xb_); } while (0)
    if (fresh(kp).use_cg_sync) grid.sync();
    GSYNC();
#pragma unroll 1
    for (int layer = 0; layer < DEPTH; ++layer) {
        const int j = layer >> 1;
        if (layer == 0) { { const Params& p = fresh(kp); phase_norm(p, 0, p.x, bid, nb, tid); }
        GSYNC(); }
        if ((layer & 1) == 0) {
            for (int rep = 0; rep < ((PROBE_MASK & 4) ? 2 : 1); ++rep) { phase_hyb_in<HybIn>(fresh(kp), j, smem, bid, nb, tid); }
            GSYNC();
            for (int rep = 0; rep < ((PROBE_MASK & 8) ? 2 : 1); ++rep) { phase_dsa(fresh(kp), j, smem, bid, nb, tid, layer == 0 ? 1 : 3, layer == 0 ? 3 : 4); }
            for (int rep = 0; rep < ((PROBE_MASK & 16) ? 2 : 1); ++rep) { phase_conv(fresh(kp), j, bid, nb, tid); }
            GSYNC();
            { const Params& p = fresh(kp); phase_out_proj(p, layer, p.hy_w_out + (size_t)j * 1024 * 1024, layer == 0 ? p.x : p.out, smem, bid, nb, tid); }
        } else {
            for (int rep = 0; rep < ((PROBE_MASK & 32) ? 2 : 1); ++rep) { phase_ml_in(fresh(kp), j, smem, bid, nb, tid); }
            GSYNC();
            for (int rep = 0; rep < ((PROBE_MASK & 64) ? 2 : 1); ++rep) { phase_ml1(fresh(kp), smem, bid, nb, tid); }
            GSYNC();
            for (int rep = 0; rep < ((PROBE_MASK & 128) ? 2 : 1); ++rep) { phase_ml2(fresh(kp), smem, bid, nb, tid); }
            GSYNC();
            for (int rep = 0; rep < ((PROBE_MASK & 256) ? 2 : 1); ++rep) { phase_ml3(fresh(kp), j, smem, bid, nb, tid); }
            GSYNC();
            { const Params& p = fresh(kp); phase_out_proj(p, layer, p.ml_w_out + (size_t)j * 1024 * 1024, p.out, smem, bid, nb, tid); }
        }
        GSYNC();
        phase_ffn_norm_router(fresh(kp), layer, smem, bid, nb, tid);
        GSYNC();
        for (int rep = 0; rep < ((PROBE_MASK & 512) ? 2 : 1); ++rep) { phase_moe<1>(fresh(kp), layer, smem, bid, nb, tid); }
        GSYNC();
        for (int rep = 0; rep < ((PROBE_MASK & 1024) ? 2 : 1); ++rep) { phase_moe<2>(fresh(kp), layer, smem, bid, nb, tid); }
        GSYNC();
        phase_combine_norm(fresh(kp), layer, bid, nb, tid);
        if (layer + 1 < DEPTH) GSYNC();
    }
}
#undef tid
#undef GSYNC

extern "C" void kernel_launch(void* const* d_in, const int* in_sizes, int n_in, void* d_out, int out_size, void* d_ws, size_t ws_size, hipStream_t stream) {
    Params p{};
    const float** f = (const float**)&p;
    for (int i = 0; i < 22; ++i) f[i] = (const float*)d_in[i];
    p.out = (float*)d_out;
    p.ws = (unsigned char*)d_ws;
    if (ws_size < WS_END) { fprintf(stderr, "workspace too small: %zu < %zu\n", ws_size, (size_t)WS_END); return; }
    static int grid_blocks = 0;
    if (!grid_blocks) {
        int dev = 0, cus = 0, per_cu = 0;
        hipGetDevice(&dev);
        hipDeviceGetAttribute(&cus, hipDeviceAttributeMultiprocessorCount, dev);
        hipOccupancyMaxActiveBlocksPerMultiprocessor(&per_cu, hybrid_fwd_megakernel, 256, 0);
        if (per_cu > 2) per_cu = 2;
        grid_blocks = cus * per_cu;
    }
    (void)hipMemsetAsync((unsigned char*)d_ws + WS_BAR, 0, XCD_BAR_WORDS_C * 4, stream);
    void* args[] = {&p};
    hipError_t e = hipLaunchCooperativeKernel((void*)hybrid_fwd_megakernel, dim3(grid_blocks), dim3(256), args, 0, stream);
    if (e != hipSuccess) fprintf(stderr, "cooperative launch failed: %s (grid %d)\n", hipGetErrorString(e), grid_blocks);
}
```

```cpp
#include <hip/hip_runtime.h>
#include <hip/hip_cooperative_groups.h>
#include <stdint.h>
#include <cstdio>

#define DI __device__ __forceinline__
typedef unsigned short bf16_t;
typedef short bf16x8 __attribute__((ext_vector_type(8)));
typedef float f32x16 __attribute__((ext_vector_type(16)));
typedef float f32x4 __attribute__((ext_vector_type(4)));
typedef float f32x2 __attribute__((ext_vector_type(2)));
typedef unsigned u32x4 __attribute__((ext_vector_type(4)));
typedef unsigned u32x2 __attribute__((ext_vector_type(2)));
typedef __bf16 bf16x2_t __attribute__((ext_vector_type(2)));

constexpr int D = 1024, NB = 8, S = 2048, T = NB * S, DEPTH = 4;
constexpr int HYB_IN = 2760, ML_IN = 3088;
constexpr int NEXP = 32, DEXP = 512, NASG = T * 2;
constexpr float EPS = 1e-6f;
constexpr int XCD_BAR_WORDS_C = 3456;

constexpr size_t al256(size_t x) { return (x + 255) & ~(size_t)255; }
constexpr size_t WS_MOD = 0;
constexpr size_t WS_ROPEC = WS_MOD + al256((size_t)4 * 8 * 6144 * 4);
constexpr size_t WS_ROPES = WS_ROPEC + al256((size_t)2048 * 32 * 4);
constexpr size_t WS_ECNT = WS_ROPES + al256((size_t)2048 * 32 * 4);
constexpr int ECS = 64;
constexpr size_t WS_H = WS_ECNT + al256(4 * 32 * ECS * 4);
constexpr size_t WS_YMIX = WS_H + al256((size_t)T * 1024 * 2);
constexpr size_t WS_Q = WS_YMIX + al256((size_t)T * 1024 * 2);
constexpr size_t WS_K = WS_Q + al256((size_t)T * 512 * 2);
constexpr size_t WS_V = WS_K + al256((size_t)T * 64 * 2);
constexpr size_t WS_IQ = WS_V + al256((size_t)T * 64 * 2);
constexpr size_t WS_IK = WS_IQ + al256((size_t)T * 512 * 2);
constexpr size_t WS_IW = WS_IK + al256((size_t)T * 64 * 2);
constexpr size_t WS_BG = WS_IW + al256((size_t)T * 8 * 4);
constexpr size_t WS_Z = WS_BG + al256((size_t)T * 512 * 2);
constexpr size_t WS_MASK = WS_Z + al256((size_t)T * 512 * 2);
constexpr size_t WS_MQ = WS_MASK + al256((size_t)T * 64 * 4);
constexpr size_t WS_MK = WS_MQ + al256((size_t)T * 512 * 2);
constexpr size_t WS_MV = WS_MK + al256((size_t)T * 512 * 2);
constexpr size_t WS_MIG = WS_MV + al256((size_t)T * 1024 * 2);
constexpr size_t WS_MFG = WS_MIG + al256((size_t)T * 8 * 4);
constexpr size_t WS_MOG = WS_MFG + al256((size_t)T * 8 * 4);
constexpr size_t WS_EW = WS_MOG + al256((size_t)T * 1024 * 2);
constexpr size_t WS_ELIST = WS_EW + al256((size_t)NASG * 4);
constexpr size_t WS_H1 = WS_ELIST + al256((size_t)NEXP * NASG * 4);
constexpr size_t WS_Y = WS_H1 + al256((size_t)NASG * 512 * 2);
constexpr size_t WS_MKT = WS_Y + al256((size_t)NASG * 1024 * 2);
constexpr size_t WS_UBUF = WS_MKT + al256((size_t)64 * 64 * S * 2);
constexpr size_t WS_UNBUF = WS_UBUF + al256((size_t)64 * 32 * 8192 * 4);
constexpr size_t WS_MLOC = WS_UNBUF + al256((size_t)64 * 32 * 64 * 4);
constexpr size_t WS_CBUF = WS_MLOC + al256((size_t)64 * 32 * 2 * 4);
constexpr size_t WS_NBUF = WS_CBUF + al256((size_t)64 * 32 * 8192 * 2);
constexpr size_t WS_MST = WS_NBUF + al256((size_t)64 * 32 * 64 * 4);
constexpr size_t WS_PART = WS_MST + al256((size_t)64 * 32 * 4);
constexpr size_t WS_WHYB = WS_PART + al256((size_t)T * 16 * 4);
constexpr size_t WS_WML = WS_WHYB + al256((size_t)2 * 2816 * 1024 * 2);
constexpr size_t WS_WOUT = WS_WML + al256((size_t)2 * 3200 * 1024 * 2);
constexpr size_t WS_WM1 = WS_WOUT + al256((size_t)4 * 1024 * 1024 * 2);
constexpr size_t WS_WM2 = WS_WM1 + al256((size_t)4 * 32 * 1024 * 1024 * 2);
constexpr size_t WS_BAR = WS_WM2 + al256((size_t)4 * 32 * 1024 * 512 * 2);
constexpr size_t WS_END = WS_BAR + al256((size_t)XCD_BAR_WORDS_C * 4);

struct Params {
    const float *x, *c, *ada_w, *ada_b, *norm_mix, *norm_ffn, *hy_w_in, *hy_q_norm, *hy_k_norm, *hy_conv_w, *hy_w_out;
    const float *ml_w_in, *ml_b_gates, *ml_out_norm, *ml_w_out, *moe_w_group, *moe_b_group, *moe_w_expert, *moe_b_expert;
    const float *moe_w_gate, *moe_w_up, *moe_w_down;
    float* out;
    unsigned char* ws;
    unsigned long long use_cg_sync;
};

DI unsigned pk2(float lo, float hi) { f32x2 v = {lo, hi}; bf16x2_t b = __builtin_convertvector(v, bf16x2_t); return __builtin_bit_cast(unsigned, b); }
DI bf16_t f2bf(float x) { return (bf16_t)(pk2(x, 0.f) & 0xffffu); }
DI float bf2f(bf16_t h) { return __uint_as_float(((unsigned)h) << 16); }
DI float bflo(unsigned u) { return __uint_as_float(u << 16); }
DI float bfhi(unsigned u) { return __uint_as_float(u & 0xffff0000u); }
DI float wave_sum(float v) { for (int m = 32; m >= 1; m >>= 1) v += __shfl_xor(v, m); return v; }
DI float wave_max(float v) { for (int m = 32; m >= 1; m >>= 1) v = fmaxf(v, __shfl_xor(v, m)); return v; }
DI float half_sum(float v) { for (int m = 16; m >= 1; m >>= 1) v += __shfl_xor(v, m); return v; }
DI float sigmoidf_(float x) { return 1.f / (1.f + __expf(-x)); }
DI int lane_id() { int x; asm volatile("v_mbcnt_lo_u32_b32 %0, -1, 0\n\tv_mbcnt_hi_u32_b32 %0, -1, %0" : "=v"(x)); return x; }
DI int opqs(int x) { asm volatile("" : "+s"(x)); return x; }
DI int opq(int x) { asm volatile("" : "+v"(x)); return x; }

DI int swz(int row, int slot) { return row * 128 + ((slot ^ ((row >> 1) & 7)) << 4); }
DI int crow(int reg, int lane) { return (reg & 3) + 8 * (reg >> 2) + 4 * (lane >> 5); }

template <class P>
DI void gemm_tile(const P& pr, unsigned char* smem, int tid) {
    const int lane = tid & 63, wid = tid >> 6, wr = wid >> 1, wc = wid & 1;
    const bf16_t* abase = pr.a_base();
    const bf16_t* bbase = pr.b_base();
    const int kdim = pr.kt() * 64;
    int gao[4], gbo[4];
#pragma unroll
    for (int i = 0; i < 4; ++i) {
        const int row = (tid >> 3) + 32 * i, sl = (tid & 7) ^ ((row >> 1) & 7);
        const int o = pr.a_off(row);
        gao[i] = (o >= 0 ? o : 0) + sl * 8; gbo[i] = row * kdim + sl * 8;
    }
#define GLDS(buf, kt) do { _Pragma("unroll") for (int i = 0; i < 4; ++i) { \
        __builtin_amdgcn_global_load_lds((const unsigned*)(abase + gao[i] + (kt) * 64), (__attribute__((address_space(3))) unsigned*)(smem + (buf) * 32768 + (i * 256 + wid * 64) * 16), 16, 0, 0); \
        __builtin_amdgcn_global_load_lds((const unsigned*)(bbase + gbo[i] + (kt) * 64), (__attribute__((address_space(3))) unsigned*)(smem + (buf) * 32768 + 16384 + (i * 256 + wid * 64) * 16), 16, 0, 0); } } while (0)
#define DMA_WAIT_SYNC() do { asm volatile("s_waitcnt vmcnt(0)" ::: "memory"); __syncthreads(); } while (0)
#define COMPUTE(buf) do { const unsigned char* As = smem + (buf) * 32768; const unsigned char* Bs = As + 16384; \
        _Pragma("unroll") for (int ks = 0; ks < 4; ++ks) { const int slot = ks * 2 + (lane >> 5); \
            const bf16x8 a0 = *(const bf16x8*)(As + swz(wr * 64 + (lane & 31), slot)); const bf16x8 a1 = *(const bf16x8*)(As + swz(wr * 64 + 32 + (lane & 31), slot)); \
            const bf16x8 b0 = *(const bf16x8*)(Bs + swz(wc * 64 + (lane & 31), slot)); const bf16x8 b1 = *(const bf16x8*)(Bs + swz(wc * 64 + 32 + (lane & 31), slot)); \
            acc[0][0] = __builtin_amdgcn_mfma_f32_32x32x16_bf16(a0, b0, acc[0][0], 0, 0, 0); acc[0][1] = __builtin_amdgcn_mfma_f32_32x32x16_bf16(a0, b1, acc[0][1], 0, 0, 0); \
            acc[1][0] = __builtin_amdgcn_mfma_f32_32x32x16_bf16(a1, b0, acc[1][0], 0, 0, 0); acc[1][1] = __builtin_amdgcn_mfma_f32_32x32x16_bf16(a1, b1, acc[1][1], 0, 0, 0); } } while (0)
    f32x16 acc[2][2];
#pragma unroll
    for (int a = 0; a < 2; ++a)
#pragma unroll
        for (int b = 0; b < 2; ++b)
#pragma unroll
            for (int r = 0; r < 16; ++r) acc[a][b][r] = 0.f;
    const int KT = pr.kt();
    __syncthreads();
    GLDS(0, 0);
    DMA_WAIT_SYNC();
    for (int kt = 0; kt < KT; kt += 2) {
        GLDS(1, kt + 1);
        COMPUTE(0);
        DMA_WAIT_SYNC();
        if (kt + 2 < KT) GLDS(0, kt + 2);
        COMPUTE(1);
        DMA_WAIT_SYNC();
    }
#undef GLDS
#undef DMA_WAIT_SYNC
#undef COMPUTE
    pr.epi(acc, wr, wc, lane, smem + wid * 8192);
}

template <class P>
DI void convert_tile(const P& pr, bf16_t* dst, int kdim, int kt, unsigned char* smem, int tid) {
    unsigned char* Bs = smem;
    const int ng = tid & 31, kg = tid >> 5;
    int width = 0;
    const float* bp = pr.b_col(ng >> 3, width);
    const int cig = (ng & 7) * 4;
    const bool bvalid = cig < width;
    const int ldb = pr.ldb();
    bp += cig + (size_t)(kt * 64 + kg * 8) * ldb;
    f32x4 rb[8];
#pragma unroll
    for (int kk = 0; kk < 8; ++kk) rb[kk] = bvalid ? *(const f32x4*)(bp + (size_t)kk * ldb) : (f32x4){0.f, 0.f, 0.f, 0.f};
    __syncthreads();
#pragma unroll
    for (int j = 0; j < 4; ++j) {
        u32x4 v = {pk2(rb[0][j], rb[1][j]), pk2(rb[2][j], rb[3][j]), pk2(rb[4][j], rb[5][j]), pk2(rb[6][j], rb[7][j])};
        *(u32x4*)(Bs + swz(ng * 4 + j, kg)) = v;
    }
    __syncthreads();
#pragma unroll
    for (int i = 0; i < 4; ++i) {
        const int n = (tid >> 3) + 32 * i;
        *(u32x4*)(dst + (size_t)n * kdim + kt * 64 + (tid & 7) * 8) = *(const u32x4*)(Bs + swz(n, tid & 7));
    }
}

template <int NC> DI void stage_put(unsigned char* wl, int mi, int ni, int r, int lane, float v) { *(bf16_t*)(wl + ((mi * 32 + crow(r, lane)) * NC + ni * 32 + (lane & 31)) * 2) = f2bf(v); }
template <int NC, class RowPtr> DI void stage_flush(unsigned char* wl, int lane, RowPtr rp) {
    constexpr int CH = NC / 8, RPI = 64 / CH, NIT = 64 / RPI;
#pragma unroll
    for (int i = 0; i < NIT; ++i) {
        const int row = lane / CH + RPI * i, ch = lane % CH;
        const u32x4 d = *(const u32x4*)(wl + (row * NC + ch * 8) * 2);
        bf16_t* dst = rp(row);
        if (dst) *(u32x4*)(dst + ch * 8) = d;
    }
}

struct HybIn {
    const Params* p; int j, tm, tn;
    DI int kt() const { return 16; }
    DI int ldb() const { return HYB_IN; }
    DI const bf16_t* a_base() const { return (const bf16_t*)(p->ws + WS_H); }
    DI int a_off(int r) const { return (tm * 128 + r) * 1024; }
    DI static void pair_cols(int pr, int ni, int& base, int& width) {
        width = 32;
        if (pr < 8) base = 64 * pr + 32 * ni;
        else if (pr == 8) base = 512 + 32 * ni;
        else if (pr == 9) base = 576 + 32 * ni;
        else if (pr < 18) base = 640 + 64 * (pr - 10) + 32 * ni;
        else if (pr == 18) base = 1152 + 32 * ni;
        else if (pr == 19) { base = 1216; width = ni == 0 ? 8 : 0; }
        else if (pr < 28) base = 1224 + 64 * (pr - 20) + 32 * ni;
        else base = (ni == 0 ? 1736 : 2248) + 32 * (pr - 28);
    }
    DI const float* b_col(int g, int& width) const { int base; pair_cols(tn * 2 + (g >> 1), g & 1, base, width); return p->hy_w_in + (size_t)j * 1024 * HYB_IN + base; }
    DI const bf16_t* b_base() const { return (const bf16_t*)(p->ws + WS_WHYB) + (size_t)(j * 22 + tn) * 128 * 1024; }
    DI void epi(f32x16 (&acc)[2][2], int wr, int wc, int lane, unsigned char* wl) const {
        const int pr = tn * 2 + wc, c = lane & 31;
        const int t0 = tm * 128 + wr * 64;
        unsigned char* ws = p->ws;
        const float* ropec = (const float*)(ws + WS_ROPEC);
        const float* ropes = (const float*)(ws + WS_ROPES);
        if (pr < 9 || (pr >= 10 && pr < 19)) {
            const bool donorm = pr < 9;
            const float* gam = pr < 8 ? p->hy_q_norm + j * 64 : p->hy_k_norm + j * 64;
            bf16_t* ob; int ld, cb;
            if (pr < 8) { ob = (bf16_t*)(ws + WS_Q); ld = 512; cb = 64 * pr; }
            else if (pr == 8) { ob = (bf16_t*)(ws + WS_K); ld = 64; cb = 0; }
            else if (pr < 18) { ob = (bf16_t*)(ws + WS_IQ); ld = 512; cb = 64 * (pr - 10); }
            else { ob = (bf16_t*)(ws + WS_IK); ld = 64; cb = 0; }
            float g1 = 1.f, g2 = 1.f;
            if (donorm) { g1 = gam[c]; g2 = gam[c + 32]; }
#pragma unroll
            for (int mi = 0; mi < 2; ++mi)
#pragma unroll
                for (int r = 0; r < 16; ++r) {
                    float x1 = acc[mi][0][r], x2 = acc[mi][1][r];
                    const int t = t0 + mi * 32 + crow(r, lane), pos = t & (S - 1);
                    if (donorm) { float ss = half_sum(x1 * x1 + x2 * x2); float rstd = rsqrtf(ss * (1.f / 64.f) + EPS); x1 *= rstd * g1; x2 *= rstd * g2; }
                    const float cs = ropec[pos * 32 + c], sn = ropes[pos * 32 + c];
                    stage_put<64>(wl, mi, 0, r, lane, x1 * cs - x2 * sn);
                    stage_put<64>(wl, mi, 1, r, lane, x2 * cs + x1 * sn);
                }
            stage_flush<64>(wl, lane, [&](int row) { return ob + (size_t)(t0 + row) * ld + cb; });
        } else if (pr == 9) {
            bf16_t* ob = (bf16_t*)(ws + WS_V);
#pragma unroll
            for (int mi = 0; mi < 2; ++mi)
#pragma unroll
                for (int ni = 0; ni < 2; ++ni)
#pragma unroll
                    for (int g4 = 0; g4 < 4; ++g4) {
                        const int t = t0 + mi * 32 + 8 * g4 + 4 * (lane >> 5), pos = t & (S - 1), bb = t >> 11;
                        u32x2 o = {pk2(acc[mi][ni][4 * g4], acc[mi][ni][4 * g4 + 1]), pk2(acc[mi][ni][4 * g4 + 2], acc[mi][ni][4 * g4 + 3])};
                        *(u32x2*)(ob + ((size_t)(bb * 64 + ni * 32 + c)) * S + pos) = o;
                    }
        } else if (pr == 19) {
            float* ob = (float*)(ws + WS_IW);
            if (c < 8) {
#pragma unroll
                for (int mi = 0; mi < 2; ++mi)
#pragma unroll
                    for (int r = 0; r < 16; ++r) { const int t = t0 + mi * 32 + crow(r, lane); ob[(size_t)t * 8 + c] = acc[mi][0][r] * (0.125f * 0.35355339059327373f); }
            }
        } else if (pr < 28) {
            bf16_t* ob = (bf16_t*)(ws + WS_BG); const int cb = 64 * (pr - 20);
#pragma unroll
            for (int mi = 0; mi < 2; ++mi)
#pragma unroll
                for (int r = 0; r < 16; ++r) { stage_put<64>(wl, mi, 0, r, lane, acc[mi][0][r]); stage_put<64>(wl, mi, 1, r, lane, acc[mi][1][r]); }
            stage_flush<64>(wl, lane, [&](int row) { return ob + (size_t)(t0 + row) * 512 + cb; });
        } else {
            bf16_t* ob = (bf16_t*)(ws + WS_Z); const int cb = 32 * (pr - 28);
#pragma unroll
            for (int mi = 0; mi < 2; ++mi)
#pragma unroll
                for (int r = 0; r < 16; ++r) stage_put<32>(wl, mi, 0, r, lane, acc[mi][0][r] * acc[mi][1][r]);
            stage_flush<32>(wl, lane, [&](int row) { return ob + (size_t)(t0 + row) * 512 + cb; });
        }
    }
};


struct HybCols8 {
    const Params* p; int j, tm, tn;
    DI int ldb() const { return HYB_IN; }
    DI const float* b_col(int g, int& width) const {
        const int u = tn >> 1, bj = tn & 1; int base; width = 32;
        if (u < 2) base = 64 * (4 * u + g) + 32 * bj;
        else if (u < 4) base = 640 + 64 * (4 * (u - 2) + g) + 32 * bj;
        else if (u == 4) { if (g == 0) base = 512 + 32 * bj; else if (g == 1) base = 576 + 32 * bj; else if (g == 2) base = 1152 + 32 * bj; else { base = 1216; width = bj == 0 ? 8 : 0; } }
        else if (u < 7) base = 1224 + (u - 5) * 256 + 128 * bj + 32 * g;
        else base = (bj == 0 ? 1736 : 2248) + (u - 7) * 128 + 32 * g;
        return p->hy_w_in + (size_t)j * 1024 * HYB_IN + base;
    }
};

struct MlIn {
    const Params* p; int j, tm, tn;
    DI int kt() const { return 16; }
    DI int ldb() const { return ML_IN; }
    DI const bf16_t* a_base() const { return (const bf16_t*)(p->ws + WS_H); }
    DI int a_off(int r) const { return (tm * 128 + r) * 1024; }
    DI const float* b_col(int g, int& width) const {
        const int pr = tn * 2 + (g >> 1), ni = g & 1; int base; width = 32;
        if (pr < 32) base = 64 * pr + 32 * ni;
        else if (pr == 32) { base = 2048 + 8 * ni; width = 8; }
        else if (pr < 49) base = 2064 + 64 * (pr - 33) + 32 * ni;
        else { base = 0; width = 0; }
        return p->ml_w_in + (size_t)j * 1024 * ML_IN + base;
    }
    DI const bf16_t* b_base() const { return (const bf16_t*)(p->ws + WS_WML) + (size_t)(j * 25 + tn) * 128 * 1024; }
    DI void epi(f32x16 (&acc)[2][2], int wr, int wc, int lane, unsigned char* wl) const {
        const int pr = tn * 2 + wc, c = lane & 31;
        const int t0 = tm * 128 + wr * 64;
        unsigned char* ws = p->ws;
        if (pr < 16) {
            bf16_t* ob; int cb; float sc = 1.f;
            if (pr < 8) { ob = (bf16_t*)(ws + WS_MQ); cb = 64 * pr; sc = 0.125f; }
            else { ob = (bf16_t*)(ws + WS_MK); cb = 64 * (pr - 8); }
#pragma unroll
            for (int mi = 0; mi < 2; ++mi)
#pragma unroll
                for (int r = 0; r < 16; ++r) { stage_put<64>(wl, mi, 0, r, lane, acc[mi][0][r] * sc); stage_put<64>(wl, mi, 1, r, lane, acc[mi][1][r] * sc); }
            stage_flush<64>(wl, lane, [&](int row) { return ob + (size_t)(t0 + row) * 512 + cb; });
        }
        if (pr >= 8 && pr < 32) {
            bf16_t* ob; int nrow, hd, r0;
            if (pr < 16) { ob = (bf16_t*)(ws + WS_MKT); nrow = 64; hd = pr - 8; r0 = 0; }
            else { ob = (bf16_t*)(ws + WS_MV); nrow = 128; hd = (pr - 16) >> 1; r0 = 64 * ((pr - 16) & 1); }
#pragma unroll
            for (int mi = 0; mi < 2; ++mi)
#pragma unroll
                for (int ni = 0; ni < 2; ++ni)
#pragma unroll
                    for (int g4 = 0; g4 < 4; ++g4) {
                        const int t = t0 + mi * 32 + 8 * g4 + 4 * (lane >> 5), pos = t & (S - 1), bb = t >> 11;
                        u32x2 o = {pk2(acc[mi][ni][4 * g4], acc[mi][ni][4 * g4 + 1]), pk2(acc[mi][ni][4 * g4 + 2], acc[mi][ni][4 * g4 + 3])};
                        *(u32x2*)(ob + ((size_t)((bb * 8 + hd) * nrow + r0 + ni * 32 + c)) * S + pos) = o;
                    }
        } else if (pr == 32) {
            if (c < 8) {
                float* oi = (float*)(ws + WS_MIG); float* of = (float*)(ws + WS_MFG);
                const float bi = p->ml_b_gates[j * 16 + c], bfg = p->ml_b_gates[j * 16 + 8 + c];
#pragma unroll
                for (int mi = 0; mi < 2; ++mi)
#pragma unroll
                    for (int r = 0; r < 16; ++r) {
                        const int t = t0 + mi * 32 + crow(r, lane);
                        oi[(size_t)t * 8 + c] = acc[mi][0][r] + bi;
                        const float f = acc[mi][1][r] + bfg;
                        of[(size_t)t * 8 + c] = fminf(f, 0.f) - log1pf(__expf(-fabsf(f)));
                    }
            }
        } else if (pr >= 33 && pr < 49) {
            bf16_t* ob = (bf16_t*)(ws + WS_MOG); const int cb = 64 * (pr - 33);
#pragma unroll
            for (int mi = 0; mi < 2; ++mi)
#pragma unroll
                for (int r = 0; r < 16; ++r) { stage_put<64>(wl, mi, 0, r, lane, sigmoidf_(acc[mi][0][r])); stage_put<64>(wl, mi, 1, r, lane, sigmoidf_(acc[mi][1][r])); }
            stage_flush<64>(wl, lane, [&](int row) { return ob + (size_t)(t0 + row) * 1024 + cb; });
        }
    }
};


struct MlCols8 {
    const Params* p; int j, tm, tn;
    DI int ldb() const { return ML_IN; }
    DI const float* b_col(int g, int& width) const {
        const int u = tn >> 1, bj = tn & 1; int base; width = 32;
        if (tn == 24) { base = 2048 + 8 * (g & 1); width = g < 2 ? 8 : 0; }
        else if (u < 2) base = 64 * (4 * u + g) + 32 * bj;
        else if (u < 4) base = 512 + 64 * (4 * (u - 2) + g) + 32 * bj;
        else if (u < 8) base = 1024 + (2 * (u - 4) + bj) * 128 + 32 * g;
        else base = 2064 + (u - 8) * 256 + 128 * bj + 32 * g;
        return p->ml_w_in + (size_t)j * 1024 * ML_IN + base;
    }
};
struct MlGates {
    const Params* p; int j, tm;
    DI int kt() const { return 16; }
    DI const bf16_t* a_base() const { return (const bf16_t*)(p->ws + WS_H); }
    DI int a_off(int r) const { return (tm * 128 + r) * 1024; }
    DI const bf16_t* b_base() const { return (const bf16_t*)(p->ws + WS_WML) + (size_t)(j * 25 + 24) * 128 * 1024; }
    DI void epi(f32x16 (&acc)[2][2], int wr, int wc, int lane, unsigned char* wl) const {
        const int c = lane & 31, t0 = tm * 128 + wr * 64;
        if (wc == 0 && c < 8) {
            float* oi = (float*)(p->ws + WS_MIG); float* of = (float*)(p->ws + WS_MFG);
            const float bi = p->ml_b_gates[j * 16 + c], bfg = p->ml_b_gates[j * 16 + 8 + c];
#pragma unroll
            for (int mi = 0; mi < 2; ++mi)
#pragma unroll
                for (int r = 0; r < 16; ++r) {
                    const int t = t0 + mi * 32 + crow(r, lane);
                    oi[(size_t)t * 8 + c] = acc[mi][0][r] + bi;
                    const float f = acc[mi][1][r] + bfg;
                    of[(size_t)t * 8 + c] = fminf(f, 0.f) - log1pf(__expf(-fabsf(f)));
                }
        }
    }
};

struct OutProj {
    const Params* p; const float* W; const float* src; int layer, tm, tn;
    DI int kt() const { return 16; }
    DI int ldb() const { return 1024; }
    DI const bf16_t* a_base() const { return (const bf16_t*)(p->ws + WS_YMIX); }
    DI int a_off(int r) const { return (tm * 128 + r) * 1024; }
    DI const float* b_col(int g, int& width) const { width = 32; return W + tn * 128 + g * 32; }
    DI const bf16_t* b_base() const { return (const bf16_t*)(p->ws + WS_WOUT) + (size_t)(layer * 8 + tn) * 128 * 1024; }
    DI void epi(f32x16 (&acc)[2][2], int wr, int wc, int lane, unsigned char* wl) const {
        const int c = lane & 31, t0 = tm * 128 + wr * 64, wid = wr * 2 + wc;
        float* fl = (float*)(wl + wid * 8192);
#pragma unroll
        for (int mi = 0; mi < 2; ++mi)
#pragma unroll
            for (int ni = 0; ni < 2; ++ni)
#pragma unroll
                for (int r = 0; r < 16; ++r) fl[(mi * 32 + crow(r, lane)) * 64 + ni * 32 + c] = acc[mi][ni][r];
        const float* mod = (const float*)(p->ws + WS_MOD) + (size_t)layer * 8 * 6144;
        const int ch = lane & 15, n = tn * 128 + wc * 64 + ch * 4;
        const f32x4 g = *(const f32x4*)(mod + (t0 >> 11) * 6144 + 2048 + n);
        float* part = (float*)(p->ws + WS_PART);
#pragma unroll 4
        for (int i = 0; i < 16; ++i) {
            const int row = (lane >> 4) + 4 * i, t = t0 + row;
            const f32x4 a = *(const f32x4*)(fl + row * 64 + ch * 4);
            const f32x4 o = *(const f32x4*)(src + (size_t)t * 1024 + n) + g * a;
            *(f32x4*)(p->out + (size_t)t * 1024 + n) = o;
            float ss = o[0] * o[0] + o[1] * o[1] + o[2] * o[2] + o[3] * o[3];
            ss += __shfl_xor(ss, 1); ss += __shfl_xor(ss, 2); ss += __shfl_xor(ss, 4); ss += __shfl_xor(ss, 8);
            if (ch == 0) part[(size_t)t * 16 + tn * 2 + wc] = ss;
        }
    }
};

struct Moe1 {
    const Params* p; int layer, e, mt, nt, cnt, roff;
    DI int kt() const { return 16; }
    DI int ldb() const { return DEXP; }
    DI const bf16_t* a_base() const { return (const bf16_t*)(p->ws + WS_H); }
    DI int a_off(int r) const {
        const int rr = mt * 128 + r; if (rr >= cnt) return -1;
        const int a = ((const int*)(p->ws + WS_ELIST))[(size_t)e * NASG + rr];
        return (a >> 1) * 1024;
    }
    DI const float* b_col(int g, int& width) const {
        width = 32; const int pr = nt * 2 + (g >> 1);
        const float* base = (g & 1) ? p->moe_w_up : p->moe_w_gate;
        return base + ((size_t)layer * NEXP + e) * (size_t)(D * DEXP) + 32 * pr;
    }
    DI const bf16_t* b_base() const { return (const bf16_t*)(p->ws + WS_WM1) + (size_t)((layer * NEXP + e) * 8 + nt) * 128 * 1024; }
    DI void epi(f32x16 (&acc)[2][2], int wr, int wc, int lane, unsigned char* wl) const {
        const int c = lane & 31, pr = nt * 2 + wc;
        bf16_t* ob = (bf16_t*)(p->ws + WS_H1);
#pragma unroll
        for (int mi = 0; mi < 2; ++mi)
#pragma unroll
            for (int r = 0; r < 16; ++r) {
                const float g = acc[mi][0][r], u = acc[mi][1][r];
                stage_put<32>(wl, mi, 0, r, lane, g / (1.f + __expf(-g)) * u);
            }
        const int rb = mt * 128 + wr * 64;
        stage_flush<32>(wl, lane, [&](int row) { return rb + row < cnt ? ob + (size_t)(roff + rb + row) * 512 + 32 * pr : (bf16_t*)nullptr; });
    }
};

struct Moe2 {
    const Params* p; int layer, e, mt, nt, cnt, roff;
    DI int kt() const { return 8; }
    DI int ldb() const { return D; }
    DI const bf16_t* a_base() const { return (const bf16_t*)(p->ws + WS_H1); }
    DI int a_off(int r) const { const int rr = mt * 128 + r; if (rr >= cnt) return -1; return (roff + rr) * 512; }
    DI const float* b_col(int g, int& width) const { width = 32; return p->moe_w_down + ((size_t)layer * NEXP + e) * (size_t)(DEXP * D) + nt * 128 + g * 32; }
    DI const bf16_t* b_base() const { return (const bf16_t*)(p->ws + WS_WM2) + (size_t)((layer * NEXP + e) * 8 + nt) * 128 * 512; }
    DI void epi(f32x16 (&acc)[2][2], int wr, int wc, int lane, unsigned char* wl) const {
        const int c = lane & 31;
        bf16_t* ob = (bf16_t*)(p->ws + WS_Y);
        const int* el = (const int*)(p->ws + WS_ELIST) + (size_t)e * NASG;
#pragma unroll
        for (int mi = 0; mi < 2; ++mi)
#pragma unroll
            for (int r = 0; r < 16; ++r) { stage_put<64>(wl, mi, 0, r, lane, acc[mi][0][r]); stage_put<64>(wl, mi, 1, r, lane, acc[mi][1][r]); }
        const int rb = mt * 128 + wr * 64;
        stage_flush<64>(wl, lane, [&](int row) { return rb + row < cnt ? ob + (size_t)el[rb + row] * 1024 + nt * 128 + wc * 64 : (bf16_t*)nullptr; });
    }
};

DI void convert_moe_layers(const Params& p, int l0, int l1, unsigned char* smem, int bid, int nb, int tid) {
    const int PER = 32 * 8 * 16 + 32 * 8 * 8, total = (l1 - l0) * PER;
    for (int item = bid; item < total; item += nb) {
        const int l = l0 + item / PER; int ci = item % PER;
        if (ci < 4096) { const int kt = ci & 15, nt = (ci >> 4) & 7, e = ci >> 7; Moe1 pr{&p, l, e, 0, nt, 0, 0}; convert_tile(pr, (bf16_t*)(p.ws + WS_WM1) + (size_t)((l * 32 + e) * 8 + nt) * 128 * 1024, 1024, kt, smem, tid); }
        else { ci -= 4096; const int kt = ci & 7, nt = (ci >> 3) & 7, e = ci >> 6; Moe2 pr{&p, l, e, 0, nt, 0, 0}; convert_tile(pr, (bf16_t*)(p.ws + WS_WM2) + (size_t)((l * 32 + e) * 8 + nt) * 128 * 512, 512, kt, smem, tid); }
    }
    __syncthreads();
}

DI void phase_init(const Params& p, unsigned char* smem, int bid, int nb, int tid) {
    float* sc = (float*)smem;
    float* red = (float*)(smem + 32768);
    const int NMOD = DEPTH * 96, NROPE = 256;
    const int C_HYB = 2 * 22 * 16, C_ML = 2 * 25 * 16, C_OUT = 4 * 8 * 16;
    for (int ci = bid; ci < C_HYB + C_ML + C_OUT; ci += nb) {
        int c2 = ci;
        if (c2 < C_HYB) { const int kt = c2 & 15, tn = (c2 >> 4) % 22, j = (c2 >> 4) / 22; HybCols8 pr{&p, j, 0, tn}; convert_tile(pr, (bf16_t*)(p.ws + WS_WHYB) + (size_t)(j * 22 + tn) * 128 * 1024, 1024, kt, smem, tid); continue; }
        c2 -= C_HYB;
        if (c2 < C_ML) { const int kt = c2 & 15, tn = (c2 >> 4) % 25, j = (c2 >> 4) / 25; MlCols8 pr{&p, j, 0, tn}; convert_tile(pr, (bf16_t*)(p.ws + WS_WML) + (size_t)(j * 25 + tn) * 128 * 1024, 1024, kt, smem, tid); continue; }
        c2 -= C_ML;
        { const int kt = c2 & 15, tn = (c2 >> 4) & 7, l = c2 >> 7; const float* W = ((l & 1) ? p.ml_w_out : p.hy_w_out) + (size_t)(l >> 1) * 1024 * 1024;
            OutProj pr{&p, W, nullptr, l, 0, tn}; convert_tile(pr, (bf16_t*)(p.ws + WS_WOUT) + (size_t)(l * 8 + tn) * 128 * 1024, 1024, kt, smem, tid); }
    }
    for (int item = bid; item < NMOD; item += nb) {
        __syncthreads();
        for (int i = tid; i < 8 * 1024; i += 256) { const float v = p.c[i]; sc[i] = v / (1.f + __expf(-v)); }
        __syncthreads();
        const int l = item / 96, jb = item % 96, cq = tid & 15, ksl = tid >> 4;
        const float* w = p.ada_w + (size_t)l * 1024 * 6144 + jb * 64 + cq * 4;
        f32x4 acc[8];
#pragma unroll
        for (int b = 0; b < 8; ++b) acc[b] = (f32x4){0.f, 0.f, 0.f, 0.f};
        for (int ii = 0; ii < 64; ++ii) {
            const int i = ksl * 64 + ii;
            const f32x4 wv = *(const f32x4*)(w + (size_t)i * 6144);
#pragma unroll
            for (int b = 0; b < 8; ++b) acc[b] += wv * sc[b * 1024 + i];
        }
#pragma unroll
        for (int b = 0; b < 8; ++b) *(f32x4*)(red + (ksl * 8 + b) * 64 + cq * 4) = acc[b];
        __syncthreads();
        for (int o = tid; o < 512; o += 256) {
            const int b = o >> 6, cc = o & 63; float s = 0.f;
            for (int k = 0; k < 16; ++k) s += red[(k * 8 + b) * 64 + cc];
            ((float*)(p.ws + WS_MOD))[((size_t)l * 8 + b) * 6144 + jb * 64 + cc] = s + p.ada_b[l * 6144 + jb * 64 + cc];
        }
    }
    for (int item = bid; item < NROPE + 1; item += nb) {
        if (item < NROPE) {
            const int idx = item * 256 + tid;
            const int pos = idx >> 5, i = idx & 31;
            const float inv = 1.0f / powf(10000.0f, (float)(2 * i) / 64.0f);
            const float ang = (float)pos * inv;
            ((float*)(p.ws + WS_ROPEC))[idx] = cosf(ang);
            ((float*)(p.ws + WS_ROPES))[idx] = sinf(ang);
        } else {
            if (tid < DEPTH * 32) ((int*)(p.ws + WS_ECNT))[tid * ECS] = 0;
        }
    }
    __syncthreads();
    convert_moe_layers(p, 0, 1, smem, bid, nb, tid);
}

DI void phase_norm(const Params& p, int layer, const float* src, int bid, int nb, int tid) {
    const int lane = tid & 63, wid = tid >> 6;
    const float* mod = (const float*)(p.ws + WS_MOD) + (size_t)layer * 8 * 6144;
    const float* gam = p.norm_mix + layer * 1024;
    bf16_t* H = (bf16_t*)(p.ws + WS_H);
    for (int item = bid; item < T / 4; item += nb) {
        const int t = item * 4 + wid, b = t >> 11;
        const float* xr = src + (size_t)t * 1024;
        f32x4 v[4]; float ss = 0.f;
#pragma unroll
        for (int i = 0; i < 4; ++i) { v[i] = *(const f32x4*)(xr + (lane + 64 * i) * 4); ss += v[i][0] * v[i][0] + v[i][1] * v[i][1] + v[i][2] * v[i][2] + v[i][3] * v[i][3]; }
        ss = wave_sum(ss);
        const float rstd = rsqrtf(ss * (1.f / 1024.f) + EPS);
#pragma unroll
        for (int i = 0; i < 4; ++i) {
            const int c0 = (lane + 64 * i) * 4;
            const f32x4 g = *(const f32x4*)(gam + c0), sh = *(const f32x4*)(mod + b * 6144 + c0), sc = *(const f32x4*)(mod + b * 6144 + 1024 + c0);
            f32x4 h = v[i] * rstd * g * (sc + 1.f) + sh;
            u32x2 o = {pk2(h[0], h[1]), pk2(h[2], h[3])};
            *(u32x2*)(H + (size_t)t * 1024 + c0) = o;
        }
    }
}

DI void phase_ffn_norm_router(const Params& p, int layer, unsigned char* smem, int bid, int nb, int tid) {
    float* rstd_s = (float*)smem;
    float* lg = (float*)(smem + 512);
    float* hs = (float*)(smem + 512 + 32 * 37 * 4);
    float* wcs = (float*)(smem + 5248 + 2 * 32 * 65 * 4);
    const int lane = tid & 63, og = __builtin_amdgcn_readfirstlane(tid >> 6), tok = lane & 31, kh = lane >> 5;
    const float* mod = (const float*)(p.ws + WS_MOD) + (size_t)layer * 8 * 6144;
    const float* gam = p.norm_ffn + layer * 1024;
    const float* wg = p.moe_w_group + (size_t)layer * 1024 * 4;
    const float* we = p.moe_w_expert + (size_t)layer * 1024 * 32;
    bf16_t* H = (bf16_t*)(p.ws + WS_H);
    int* ecnt = (int*)(p.ws + WS_ECNT) + layer * 32 * ECS;
    int* elist = (int*)(p.ws + WS_ELIST);
    float* ew = (float*)(p.ws + WS_EW);
    for (int item = bid; item < T / 32; item += nb) {
        const int t0 = item * 32, b = t0 >> 11;
        __syncthreads();
        if (tid < 32) {
            const f32x4* pp = (const f32x4*)((const float*)(p.ws + WS_PART) + (size_t)(t0 + tid) * 16);
            const f32x4 a = pp[0], b4 = pp[1], c4 = pp[2], d4 = pp[3];
            const float ss = ((a[0] + a[1]) + (a[2] + a[3])) + ((b4[0] + b4[1]) + (b4[2] + b4[3])) + ((c4[0] + c4[1]) + (c4[2] + c4[3])) + ((d4[0] + d4[1]) + (d4[2] + d4[3]));
            rstd_s[tid] = rsqrtf(ss * (1.f / 1024.f) + EPS);
        }
        const int stok = tid >> 3, sk0 = (tid & 7) * 8;
        const float* xrow = p.out + (size_t)(t0 + stok) * 1024 + sk0;
        const float* mrow = mod + b * 6144 + sk0;
        f32x4 xa[2], ga[2], sha[2], sca[2], wa[3], xb[2], gb2[2], shb[2], scb[2], wb2[3];
#define FFN_LOAD(xv, gv, shv, scv, wv, k0) do { _Pragma("unroll") for (int q = 0; q < 2; ++q) { xv[q] = *(const f32x4*)(xrow + (k0) + 4 * q); gv[q] = *(const f32x4*)(gam + sk0 + (k0) + 4 * q); \
            shv[q] = *(const f32x4*)(mrow + 3072 + (k0) + 4 * q); scv[q] = *(const f32x4*)(mrow + 4096 + (k0) + 4 * q); } \
            wv[0] = *(const f32x4*)(we + (k0) * 32 + tid * 4); wv[1] = *(const f32x4*)(we + (k0) * 32 + 1024 + tid * 4); wv[2] = *(const f32x4*)(wg + (k0) * 4 + (tid & 63) * 4); } while (0)
#define FFN_STEP(xv, gv, shv, scv, wv, kc) do { const int k0 = (kc) * 64; float* hb = hs + ((kc) & 1) * (32 * 65); float* wb = wcs + ((kc) & 1) * (64 * 40); u32x4 ho; \
            _Pragma("unroll") for (int q = 0; q < 2; ++q) { const f32x4 h = xv[q] * srstd * gv[q] * (scv[q] + 1.f) + shv[q]; ho[2 * q] = pk2(h[0], h[1]); ho[2 * q + 1] = pk2(h[2], h[3]); \
                float* hp = hb + stok * 65 + sk0 + 4 * q; hp[0] = h[0]; hp[1] = h[1]; hp[2] = h[2]; hp[3] = h[3]; } \
            *(u32x4*)(H + (size_t)(t0 + stok) * 1024 + k0 + sk0) = ho; \
            *(f32x4*)(wb + (tid >> 3) * 40 + 4 + (tid & 7) * 4) = wv[0]; *(f32x4*)(wb + (32 + (tid >> 3)) * 40 + 4 + (tid & 7) * 4) = wv[1]; if (tid < 64) *(f32x4*)(wb + tid * 40) = wv[2]; \
            if ((kc) + 2 < 16) FFN_LOAD(xv, gv, shv, scv, wv, k0 + 128); \
            __syncthreads(); \
            if (og < 3) { const float* hr = hb + tok * 65 + kh * 32; const float* wr_ = wb + kh * 32 * 40 + og * 12; \
                _Pragma("unroll 8") for (int kk = 0; kk < 32; ++kk) { const float hv = hr[kk]; \
                    acc[0] += *(const f32x4*)(wr_ + kk * 40) * hv; acc[1] += *(const f32x4*)(wr_ + kk * 40 + 4) * hv; acc[2] += *(const f32x4*)(wr_ + kk * 40 + 8) * hv; } } } while (0)
        FFN_LOAD(xa, ga, sha, sca, wa, 0);
        FFN_LOAD(xb, gb2, shb, scb, wb2, 64);
        __syncthreads();
        const float srstd = rstd_s[stok];
        f32x4 acc[3];
#pragma unroll
        for (int o = 0; o < 3; ++o) acc[o] = (f32x4){0.f, 0.f, 0.f, 0.f};
        for (int kc = 0; kc < 16; kc += 2) {
            FFN_STEP(xa, ga, sha, sca, wa, kc);
            FFN_STEP(xb, gb2, shb, scb, wb2, kc + 1);
        }
#undef FFN_STEP
#undef FFN_LOAD
        if (og < 3) {
#pragma unroll
            for (int o = 0; o < 3; ++o)
#pragma unroll
                for (int e = 0; e < 4; ++e) { const float v = acc[o][e] + __shfl_xor(acc[o][e], 32); if (kh == 0) lg[tok * 37 + og * 12 + 4 * o + e] = v; }
        }
        __syncthreads();
        if (tid < 32) {
            const int t = t0 + tid;
            float gl[4]; float gmax = -INFINITY; int gsel = 0;
#pragma unroll
            for (int g = 0; g < 4; ++g) { gl[g] = lg[tid * 37 + g] + p.moe_b_group[layer * 4 + g]; if (gl[g] > gmax) { gmax = gl[g]; gsel = g; } }
            float gsum = 0.f;
#pragma unroll
            for (int g = 0; g < 4; ++g) gsum += __expf(gl[g] - gmax);
            const float pg = 1.f / gsum;
            float v1 = -INFINITY, v2 = -INFINITY; int i1 = 0, i2 = 0;
            for (int jx = 0; jx < 8; ++jx) {
                const float v = lg[tid * 37 + 4 + gsel * 8 + jx] + p.moe_b_expert[layer * 32 + gsel * 8 + jx];
                if (v > v1) { v2 = v1; i2 = i1; v1 = v; i1 = jx; } else if (v > v2) { v2 = v; i2 = jx; }
            }
            const float e2 = __expf(v2 - v1), den = 1.f / (1.f + e2);
            const float w1 = pg * den, w2 = pg * e2 * den;
            const int ea = gsel * 8 + i1, eb = gsel * 8 + i2;
            int* cl = (int*)rstd_s + 32;
            cl[tid] = 0;
            const int la = atomicAdd(&cl[ea], 1);
            const int lb = atomicAdd(&cl[eb], 1);
            { const int n = cl[tid]; cl[32 + tid] = n > 0 ? atomicAdd(&ecnt[tid * ECS], n) : 0; }
            const int ra = cl[32 + ea] + la, rb = cl[32 + eb] + lb;
            elist[(size_t)ea * NASG + ra] = t * 2; ew[t * 2] = w1;
            elist[(size_t)eb * NASG + rb] = t * 2 + 1; ew[t * 2 + 1] = w2;
        }
    }
}

DI bool dense_item(int i, int NT, int xcd, int& tm, int& tn) {
    if (i >= 16 * NT) return false;
    const int mg = i / (8 * NT), r = i % (8 * NT);
    tn = r >> 3; tm = xcd * 16 + mg * 8 + (r & 7);
    return true;
}
template <class PR> DI void phase_hyb_in(const Params& p, int j, unsigned char* smem, int xcd, int lb, int nlb, int tid) {
    int tm, tn;
    for (int i = lb; dense_item(i, 22, xcd, tm, tn); i += nlb) { HybIn pr{&p, j, tm, tn}; gemm_tile(pr, smem, opq(tid)); }
}
DI void phase_ml_in(const Params& p, int j, unsigned char* smem, int xcd, int lb, int nlb, int tid) {
    int tm, tn;
    for (int i = lb; dense_item(i, 25, xcd, tm, tn); i += nlb) { MlIn pr{&p, j, tm, tn}; gemm_tile(pr, smem, opq(tid)); }
}
DI void phase_out_proj(const Params& p, int layer, const float* W, const float* src, unsigned char* smem, int xcd, int lb, int nlb, int tid) {
    int tm, tn;
    for (int i = lb; dense_item(i, 8, xcd, tm, tn); i += nlb) { OutProj pr{&p, W, src, layer, tm, tn}; gemm_tile(pr, smem, opq(tid)); }
}
template <int WHICH> DI void phase_moe(const Params& p, int layer, unsigned char* smem, int xcd, int lb, int nlb, int tid) {
    int* toff = (int*)(smem + 65600);
    __syncthreads();
    if (tid == 0) {
        const int* ecnt = (const int*)(p.ws + WS_ECNT) + layer * 32 * ECS;
        int ta = 0, ra = 0;
        for (int e = 0; e < 32; ++e) {
            const int c = ecnt[e * ECS];
            if ((e & 7) == xcd) { const int q = e >> 3; toff[q] = ta; toff[8 + q] = ra; toff[16 + q] = c; ta += (c + 127) >> 7; }
            ra += c;
        }
        toff[4] = ta;
    }
    __syncthreads();
    const int total = toff[4] * 8;
    for (int item = lb; item < total; item += nlb) {
        const int mg = item >> 3, nt = item & 7;
        int q = 0;
        while (q < 3 && toff[q + 1] <= mg) ++q;
        const int e = q * 8 + xcd, cnt = toff[16 + q], roff = toff[8 + q];
        if (WHICH == 1) { Moe1 pr{&p, layer, e, mg - toff[q], nt, cnt, roff}; gemm_tile(pr, smem, opq(tid)); }
        else { Moe2 pr{&p, layer, e, mg - toff[q], nt, cnt, roff}; gemm_tile(pr, smem, opq(tid)); }
    }
}

DI void phase_combine_norm(const Params& p, int layer, int bid, int nb, int tid) {
    const int lane = tid & 63, wid = tid >> 6;
    const float* mod = (const float*)(p.ws + WS_MOD) + (size_t)layer * 8 * 6144;
    const float* modn = mod + 8 * 6144;
    const float* gam = p.norm_mix + (layer + 1) * 1024;
    const bf16_t* Y = (const bf16_t*)(p.ws + WS_Y);
    const float* ew = (const float*)(p.ws + WS_EW);
    bf16_t* H = (bf16_t*)(p.ws + WS_H);
    const bool has_next = layer + 1 < DEPTH;
    for (int item = bid; item < T / 4; item += nb) {
        const int t = item * 4 + wid, b = t >> 11;
        const float w0 = ew[2 * t], w1 = ew[2 * t + 1];
        f32x4 v[4]; float ss = 0.f;
#pragma unroll
        for (int i = 0; i < 4; ++i) {
            const int c0 = (lane + 64 * i) * 4;
            v[i] = *(const f32x4*)(p.out + (size_t)t * 1024 + c0);
            const f32x4 g = *(const f32x4*)(mod + b * 6144 + 5120 + c0);
            const u32x2 y0 = *(const u32x2*)(Y + (size_t)(2 * t) * 1024 + c0), y1 = *(const u32x2*)(Y + (size_t)(2 * t + 1) * 1024 + c0);
            v[i][0] += g[0] * (w0 * bflo(y0[0]) + w1 * bflo(y1[0])); v[i][1] += g[1] * (w0 * bfhi(y0[0]) + w1 * bfhi(y1[0]));
            v[i][2] += g[2] * (w0 * bflo(y0[1]) + w1 * bflo(y1[1])); v[i][3] += g[3] * (w0 * bfhi(y0[1]) + w1 * bfhi(y1[1]));
            *(f32x4*)(p.out + (size_t)t * 1024 + c0) = v[i];
            ss += v[i][0] * v[i][0] + v[i][1] * v[i][1] + v[i][2] * v[i][2] + v[i][3] * v[i][3];
        }
        if (has_next) {
            ss = wave_sum(ss);
            const float rstd = rsqrtf(ss * (1.f / 1024.f) + EPS);
#pragma unroll
            for (int i = 0; i < 4; ++i) {
                const int c0 = (lane + 64 * i) * 4;
                const f32x4 g = *(const f32x4*)(gam + c0), sh = *(const f32x4*)(modn + b * 6144 + c0), sc = *(const f32x4*)(modn + b * 6144 + 1024 + c0);
                const f32x4 h = v[i] * rstd * g * (sc + 1.f) + sh;
                u32x2 o = {pk2(h[0], h[1]), pk2(h[2], h[3])};
                *(u32x2*)(H + (size_t)t * 1024 + c0) = o;
            }
        }
    }
}

DI unsigned sortable(float f) { const unsigned u = __float_as_uint(f); return (u & 0x80000000u) ? ~u : (u | 0x80000000u); }
DI int half_sum_i(int v) { for (int m = 16; m >= 1; m >>= 1) v += __shfl_xor(v, m); return v; }

DI void phase_dsa(const Params& p, int j, unsigned char* smem, int bid, int nb, int tid, int cv0 = 0, int cv1 = 0) {
    if (cv1 > cv0 && bid >= (nb >> 1)) convert_moe_layers(p, cv0, cv1, smem, bid, nb, tid);
    const int lane = tid & 63, wid = tid >> 6, c = lane & 31, hh = lane >> 5;
    unsigned* mw = (unsigned*)smem + wid * 256;
    const bf16_t* IQ = (const bf16_t*)(p.ws + WS_IQ);
    const bf16_t* IK = (const bf16_t*)(p.ws + WS_IK);
    const float* IW = (const float*)(p.ws + WS_IW);
    const bf16_t* Q = (const bf16_t*)(p.ws + WS_Q);
    const bf16_t* K = (const bf16_t*)(p.ws + WS_K);
    const bf16_t* VT = (const bf16_t*)(p.ws + WS_V);
    bf16_t* Y = (bf16_t*)(p.ws + WS_YMIX);
    const float gq = wave_max(fabsf(p.hy_q_norm[j * 64 + lane])), gk = wave_max(fabsf(p.hy_k_norm[j * 64 + lane]));
    const float LOG2E = 1.4426950408889634f;
    const float c1 = 0.125f * LOG2E, c2 = 8.f * gq * gk * LOG2E;
    const unsigned lt = (1u << c) - 1u;
    for (int it = bid, rnd = 0; it < 1024; it += nb, ++rnd) {
        const int item = (rnd & 1) ? (rnd + 1) * nb - 1 - bid : it;
        if (item >= 1024) continue;
        const int qt = 127 - (item >> 3), b = item & 7;
        const int pos0 = qt * 16 + 4 * wid;
        const size_t tb = (size_t)b * S, t0 = tb + pos0;
        const int tmax = (pos0 + 3) >> 5;
        if (pos0 >= 256) {
            bf16x8 iqf[4];
            {
                const int i = (c & 3) + 4 * (c >> 3), rh = (c >> 2) & 1, qq = 2 * rh + (i >> 3), hd = i & 7;
                const bf16_t* ip = IQ + (t0 + qq) * 512 + hd * 64 + 8 * hh;
#pragma unroll
                for (int ks = 0; ks < 4; ++ks) iqf[ks] = *(const bf16x8*)(ip + 16 * ks);
            }
            float* wl = (float*)(smem + 4096) + wid * 32 + hh * 16;
            if (c < 4) *(f32x4*)(wl + 4 * c) = *(const f32x4*)(IW + (t0 + 2 * hh) * 8 + 4 * c);
            unsigned sk[64][2];
            const bf16_t* kpi = IK + (tb + c) * 64 + 8 * hh;
            const int lim0 = pos0 + 2 * hh - c;
#pragma unroll
            for (int tile = 0; tile < 64; ++tile) {
                unsigned k0 = 0u, k1 = 0u;
                if (tile <= tmax) {
                    bf16x8 bk[4];
#pragma unroll
                    for (int ks = 0; ks < 4; ++ks) bk[ks] = *(const bf16x8*)(kpi + 16 * ks);
                    kpi += 32 * 64;
                    asm volatile("" : "+v"(kpi));
                    f32x16 acc;
#pragma unroll
                    for (int r = 0; r < 16; ++r) acc[r] = 0.f;
#pragma unroll
                    for (int ks = 0; ks < 4; ++ks) acc = __builtin_amdgcn_mfma_f32_32x32x16_bf16(iqf[ks], bk[ks], acc, 0, 0, 0);
                    float s0 = 0.f, s1 = 0.f;
#pragma unroll
                    for (int q4 = 0; q4 < 2; ++q4) {
                        const f32x4 wa = *(const f32x4*)(wl + 4 * q4), wb = *(const f32x4*)(wl + 8 + 4 * q4);
#pragma unroll
                        for (int e = 0; e < 4; ++e) { s0 += fmaxf(acc[4 * q4 + e], 0.f) * wa[e]; s1 += fmaxf(acc[8 + 4 * q4 + e], 0.f) * wb[e]; }
                    }
                    k0 = tile * 32 <= lim0 ? sortable(s0) : 0u;
                    k1 = tile * 32 <= lim0 + 1 ? sortable(s1) : 0u;
                }
                sk[tile][0] = k0; sk[tile][1] = k1;
            }
            unsigned v0 = 0u, v1 = 0u; bool d0 = false, d1 = false;
            const int tg = tmax >> 3;
            for (int bit = 31; bit >= 0; --bit) {
                const unsigned c0 = v0 | (1u << bit), c1b = v1 | (1u << bit);
                int n0 = 0, n1 = 0;
#pragma unroll
                for (int g = 0; g < 8; ++g) {
                    if (g <= tg) {
#pragma unroll
                        for (int u = 0; u < 8; ++u) { n0 += sk[g * 8 + u][0] >= c0 ? 1 : 0; n1 += sk[g * 8 + u][1] >= c1b ? 1 : 0; }
                    }
                }
                const int n01 = half_sum_i(n0 | (n1 << 16));
                n0 = n01 & 0xffff; n1 = n01 >> 16;
                if (!d0 && n0 >= 256) { v0 = c0; d0 = n0 == 256; }
                if (!d1 && n1 >= 256) { v1 = c1b; d1 = n1 == 256; }
                if (__all(d0 && d1)) break;
            }
            int g0 = 0, g1 = 0;
#pragma unroll
            for (int g = 0; g < 8; ++g) {
                if (g <= tg) {
#pragma unroll
                    for (int u = 0; u < 8; ++u) { g0 += sk[g * 8 + u][0] > v0 ? 1 : 0; g1 += sk[g * 8 + u][1] > v1 ? 1 : 0; }
                }
            }
            const int g01 = half_sum_i(g0 | (g1 << 16));
            const int need0 = 256 - (g01 & 0xffff), need1 = 256 - (g01 >> 16);
            int run0 = 0, run1 = 0;
#pragma unroll
            for (int tile = 0; tile < 64; ++tile) {
                if (tile <= tmax) {
                    const unsigned k0 = sk[tile][0], k1 = sk[tile][1];
                    const bool tie0 = k0 == v0, tie1 = k1 == v1;
                    const unsigned long long tb0 = __ballot(tie0), tb1 = __ballot(tie1);
                    const unsigned th0 = hh ? (unsigned)(tb0 >> 32) : (unsigned)tb0, th1 = hh ? (unsigned)(tb1 >> 32) : (unsigned)tb1;
                    const bool sel0 = k0 > v0 || (tie0 && run0 + __popc(th0 & lt) < need0);
                    const bool sel1 = k1 > v1 || (tie1 && run1 + __popc(th1 & lt) < need1);
                    run0 += __popc(th0); run1 += __popc(th1);
                    const unsigned long long sb0 = __ballot(sel0), sb1 = __ballot(sel1);
                    if (lane == 0) { u32x4 o = {(unsigned)sb0, (unsigned)sb1, (unsigned)(sb0 >> 32), (unsigned)(sb1 >> 32)}; *(u32x4*)(mw + tile * 4) = o; }
                }
            }
        } else {
            const int tile = lane >> 2, qq = lane & 3, pq = pos0 + qq;
            if (tile <= tmax) {
                unsigned m;
                if (32 * tile + 31 <= pq) m = 0xffffffffu; else if (32 * tile > pq) m = 0u; else m = (2u << (pq - 32 * tile)) - 1u;
                mw[tile * 4 + qq] = m;
            }
        }
        bf16x8 qf[4];
        {
            const bf16_t* qp = Q + (t0 + (c >> 3)) * 512 + (c & 7) * 64 + 8 * hh;
#pragma unroll
            for (int ks = 0; ks < 4; ++ks) qf[ks] = *(const bf16x8*)(qp + 16 * ks);
        }
        f32x16 o0, o1;
#pragma unroll
        for (int r = 0; r < 16; ++r) { o0[r] = 0.f; o1[r] = 0.f; }
        float lsum = 0.f;
        const int kperm = (c & ~12) | ((c & 4) << 1) | ((c & 8) >> 1);
        const bf16_t* kp = K + (tb + kperm) * 64 + 8 * hh;
        const bf16_t* vp = VT + ((size_t)(b * 64 + c)) * S + 8 * hh;
        bf16x8 kf[4], vf[4];
#pragma unroll
        for (int ks = 0; ks < 4; ++ks) kf[ks] = *(const bf16x8*)(kp + 16 * ks);
        vf[0] = *(const bf16x8*)(vp); vf[1] = *(const bf16x8*)(vp + (size_t)32 * S); vf[2] = *(const bf16x8*)(vp + 16); vf[3] = *(const bf16x8*)(vp + (size_t)32 * S + 16);
        for (int tile = 0; tile <= tmax; ++tile) {
            const unsigned mword = mw[tile * 4 + (c >> 3)];
            bf16x8 kc[4], vc[4];
#pragma unroll
            for (int ks = 0; ks < 4; ++ks) { kc[ks] = kf[ks]; vc[ks] = vf[ks]; }
            if (tile < tmax) {
                kp += 32 * 64; vp += 32;
#pragma unroll
                for (int ks = 0; ks < 4; ++ks) kf[ks] = *(const bf16x8*)(kp + 16 * ks);
                vf[0] = *(const bf16x8*)(vp); vf[1] = *(const bf16x8*)(vp + (size_t)32 * S); vf[2] = *(const bf16x8*)(vp + 16); vf[3] = *(const bf16x8*)(vp + (size_t)32 * S + 16);
            }
            f32x16 x;
#pragma unroll
            for (int r = 0; r < 16; ++r) x[r] = 0.f;
#pragma unroll
            for (int ks = 0; ks < 4; ++ks) x = __builtin_amdgcn_mfma_f32_32x32x16_bf16(kc[ks], qf[ks], x, 0, 0, 0);
#pragma unroll
            for (int s = 0; s < 2; ++s) {
                const unsigned bits = mword >> (16 * s + 8 * hh);
                float pr[8];
#pragma unroll
                for (int jx = 0; jx < 8; ++jx) {
                    const float e = __builtin_amdgcn_exp2f(x[8 * s + jx] * c1 - c2);
                    pr[jx] = __uint_as_float(__float_as_uint(e) & (unsigned)__builtin_amdgcn_sbfe((int)bits, jx, 1));
                    lsum += pr[jx];
                }
                u32x4 pk = {pk2(pr[0], pr[1]), pk2(pr[2], pr[3]), pk2(pr[4], pr[5]), pk2(pr[6], pr[7])};
                const bf16x8 pf = __builtin_bit_cast(bf16x8, pk);
                o0 = __builtin_amdgcn_mfma_f32_32x32x16_bf16(vc[2 * s], pf, o0, 0, 0, 0);
                o1 = __builtin_amdgcn_mfma_f32_32x32x16_bf16(vc[2 * s + 1], pf, o1, 0, 0, 0);
            }
        }
        lsum += __shfl_xor(lsum, 32);
        const float inv = 1.f / lsum;
        bf16_t* yp = Y + (t0 + (c >> 3)) * 1024 + (c & 7) * 64 + 4 * hh;
#pragma unroll
        for (int g4 = 0; g4 < 4; ++g4) {
            u32x2 a = {pk2(o0[4 * g4] * inv, o0[4 * g4 + 1] * inv), pk2(o0[4 * g4 + 2] * inv, o0[4 * g4 + 3] * inv)};
            u32x2 bq = {pk2(o1[4 * g4] * inv, o1[4 * g4 + 1] * inv), pk2(o1[4 * g4 + 2] * inv, o1[4 * g4 + 3] * inv)};
            *(u32x2*)(yp + 8 * g4) = a;
            *(u32x2*)(yp + 32 + 8 * g4) = bq;
        }
    }
    if (cv1 > cv0 && bid < (nb >> 1)) convert_moe_layers(p, cv0, cv1, smem, bid, nb, tid);
}

DI void phase_conv(const Params& p, int j, int bid, int nb, int tid) {
    const bf16_t* Z = (const bf16_t*)(p.ws + WS_Z);
    const bf16_t* BG = (const bf16_t*)(p.ws + WS_BG);
    bf16_t* Y = (bf16_t*)(p.ws + WS_YMIX);
    const float* cw = p.hy_conv_w + (size_t)j * 3 * 512;
    for (int item = bid; item < T / 4; item += nb) {
        const int t = item * 4 + (tid >> 6), c0 = (tid & 63) * 8, pos = t & (S - 1);
        float acc[8];
#pragma unroll
        for (int e = 0; e < 8; ++e) acc[e] = 0.f;
#pragma unroll
        for (int jj = 0; jj < 3; ++jj) {
            const int dp = jj - 2;
            if (pos + dp >= 0) {
                const u32x4 z = *(const u32x4*)(Z + (size_t)(t + dp) * 512 + c0);
#pragma unroll
                for (int e = 0; e < 4; ++e) { acc[2 * e] += cw[jj * 512 + c0 + 2 * e] * bflo(z[e]); acc[2 * e + 1] += cw[jj * 512 + c0 + 2 * e + 1] * bfhi(z[e]); }
            }
        }
        const u32x4 g = *(const u32x4*)(BG + (size_t)t * 512 + c0);
        u32x4 o;
#pragma unroll
        for (int e = 0; e < 4; ++e) o[e] = pk2(acc[2 * e] * bflo(g[e]), acc[2 * e + 1] * bfhi(g[e]));
        *(u32x4*)(Y + (size_t)t * 1024 + 512 + c0) = o;
    }
}

DI float wave_incl_sum(float x, int lane) { for (int d = 1; d < 64; d <<= 1) { const float t = __shfl_up(x, d); if (lane >= d) x += t; } return x; }
DI float wave_incl_max(float x, int lane) { for (int d = 1; d < 64; d <<= 1) { const float t = __shfl_up(x, d); if (lane >= d) x = fmaxf(x, t); } return x; }
DI bf16x8 scale_frag(bf16x8 f, const float* w8) {
    const u32x4 u = __builtin_bit_cast(u32x4, f);
    u32x4 o;
#pragma unroll
    for (int e = 0; e < 4; ++e) o[e] = pk2(bflo(u[e]) * w8[2 * e], bfhi(u[e]) * w8[2 * e + 1]);
    return __builtin_bit_cast(bf16x8, o);
}

DI void phase_ml1(const Params& p, unsigned char* smem, int bid, int nb, int tid) {
    const int lane = tid & 63, wid = tid >> 6, c = lane & 31, hh = lane >> 5;
    float* wsl = (float*)smem + wid * 64;
    const bf16_t* KT = (const bf16_t*)(p.ws + WS_MKT);
    const bf16_t* VT = (const bf16_t*)(p.ws + WS_MV);
    const float* MIG = (const float*)(p.ws + WS_MIG);
    const float* MFG = (const float*)(p.ws + WS_MFG);
    float* UB = (float*)(p.ws + WS_UBUF);
    float* UN = (float*)(p.ws + WS_UNBUF);
    float* ML = (float*)(p.ws + WS_MLOC);
    for (int item = bid; item < 2048; item += nb) {
        const int bh = item >> 5, ch = item & 31, b = bh >> 3, h = bh & 7;
        const size_t tb = (size_t)b * S + ch * 64;
        const float lf = MFG[(tb + lane) * 8 + h], ig = MIG[(tb + lane) * 8 + h];
        const float bc = wave_incl_sum(lf, lane);
        const float blast = __shfl(bc, 63);
        const float g = blast - bc + ig;
        const float gmax = wave_max(g);
        wsl[lane] = __expf(g - gmax);
        if (wid == 0 && lane == 0) { ML[item * 2] = blast; ML[item * 2 + 1] = gmax; }
        f32x16 u0, u1;
#pragma unroll
        for (int r = 0; r < 16; ++r) { u0[r] = 0.f; u1[r] = 0.f; }
        const bf16_t* vp = VT + ((size_t)(bh * 128 + wid * 32 + c)) * S + ch * 64 + 8 * hh;
        const bf16_t* kp = KT + ((size_t)(bh * 64 + c)) * S + ch * 64 + 8 * hh;
#pragma unroll
        for (int ks = 0; ks < 4; ++ks) {
            float w8[8];
            const f32x4 wa = *(const f32x4*)(wsl + 16 * ks + 8 * hh), wb = *(const f32x4*)(wsl + 16 * ks + 8 * hh + 4);
            w8[0] = wa[0]; w8[1] = wa[1]; w8[2] = wa[2]; w8[3] = wa[3]; w8[4] = wb[0]; w8[5] = wb[1]; w8[6] = wb[2]; w8[7] = wb[3];
            const bf16x8 va = *(const bf16x8*)(vp + 16 * ks);
            const bf16x8 k0 = scale_frag(*(const bf16x8*)(kp + 16 * ks), w8);
            const bf16x8 k1 = scale_frag(*(const bf16x8*)(kp + (size_t)32 * S + 16 * ks), w8);
            u0 = __builtin_amdgcn_mfma_f32_32x32x16_bf16(va, k0, u0, 0, 0, 0);
            u1 = __builtin_amdgcn_mfma_f32_32x32x16_bf16(va, k1, u1, 0, 0, 0);
        }
        float* up = UB + ((size_t)item * 128 + wid * 32) * 64 + c;
#pragma unroll
        for (int r = 0; r < 16; ++r) { const int v = crow(r, lane); up[v * 64] = u0[r]; up[v * 64 + 32] = u1[r]; }
        if (wid == 0) {
            const u32x4* kr = (const u32x4*)(KT + ((size_t)(bh * 64 + lane)) * S + ch * 64);
            float a = 0.f;
#pragma unroll
            for (int q = 0; q < 8; ++q) { const u32x4 u = kr[q];
#pragma unroll
                for (int e = 0; e < 4; ++e) a += wsl[q * 8 + 2 * e] * bflo(u[e]) + wsl[q * 8 + 2 * e + 1] * bfhi(u[e]); }
            UN[(size_t)item * 64 + lane] = a;
        }
    }
}

DI void phase_ml2(const Params& p, unsigned char* smem, int bid, int nb, int tid) {
    float* dec = (float*)smem;
    float* scl = dec + 32;
    const float* UB = (const float*)(p.ws + WS_UBUF);
    const float* UN = (const float*)(p.ws + WS_UNBUF);
    const float* ML = (const float*)(p.ws + WS_MLOC);
    bf16_t* CB = (bf16_t*)(p.ws + WS_CBUF);
    float* NBF = (float*)(p.ws + WS_NBUF);
    float* MST = (float*)(p.ws + WS_MST);
    for (int item = bid; item < 512; item += nb) {
        const int bh = item >> 3, sl = item & 7;
        __syncthreads();
        if (tid == 0) {
            float m = 0.f;
            for (int ch = 0; ch < 32; ++ch) {
                const float bl = ML[(bh * 32 + ch) * 2], gm = ML[(bh * 32 + ch) * 2 + 1];
                const float mn = fmaxf(bl + m, gm);
                dec[ch] = __expf(bl + m - mn); scl[ch] = __expf(gm - mn);
                if (sl == 0) MST[bh * 32 + ch] = m;
                m = mn;
            }
        }
        __syncthreads();
        f32x4 st = {0.f, 0.f, 0.f, 0.f};
        const size_t e0 = (size_t)sl * 1024 + tid * 4;
        f32x4 ub[32];
#pragma unroll
        for (int ch = 0; ch < 32; ++ch) ub[ch] = *(const f32x4*)(UB + ((size_t)(bh * 32 + ch)) * 8192 + e0);
#pragma unroll
        for (int ch = 0; ch < 32; ++ch) {
            st = st * dec[ch] + ub[ch] * scl[ch];
            u32x2 o = {pk2(st[0], st[1]), pk2(st[2], st[3])};
            *(u32x2*)(CB + ((size_t)(bh * 32 + ch)) * 8192 + e0) = o;
        }
        if (sl == 0 && tid < 64) {
            float nst = 0.f, un[32];
#pragma unroll
            for (int ch = 0; ch < 32; ++ch) un[ch] = UN[(size_t)(bh * 32 + ch) * 64 + tid];
#pragma unroll
            for (int ch = 0; ch < 32; ++ch) { nst = nst * dec[ch] + un[ch] * scl[ch]; NBF[(size_t)(bh * 32 + ch) * 64 + tid] = nst; }
        }
    }
}

DI void phase_ml3(const Params& p, int j, unsigned char* smem, int bid, int nb, int tid) {
    const int lane = tid & 63, wid = tid >> 6, c = lane & 31, hh = lane >> 5;
    float* al = (float*)smem + wid * 64;
    float* ssum = (float*)smem + 256;
    const bf16_t* MQ = (const bf16_t*)(p.ws + WS_MQ);
    const bf16_t* MK = (const bf16_t*)(p.ws + WS_MK);
    const bf16_t* VT = (const bf16_t*)(p.ws + WS_MV);
    const float* MIG = (const float*)(p.ws + WS_MIG);
    const float* MFG = (const float*)(p.ws + WS_MFG);
    const bf16_t* MOG = (const bf16_t*)(p.ws + WS_MOG);
    const bf16_t* CB = (const bf16_t*)(p.ws + WS_CBUF);
    const float* NBF = (const float*)(p.ws + WS_NBUF);
    const float* MST = (const float*)(p.ws + WS_MST);
    bf16_t* Y = (bf16_t*)(p.ws + WS_YMIX);
    const int kperm = (c & ~12) | ((c & 4) << 1) | ((c & 8) >> 1);
    for (int item = bid; item < 2048; item += nb) {
        const int bh = item >> 5, ch = item & 31, b = bh >> 3, h = bh & 7;
        const size_t tb = (size_t)b * S + ch * 64;
        const float lf = MFG[(tb + lane) * 8 + h], ig = MIG[(tb + lane) * 8 + h];
        const float bc = wave_incl_sum(lf, lane);
        const float av = ig - bc;
        const float mprev = MST[item];
        const float Mv = fmaxf(mprev, wave_incl_max(av, lane));
        __syncthreads();
        al[lane] = av;
        float Mt[2], wint[2], emt[2];
#pragma unroll
        for (int tt = 0; tt < 2; ++tt) { Mt[tt] = __shfl(Mv, 32 * tt + c); wint[tt] = __expf(mprev - Mt[tt]); emt[tt] = __expf(-(__shfl(bc, 32 * tt + c) + Mt[tt])); }
        bf16x8 qf[2][4], kf[2][4];
#pragma unroll
        for (int tt = 0; tt < 2; ++tt) {
            const bf16_t* qp = MQ + (tb + 32 * tt + c) * 512 + h * 64 + 8 * hh;
            const bf16_t* kp = MK + (tb + 32 * tt + kperm) * 512 + h * 64 + 8 * hh;
#pragma unroll
            for (int ks = 0; ks < 4; ++ks) { qf[tt][ks] = *(const bf16x8*)(qp + 16 * ks); kf[tt][ks] = *(const bf16x8*)(kp + 16 * ks); }
        }
        f32x16 o[2];
#pragma unroll
        for (int tt = 0; tt < 2; ++tt)
#pragma unroll
            for (int r = 0; r < 16; ++r) o[tt][r] = 0.f;
        float nq[2] = {0.f, 0.f};
        if (ch > 0) {
            const bf16_t* cp = CB + ((size_t)(item - 1) * 128 + wid * 32 + c) * 64 + 8 * hh;
            const float* np = NBF + (size_t)(item - 1) * 64 + 8 * hh;
#pragma unroll
            for (int ks = 0; ks < 4; ++ks) {
                const bf16x8 cf = *(const bf16x8*)(cp + 16 * ks);
                o[0] = __builtin_amdgcn_mfma_f32_32x32x16_bf16(cf, qf[0][ks], o[0], 0, 0, 0);
                o[1] = __builtin_amdgcn_mfma_f32_32x32x16_bf16(cf, qf[1][ks], o[1], 0, 0, 0);
                const f32x4 n0 = *(const f32x4*)(np + 16 * ks), n1 = *(const f32x4*)(np + 16 * ks + 4);
#pragma unroll
                for (int tt = 0; tt < 2; ++tt) {
                    const u32x4 u = __builtin_bit_cast(u32x4, qf[tt][ks]);
                    nq[tt] += n0[0] * bflo(u[0]) + n0[1] * bfhi(u[0]) + n0[2] * bflo(u[1]) + n0[3] * bfhi(u[1]) + n1[0] * bflo(u[2]) + n1[1] * bfhi(u[2]) + n1[2] * bflo(u[3]) + n1[3] * bfhi(u[3]);
                }
            }
#pragma unroll
            for (int tt = 0; tt < 2; ++tt) {
                nq[tt] += __shfl_xor(nq[tt], 32);
#pragma unroll
                for (int r = 0; r < 16; ++r) o[tt][r] *= wint[tt];
            }
        }
        float csum[2] = {0.f, 0.f};
        const bf16_t* vp = VT + ((size_t)(bh * 128 + wid * 32 + c)) * S + ch * 64 + 8 * hh;
#pragma unroll
        for (int tt = 0; tt < 2; ++tt) {
#pragma unroll
            for (int st = 0; st <= tt; ++st) {
                f32x16 x;
#pragma unroll
                for (int r = 0; r < 16; ++r) x[r] = 0.f;
#pragma unroll
                for (int ks = 0; ks < 4; ++ks) x = __builtin_amdgcn_mfma_f32_32x32x16_bf16(kf[st][ks], qf[tt][ks], x, 0, 0, 0);
#pragma unroll
                for (int k2 = 0; k2 < 2; ++k2) {
                    const int s0 = 32 * st + 16 * k2 + 8 * hh;
                    const f32x4 a0 = *(const f32x4*)(al + s0), a1 = *(const f32x4*)(al + s0 + 4);
                    const float a8[8] = {a0[0], a0[1], a0[2], a0[3], a1[0], a1[1], a1[2], a1[3]};
                    float pr[8];
#pragma unroll
                    for (int jx = 0; jx < 8; ++jx) {
                        const float e = __expf(a8[jx] - Mt[tt]) * x[8 * k2 + jx];
                        pr[jx] = (st < tt || s0 + jx <= 32 * tt + c) ? e : 0.f;
                        csum[tt] += pr[jx];
                    }
                    u32x4 pk = {pk2(pr[0], pr[1]), pk2(pr[2], pr[3]), pk2(pr[4], pr[5]), pk2(pr[6], pr[7])};
                    const bf16x8 vf = *(const bf16x8*)(vp + 32 * st + 16 * k2);
                    o[tt] = __builtin_amdgcn_mfma_f32_32x32x16_bf16(vf, __builtin_bit_cast(bf16x8, pk), o[tt], 0, 0, 0);
                }
            }
        }
        float ss[2];
#pragma unroll
        for (int tt = 0; tt < 2; ++tt) {
            csum[tt] += __shfl_xor(csum[tt], 32);
            const float den = wint[tt] * nq[tt] + csum[tt];
            const float rd = 1.f / fmaxf(fabsf(den), emt[tt]);
            float s2 = 0.f;
#pragma unroll
            for (int r = 0; r < 16; ++r) { o[tt][r] *= rd; s2 += o[tt][r] * o[tt][r]; }
            s2 += __shfl_xor(s2, 32);
            ss[tt] = s2;
            if (hh == 0) ssum[wid * 64 + 32 * tt + c] = s2;
        }
        __syncthreads();
#pragma unroll
        for (int tt = 0; tt < 2; ++tt) {
            const int tcol = 32 * tt + c;
            const float tot = ssum[tcol] + ssum[64 + tcol] + ssum[128 + tcol] + ssum[192 + tcol];
            const float rstd = rsqrtf(tot * (1.f / 128.f) + EPS);
            const size_t ro = (tb + tcol) * 1024 + h * 128 + wid * 32 + 4 * hh;
            const float* gp = p.ml_out_norm + j * 1024 + h * 128 + wid * 32 + 4 * hh;
#pragma unroll
            for (int g4 = 0; g4 < 4; ++g4) {
                const f32x4 gm = *(const f32x4*)(gp + 8 * g4);
                const u32x2 og = *(const u32x2*)(MOG + ro + 8 * g4);
                u32x2 ov = {pk2(o[tt][4 * g4] * rstd * gm[0] * bflo(og[0]), o[tt][4 * g4 + 1] * rstd * gm[1] * bfhi(og[0])),
                            pk2(o[tt][4 * g4 + 2] * rstd * gm[2] * bflo(og[1]), o[tt][4 * g4 + 3] * rstd * gm[3] * bfhi(og[1]))};
                *(u32x2*)(Y + ro + 8 * g4) = ov;
            }
        }
    }
}


namespace pg8 {
#define PG8_LAS __attribute__((address_space(3)))
typedef unsigned short bf16_t;
typedef short bf16x8 __attribute__((ext_vector_type(8)));
typedef float f32x4 __attribute__((ext_vector_type(4)));
typedef unsigned u32x4 __attribute__((ext_vector_type(4)));
constexpr int BM = 256, BK = 64, HALF = 128, HTB = HALF * BK * 2  , STAGE_BYTES = 8 * HTB, NXCD = 8, WGM = 8;

__host__ __device__ __forceinline__ int lds_byte(int r, int c) { const int st = (r >> 4) * 2 + (c >> 5), rr = r & 15, cc = c & 31, ob = rr * 64 + cc * 2; return st * 1024 + (ob ^ (((ob >> 9) & 1) << 5)); }
__host__ __device__ __forceinline__ void stage_rc(int b, int& R, int& C) { const int st = b / 1024, sb = b % 1024, swz = sb ^ (((sb >> 9) & 1) << 5); R = (st >> 1) * 16 + swz / 64; C = (st & 1) * 32 + (swz % 64) / 2; }
__host__ __device__ __forceinline__ int perm32(int rho) { const int n = rho >> 4, i = rho & 15; return 8 * (i >> 2) + 4 * n + (i & 3); }

struct Unit { int pm, pn; };
struct Gemm { const bf16_t* A; const bf16_t* Bt; int M, N, K; };

struct StaticOrder {
    int nM, nN, nwg, G, c;
    __host__ __device__ void init(int M, int N, int G_, int c_) { nM = M / BM; nN = N / BM; nwg = nM * nN; G = G_; c = c_; }
    __host__ __device__ bool next(int i, Unit& u) const {
        const long L = (long)i * G + c; if (L >= nwg) return false;
        int wgid = (int)L; { const int q = nwg / NXCD, r = nwg % NXCD, xcd = wgid % NXCD, off = wgid / NXCD; wgid = (xcd < r ? xcd * (q + 1) : r * (q + 1) + (xcd - r) * q) + off; }
        const int nig = WGM * nN, gid = wgid / nig, fm = gid * WGM, gsz = (nM - fm) < WGM ? (nM - fm) : WGM;
        u.pm = fm + ((wgid % nig) % gsz); u.pn = (wgid % nig) / gsz; return true;
    }
    __device__ __forceinline__ void a_ready(const Unit&) const {}
    __device__ __forceinline__ void done(const Unit&) const {}
};


template <class Epi, class Sched, bool ALIGN_EPI = false, bool SP2 = false>
__device__ __forceinline__ void gemm_phase(PG8_LAS unsigned char* lds, const Gemm g, const Sched& S, const Epi& E, int tid512) {
    const int tid = opq(tid512), wid = __builtin_amdgcn_readfirstlane(tid >> 6), lane = tid & 63, wr = wid >> 2, wc = wid & 3, fr = lane & 15, fq = lane >> 4;
    const int K = g.K, nt = K / BK;
    unsigned voffA[2], voffB[2];
#pragma unroll
    for (int i = 0; i < 2; ++i) { int R, C; stage_rc(tid * 16 + i * 8192, R, C); const int Rb = Epi::PERM ? ((R & ~31) + perm32(R & 31)) : R;
        voffA[i] = (unsigned)(R * K + C) * 2u; voffB[i] = (unsigned)(Rb * K + C) * 2u; }
    const size_t kstep = (size_t)(BK * 2);
    const size_t hstep = (size_t)HALF * K * 2;
    const size_t tstep = 2 * hstep;
    const unsigned ldsw = (unsigned)wid * 1024u;
    const int aoff = lds_byte(wr * 64 + fr, fq * 8), boff = lds_byte(wc * 32 + fr, fq * 8);
#define PG8_SA(b, h) (((b) * 2 + (h)) * HTB)
#define PG8_SB(b, h) ((4 + (b) * 2 + (h)) * HTB)
#define PG8_STAGE(bufoff, gbase, voff) do { _Pragma("unroll") for (int _i = 0; _i < 2; ++_i) \
        __builtin_amdgcn_global_load_lds((const unsigned*)((const char*)(gbase) + (voff)[_i]), (PG8_LAS unsigned*)(lds + (bufoff) + ldsw + _i * 8192), 16, 0, 0); } while (0)
#define PG8_LDA(dst, b, h) do { _Pragma("unroll") for (int m = 0; m < 4; ++m) _Pragma("unroll") for (int k = 0; k < 2; ++k) dst[m][k] = *(const PG8_LAS bf16x8*)(lds + PG8_SA(b, h) + aoff + m * 2048 + k * 1024); } while (0)
#define PG8_LDB(dst, b, h) do { _Pragma("unroll") for (int n = 0; n < 2; ++n) _Pragma("unroll") for (int k = 0; k < 2; ++k) dst[n][k] = *(const PG8_LAS bf16x8*)(lds + PG8_SB(b, h) + boff + n * 2048 + k * 1024); } while (0)
#define PG8_MMA(ai, bj, At, Bt) do { __builtin_amdgcn_s_setprio(1); _Pragma("unroll") for (int m = 0; m < 4; ++m) _Pragma("unroll") for (int n = 0; n < 2; ++n) _Pragma("unroll") for (int k = 0; k < 2; ++k) \
        acc[ai][bj][m][n] = __builtin_amdgcn_mfma_f32_16x16x32_bf16(Bt[n][k], At[m][k], acc[ai][bj][m][n], 0, 0, 0); __builtin_amdgcn_s_setprio(0); } while (0)
#define PG8_WAIT_V(n) asm volatile("s_waitcnt vmcnt(" #n ")" ::: "memory")
#define PG8_WAIT_L(n) asm volatile("s_waitcnt lgkmcnt(" #n ")" ::: "memory")
#define PG8_BAR __builtin_amdgcn_s_barrier()
#define PG8_SCHED __builtin_amdgcn_sched_barrier(0)
    Unit cur, nxt; int ui = 0;
    if (!S.next(0, cur)) return;
    f32x4 acc[2][2][4][2];
#pragma unroll
    for (int a = 0; a < 2; ++a)
#pragma unroll
        for (int b = 0; b < 2; ++b)
#pragma unroll
            for (int m = 0; m < 4; ++m)
#pragma unroll
                for (int n = 0; n < 2; ++n) acc[a][b][m][n] = (f32x4){0.f, 0.f, 0.f, 0.f};
    bf16x8 At[4][2], B0[2][2], B1[2][2];
    const char* cA = (const char*)g.A + (size_t)cur.pm * tstep; const char* cB = (const char*)g.Bt + (size_t)cur.pn * tstep;
    S.a_ready(cur);
    if constexpr (SP2) {
        PG8_STAGE(PG8_SB(0, 0), cB, voffB); PG8_STAGE(PG8_SB(0, 1), cB + hstep, voffB); PG8_STAGE(PG8_SA(0, 0), cA, voffA); PG8_STAGE(PG8_SA(0, 1), cA + hstep, voffA);
        if (wr == 1) PG8_BAR;
        PG8_WAIT_V(2); PG8_BAR;
        PG8_STAGE(PG8_SB(1, 0), cB + kstep, voffB); PG8_STAGE(PG8_SA(1, 0), cA + kstep, voffA); PG8_STAGE(PG8_SB(1, 1), cB + hstep + kstep, voffB);
        PG8_WAIT_V(6); PG8_BAR;
    } else {
        PG8_STAGE(PG8_SB(0, 0), cB, voffB); PG8_STAGE(PG8_SA(0, 0), cA, voffA); PG8_STAGE(PG8_SB(0, 1), cB + hstep, voffB); PG8_STAGE(PG8_SA(0, 1), cA + hstep, voffA);
        if (wr == 1) PG8_BAR;
        PG8_WAIT_V(4); PG8_BAR;
        PG8_STAGE(PG8_SB(1, 0), cB + kstep, voffB); PG8_STAGE(PG8_SA(1, 0), cA + kstep, voffA); PG8_STAGE(PG8_SB(1, 1), cB + hstep + kstep, voffB);
        PG8_WAIT_V(6); PG8_BAR;
    }
    for (;;) {
        const bool has_next = S.next(ui + 1, nxt);
        const char* nA = has_next ? (const char*)g.A + (size_t)nxt.pm * tstep : cA; const char* nB = has_next ? (const char*)g.Bt + (size_t)nxt.pn * tstep : cB;
        for (int t = 0; t < nt; t += 2) {
            const bool last = (t == nt - 2);
            const char* a1 = cA + (size_t)(t + 1) * kstep;
            const char* a2 = last ? nA : cA + (size_t)(t + 2) * kstep; const char* b2 = last ? nB : cB + (size_t)(t + 2) * kstep;
            const char* a3 = a2 + kstep; const char* b3 = b2 + kstep;
            if (last && has_next) S.a_ready(nxt);
            if constexpr (SP2) {
            PG8_LDB(B0, 0, 0); PG8_LDB(B1, 0, 1); PG8_SCHED; PG8_LDA(At, 0, 0); PG8_STAGE(PG8_SA(1, 1), a1 + hstep, voffA);
            PG8_WAIT_V(8); PG8_WAIT_L(0); PG8_BAR; PG8_MMA(0, 0, At, B0); PG8_MMA(0, 1, At, B1); PG8_BAR; PG8_SCHED;
            PG8_LDA(At, 0, 1); PG8_STAGE(PG8_SB(0, 0), b2, voffB); PG8_STAGE(PG8_SB(0, 1), b2 + hstep, voffB); PG8_STAGE(PG8_SA(0, 0), a2, voffA);
            PG8_WAIT_V(8); PG8_WAIT_L(0); PG8_BAR; PG8_MMA(1, 0, At, B0); PG8_MMA(1, 1, At, B1); PG8_BAR; PG8_SCHED;
            PG8_LDB(B0, 1, 0); PG8_LDB(B1, 1, 1); PG8_SCHED; PG8_LDA(At, 1, 0); PG8_STAGE(PG8_SA(0, 1), a2 + hstep, voffA);
            PG8_WAIT_V(8); PG8_WAIT_L(0); PG8_BAR; PG8_MMA(0, 0, At, B0); PG8_MMA(0, 1, At, B1); PG8_BAR; PG8_SCHED;
            PG8_LDA(At, 1, 1); PG8_STAGE(PG8_SB(1, 0), b3, voffB); PG8_STAGE(PG8_SB(1, 1), b3 + hstep, voffB); PG8_STAGE(PG8_SA(1, 0), a3, voffA);
            PG8_WAIT_V(8); PG8_WAIT_L(0); PG8_BAR; PG8_MMA(1, 0, At, B0); PG8_MMA(1, 1, At, B1); PG8_BAR; PG8_SCHED;
            } else {
            PG8_LDB(B0, 0, 0); PG8_SCHED; PG8_LDA(At, 0, 0); PG8_STAGE(PG8_SA(1, 1), a1 + hstep, voffA);
            PG8_WAIT_L(8); PG8_BAR; PG8_WAIT_L(0); PG8_MMA(0, 0, At, B0); PG8_BAR; PG8_SCHED;
            PG8_LDB(B1, 0, 1); PG8_STAGE(PG8_SB(0, 0), b2, voffB);
            PG8_BAR; PG8_WAIT_L(0); PG8_MMA(0, 1, At, B1); PG8_BAR;
            PG8_LDA(At, 0, 1); PG8_STAGE(PG8_SA(0, 0), a2, voffA);
            PG8_BAR; PG8_WAIT_L(0); PG8_MMA(1, 0, At, B0); PG8_BAR; PG8_SCHED;
            PG8_STAGE(PG8_SB(0, 1), b2 + hstep, voffB);
            PG8_WAIT_V(6); PG8_BAR; PG8_MMA(1, 1, At, B1); PG8_BAR;
            PG8_LDB(B0, 1, 0); PG8_SCHED; PG8_LDA(At, 1, 0); PG8_STAGE(PG8_SA(0, 1), a2 + hstep, voffA);
            PG8_WAIT_L(8); PG8_BAR; PG8_WAIT_L(0); PG8_MMA(0, 0, At, B0); PG8_BAR; PG8_SCHED;
            PG8_LDB(B1, 1, 1); PG8_STAGE(PG8_SB(1, 0), b3, voffB);
            PG8_BAR; PG8_WAIT_L(0); PG8_MMA(0, 1, At, B1); PG8_BAR;
            PG8_LDA(At, 1, 1); PG8_STAGE(PG8_SA(1, 0), a3, voffA);
            PG8_BAR; PG8_WAIT_L(0); PG8_MMA(1, 0, At, B0); PG8_BAR; PG8_SCHED;
            PG8_STAGE(PG8_SB(1, 1), b3 + hstep, voffB);
            PG8_WAIT_V(6); PG8_BAR; PG8_MMA(1, 1, At, B1); PG8_BAR;
            }
        }
        if constexpr (ALIGN_EPI) { if (wr == 0) PG8_BAR; }
        if constexpr (!Epi::AFTER_DRAIN) { E(acc, cur, wr, wc, fr, fq); S.done(cur); }
        if (!has_next) break;
#pragma unroll
        for (int a = 0; a < 2; ++a)
#pragma unroll
            for (int b = 0; b < 2; ++b)
#pragma unroll
                for (int m = 0; m < 4; ++m)
#pragma unroll
                    for (int n = 0; n < 2; ++n) acc[a][b][m][n] = (f32x4){0.f, 0.f, 0.f, 0.f};
        cur = nxt; cA = nA; cB = nB; ++ui;
        if constexpr (ALIGN_EPI) { if (wr == 1) PG8_BAR; }
    }
    PG8_WAIT_V(0);
    if constexpr (!ALIGN_EPI) { if (wr == 0) PG8_BAR; }
    PG8_BAR;
    if constexpr (Epi::AFTER_DRAIN) { E.fused(acc, cur, wr, wc, fr, fq, lds, wid, lane); S.done(cur); }
#undef PG8_SA
#undef PG8_SB
#undef PG8_STAGE
#undef PG8_LDA
#undef PG8_LDB
#undef PG8_MMA
#undef PG8_WAIT_V
#undef PG8_WAIT_L
#undef PG8_BAR
#undef PG8_SCHED
}
}

struct OutEpi8 {
    static constexpr bool PERM = false, AFTER_DRAIN = false;
    const float* src; float* dst; const float* gate; float* part;
    __device__ __forceinline__ void operator()(const pg8::f32x4 (&acc)[2][2][4][2], const pg8::Unit& u, int wr, int wc, int fr, int fq) const {
#pragma unroll
        for (int ai = 0; ai < 2; ++ai)
#pragma unroll
            for (int m = 0; m < 4; ++m) {
                const int t = u.pm * 256 + ai * 128 + wr * 64 + m * 16 + fr;
                const float* gp = gate + (t >> 11) * 6144;
                float ss = 0.f;
#pragma unroll
                for (int bj = 0; bj < 2; ++bj)
#pragma unroll
                    for (int n = 0; n < 2; ++n) {
                        const int col = u.pn * 256 + bj * 128 + wc * 32 + n * 16 + fq * 4;
                        const pg8::f32x4 g = *(const pg8::f32x4*)(gp + col);
                        const pg8::f32x4 o = *(const pg8::f32x4*)(src + (size_t)t * 1024 + col) + g * acc[ai][bj][m][n];
                        *(pg8::f32x4*)(dst + (size_t)t * 1024 + col) = o;
                        ss += o[0] * o[0] + o[1] * o[1] + o[2] * o[2] + o[3] * o[3];
                    }
                ss += __shfl_xor(ss, 16); ss += __shfl_xor(ss, 32);
                if (fq == 0) part[(size_t)t * 16 + u.pn * 4 + wc] = ss;
            }
    }
};


DI unsigned cvtpk(float lo, float hi) { return pk2(lo, hi); }
struct HybEpi8 {
    static constexpr bool PERM = true, AFTER_DRAIN = false;
    const Params* p; int j;
    __device__ __forceinline__ void operator()(const pg8::f32x4 (&acc)[2][2][4][2], const pg8::Unit& u, int wr, int wc, int fr, int fq) const {
        unsigned char* ws = p->ws;
        const int un = u.pn;
        if (un < 5 && !(un == 4 && (wc == 1 || wc == 3))) {
            const bool donorm = un < 2 || (un == 4 && wc == 0);
            bf16_t* ob; int ld, cb; const float* gam = p->hy_q_norm + j * 64;
            if (un < 2) { ob = (bf16_t*)(ws + WS_Q); ld = 512; cb = 64 * (4 * un + wc); }
            else if (un < 4) { ob = (bf16_t*)(ws + WS_IQ); ld = 512; cb = 64 * (4 * (un - 2) + wc); }
            else if (wc == 0) { ob = (bf16_t*)(ws + WS_K); ld = 64; cb = 0; gam = p->hy_k_norm + j * 64; }
            else { ob = (bf16_t*)(ws + WS_IK); ld = 64; cb = 0; }
            pg8::f32x4 g0[2], g1[2];
#pragma unroll
            for (int n = 0; n < 2; ++n) { g0[n] = donorm ? *(const pg8::f32x4*)(gam + 8 * fq + 4 * n) : (pg8::f32x4){1.f, 1.f, 1.f, 1.f}; g1[n] = donorm ? *(const pg8::f32x4*)(gam + 32 + 8 * fq + 4 * n) : (pg8::f32x4){1.f, 1.f, 1.f, 1.f}; }
            const float* ropec = (const float*)(ws + WS_ROPEC);
            const float* ropes = (const float*)(ws + WS_ROPES);
#pragma unroll
            for (int ai = 0; ai < 2; ++ai)
#pragma unroll
                for (int m = 0; m < 4; ++m) {
                    const int t = opq(u.pm * 256 + ai * 128 + wr * 64 + m * 16 + fr), pos = t & (S - 1);
                    float rstd = 1.f;
                    if (donorm) {
                        float ss = 0.f;
#pragma unroll
                        for (int bj = 0; bj < 2; ++bj)
#pragma unroll
                            for (int n = 0; n < 2; ++n) { const pg8::f32x4 x = acc[ai][bj][m][n]; ss += x[0] * x[0] + x[1] * x[1] + x[2] * x[2] + x[3] * x[3]; }
                        ss += __shfl_xor(ss, 16); ss += __shfl_xor(ss, 32);
                        rstd = rsqrtf(ss * (1.f / 64.f) + EPS);
                    }
                    u32x4 o1, o2;
#pragma unroll
                    for (int n = 0; n < 2; ++n) {
                        const pg8::f32x4 cs = *(const pg8::f32x4*)(ropec + pos * 32 + 8 * fq + 4 * n), sn = *(const pg8::f32x4*)(ropes + pos * 32 + 8 * fq + 4 * n);
                        const pg8::f32x4 x1 = acc[ai][0][m][n] * rstd * g0[n], x2 = acc[ai][1][m][n] * rstd * g1[n];
                        const pg8::f32x4 y1 = x1 * cs - x2 * sn, y2 = x2 * cs + x1 * sn;
                        o1[2 * n] = cvtpk(y1[0], y1[1]); o1[2 * n + 1] = cvtpk(y1[2], y1[3]);
                        o2[2 * n] = cvtpk(y2[0], y2[1]); o2[2 * n + 1] = cvtpk(y2[2], y2[3]);
                    }
                    *(u32x4*)(ob + (size_t)t * ld + cb + 8 * fq) = o1;
                    *(u32x4*)(ob + (size_t)t * ld + cb + 32 + 8 * fq) = o2;
                }
        } else if (un == 4 && wc == 1) {
            bf16_t* ob = (bf16_t*)(ws + WS_V);
#pragma unroll
            for (int ai = 0; ai < 2; ++ai)
#pragma unroll
                for (int m = 0; m < 4; ++m) {
                    const int t = opq(u.pm * 256 + ai * 128 + wr * 64 + m * 16 + fr), pos = t & (S - 1), bb = t >> 11;
#pragma unroll
                    for (int bj = 0; bj < 2; ++bj)
#pragma unroll
                        for (int n = 0; n < 2; ++n)
#pragma unroll
                            for (int e = 0; e < 4; ++e) ob[((size_t)(bb * 64 + 32 * bj + 8 * fq + 4 * n + e)) * S + pos] = f2bf(acc[ai][bj][m][n][e]);
                }
        } else if (un == 4) {
            float* ob = (float*)(ws + WS_IW);
            if (fq == 0) {
#pragma unroll
                for (int ai = 0; ai < 2; ++ai)
#pragma unroll
                    for (int m = 0; m < 4; ++m) {
                        const int t = u.pm * 256 + ai * 128 + wr * 64 + m * 16 + fr;
                        *(pg8::f32x4*)(ob + (size_t)t * 8) = acc[ai][0][m][0] * (0.125f * 0.35355339059327373f);
                        *(pg8::f32x4*)(ob + (size_t)t * 8 + 4) = acc[ai][0][m][1] * (0.125f * 0.35355339059327373f);
                    }
            }
        } else if (un < 7) {
            bf16_t* ob = (bf16_t*)(ws + WS_BG);
#pragma unroll
            for (int ai = 0; ai < 2; ++ai)
#pragma unroll
                for (int m = 0; m < 4; ++m) {
                    const int t = opq(u.pm * 256 + ai * 128 + wr * 64 + m * 16 + fr);
#pragma unroll
                    for (int bj = 0; bj < 2; ++bj) {
                        const pg8::f32x4 a = acc[ai][bj][m][0], b = acc[ai][bj][m][1];
                        u32x4 o = {cvtpk(a[0], a[1]), cvtpk(a[2], a[3]), cvtpk(b[0], b[1]), cvtpk(b[2], b[3])};
                        *(u32x4*)(ob + (size_t)t * 512 + (un - 5) * 256 + 128 * bj + 32 * wc + 8 * fq) = o;
                    }
                }
        } else {
            bf16_t* ob = (bf16_t*)(ws + WS_Z);
#pragma unroll
            for (int ai = 0; ai < 2; ++ai)
#pragma unroll
                for (int m = 0; m < 4; ++m) {
                    const int t = opq(u.pm * 256 + ai * 128 + wr * 64 + m * 16 + fr);
                    const pg8::f32x4 a = acc[ai][0][m][0] * acc[ai][1][m][0], b = acc[ai][0][m][1] * acc[ai][1][m][1];
                    u32x4 o = {cvtpk(a[0], a[1]), cvtpk(a[2], a[3]), cvtpk(b[0], b[1]), cvtpk(b[2], b[3])};
                    *(u32x4*)(ob + (size_t)t * 512 + (un - 7) * 128 + 32 * wc + 8 * fq) = o;
                }
        }
    }
};


struct MlEpi8 {
    static constexpr bool PERM = true, AFTER_DRAIN = false;
    const Params* p; int j;
    __device__ __forceinline__ void operator()(const pg8::f32x4 (&acc)[2][2][4][2], const pg8::Unit& u, int wr, int wc, int fr, int fq) const {
        unsigned char* ws = p->ws;
        const int un = u.pn;
        if (un < 4 || un >= 8) {
            bf16_t* ob; int ld, cb0; float sc = 1.f;
            if (un < 2) { ob = (bf16_t*)(ws + WS_MQ); ld = 512; cb0 = 64 * (4 * un + wc); sc = 0.125f; }
            else if (un < 4) { ob = (bf16_t*)(ws + WS_MK); ld = 512; cb0 = 64 * (4 * (un - 2) + wc); }
            else { ob = (bf16_t*)(ws + WS_MOG); ld = 1024; cb0 = (un - 8) * 256 + 32 * wc; }
            const int bstep = un < 4 ? 32 : 128;
#pragma unroll
            for (int ai = 0; ai < 2; ++ai)
#pragma unroll
                for (int m = 0; m < 4; ++m) {
                    const int t = opq(u.pm * 256 + ai * 128 + wr * 64 + m * 16 + fr);
#pragma unroll
                    for (int bj = 0; bj < 2; ++bj) {
                        pg8::f32x4 a = acc[ai][bj][m][0] * sc, b = acc[ai][bj][m][1] * sc;
                        if (un >= 8) { for (int e = 0; e < 4; ++e) { a[e] = sigmoidf_(a[e]); b[e] = sigmoidf_(b[e]); } }
                        u32x4 o = {cvtpk(a[0], a[1]), cvtpk(a[2], a[3]), cvtpk(b[0], b[1]), cvtpk(b[2], b[3])};
                        *(u32x4*)(ob + (size_t)t * ld + cb0 + bstep * bj + 8 * fq) = o;
                    }
                }
        }
        if (un >= 2 && un < 8) {
            bf16_t* ob = (bf16_t*)(ws + (un < 4 ? WS_MKT : WS_MV));
#pragma unroll
            for (int ai = 0; ai < 2; ++ai)
#pragma unroll
                for (int m = 0; m < 4; ++m) {
                    const int t = opq(u.pm * 256 + ai * 128 + wr * 64 + m * 16 + fr), pos = t & (S - 1), bb = t >> 11;
#pragma unroll
                    for (int bj = 0; bj < 2; ++bj) {
                        const size_t rowb = un < 4 ? (size_t)((bb * 8 + 4 * (un - 2) + wc) * 64 + 32 * bj + 8 * fq) : (size_t)((bb * 8 + 2 * (un - 4) + bj) * 128 + 32 * wc + 8 * fq);
#pragma unroll
                        for (int n = 0; n < 2; ++n)
#pragma unroll
                            for (int e = 0; e < 4; ++e) ob[(rowb + 4 * n + e) * S + pos] = f2bf(acc[ai][bj][m][n][e]);
                    }
                }
        }
    }
};

#define XB_TMO      128
#define XB_XCNT(j)  (256  + 64 * (j))
#define XB_XSUB(j)  (1280 + 64 * (j))
#define XB_XGEN(j)  (2304 + 64 * (j))
#define XB_TOP      3328
#define XB_TOPGEN   3392
#define XCD_BAR_WORDS 3456
#define XB_SPIN_CAP (1u << 22)
#define LAS __attribute__((address_space(3)))
DI unsigned xb_ld(unsigned* p) { return __hip_atomic_load(p, __ATOMIC_RELAXED, __HIP_MEMORY_SCOPE_AGENT); }
DI unsigned xb_add(unsigned* p, unsigned v) { return __hip_atomic_fetch_add(p, v, __ATOMIC_RELAXED, __HIP_MEMORY_SCOPE_AGENT); }
DI unsigned xb_xcc_id() { return (unsigned)__builtin_amdgcn_s_getreg((3 << 11) | 20) & 0xFu; }
#define XB_SPIN(cond, bar) do { unsigned _sp = 0; while (cond) { __builtin_amdgcn_s_sleep(1); \
    if ((++_sp & 255u) == 0u) { if (xb_ld(&(bar)[XB_TMO])) break; if (_sp > XB_SPIN_CAP) { atomicAdd(&(bar)[XB_TMO], 1u); break; } } } } while (0)
struct XcdBarrier { unsigned* bar; unsigned x; volatile LAS unsigned* st; };
DI XcdBarrier xcd_barrier_post(unsigned* bar, volatile LAS unsigned* st, bool leader) {
    XcdBarrier b; b.bar = bar; b.x = xb_xcc_id(); b.st = st;
    if (leader) (void)xb_add(&bar[XB_XCNT(b.x)], 1u);
    return b;
}
DI void xcd_barrier_complete(unsigned* bar, unsigned x, unsigned& nloc, unsigned& nx) {
    const unsigned G = gridDim.x * gridDim.y * gridDim.z;
    unsigned sum, cnt, mine, sp = 0u;
    for (;;) {
        sum = 0u; cnt = 0u; mine = 0u;
#pragma unroll
        for (unsigned j = 0; j < 16; ++j) { const unsigned c = xb_ld(&bar[XB_XCNT(j)]); sum += c; cnt += (c > 0u) ? 1u : 0u; mine = (j == x) ? c : mine; }
        if (sum == G) break;
        __builtin_amdgcn_s_sleep(1);
        if ((++sp & 255u) == 0u) { if (xb_ld(&bar[XB_TMO])) break; if (sp > XB_SPIN_CAP) { atomicAdd(&bar[XB_TMO], 1u); break; } }
    }
    nloc = mine > 0u ? mine : 1u; nx = cnt > 0u ? cnt : 1u;
}
DI void xcd_barrier(const XcdBarrier& b, bool leader) {
    asm volatile("s_waitcnt vmcnt(0)" ::: "memory");
    __syncthreads();
    if (leader) {
        unsigned* bar = b.bar;
        __builtin_amdgcn_s_waitcnt(0);
        unsigned nloc = b.st[0], nx = b.st[1];
        if (nloc == 0u) { xcd_barrier_complete(bar, b.x, nloc, nx); b.st[0] = nloc; b.st[1] = nx; }
        const unsigned old = xb_add(&bar[XB_XSUB(b.x)], 1u);
        const unsigned gen = old / nloc;
        if (old + 1u == (gen + 1u) * nloc) {
            __builtin_amdgcn_fence(__ATOMIC_RELEASE, "agent");
            asm volatile("s_waitcnt vmcnt(0)" ::: "memory");
            const unsigned og = xb_add(&bar[XB_TOP], 1u);
            const unsigned tg = og / nx;
            if (og + 1u == (tg + 1u) * nx) xb_add(&bar[XB_TOPGEN], 1u);
            else XB_SPIN(xb_ld(&bar[XB_TOPGEN]) == tg, bar);
            __builtin_amdgcn_fence(__ATOMIC_ACQUIRE, "agent");
            xb_add(&bar[XB_XGEN(b.x)], 1u);
            asm volatile("s_waitcnt vmcnt(0)" ::: "memory");
        } else {
            XB_SPIN(xb_ld(&bar[XB_XGEN(b.x)]) == gen, bar);
            __builtin_amdgcn_fence(__ATOMIC_ACQUIRE, "agent");
            asm volatile("s_waitcnt vmcnt(0)" ::: "memory");
        }
    }
    __syncthreads();
}

namespace cg = cooperative_groups;
constexpr int MEGA_LDS = 65536 + 256;

DI const Params& fresh(const Params* kp) { asm volatile("" : "+s"(kp)); return *kp; }

#ifndef PROBE_MASK
#define PROBE_MASK 0
#endif
__global__ void __launch_bounds__(512, 2) hybrid_fwd_megakernel(Params p_arg) {
    __shared__ __attribute__((aligned(16))) unsigned char smem_all[2 * MEGA_LDS + 256];
    cg::grid_group grid = cg::this_grid();
    const Params* kp = (const Params*)__builtin_amdgcn_kernarg_segment_ptr();
    const int wave8 = __builtin_amdgcn_readfirstlane((int)(threadIdx.x >> 6));
    const int vb = wave8 >> 2;
#define tid0 ((wave8 & 3) * 64 + lane_id())
    unsigned char* smem = smem_all + vb * MEGA_LDS;
    const int bid0 = blockIdx.x * 2 + vb, nb = gridDim.x * 2;
    const int gx0 = blockIdx.x & 7, glb0 = (blockIdx.x >> 3) * 2 + vb, gnl = (gridDim.x >> 3) * 2;
#define bid opqs(bid0)
#define gx opqs(gx0)
#define glb opqs(glb0)
#define tid opq(tid0)
    volatile LAS unsigned* xst = (volatile LAS unsigned*)(smem_all + 2 * MEGA_LDS);
    if (wave8 == 0 && lane_id() == 0) { xst[0] = 0u; xst[1] = 0u; }
    __syncthreads();
    (void)xcd_barrier_post((unsigned*)(fresh(kp).ws + WS_BAR), xst, wave8 == 0 && lane_id() == 0);
    for (int rep = 0; rep < ((PROBE_MASK & 1) ? 2 : 1); ++rep) { phase_init(fresh(kp), smem, bid, nb, tid); }
#define GSYNC() do { XcdBarrier xb_; xb_.bar = (unsigned*)(fresh(kp).ws + WS_BAR); xb_.x = xb_xcc_id(); xb_.st = (volatile LAS unsigned*)(smem_all + 2 * MEGA_LDS); xcd_barrier(xb_, wave8 == 0 && lane_id() == 0); } while (0)
    if (fresh(kp).use_cg_sync) grid.sync();
    GSYNC();
#pragma unroll 1
    for (int layer = 0; layer < DEPTH; ++layer) {
        const int j = layer >> 1;
        if (layer == 0) { { const Params& p = fresh(kp); phase_norm(p, 0, p.x, bid, nb, tid); }
        GSYNC(); }
        if ((layer & 1) == 0) {
            for (int rep = 0; rep < ((PROBE_MASK & 4) ? 2 : 1); ++rep) { { const Params& p = fresh(kp);
              pg8::Gemm g8{(const pg8::bf16_t*)(p.ws + WS_H), (const pg8::bf16_t*)(p.ws + WS_WHYB) + (size_t)j * 2816 * 1024, T, 2816, 1024};
              pg8::StaticOrder S8; S8.init(T, 2816, (int)gridDim.x, (int)blockIdx.x);
              HybEpi8 E8{&p, j};
              pg8::gemm_phase<HybEpi8, pg8::StaticOrder, true, true>((PG8_LAS unsigned char*)smem_all, g8, S8, E8, wave8 * 64 + lane_id()); } }
            GSYNC();
            for (int rep = 0; rep < ((PROBE_MASK & 8) ? 2 : 1); ++rep) { phase_dsa(fresh(kp), j, smem, bid, nb, tid, layer == 0 ? 1 : 3, layer == 0 ? 3 : 4); }
            for (int rep = 0; rep < ((PROBE_MASK & 16) ? 2 : 1); ++rep) { phase_conv(fresh(kp), j, bid, nb, tid); }
            GSYNC();
            { const Params& p = fresh(kp);
              pg8::Gemm g8{(const pg8::bf16_t*)(p.ws + WS_YMIX), (const pg8::bf16_t*)(p.ws + WS_WOUT) + (size_t)layer * 1024 * 1024, T, 1024, 1024};
              pg8::StaticOrder S8; S8.init(T, 1024, (int)gridDim.x, (int)blockIdx.x);
              OutEpi8 E8{layer == 0 ? p.x : p.out, p.out, (const float*)(p.ws + WS_MOD) + (size_t)layer * 8 * 6144 + 2048, (float*)(p.ws + WS_PART)};
              pg8::gemm_phase<OutEpi8, pg8::StaticOrder, false, true>((PG8_LAS unsigned char*)smem_all, g8, S8, E8, wave8 * 64 + lane_id()); }
        } else {
            for (int rep = 0; rep < ((PROBE_MASK & 32) ? 2 : 1); ++rep) { { const Params& p = fresh(kp);
              pg8::Gemm g8{(const pg8::bf16_t*)(p.ws + WS_H), (const pg8::bf16_t*)(p.ws + WS_WML) + (size_t)j * 3200 * 1024, T, 3072, 1024};
              pg8::StaticOrder S8; S8.init(T, 3072, (int)gridDim.x, (int)blockIdx.x);
              MlEpi8 E8{&p, j};
              pg8::gemm_phase<MlEpi8, pg8::StaticOrder, true, true>((PG8_LAS unsigned char*)smem_all, g8, S8, E8, wave8 * 64 + lane_id());
              for (int gi = glb; gi < 16; gi += gnl) { MlGates pr{&p, j, gx * 16 + gi}; gemm_tile(pr, smem, tid); } } }
            GSYNC();
            for (int rep = 0; rep < ((PROBE_MASK & 64) ? 2 : 1); ++rep) { phase_ml1(fresh(kp), smem, bid, nb, tid); }
            GSYNC();
            for (int rep = 0; rep < ((PROBE_MASK & 128) ? 2 : 1); ++rep) { phase_ml2(fresh(kp), smem, bid, nb, tid); }
            GSYNC();
            for (int rep = 0; rep < ((PROBE_MASK & 256) ? 2 : 1); ++rep) { phase_ml3(fresh(kp), j, smem, bid, nb, tid); }
            GSYNC();
            { const Params& p = fresh(kp);
              pg8::Gemm g8{(const pg8::bf16_t*)(p.ws + WS_YMIX), (const pg8::bf16_t*)(p.ws + WS_WOUT) + (size_t)layer * 1024 * 1024, T, 1024, 1024};
              pg8::StaticOrder S8; S8.init(T, 1024, (int)gridDim.x, (int)blockIdx.x);
              OutEpi8 E8{p.out, p.out, (const float*)(p.ws + WS_MOD) + (size_t)layer * 8 * 6144 + 2048, (float*)(p.ws + WS_PART)};
              pg8::gemm_phase<OutEpi8, pg8::StaticOrder, false, true>((PG8_LAS unsigned char*)smem_all, g8, S8, E8, wave8 * 64 + lane_id()); }
        }
        GSYNC();
        phase_ffn_norm_router(fresh(kp), layer, smem, bid, nb, tid);
        GSYNC();
        for (int rep = 0; rep < ((PROBE_MASK & 512) ? 2 : 1); ++rep) { phase_moe<1>(fresh(kp), layer, smem, gx, glb, gnl, tid); }
        GSYNC();
        for (int rep = 0; rep < ((PROBE_MASK & 1024) ? 2 : 1); ++rep) { phase_moe<2>(fresh(kp), layer, smem, gx, glb, gnl, tid); }
        GSYNC();
        phase_combine_norm(fresh(kp), layer, bid, nb, tid);
        if (layer + 1 < DEPTH) GSYNC();
    }
}
#undef tid
#undef tid0
#undef bid
#undef gx
#undef glb
#undef GSYNC

extern "C" void kernel_launch(void* const* d_in, const int* in_sizes, int n_in, void* d_out, int out_size, void* d_ws, size_t ws_size, hipStream_t stream) {
    Params p{};
    const float** f = (const float**)&p;
    for (int i = 0; i < 22; ++i) f[i] = (const float*)d_in[i];
    p.out = (float*)d_out;
    p.ws = (unsigned char*)d_ws;
    if (ws_size < WS_END) { fprintf(stderr, "workspace too small: %zu < %zu\n", ws_size, (size_t)WS_END); return; }
    static int grid_blocks = 0;
    if (!grid_blocks) {
        int dev = 0, cus = 0, per_cu = 0;
        hipGetDevice(&dev);
        hipDeviceGetAttribute(&cus, hipDeviceAttributeMultiprocessorCount, dev);
        hipOccupancyMaxActiveBlocksPerMultiprocessor(&per_cu, hybrid_fwd_megakernel, 512, 0);
        if (per_cu > 1) per_cu = 1;
        grid_blocks = cus * per_cu;
    }
    (void)hipMemsetAsync((unsigned char*)d_ws + WS_BAR, 0, XCD_BAR_WORDS_C * 4, stream);
    void* args[] = {&p};
    hipError_t e = hipLaunchCooperativeKernel((void*)hybrid_fwd_megakernel, dim3(grid_blocks), dim3(512), args, 0, stream);
    if (e != hipSuccess) fprintf(stderr, "cooperative launch failed: %s (grid %d)\n", hipGetErrorString(e), grid_blocks);
}
```

```cpp
#include <hip/hip_runtime.h>
#include <hip/hip_cooperative_groups.h>
#include <stdint.h>
#include <cstdio>

#define DI __device__ __forceinline__
typedef unsigned short bf16_t;
typedef short bf16x8 __attribute__((ext_vector_type(8)));
typedef float f32x16 __attribute__((ext_vector_type(16)));
typedef float f32x4 __attribute__((ext_vector_type(4)));
typedef float f32x2 __attribute__((ext_vector_type(2)));
typedef unsigned u32x4 __attribute__((ext_vector_type(4)));
typedef unsigned u32x2 __attribute__((ext_vector_type(2)));
typedef __bf16 bf16x2_t __attribute__((ext_vector_type(2)));

constexpr int D = 1024, NB = 8, S = 2048, T = NB * S, DEPTH = 4;
constexpr int HYB_IN = 2760, ML_IN = 3088;
constexpr int NEXP = 32, DEXP = 512, NASG = T * 2;
constexpr float EPS = 1e-6f;
constexpr int XCD_BAR_WORDS_C = 3456;

constexpr size_t al256(size_t x) { return (x + 255) & ~(size_t)255; }
constexpr size_t WS_MOD = 0;
constexpr size_t WS_ROPEC = WS_MOD + al256((size_t)4 * 8 * 6144 * 4);
constexpr size_t WS_ROPES = WS_ROPEC + al256((size_t)2048 * 32 * 4);
constexpr size_t WS_ECNT = WS_ROPES + al256((size_t)2048 * 32 * 4);
constexpr int ECS = 64;
constexpr size_t WS_H = WS_ECNT + al256(4 * 32 * ECS * 4);
constexpr size_t WS_YMIX = WS_H + al256((size_t)T * 1024 * 2);
constexpr size_t WS_Q = WS_YMIX + al256((size_t)T * 1024 * 2);
constexpr size_t WS_K = WS_Q + al256((size_t)T * 512 * 2);
constexpr size_t WS_V = WS_K + al256((size_t)T * 64 * 2);
constexpr size_t WS_IQ = WS_V + al256((size_t)T * 64 * 2);
constexpr size_t WS_IK = WS_IQ + al256((size_t)T * 512 * 2);
constexpr size_t WS_IW = WS_IK + al256((size_t)T * 64 * 2);
constexpr size_t WS_BG = WS_IW + al256((size_t)T * 8 * 4);
constexpr size_t WS_Z = WS_BG + al256((size_t)T * 512 * 2);
constexpr size_t WS_MASK = WS_Z + al256((size_t)T * 512 * 2);
constexpr size_t WS_MQ = WS_MASK + al256((size_t)T * 64 * 4);
constexpr size_t WS_MK = WS_MQ + al256((size_t)T * 512 * 2);
constexpr size_t WS_MV = WS_MK + al256((size_t)T * 512 * 2);
constexpr size_t WS_MIG = WS_MV + al256((size_t)T * 1024 * 2);
constexpr size_t WS_MFG = WS_MIG + al256((size_t)T * 8 * 4);
constexpr size_t WS_MOG = WS_MFG + al256((size_t)T * 8 * 4);
constexpr size_t WS_EW = WS_MOG + al256((size_t)T * 1024 * 2);
constexpr size_t WS_ELIST = WS_EW + al256((size_t)NASG * 4);
constexpr size_t WS_H1 = WS_ELIST + al256((size_t)NEXP * NASG * 4);
constexpr size_t WS_Y = WS_H1 + al256((size_t)NASG * 512 * 2);
constexpr size_t WS_MKT = WS_Y + al256((size_t)NASG * 1024 * 2);
constexpr size_t WS_UBUF = WS_MKT + al256((size_t)64 * 64 * S * 2);
constexpr size_t WS_UNBUF = WS_UBUF + al256((size_t)64 * 32 * 8192 * 4);
constexpr size_t WS_MLOC = WS_UNBUF + al256((size_t)64 * 32 * 64 * 4);
constexpr size_t WS_CBUF = WS_MLOC + al256((size_t)64 * 32 * 2 * 4);
constexpr size_t WS_NBUF = WS_CBUF + al256((size_t)64 * 32 * 8192 * 2);
constexpr size_t WS_MST = WS_NBUF + al256((size_t)64 * 32 * 64 * 4);
constexpr size_t WS_PART = WS_MST + al256((size_t)64 * 32 * 4);
constexpr size_t WS_WHYB = WS_PART + al256((size_t)T * 16 * 4);
constexpr size_t WS_WML = WS_WHYB + al256((size_t)2 * 2816 * 1024 * 2);
constexpr size_t WS_WOUT = WS_WML + al256((size_t)2 * 3200 * 1024 * 2);
constexpr size_t WS_WM1 = WS_WOUT + al256((size_t)4 * 1024 * 1024 * 2);
constexpr size_t WS_WM2 = WS_WM1 + al256((size_t)4 * 32 * 1024 * 1024 * 2);
constexpr size_t WS_BAR = WS_WM2 + al256((size_t)4 * 32 * 1024 * 512 * 2);
constexpr size_t WS_END = WS_BAR + al256((size_t)XCD_BAR_WORDS_C * 4);

struct Params {
    const float *x, *c, *ada_w, *ada_b, *norm_mix, *norm_ffn, *hy_w_in, *hy_q_norm, *hy_k_norm, *hy_conv_w, *hy_w_out;
    const float *ml_w_in, *ml_b_gates, *ml_out_norm, *ml_w_out, *moe_w_group, *moe_b_group, *moe_w_expert, *moe_b_expert;
    const float *moe_w_gate, *moe_w_up, *moe_w_down;
    float* out;
    unsigned char* ws;
    unsigned long long use_cg_sync;
};

DI unsigned pk2(float lo, float hi) { f32x2 v = {lo, hi}; bf16x2_t b = __builtin_convertvector(v, bf16x2_t); return __builtin_bit_cast(unsigned, b); }
DI bf16_t f2bf(float x) { return (bf16_t)(pk2(x, 0.f) & 0xffffu); }
DI float bf2f(bf16_t h) { return __uint_as_float(((unsigned)h) << 16); }
DI float bflo(unsigned u) { return __uint_as_float(u << 16); }
DI float bfhi(unsigned u) { return __uint_as_float(u & 0xffff0000u); }
DI int lane_id() { int x; asm volatile("v_mbcnt_lo_u32_b32 %0, -1, 0\n\tv_mbcnt_hi_u32_b32 %0, -1, %0" : "=v"(x)); return x; }
template <int M> DI int sx_i(int v) {
    if constexpr (M < 32) return __builtin_amdgcn_ds_swizzle(v, (M << 10) | 0x1f);
    else return __builtin_amdgcn_ds_bpermute((lane_id() ^ 32) << 2, v);
}
template <int M> DI float sx_f(float v) { return __int_as_float(sx_i<M>(__float_as_int(v))); }
DI float lane_get_f(float v, int src) { return __int_as_float(__builtin_amdgcn_ds_bpermute(src << 2, __float_as_int(v))); }
DI float wave_sum(float v) { v += sx_f<32>(v); v += sx_f<16>(v); v += sx_f<8>(v); v += sx_f<4>(v); v += sx_f<2>(v); v += sx_f<1>(v); return v; }
DI float wave_max(float v) { v = fmaxf(v, sx_f<32>(v)); v = fmaxf(v, sx_f<16>(v)); v = fmaxf(v, sx_f<8>(v)); v = fmaxf(v, sx_f<4>(v)); v = fmaxf(v, sx_f<2>(v)); v = fmaxf(v, sx_f<1>(v)); return v; }
DI float half_sum(float v) { v += sx_f<16>(v); v += sx_f<8>(v); v += sx_f<4>(v); v += sx_f<2>(v); v += sx_f<1>(v); return v; }
DI float sigmoidf_(float x) { return 1.f / (1.f + __expf(-x)); }
DI unsigned char* uniform_ptr(unsigned char* q) {
    const unsigned long long w = (unsigned long long)q;
    const unsigned lo = __builtin_amdgcn_readfirstlane((unsigned)w), hi = __builtin_amdgcn_readfirstlane((unsigned)(w >> 32));
    return (unsigned char*)(((unsigned long long)hi << 32) | lo);
}
DI int opqs(int x) { asm volatile("" : "+s"(x)); return x; }
DI int opq(int x) { asm volatile("" : "+v"(x)); return x; }

DI int swz(int row, int slot) { return row * 128 + ((slot ^ ((row >> 1) & 7)) << 4); }
DI int crow(int reg, int lane) { return (reg & 3) + 8 * (reg >> 2) + 4 * (lane >> 5); }

template <class P>
DI void gemm_tile(const P& pr, unsigned char* smem, int tid) {
    const int lane = tid & 63, wid = tid >> 6, wr = wid >> 1, wc = wid & 1;
    const bf16_t* abase = pr.a_base();
    const bf16_t* bbase = pr.b_base();
    const int kdim = pr.kt() * 64;
    int gao[4], gbo[4];
#pragma unroll
    for (int i = 0; i < 4; ++i) {
        const int row = (tid >> 3) + 32 * i, sl = (tid & 7) ^ ((row >> 1) & 7);
        const int o = pr.a_off(row);
        gao[i] = (o >= 0 ? o : 0) + sl * 8; gbo[i] = row * kdim + sl * 8;
    }
#define GLDS(buf, kt) do { _Pragma("unroll") for (int i = 0; i < 4; ++i) { \
        __builtin_amdgcn_global_load_lds((const unsigned*)(abase + gao[i] + (kt) * 64), (__attribute__((address_space(3))) unsigned*)(smem + (buf) * 32768 + (i * 256 + wid * 64) * 16), 16, 0, 0); \
        __builtin_amdgcn_global_load_lds((const unsigned*)(bbase + gbo[i] + (kt) * 64), (__attribute__((address_space(3))) unsigned*)(smem + (buf) * 32768 + 16384 + (i * 256 + wid * 64) * 16), 16, 0, 0); } } while (0)
#define DMA_WAIT_SYNC() do { asm volatile("s_waitcnt vmcnt(0)" ::: "memory"); __syncthreads(); } while (0)
#define COMPUTE(buf) do { const unsigned char* As = smem + (buf) * 32768; const unsigned char* Bs = As + 16384; \
        _Pragma("unroll") for (int ks = 0; ks < 4; ++ks) { const int slot = ks * 2 + (lane >> 5); \
            const bf16x8 a0 = *(const bf16x8*)(As + swz(wr * 64 + (lane & 31), slot)); const bf16x8 a1 = *(const bf16x8*)(As + swz(wr * 64 + 32 + (lane & 31), slot)); \
            const bf16x8 b0 = *(const bf16x8*)(Bs + swz(wc * 64 + (lane & 31), slot)); const bf16x8 b1 = *(const bf16x8*)(Bs + swz(wc * 64 + 32 + (lane & 31), slot)); \
            acc[0][0] = __builtin_amdgcn_mfma_f32_32x32x16_bf16(a0, b0, acc[0][0], 0, 0, 0); acc[0][1] = __builtin_amdgcn_mfma_f32_32x32x16_bf16(a0, b1, acc[0][1], 0, 0, 0); \
            acc[1][0] = __builtin_amdgcn_mfma_f32_32x32x16_bf16(a1, b0, acc[1][0], 0, 0, 0); acc[1][1] = __builtin_amdgcn_mfma_f32_32x32x16_bf16(a1, b1, acc[1][1], 0, 0, 0); } } while (0)
    f32x16 acc[2][2];
#pragma unroll
    for (int a = 0; a < 2; ++a)
#pragma unroll
        for (int b = 0; b < 2; ++b)
#pragma unroll
            for (int r = 0; r < 16; ++r) acc[a][b][r] = 0.f;
    const int KT = pr.kt();
    __syncthreads();
    GLDS(0, 0);
    DMA_WAIT_SYNC();
    for (int kt = 0; kt < KT; kt += 2) {
        GLDS(1, kt + 1);
        COMPUTE(0);
        DMA_WAIT_SYNC();
        if (kt + 2 < KT) GLDS(0, kt + 2);
        COMPUTE(1);
        DMA_WAIT_SYNC();
    }
#undef GLDS
#undef DMA_WAIT_SYNC
#undef COMPUTE
    pr.epi(acc, wr, wc, lane, smem + wid * 8192);
}

template <class P>
DI void convert_tile(const P& pr, bf16_t* dst, int kdim, int kt, unsigned char* smem, int tid) {
    unsigned char* Bs = smem;
    const int ng = tid & 31, kg = tid >> 5;
    int width = 0;
    const float* bp = pr.b_col(ng >> 3, width);
    const int cig = (ng & 7) * 4;
    const bool bvalid = cig < width;
    const int ldb = pr.ldb();
    bp += cig + (size_t)(kt * 64 + kg * 8) * ldb;
    f32x4 rb[8];
#pragma unroll
    for (int kk = 0; kk < 8; ++kk) rb[kk] = bvalid ? *(const f32x4*)(bp + (size_t)kk * ldb) : (f32x4){0.f, 0.f, 0.f, 0.f};
    __syncthreads();
#pragma unroll
    for (int j = 0; j < 4; ++j) {
        u32x4 v = {pk2(rb[0][j], rb[1][j]), pk2(rb[2][j], rb[3][j]), pk2(rb[4][j], rb[5][j]), pk2(rb[6][j], rb[7][j])};
        *(u32x4*)(Bs + swz(ng * 4 + j, kg)) = v;
    }
    __syncthreads();
#pragma unroll
    for (int i = 0; i < 4; ++i) {
        const int n = (tid >> 3) + 32 * i;
        *(u32x4*)(dst + (size_t)n * kdim + kt * 64 + (tid & 7) * 8) = *(const u32x4*)(Bs + swz(n, tid & 7));
    }
}

template <int NC> DI void stage_put(unsigned char* wl, int mi, int ni, int r, int lane, float v) { *(bf16_t*)(wl + ((mi * 32 + crow(r, lane)) * NC + ni * 32 + (lane & 31)) * 2) = f2bf(v); }
template <int NC, class RowPtr> DI void stage_flush(unsigned char* wl, int lane, RowPtr rp) {
    constexpr int CH = NC / 8, RPI = 64 / CH, NIT = 64 / RPI;
#pragma unroll
    for (int i = 0; i < NIT; ++i) {
        const int row = lane / CH + RPI * i, ch = lane % CH;
        const u32x4 d = *(const u32x4*)(wl + (row * NC + ch * 8) * 2);
        bf16_t* dst = rp(row);
        if (dst) *(u32x4*)(dst + ch * 8) = d;
    }
}

struct HybIn {
    const Params* p; int j, tm, tn;
    DI int kt() const { return 16; }
    DI int ldb() const { return HYB_IN; }
    DI const bf16_t* a_base() const { return (const bf16_t*)(p->ws + WS_H); }
    DI int a_off(int r) const { return (tm * 128 + r) * 1024; }
    DI static void pair_cols(int pr, int ni, int& base, int& width) {
        width = 32;
        if (pr < 8) base = 64 * pr + 32 * ni;
        else if (pr == 8) base = 512 + 32 * ni;
        else if (pr == 9) base = 576 + 32 * ni;
        else if (pr < 18) base = 640 + 64 * (pr - 10) + 32 * ni;
        else if (pr == 18) base = 1152 + 32 * ni;
        else if (pr == 19) { base = 1216; width = ni == 0 ? 8 : 0; }
        else if (pr < 28) base = 1224 + 64 * (pr - 20) + 32 * ni;
        else base = (ni == 0 ? 1736 : 2248) + 32 * (pr - 28);
    }
    DI const float* b_col(int g, int& width) const { int base; pair_cols(tn * 2 + (g >> 1), g & 1, base, width); return p->hy_w_in + (size_t)j * 1024 * HYB_IN + base; }
    DI const bf16_t* b_base() const { return (const bf16_t*)(p->ws + WS_WHYB) + (size_t)(j * 22 + tn) * 128 * 1024; }
    DI void epi(f32x16 (&acc)[2][2], int wr, int wc, int lane, unsigned char* wl) const {
        const int pr = tn * 2 + wc, c = lane & 31;
        const int t0 = tm * 128 + wr * 64;
        unsigned char* ws = p->ws;
        const float* ropec = (const float*)(ws + WS_ROPEC);
        const float* ropes = (const float*)(ws + WS_ROPES);
        if (pr < 9 || (pr >= 10 && pr < 19)) {
            const bool donorm = pr < 9;
            const float* gam = pr < 8 ? p->hy_q_norm + j * 64 : p->hy_k_norm + j * 64;
            bf16_t* ob; int ld, cb;
            if (pr < 8) { ob = (bf16_t*)(ws + WS_Q); ld = 512; cb = 64 * pr; }
            else if (pr == 8) { ob = (bf16_t*)(ws + WS_K); ld = 64; cb = 0; }
            else if (pr < 18) { ob = (bf16_t*)(ws + WS_IQ); ld = 512; cb = 64 * (pr - 10); }
            else { ob = (bf16_t*)(ws + WS_IK); ld = 64; cb = 0; }
            float g1 = 1.f, g2 = 1.f;
            if (donorm) { g1 = gam[c]; g2 = gam[c + 32]; }
#pragma unroll
            for (int mi = 0; mi < 2; ++mi)
#pragma unroll
                for (int r = 0; r < 16; ++r) {
                    float x1 = acc[mi][0][r], x2 = acc[mi][1][r];
                    const int t = t0 + mi * 32 + crow(r, lane), pos = t & (S - 1);
                    if (donorm) { float ss = half_sum(x1 * x1 + x2 * x2); float rstd = rsqrtf(ss * (1.f / 64.f) + EPS); x1 *= rstd * g1; x2 *= rstd * g2; }
                    const float cs = ropec[pos * 32 + c], sn = ropes[pos * 32 + c];
                    stage_put<64>(wl, mi, 0, r, lane, x1 * cs - x2 * sn);
                    stage_put<64>(wl, mi, 1, r, lane, x2 * cs + x1 * sn);
                }
            stage_flush<64>(wl, lane, [&](int row) { return ob + (size_t)(t0 + row) * ld + cb; });
        } else if (pr == 9) {
            bf16_t* ob = (bf16_t*)(ws + WS_V);
#pragma unroll
            for (int mi = 0; mi < 2; ++mi)
#pragma unroll
                for (int ni = 0; ni < 2; ++ni)
#pragma unroll
                    for (int g4 = 0; g4 < 4; ++g4) {
                        const int t = t0 + mi * 32 + 8 * g4 + 4 * (lane >> 5), pos = t & (S - 1), bb = t >> 11;
                        u32x2 o = {pk2(acc[mi][ni][4 * g4], acc[mi][ni][4 * g4 + 1]), pk2(acc[mi][ni][4 * g4 + 2], acc[mi][ni][4 * g4 + 3])};
                        *(u32x2*)(ob + ((size_t)(bb * 64 + ni * 32 + c)) * S + pos) = o;
                    }
        } else if (pr == 19) {
            float* ob = (float*)(ws + WS_IW);
            if (c < 8) {
#pragma unroll
                for (int mi = 0; mi < 2; ++mi)
#pragma unroll
                    for (int r = 0; r < 16; ++r) { const int t = t0 + mi * 32 + crow(r, lane); ob[(size_t)t * 8 + c] = acc[mi][0][r] * (0.125f * 0.35355339059327373f); }
            }
        } else if (pr < 28) {
            bf16_t* ob = (bf16_t*)(ws + WS_BG); const int cb = 64 * (pr - 20);
#pragma unroll
            for (int mi = 0; mi < 2; ++mi)
#pragma unroll
                for (int r = 0; r < 16; ++r) { stage_put<64>(wl, mi, 0, r, lane, acc[mi][0][r]); stage_put<64>(wl, mi, 1, r, lane, acc[mi][1][r]); }
            stage_flush<64>(wl, lane, [&](int row) { return ob + (size_t)(t0 + row) * 512 + cb; });
        } else {
            bf16_t* ob = (bf16_t*)(ws + WS_Z); const int cb = 32 * (pr - 28);
#pragma unroll
            for (int mi = 0; mi < 2; ++mi)
#pragma unroll
                for (int r = 0; r < 16; ++r) stage_put<32>(wl, mi, 0, r, lane, acc[mi][0][r] * acc[mi][1][r]);
            stage_flush<32>(wl, lane, [&](int row) { return ob + (size_t)(t0 + row) * 512 + cb; });
        }
    }
};


struct HybCols8 {
    const Params* p; int j, tm, tn;
    DI int ldb() const { return HYB_IN; }
    DI const float* b_col(int g, int& width) const {
        const int u = tn >> 1, bj = tn & 1; int base; width = 32;
        if (u < 2) base = 64 * (4 * u + g) + 32 * bj;
        else if (u < 4) base = 640 + 64 * (4 * (u - 2) + g) + 32 * bj;
        else if (u == 4) { if (g == 0) base = 512 + 32 * bj; else if (g == 1) base = 576 + 32 * bj; else if (g == 2) base = 1152 + 32 * bj; else { base = 1216; width = bj == 0 ? 8 : 0; } }
        else if (u < 7) base = 1224 + (u - 5) * 256 + 128 * bj + 32 * g;
        else base = (bj == 0 ? 1736 : 2248) + (u - 7) * 128 + 32 * g;
        return p->hy_w_in + (size_t)j * 1024 * HYB_IN + base;
    }
};

struct MlIn {
    const Params* p; int j, tm, tn;
    DI int kt() const { return 16; }
    DI int ldb() const { return ML_IN; }
    DI const bf16_t* a_base() const { return (const bf16_t*)(p->ws + WS_H); }
    DI int a_off(int r) const { return (tm * 128 + r) * 1024; }
    DI const float* b_col(int g, int& width) const {
        const int pr = tn * 2 + (g >> 1), ni = g & 1; int base; width = 32;
        if (pr < 32) base = 64 * pr + 32 * ni;
        else if (pr == 32) { base = 2048 + 8 * ni; width = 8; }
        else if (pr < 49) base = 2064 + 64 * (pr - 33) + 32 * ni;
        else { base = 0; width = 0; }
        return p->ml_w_in + (size_t)j * 1024 * ML_IN + base;
    }
    DI const bf16_t* b_base() const { return (const bf16_t*)(p->ws + WS_WML) + (size_t)(j * 25 + tn) * 128 * 1024; }
    DI void epi(f32x16 (&acc)[2][2], int wr, int wc, int lane, unsigned char* wl) const {
        const int pr = tn * 2 + wc, c = lane & 31;
        const int t0 = tm * 128 + wr * 64;
        unsigned char* ws = p->ws;
        if (pr < 16) {
            bf16_t* ob; int cb; float sc = 1.f;
            if (pr < 8) { ob = (bf16_t*)(ws + WS_MQ); cb = 64 * pr; sc = 0.125f; }
            else { ob = (bf16_t*)(ws + WS_MK); cb = 64 * (pr - 8); }
#pragma unroll
            for (int mi = 0; mi < 2; ++mi)
#pragma unroll
                for (int r = 0; r < 16; ++r) { stage_put<64>(wl, mi, 0, r, lane, acc[mi][0][r] * sc); stage_put<64>(wl, mi, 1, r, lane, acc[mi][1][r] * sc); }
            stage_flush<64>(wl, lane, [&](int row) { return ob + (size_t)(t0 + row) * 512 + cb; });
        }
        if (pr >= 8 && pr < 32) {
            bf16_t* ob; int nrow, hd, r0;
            if (pr < 16) { ob = (bf16_t*)(ws + WS_MKT); nrow = 64; hd = pr - 8; r0 = 0; }
            else { ob = (bf16_t*)(ws + WS_MV); nrow = 128; hd = (pr - 16) >> 1; r0 = 64 * ((pr - 16) & 1); }
#pragma unroll
            for (int mi = 0; mi < 2; ++mi)
#pragma unroll
                for (int ni = 0; ni < 2; ++ni)
#pragma unroll
                    for (int g4 = 0; g4 < 4; ++g4) {
                        const int t = t0 + mi * 32 + 8 * g4 + 4 * (lane >> 5), pos = t & (S - 1), bb = t >> 11;
                        u32x2 o = {pk2(acc[mi][ni][4 * g4], acc[mi][ni][4 * g4 + 1]), pk2(acc[mi][ni][4 * g4 + 2], acc[mi][ni][4 * g4 + 3])};
                        *(u32x2*)(ob + ((size_t)((bb * 8 + hd) * nrow + r0 + ni * 32 + c)) * S + pos) = o;
                    }
        } else if (pr == 32) {
            if (c < 8) {
                float* oi = (float*)(ws + WS_MIG); float* of = (float*)(ws + WS_MFG);
                const float bi = p->ml_b_gates[j * 16 + c], bfg = p->ml_b_gates[j * 16 + 8 + c];
#pragma unroll
                for (int mi = 0; mi < 2; ++mi)
#pragma unroll
                    for (int r = 0; r < 16; ++r) {
                        const int t = t0 + mi * 32 + crow(r, lane);
                        oi[(size_t)t * 8 + c] = acc[mi][0][r] + bi;
                        const float f = acc[mi][1][r] + bfg;
                        of[(size_t)t * 8 + c] = fminf(f, 0.f) - log1pf(__expf(-fabsf(f)));
                    }
            }
        } else if (pr >= 33 && pr < 49) {
            bf16_t* ob = (bf16_t*)(ws + WS_MOG); const int cb = 64 * (pr - 33);
#pragma unroll
            for (int mi = 0; mi < 2; ++mi)
#pragma unroll
                for (int r = 0; r < 16; ++r) { stage_put<64>(wl, mi, 0, r, lane, sigmoidf_(acc[mi][0][r])); stage_put<64>(wl, mi, 1, r, lane, sigmoidf_(acc[mi][1][r])); }
            stage_flush<64>(wl, lane, [&](int row) { return ob + (size_t)(t0 + row) * 1024 + cb; });
        }
    }
};


struct MlCols8 {
    const Params* p; int j, tm, tn;
    DI int ldb() const { return ML_IN; }
    DI const float* b_col(int g, int& width) const {
        const int u = tn >> 1, bj = tn & 1; int base; width = 32;
        if (tn == 24) { base = 2048 + 8 * (g & 1); width = g < 2 ? 8 : 0; }
        else if (u < 2) base = 64 * (4 * u + g) + 32 * bj;
        else if (u < 4) base = 512 + 64 * (4 * (u - 2) + g) + 32 * bj;
        else if (u < 8) base = 1024 + (2 * (u - 4) + bj) * 128 + 32 * g;
        else base = 2064 + (u - 8) * 256 + 128 * bj + 32 * g;
        return p->ml_w_in + (size_t)j * 1024 * ML_IN + base;
    }
};
struct MlGates {
    const Params* p; int j, tm;
    DI int kt() const { return 16; }
    DI const bf16_t* a_base() const { return (const bf16_t*)(p->ws + WS_H); }
    DI int a_off(int r) const { return (tm * 128 + r) * 1024; }
    DI const bf16_t* b_base() const { return (const bf16_t*)(p->ws + WS_WML) + (size_t)(j * 25 + 24) * 128 * 1024; }
    DI void epi(f32x16 (&acc)[2][2], int wr, int wc, int lane, unsigned char* wl) const {
        const int c = lane & 31, t0 = tm * 128 + wr * 64;
        if (wc == 0 && c < 8) {
            float* oi = (float*)(p->ws + WS_MIG); float* of = (float*)(p->ws + WS_MFG);
            const float bi = p->ml_b_gates[j * 16 + c], bfg = p->ml_b_gates[j * 16 + 8 + c];
#pragma unroll
            for (int mi = 0; mi < 2; ++mi)
#pragma unroll
                for (int r = 0; r < 16; ++r) {
                    const int t = t0 + mi * 32 + crow(r, lane);
                    oi[(size_t)t * 8 + c] = acc[mi][0][r] + bi;
                    const float f = acc[mi][1][r] + bfg;
                    of[(size_t)t * 8 + c] = fminf(f, 0.f) - log1pf(__expf(-fabsf(f)));
                }
        }
    }
};

struct OutProj {
    const Params* p; const float* W; const float* src; int layer, tm, tn;
    DI int kt() const { return 16; }
    DI int ldb() const { return 1024; }
    DI const bf16_t* a_base() const { return (const bf16_t*)(p->ws + WS_YMIX); }
    DI int a_off(int r) const { return (tm * 128 + r) * 1024; }
    DI const float* b_col(int g, int& width) const { width = 32; return W + tn * 128 + g * 32; }
    DI const bf16_t* b_base() const { return (const bf16_t*)(p->ws + WS_WOUT) + (size_t)(layer * 8 + tn) * 128 * 1024; }
    DI void epi(f32x16 (&acc)[2][2], int wr, int wc, int lane, unsigned char* wl) const {
        const int c = lane & 31, t0 = tm * 128 + wr * 64, wid = wr * 2 + wc;
        float* fl = (float*)(wl + wid * 8192);
#pragma unroll
        for (int mi = 0; mi < 2; ++mi)
#pragma unroll
            for (int ni = 0; ni < 2; ++ni)
#pragma unroll
                for (int r = 0; r < 16; ++r) fl[(mi * 32 + crow(r, lane)) * 64 + ni * 32 + c] = acc[mi][ni][r];
        const float* mod = (const float*)(p->ws + WS_MOD) + (size_t)layer * 8 * 6144;
        const int ch = lane & 15, n = tn * 128 + wc * 64 + ch * 4;
        const f32x4 g = *(const f32x4*)(mod + (t0 >> 11) * 6144 + 2048 + n);
        float* part = (float*)(p->ws + WS_PART);
#pragma unroll 4
        for (int i = 0; i < 16; ++i) {
            const int row = (lane >> 4) + 4 * i, t = t0 + row;
            const f32x4 a = *(const f32x4*)(fl + row * 64 + ch * 4);
            const f32x4 o = *(const f32x4*)(src + (size_t)t * 1024 + n) + g * a;
            *(f32x4*)(p->out + (size_t)t * 1024 + n) = o;
            float ss = o[0] * o[0] + o[1] * o[1] + o[2] * o[2] + o[3] * o[3];
            ss += sx_f<1>(ss); ss += sx_f<2>(ss); ss += sx_f<4>(ss); ss += sx_f<8>(ss);
            if (ch == 0) part[(size_t)t * 16 + tn * 2 + wc] = ss;
        }
    }
};

struct Moe1 {
    const Params* p; int layer, e, mt, nt, cnt, roff;
    DI int kt() const { return 16; }
    DI int ldb() const { return DEXP; }
    DI const bf16_t* a_base() const { return (const bf16_t*)(p->ws + WS_H); }
    DI int a_off(int r) const {
        const int rr = mt * 128 + r; if (rr >= cnt) return -1;
        const int a = ((const int*)(p->ws + WS_ELIST))[(size_t)e * NASG + rr];
        return (a >> 1) * 1024;
    }
    DI const float* b_col(int g, int& width) const {
        width = 32;
        const float* base = (nt & 1) ? p->moe_w_up : p->moe_w_gate;
        return base + ((size_t)layer * NEXP + e) * (size_t)(D * DEXP) + 128 * (nt >> 1) + 32 * g;
    }
    DI const bf16_t* b_base() const { return (const bf16_t*)(p->ws + WS_WM1) + (size_t)((layer * NEXP + e) * 8 + nt) * 128 * 1024; }
    DI void epi(f32x16 (&acc)[2][2], int wr, int wc, int lane, unsigned char* wl) const {
        const int c = lane & 31, pr = nt * 2 + wc;
        bf16_t* ob = (bf16_t*)(p->ws + WS_H1);
#pragma unroll
        for (int mi = 0; mi < 2; ++mi)
#pragma unroll
            for (int r = 0; r < 16; ++r) {
                const float g = acc[mi][0][r], u = acc[mi][1][r];
                stage_put<32>(wl, mi, 0, r, lane, g / (1.f + __expf(-g)) * u);
            }
        const int rb = mt * 128 + wr * 64;
        stage_flush<32>(wl, lane, [&](int row) { return rb + row < cnt ? ob + (size_t)(roff + rb + row) * 512 + 32 * pr : (bf16_t*)nullptr; });
    }
};

struct Moe2 {
    const Params* p; int layer, e, mt, nt, cnt, roff;
    DI int kt() const { return 8; }
    DI int ldb() const { return D; }
    DI const bf16_t* a_base() const { return (const bf16_t*)(p->ws + WS_H1); }
    DI int a_off(int r) const { const int rr = mt * 128 + r; if (rr >= cnt) return -1; return (roff + rr) * 512; }
    DI const float* b_col(int g, int& width) const { width = 32; return p->moe_w_down + ((size_t)layer * NEXP + e) * (size_t)(DEXP * D) + nt * 128 + g * 32; }
    DI const bf16_t* b_base() const { return (const bf16_t*)(p->ws + WS_WM2) + (size_t)((layer * NEXP + e) * 8 + nt) * 128 * 512; }
    DI void epi(f32x16 (&acc)[2][2], int wr, int wc, int lane, unsigned char* wl) const {
        const int c = lane & 31;
        bf16_t* ob = (bf16_t*)(p->ws + WS_Y);
        const int* el = (const int*)(p->ws + WS_ELIST) + (size_t)e * NASG;
#pragma unroll
        for (int mi = 0; mi < 2; ++mi)
#pragma unroll
            for (int r = 0; r < 16; ++r) { stage_put<64>(wl, mi, 0, r, lane, acc[mi][0][r]); stage_put<64>(wl, mi, 1, r, lane, acc[mi][1][r]); }
        const int rb = mt * 128 + wr * 64;
        stage_flush<64>(wl, lane, [&](int row) { return rb + row < cnt ? ob + (size_t)el[rb + row] * 1024 + nt * 128 + wc * 64 : (bf16_t*)nullptr; });
    }
};

DI void convert_moe_layers(const Params& p, int l0, int l1, unsigned char* smem, int bid, int nb, int tid) {
    const int PER = 32 * 8 * 16 + 32 * 8 * 8, total = (l1 - l0) * PER;
    for (int item = bid; item < total; item += nb) {
        const int l = l0 + item / PER; int ci = item % PER;
        if (ci < 4096) { const int kt = ci & 15, nt = (ci >> 4) & 7, e = ci >> 7; Moe1 pr{&p, l, e, 0, nt, 0, 0}; convert_tile(pr, (bf16_t*)(p.ws + WS_WM1) + (size_t)((l * 32 + e) * 8 + nt) * 128 * 1024, 1024, kt, smem, tid); }
        else { ci -= 4096; const int kt = ci & 7, nt = (ci >> 3) & 7, e = ci >> 6; Moe2 pr{&p, l, e, 0, nt, 0, 0}; convert_tile(pr, (bf16_t*)(p.ws + WS_WM2) + (size_t)((l * 32 + e) * 8 + nt) * 128 * 512, 512, kt, smem, tid); }
    }
    __syncthreads();
}

DI void phase_init(const Params& p, unsigned char* smem, int bid, int nb, int tid) {
    float* sc = (float*)smem;
    float* red = (float*)(smem + 32768);
    const int NMOD = DEPTH * 96, NROPE = 256;
    const int C_HYB = 2 * 22 * 16, C_ML = 2 * 25 * 16, C_OUT = 4 * 8 * 16;
    for (int ci = bid; ci < C_HYB + C_ML + C_OUT; ci += nb) {
        int c2 = ci;
        if (c2 < C_HYB) { const int kt = c2 & 15, tn = (c2 >> 4) % 22, j = (c2 >> 4) / 22; HybCols8 pr{&p, j, 0, tn}; convert_tile(pr, (bf16_t*)(p.ws + WS_WHYB) + (size_t)(j * 22 + tn) * 128 * 1024, 1024, kt, smem, tid); continue; }
        c2 -= C_HYB;
        if (c2 < C_ML) { const int kt = c2 & 15, tn = (c2 >> 4) % 25, j = (c2 >> 4) / 25; MlCols8 pr{&p, j, 0, tn}; convert_tile(pr, (bf16_t*)(p.ws + WS_WML) + (size_t)(j * 25 + tn) * 128 * 1024, 1024, kt, smem, tid); continue; }
        c2 -= C_ML;
        { const int kt = c2 & 15, tn = (c2 >> 4) & 7, l = c2 >> 7; const float* W = ((l & 1) ? p.ml_w_out : p.hy_w_out) + (size_t)(l >> 1) * 1024 * 1024;
            OutProj pr{&p, W, nullptr, l, 0, tn}; convert_tile(pr, (bf16_t*)(p.ws + WS_WOUT) + (size_t)(l * 8 + tn) * 128 * 1024, 1024, kt, smem, tid); }
    }
    for (int item = bid; item < NMOD; item += nb) {
        __syncthreads();
        for (int i = tid; i < 8 * 1024; i += 256) { const float v = p.c[i]; sc[i] = v / (1.f + __expf(-v)); }
        __syncthreads();
        const int l = item / 96, jb = item % 96, cq = tid & 15, ksl = tid >> 4;
        const float* w = p.ada_w + (size_t)l * 1024 * 6144 + jb * 64 + cq * 4;
        f32x4 acc[8];
#pragma unroll
        for (int b = 0; b < 8; ++b) acc[b] = (f32x4){0.f, 0.f, 0.f, 0.f};
        for (int ii = 0; ii < 64; ++ii) {
            const int i = ksl * 64 + ii;
            const f32x4 wv = *(const f32x4*)(w + (size_t)i * 6144);
#pragma unroll
            for (int b = 0; b < 8; ++b) acc[b] += wv * sc[b * 1024 + i];
        }
#pragma unroll
        for (int b = 0; b < 8; ++b) *(f32x4*)(red + (ksl * 8 + b) * 64 + cq * 4) = acc[b];
        __syncthreads();
        for (int o = tid; o < 512; o += 256) {
            const int b = o >> 6, cc = o & 63; float s = 0.f;
            for (int k = 0; k < 16; ++k) s += red[(k * 8 + b) * 64 + cc];
            ((float*)(p.ws + WS_MOD))[((size_t)l * 8 + b) * 6144 + jb * 64 + cc] = s + p.ada_b[l * 6144 + jb * 64 + cc];
        }
    }
    for (int item = bid; item < NROPE + 1; item += nb) {
        if (item < NROPE) {
            const int idx = item * 256 + tid;
            const int pos = idx >> 5, i = idx & 31;
            const float inv = 1.0f / powf(10000.0f, (float)(2 * i) / 64.0f);
            const float ang = (float)pos * inv;
            ((float*)(p.ws + WS_ROPEC))[idx] = cosf(ang);
            ((float*)(p.ws + WS_ROPES))[idx] = sinf(ang);
        } else {
            if (tid < DEPTH * 32) ((int*)(p.ws + WS_ECNT))[tid * ECS] = 0;
        }
    }
    __syncthreads();
    convert_moe_layers(p, 0, 1, smem, bid, nb, tid);
}

DI void phase_norm(const Params& p, int layer, const float* src, int bid, int nb, int tid) {
    const int lane = tid & 63, wid = tid >> 6;
    const float* mod = (const float*)(p.ws + WS_MOD) + (size_t)layer * 8 * 6144;
    const float* gam = p.norm_mix + layer * 1024;
    bf16_t* H = (bf16_t*)(p.ws + WS_H);
    for (int item = bid; item < T / 4; item += nb) {
        const int t = item * 4 + wid, b = t >> 11;
        const float* xr = src + (size_t)t * 1024;
        f32x4 v[4]; float ss = 0.f;
#pragma unroll
        for (int i = 0; i < 4; ++i) { v[i] = *(const f32x4*)(xr + (lane + 64 * i) * 4); ss += v[i][0] * v[i][0] + v[i][1] * v[i][1] + v[i][2] * v[i][2] + v[i][3] * v[i][3]; }
        ss = wave_sum(ss);
        const float rstd = rsqrtf(ss * (1.f / 1024.f) + EPS);
#pragma unroll
        for (int i = 0; i < 4; ++i) {
            const int c0 = (lane + 64 * i) * 4;
            const f32x4 g = *(const f32x4*)(gam + c0), sh = *(const f32x4*)(mod + b * 6144 + c0), sc = *(const f32x4*)(mod + b * 6144 + 1024 + c0);
            f32x4 h = v[i] * rstd * g * (sc + 1.f) + sh;
            u32x2 o = {pk2(h[0], h[1]), pk2(h[2], h[3])};
            *(u32x2*)(H + (size_t)t * 1024 + c0) = o;
        }
    }
}

DI void phase_ffn_norm_router(const Params& p, int layer, unsigned char* smem, int bid, int nb, int tid) {
    float* rstd_s = (float*)smem;
    float* lg = (float*)(smem + 512);
    float* hs = (float*)(smem + 512 + 32 * 37 * 4);
    float* wcs = (float*)(smem + 5248 + 2 * 32 * 65 * 4);
    const int lane = tid & 63, og = __builtin_amdgcn_readfirstlane(tid >> 6), tok = lane & 31, kh = lane >> 5;
    const float* mod = (const float*)(p.ws + WS_MOD) + (size_t)layer * 8 * 6144;
    const float* gam = p.norm_ffn + layer * 1024;
    const float* wg = p.moe_w_group + (size_t)layer * 1024 * 4;
    const float* we = p.moe_w_expert + (size_t)layer * 1024 * 32;
    bf16_t* H = (bf16_t*)(p.ws + WS_H);
    int* ecnt = (int*)(p.ws + WS_ECNT) + layer * 32 * ECS;
    int* elist = (int*)(p.ws + WS_ELIST);
    float* ew = (float*)(p.ws + WS_EW);
    for (int item = bid; item < T / 32; item += nb) {
        const int t0 = item * 32, b = t0 >> 11;
        __syncthreads();
        if (tid < 32) {
            const f32x4* pp = (const f32x4*)((const float*)(p.ws + WS_PART) + (size_t)(t0 + tid) * 16);
            const f32x4 a = pp[0], b4 = pp[1], c4 = pp[2], d4 = pp[3];
            const float ss = ((a[0] + a[1]) + (a[2] + a[3])) + ((b4[0] + b4[1]) + (b4[2] + b4[3])) + ((c4[0] + c4[1]) + (c4[2] + c4[3])) + ((d4[0] + d4[1]) + (d4[2] + d4[3]));
            rstd_s[tid] = rsqrtf(ss * (1.f / 1024.f) + EPS);
        }
        const int stok = tid >> 3, sk0 = (tid & 7) * 8;
        const float* xrow = p.out + (size_t)(t0 + stok) * 1024 + sk0;
        const float* mrow = mod + b * 6144 + sk0;
        f32x4 xa[2], ga[2], sha[2], sca[2], wa[3], xb[2], gb2[2], shb[2], scb[2], wb2[3];
#define FFN_LOAD(xv, gv, shv, scv, wv, k0) do { _Pragma("unroll") for (int q = 0; q < 2; ++q) { xv[q] = *(const f32x4*)(xrow + (k0) + 4 * q); gv[q] = *(const f32x4*)(gam + sk0 + (k0) + 4 * q); \
            shv[q] = *(const f32x4*)(mrow + 3072 + (k0) + 4 * q); scv[q] = *(const f32x4*)(mrow + 4096 + (k0) + 4 * q); } \
            wv[0] = *(const f32x4*)(we + (k0) * 32 + tid * 4); wv[1] = *(const f32x4*)(we + (k0) * 32 + 1024 + tid * 4); wv[2] = *(const f32x4*)(wg + (k0) * 4 + (tid & 63) * 4); } while (0)
#define FFN_STEP(xv, gv, shv, scv, wv, kc) do { const int k0 = (kc) * 64; float* hb = hs + ((kc) & 1) * (32 * 65); float* wb = wcs + ((kc) & 1) * (64 * 40); u32x4 ho; \
            _Pragma("unroll") for (int q = 0; q < 2; ++q) { const f32x4 h = xv[q] * srstd * gv[q] * (scv[q] + 1.f) + shv[q]; ho[2 * q] = pk2(h[0], h[1]); ho[2 * q + 1] = pk2(h[2], h[3]); \
                float* hp = hb + stok * 65 + sk0 + 4 * q; hp[0] = h[0]; hp[1] = h[1]; hp[2] = h[2]; hp[3] = h[3]; } \
            *(u32x4*)(H + (size_t)(t0 + stok) * 1024 + k0 + sk0) = ho; \
            *(f32x4*)(wb + (tid >> 3) * 40 + 4 + (tid & 7) * 4) = wv[0]; *(f32x4*)(wb + (32 + (tid >> 3)) * 40 + 4 + (tid & 7) * 4) = wv[1]; if (tid < 64) *(f32x4*)(wb + tid * 40) = wv[2]; \
            if ((kc) + 2 < 16) FFN_LOAD(xv, gv, shv, scv, wv, k0 + 128); \
            __syncthreads(); \
            if (og < 3) { const float* hr = hb + tok * 65 + kh * 32; const float* wr_ = wb + kh * 32 * 40 + og * 12; \
                _Pragma("unroll 8") for (int kk = 0; kk < 32; ++kk) { const float hv = hr[kk]; \
                    acc[0] += *(const f32x4*)(wr_ + kk * 40) * hv; acc[1] += *(const f32x4*)(wr_ + kk * 40 + 4) * hv; acc[2] += *(const f32x4*)(wr_ + kk * 40 + 8) * hv; } } } while (0)
        FFN_LOAD(xa, ga, sha, sca, wa, 0);
        FFN_LOAD(xb, gb2, shb, scb, wb2, 64);
        __syncthreads();
        const float srstd = rstd_s[stok];
        f32x4 acc[3];
#pragma unroll
        for (int o = 0; o < 3; ++o) acc[o] = (f32x4){0.f, 0.f, 0.f, 0.f};
        for (int kc = 0; kc < 16; kc += 2) {
            FFN_STEP(xa, ga, sha, sca, wa, kc);
            FFN_STEP(xb, gb2, shb, scb, wb2, kc + 1);
        }
#undef FFN_STEP
#undef FFN_LOAD
        if (og < 3) {
#pragma unroll
            for (int o = 0; o < 3; ++o)
#pragma unroll
                for (int e = 0; e < 4; ++e) { const float v = acc[o][e] + sx_f<32>(acc[o][e]); if (kh == 0) lg[tok * 37 + og * 12 + 4 * o + e] = v; }
        }
        __syncthreads();
        if (tid < 32) {
            const int t = t0 + tid;
            float gl[4]; float gmax = -INFINITY; int gsel = 0;
#pragma unroll
            for (int g = 0; g < 4; ++g) { gl[g] = lg[tid * 37 + g] + p.moe_b_group[layer * 4 + g]; if (gl[g] > gmax) { gmax = gl[g]; gsel = g; } }
            float gsum = 0.f;
#pragma unroll
            for (int g = 0; g < 4; ++g) gsum += __expf(gl[g] - gmax);
            const float pg = 1.f / gsum;
            float v1 = -INFINITY, v2 = -INFINITY; int i1 = 0, i2 = 0;
            for (int jx = 0; jx < 8; ++jx) {
                const float v = lg[tid * 37 + 4 + gsel * 8 + jx] + p.moe_b_expert[layer * 32 + gsel * 8 + jx];
                if (v > v1) { v2 = v1; i2 = i1; v1 = v; i1 = jx; } else if (v > v2) { v2 = v; i2 = jx; }
            }
            const float e2 = __expf(v2 - v1), den = 1.f / (1.f + e2);
            const float w1 = pg * den, w2 = pg * e2 * den;
            const int ea = gsel * 8 + i1, eb = gsel * 8 + i2;
            int* cl = (int*)rstd_s + 32;
            cl[tid] = 0;
            const int la = atomicAdd(&cl[ea], 1);
            const int lb = atomicAdd(&cl[eb], 1);
            { const int n = cl[tid]; cl[32 + tid] = n > 0 ? atomicAdd(&ecnt[tid * ECS], n) : 0; }
            const int ra = cl[32 + ea] + la, rb = cl[32 + eb] + lb;
            elist[(size_t)ea * NASG + ra] = t * 2; ew[t * 2] = w1;
            elist[(size_t)eb * NASG + rb] = t * 2 + 1; ew[t * 2 + 1] = w2;
        }
    }
}

DI bool dense_item(int i, int NT, int xcd, int& tm, int& tn) {
    if (i >= 16 * NT) return false;
    const int mg = i / (8 * NT), r = i % (8 * NT);
    tn = r >> 3; tm = xcd * 16 + mg * 8 + (r & 7);
    return true;
}
template <class PR> DI void phase_hyb_in(const Params& p, int j, unsigned char* smem, int xcd, int lb, int nlb, int tid) {
    int tm, tn;
    for (int i = lb; dense_item(i, 22, xcd, tm, tn); i += nlb) { HybIn pr{&p, j, tm, tn}; gemm_tile(pr, smem, opq(tid)); }
}
DI void phase_ml_in(const Params& p, int j, unsigned char* smem, int xcd, int lb, int nlb, int tid) {
    int tm, tn;
    for (int i = lb; dense_item(i, 25, xcd, tm, tn); i += nlb) { MlIn pr{&p, j, tm, tn}; gemm_tile(pr, smem, opq(tid)); }
}
DI void phase_out_proj(const Params& p, int layer, const float* W, const float* src, unsigned char* smem, int xcd, int lb, int nlb, int tid) {
    int tm, tn;
    for (int i = lb; dense_item(i, 8, xcd, tm, tn); i += nlb) { OutProj pr{&p, W, src, layer, tm, tn}; gemm_tile(pr, smem, opq(tid)); }
}
template <int WHICH> DI void phase_moe(const Params& p, int layer, unsigned char* smem, int xcd, int lb, int nlb, int tid) {
    int* toff = (int*)(smem + 65600);
    __syncthreads();
    if (tid == 0) {
        const int* ecnt = (const int*)(p.ws + WS_ECNT) + layer * 32 * ECS;
        int ta = 0, ra = 0;
        for (int e = 0; e < 32; ++e) {
            const int c = ecnt[e * ECS];
            if ((e & 7) == xcd) { const int q = e >> 3; toff[q] = ta; toff[8 + q] = ra; toff[16 + q] = c; ta += (c + 127) >> 7; }
            ra += c;
        }
        toff[4] = ta;
    }
    __syncthreads();
    const int total = toff[4] * 8;
    for (int item = lb; item < total; item += nlb) {
        const int mg = item >> 3, nt = item & 7;
        int q = 0;
        while (q < 3 && toff[q + 1] <= mg) ++q;
        const int e = q * 8 + xcd, cnt = toff[16 + q], roff = toff[8 + q];
        if (WHICH == 1) { Moe1 pr{&p, layer, e, mg - toff[q], nt, cnt, roff}; gemm_tile(pr, smem, opq(tid)); }
        else { Moe2 pr{&p, layer, e, mg - toff[q], nt, cnt, roff}; gemm_tile(pr, smem, opq(tid)); }
    }
}

DI void phase_combine_norm(const Params& p, int layer, int bid, int nb, int tid) {
    const int lane = tid & 63, wid = tid >> 6;
    const float* mod = (const float*)(p.ws + WS_MOD) + (size_t)layer * 8 * 6144;
    const float* modn = mod + 8 * 6144;
    const float* gam = p.norm_mix + (layer + 1) * 1024;
    const bf16_t* Y = (const bf16_t*)(p.ws + WS_Y);
    const float* ew = (const float*)(p.ws + WS_EW);
    bf16_t* H = (bf16_t*)(p.ws + WS_H);
    const bool has_next = layer + 1 < DEPTH;
    for (int item = bid; item < T / 4; item += nb) {
        const int t = item * 4 + wid, b = t >> 11;
        const float w0 = ew[2 * t], w1 = ew[2 * t + 1];
        f32x4 v[4]; float ss = 0.f;
#pragma unroll
        for (int i = 0; i < 4; ++i) {
            const int c0 = (lane + 64 * i) * 4;
            v[i] = *(const f32x4*)(p.out + (size_t)t * 1024 + c0);
            const f32x4 g = *(const f32x4*)(mod + b * 6144 + 5120 + c0);
            const u32x2 y0 = *(const u32x2*)(Y + (size_t)(2 * t) * 1024 + c0), y1 = *(const u32x2*)(Y + (size_t)(2 * t + 1) * 1024 + c0);
            v[i][0] += g[0] * (w0 * bflo(y0[0]) + w1 * bflo(y1[0])); v[i][1] += g[1] * (w0 * bfhi(y0[0]) + w1 * bfhi(y1[0]));
            v[i][2] += g[2] * (w0 * bflo(y0[1]) + w1 * bflo(y1[1])); v[i][3] += g[3] * (w0 * bfhi(y0[1]) + w1 * bfhi(y1[1]));
            *(f32x4*)(p.out + (size_t)t * 1024 + c0) = v[i];
            ss += v[i][0] * v[i][0] + v[i][1] * v[i][1] + v[i][2] * v[i][2] + v[i][3] * v[i][3];
        }
        if (has_next) {
            ss = wave_sum(ss);
            const float rstd = rsqrtf(ss * (1.f / 1024.f) + EPS);
#pragma unroll
            for (int i = 0; i < 4; ++i) {
                const int c0 = (lane + 64 * i) * 4;
                const f32x4 g = *(const f32x4*)(gam + c0), sh = *(const f32x4*)(modn + b * 6144 + c0), sc = *(const f32x4*)(modn + b * 6144 + 1024 + c0);
                const f32x4 h = v[i] * rstd * g * (sc + 1.f) + sh;
                u32x2 o = {pk2(h[0], h[1]), pk2(h[2], h[3])};
                *(u32x2*)(H + (size_t)t * 1024 + c0) = o;
            }
        }
    }
}

DI unsigned sortable(float f) { const unsigned u = __float_as_uint(f); return (u & 0x80000000u) ? ~u : (u | 0x80000000u); }
DI int half_sum_i(int v) { v += sx_i<16>(v); v += sx_i<8>(v); v += sx_i<4>(v); v += sx_i<2>(v); v += sx_i<1>(v); return v; }

DI void phase_dsa(const Params& p, int j, unsigned char* smem, int bid, int nb, int tid, int cv0 = 0, int cv1 = 0) {
    if (cv1 > cv0 && bid >= (nb >> 1)) convert_moe_layers(p, cv0, cv1, smem, bid, nb, tid);
    const int lane = tid & 63, wid = tid >> 6, c = lane & 31, hh = lane >> 5;
    unsigned* mw = (unsigned*)smem + wid * 256;
    const bf16_t* IQ = (const bf16_t*)(p.ws + WS_IQ);
    const bf16_t* IK = (const bf16_t*)(p.ws + WS_IK);
    const float* IW = (const float*)(p.ws + WS_IW);
    const bf16_t* Q = (const bf16_t*)(p.ws + WS_Q);
    const bf16_t* K = (const bf16_t*)(p.ws + WS_K);
    const bf16_t* VT = (const bf16_t*)(p.ws + WS_V);
    bf16_t* Y = (bf16_t*)(p.ws + WS_YMIX);
    const float gq = wave_max(fabsf(p.hy_q_norm[j * 64 + lane])), gk = wave_max(fabsf(p.hy_k_norm[j * 64 + lane]));
    const float LOG2E = 1.4426950408889634f;
    const float c1 = 0.125f * LOG2E, c2 = 8.f * gq * gk * LOG2E;
    const unsigned lt = (1u << c) - 1u;
    for (int it = bid, rnd = 0; it < 1024; it += nb, ++rnd) {
        const int item = (rnd & 1) ? (rnd + 1) * nb - 1 - bid : it;
        if (item >= 1024) continue;
        const int qt = 127 - (item >> 3), b = item & 7;
        const int pos0 = qt * 16 + 4 * wid;
        const size_t tb = (size_t)b * S, t0 = tb + pos0;
        const int tmax = (pos0 + 3) >> 5;
        if (pos0 >= 256) {
            bf16x8 iqf[4];
            {
                const int i = (c & 3) + 4 * (c >> 3), rh = (c >> 2) & 1, qq = 2 * rh + (i >> 3), hd = i & 7;
                const bf16_t* ip = IQ + (t0 + qq) * 512 + hd * 64 + 8 * hh;
#pragma unroll
                for (int ks = 0; ks < 4; ++ks) iqf[ks] = *(const bf16x8*)(ip + 16 * ks);
            }
            float* wl = (float*)(smem + 4096) + wid * 32 + hh * 16;
            if (c < 4) *(f32x4*)(wl + 4 * c) = *(const f32x4*)(IW + (t0 + 2 * hh) * 8 + 4 * c);
            unsigned sk[64][2];
            const bf16_t* kpi = IK + (tb + c) * 64 + 8 * hh;
            const int lim0 = pos0 + 2 * hh - c;
#pragma unroll
            for (int tile = 0; tile < 64; ++tile) {
                unsigned k0 = 0u, k1 = 0u;
                if (tile <= tmax) {
                    bf16x8 bk[4];
#pragma unroll
                    for (int ks = 0; ks < 4; ++ks) bk[ks] = *(const bf16x8*)(kpi + 16 * ks);
                    kpi += 32 * 64;
                    asm volatile("" : "+v"(kpi));
                    f32x16 acc;
#pragma unroll
                    for (int r = 0; r < 16; ++r) acc[r] = 0.f;
#pragma unroll
                    for (int ks = 0; ks < 4; ++ks) acc = __builtin_amdgcn_mfma_f32_32x32x16_bf16(iqf[ks], bk[ks], acc, 0, 0, 0);
                    float s0 = 0.f, s1 = 0.f;
#pragma unroll
                    for (int q4 = 0; q4 < 2; ++q4) {
                        const f32x4 wa = *(const f32x4*)(wl + 4 * q4), wb = *(const f32x4*)(wl + 8 + 4 * q4);
#pragma unroll
                        for (int e = 0; e < 4; ++e) { s0 += fmaxf(acc[4 * q4 + e], 0.f) * wa[e]; s1 += fmaxf(acc[8 + 4 * q4 + e], 0.f) * wb[e]; }
                    }
                    k0 = tile * 32 <= lim0 ? sortable(s0) : 0u;
                    k1 = tile * 32 <= lim0 + 1 ? sortable(s1) : 0u;
                }
                sk[tile][0] = k0; sk[tile][1] = k1;
            }
            unsigned v0 = 0u, v1 = 0u; bool d0 = false, d1 = false;
            const int tg = tmax >> 3;
            for (int bit = 31; bit >= 0; --bit) {
                const unsigned c0 = v0 | (1u << bit), c1b = v1 | (1u << bit);
                int n0 = 0, n1 = 0;
#pragma unroll
                for (int g = 0; g < 8; ++g) {
                    if (g <= tg) {
#pragma unroll
                        for (int u = 0; u < 8; ++u) { n0 += sk[g * 8 + u][0] >= c0 ? 1 : 0; n1 += sk[g * 8 + u][1] >= c1b ? 1 : 0; }
                    }
                }
                const int n01 = half_sum_i(n0 | (n1 << 16));
                n0 = n01 & 0xffff; n1 = n01 >> 16;
                if (!d0 && n0 >= 256) { v0 = c0; d0 = n0 == 256; }
                if (!d1 && n1 >= 256) { v1 = c1b; d1 = n1 == 256; }
                if (__all(d0 && d1)) break;
            }
            int g0 = 0, g1 = 0;
#pragma unroll
            for (int g = 0; g < 8; ++g) {
                if (g <= tg) {
#pragma unroll
                    for (int u = 0; u < 8; ++u) { g0 += sk[g * 8 + u][0] > v0 ? 1 : 0; g1 += sk[g * 8 + u][1] > v1 ? 1 : 0; }
                }
            }
            const int g01 = half_sum_i(g0 | (g1 << 16));
            const int need0 = 256 - (g01 & 0xffff), need1 = 256 - (g01 >> 16);
            int run0 = 0, run1 = 0;
#pragma unroll
            for (int tile = 0; tile < 64; ++tile) {
                if (tile <= tmax) {
                    const unsigned k0 = sk[tile][0], k1 = sk[tile][1];
                    const bool tie0 = k0 == v0, tie1 = k1 == v1;
                    const unsigned long long tb0 = __ballot(tie0), tb1 = __ballot(tie1);
                    const unsigned th0 = hh ? (unsigned)(tb0 >> 32) : (unsigned)tb0, th1 = hh ? (unsigned)(tb1 >> 32) : (unsigned)tb1;
                    const bool sel0 = k0 > v0 || (tie0 && run0 + __popc(th0 & lt) < need0);
                    const bool sel1 = k1 > v1 || (tie1 && run1 + __popc(th1 & lt) < need1);
                    run0 += __popc(th0); run1 += __popc(th1);
                    const unsigned long long sb0 = __ballot(sel0), sb1 = __ballot(sel1);
                    if (lane == 0) { u32x4 o = {(unsigned)sb0, (unsigned)sb1, (unsigned)(sb0 >> 32), (unsigned)(sb1 >> 32)}; *(u32x4*)(mw + tile * 4) = o; }
                }
            }
        } else {
            const int tile = lane >> 2, qq = lane & 3, pq = pos0 + qq;
            if (tile <= tmax) {
                unsigned m;
                if (32 * tile + 31 <= pq) m = 0xffffffffu; else if (32 * tile > pq) m = 0u; else m = (2u << (pq - 32 * tile)) - 1u;
                mw[tile * 4 + qq] = m;
            }
        }
        bf16x8 qf[4];
        {
            const bf16_t* qp = Q + (t0 + (c >> 3)) * 512 + (c & 7) * 64 + 8 * hh;
#pragma unroll
            for (int ks = 0; ks < 4; ++ks) qf[ks] = *(const bf16x8*)(qp + 16 * ks);
        }
        f32x16 o0, o1;
#pragma unroll
        for (int r = 0; r < 16; ++r) { o0[r] = 0.f; o1[r] = 0.f; }
        float lsum = 0.f;
        const int kperm = (c & ~12) | ((c & 4) << 1) | ((c & 8) >> 1);
        const bf16_t* kp = K + (tb + kperm) * 64 + 8 * hh;
        const bf16_t* vp = VT + ((size_t)(b * 64 + c)) * S + 8 * hh;
        bf16x8 kf[4], vf[4];
#pragma unroll
        for (int ks = 0; ks < 4; ++ks) kf[ks] = *(const bf16x8*)(kp + 16 * ks);
        vf[0] = *(const bf16x8*)(vp); vf[1] = *(const bf16x8*)(vp + (size_t)32 * S); vf[2] = *(const bf16x8*)(vp + 16); vf[3] = *(const bf16x8*)(vp + (size_t)32 * S + 16);
        for (int tile = 0; tile <= tmax; ++tile) {
            const unsigned mword = mw[tile * 4 + (c >> 3)];
            bf16x8 kc[4], vc[4];
#pragma unroll
            for (int ks = 0; ks < 4; ++ks) { kc[ks] = kf[ks]; vc[ks] = vf[ks]; }
            if (tile < tmax) {
                kp += 32 * 64; vp += 32;
#pragma unroll
                for (int ks = 0; ks < 4; ++ks) kf[ks] = *(const bf16x8*)(kp + 16 * ks);
                vf[0] = *(const bf16x8*)(vp); vf[1] = *(const bf16x8*)(vp + (size_t)32 * S); vf[2] = *(const bf16x8*)(vp + 16); vf[3] = *(const bf16x8*)(vp + (size_t)32 * S + 16);
            }
            f32x16 x;
#pragma unroll
            for (int r = 0; r < 16; ++r) x[r] = 0.f;
#pragma unroll
            for (int ks = 0; ks < 4; ++ks) x = __builtin_amdgcn_mfma_f32_32x32x16_bf16(kc[ks], qf[ks], x, 0, 0, 0);
#pragma unroll
            for (int s = 0; s < 2; ++s) {
                const unsigned bits = mword >> (16 * s + 8 * hh);
                float pr[8];
#pragma unroll
                for (int jx = 0; jx < 8; ++jx) {
                    const float e = __builtin_amdgcn_exp2f(x[8 * s + jx] * c1 - c2);
                    pr[jx] = __uint_as_float(__float_as_uint(e) & (unsigned)__builtin_amdgcn_sbfe((int)bits, jx, 1));
                    lsum += pr[jx];
                }
                u32x4 pk = {pk2(pr[0], pr[1]), pk2(pr[2], pr[3]), pk2(pr[4], pr[5]), pk2(pr[6], pr[7])};
                const bf16x8 pf = __builtin_bit_cast(bf16x8, pk);
                o0 = __builtin_amdgcn_mfma_f32_32x32x16_bf16(vc[2 * s], pf, o0, 0, 0, 0);
                o1 = __builtin_amdgcn_mfma_f32_32x32x16_bf16(vc[2 * s + 1], pf, o1, 0, 0, 0);
            }
        }
        lsum += sx_f<32>(lsum);
        const float inv = 1.f / lsum;
        bf16_t* yp = Y + (t0 + (c >> 3)) * 1024 + (c & 7) * 64 + 4 * hh;
#pragma unroll
        for (int g4 = 0; g4 < 4; ++g4) {
            u32x2 a = {pk2(o0[4 * g4] * inv, o0[4 * g4 + 1] * inv), pk2(o0[4 * g4 + 2] * inv, o0[4 * g4 + 3] * inv)};
            u32x2 bq = {pk2(o1[4 * g4] * inv, o1[4 * g4 + 1] * inv), pk2(o1[4 * g4 + 2] * inv, o1[4 * g4 + 3] * inv)};
            *(u32x2*)(yp + 8 * g4) = a;
            *(u32x2*)(yp + 32 + 8 * g4) = bq;
        }
    }
    if (cv1 > cv0 && bid < (nb >> 1)) convert_moe_layers(p, cv0, cv1, smem, bid, nb, tid);
}

DI void phase_conv(const Params& p, int j, int bid, int nb, int tid) {
    const bf16_t* Z = (const bf16_t*)(p.ws + WS_Z);
    const bf16_t* BG = (const bf16_t*)(p.ws + WS_BG);
    bf16_t* Y = (bf16_t*)(p.ws + WS_YMIX);
    const float* cw = p.hy_conv_w + (size_t)j * 3 * 512;
    for (int item = bid; item < T / 4; item += nb) {
        const int t = item * 4 + (tid >> 6), c0 = (tid & 63) * 8, pos = t & (S - 1);
        float acc[8];
#pragma unroll
        for (int e = 0; e < 8; ++e) acc[e] = 0.f;
#pragma unroll
        for (int jj = 0; jj < 3; ++jj) {
            const int dp = jj - 2;
            if (pos + dp >= 0) {
                const u32x4 z = *(const u32x4*)(Z + (size_t)(t + dp) * 512 + c0);
#pragma unroll
                for (int e = 0; e < 4; ++e) { acc[2 * e] += cw[jj * 512 + c0 + 2 * e] * bflo(z[e]); acc[2 * e + 1] += cw[jj * 512 + c0 + 2 * e + 1] * bfhi(z[e]); }
            }
        }
        const u32x4 g = *(const u32x4*)(BG + (size_t)t * 512 + c0);
        u32x4 o;
#pragma unroll
        for (int e = 0; e < 4; ++e) o[e] = pk2(acc[2 * e] * bflo(g[e]), acc[2 * e + 1] * bfhi(g[e]));
        *(u32x4*)(Y + (size_t)t * 1024 + 512 + c0) = o;
    }
}

DI float wave_incl_sum(float x, int lane) { for (int d = 1; d < 64; d <<= 1) { const float t = lane_get_f(x, lane >= d ? lane - d : lane); if (lane >= d) x += t; } return x; }
DI float wave_incl_max(float x, int lane) { for (int d = 1; d < 64; d <<= 1) { const float t = lane_get_f(x, lane >= d ? lane - d : lane); if (lane >= d) x = fmaxf(x, t); } return x; }
DI bf16x8 scale_frag(bf16x8 f, const float* w8) {
    const u32x4 u = __builtin_bit_cast(u32x4, f);
    u32x4 o;
#pragma unroll
    for (int e = 0; e < 4; ++e) o[e] = pk2(bflo(u[e]) * w8[2 * e], bfhi(u[e]) * w8[2 * e + 1]);
    return __builtin_bit_cast(bf16x8, o);
}

DI void phase_ml1(const Params& p, unsigned char* smem, int bid, int nb, int tid) {
    const int lane = tid & 63, wid = tid >> 6, c = lane & 31, hh = lane >> 5;
    float* wsl = (float*)smem + wid * 64;
    const bf16_t* KT = (const bf16_t*)(p.ws + WS_MKT);
    const bf16_t* VT = (const bf16_t*)(p.ws + WS_MV);
    const float* MIG = (const float*)(p.ws + WS_MIG);
    const float* MFG = (const float*)(p.ws + WS_MFG);
    float* UB = (float*)(p.ws + WS_UBUF);
    float* UN = (float*)(p.ws + WS_UNBUF);
    float* ML = (float*)(p.ws + WS_MLOC);
    for (int item = bid; item < 2048; item += nb) {
        const int bh = item >> 5, ch = item & 31, b = bh >> 3, h = bh & 7;
        const size_t tb = (size_t)b * S + ch * 64;
        const float lf = MFG[(tb + lane) * 8 + h], ig = MIG[(tb + lane) * 8 + h];
        const float bc = wave_incl_sum(lf, lane);
        const float blast = lane_get_f(bc, 63);
        const float g = blast - bc + ig;
        const float gmax = wave_max(g);
        wsl[lane] = __expf(g - gmax);
        if (wid == 0 && lane == 0) { ML[item * 2] = blast; ML[item * 2 + 1] = gmax; }
        f32x16 u0, u1;
#pragma unroll
        for (int r = 0; r < 16; ++r) { u0[r] = 0.f; u1[r] = 0.f; }
        const bf16_t* vp = VT + ((size_t)(bh * 128 + wid * 32 + c)) * S + ch * 64 + 8 * hh;
        const bf16_t* kp = KT + ((size_t)(bh * 64 + c)) * S + ch * 64 + 8 * hh;
#pragma unroll
        for (int ks = 0; ks < 4; ++ks) {
            float w8[8];
            const f32x4 wa = *(const f32x4*)(wsl + 16 * ks + 8 * hh), wb = *(const f32x4*)(wsl + 16 * ks + 8 * hh + 4);
            w8[0] = wa[0]; w8[1] = wa[1]; w8[2] = wa[2]; w8[3] = wa[3]; w8[4] = wb[0]; w8[5] = wb[1]; w8[6] = wb[2]; w8[7] = wb[3];
            const bf16x8 va = *(const bf16x8*)(vp + 16 * ks);
            const bf16x8 k0 = scale_frag(*(const bf16x8*)(kp + 16 * ks), w8);
            const bf16x8 k1 = scale_frag(*(const bf16x8*)(kp + (size_t)32 * S + 16 * ks), w8);
            u0 = __builtin_amdgcn_mfma_f32_32x32x16_bf16(va, k0, u0, 0, 0, 0);
            u1 = __builtin_amdgcn_mfma_f32_32x32x16_bf16(va, k1, u1, 0, 0, 0);
        }
        float* up = UB + ((size_t)item * 128 + wid * 32) * 64 + c;
#pragma unroll
        for (int r = 0; r < 16; ++r) { const int v = crow(r, lane); up[v * 64] = u0[r]; up[v * 64 + 32] = u1[r]; }
        if (wid == 0) {
            const u32x4* kr = (const u32x4*)(KT + ((size_t)(bh * 64 + lane)) * S + ch * 64);
            float a = 0.f;
#pragma unroll
            for (int q = 0; q < 8; ++q) { const u32x4 u = kr[q];
#pragma unroll
                for (int e = 0; e < 4; ++e) a += wsl[q * 8 + 2 * e] * bflo(u[e]) + wsl[q * 8 + 2 * e + 1] * bfhi(u[e]); }
            UN[(size_t)item * 64 + lane] = a;
        }
    }
}

DI void phase_ml2(const Params& p, unsigned char* smem, int bid, int nb, int tid) {
    float* dec = (float*)smem;
    float* scl = dec + 32;
    const float* UB = (const float*)(p.ws + WS_UBUF);
    const float* UN = (const float*)(p.ws + WS_UNBUF);
    const float* ML = (const float*)(p.ws + WS_MLOC);
    bf16_t* CB = (bf16_t*)(p.ws + WS_CBUF);
    float* NBF = (float*)(p.ws + WS_NBUF);
    float* MST = (float*)(p.ws + WS_MST);
    for (int item = bid; item < 512; item += nb) {
        const int bh = item >> 3, sl = item & 7;
        __syncthreads();
        if (tid == 0) {
            float m = 0.f;
            for (int ch = 0; ch < 32; ++ch) {
                const float bl = ML[(bh * 32 + ch) * 2], gm = ML[(bh * 32 + ch) * 2 + 1];
                const float mn = fmaxf(bl + m, gm);
                dec[ch] = __expf(bl + m - mn); scl[ch] = __expf(gm - mn);
                if (sl == 0) MST[bh * 32 + ch] = m;
                m = mn;
            }
        }
        __syncthreads();
        f32x4 st = {0.f, 0.f, 0.f, 0.f};
        const size_t e0 = (size_t)sl * 1024 + tid * 4;
        f32x4 ub[32];
#pragma unroll
        for (int ch = 0; ch < 32; ++ch) ub[ch] = *(const f32x4*)(UB + ((size_t)(bh * 32 + ch)) * 8192 + e0);
#pragma unroll
        for (int ch = 0; ch < 32; ++ch) {
            st = st * dec[ch] + ub[ch] * scl[ch];
            u32x2 o = {pk2(st[0], st[1]), pk2(st[2], st[3])};
            *(u32x2*)(CB + ((size_t)(bh * 32 + ch)) * 8192 + e0) = o;
        }
        if (sl == 0 && tid < 64) {
            float nst = 0.f, un[32];
#pragma unroll
            for (int ch = 0; ch < 32; ++ch) un[ch] = UN[(size_t)(bh * 32 + ch) * 64 + tid];
#pragma unroll
            for (int ch = 0; ch < 32; ++ch) { nst = nst * dec[ch] + un[ch] * scl[ch]; NBF[(size_t)(bh * 32 + ch) * 64 + tid] = nst; }
        }
    }
}

DI void phase_ml3(const Params& p, int j, unsigned char* smem, int bid, int nb, int tid) {
    const int lane = tid & 63, wid = tid >> 6, c = lane & 31, hh = lane >> 5;
    float* al = (float*)smem + wid * 64;
    float* ssum = (float*)smem + 256;
    const bf16_t* MQ = (const bf16_t*)(p.ws + WS_MQ);
    const bf16_t* MK = (const bf16_t*)(p.ws + WS_MK);
    const bf16_t* VT = (const bf16_t*)(p.ws + WS_MV);
    const float* MIG = (const float*)(p.ws + WS_MIG);
    const float* MFG = (const float*)(p.ws + WS_MFG);
    const bf16_t* MOG = (const bf16_t*)(p.ws + WS_MOG);
    const bf16_t* CB = (const bf16_t*)(p.ws + WS_CBUF);
    const float* NBF = (const float*)(p.ws + WS_NBUF);
    const float* MST = (const float*)(p.ws + WS_MST);
    bf16_t* Y = (bf16_t*)(p.ws + WS_YMIX);
    const int kperm = (c & ~12) | ((c & 4) << 1) | ((c & 8) >> 1);
    for (int item = bid; item < 2048; item += nb) {
        const int bh = item >> 5, ch = item & 31, b = bh >> 3, h = bh & 7;
        const size_t tb = (size_t)b * S + ch * 64;
        const float lf = MFG[(tb + lane) * 8 + h], ig = MIG[(tb + lane) * 8 + h];
        const float bc = wave_incl_sum(lf, lane);
        const float av = ig - bc;
        const float mprev = MST[item];
        const float Mv = fmaxf(mprev, wave_incl_max(av, lane));
        __syncthreads();
        al[lane] = av;
        float Mt[2], wint[2], emt[2];
#pragma unroll
        for (int tt = 0; tt < 2; ++tt) { Mt[tt] = lane_get_f(Mv, 32 * tt + c); wint[tt] = __expf(mprev - Mt[tt]); emt[tt] = __expf(-(lane_get_f(bc, 32 * tt + c) + Mt[tt])); }
        bf16x8 qf[2][4], kf[2][4];
#pragma unroll
        for (int tt = 0; tt < 2; ++tt) {
            const bf16_t* qp = MQ + (tb + 32 * tt + c) * 512 + h * 64 + 8 * hh;
            const bf16_t* kp = MK + (tb + 32 * tt + kperm) * 512 + h * 64 + 8 * hh;
#pragma unroll
            for (int ks = 0; ks < 4; ++ks) { qf[tt][ks] = *(const bf16x8*)(qp + 16 * ks); kf[tt][ks] = *(const bf16x8*)(kp + 16 * ks); }
        }
        f32x16 o[2];
#pragma unroll
        for (int tt = 0; tt < 2; ++tt)
#pragma unroll
            for (int r = 0; r < 16; ++r) o[tt][r] = 0.f;
        float nq[2] = {0.f, 0.f};
        if (ch > 0) {
            const bf16_t* cp = CB + ((size_t)(item - 1) * 128 + wid * 32 + c) * 64 + 8 * hh;
            const float* np = NBF + (size_t)(item - 1) * 64 + 8 * hh;
#pragma unroll
            for (int ks = 0; ks < 4; ++ks) {
                const bf16x8 cf = *(const bf16x8*)(cp + 16 * ks);
                o[0] = __builtin_amdgcn_mfma_f32_32x32x16_bf16(cf, qf[0][ks], o[0], 0, 0, 0);
                o[1] = __builtin_amdgcn_mfma_f32_32x32x16_bf16(cf, qf[1][ks], o[1], 0, 0, 0);
                const f32x4 n0 = *(const f32x4*)(np + 16 * ks), n1 = *(const f32x4*)(np + 16 * ks + 4);
#pragma unroll
                for (int tt = 0; tt < 2; ++tt) {
                    const u32x4 u = __builtin_bit_cast(u32x4, qf[tt][ks]);
                    nq[tt] += n0[0] * bflo(u[0]) + n0[1] * bfhi(u[0]) + n0[2] * bflo(u[1]) + n0[3] * bfhi(u[1]) + n1[0] * bflo(u[2]) + n1[1] * bfhi(u[2]) + n1[2] * bflo(u[3]) + n1[3] * bfhi(u[3]);
                }
            }
#pragma unroll
            for (int tt = 0; tt < 2; ++tt) {
                nq[tt] += sx_f<32>(nq[tt]);
#pragma unroll
                for (int r = 0; r < 16; ++r) o[tt][r] *= wint[tt];
            }
        }
        float csum[2] = {0.f, 0.f};
        const bf16_t* vp = VT + ((size_t)(bh * 128 + wid * 32 + c)) * S + ch * 64 + 8 * hh;
#pragma unroll
        for (int tt = 0; tt < 2; ++tt) {
#pragma unroll
            for (int st = 0; st <= tt; ++st) {
                f32x16 x;
#pragma unroll
                for (int r = 0; r < 16; ++r) x[r] = 0.f;
#pragma unroll
                for (int ks = 0; ks < 4; ++ks) x = __builtin_amdgcn_mfma_f32_32x32x16_bf16(kf[st][ks], qf[tt][ks], x, 0, 0, 0);
#pragma unroll
                for (int k2 = 0; k2 < 2; ++k2) {
                    const int s0 = 32 * st + 16 * k2 + 8 * hh;
                    const f32x4 a0 = *(const f32x4*)(al + s0), a1 = *(const f32x4*)(al + s0 + 4);
                    const float a8[8] = {a0[0], a0[1], a0[2], a0[3], a1[0], a1[1], a1[2], a1[3]};
                    float pr[8];
#pragma unroll
                    for (int jx = 0; jx < 8; ++jx) {
                        const float e = __expf(a8[jx] - Mt[tt]) * x[8 * k2 + jx];
                        pr[jx] = (st < tt || s0 + jx <= 32 * tt + c) ? e : 0.f;
                        csum[tt] += pr[jx];
                    }
                    u32x4 pk = {pk2(pr[0], pr[1]), pk2(pr[2], pr[3]), pk2(pr[4], pr[5]), pk2(pr[6], pr[7])};
                    const bf16x8 vf = *(const bf16x8*)(vp + 32 * st + 16 * k2);
                    o[tt] = __builtin_amdgcn_mfma_f32_32x32x16_bf16(vf, __builtin_bit_cast(bf16x8, pk), o[tt], 0, 0, 0);
                }
            }
        }
        float ss[2];
#pragma unroll
        for (int tt = 0; tt < 2; ++tt) {
            csum[tt] += sx_f<32>(csum[tt]);
            const float den = wint[tt] * nq[tt] + csum[tt];
            const float rd = 1.f / fmaxf(fabsf(den), emt[tt]);
            float s2 = 0.f;
#pragma unroll
            for (int r = 0; r < 16; ++r) { o[tt][r] *= rd; s2 += o[tt][r] * o[tt][r]; }
            s2 += sx_f<32>(s2);
            ss[tt] = s2;
            if (hh == 0) ssum[wid * 64 + 32 * tt + c] = s2;
        }
        __syncthreads();
#pragma unroll
        for (int tt = 0; tt < 2; ++tt) {
            const int tcol = 32 * tt + c;
            const float tot = ssum[tcol] + ssum[64 + tcol] + ssum[128 + tcol] + ssum[192 + tcol];
            const float rstd = rsqrtf(tot * (1.f / 128.f) + EPS);
            const size_t ro = (tb + tcol) * 1024 + h * 128 + wid * 32 + 4 * hh;
            const float* gp = p.ml_out_norm + j * 1024 + h * 128 + wid * 32 + 4 * hh;
#pragma unroll
            for (int g4 = 0; g4 < 4; ++g4) {
                const f32x4 gm = *(const f32x4*)(gp + 8 * g4);
                const u32x2 og = *(const u32x2*)(MOG + ro + 8 * g4);
                u32x2 ov = {pk2(o[tt][4 * g4] * rstd * gm[0] * bflo(og[0]), o[tt][4 * g4 + 1] * rstd * gm[1] * bfhi(og[0])),
                            pk2(o[tt][4 * g4 + 2] * rstd * gm[2] * bflo(og[1]), o[tt][4 * g4 + 3] * rstd * gm[3] * bfhi(og[1]))};
                *(u32x2*)(Y + ro + 8 * g4) = ov;
            }
        }
    }
}


namespace pg8 {
#define PG8_LAS __attribute__((address_space(3)))
typedef unsigned short bf16_t;
typedef short bf16x8 __attribute__((ext_vector_type(8)));
typedef float f32x4 __attribute__((ext_vector_type(4)));
typedef unsigned u32x4 __attribute__((ext_vector_type(4)));
constexpr int BM = 256, BK = 64, HALF = 128, HTB = HALF * BK * 2  , STAGE_BYTES = 8 * HTB, NXCD = 8, WGM = 8;

__host__ __device__ __forceinline__ int lds_byte(int r, int c) { const int st = (r >> 4) * 2 + (c >> 5), rr = r & 15, cc = c & 31, ob = rr * 64 + cc * 2; return st * 1024 + (ob ^ (((ob >> 9) & 1) << 5)); }
__host__ __device__ __forceinline__ void stage_rc(int b, int& R, int& C) { const int st = b / 1024, sb = b % 1024, swz = sb ^ (((sb >> 9) & 1) << 5); R = (st >> 1) * 16 + swz / 64; C = (st & 1) * 32 + (swz % 64) / 2; }
__host__ __device__ __forceinline__ int perm32(int rho) { const int n = rho >> 4, i = rho & 15; return 8 * (i >> 2) + 4 * n + (i & 3); }

struct Unit { int pm, pn; };
struct Gemm { const bf16_t* A; const bf16_t* Bt; int M, N, K; };

struct StaticOrder {
    int nM, nN, nwg, G, c;
    __host__ __device__ void init(int M, int N, int G_, int c_) { nM = M / BM; nN = N / BM; nwg = nM * nN; G = G_; c = c_; }
    __host__ __device__ bool next(int i, Unit& u) const {
        const long L = (long)i * G + c; if (L >= nwg) return false;
        int wgid = (int)L; { const int q = nwg / NXCD, r = nwg % NXCD, xcd = wgid % NXCD, off = wgid / NXCD; wgid = (xcd < r ? xcd * (q + 1) : r * (q + 1) + (xcd - r) * q) + off; }
        const int nig = WGM * nN, gid = wgid / nig, fm = gid * WGM, gsz = (nM - fm) < WGM ? (nM - fm) : WGM;
        u.pm = fm + ((wgid % nig) % gsz); u.pn = (wgid % nig) / gsz; return true;
    }
    static constexpr bool GATHER = false;
    __device__ __forceinline__ unsigned a_off(const Unit&, int) const { return 0u; }
    __device__ __forceinline__ void a_ready(const Unit&) const {}
    __device__ __forceinline__ void done(const Unit&) const {}
};


template <class Epi, class Sched, bool ALIGN_EPI = false, bool SP2 = false>
__device__ __forceinline__ void gemm_phase(PG8_LAS unsigned char* lds, const Gemm g, const Sched& S, const Epi& E, int tid512) {
    const int tid = opq(tid512), wid = __builtin_amdgcn_readfirstlane(tid >> 6), lane = tid & 63, wr = wid >> 2, wc = wid & 3, fr = lane & 15, fq = lane >> 4;
    const int K = g.K, nt = K / BK;
    unsigned voffA[2], voffB[2];
    int rowA[2];
#pragma unroll
    for (int i = 0; i < 2; ++i) { int R, C; stage_rc(tid * 16 + i * 8192, R, C); const int Rb = Epi::PERM ? ((R & ~31) + perm32(R & 31)) : R;
        voffA[i] = (unsigned)(R * K + C) * 2u; voffB[i] = (unsigned)(Rb * K + C) * 2u; rowA[i] = R; if (Sched::GATHER) voffA[i] = (unsigned)C * 2u; }
    const size_t kstep = (size_t)(BK * 2);
    const size_t hstep = (size_t)HALF * K * 2;
    const size_t tstep = 2 * hstep;
    const unsigned ldsw = (unsigned)wid * 1024u;
    const int aoff = lds_byte(wr * 64 + fr, fq * 8), boff = lds_byte(wc * 32 + fr, fq * 8);
#define PG8_SA(b, h) (((b) * 2 + (h)) * HTB)
#define PG8_SB(b, h) ((4 + (b) * 2 + (h)) * HTB)
#define PG8_STAGE(bufoff, gbase, voff) do { _Pragma("unroll") for (int _i = 0; _i < 2; ++_i) \
        __builtin_amdgcn_global_load_lds((const unsigned*)((const char*)(gbase) + (voff)[_i]), (PG8_LAS unsigned*)(lds + (bufoff) + ldsw + _i * 8192), 16, 0, 0); } while (0)
#define PG8_LDA(dst, b, h) do { _Pragma("unroll") for (int m = 0; m < 4; ++m) _Pragma("unroll") for (int k = 0; k < 2; ++k) dst[m][k] = *(const PG8_LAS bf16x8*)(lds + PG8_SA(b, h) + aoff + m * 2048 + k * 1024); } while (0)
#define PG8_LDB(dst, b, h) do { _Pragma("unroll") for (int n = 0; n < 2; ++n) _Pragma("unroll") for (int k = 0; k < 2; ++k) dst[n][k] = *(const PG8_LAS bf16x8*)(lds + PG8_SB(b, h) + boff + n * 2048 + k * 1024); } while (0)
#define PG8_MMA(ai, bj, At, Bt) do { __builtin_amdgcn_s_setprio(1); _Pragma("unroll") for (int m = 0; m < 4; ++m) _Pragma("unroll") for (int n = 0; n < 2; ++n) _Pragma("unroll") for (int k = 0; k < 2; ++k) \
        acc[ai][bj][m][n] = __builtin_amdgcn_mfma_f32_16x16x32_bf16(Bt[n][k], At[m][k], acc[ai][bj][m][n], 0, 0, 0); __builtin_amdgcn_s_setprio(0); } while (0)
#define PG8_WAIT_V(n) asm volatile("s_waitcnt vmcnt(" #n ")" ::: "memory")
#define PG8_WAIT_L(n) asm volatile("s_waitcnt lgkmcnt(" #n ")" ::: "memory")
#define PG8_BAR __builtin_amdgcn_s_barrier()
#define PG8_SCHED __builtin_amdgcn_sched_barrier(0)
    unsigned oaC[2][2], oaN[2][2];
#define PG8_GOFF(dst, unit) do { _Pragma("unroll") for (int _h = 0; _h < 2; ++_h) _Pragma("unroll") for (int _i = 0; _i < 2; ++_i) dst[_h][_i] = S.a_off(unit, _h * HALF + rowA[_i]) + voffA[_i]; } while (0)
#define PG8_STAGE_G(bufoff, offs, koff) do { _Pragma("unroll") for (int _i = 0; _i < 2; ++_i) \
        __builtin_amdgcn_global_load_lds((const unsigned*)(((const char*)g.A + (koff)) + (offs)[_i]), (PG8_LAS unsigned*)(lds + (bufoff) + ldsw + _i * 8192), 16, 0, 0); } while (0)
    Unit cur, nxt; int ui = 0;
    if (!S.next(0, cur)) return;
    if constexpr (Sched::GATHER) { PG8_GOFF(oaC, cur); PG8_GOFF(oaN, cur); }
    f32x4 acc[2][2][4][2];
#pragma unroll
    for (int a = 0; a < 2; ++a)
#pragma unroll
        for (int b = 0; b < 2; ++b)
#pragma unroll
            for (int m = 0; m < 4; ++m)
#pragma unroll
                for (int n = 0; n < 2; ++n) acc[a][b][m][n] = (f32x4){0.f, 0.f, 0.f, 0.f};
    bf16x8 At[4][2], B0[2][2], B1[2][2];
    const char* cA = (const char*)g.A + (size_t)cur.pm * tstep; const char* cB = (const char*)g.Bt + (size_t)cur.pn * tstep;
    S.a_ready(cur);
    if constexpr (SP2) {
        PG8_STAGE(PG8_SB(0, 0), cB, voffB); PG8_STAGE(PG8_SB(0, 1), cB + hstep, voffB);
        if constexpr (Sched::GATHER) { PG8_STAGE_G(PG8_SA(0, 0), oaC[0], 0); PG8_STAGE_G(PG8_SA(0, 1), oaC[1], 0); } else { PG8_STAGE(PG8_SA(0, 0), cA, voffA); PG8_STAGE(PG8_SA(0, 1), cA + hstep, voffA); }
        if (wr == 1) PG8_BAR;
        PG8_WAIT_V(2); PG8_BAR;
        PG8_STAGE(PG8_SB(1, 0), cB + kstep, voffB);
        if constexpr (Sched::GATHER) PG8_STAGE_G(PG8_SA(1, 0), oaC[0], kstep); else PG8_STAGE(PG8_SA(1, 0), cA + kstep, voffA);
        PG8_STAGE(PG8_SB(1, 1), cB + hstep + kstep, voffB);
        PG8_WAIT_V(6); PG8_BAR;
    } else {
        PG8_STAGE(PG8_SB(0, 0), cB, voffB); PG8_STAGE(PG8_SA(0, 0), cA, voffA); PG8_STAGE(PG8_SB(0, 1), cB + hstep, voffB); PG8_STAGE(PG8_SA(0, 1), cA + hstep, voffA);
        if (wr == 1) PG8_BAR;
        PG8_WAIT_V(4); PG8_BAR;
        PG8_STAGE(PG8_SB(1, 0), cB + kstep, voffB); PG8_STAGE(PG8_SA(1, 0), cA + kstep, voffA); PG8_STAGE(PG8_SB(1, 1), cB + hstep + kstep, voffB);
        PG8_WAIT_V(6); PG8_BAR;
    }
    for (;;) {
        const bool has_next = S.next(ui + 1, nxt);
        const char* nA = has_next ? (const char*)g.A + (size_t)nxt.pm * tstep : cA; const char* nB = has_next ? (const char*)g.Bt + (size_t)nxt.pn * tstep : cB;
        for (int t = 0; t < nt; t += 2) {
            const bool last = (t == nt - 2);
            const char* a1 = cA + (size_t)(t + 1) * kstep;
            const char* a2 = last ? nA : cA + (size_t)(t + 2) * kstep; const char* b2 = last ? nB : cB + (size_t)(t + 2) * kstep;
            const char* a3 = a2 + kstep; const char* b3 = b2 + kstep;
            if (last && has_next) S.a_ready(nxt);
            unsigned oaS[2][2]; size_t k2 = 0;
            if constexpr (Sched::GATHER) {
                if (last && has_next) PG8_GOFF(oaN, nxt);
                const bool fromN = last && has_next;
#pragma unroll
                for (int _h = 0; _h < 2; ++_h)
#pragma unroll
                    for (int _i = 0; _i < 2; ++_i) oaS[_h][_i] = fromN ? oaN[_h][_i] : oaC[_h][_i];
                k2 = last ? (size_t)0 : (size_t)(t + 2) * kstep;
            }
            if constexpr (SP2) {
            PG8_LDB(B0, 0, 0); PG8_LDB(B1, 0, 1); PG8_SCHED; PG8_LDA(At, 0, 0);
            if constexpr (Sched::GATHER) PG8_STAGE_G(PG8_SA(1, 1), oaC[1], (size_t)(t + 1) * kstep); else PG8_STAGE(PG8_SA(1, 1), a1 + hstep, voffA);
            PG8_WAIT_V(8); PG8_WAIT_L(0); PG8_BAR; PG8_MMA(0, 0, At, B0); PG8_MMA(0, 1, At, B1); PG8_BAR; PG8_SCHED;
            PG8_LDA(At, 0, 1); PG8_STAGE(PG8_SB(0, 0), b2, voffB); PG8_STAGE(PG8_SB(0, 1), b2 + hstep, voffB);
            if constexpr (Sched::GATHER) PG8_STAGE_G(PG8_SA(0, 0), oaS[0], k2); else PG8_STAGE(PG8_SA(0, 0), a2, voffA);
            PG8_WAIT_V(8); PG8_WAIT_L(0); PG8_BAR; PG8_MMA(1, 0, At, B0); PG8_MMA(1, 1, At, B1); PG8_BAR; PG8_SCHED;
            PG8_LDB(B0, 1, 0); PG8_LDB(B1, 1, 1); PG8_SCHED; PG8_LDA(At, 1, 0);
            if constexpr (Sched::GATHER) PG8_STAGE_G(PG8_SA(0, 1), oaS[1], k2); else PG8_STAGE(PG8_SA(0, 1), a2 + hstep, voffA);
            PG8_WAIT_V(8); PG8_WAIT_L(0); PG8_BAR; PG8_MMA(0, 0, At, B0); PG8_MMA(0, 1, At, B1); PG8_BAR; PG8_SCHED;
            PG8_LDA(At, 1, 1); PG8_STAGE(PG8_SB(1, 0), b3, voffB); PG8_STAGE(PG8_SB(1, 1), b3 + hstep, voffB);
            if constexpr (Sched::GATHER) PG8_STAGE_G(PG8_SA(1, 0), oaS[0], k2 + kstep); else PG8_STAGE(PG8_SA(1, 0), a3, voffA);
            PG8_WAIT_V(8); PG8_WAIT_L(0); PG8_BAR; PG8_MMA(1, 0, At, B0); PG8_MMA(1, 1, At, B1); PG8_BAR; PG8_SCHED;
            } else {
            PG8_LDB(B0, 0, 0); PG8_SCHED; PG8_LDA(At, 0, 0); PG8_STAGE(PG8_SA(1, 1), a1 + hstep, voffA);
            PG8_WAIT_L(8); PG8_BAR; PG8_WAIT_L(0); PG8_MMA(0, 0, At, B0); PG8_BAR; PG8_SCHED;
            PG8_LDB(B1, 0, 1); PG8_STAGE(PG8_SB(0, 0), b2, voffB);
            PG8_BAR; PG8_WAIT_L(0); PG8_MMA(0, 1, At, B1); PG8_BAR;
            PG8_LDA(At, 0, 1); PG8_STAGE(PG8_SA(0, 0), a2, voffA);
            PG8_BAR; PG8_WAIT_L(0); PG8_MMA(1, 0, At, B0); PG8_BAR; PG8_SCHED;
            PG8_STAGE(PG8_SB(0, 1), b2 + hstep, voffB);
            PG8_WAIT_V(6); PG8_BAR; PG8_MMA(1, 1, At, B1); PG8_BAR;
            PG8_LDB(B0, 1, 0); PG8_SCHED; PG8_LDA(At, 1, 0); PG8_STAGE(PG8_SA(0, 1), a2 + hstep, voffA);
            PG8_WAIT_L(8); PG8_BAR; PG8_WAIT_L(0); PG8_MMA(0, 0, At, B0); PG8_BAR; PG8_SCHED;
            PG8_LDB(B1, 1, 1); PG8_STAGE(PG8_SB(1, 0), b3, voffB);
            PG8_BAR; PG8_WAIT_L(0); PG8_MMA(0, 1, At, B1); PG8_BAR;
            PG8_LDA(At, 1, 1); PG8_STAGE(PG8_SA(1, 0), a3, voffA);
            PG8_BAR; PG8_WAIT_L(0); PG8_MMA(1, 0, At, B0); PG8_BAR; PG8_SCHED;
            PG8_STAGE(PG8_SB(1, 1), b3 + hstep, voffB);
            PG8_WAIT_V(6); PG8_BAR; PG8_MMA(1, 1, At, B1); PG8_BAR;
            }
        }
        if constexpr (ALIGN_EPI) { if (wr == 0) PG8_BAR; }
        if constexpr (!Epi::AFTER_DRAIN) { E(acc, cur, wr, wc, fr, fq); S.done(cur); }
        if (!has_next) break;
#pragma unroll
        for (int a = 0; a < 2; ++a)
#pragma unroll
            for (int b = 0; b < 2; ++b)
#pragma unroll
                for (int m = 0; m < 4; ++m)
#pragma unroll
                    for (int n = 0; n < 2; ++n) acc[a][b][m][n] = (f32x4){0.f, 0.f, 0.f, 0.f};
        cur = nxt; cA = nA; cB = nB; ++ui;
        if constexpr (Sched::GATHER) {
#pragma unroll
            for (int _h = 0; _h < 2; ++_h)
#pragma unroll
                for (int _i = 0; _i < 2; ++_i) oaC[_h][_i] = oaN[_h][_i];
        }
        if constexpr (ALIGN_EPI) { if (wr == 1) PG8_BAR; }
    }
    PG8_WAIT_V(0);
    if constexpr (!ALIGN_EPI) { if (wr == 0) PG8_BAR; }
    PG8_BAR;
    if constexpr (Epi::AFTER_DRAIN) { E.fused(acc, cur, wr, wc, fr, fq, lds, wid, lane); S.done(cur); }
#undef PG8_GOFF
#undef PG8_STAGE_G
#undef PG8_SA
#undef PG8_SB
#undef PG8_STAGE
#undef PG8_LDA
#undef PG8_LDB
#undef PG8_MMA
#undef PG8_WAIT_V
#undef PG8_WAIT_L
#undef PG8_BAR
#undef PG8_SCHED
}
}

struct OutEpi8 {
    static constexpr bool PERM = false, AFTER_DRAIN = false;
    const float* src; float* dst; const float* gate; float* part;
    __device__ __forceinline__ void operator()(const pg8::f32x4 (&acc)[2][2][4][2], const pg8::Unit& u, int wr, int wc, int fr, int fq) const {
#pragma unroll
        for (int ai = 0; ai < 2; ++ai)
#pragma unroll
            for (int m = 0; m < 4; ++m) {
                const int t = u.pm * 256 + ai * 128 + wr * 64 + m * 16 + fr;
                const float* gp = gate + (t >> 11) * 6144;
                float ss = 0.f;
#pragma unroll
                for (int bj = 0; bj < 2; ++bj)
#pragma unroll
                    for (int n = 0; n < 2; ++n) {
                        const int col = u.pn * 256 + bj * 128 + wc * 32 + n * 16 + fq * 4;
                        const pg8::f32x4 g = *(const pg8::f32x4*)(gp + col);
                        const pg8::f32x4 o = *(const pg8::f32x4*)(src + (size_t)t * 1024 + col) + g * acc[ai][bj][m][n];
                        *(pg8::f32x4*)(dst + (size_t)t * 1024 + col) = o;
                        ss += o[0] * o[0] + o[1] * o[1] + o[2] * o[2] + o[3] * o[3];
                    }
                ss += sx_f<16>(ss); ss += sx_f<32>(ss);
                if (fq == 0) part[(size_t)t * 16 + u.pn * 4 + wc] = ss;
            }
    }
};


DI unsigned cvtpk(float lo, float hi) { return pk2(lo, hi); }
struct HybEpi8 {
    static constexpr bool PERM = true, AFTER_DRAIN = false;
    const Params* p; int j;
    __device__ __forceinline__ void operator()(const pg8::f32x4 (&acc)[2][2][4][2], const pg8::Unit& u, int wr, int wc, int fr, int fq) const {
        unsigned char* ws = p->ws;
        const int un = u.pn;
        if (un < 5 && !(un == 4 && (wc == 1 || wc == 3))) {
            const bool donorm = un < 2 || (un == 4 && wc == 0);
            bf16_t* ob; int ld, cb; const float* gam = p->hy_q_norm + j * 64;
            if (un < 2) { ob = (bf16_t*)(ws + WS_Q); ld = 512; cb = 64 * (4 * un + wc); }
            else if (un < 4) { ob = (bf16_t*)(ws + WS_IQ); ld = 512; cb = 64 * (4 * (un - 2) + wc); }
            else if (wc == 0) { ob = (bf16_t*)(ws + WS_K); ld = 64; cb = 0; gam = p->hy_k_norm + j * 64; }
            else { ob = (bf16_t*)(ws + WS_IK); ld = 64; cb = 0; }
            pg8::f32x4 g0[2], g1[2];
#pragma unroll
            for (int n = 0; n < 2; ++n) { g0[n] = donorm ? *(const pg8::f32x4*)(gam + 8 * fq + 4 * n) : (pg8::f32x4){1.f, 1.f, 1.f, 1.f}; g1[n] = donorm ? *(const pg8::f32x4*)(gam + 32 + 8 * fq + 4 * n) : (pg8::f32x4){1.f, 1.f, 1.f, 1.f}; }
            const float* ropec = (const float*)(ws + WS_ROPEC);
            const float* ropes = (const float*)(ws + WS_ROPES);
#pragma unroll
            for (int ai = 0; ai < 2; ++ai)
#pragma unroll
                for (int m = 0; m < 4; ++m) {
                    const int t = opq(u.pm * 256 + ai * 128 + wr * 64 + m * 16 + fr), pos = t & (S - 1);
                    float rstd = 1.f;
                    if (donorm) {
                        float ss = 0.f;
#pragma unroll
                        for (int bj = 0; bj < 2; ++bj)
#pragma unroll
                            for (int n = 0; n < 2; ++n) { const pg8::f32x4 x = acc[ai][bj][m][n]; ss += x[0] * x[0] + x[1] * x[1] + x[2] * x[2] + x[3] * x[3]; }
                        ss += sx_f<16>(ss); ss += sx_f<32>(ss);
                        rstd = rsqrtf(ss * (1.f / 64.f) + EPS);
                    }
                    u32x4 o1, o2;
#pragma unroll
                    for (int n = 0; n < 2; ++n) {
                        const pg8::f32x4 cs = *(const pg8::f32x4*)(ropec + pos * 32 + 8 * fq + 4 * n), sn = *(const pg8::f32x4*)(ropes + pos * 32 + 8 * fq + 4 * n);
                        const pg8::f32x4 x1 = acc[ai][0][m][n] * rstd * g0[n], x2 = acc[ai][1][m][n] * rstd * g1[n];
                        const pg8::f32x4 y1 = x1 * cs - x2 * sn, y2 = x2 * cs + x1 * sn;
                        o1[2 * n] = cvtpk(y1[0], y1[1]); o1[2 * n + 1] = cvtpk(y1[2], y1[3]);
                        o2[2 * n] = cvtpk(y2[0], y2[1]); o2[2 * n + 1] = cvtpk(y2[2], y2[3]);
                    }
                    *(u32x4*)(ob + (size_t)t * ld + cb + 8 * fq) = o1;
                    *(u32x4*)(ob + (size_t)t * ld + cb + 32 + 8 * fq) = o2;
                }
        } else if (un == 4 && wc == 1) {
            bf16_t* ob = (bf16_t*)(ws + WS_V);
#pragma unroll
            for (int ai = 0; ai < 2; ++ai)
#pragma unroll
                for (int m = 0; m < 4; ++m) {
                    const int t = opq(u.pm * 256 + ai * 128 + wr * 64 + m * 16 + fr), pos = t & (S - 1), bb = t >> 11;
#pragma unroll
                    for (int bj = 0; bj < 2; ++bj)
#pragma unroll
                        for (int n = 0; n < 2; ++n)
#pragma unroll
                            for (int e = 0; e < 4; ++e) ob[((size_t)(bb * 64 + 32 * bj + 8 * fq + 4 * n + e)) * S + pos] = f2bf(acc[ai][bj][m][n][e]);
                }
        } else if (un == 4) {
            float* ob = (float*)(ws + WS_IW);
            if (fq == 0) {
#pragma unroll
                for (int ai = 0; ai < 2; ++ai)
#pragma unroll
                    for (int m = 0; m < 4; ++m) {
                        const int t = u.pm * 256 + ai * 128 + wr * 64 + m * 16 + fr;
                        *(pg8::f32x4*)(ob + (size_t)t * 8) = acc[ai][0][m][0] * (0.125f * 0.35355339059327373f);
                        *(pg8::f32x4*)(ob + (size_t)t * 8 + 4) = acc[ai][0][m][1] * (0.125f * 0.35355339059327373f);
                    }
            }
        } else if (un < 7) {
            bf16_t* ob = (bf16_t*)(ws + WS_BG);
#pragma unroll
            for (int ai = 0; ai < 2; ++ai)
#pragma unroll
                for (int m = 0; m < 4; ++m) {
                    const int t = opq(u.pm * 256 + ai * 128 + wr * 64 + m * 16 + fr);
#pragma unroll
                    for (int bj = 0; bj < 2; ++bj) {
                        const pg8::f32x4 a = acc[ai][bj][m][0], b = acc[ai][bj][m][1];
                        u32x4 o = {cvtpk(a[0], a[1]), cvtpk(a[2], a[3]), cvtpk(b[0], b[1]), cvtpk(b[2], b[3])};
                        *(u32x4*)(ob + (size_t)t * 512 + (un - 5) * 256 + 128 * bj + 32 * wc + 8 * fq) = o;
                    }
                }
        } else {
            bf16_t* ob = (bf16_t*)(ws + WS_Z);
#pragma unroll
            for (int ai = 0; ai < 2; ++ai)
#pragma unroll
                for (int m = 0; m < 4; ++m) {
                    const int t = opq(u.pm * 256 + ai * 128 + wr * 64 + m * 16 + fr);
                    const pg8::f32x4 a = acc[ai][0][m][0] * acc[ai][1][m][0], b = acc[ai][0][m][1] * acc[ai][1][m][1];
                    u32x4 o = {cvtpk(a[0], a[1]), cvtpk(a[2], a[3]), cvtpk(b[0], b[1]), cvtpk(b[2], b[3])};
                    *(u32x4*)(ob + (size_t)t * 512 + (un - 7) * 128 + 32 * wc + 8 * fq) = o;
                }
        }
    }
};


struct MlEpi8 {
    static constexpr bool PERM = true, AFTER_DRAIN = false;
    const Params* p; int j;
    __device__ __forceinline__ void operator()(const pg8::f32x4 (&acc)[2][2][4][2], const pg8::Unit& u, int wr, int wc, int fr, int fq) const {
        unsigned char* ws = p->ws;
        const int un = u.pn;
        if (un < 4 || un >= 8) {
            bf16_t* ob; int ld, cb0; float sc = 1.f;
            if (un < 2) { ob = (bf16_t*)(ws + WS_MQ); ld = 512; cb0 = 64 * (4 * un + wc); sc = 0.125f; }
            else if (un < 4) { ob = (bf16_t*)(ws + WS_MK); ld = 512; cb0 = 64 * (4 * (un - 2) + wc); }
            else { ob = (bf16_t*)(ws + WS_MOG); ld = 1024; cb0 = (un - 8) * 256 + 32 * wc; }
            const int bstep = un < 4 ? 32 : 128;
#pragma unroll
            for (int ai = 0; ai < 2; ++ai)
#pragma unroll
                for (int m = 0; m < 4; ++m) {
                    const int t = opq(u.pm * 256 + ai * 128 + wr * 64 + m * 16 + fr);
#pragma unroll
                    for (int bj = 0; bj < 2; ++bj) {
                        pg8::f32x4 a = acc[ai][bj][m][0] * sc, b = acc[ai][bj][m][1] * sc;
                        if (un >= 8) { for (int e = 0; e < 4; ++e) { a[e] = sigmoidf_(a[e]); b[e] = sigmoidf_(b[e]); } }
                        u32x4 o = {cvtpk(a[0], a[1]), cvtpk(a[2], a[3]), cvtpk(b[0], b[1]), cvtpk(b[2], b[3])};
                        *(u32x4*)(ob + (size_t)t * ld + cb0 + bstep * bj + 8 * fq) = o;
                    }
                }
        }
        if (un >= 2 && un < 8) {
            bf16_t* ob = (bf16_t*)(ws + (un < 4 ? WS_MKT : WS_MV));
#pragma unroll
            for (int ai = 0; ai < 2; ++ai)
#pragma unroll
                for (int m = 0; m < 4; ++m) {
                    const int t = opq(u.pm * 256 + ai * 128 + wr * 64 + m * 16 + fr), pos = t & (S - 1), bb = t >> 11;
#pragma unroll
                    for (int bj = 0; bj < 2; ++bj) {
                        const size_t rowb = un < 4 ? (size_t)((bb * 8 + 4 * (un - 2) + wc) * 64 + 32 * bj + 8 * fq) : (size_t)((bb * 8 + 2 * (un - 4) + bj) * 128 + 32 * wc + 8 * fq);
#pragma unroll
                        for (int n = 0; n < 2; ++n)
#pragma unroll
                            for (int e = 0; e < 4; ++e) ob[(rowb + 4 * n + e) * S + pos] = f2bf(acc[ai][bj][m][n][e]);
                    }
                }
        }
    }
};


struct MoeOrder8 {
    static constexpr bool GATHER = true;
    const int* tab; const int* elist; int G, c, total, mode;
    __device__ __forceinline__ bool next(int i, pg8::Unit& u) const {
        const int L = i * G + c; if (L >= total) return false;
        const int ru = L >> 2; int e = 0;
        while (e < 31 && tab[e + 1] <= ru) ++e;
        u.pm = __builtin_amdgcn_readfirstlane((e << 8) | (ru - tab[e])); u.pn = __builtin_amdgcn_readfirstlane(e * 4 + (L & 3)); return true;
    }
    __device__ __forceinline__ unsigned a_off(const pg8::Unit& u, int row) const {
        const int e = u.pm >> 8, lr = (u.pm & 255) * 256 + row;
        if (lr >= tab[40 + e]) return 0u;
        if (mode == 1) return (unsigned)(elist[e * NASG + lr] >> 1) * 2048u;
        return (unsigned)(tab[80 + e] + lr) * 1024u;
    }
    __device__ __forceinline__ void a_ready(const pg8::Unit&) const {}
    __device__ __forceinline__ void done(const pg8::Unit&) const {}
};
struct Moe1Epi8 {
    static constexpr bool PERM = true, AFTER_DRAIN = false;
    const int* tab; bf16_t* h1;
    __device__ __forceinline__ void operator()(const pg8::f32x4 (&acc)[2][2][4][2], const pg8::Unit& u, int wr, int wc, int fr, int fq) const {
        const int e = u.pm >> 8, mu = u.pm & 255, nu = u.pn & 3, cnt = tab[40 + e], roff = tab[80 + e];
#pragma unroll
        for (int ai = 0; ai < 2; ++ai)
#pragma unroll
            for (int m = 0; m < 4; ++m) {
                const int lr = opq(mu * 256 + ai * 128 + wr * 64 + m * 16 + fr);
                if (lr < cnt) {
                    u32x4 o;
#pragma unroll
                    for (int n = 0; n < 2; ++n) {
                        const pg8::f32x4 g = acc[ai][0][m][n], up = acc[ai][1][m][n]; float h[4];
#pragma unroll
                        for (int x = 0; x < 4; ++x) h[x] = g[x] / (1.f + __expf(-g[x])) * up[x];
                        o[2 * n] = cvtpk(h[0], h[1]); o[2 * n + 1] = cvtpk(h[2], h[3]);
                    }
                    *(u32x4*)(h1 + (size_t)(roff + lr) * 512 + 128 * nu + 32 * wc + 8 * fq) = o;
                }
            }
    }
};
struct Moe2Epi8 {
    static constexpr bool PERM = true, AFTER_DRAIN = false;
    const int* tab; const int* elist; bf16_t* y;
    __device__ __forceinline__ void operator()(const pg8::f32x4 (&acc)[2][2][4][2], const pg8::Unit& u, int wr, int wc, int fr, int fq) const {
        const int e = u.pm >> 8, mu = u.pm & 255, nu = u.pn & 3, cnt = tab[40 + e];
#pragma unroll
        for (int ai = 0; ai < 2; ++ai)
#pragma unroll
            for (int m = 0; m < 4; ++m) {
                const int lr = opq(mu * 256 + ai * 128 + wr * 64 + m * 16 + fr);
                if (lr < cnt) {
                    const int a = elist[e * NASG + lr];
#pragma unroll
                    for (int bj = 0; bj < 2; ++bj) {
                        const pg8::f32x4 v0 = acc[ai][bj][m][0], v1 = acc[ai][bj][m][1];
                        u32x4 o = {cvtpk(v0[0], v0[1]), cvtpk(v0[2], v0[3]), cvtpk(v1[0], v1[1]), cvtpk(v1[2], v1[3])};
                        *(u32x4*)(y + (size_t)a * 1024 + 256 * nu + 128 * bj + 32 * wc + 8 * fq) = o;
                    }
                }
            }
    }
};

#define XB_TMO      128
#define XB_XCNT(j)  (256  + 64 * (j))
#define XB_XSUB(j)  (1280 + 64 * (j))
#define XB_XGEN(j)  (2304 + 64 * (j))
#define XB_TOP      3328
#define XB_TOPGEN   3392
#define XCD_BAR_WORDS 3456
#define XB_SPIN_CAP (1u << 22)
#define LAS __attribute__((address_space(3)))
DI unsigned xb_ld(unsigned* p) { return __hip_atomic_load(p, __ATOMIC_RELAXED, __HIP_MEMORY_SCOPE_AGENT); }
DI unsigned xb_add(unsigned* p, unsigned v) { return __hip_atomic_fetch_add(p, v, __ATOMIC_RELAXED, __HIP_MEMORY_SCOPE_AGENT); }
DI unsigned xb_xcc_id() { return (unsigned)__builtin_amdgcn_s_getreg((3 << 11) | 20) & 0xFu; }
#define XB_SPIN(cond, bar) do { unsigned _sp = 0; while (cond) { __builtin_amdgcn_s_sleep(1); \
    if ((++_sp & 255u) == 0u) { if (xb_ld(&(bar)[XB_TMO])) break; if (_sp > XB_SPIN_CAP) { atomicAdd(&(bar)[XB_TMO], 1u); break; } } } } while (0)
struct XcdBarrier { unsigned* bar; unsigned x; volatile LAS unsigned* st; };
DI XcdBarrier xcd_barrier_post(unsigned* bar, volatile LAS unsigned* st, bool leader) {
    XcdBarrier b; b.bar = bar; b.x = xb_xcc_id(); b.st = st;
    if (leader) (void)xb_add(&bar[XB_XCNT(b.x)], 1u);
    return b;
}
DI void xcd_barrier_complete(unsigned* bar, unsigned x, unsigned& nloc, unsigned& nx) {
    const unsigned G = gridDim.x * gridDim.y * gridDim.z;
    unsigned sum, cnt, mine, sp = 0u;
    for (;;) {
        sum = 0u; cnt = 0u; mine = 0u;
#pragma unroll
        for (unsigned j = 0; j < 16; ++j) { const unsigned c = xb_ld(&bar[XB_XCNT(j)]); sum += c; cnt += (c > 0u) ? 1u : 0u; mine = (j == x) ? c : mine; }
        if (sum == G) break;
        __builtin_amdgcn_s_sleep(1);
        if ((++sp & 255u) == 0u) { if (xb_ld(&bar[XB_TMO])) break; if (sp > XB_SPIN_CAP) { atomicAdd(&bar[XB_TMO], 1u); break; } }
    }
    nloc = mine > 0u ? mine : 1u; nx = cnt > 0u ? cnt : 1u;
}
DI void xcd_barrier(const XcdBarrier& b, bool leader) {
    asm volatile("s_waitcnt vmcnt(0)" ::: "memory");
    __syncthreads();
    if (leader) {
        unsigned* bar = b.bar;
        __builtin_amdgcn_s_waitcnt(0);
        unsigned nloc = b.st[0], nx = b.st[1];
        if (nloc == 0u) { xcd_barrier_complete(bar, b.x, nloc, nx); b.st[0] = nloc; b.st[1] = nx; }
        const unsigned old = xb_add(&bar[XB_XSUB(b.x)], 1u);
        const unsigned gen = old / nloc;
        if (old + 1u == (gen + 1u) * nloc) {
            __builtin_amdgcn_fence(__ATOMIC_RELEASE, "agent");
            asm volatile("s_waitcnt vmcnt(0)" ::: "memory");
            const unsigned og = xb_add(&bar[XB_TOP], 1u);
            const unsigned tg = og / nx;
            if (og + 1u == (tg + 1u) * nx) xb_add(&bar[XB_TOPGEN], 1u);
            else XB_SPIN(xb_ld(&bar[XB_TOPGEN]) == tg, bar);
            __builtin_amdgcn_fence(__ATOMIC_ACQUIRE, "agent");
            xb_add(&bar[XB_XGEN(b.x)], 1u);
            asm volatile("s_waitcnt vmcnt(0)" ::: "memory");
        } else {
            XB_SPIN(xb_ld(&bar[XB_XGEN(b.x)]) == gen, bar);
            __builtin_amdgcn_fence(__ATOMIC_ACQUIRE, "agent");
            asm volatile("s_waitcnt vmcnt(0)" ::: "memory");
        }
    }
    __syncthreads();
}

namespace cg = cooperative_groups;
constexpr int MEGA_LDS = 65536 + 256;

DI const Params& fresh(const Params* kp) { asm volatile("" : "+s"(kp)); return *kp; }

#ifndef PROBE_MASK
#define PROBE_MASK 0
#endif
__global__ void __launch_bounds__(512, 2) hybrid_fwd_megakernel(Params p_arg) {
    __shared__ __attribute__((aligned(16))) unsigned char smem_all[2 * MEGA_LDS + 1024];
    cg::grid_group grid = cg::this_grid();
    const Params* kp = (const Params*)__builtin_amdgcn_kernarg_segment_ptr();
    const int wave8 = __builtin_amdgcn_readfirstlane((int)(threadIdx.x >> 6));
    const int vb = wave8 >> 2;
#define tid0 ((wave8 & 3) * 64 + lane_id())
    unsigned char* smem = smem_all + vb * MEGA_LDS;
    const int bid0 = blockIdx.x * 2 + vb, nb = gridDim.x * 2;
    const int gx0 = blockIdx.x & 7, glb0 = (blockIdx.x >> 3) * 2 + vb, gnl = (gridDim.x >> 3) * 2;
#define bid opqs(bid0)
#define gx opqs(gx0)
#define glb opqs(glb0)
#define tid opq(tid0)
    volatile LAS unsigned* xst = (volatile LAS unsigned*)(smem_all + 2 * MEGA_LDS);
    if (wave8 == 0 && lane_id() == 0) { xst[0] = 0u; xst[1] = 0u; }
    __syncthreads();
    (void)xcd_barrier_post((unsigned*)(fresh(kp).ws + WS_BAR), xst, wave8 == 0 && lane_id() == 0);
    for (int rep = 0; rep < ((PROBE_MASK & 1) ? 2 : 1); ++rep) { phase_init(fresh(kp), smem, bid, nb, tid); }
#define GSYNC() do { XcdBarrier xb_; xb_.bar = (unsigned*)(fresh(kp).ws + WS_BAR); xb_.x = xb_xcc_id(); xb_.st = (volatile LAS unsigned*)(smem_all + 2 * MEGA_LDS); xcd_barrier(xb_, wave8 == 0 && lane_id() == 0); } while (0)
    if (fresh(kp).use_cg_sync) grid.sync();
    GSYNC();
#pragma unroll 1
    for (int layer = 0; layer < DEPTH; ++layer) {
        const int j = layer >> 1;
        if (layer == 0) { { const Params& p = fresh(kp); phase_norm(p, 0, p.x, bid, nb, tid); }
        GSYNC(); }
        if ((layer & 1) == 0) {
            for (int rep = 0; rep < ((PROBE_MASK & 4) ? 2 : 1); ++rep) { { const Params& p = fresh(kp);
              pg8::Gemm g8{(const pg8::bf16_t*)(p.ws + WS_H), (const pg8::bf16_t*)(p.ws + WS_WHYB) + (size_t)j * 2816 * 1024, T, 2816, 1024};
              pg8::StaticOrder S8; S8.init(T, 2816, (int)gridDim.x, (int)blockIdx.x);
              HybEpi8 E8{&p, j};
              pg8::gemm_phase<HybEpi8, pg8::StaticOrder, true, true>((PG8_LAS unsigned char*)smem_all, g8, S8, E8, wave8 * 64 + lane_id()); } }
            GSYNC();
            for (int rep = 0; rep < ((PROBE_MASK & 8) ? 2 : 1); ++rep) { phase_dsa(fresh(kp), j, smem, bid, nb, tid, layer == 0 ? 1 : 3, layer == 0 ? 3 : 4); }
            for (int rep = 0; rep < ((PROBE_MASK & 16) ? 2 : 1); ++rep) { phase_conv(fresh(kp), j, bid, nb, tid); }
            GSYNC();
            { const Params& p = fresh(kp);
              pg8::Gemm g8{(const pg8::bf16_t*)(p.ws + WS_YMIX), (const pg8::bf16_t*)(p.ws + WS_WOUT) + (size_t)layer * 1024 * 1024, T, 1024, 1024};
              pg8::StaticOrder S8; S8.init(T, 1024, (int)gridDim.x, (int)blockIdx.x);
              OutEpi8 E8{layer == 0 ? p.x : p.out, p.out, (const float*)(p.ws + WS_MOD) + (size_t)layer * 8 * 6144 + 2048, (float*)(p.ws + WS_PART)};
              pg8::gemm_phase<OutEpi8, pg8::StaticOrder, false, true>((PG8_LAS unsigned char*)smem_all, g8, S8, E8, wave8 * 64 + lane_id()); }
        } else {
            for (int rep = 0; rep < ((PROBE_MASK & 32) ? 2 : 1); ++rep) { { const Params& p = fresh(kp);
              pg8::Gemm g8{(const pg8::bf16_t*)(p.ws + WS_H), (const pg8::bf16_t*)(p.ws + WS_WML) + (size_t)j * 3200 * 1024, T, 3072, 1024};
              pg8::StaticOrder S8; S8.init(T, 3072, (int)gridDim.x, (int)blockIdx.x);
              MlEpi8 E8{&p, j};
              pg8::gemm_phase<MlEpi8, pg8::StaticOrder, true, true>((PG8_LAS unsigned char*)smem_all, g8, S8, E8, wave8 * 64 + lane_id());
              for (int gi = glb; gi < 16; gi += gnl) { MlGates pr{&p, j, gx * 16 + gi}; gemm_tile(pr, smem, tid); } } }
            GSYNC();
            for (int rep = 0; rep < ((PROBE_MASK & 64) ? 2 : 1); ++rep) { phase_ml1(fresh(kp), smem, bid, nb, tid); }
            GSYNC();
            for (int rep = 0; rep < ((PROBE_MASK & 128) ? 2 : 1); ++rep) { phase_ml2(fresh(kp), smem, bid, nb, tid); }
            GSYNC();
            for (int rep = 0; rep < ((PROBE_MASK & 256) ? 2 : 1); ++rep) { phase_ml3(fresh(kp), j, smem, bid, nb, tid); }
            GSYNC();
            { const Params& p = fresh(kp);
              pg8::Gemm g8{(const pg8::bf16_t*)(p.ws + WS_YMIX), (const pg8::bf16_t*)(p.ws + WS_WOUT) + (size_t)layer * 1024 * 1024, T, 1024, 1024};
              pg8::StaticOrder S8; S8.init(T, 1024, (int)gridDim.x, (int)blockIdx.x);
              OutEpi8 E8{p.out, p.out, (const float*)(p.ws + WS_MOD) + (size_t)layer * 8 * 6144 + 2048, (float*)(p.ws + WS_PART)};
              pg8::gemm_phase<OutEpi8, pg8::StaticOrder, false, true>((PG8_LAS unsigned char*)smem_all, g8, S8, E8, wave8 * 64 + lane_id()); }
        }
        GSYNC();
        phase_ffn_norm_router(fresh(kp), layer, smem, bid, nb, tid);
        GSYNC();
        { const Params& p = fresh(kp); unsigned char* wsu = uniform_ptr(p.ws);
          int* mtab = (int*)(smem_all + 2 * MEGA_LDS + 64);
          __syncthreads();
          if (wave8 == 0 && lane_id() == 0) {
              const int* ecnt = (const int*)(wsu + WS_ECNT) + layer * 32 * ECS; int ua = 0, ra = 0;
              for (int e = 0; e < 32; ++e) { const int cn = ecnt[e * ECS]; mtab[e] = ua; mtab[40 + e] = cn; mtab[80 + e] = ra; ua += (cn + 255) >> 8; ra += cn; }
              mtab[32] = ua;
          }
          __syncthreads();
          MoeOrder8 S8{mtab, (const int*)(wsu + WS_ELIST), (int)gridDim.x, (int)blockIdx.x, mtab[32] * 4, 1};
          pg8::Gemm g8{(const pg8::bf16_t*)(wsu + WS_H), (const pg8::bf16_t*)(wsu + WS_WM1) + (size_t)layer * 32 * 1024 * 1024, 0, 0, 1024};
          Moe1Epi8 E8{mtab, (bf16_t*)(wsu + WS_H1)};
          pg8::gemm_phase<Moe1Epi8, MoeOrder8, true, true>((PG8_LAS unsigned char*)smem_all, g8, S8, E8, wave8 * 64 + lane_id()); }
        GSYNC();
        { const Params& p = fresh(kp); unsigned char* wsu = uniform_ptr(p.ws);
          int* mtab = (int*)(smem_all + 2 * MEGA_LDS + 64);
          MoeOrder8 S8{mtab, (const int*)(wsu + WS_ELIST), (int)gridDim.x, (int)blockIdx.x, mtab[32] * 4, 2};
          pg8::Gemm g8{(const pg8::bf16_t*)(wsu + WS_H1), (const pg8::bf16_t*)(wsu + WS_WM2) + (size_t)layer * 32 * 1024 * 512, 0, 0, 512};
          Moe2Epi8 E8{mtab, (const int*)(wsu + WS_ELIST), (bf16_t*)(wsu + WS_Y)};
          pg8::gemm_phase<Moe2Epi8, MoeOrder8, true, true>((PG8_LAS unsigned char*)smem_all, g8, S8, E8, wave8 * 64 + lane_id()); }
        GSYNC();
        phase_combine_norm(fresh(kp), layer, bid, nb, tid);
        if (layer + 1 < DEPTH) GSYNC();
    }
}
#undef tid
#undef tid0
#undef bid
#undef gx
#undef glb
#undef GSYNC

extern "C" void kernel_launch(void* const* d_in, const int* in_sizes, int n_in, void* d_out, int out_size, void* d_ws, size_t ws_size, hipStream_t stream) {
    Params p{};
    const float** f = (const float**)&p;
    for (int i = 0; i < 22; ++i) f[i] = (const float*)d_in[i];
    p.out = (float*)d_out;
    p.ws = (unsigned char*)d_ws;
    if (ws_size < WS_END) { fprintf(stderr, "workspace too small: %zu < %zu\n", ws_size, (size_t)WS_END); return; }
    static int grid_blocks = 0;
    if (!grid_blocks) {
        int dev = 0, cus = 0, per_cu = 0;
        hipGetDevice(&dev);
        hipDeviceGetAttribute(&cus, hipDeviceAttributeMultiprocessorCount, dev);
        hipOccupancyMaxActiveBlocksPerMultiprocessor(&per_cu, hybrid_fwd_megakernel, 512, 0);
        if (per_cu > 1) per_cu = 1;
        grid_blocks = cus * per_cu;
    }
    (void)hipMemsetAsync((unsigned char*)d_ws + WS_BAR, 0, XCD_BAR_WORDS_C * 4, stream);
    void* args[] = {&p};
    hipError_t e = hipLaunchCooperativeKernel((void*)hybrid_fwd_megakernel, dim3(grid_blocks), dim3(512), args, 0, stream);
    if (e != hipSuccess) fprintf(stderr, "cooperative launch failed: %s (grid %d)\n", hipGetErrorString(e), grid_blocks);
}
```

```cpp
#include <hip/hip_runtime.h>
#include <hip/hip_cooperative_groups.h>
#include <stdint.h>
#include <cstdio>

#define DI __device__ __forceinline__
typedef unsigned short bf16_t;
typedef short bf16x8 __attribute__((ext_vector_type(8)));
typedef float f32x16 __attribute__((ext_vector_type(16)));
typedef float f32x4 __attribute__((ext_vector_type(4)));
typedef float f32x2 __attribute__((ext_vector_type(2)));
typedef unsigned u32x4 __attribute__((ext_vector_type(4)));
typedef unsigned u32x2 __attribute__((ext_vector_type(2)));
typedef __bf16 bf16x2_t __attribute__((ext_vector_type(2)));

constexpr int D = 1024, NB = 8, S = 2048, T = NB * S, DEPTH = 4;
constexpr int HYB_IN = 2760, ML_IN = 3088;
constexpr int NEXP = 32, DEXP = 512, NASG = T * 2;
constexpr float EPS = 1e-6f;
constexpr int XCD_BAR_WORDS_C = 3456;

constexpr size_t al256(size_t x) { return (x + 255) & ~(size_t)255; }
constexpr size_t WS_MOD = 0;
constexpr size_t WS_ROPEC = WS_MOD + al256((size_t)4 * 8 * 6144 * 4);
constexpr size_t WS_ROPES = WS_ROPEC + al256((size_t)2048 * 32 * 4);
constexpr size_t WS_ECNT = WS_ROPES + al256((size_t)2048 * 32 * 4);
constexpr int ECS = 64;
constexpr size_t WS_H = WS_ECNT + al256(4 * 32 * ECS * 4);
constexpr size_t WS_YMIX = WS_H + al256((size_t)T * 1024 * 2);
constexpr size_t WS_Q = WS_YMIX + al256((size_t)T * 1024 * 2);
constexpr size_t WS_K = WS_Q + al256((size_t)T * 512 * 2);
constexpr size_t WS_V = WS_K + al256((size_t)T * 64 * 2);
constexpr size_t WS_IQ = WS_V + al256((size_t)T * 64 * 2);
constexpr size_t WS_IK = WS_IQ + al256((size_t)T * 512 * 2);
constexpr size_t WS_IW = WS_IK + al256((size_t)T * 64 * 2);
constexpr size_t WS_BG = WS_IW + al256((size_t)T * 8 * 4);
constexpr size_t WS_Z = WS_BG + al256((size_t)T * 512 * 2);
constexpr size_t WS_MASK = WS_Z + al256((size_t)T * 512 * 2);
constexpr size_t WS_MQ = WS_MASK + al256((size_t)T * 64 * 4);
constexpr size_t WS_MK = WS_MQ + al256((size_t)T * 512 * 2);
constexpr size_t WS_MV = WS_MK + al256((size_t)T * 512 * 2);
constexpr size_t WS_MIG = WS_MV + al256((size_t)T * 1024 * 2);
constexpr size_t WS_MFG = WS_MIG + al256((size_t)T * 8 * 4);
constexpr size_t WS_MOG = WS_MFG + al256((size_t)T * 8 * 4);
constexpr size_t WS_EW = WS_MOG + al256((size_t)T * 1024 * 2);
constexpr size_t WS_ELIST = WS_EW + al256((size_t)NASG * 4);
constexpr size_t WS_H1 = WS_ELIST + al256((size_t)NEXP * NASG * 4);
constexpr size_t WS_Y = WS_H1 + al256((size_t)NASG * 512 * 2);
constexpr size_t WS_MKT = WS_Y + al256((size_t)NASG * 1024 * 2);
constexpr size_t WS_UBUF = WS_MKT + al256((size_t)64 * 64 * S * 2);
constexpr size_t WS_UNBUF = WS_UBUF + al256((size_t)64 * 32 * 8192 * 4);
constexpr size_t WS_MLOC = WS_UNBUF + al256((size_t)64 * 32 * 64 * 4);
constexpr size_t WS_CBUF = WS_MLOC + al256((size_t)64 * 32 * 2 * 4);
constexpr size_t WS_NBUF = WS_CBUF + al256((size_t)64 * 32 * 8192 * 2);
constexpr size_t WS_MST = WS_NBUF + al256((size_t)64 * 32 * 64 * 4);
constexpr size_t WS_PART = WS_MST + al256((size_t)64 * 32 * 4);
constexpr size_t WS_WHYB = WS_PART + al256((size_t)T * 16 * 4);
constexpr size_t WS_WML = WS_WHYB + al256((size_t)2 * 2816 * 1024 * 2);
constexpr size_t WS_WOUT = WS_WML + al256((size_t)2 * 3200 * 1024 * 2);
constexpr size_t WS_WM1 = WS_WOUT + al256((size_t)4 * 1024 * 1024 * 2);
constexpr size_t WS_WM2 = WS_WM1 + al256((size_t)4 * 32 * 1024 * 1024 * 2);
constexpr size_t WS_BAR = WS_WM2 + al256((size_t)4 * 32 * 1024 * 512 * 2);
constexpr size_t WS_END = WS_BAR + al256((size_t)XCD_BAR_WORDS_C * 4);

struct Params {
    const float *x, *c, *ada_w, *ada_b, *norm_mix, *norm_ffn, *hy_w_in, *hy_q_norm, *hy_k_norm, *hy_conv_w, *hy_w_out;
    const float *ml_w_in, *ml_b_gates, *ml_out_norm, *ml_w_out, *moe_w_group, *moe_b_group, *moe_w_expert, *moe_b_expert;
    const float *moe_w_gate, *moe_w_up, *moe_w_down;
    float* out;
    unsigned char* ws;
    unsigned long long use_cg_sync;
};

DI unsigned pk2(float lo, float hi) { f32x2 v = {lo, hi}; bf16x2_t b = __builtin_convertvector(v, bf16x2_t); return __builtin_bit_cast(unsigned, b); }
DI bf16_t f2bf(float x) { return (bf16_t)(pk2(x, 0.f) & 0xffffu); }
DI float bf2f(bf16_t h) { return __uint_as_float(((unsigned)h) << 16); }
DI float bflo(unsigned u) { return __uint_as_float(u << 16); }
DI float bfhi(unsigned u) { return __uint_as_float(u & 0xffff0000u); }
DI int lane_id() { int x; asm volatile("v_mbcnt_lo_u32_b32 %0, -1, 0\n\tv_mbcnt_hi_u32_b32 %0, -1, %0" : "=v"(x)); return x; }
template <int M> DI int sx_i(int v) {
    if constexpr (M < 32) return __builtin_amdgcn_ds_swizzle(v, (M << 10) | 0x1f);
    else return __builtin_amdgcn_ds_bpermute((lane_id() ^ 32) << 2, v);
}
template <int M> DI float sx_f(float v) { return __int_as_float(sx_i<M>(__float_as_int(v))); }
DI float lane_get_f(float v, int src) { return __int_as_float(__builtin_amdgcn_ds_bpermute(src << 2, __float_as_int(v))); }
DI float wave_sum(float v) { v += sx_f<32>(v); v += sx_f<16>(v); v += sx_f<8>(v); v += sx_f<4>(v); v += sx_f<2>(v); v += sx_f<1>(v); return v; }
DI float wave_max(float v) { v = fmaxf(v, sx_f<32>(v)); v = fmaxf(v, sx_f<16>(v)); v = fmaxf(v, sx_f<8>(v)); v = fmaxf(v, sx_f<4>(v)); v = fmaxf(v, sx_f<2>(v)); v = fmaxf(v, sx_f<1>(v)); return v; }
DI float half_sum(float v) { v += sx_f<16>(v); v += sx_f<8>(v); v += sx_f<4>(v); v += sx_f<2>(v); v += sx_f<1>(v); return v; }
DI float sigmoidf_(float x) { return 1.f / (1.f + __expf(-x)); }
DI unsigned char* uniform_ptr(unsigned char* q) {
    const unsigned long long w = (unsigned long long)q;
    const unsigned lo = __builtin_amdgcn_readfirstlane((unsigned)w), hi = __builtin_amdgcn_readfirstlane((unsigned)(w >> 32));
    return (unsigned char*)(((unsigned long long)hi << 32) | lo);
}
DI int opqs(int x) { asm volatile("" : "+s"(x)); return x; }
DI int opq(int x) { asm volatile("" : "+v"(x)); return x; }

DI int swz(int row, int slot) { return row * 128 + ((slot ^ ((row >> 1) & 7)) << 4); }
DI int crow(int reg, int lane) { return (reg & 3) + 8 * (reg >> 2) + 4 * (lane >> 5); }

template <class P>
DI void gemm_tile(const P& pr, unsigned char* smem, int tid) {
    const int lane = tid & 63, wid = tid >> 6, wr = wid >> 1, wc = wid & 1;
    const bf16_t* abase = pr.a_base();
    const bf16_t* bbase = pr.b_base();
    const int kdim = pr.kt() * 64;
    int gao[4], gbo[4];
#pragma unroll
    for (int i = 0; i < 4; ++i) {
        const int row = (tid >> 3) + 32 * i, sl = (tid & 7) ^ ((row >> 1) & 7);
        const int o = pr.a_off(row);
        gao[i] = (o >= 0 ? o : 0) + sl * 8; gbo[i] = row * kdim + sl * 8;
    }
#define GLDS(buf, kt) do { _Pragma("unroll") for (int i = 0; i < 4; ++i) { \
        __builtin_amdgcn_global_load_lds((const unsigned*)(abase + gao[i] + (kt) * 64), (__attribute__((address_space(3))) unsigned*)(smem + (buf) * 32768 + (i * 256 + wid * 64) * 16), 16, 0, 0); \
        __builtin_amdgcn_global_load_lds((const unsigned*)(bbase + gbo[i] + (kt) * 64), (__attribute__((address_space(3))) unsigned*)(smem + (buf) * 32768 + 16384 + (i * 256 + wid * 64) * 16), 16, 0, 0); } } while (0)
#define DMA_WAIT_SYNC() do { asm volatile("s_waitcnt vmcnt(0)" ::: "memory"); __syncthreads(); } while (0)
#define COMPUTE(buf) do { const unsigned char* As = smem + (buf) * 32768; const unsigned char* Bs = As + 16384; \
        _Pragma("unroll") for (int ks = 0; ks < 4; ++ks) { const int slot = ks * 2 + (lane >> 5); \
            const bf16x8 a0 = *(const bf16x8*)(As + swz(wr * 64 + (lane & 31), slot)); const bf16x8 a1 = *(const bf16x8*)(As + swz(wr * 64 + 32 + (lane & 31), slot)); \
            const bf16x8 b0 = *(const bf16x8*)(Bs + swz(wc * 64 + (lane & 31), slot)); const bf16x8 b1 = *(const bf16x8*)(Bs + swz(wc * 64 + 32 + (lane & 31), slot)); \
            acc[0][0] = __builtin_amdgcn_mfma_f32_32x32x16_bf16(a0, b0, acc[0][0], 0, 0, 0); acc[0][1] = __builtin_amdgcn_mfma_f32_32x32x16_bf16(a0, b1, acc[0][1], 0, 0, 0); \
            acc[1][0] = __builtin_amdgcn_mfma_f32_32x32x16_bf16(a1, b0, acc[1][0], 0, 0, 0); acc[1][1] = __builtin_amdgcn_mfma_f32_32x32x16_bf16(a1, b1, acc[1][1], 0, 0, 0); } } while (0)
    f32x16 acc[2][2];
#pragma unroll
    for (int a = 0; a < 2; ++a)
#pragma unroll
        for (int b = 0; b < 2; ++b)
#pragma unroll
            for (int r = 0; r < 16; ++r) acc[a][b][r] = 0.f;
    const int KT = pr.kt();
    __syncthreads();
    GLDS(0, 0);
    DMA_WAIT_SYNC();
    for (int kt = 0; kt < KT; kt += 2) {
        GLDS(1, kt + 1);
        COMPUTE(0);
        DMA_WAIT_SYNC();
        if (kt + 2 < KT) GLDS(0, kt + 2);
        COMPUTE(1);
        DMA_WAIT_SYNC();
    }
#undef GLDS
#undef DMA_WAIT_SYNC
#undef COMPUTE
    pr.epi(acc, wr, wc, lane, smem + wid * 8192);
}

template <class P>
DI void convert_tile(const P& pr, bf16_t* dst, int kdim, int kt, unsigned char* smem, int tid) {
    unsigned char* Bs = smem;
    const int ng = tid & 31, kg = tid >> 5;
    int width = 0;
    const float* bp = pr.b_col(ng >> 3, width);
    const int cig = (ng & 7) * 4;
    const bool bvalid = cig < width;
    const int ldb = pr.ldb();
    bp += cig + (size_t)(kt * 64 + kg * 8) * ldb;
    f32x4 rb[8];
#pragma unroll
    for (int kk = 0; kk < 8; ++kk) rb[kk] = bvalid ? *(const f32x4*)(bp + (size_t)kk * ldb) : (f32x4){0.f, 0.f, 0.f, 0.f};
    __syncthreads();
#pragma unroll
    for (int j = 0; j < 4; ++j) {
        u32x4 v = {pk2(rb[0][j], rb[1][j]), pk2(rb[2][j], rb[3][j]), pk2(rb[4][j], rb[5][j]), pk2(rb[6][j], rb[7][j])};
        *(u32x4*)(Bs + swz(ng * 4 + j, kg)) = v;
    }
    __syncthreads();
#pragma unroll
    for (int i = 0; i < 4; ++i) {
        const int n = (tid >> 3) + 32 * i;
        *(u32x4*)(dst + (size_t)n * kdim + kt * 64 + (tid & 7) * 8) = *(const u32x4*)(Bs + swz(n, tid & 7));
    }
}

template <int NC> DI void stage_put(unsigned char* wl, int mi, int ni, int r, int lane, float v) { *(bf16_t*)(wl + ((mi * 32 + crow(r, lane)) * NC + ni * 32 + (lane & 31)) * 2) = f2bf(v); }
template <int NC, class RowPtr> DI void stage_flush(unsigned char* wl, int lane, RowPtr rp) {
    constexpr int CH = NC / 8, RPI = 64 / CH, NIT = 64 / RPI;
#pragma unroll
    for (int i = 0; i < NIT; ++i) {
        const int row = lane / CH + RPI * i, ch = lane % CH;
        const u32x4 d = *(const u32x4*)(wl + (row * NC + ch * 8) * 2);
        bf16_t* dst = rp(row);
        if (dst) *(u32x4*)(dst + ch * 8) = d;
    }
}

struct HybIn {
    const Params* p; int j, tm, tn;
    DI int kt() const { return 16; }
    DI int ldb() const { return HYB_IN; }
    DI const bf16_t* a_base() const { return (const bf16_t*)(p->ws + WS_H); }
    DI int a_off(int r) const { return (tm * 128 + r) * 1024; }
    DI static void pair_cols(int pr, int ni, int& base, int& width) {
        width = 32;
        if (pr < 8) base = 64 * pr + 32 * ni;
        else if (pr == 8) base = 512 + 32 * ni;
        else if (pr == 9) base = 576 + 32 * ni;
        else if (pr < 18) base = 640 + 64 * (pr - 10) + 32 * ni;
        else if (pr == 18) base = 1152 + 32 * ni;
        else if (pr == 19) { base = 1216; width = ni == 0 ? 8 : 0; }
        else if (pr < 28) base = 1224 + 64 * (pr - 20) + 32 * ni;
        else base = (ni == 0 ? 1736 : 2248) + 32 * (pr - 28);
    }
    DI const float* b_col(int g, int& width) const { int base; pair_cols(tn * 2 + (g >> 1), g & 1, base, width); return p->hy_w_in + (size_t)j * 1024 * HYB_IN + base; }
    DI const bf16_t* b_base() const { return (const bf16_t*)(p->ws + WS_WHYB) + (size_t)(j * 22 + tn) * 128 * 1024; }
    DI void epi(f32x16 (&acc)[2][2], int wr, int wc, int lane, unsigned char* wl) const {
        const int pr = tn * 2 + wc, c = lane & 31;
        const int t0 = tm * 128 + wr * 64;
        unsigned char* ws = p->ws;
        const float* ropec = (const float*)(ws + WS_ROPEC);
        const float* ropes = (const float*)(ws + WS_ROPES);
        if (pr < 9 || (pr >= 10 && pr < 19)) {
            const bool donorm = pr < 9;
            const float* gam = pr < 8 ? p->hy_q_norm + j * 64 : p->hy_k_norm + j * 64;
            bf16_t* ob; int ld, cb;
            if (pr < 8) { ob = (bf16_t*)(ws + WS_Q); ld = 512; cb = 64 * pr; }
            else if (pr == 8) { ob = (bf16_t*)(ws + WS_K); ld = 64; cb = 0; }
            else if (pr < 18) { ob = (bf16_t*)(ws + WS_IQ); ld = 512; cb = 64 * (pr - 10); }
            else { ob = (bf16_t*)(ws + WS_IK); ld = 64; cb = 0; }
            float g1 = 1.f, g2 = 1.f;
            if (donorm) { g1 = gam[c]; g2 = gam[c + 32]; }
#pragma unroll
            for (int mi = 0; mi < 2; ++mi)
#pragma unroll
                for (int r = 0; r < 16; ++r) {
                    float x1 = acc[mi][0][r], x2 = acc[mi][1][r];
                    const int t = t0 + mi * 32 + crow(r, lane), pos = t & (S - 1);
                    if (donorm) { float ss = half_sum(x1 * x1 + x2 * x2); float rstd = rsqrtf(ss * (1.f / 64.f) + EPS); x1 *= rstd * g1; x2 *= rstd * g2; }
                    const float cs = ropec[pos * 32 + c], sn = ropes[pos * 32 + c];
                    stage_put<64>(wl, mi, 0, r, lane, x1 * cs - x2 * sn);
                    stage_put<64>(wl, mi, 1, r, lane, x2 * cs + x1 * sn);
                }
            stage_flush<64>(wl, lane, [&](int row) { return ob + (size_t)(t0 + row) * ld + cb; });
        } else if (pr == 9) {
            bf16_t* ob = (bf16_t*)(ws + WS_V);
#pragma unroll
            for (int mi = 0; mi < 2; ++mi)
#pragma unroll
                for (int ni = 0; ni < 2; ++ni)
#pragma unroll
                    for (int g4 = 0; g4 < 4; ++g4) {
                        const int t = t0 + mi * 32 + 8 * g4 + 4 * (lane >> 5), pos = t & (S - 1), bb = t >> 11;
                        u32x2 o = {pk2(acc[mi][ni][4 * g4], acc[mi][ni][4 * g4 + 1]), pk2(acc[mi][ni][4 * g4 + 2], acc[mi][ni][4 * g4 + 3])};
                        *(u32x2*)(ob + ((size_t)(bb * 64 + ni * 32 + c)) * S + pos) = o;
                    }
        } else if (pr == 19) {
            float* ob = (float*)(ws + WS_IW);
            if (c < 8) {
#pragma unroll
                for (int mi = 0; mi < 2; ++mi)
#pragma unroll
                    for (int r = 0; r < 16; ++r) { const int t = t0 + mi * 32 + crow(r, lane); ob[(size_t)t * 8 + c] = acc[mi][0][r] * (0.125f * 0.35355339059327373f); }
            }
        } else if (pr < 28) {
            bf16_t* ob = (bf16_t*)(ws + WS_BG); const int cb = 64 * (pr - 20);
#pragma unroll
            for (int mi = 0; mi < 2; ++mi)
#pragma unroll
                for (int r = 0; r < 16; ++r) { stage_put<64>(wl, mi, 0, r, lane, acc[mi][0][r]); stage_put<64>(wl, mi, 1, r, lane, acc[mi][1][r]); }
            stage_flush<64>(wl, lane, [&](int row) { return ob + (size_t)(t0 + row) * 512 + cb; });
        } else {
            bf16_t* ob = (bf16_t*)(ws + WS_Z); const int cb = 32 * (pr - 28);
#pragma unroll
            for (int mi = 0; mi < 2; ++mi)
#pragma unroll
                for (int r = 0; r < 16; ++r) stage_put<32>(wl, mi, 0, r, lane, acc[mi][0][r] * acc[mi][1][r]);
            stage_flush<32>(wl, lane, [&](int row) { return ob + (size_t)(t0 + row) * 512 + cb; });
        }
    }
};


struct HybCols8 {
    const Params* p; int j, tm, tn;
    DI int ldb() const { return HYB_IN; }
    DI const float* b_col(int g, int& width) const {
        const int u = tn >> 1, bj = tn & 1; int base; width = 32;
        if (u < 2) base = 64 * (4 * u + g) + 32 * bj;
        else if (u < 4) base = 640 + 64 * (4 * (u - 2) + g) + 32 * bj;
        else if (u == 4) { if (g == 0) base = 512 + 32 * bj; else if (g == 1) base = 576 + 32 * bj; else if (g == 2) base = 1152 + 32 * bj; else { base = 1216; width = bj == 0 ? 8 : 0; } }
        else if (u < 7) base = 1224 + (u - 5) * 256 + 128 * bj + 32 * g;
        else base = (bj == 0 ? 1736 : 2248) + (u - 7) * 128 + 32 * g;
        return p->hy_w_in + (size_t)j * 1024 * HYB_IN + base;
    }
};

struct MlIn {
    const Params* p; int j, tm, tn;
    DI int kt() const { return 16; }
    DI int ldb() const { return ML_IN; }
    DI const bf16_t* a_base() const { return (const bf16_t*)(p->ws + WS_H); }
    DI int a_off(int r) const { return (tm * 128 + r) * 1024; }
    DI const float* b_col(int g, int& width) const {
        const int pr = tn * 2 + (g >> 1), ni = g & 1; int base; width = 32;
        if (pr < 32) base = 64 * pr + 32 * ni;
        else if (pr == 32) { base = 2048 + 8 * ni; width = 8; }
        else if (pr < 49) base = 2064 + 64 * (pr - 33) + 32 * ni;
        else { base = 0; width = 0; }
        return p->ml_w_in + (size_t)j * 1024 * ML_IN + base;
    }
    DI const bf16_t* b_base() const { return (const bf16_t*)(p->ws + WS_WML) + (size_t)(j * 25 + tn) * 128 * 1024; }
    DI void epi(f32x16 (&acc)[2][2], int wr, int wc, int lane, unsigned char* wl) const {
        const int pr = tn * 2 + wc, c = lane & 31;
        const int t0 = tm * 128 + wr * 64;
        unsigned char* ws = p->ws;
        if (pr < 16) {
            bf16_t* ob; int cb; float sc = 1.f;
            if (pr < 8) { ob = (bf16_t*)(ws + WS_MQ); cb = 64 * pr; sc = 0.125f; }
            else { ob = (bf16_t*)(ws + WS_MK); cb = 64 * (pr - 8); }
#pragma unroll
            for (int mi = 0; mi < 2; ++mi)
#pragma unroll
                for (int r = 0; r < 16; ++r) { stage_put<64>(wl, mi, 0, r, lane, acc[mi][0][r] * sc); stage_put<64>(wl, mi, 1, r, lane, acc[mi][1][r] * sc); }
            stage_flush<64>(wl, lane, [&](int row) { return ob + (size_t)(t0 + row) * 512 + cb; });
        }
        if (pr >= 8 && pr < 32) {
            bf16_t* ob; int nrow, hd, r0;
            if (pr < 16) { ob = (bf16_t*)(ws + WS_MKT); nrow = 64; hd = pr - 8; r0 = 0; }
            else { ob = (bf16_t*)(ws + WS_MV); nrow = 128; hd = (pr - 16) >> 1; r0 = 64 * ((pr - 16) & 1); }
#pragma unroll
            for (int mi = 0; mi < 2; ++mi)
#pragma unroll
                for (int ni = 0; ni < 2; ++ni)
#pragma unroll
                    for (int g4 = 0; g4 < 4; ++g4) {
                        const int t = t0 + mi * 32 + 8 * g4 + 4 * (lane >> 5), pos = t & (S - 1), bb = t >> 11;
                        u32x2 o = {pk2(acc[mi][ni][4 * g4], acc[mi][ni][4 * g4 + 1]), pk2(acc[mi][ni][4 * g4 + 2], acc[mi][ni][4 * g4 + 3])};
                        *(u32x2*)(ob + ((size_t)((bb * 8 + hd) * nrow + r0 + ni * 32 + c)) * S + pos) = o;
                    }
        } else if (pr == 32) {
            if (c < 8) {
                float* oi = (float*)(ws + WS_MIG); float* of = (float*)(ws + WS_MFG);
                const float bi = p->ml_b_gates[j * 16 + c], bfg = p->ml_b_gates[j * 16 + 8 + c];
#pragma unroll
                for (int mi = 0; mi < 2; ++mi)
#pragma unroll
                    for (int r = 0; r < 16; ++r) {
                        const int t = t0 + mi * 32 + crow(r, lane);
                        oi[(size_t)t * 8 + c] = acc[mi][0][r] + bi;
                        const float f = acc[mi][1][r] + bfg;
                        of[(size_t)t * 8 + c] = fminf(f, 0.f) - log1pf(__expf(-fabsf(f)));
                    }
            }
        } else if (pr >= 33 && pr < 49) {
            bf16_t* ob = (bf16_t*)(ws + WS_MOG); const int cb = 64 * (pr - 33);
#pragma unroll
            for (int mi = 0; mi < 2; ++mi)
#pragma unroll
                for (int r = 0; r < 16; ++r) { stage_put<64>(wl, mi, 0, r, lane, sigmoidf_(acc[mi][0][r])); stage_put<64>(wl, mi, 1, r, lane, sigmoidf_(acc[mi][1][r])); }
            stage_flush<64>(wl, lane, [&](int row) { return ob + (size_t)(t0 + row) * 1024 + cb; });
        }
    }
};


struct MlCols8 {
    const Params* p; int j, tm, tn;
    DI int ldb() const { return ML_IN; }
    DI const float* b_col(int g, int& width) const {
        const int u = tn >> 1, bj = tn & 1; int base; width = 32;
        if (tn == 24) { base = 2048 + 8 * (g & 1); width = g < 2 ? 8 : 0; }
        else if (u < 2) base = 64 * (4 * u + g) + 32 * bj;
        else if (u < 4) base = 512 + 64 * (4 * (u - 2) + g) + 32 * bj;
        else if (u < 8) base = 1024 + (2 * (u - 4) + bj) * 128 + 32 * g;
        else base = 2064 + (u - 8) * 256 + 128 * bj + 32 * g;
        return p->ml_w_in + (size_t)j * 1024 * ML_IN + base;
    }
};
struct MlGates {
    const Params* p; int j, tm;
    DI int kt() const { return 16; }
    DI const bf16_t* a_base() const { return (const bf16_t*)(p->ws + WS_H); }
    DI int a_off(int r) const { return (tm * 128 + r) * 1024; }
    DI const bf16_t* b_base() const { return (const bf16_t*)(p->ws + WS_WML) + (size_t)(j * 25 + 24) * 128 * 1024; }
    DI void epi(f32x16 (&acc)[2][2], int wr, int wc, int lane, unsigned char* wl) const {
        const int c = lane & 31, t0 = tm * 128 + wr * 64;
        if (wc == 0 && c < 8) {
            float* oi = (float*)(p->ws + WS_MIG); float* of = (float*)(p->ws + WS_MFG);
            const float bi = p->ml_b_gates[j * 16 + c], bfg = p->ml_b_gates[j * 16 + 8 + c];
#pragma unroll
            for (int mi = 0; mi < 2; ++mi)
#pragma unroll
                for (int r = 0; r < 16; ++r) {
                    const int t = t0 + mi * 32 + crow(r, lane);
                    oi[(size_t)t * 8 + c] = acc[mi][0][r] + bi;
                    const float f = acc[mi][1][r] + bfg;
                    of[(size_t)t * 8 + c] = fminf(f, 0.f) - log1pf(__expf(-fabsf(f)));
                }
        }
    }
};

struct OutProj {
    const Params* p; const float* W; const float* src; int layer, tm, tn;
    DI int kt() const { return 16; }
    DI int ldb() const { return 1024; }
    DI const bf16_t* a_base() const { return (const bf16_t*)(p->ws + WS_YMIX); }
    DI int a_off(int r) const { return (tm * 128 + r) * 1024; }
    DI const float* b_col(int g, int& width) const { width = 32; return W + tn * 128 + g * 32; }
    DI const bf16_t* b_base() const { return (const bf16_t*)(p->ws + WS_WOUT) + (size_t)(layer * 8 + tn) * 128 * 1024; }
    DI void epi(f32x16 (&acc)[2][2], int wr, int wc, int lane, unsigned char* wl) const {
        const int c = lane & 31, t0 = tm * 128 + wr * 64, wid = wr * 2 + wc;
        float* fl = (float*)(wl + wid * 8192);
#pragma unroll
        for (int mi = 0; mi < 2; ++mi)
#pragma unroll
            for (int ni = 0; ni < 2; ++ni)
#pragma unroll
                for (int r = 0; r < 16; ++r) fl[(mi * 32 + crow(r, lane)) * 64 + ni * 32 + c] = acc[mi][ni][r];
        const float* mod = (const float*)(p->ws + WS_MOD) + (size_t)layer * 8 * 6144;
        const int ch = lane & 15, n = tn * 128 + wc * 64 + ch * 4;
        const f32x4 g = *(const f32x4*)(mod + (t0 >> 11) * 6144 + 2048 + n);
        float* part = (float*)(p->ws + WS_PART);
#pragma unroll 4
        for (int i = 0; i < 16; ++i) {
            const int row = (lane >> 4) + 4 * i, t = t0 + row;
            const f32x4 a = *(const f32x4*)(fl + row * 64 + ch * 4);
            const f32x4 o = *(const f32x4*)(src + (size_t)t * 1024 + n) + g * a;
            *(f32x4*)(p->out + (size_t)t * 1024 + n) = o;
            float ss = o[0] * o[0] + o[1] * o[1] + o[2] * o[2] + o[3] * o[3];
            ss += sx_f<1>(ss); ss += sx_f<2>(ss); ss += sx_f<4>(ss); ss += sx_f<8>(ss);
            if (ch == 0) part[(size_t)t * 16 + tn * 2 + wc] = ss;
        }
    }
};

struct Moe1 {
    const Params* p; int layer, e, mt, nt, cnt, roff;
    DI int kt() const { return 16; }
    DI int ldb() const { return DEXP; }
    DI const bf16_t* a_base() const { return (const bf16_t*)(p->ws + WS_H); }
    DI int a_off(int r) const {
        const int rr = mt * 128 + r; if (rr >= cnt) return -1;
        const int a = ((const int*)(p->ws + WS_ELIST))[(size_t)e * NASG + rr];
        return (a >> 1) * 1024;
    }
    DI const float* b_col(int g, int& width) const {
        width = 32;
        const float* base = (nt & 1) ? p->moe_w_up : p->moe_w_gate;
        return base + ((size_t)layer * NEXP + e) * (size_t)(D * DEXP) + 128 * (nt >> 1) + 32 * g;
    }
    DI const bf16_t* b_base() const { return (const bf16_t*)(p->ws + WS_WM1) + (size_t)((layer * NEXP + e) * 8 + nt) * 128 * 1024; }
    DI void epi(f32x16 (&acc)[2][2], int wr, int wc, int lane, unsigned char* wl) const {
        const int c = lane & 31, pr = nt * 2 + wc;
        bf16_t* ob = (bf16_t*)(p->ws + WS_H1);
#pragma unroll
        for (int mi = 0; mi < 2; ++mi)
#pragma unroll
            for (int r = 0; r < 16; ++r) {
                const float g = acc[mi][0][r], u = acc[mi][1][r];
                stage_put<32>(wl, mi, 0, r, lane, g / (1.f + __expf(-g)) * u);
            }
        const int rb = mt * 128 + wr * 64;
        stage_flush<32>(wl, lane, [&](int row) { return rb + row < cnt ? ob + (size_t)(roff + rb + row) * 512 + 32 * pr : (bf16_t*)nullptr; });
    }
};

struct Moe2 {
    const Params* p; int layer, e, mt, nt, cnt, roff;
    DI int kt() const { return 8; }
    DI int ldb() const { return D; }
    DI const bf16_t* a_base() const { return (const bf16_t*)(p->ws + WS_H1); }
    DI int a_off(int r) const { const int rr = mt * 128 + r; if (rr >= cnt) return -1; return (roff + rr) * 512; }
    DI const float* b_col(int g, int& width) const { width = 32; return p->moe_w_down + ((size_t)layer * NEXP + e) * (size_t)(DEXP * D) + nt * 128 + g * 32; }
    DI const bf16_t* b_base() const { return (const bf16_t*)(p->ws + WS_WM2) + (size_t)((layer * NEXP + e) * 8 + nt) * 128 * 512; }
    DI void epi(f32x16 (&acc)[2][2], int wr, int wc, int lane, unsigned char* wl) const {
        const int c = lane & 31;
        bf16_t* ob = (bf16_t*)(p->ws + WS_Y);
        const int* el = (const int*)(p->ws + WS_ELIST) + (size_t)e * NASG;
#pragma unroll
        for (int mi = 0; mi < 2; ++mi)
#pragma unroll
            for (int r = 0; r < 16; ++r) { stage_put<64>(wl, mi, 0, r, lane, acc[mi][0][r]); stage_put<64>(wl, mi, 1, r, lane, acc[mi][1][r]); }
        const int rb = mt * 128 + wr * 64;
        stage_flush<64>(wl, lane, [&](int row) { return rb + row < cnt ? ob + (size_t)el[rb + row] * 1024 + nt * 128 + wc * 64 : (bf16_t*)nullptr; });
    }
};

DI void convert_moe_layers(const Params& p, int l0, int l1, unsigned char* smem, int bid, int nb, int tid) {
    const int PER = 32 * 8 * 16 + 32 * 8 * 8, total = (l1 - l0) * PER;
    for (int item = bid; item < total; item += nb) {
        const int l = l0 + item / PER; int ci = item % PER;
        if (ci < 4096) { const int kt = ci & 15, nt = (ci >> 4) & 7, e = ci >> 7; Moe1 pr{&p, l, e, 0, nt, 0, 0}; convert_tile(pr, (bf16_t*)(p.ws + WS_WM1) + (size_t)((l * 32 + e) * 8 + nt) * 128 * 1024, 1024, kt, smem, tid); }
        else { ci -= 4096; const int kt = ci & 7, nt = (ci >> 3) & 7, e = ci >> 6; Moe2 pr{&p, l, e, 0, nt, 0, 0}; convert_tile(pr, (bf16_t*)(p.ws + WS_WM2) + (size_t)((l * 32 + e) * 8 + nt) * 128 * 512, 512, kt, smem, tid); }
    }
    __syncthreads();
}

DI void phase_init(const Params& p, unsigned char* smem, int bid, int nb, int tid) {
    float* sc = (float*)smem;
    float* red = (float*)(smem + 32768);
    const int NMOD = DEPTH * 96, NROPE = 256;
    const int C_HYB = 2 * 22 * 16, C_ML = 2 * 25 * 16, C_OUT = 4 * 8 * 16;
    for (int ci = bid; ci < C_HYB + C_ML + C_OUT; ci += nb) {
        int c2 = ci;
        if (c2 < C_HYB) { const int kt = c2 & 15, tn = (c2 >> 4) % 22, j = (c2 >> 4) / 22; HybCols8 pr{&p, j, 0, tn}; convert_tile(pr, (bf16_t*)(p.ws + WS_WHYB) + (size_t)(j * 22 + tn) * 128 * 1024, 1024, kt, smem, tid); continue; }
        c2 -= C_HYB;
        if (c2 < C_ML) { const int kt = c2 & 15, tn = (c2 >> 4) % 25, j = (c2 >> 4) / 25; MlCols8 pr{&p, j, 0, tn}; convert_tile(pr, (bf16_t*)(p.ws + WS_WML) + (size_t)(j * 25 + tn) * 128 * 1024, 1024, kt, smem, tid); continue; }
        c2 -= C_ML;
        { const int kt = c2 & 15, tn = (c2 >> 4) & 7, l = c2 >> 7; const float* W = ((l & 1) ? p.ml_w_out : p.hy_w_out) + (size_t)(l >> 1) * 1024 * 1024;
            OutProj pr{&p, W, nullptr, l, 0, tn}; convert_tile(pr, (bf16_t*)(p.ws + WS_WOUT) + (size_t)(l * 8 + tn) * 128 * 1024, 1024, kt, smem, tid); }
    }
    for (int item = bid; item < NMOD; item += nb) {
        __syncthreads();
        for (int i = tid; i < 8 * 1024; i += 256) { const float v = p.c[i]; sc[i] = v / (1.f + __expf(-v)); }
        __syncthreads();
        const int l = item / 96, jb = item % 96, cq = tid & 15, ksl = tid >> 4;
        const float* w = p.ada_w + (size_t)l * 1024 * 6144 + jb * 64 + cq * 4;
        f32x4 acc[8];
#pragma unroll
        for (int b = 0; b < 8; ++b) acc[b] = (f32x4){0.f, 0.f, 0.f, 0.f};
        for (int ii = 0; ii < 64; ++ii) {
            const int i = ksl * 64 + ii;
            const f32x4 wv = *(const f32x4*)(w + (size_t)i * 6144);
#pragma unroll
            for (int b = 0; b < 8; ++b) acc[b] += wv * sc[b * 1024 + i];
        }
#pragma unroll
        for (int b = 0; b < 8; ++b) *(f32x4*)(red + (ksl * 8 + b) * 64 + cq * 4) = acc[b];
        __syncthreads();
        for (int o = tid; o < 512; o += 256) {
            const int b = o >> 6, cc = o & 63; float s = 0.f;
            for (int k = 0; k < 16; ++k) s += red[(k * 8 + b) * 64 + cc];
            ((float*)(p.ws + WS_MOD))[((size_t)l * 8 + b) * 6144 + jb * 64 + cc] = s + p.ada_b[l * 6144 + jb * 64 + cc];
        }
    }
    for (int item = bid; item < NROPE + 1; item += nb) {
        if (item < NROPE) {
            const int idx = item * 256 + tid;
            const int pos = idx >> 5, i = idx & 31;
            const float inv = 1.0f / powf(10000.0f, (float)(2 * i) / 64.0f);
            const float ang = (float)pos * inv;
            ((float*)(p.ws + WS_ROPEC))[idx] = cosf(ang);
            ((float*)(p.ws + WS_ROPES))[idx] = sinf(ang);
        } else {
            if (tid < DEPTH * 32) ((int*)(p.ws + WS_ECNT))[tid * ECS] = 0;
        }
    }
    __syncthreads();
    convert_moe_layers(p, 0, 1, smem, bid, nb, tid);
}

DI void phase_norm(const Params& p, int layer, const float* src, int bid, int nb, int tid) {
    const int lane = tid & 63, wid = tid >> 6;
    const float* mod = (const float*)(p.ws + WS_MOD) + (size_t)layer * 8 * 6144;
    const float* gam = p.norm_mix + layer * 1024;
    bf16_t* H = (bf16_t*)(p.ws + WS_H);
    for (int item = bid; item < T / 4; item += nb) {
        const int t = item * 4 + wid, b = t >> 11;
        const float* xr = src + (size_t)t * 1024;
        f32x4 v[4]; float ss = 0.f;
#pragma unroll
        for (int i = 0; i < 4; ++i) { v[i] = *(const f32x4*)(xr + (lane + 64 * i) * 4); ss += v[i][0] * v[i][0] + v[i][1] * v[i][1] + v[i][2] * v[i][2] + v[i][3] * v[i][3]; }
        ss = wave_sum(ss);
        const float rstd = rsqrtf(ss * (1.f / 1024.f) + EPS);
#pragma unroll
        for (int i = 0; i < 4; ++i) {
            const int c0 = (lane + 64 * i) * 4;
            const f32x4 g = *(const f32x4*)(gam + c0), sh = *(const f32x4*)(mod + b * 6144 + c0), sc = *(const f32x4*)(mod + b * 6144 + 1024 + c0);
            f32x4 h = v[i] * rstd * g * (sc + 1.f) + sh;
            u32x2 o = {pk2(h[0], h[1]), pk2(h[2], h[3])};
            *(u32x2*)(H + (size_t)t * 1024 + c0) = o;
        }
    }
}

DI void phase_ffn_norm_router(const Params& p, int layer, unsigned char* smem, int bid, int nb, int tid) {
    float* rstd_s = (float*)smem;
    float* lg = (float*)(smem + 512);
    float* hs = (float*)(smem + 512 + 32 * 37 * 4);
    float* wcs = (float*)(smem + 5248 + 2 * 32 * 65 * 4);
    const int lane = tid & 63, og = __builtin_amdgcn_readfirstlane(tid >> 6), tok = lane & 31, kh = lane >> 5;
    const float* mod = (const float*)(p.ws + WS_MOD) + (size_t)layer * 8 * 6144;
    const float* gam = p.norm_ffn + layer * 1024;
    const float* wg = p.moe_w_group + (size_t)layer * 1024 * 4;
    const float* we = p.moe_w_expert + (size_t)layer * 1024 * 32;
    bf16_t* H = (bf16_t*)(p.ws + WS_H);
    int* ecnt = (int*)(p.ws + WS_ECNT) + layer * 32 * ECS;
    int* elist = (int*)(p.ws + WS_ELIST);
    float* ew = (float*)(p.ws + WS_EW);
    for (int item = bid; item < T / 32; item += nb) {
        const int t0 = item * 32, b = t0 >> 11;
        __syncthreads();
        if (tid < 32) {
            const f32x4* pp = (const f32x4*)((const float*)(p.ws + WS_PART) + (size_t)(t0 + tid) * 16);
            const f32x4 a = pp[0], b4 = pp[1], c4 = pp[2], d4 = pp[3];
            const float ss = ((a[0] + a[1]) + (a[2] + a[3])) + ((b4[0] + b4[1]) + (b4[2] + b4[3])) + ((c4[0] + c4[1]) + (c4[2] + c4[3])) + ((d4[0] + d4[1]) + (d4[2] + d4[3]));
            rstd_s[tid] = rsqrtf(ss * (1.f / 1024.f) + EPS);
        }
        const int stok = tid >> 3, sk0 = (tid & 7) * 8;
        const float* xrow = p.out + (size_t)(t0 + stok) * 1024 + sk0;
        const float* mrow = mod + b * 6144 + sk0;
        f32x4 xa[2], ga[2], sha[2], sca[2], wa[3], xb[2], gb2[2], shb[2], scb[2], wb2[3];
#define FFN_LOAD(xv, gv, shv, scv, wv, k0) do { _Pragma("unroll") for (int q = 0; q < 2; ++q) { xv[q] = *(const f32x4*)(xrow + (k0) + 4 * q); gv[q] = *(const f32x4*)(gam + sk0 + (k0) + 4 * q); \
            shv[q] = *(const f32x4*)(mrow + 3072 + (k0) + 4 * q); scv[q] = *(const f32x4*)(mrow + 4096 + (k0) + 4 * q); } \
            wv[0] = *(const f32x4*)(we + (k0) * 32 + tid * 4); wv[1] = *(const f32x4*)(we + (k0) * 32 + 1024 + tid * 4); wv[2] = *(const f32x4*)(wg + (k0) * 4 + (tid & 63) * 4); } while (0)
#define FFN_STEP(xv, gv, shv, scv, wv, kc) do { const int k0 = (kc) * 64; float* hb = hs + ((kc) & 1) * (32 * 65); float* wb = wcs + ((kc) & 1) * (64 * 40); u32x4 ho; \
            _Pragma("unroll") for (int q = 0; q < 2; ++q) { const f32x4 h = xv[q] * srstd * gv[q] * (scv[q] + 1.f) + shv[q]; ho[2 * q] = pk2(h[0], h[1]); ho[2 * q + 1] = pk2(h[2], h[3]); \
                float* hp = hb + stok * 65 + sk0 + 4 * q; hp[0] = h[0]; hp[1] = h[1]; hp[2] = h[2]; hp[3] = h[3]; } \
            *(u32x4*)(H + (size_t)(t0 + stok) * 1024 + k0 + sk0) = ho; \
            *(f32x4*)(wb + (tid >> 3) * 40 + 4 + (tid & 7) * 4) = wv[0]; *(f32x4*)(wb + (32 + (tid >> 3)) * 40 + 4 + (tid & 7) * 4) = wv[1]; if (tid < 64) *(f32x4*)(wb + tid * 40) = wv[2]; \
            if ((kc) + 2 < 16) FFN_LOAD(xv, gv, shv, scv, wv, k0 + 128); \
            __syncthreads(); \
            if (og < 3) { const float* hr = hb + tok * 65 + kh * 32; const float* wr_ = wb + kh * 32 * 40 + og * 12; \
                _Pragma("unroll 8") for (int kk = 0; kk < 32; ++kk) { const float hv = hr[kk]; \
                    acc[0] += *(const f32x4*)(wr_ + kk * 40) * hv; acc[1] += *(const f32x4*)(wr_ + kk * 40 + 4) * hv; acc[2] += *(const f32x4*)(wr_ + kk * 40 + 8) * hv; } } } while (0)
        FFN_LOAD(xa, ga, sha, sca, wa, 0);
        FFN_LOAD(xb, gb2, shb, scb, wb2, 64);
        __syncthreads();
        const float srstd = rstd_s[stok];
        f32x4 acc[3];
#pragma unroll
        for (int o = 0; o < 3; ++o) acc[o] = (f32x4){0.f, 0.f, 0.f, 0.f};
        for (int kc = 0; kc < 16; kc += 2) {
            FFN_STEP(xa, ga, sha, sca, wa, kc);
            FFN_STEP(xb, gb2, shb, scb, wb2, kc + 1);
        }
#undef FFN_STEP
#undef FFN_LOAD
        if (og < 3) {
#pragma unroll
            for (int o = 0; o < 3; ++o)
#pragma unroll
                for (int e = 0; e < 4; ++e) { const float v = acc[o][e] + sx_f<32>(acc[o][e]); if (kh == 0) lg[tok * 37 + og * 12 + 4 * o + e] = v; }
        }
        __syncthreads();
        if (tid < 32) {
            const int t = t0 + tid;
            float gl[4]; float gmax = -INFINITY; int gsel = 0;
#pragma unroll
            for (int g = 0; g < 4; ++g) { gl[g] = lg[tid * 37 + g] + p.moe_b_group[layer * 4 + g]; if (gl[g] > gmax) { gmax = gl[g]; gsel = g; } }
            float gsum = 0.f;
#pragma unroll
            for (int g = 0; g < 4; ++g) gsum += __expf(gl[g] - gmax);
            const float pg = 1.f / gsum;
            float v1 = -INFINITY, v2 = -INFINITY; int i1 = 0, i2 = 0;
            for (int jx = 0; jx < 8; ++jx) {
                const float v = lg[tid * 37 + 4 + gsel * 8 + jx] + p.moe_b_expert[layer * 32 + gsel * 8 + jx];
                if (v > v1) { v2 = v1; i2 = i1; v1 = v; i1 = jx; } else if (v > v2) { v2 = v; i2 = jx; }
            }
            const float e2 = __expf(v2 - v1), den = 1.f / (1.f + e2);
            const float w1 = pg * den, w2 = pg * e2 * den;
            const int ea = gsel * 8 + i1, eb = gsel * 8 + i2;
            int* cl = (int*)rstd_s + 32;
            cl[tid] = 0;
            const int la = atomicAdd(&cl[ea], 1);
            const int lb = atomicAdd(&cl[eb], 1);
            { const int n = cl[tid]; cl[32 + tid] = n > 0 ? atomicAdd(&ecnt[tid * ECS], n) : 0; }
            const int ra = cl[32 + ea] + la, rb = cl[32 + eb] + lb;
            elist[(size_t)ea * NASG + ra] = t * 2; ew[t * 2] = w1;
            elist[(size_t)eb * NASG + rb] = t * 2 + 1; ew[t * 2 + 1] = w2;
        }
    }
}

DI bool dense_item(int i, int NT, int xcd, int& tm, int& tn) {
    if (i >= 16 * NT) return false;
    const int mg = i / (8 * NT), r = i % (8 * NT);
    tn = r >> 3; tm = xcd * 16 + mg * 8 + (r & 7);
    return true;
}
template <class PR> DI void phase_hyb_in(const Params& p, int j, unsigned char* smem, int xcd, int lb, int nlb, int tid) {
    int tm, tn;
    for (int i = lb; dense_item(i, 22, xcd, tm, tn); i += nlb) { HybIn pr{&p, j, tm, tn}; gemm_tile(pr, smem, opq(tid)); }
}
DI void phase_ml_in(const Params& p, int j, unsigned char* smem, int xcd, int lb, int nlb, int tid) {
    int tm, tn;
    for (int i = lb; dense_item(i, 25, xcd, tm, tn); i += nlb) { MlIn pr{&p, j, tm, tn}; gemm_tile(pr, smem, opq(tid)); }
}
DI void phase_out_proj(const Params& p, int layer, const float* W, const float* src, unsigned char* smem, int xcd, int lb, int nlb, int tid) {
    int tm, tn;
    for (int i = lb; dense_item(i, 8, xcd, tm, tn); i += nlb) { OutProj pr{&p, W, src, layer, tm, tn}; gemm_tile(pr, smem, opq(tid)); }
}
template <int WHICH> DI void phase_moe(const Params& p, int layer, unsigned char* smem, int xcd, int lb, int nlb, int tid) {
    int* toff = (int*)(smem + 65600);
    __syncthreads();
    if (tid == 0) {
        const int* ecnt = (const int*)(p.ws + WS_ECNT) + layer * 32 * ECS;
        int ta = 0, ra = 0;
        for (int e = 0; e < 32; ++e) {
            const int c = ecnt[e * ECS];
            if ((e & 7) == xcd) { const int q = e >> 3; toff[q] = ta; toff[8 + q] = ra; toff[16 + q] = c; ta += (c + 127) >> 7; }
            ra += c;
        }
        toff[4] = ta;
    }
    __syncthreads();
    const int total = toff[4] * 8;
    for (int item = lb; item < total; item += nlb) {
        const int mg = item >> 3, nt = item & 7;
        int q = 0;
        while (q < 3 && toff[q + 1] <= mg) ++q;
        const int e = q * 8 + xcd, cnt = toff[16 + q], roff = toff[8 + q];
        if (WHICH == 1) { Moe1 pr{&p, layer, e, mg - toff[q], nt, cnt, roff}; gemm_tile(pr, smem, opq(tid)); }
        else { Moe2 pr{&p, layer, e, mg - toff[q], nt, cnt, roff}; gemm_tile(pr, smem, opq(tid)); }
    }
}

DI void phase_combine_norm(const Params& p, int layer, int bid, int nb, int tid) {
    const int lane = tid & 63, wid = tid >> 6;
    const float* mod = (const float*)(p.ws + WS_MOD) + (size_t)layer * 8 * 6144;
    const float* modn = mod + 8 * 6144;
    const float* gam = p.norm_mix + (layer + 1) * 1024;
    const bf16_t* Y = (const bf16_t*)(p.ws + WS_Y);
    const float* ew = (const float*)(p.ws + WS_EW);
    bf16_t* H = (bf16_t*)(p.ws + WS_H);
    const bool has_next = layer + 1 < DEPTH;
    for (int item = bid; item < T / 4; item += nb) {
        const int t = item * 4 + wid, b = t >> 11;
        const float w0 = ew[2 * t], w1 = ew[2 * t + 1];
        f32x4 v[4]; float ss = 0.f;
#pragma unroll
        for (int i = 0; i < 4; ++i) {
            const int c0 = (lane + 64 * i) * 4;
            v[i] = *(const f32x4*)(p.out + (size_t)t * 1024 + c0);
            const f32x4 g = *(const f32x4*)(mod + b * 6144 + 5120 + c0);
            const u32x2 y0 = *(const u32x2*)(Y + (size_t)(2 * t) * 1024 + c0), y1 = *(const u32x2*)(Y + (size_t)(2 * t + 1) * 1024 + c0);
            v[i][0] += g[0] * (w0 * bflo(y0[0]) + w1 * bflo(y1[0])); v[i][1] += g[1] * (w0 * bfhi(y0[0]) + w1 * bfhi(y1[0]));
            v[i][2] += g[2] * (w0 * bflo(y0[1]) + w1 * bflo(y1[1])); v[i][3] += g[3] * (w0 * bfhi(y0[1]) + w1 * bfhi(y1[1]));
            *(f32x4*)(p.out + (size_t)t * 1024 + c0) = v[i];
            ss += v[i][0] * v[i][0] + v[i][1] * v[i][1] + v[i][2] * v[i][2] + v[i][3] * v[i][3];
        }
        if (has_next) {
            ss = wave_sum(ss);
            const float rstd = rsqrtf(ss * (1.f / 1024.f) + EPS);
#pragma unroll
            for (int i = 0; i < 4; ++i) {
                const int c0 = (lane + 64 * i) * 4;
                const f32x4 g = *(const f32x4*)(gam + c0), sh = *(const f32x4*)(modn + b * 6144 + c0), sc = *(const f32x4*)(modn + b * 6144 + 1024 + c0);
                const f32x4 h = v[i] * rstd * g * (sc + 1.f) + sh;
                u32x2 o = {pk2(h[0], h[1]), pk2(h[2], h[3])};
                *(u32x2*)(H + (size_t)t * 1024 + c0) = o;
            }
        }
    }
}

DI unsigned sortable(float f) { const unsigned u = __float_as_uint(f); return (u & 0x80000000u) ? ~u : (u | 0x80000000u); }
DI int half_sum_i(int v) { v += sx_i<16>(v); v += sx_i<8>(v); v += sx_i<4>(v); v += sx_i<2>(v); v += sx_i<1>(v); return v; }

struct CvTask { const float* src; bf16_t* dst; int ldb, kdim; };
DI CvTask cv_task(const Params& p, int l0, int id) {
    const int PER = 32 * 8 * 16 * 4 + 32 * 8 * 8 * 4;
    const int l = l0 + id / PER; int ci = id % PER; CvTask t;
    if (ci < 16384) {
        const int g = ci & 3, kt = (ci >> 2) & 15, nt = (ci >> 6) & 7, e = ci >> 9; int w;
        Moe1 pr{&p, l, e, 0, nt, 0, 0};
        t.ldb = DEXP; t.kdim = 1024; t.src = pr.b_col(g, w) + (size_t)(kt * 64) * DEXP;
        t.dst = (bf16_t*)(p.ws + WS_WM1) + ((size_t)((l * 32 + e) * 8 + nt) * 128 + g * 32) * 1024 + kt * 64;
    } else {
        ci -= 16384;
        const int g = ci & 3, kt = (ci >> 2) & 7, nt = (ci >> 5) & 7, e = ci >> 8; int w;
        Moe2 pr{&p, l, e, 0, nt, 0, 0};
        t.ldb = D; t.kdim = 512; t.src = pr.b_col(g, w) + (size_t)(kt * 64) * D;
        t.dst = (bf16_t*)(p.ws + WS_WM2) + ((size_t)((l * 32 + e) * 8 + nt) * 128 + g * 32) * 512 + kt * 64;
    }
    return t;
}
DI void cv_issue(const CvTask& t, int lane, f32x4 (&rb)[8]) {
    const float* s = t.src + (size_t)((lane >> 3) * 8) * t.ldb + (lane & 7) * 4;
#pragma unroll
    for (int kk = 0; kk < 8; ++kk) rb[kk] = *(const f32x4*)(s + (size_t)kk * t.ldb);
}
DI void cv_finish(const CvTask& t, int lane, const f32x4 (&rb)[8]) {
    bf16_t* d = t.dst + (size_t)((lane & 7) * 4) * t.kdim + (lane >> 3) * 8;
#pragma unroll
    for (int jx = 0; jx < 4; ++jx) {
        u32x4 v = {pk2(rb[0][jx], rb[1][jx]), pk2(rb[2][jx], rb[3][jx]), pk2(rb[4][jx], rb[5][jx]), pk2(rb[6][jx], rb[7][jx])};
        *(u32x4*)(d + (size_t)jx * t.kdim) = v;
    }
}
DI void convert_moe_waves(const Params& p, int l0, int l1, int gwave, int nwaves, int lane) {
    const int total = (l1 - l0) * 24576;
    for (int id = gwave; id < total; id += 2 * nwaves) {
        f32x4 ra[8], rb[8];
        const CvTask t0 = cv_task(p, l0, id);
        cv_issue(t0, lane, ra);
        const bool two = id + nwaves < total;
        if (two) { const CvTask t1 = cv_task(p, l0, id + nwaves); cv_issue(t1, lane, rb); cv_finish(t0, lane, ra); cv_finish(t1, lane, rb); }
        else cv_finish(t0, lane, ra);
    }
}

DI void phase_dsa(const Params& p, int j, unsigned char* smem, int bid, int nb, int tid, int cv0 = 0, int cv1 = 0) {
    if (cv1 > cv0 && (bid & 1)) convert_moe_waves(p, cv0, cv1, bid * 4 + (tid >> 6), nb * 4, tid & 63);
    const int lane = tid & 63, wid = tid >> 6, c = lane & 31, hh = lane >> 5;
    unsigned* mw = (unsigned*)smem + wid * 256;
    const bf16_t* IQ = (const bf16_t*)(p.ws + WS_IQ);
    const bf16_t* IK = (const bf16_t*)(p.ws + WS_IK);
    const float* IW = (const float*)(p.ws + WS_IW);
    const bf16_t* Q = (const bf16_t*)(p.ws + WS_Q);
    const bf16_t* K = (const bf16_t*)(p.ws + WS_K);
    const bf16_t* VT = (const bf16_t*)(p.ws + WS_V);
    bf16_t* Y = (bf16_t*)(p.ws + WS_YMIX);
    const float gq = wave_max(fabsf(p.hy_q_norm[j * 64 + lane])), gk = wave_max(fabsf(p.hy_k_norm[j * 64 + lane]));
    const float LOG2E = 1.4426950408889634f;
    const float c1 = 0.125f * LOG2E, c2 = 8.f * gq * gk * LOG2E;
    const unsigned lt = (1u << c) - 1u;
    for (int it = bid, rnd = 0; it < 1024; it += nb, ++rnd) {
        const int item = (rnd & 1) ? (rnd + 1) * nb - 1 - bid : it;
        if (item >= 1024) continue;
        const int qt = 127 - (item >> 3), b = item & 7;
        const int pos0 = qt * 16 + 4 * wid;
        const size_t tb = (size_t)b * S, t0 = tb + pos0;
        const int tmax = (pos0 + 3) >> 5;
        if (pos0 >= 256) {
            bf16x8 iqf[4];
            {
                const int i = (c & 3) + 4 * (c >> 3), rh = (c >> 2) & 1, qq = 2 * rh + (i >> 3), hd = i & 7;
                const bf16_t* ip = IQ + (t0 + qq) * 512 + hd * 64 + 8 * hh;
#pragma unroll
                for (int ks = 0; ks < 4; ++ks) iqf[ks] = *(const bf16x8*)(ip + 16 * ks);
            }
            float* wl = (float*)(smem + 4096) + wid * 32 + hh * 16;
            if (c < 4) *(f32x4*)(wl + 4 * c) = *(const f32x4*)(IW + (t0 + 2 * hh) * 8 + 4 * c);
            unsigned sk[64][2];
            const bf16_t* kpi = IK + (tb + c) * 64 + 8 * hh;
            const int lim0 = pos0 + 2 * hh - c;
#pragma unroll
            for (int tile = 0; tile < 64; ++tile) {
                unsigned k0 = 0u, k1 = 0u;
                if (tile <= tmax) {
                    bf16x8 bk[4];
#pragma unroll
                    for (int ks = 0; ks < 4; ++ks) bk[ks] = *(const bf16x8*)(kpi + 16 * ks);
                    kpi += 32 * 64;
                    asm volatile("" : "+v"(kpi));
                    f32x16 acc;
#pragma unroll
                    for (int r = 0; r < 16; ++r) acc[r] = 0.f;
#pragma unroll
                    for (int ks = 0; ks < 4; ++ks) acc = __builtin_amdgcn_mfma_f32_32x32x16_bf16(iqf[ks], bk[ks], acc, 0, 0, 0);
                    float s0 = 0.f, s1 = 0.f;
#pragma unroll
                    for (int q4 = 0; q4 < 2; ++q4) {
                        const f32x4 wa = *(const f32x4*)(wl + 4 * q4), wb = *(const f32x4*)(wl + 8 + 4 * q4);
#pragma unroll
                        for (int e = 0; e < 4; ++e) { s0 += fmaxf(acc[4 * q4 + e], 0.f) * wa[e]; s1 += fmaxf(acc[8 + 4 * q4 + e], 0.f) * wb[e]; }
                    }
                    k0 = tile * 32 <= lim0 ? sortable(s0) : 0u;
                    k1 = tile * 32 <= lim0 + 1 ? sortable(s1) : 0u;
                }
                sk[tile][0] = k0; sk[tile][1] = k1;
            }
            unsigned v0 = 0u, v1 = 0u; bool d0 = false, d1 = false;
            const int tg = tmax >> 3;
            for (int bit = 31; bit >= 0; --bit) {
                const unsigned c0 = v0 | (1u << bit), c1b = v1 | (1u << bit);
                int n0 = 0, n1 = 0;
#pragma unroll
                for (int g = 0; g < 8; ++g) {
                    if (g <= tg) {
#pragma unroll
                        for (int u = 0; u < 8; ++u) { n0 += sk[g * 8 + u][0] >= c0 ? 1 : 0; n1 += sk[g * 8 + u][1] >= c1b ? 1 : 0; }
                    }
                }
                const int n01 = half_sum_i(n0 | (n1 << 16));
                n0 = n01 & 0xffff; n1 = n01 >> 16;
                if (!d0 && n0 >= 256) { v0 = c0; d0 = n0 == 256; }
                if (!d1 && n1 >= 256) { v1 = c1b; d1 = n1 == 256; }
                if (__all(d0 && d1)) break;
            }
            int g0 = 0, g1 = 0;
#pragma unroll
            for (int g = 0; g < 8; ++g) {
                if (g <= tg) {
#pragma unroll
                    for (int u = 0; u < 8; ++u) { g0 += sk[g * 8 + u][0] > v0 ? 1 : 0; g1 += sk[g * 8 + u][1] > v1 ? 1 : 0; }
                }
            }
            const int g01 = half_sum_i(g0 | (g1 << 16));
            const int need0 = 256 - (g01 & 0xffff), need1 = 256 - (g01 >> 16);
            int run0 = 0, run1 = 0;
#pragma unroll
            for (int tile = 0; tile < 64; ++tile) {
                if (tile <= tmax) {
                    const unsigned k0 = sk[tile][0], k1 = sk[tile][1];
                    const bool tie0 = k0 == v0, tie1 = k1 == v1;
                    const unsigned long long tb0 = __ballot(tie0), tb1 = __ballot(tie1);
                    const unsigned th0 = hh ? (unsigned)(tb0 >> 32) : (unsigned)tb0, th1 = hh ? (unsigned)(tb1 >> 32) : (unsigned)tb1;
                    const bool sel0 = k0 > v0 || (tie0 && run0 + __popc(th0 & lt) < need0);
                    const bool sel1 = k1 > v1 || (tie1 && run1 + __popc(th1 & lt) < need1);
                    run0 += __popc(th0); run1 += __popc(th1);
                    const unsigned long long sb0 = __ballot(sel0), sb1 = __ballot(sel1);
                    if (lane == 0) { u32x4 o = {(unsigned)sb0, (unsigned)sb1, (unsigned)(sb0 >> 32), (unsigned)(sb1 >> 32)}; *(u32x4*)(mw + tile * 4) = o; }
                }
            }
        } else {
            const int tile = lane >> 2, qq = lane & 3, pq = pos0 + qq;
            if (tile <= tmax) {
                unsigned m;
                if (32 * tile + 31 <= pq) m = 0xffffffffu; else if (32 * tile > pq) m = 0u; else m = (2u << (pq - 32 * tile)) - 1u;
                mw[tile * 4 + qq] = m;
            }
        }
        bf16x8 qf[4];
        {
            const bf16_t* qp = Q + (t0 + (c >> 3)) * 512 + (c & 7) * 64 + 8 * hh;
#pragma unroll
            for (int ks = 0; ks < 4; ++ks) qf[ks] = *(const bf16x8*)(qp + 16 * ks);
        }
        f32x16 o0, o1;
#pragma unroll
        for (int r = 0; r < 16; ++r) { o0[r] = 0.f; o1[r] = 0.f; }
        float lsum = 0.f;
        const int kperm = (c & ~12) | ((c & 4) << 1) | ((c & 8) >> 1);
        const bf16_t* kp = K + (tb + kperm) * 64 + 8 * hh;
        const bf16_t* vp = VT + ((size_t)(b * 64 + c)) * S + 8 * hh;
        bf16x8 kf[4], vf[4];
#pragma unroll
        for (int ks = 0; ks < 4; ++ks) kf[ks] = *(const bf16x8*)(kp + 16 * ks);
        vf[0] = *(const bf16x8*)(vp); vf[1] = *(const bf16x8*)(vp + (size_t)32 * S); vf[2] = *(const bf16x8*)(vp + 16); vf[3] = *(const bf16x8*)(vp + (size_t)32 * S + 16);
        for (int tile = 0; tile <= tmax; ++tile) {
            const unsigned mword = mw[tile * 4 + (c >> 3)];
            bf16x8 kc[4], vc[4];
#pragma unroll
            for (int ks = 0; ks < 4; ++ks) { kc[ks] = kf[ks]; vc[ks] = vf[ks]; }
            if (tile < tmax) {
                kp += 32 * 64; vp += 32;
#pragma unroll
                for (int ks = 0; ks < 4; ++ks) kf[ks] = *(const bf16x8*)(kp + 16 * ks);
                vf[0] = *(const bf16x8*)(vp); vf[1] = *(const bf16x8*)(vp + (size_t)32 * S); vf[2] = *(const bf16x8*)(vp + 16); vf[3] = *(const bf16x8*)(vp + (size_t)32 * S + 16);
            }
            f32x16 x;
#pragma unroll
            for (int r = 0; r < 16; ++r) x[r] = 0.f;
#pragma unroll
            for (int ks = 0; ks < 4; ++ks) x = __builtin_amdgcn_mfma_f32_32x32x16_bf16(kc[ks], qf[ks], x, 0, 0, 0);
#pragma unroll
            for (int s = 0; s < 2; ++s) {
                const unsigned bits = mword >> (16 * s + 8 * hh);
                float pr[8];
#pragma unroll
                for (int jx = 0; jx < 8; ++jx) {
                    const float e = __builtin_amdgcn_exp2f(x[8 * s + jx] * c1 - c2);
                    pr[jx] = __uint_as_float(__float_as_uint(e) & (unsigned)__builtin_amdgcn_sbfe((int)bits, jx, 1));
                    lsum += pr[jx];
                }
                u32x4 pk = {pk2(pr[0], pr[1]), pk2(pr[2], pr[3]), pk2(pr[4], pr[5]), pk2(pr[6], pr[7])};
                const bf16x8 pf = __builtin_bit_cast(bf16x8, pk);
                o0 = __builtin_amdgcn_mfma_f32_32x32x16_bf16(vc[2 * s], pf, o0, 0, 0, 0);
                o1 = __builtin_amdgcn_mfma_f32_32x32x16_bf16(vc[2 * s + 1], pf, o1, 0, 0, 0);
            }
        }
        lsum += sx_f<32>(lsum);
        const float inv = 1.f / lsum;
        bf16_t* yp = Y + (t0 + (c >> 3)) * 1024 + (c & 7) * 64 + 4 * hh;
#pragma unroll
        for (int g4 = 0; g4 < 4; ++g4) {
            u32x2 a = {pk2(o0[4 * g4] * inv, o0[4 * g4 + 1] * inv), pk2(o0[4 * g4 + 2] * inv, o0[4 * g4 + 3] * inv)};
            u32x2 bq = {pk2(o1[4 * g4] * inv, o1[4 * g4 + 1] * inv), pk2(o1[4 * g4 + 2] * inv, o1[4 * g4 + 3] * inv)};
            *(u32x2*)(yp + 8 * g4) = a;
            *(u32x2*)(yp + 32 + 8 * g4) = bq;
        }
    }
    if (cv1 > cv0 && !(bid & 1)) convert_moe_waves(p, cv0, cv1, bid * 4 + (tid >> 6), nb * 4, tid & 63);
}

DI void phase_conv(const Params& p, int j, int bid, int nb, int tid) {
    const bf16_t* Z = (const bf16_t*)(p.ws + WS_Z);
    const bf16_t* BG = (const bf16_t*)(p.ws + WS_BG);
    bf16_t* Y = (bf16_t*)(p.ws + WS_YMIX);
    const float* cw = p.hy_conv_w + (size_t)j * 3 * 512;
    for (int item = bid; item < T / 4; item += nb) {
        const int t = item * 4 + (tid >> 6), c0 = (tid & 63) * 8, pos = t & (S - 1);
        float acc[8];
#pragma unroll
        for (int e = 0; e < 8; ++e) acc[e] = 0.f;
#pragma unroll
        for (int jj = 0; jj < 3; ++jj) {
            const int dp = jj - 2;
            if (pos + dp >= 0) {
                const u32x4 z = *(const u32x4*)(Z + (size_t)(t + dp) * 512 + c0);
#pragma unroll
                for (int e = 0; e < 4; ++e) { acc[2 * e] += cw[jj * 512 + c0 + 2 * e] * bflo(z[e]); acc[2 * e + 1] += cw[jj * 512 + c0 + 2 * e + 1] * bfhi(z[e]); }
            }
        }
        const u32x4 g = *(const u32x4*)(BG + (size_t)t * 512 + c0);
        u32x4 o;
#pragma unroll
        for (int e = 0; e < 4; ++e) o[e] = pk2(acc[2 * e] * bflo(g[e]), acc[2 * e + 1] * bfhi(g[e]));
        *(u32x4*)(Y + (size_t)t * 1024 + 512 + c0) = o;
    }
}

DI float wave_incl_sum(float x, int lane) { for (int d = 1; d < 64; d <<= 1) { const float t = lane_get_f(x, lane >= d ? lane - d : lane); if (lane >= d) x += t; } return x; }
DI float wave_incl_max(float x, int lane) { for (int d = 1; d < 64; d <<= 1) { const float t = lane_get_f(x, lane >= d ? lane - d : lane); if (lane >= d) x = fmaxf(x, t); } return x; }
DI bf16x8 scale_frag(bf16x8 f, const float* w8) {
    const u32x4 u = __builtin_bit_cast(u32x4, f);
    u32x4 o;
#pragma unroll
    for (int e = 0; e < 4; ++e) o[e] = pk2(bflo(u[e]) * w8[2 * e], bfhi(u[e]) * w8[2 * e + 1]);
    return __builtin_bit_cast(bf16x8, o);
}

DI void phase_ml1(const Params& p, unsigned char* smem, int bid, int nb, int tid) {
    const int lane = tid & 63, wid = tid >> 6, c = lane & 31, hh = lane >> 5;
    float* wsl = (float*)smem + wid * 64;
    const bf16_t* KT = (const bf16_t*)(p.ws + WS_MKT);
    const bf16_t* VT = (const bf16_t*)(p.ws + WS_MV);
    const float* MIG = (const float*)(p.ws + WS_MIG);
    const float* MFG = (const float*)(p.ws + WS_MFG);
    float* UB = (float*)(p.ws + WS_UBUF);
    float* UN = (float*)(p.ws + WS_UNBUF);
    float* ML = (float*)(p.ws + WS_MLOC);
    for (int item = bid; item < 2048; item += nb) {
        const int bh = item >> 5, ch = item & 31, b = bh >> 3, h = bh & 7;
        const size_t tb = (size_t)b * S + ch * 64;
        const float lf = MFG[(tb + lane) * 8 + h], ig = MIG[(tb + lane) * 8 + h];
        const float bc = wave_incl_sum(lf, lane);
        const float blast = lane_get_f(bc, 63);
        const float g = blast - bc + ig;
        const float gmax = wave_max(g);
        wsl[lane] = __expf(g - gmax);
        if (wid == 0 && lane == 0) { ML[item * 2] = blast; ML[item * 2 + 1] = gmax; }
        f32x16 u0, u1;
#pragma unroll
        for (int r = 0; r < 16; ++r) { u0[r] = 0.f; u1[r] = 0.f; }
        const bf16_t* vp = VT + ((size_t)(bh * 128 + wid * 32 + c)) * S + ch * 64 + 8 * hh;
        const bf16_t* kp = KT + ((size_t)(bh * 64 + c)) * S + ch * 64 + 8 * hh;
#pragma unroll
        for (int ks = 0; ks < 4; ++ks) {
            float w8[8];
            const f32x4 wa = *(const f32x4*)(wsl + 16 * ks + 8 * hh), wb = *(const f32x4*)(wsl + 16 * ks + 8 * hh + 4);
            w8[0] = wa[0]; w8[1] = wa[1]; w8[2] = wa[2]; w8[3] = wa[3]; w8[4] = wb[0]; w8[5] = wb[1]; w8[6] = wb[2]; w8[7] = wb[3];
            const bf16x8 va = *(const bf16x8*)(vp + 16 * ks);
            const bf16x8 k0 = scale_frag(*(const bf16x8*)(kp + 16 * ks), w8);
            const bf16x8 k1 = scale_frag(*(const bf16x8*)(kp + (size_t)32 * S + 16 * ks), w8);
            u0 = __builtin_amdgcn_mfma_f32_32x32x16_bf16(va, k0, u0, 0, 0, 0);
            u1 = __builtin_amdgcn_mfma_f32_32x32x16_bf16(va, k1, u1, 0, 0, 0);
        }
        float* up = UB + ((size_t)item * 128 + wid * 32) * 64 + c;
#pragma unroll
        for (int r = 0; r < 16; ++r) { const int v = crow(r, lane); up[v * 64] = u0[r]; up[v * 64 + 32] = u1[r]; }
        if (wid == 0) {
            const u32x4* kr = (const u32x4*)(KT + ((size_t)(bh * 64 + lane)) * S + ch * 64);
            float a = 0.f;
#pragma unroll
            for (int q = 0; q < 8; ++q) { const u32x4 u = kr[q];
#pragma unroll
                for (int e = 0; e < 4; ++e) a += wsl[q * 8 + 2 * e] * bflo(u[e]) + wsl[q * 8 + 2 * e + 1] * bfhi(u[e]); }
            UN[(size_t)item * 64 + lane] = a;
        }
    }
}

DI void phase_ml2(const Params& p, unsigned char* smem, int bid, int nb, int tid) {
    float* dec = (float*)smem;
    float* scl = dec + 32;
    const float* UB = (const float*)(p.ws + WS_UBUF);
    const float* UN = (const float*)(p.ws + WS_UNBUF);
    const float* ML = (const float*)(p.ws + WS_MLOC);
    bf16_t* CB = (bf16_t*)(p.ws + WS_CBUF);
    float* NBF = (float*)(p.ws + WS_NBUF);
    float* MST = (float*)(p.ws + WS_MST);
    for (int item = bid; item < 512; item += nb) {
        const int bh = item >> 3, sl = item & 7;
        __syncthreads();
        if (tid == 0) {
            float m = 0.f;
            for (int ch = 0; ch < 32; ++ch) {
                const float bl = ML[(bh * 32 + ch) * 2], gm = ML[(bh * 32 + ch) * 2 + 1];
                const float mn = fmaxf(bl + m, gm);
                dec[ch] = __expf(bl + m - mn); scl[ch] = __expf(gm - mn);
                if (sl == 0) MST[bh * 32 + ch] = m;
                m = mn;
            }
        }
        __syncthreads();
        f32x4 st = {0.f, 0.f, 0.f, 0.f};
        const size_t e0 = (size_t)sl * 1024 + tid * 4;
        f32x4 ub[32];
#pragma unroll
        for (int ch = 0; ch < 32; ++ch) ub[ch] = *(const f32x4*)(UB + ((size_t)(bh * 32 + ch)) * 8192 + e0);
#pragma unroll
        for (int ch = 0; ch < 32; ++ch) {
            st = st * dec[ch] + ub[ch] * scl[ch];
            u32x2 o = {pk2(st[0], st[1]), pk2(st[2], st[3])};
            *(u32x2*)(CB + ((size_t)(bh * 32 + ch)) * 8192 + e0) = o;
        }
        if (sl == 0 && tid < 64) {
            float nst = 0.f, un[32];
#pragma unroll
            for (int ch = 0; ch < 32; ++ch) un[ch] = UN[(size_t)(bh * 32 + ch) * 64 + tid];
#pragma unroll
            for (int ch = 0; ch < 32; ++ch) { nst = nst * dec[ch] + un[ch] * scl[ch]; NBF[(size_t)(bh * 32 + ch) * 64 + tid] = nst; }
        }
    }
}

DI void phase_ml3(const Params& p, int j, unsigned char* smem, int bid, int nb, int tid) {
    const int lane = tid & 63, wid = tid >> 6, c = lane & 31, hh = lane >> 5;
    float* al = (float*)smem + wid * 64;
    float* ssum = (float*)smem + 256;
    const bf16_t* MQ = (const bf16_t*)(p.ws + WS_MQ);
    const bf16_t* MK = (const bf16_t*)(p.ws + WS_MK);
    const bf16_t* VT = (const bf16_t*)(p.ws + WS_MV);
    const float* MIG = (const float*)(p.ws + WS_MIG);
    const float* MFG = (const float*)(p.ws + WS_MFG);
    const bf16_t* MOG = (const bf16_t*)(p.ws + WS_MOG);
    const bf16_t* CB = (const bf16_t*)(p.ws + WS_CBUF);
    const float* NBF = (const float*)(p.ws + WS_NBUF);
    const float* MST = (const float*)(p.ws + WS_MST);
    bf16_t* Y = (bf16_t*)(p.ws + WS_YMIX);
    const int kperm = (c & ~12) | ((c & 4) << 1) | ((c & 8) >> 1);
    for (int item = bid; item < 2048; item += nb) {
        const int bh = item >> 5, ch = item & 31, b = bh >> 3, h = bh & 7;
        const size_t tb = (size_t)b * S + ch * 64;
        const float lf = MFG[(tb + lane) * 8 + h], ig = MIG[(tb + lane) * 8 + h];
        const float bc = wave_incl_sum(lf, lane);
        const float av = ig - bc;
        const float mprev = MST[item];
        const float Mv = fmaxf(mprev, wave_incl_max(av, lane));
        __syncthreads();
        al[lane] = av;
        float Mt[2], wint[2], emt[2];
#pragma unroll
        for (int tt = 0; tt < 2; ++tt) { Mt[tt] = lane_get_f(Mv, 32 * tt + c); wint[tt] = __expf(mprev - Mt[tt]); emt[tt] = __expf(-(lane_get_f(bc, 32 * tt + c) + Mt[tt])); }
        bf16x8 qf[2][4], kf[2][4];
#pragma unroll
        for (int tt = 0; tt < 2; ++tt) {
            const bf16_t* qp = MQ + (tb + 32 * tt + c) * 512 + h * 64 + 8 * hh;
            const bf16_t* kp = MK + (tb + 32 * tt + kperm) * 512 + h * 64 + 8 * hh;
#pragma unroll
            for (int ks = 0; ks < 4; ++ks) { qf[tt][ks] = *(const bf16x8*)(qp + 16 * ks); kf[tt][ks] = *(const bf16x8*)(kp + 16 * ks); }
        }
        f32x16 o[2];
#pragma unroll
        for (int tt = 0; tt < 2; ++tt)
#pragma unroll
            for (int r = 0; r < 16; ++r) o[tt][r] = 0.f;
        float nq[2] = {0.f, 0.f};
        if (ch > 0) {
            const bf16_t* cp = CB + ((size_t)(item - 1) * 128 + wid * 32 + c) * 64 + 8 * hh;
            const float* np = NBF + (size_t)(item - 1) * 64 + 8 * hh;
#pragma unroll
            for (int ks = 0; ks < 4; ++ks) {
                const bf16x8 cf = *(const bf16x8*)(cp + 16 * ks);
                o[0] = __builtin_amdgcn_mfma_f32_32x32x16_bf16(cf, qf[0][ks], o[0], 0, 0, 0);
                o[1] = __builtin_amdgcn_mfma_f32_32x32x16_bf16(cf, qf[1][ks], o[1], 0, 0, 0);
                const f32x4 n0 = *(const f32x4*)(np + 16 * ks), n1 = *(const f32x4*)(np + 16 * ks + 4);
#pragma unroll
                for (int tt = 0; tt < 2; ++tt) {
                    const u32x4 u = __builtin_bit_cast(u32x4, qf[tt][ks]);
                    nq[tt] += n0[0] * bflo(u[0]) + n0[1] * bfhi(u[0]) + n0[2] * bflo(u[1]) + n0[3] * bfhi(u[1]) + n1[0] * bflo(u[2]) + n1[1] * bfhi(u[2]) + n1[2] * bflo(u[3]) + n1[3] * bfhi(u[3]);
                }
            }
#pragma unroll
            for (int tt = 0; tt < 2; ++tt) {
                nq[tt] += sx_f<32>(nq[tt]);
#pragma unroll
                for (int r = 0; r < 16; ++r) o[tt][r] *= wint[tt];
            }
        }
        float csum[2] = {0.f, 0.f};
        const bf16_t* vp = VT + ((size_t)(bh * 128 + wid * 32 + c)) * S + ch * 64 + 8 * hh;
#pragma unroll
        for (int tt = 0; tt < 2; ++tt) {
#pragma unroll
            for (int st = 0; st <= tt; ++st) {
                f32x16 x;
#pragma unroll
                for (int r = 0; r < 16; ++r) x[r] = 0.f;
#pragma unroll
                for (int ks = 0; ks < 4; ++ks) x = __builtin_amdgcn_mfma_f32_32x32x16_bf16(kf[st][ks], qf[tt][ks], x, 0, 0, 0);
#pragma unroll
                for (int k2 = 0; k2 < 2; ++k2) {
                    const int s0 = 32 * st + 16 * k2 + 8 * hh;
                    const f32x4 a0 = *(const f32x4*)(al + s0), a1 = *(const f32x4*)(al + s0 + 4);
                    const float a8[8] = {a0[0], a0[1], a0[2], a0[3], a1[0], a1[1], a1[2], a1[3]};
                    float pr[8];
#pragma unroll
                    for (int jx = 0; jx < 8; ++jx) {
                        const float e = __expf(a8[jx] - Mt[tt]) * x[8 * k2 + jx];
                        pr[jx] = (st < tt || s0 + jx <= 32 * tt + c) ? e : 0.f;
                        csum[tt] += pr[jx];
                    }
                    u32x4 pk = {pk2(pr[0], pr[1]), pk2(pr[2], pr[3]), pk2(pr[4], pr[5]), pk2(pr[6], pr[7])};
                    const bf16x8 vf = *(const bf16x8*)(vp + 32 * st + 16 * k2);
                    o[tt] = __builtin_amdgcn_mfma_f32_32x32x16_bf16(vf, __builtin_bit_cast(bf16x8, pk), o[tt], 0, 0, 0);
                }
            }
        }
        float ss[2];
#pragma unroll
        for (int tt = 0; tt < 2; ++tt) {
            csum[tt] += sx_f<32>(csum[tt]);
            const float den = wint[tt] * nq[tt] + csum[tt];
            const float rd = 1.f / fmaxf(fabsf(den), emt[tt]);
            float s2 = 0.f;
#pragma unroll
            for (int r = 0; r < 16; ++r) { o[tt][r] *= rd; s2 += o[tt][r] * o[tt][r]; }
            s2 += sx_f<32>(s2);
            ss[tt] = s2;
            if (hh == 0) ssum[wid * 64 + 32 * tt + c] = s2;
        }
        __syncthreads();
#pragma unroll
        for (int tt = 0; tt < 2; ++tt) {
            const int tcol = 32 * tt + c;
            const float tot = ssum[tcol] + ssum[64 + tcol] + ssum[128 + tcol] + ssum[192 + tcol];
            const float rstd = rsqrtf(tot * (1.f / 128.f) + EPS);
            const size_t ro = (tb + tcol) * 1024 + h * 128 + wid * 32 + 4 * hh;
            const float* gp = p.ml_out_norm + j * 1024 + h * 128 + wid * 32 + 4 * hh;
#pragma unroll
            for (int g4 = 0; g4 < 4; ++g4) {
                const f32x4 gm = *(const f32x4*)(gp + 8 * g4);
                const u32x2 og = *(const u32x2*)(MOG + ro + 8 * g4);
                u32x2 ov = {pk2(o[tt][4 * g4] * rstd * gm[0] * bflo(og[0]), o[tt][4 * g4 + 1] * rstd * gm[1] * bfhi(og[0])),
                            pk2(o[tt][4 * g4 + 2] * rstd * gm[2] * bflo(og[1]), o[tt][4 * g4 + 3] * rstd * gm[3] * bfhi(og[1]))};
                *(u32x2*)(Y + ro + 8 * g4) = ov;
            }
        }
    }
}


namespace pg8 {
#define PG8_LAS __attribute__((address_space(3)))
typedef unsigned short bf16_t;
typedef short bf16x8 __attribute__((ext_vector_type(8)));
typedef float f32x4 __attribute__((ext_vector_type(4)));
typedef unsigned u32x4 __attribute__((ext_vector_type(4)));
constexpr int BM = 256, BK = 64, HALF = 128, HTB = HALF * BK * 2  , STAGE_BYTES = 8 * HTB, NXCD = 8, WGM = 8;

__host__ __device__ __forceinline__ int lds_byte(int r, int c) { const int st = (r >> 4) * 2 + (c >> 5), rr = r & 15, cc = c & 31, ob = rr * 64 + cc * 2; return st * 1024 + (ob ^ (((ob >> 9) & 1) << 5)); }
__host__ __device__ __forceinline__ void stage_rc(int b, int& R, int& C) { const int st = b / 1024, sb = b % 1024, swz = sb ^ (((sb >> 9) & 1) << 5); R = (st >> 1) * 16 + swz / 64; C = (st & 1) * 32 + (swz % 64) / 2; }
__host__ __device__ __forceinline__ int perm32(int rho) { const int n = rho >> 4, i = rho & 15; return 8 * (i >> 2) + 4 * n + (i & 3); }

struct Unit { int pm, pn; };
struct Gemm { const bf16_t* A; const bf16_t* Bt; int M, N, K; };

struct StaticOrder {
    int nM, nN, nwg, G, c;
    __host__ __device__ void init(int M, int N, int G_, int c_) { nM = M / BM; nN = N / BM; nwg = nM * nN; G = G_; c = c_; }
    __host__ __device__ bool next(int i, Unit& u) const {
        const long L = (long)i * G + c; if (L >= nwg) return false;
        int wgid = (int)L; { const int q = nwg / NXCD, r = nwg % NXCD, xcd = wgid % NXCD, off = wgid / NXCD; wgid = (xcd < r ? xcd * (q + 1) : r * (q + 1) + (xcd - r) * q) + off; }
        const int nig = WGM * nN, gid = wgid / nig, fm = gid * WGM, gsz = (nM - fm) < WGM ? (nM - fm) : WGM;
        u.pm = fm + ((wgid % nig) % gsz); u.pn = (wgid % nig) / gsz; return true;
    }
    static constexpr bool GATHER = false;
    __device__ __forceinline__ unsigned a_off(const Unit&, int) const { return 0u; }
    __device__ __forceinline__ void a_ready(const Unit&) const {}
    __device__ __forceinline__ void done(const Unit&) const {}
};


template <class Epi, class Sched, bool ALIGN_EPI = false, bool SP2 = false>
__device__ __forceinline__ void gemm_phase(PG8_LAS unsigned char* lds, const Gemm g, const Sched& S, const Epi& E, int tid512) {
    const int tid = opq(tid512), wid = __builtin_amdgcn_readfirstlane(tid >> 6), lane = tid & 63, wr = wid >> 2, wc = wid & 3, fr = lane & 15, fq = lane >> 4;
    const int K = g.K, nt = K / BK;
    unsigned voffA[2], voffB[2];
    int rowA[2];
#pragma unroll
    for (int i = 0; i < 2; ++i) { int R, C; stage_rc(tid * 16 + i * 8192, R, C); const int Rb = Epi::PERM ? ((R & ~31) + perm32(R & 31)) : R;
        voffA[i] = (unsigned)(R * K + C) * 2u; voffB[i] = (unsigned)(Rb * K + C) * 2u; rowA[i] = R; if (Sched::GATHER) voffA[i] = (unsigned)C * 2u; }
    const size_t kstep = (size_t)(BK * 2);
    const size_t hstep = (size_t)HALF * K * 2;
    const size_t tstep = 2 * hstep;
    const unsigned ldsw = (unsigned)wid * 1024u;
    const int aoff = lds_byte(wr * 64 + fr, fq * 8), boff = lds_byte(wc * 32 + fr, fq * 8);
#define PG8_SA(b, h) (((b) * 2 + (h)) * HTB)
#define PG8_SB(b, h) ((4 + (b) * 2 + (h)) * HTB)
#define PG8_STAGE(bufoff, gbase, voff) do { _Pragma("unroll") for (int _i = 0; _i < 2; ++_i) \
        __builtin_amdgcn_global_load_lds((const unsigned*)((const char*)(gbase) + (voff)[_i]), (PG8_LAS unsigned*)(lds + (bufoff) + ldsw + _i * 8192), 16, 0, 0); } while (0)
#define PG8_LDA(dst, b, h) do { _Pragma("unroll") for (int m = 0; m < 4; ++m) _Pragma("unroll") for (int k = 0; k < 2; ++k) dst[m][k] = *(const PG8_LAS bf16x8*)(lds + PG8_SA(b, h) + aoff + m * 2048 + k * 1024); } while (0)
#define PG8_LDB(dst, b, h) do { _Pragma("unroll") for (int n = 0; n < 2; ++n) _Pragma("unroll") for (int k = 0; k < 2; ++k) dst[n][k] = *(const PG8_LAS bf16x8*)(lds + PG8_SB(b, h) + boff + n * 2048 + k * 1024); } while (0)
#define PG8_MMA(ai, bj, At, Bt) do { __builtin_amdgcn_s_setprio(1); _Pragma("unroll") for (int m = 0; m < 4; ++m) _Pragma("unroll") for (int n = 0; n < 2; ++n) _Pragma("unroll") for (int k = 0; k < 2; ++k) \
        acc[ai][bj][m][n] = __builtin_amdgcn_mfma_f32_16x16x32_bf16(Bt[n][k], At[m][k], acc[ai][bj][m][n], 0, 0, 0); __builtin_amdgcn_s_setprio(0); } while (0)
#define PG8_WAIT_V(n) asm volatile("s_waitcnt vmcnt(" #n ")" ::: "memory")
#define PG8_WAIT_L(n) asm volatile("s_waitcnt lgkmcnt(" #n ")" ::: "memory")
#define PG8_BAR __builtin_amdgcn_s_barrier()
#define PG8_SCHED __builtin_amdgcn_sched_barrier(0)
    unsigned oaC[2][2], oaN[2][2];
#define PG8_GOFF(dst, unit) do { _Pragma("unroll") for (int _h = 0; _h < 2; ++_h) _Pragma("unroll") for (int _i = 0; _i < 2; ++_i) dst[_h][_i] = S.a_off(unit, _h * HALF + rowA[_i]) + voffA[_i]; } while (0)
#define PG8_STAGE_G(bufoff, offs, koff) do { _Pragma("unroll") for (int _i = 0; _i < 2; ++_i) \
        __builtin_amdgcn_global_load_lds((const unsigned*)(((const char*)g.A + (koff)) + (offs)[_i]), (PG8_LAS unsigned*)(lds + (bufoff) + ldsw + _i * 8192), 16, 0, 0); } while (0)
    Unit cur, nxt; int ui = 0;
    if (!S.next(0, cur)) return;
    if constexpr (Sched::GATHER) { PG8_GOFF(oaC, cur); PG8_GOFF(oaN, cur); }
    f32x4 acc[2][2][4][2];
#pragma unroll
    for (int a = 0; a < 2; ++a)
#pragma unroll
        for (int b = 0; b < 2; ++b)
#pragma unroll
            for (int m = 0; m < 4; ++m)
#pragma unroll
                for (int n = 0; n < 2; ++n) acc[a][b][m][n] = (f32x4){0.f, 0.f, 0.f, 0.f};
    bf16x8 At[4][2], B0[2][2], B1[2][2];
    const char* cA = (const char*)g.A + (size_t)cur.pm * tstep; const char* cB = (const char*)g.Bt + (size_t)cur.pn * tstep;
    S.a_ready(cur);
    if constexpr (SP2) {
        PG8_STAGE(PG8_SB(0, 0), cB, voffB); PG8_STAGE(PG8_SB(0, 1), cB + hstep, voffB);
        if constexpr (Sched::GATHER) { PG8_STAGE_G(PG8_SA(0, 0), oaC[0], 0); PG8_STAGE_G(PG8_SA(0, 1), oaC[1], 0); } else { PG8_STAGE(PG8_SA(0, 0), cA, voffA); PG8_STAGE(PG8_SA(0, 1), cA + hstep, voffA); }
        if (wr == 1) PG8_BAR;
        PG8_WAIT_V(2); PG8_BAR;
        PG8_STAGE(PG8_SB(1, 0), cB + kstep, voffB);
        if constexpr (Sched::GATHER) PG8_STAGE_G(PG8_SA(1, 0), oaC[0], kstep); else PG8_STAGE(PG8_SA(1, 0), cA + kstep, voffA);
        PG8_STAGE(PG8_SB(1, 1), cB + hstep + kstep, voffB);
        PG8_WAIT_V(6); PG8_BAR;
    } else {
        PG8_STAGE(PG8_SB(0, 0), cB, voffB); PG8_STAGE(PG8_SA(0, 0), cA, voffA); PG8_STAGE(PG8_SB(0, 1), cB + hstep, voffB); PG8_STAGE(PG8_SA(0, 1), cA + hstep, voffA);
        if (wr == 1) PG8_BAR;
        PG8_WAIT_V(4); PG8_BAR;
        PG8_STAGE(PG8_SB(1, 0), cB + kstep, voffB); PG8_STAGE(PG8_SA(1, 0), cA + kstep, voffA); PG8_STAGE(PG8_SB(1, 1), cB + hstep + kstep, voffB);
        PG8_WAIT_V(6); PG8_BAR;
    }
    for (;;) {
        const bool has_next = S.next(ui + 1, nxt);
        const char* nA = has_next ? (const char*)g.A + (size_t)nxt.pm * tstep : cA; const char* nB = has_next ? (const char*)g.Bt + (size_t)nxt.pn * tstep : cB;
        for (int t = 0; t < nt; t += 2) {
            const bool last = (t == nt - 2);
            const char* a1 = cA + (size_t)(t + 1) * kstep;
            const char* a2 = last ? nA : cA + (size_t)(t + 2) * kstep; const char* b2 = last ? nB : cB + (size_t)(t + 2) * kstep;
            const char* a3 = a2 + kstep; const char* b3 = b2 + kstep;
            if (last && has_next) S.a_ready(nxt);
            unsigned oaS[2][2]; size_t k2 = 0;
            if constexpr (Sched::GATHER) {
                if (last && has_next) PG8_GOFF(oaN, nxt);
                const bool fromN = last && has_next;
#pragma unroll
                for (int _h = 0; _h < 2; ++_h)
#pragma unroll
                    for (int _i = 0; _i < 2; ++_i) oaS[_h][_i] = fromN ? oaN[_h][_i] : oaC[_h][_i];
                k2 = last ? (size_t)0 : (size_t)(t + 2) * kstep;
            }
            if constexpr (SP2) {
            PG8_LDB(B0, 0, 0); PG8_LDB(B1, 0, 1); PG8_SCHED; PG8_LDA(At, 0, 0);
            if constexpr (Sched::GATHER) PG8_STAGE_G(PG8_SA(1, 1), oaC[1], (size_t)(t + 1) * kstep); else PG8_STAGE(PG8_SA(1, 1), a1 + hstep, voffA);
            PG8_WAIT_V(8); PG8_WAIT_L(0); PG8_BAR; PG8_MMA(0, 0, At, B0); PG8_MMA(0, 1, At, B1); PG8_BAR; PG8_SCHED;
            PG8_LDA(At, 0, 1); PG8_STAGE(PG8_SB(0, 0), b2, voffB); PG8_STAGE(PG8_SB(0, 1), b2 + hstep, voffB);
            if constexpr (Sched::GATHER) PG8_STAGE_G(PG8_SA(0, 0), oaS[0], k2); else PG8_STAGE(PG8_SA(0, 0), a2, voffA);
            PG8_WAIT_V(8); PG8_WAIT_L(0); PG8_BAR; PG8_MMA(1, 0, At, B0); PG8_MMA(1, 1, At, B1); PG8_BAR; PG8_SCHED;
            PG8_LDB(B0, 1, 0); PG8_LDB(B1, 1, 1); PG8_SCHED; PG8_LDA(At, 1, 0);
            if constexpr (Sched::GATHER) PG8_STAGE_G(PG8_SA(0, 1), oaS[1], k2); else PG8_STAGE(PG8_SA(0, 1), a2 + hstep, voffA);
            PG8_WAIT_V(8); PG8_WAIT_L(0); PG8_BAR; PG8_MMA(0, 0, At, B0); PG8_MMA(0, 1, At, B1); PG8_BAR; PG8_SCHED;
            PG8_LDA(At, 1, 1); PG8_STAGE(PG8_SB(1, 0), b3, voffB); PG8_STAGE(PG8_SB(1, 1), b3 + hstep, voffB);
            if constexpr (Sched::GATHER) PG8_STAGE_G(PG8_SA(1, 0), oaS[0], k2 + kstep); else PG8_STAGE(PG8_SA(1, 0), a3, voffA);
            PG8_WAIT_V(8); PG8_WAIT_L(0); PG8_BAR; PG8_MMA(1, 0, At, B0); PG8_MMA(1, 1, At, B1); PG8_BAR; PG8_SCHED;
            } else {
            PG8_LDB(B0, 0, 0); PG8_SCHED; PG8_LDA(At, 0, 0); PG8_STAGE(PG8_SA(1, 1), a1 + hstep, voffA);
            PG8_WAIT_L(8); PG8_BAR; PG8_WAIT_L(0); PG8_MMA(0, 0, At, B0); PG8_BAR; PG8_SCHED;
            PG8_LDB(B1, 0, 1); PG8_STAGE(PG8_SB(0, 0), b2, voffB);
            PG8_BAR; PG8_WAIT_L(0); PG8_MMA(0, 1, At, B1); PG8_BAR;
            PG8_LDA(At, 0, 1); PG8_STAGE(PG8_SA(0, 0), a2, voffA);
            PG8_BAR; PG8_WAIT_L(0); PG8_MMA(1, 0, At, B0); PG8_BAR; PG8_SCHED;
            PG8_STAGE(PG8_SB(0, 1), b2 + hstep, voffB);
            PG8_WAIT_V(6); PG8_BAR; PG8_MMA(1, 1, At, B1); PG8_BAR;
            PG8_LDB(B0, 1, 0); PG8_SCHED; PG8_LDA(At, 1, 0); PG8_STAGE(PG8_SA(0, 1), a2 + hstep, voffA);
            PG8_WAIT_L(8); PG8_BAR; PG8_WAIT_L(0); PG8_MMA(0, 0, At, B0); PG8_BAR; PG8_SCHED;
            PG8_LDB(B1, 1, 1); PG8_STAGE(PG8_SB(1, 0), b3, voffB);
            PG8_BAR; PG8_WAIT_L(0); PG8_MMA(0, 1, At, B1); PG8_BAR;
            PG8_LDA(At, 1, 1); PG8_STAGE(PG8_SA(1, 0), a3, voffA);
            PG8_BAR; PG8_WAIT_L(0); PG8_MMA(1, 0, At, B0); PG8_BAR; PG8_SCHED;
            PG8_STAGE(PG8_SB(1, 1), b3 + hstep, voffB);
            PG8_WAIT_V(6); PG8_BAR; PG8_MMA(1, 1, At, B1); PG8_BAR;
            }
        }
        if constexpr (ALIGN_EPI) { if (wr == 0) PG8_BAR; }
        if constexpr (!Epi::AFTER_DRAIN) { E(acc, cur, wr, wc, fr, fq); S.done(cur); }
        if (!has_next) break;
#pragma unroll
        for (int a = 0; a < 2; ++a)
#pragma unroll
            for (int b = 0; b < 2; ++b)
#pragma unroll
                for (int m = 0; m < 4; ++m)
#pragma unroll
                    for (int n = 0; n < 2; ++n) acc[a][b][m][n] = (f32x4){0.f, 0.f, 0.f, 0.f};
        cur = nxt; cA = nA; cB = nB; ++ui;
        if constexpr (Sched::GATHER) {
#pragma unroll
            for (int _h = 0; _h < 2; ++_h)
#pragma unroll
                for (int _i = 0; _i < 2; ++_i) oaC[_h][_i] = oaN[_h][_i];
        }
        if constexpr (ALIGN_EPI) { if (wr == 1) PG8_BAR; }
    }
    PG8_WAIT_V(0);
    if constexpr (!ALIGN_EPI) { if (wr == 0) PG8_BAR; }
    PG8_BAR;
    if constexpr (Epi::AFTER_DRAIN) { E.fused(acc, cur, wr, wc, fr, fq, lds, wid, lane); S.done(cur); }
#undef PG8_GOFF
#undef PG8_STAGE_G
#undef PG8_SA
#undef PG8_SB
#undef PG8_STAGE
#undef PG8_LDA
#undef PG8_LDB
#undef PG8_MMA
#undef PG8_WAIT_V
#undef PG8_WAIT_L
#undef PG8_BAR
#undef PG8_SCHED
}
}

struct OutEpi8 {
    static constexpr bool PERM = false, AFTER_DRAIN = false;
    const float* src; float* dst; const float* gate; float* part;
    __device__ __forceinline__ void operator()(const pg8::f32x4 (&acc)[2][2][4][2], const pg8::Unit& u, int wr, int wc, int fr, int fq) const {
#pragma unroll
        for (int ai = 0; ai < 2; ++ai)
#pragma unroll
            for (int m = 0; m < 4; ++m) {
                const int t = u.pm * 256 + ai * 128 + wr * 64 + m * 16 + fr;
                const float* gp = gate + (t >> 11) * 6144;
                float ss = 0.f;
#pragma unroll
                for (int bj = 0; bj < 2; ++bj)
#pragma unroll
                    for (int n = 0; n < 2; ++n) {
                        const int col = u.pn * 256 + bj * 128 + wc * 32 + n * 16 + fq * 4;
                        const pg8::f32x4 g = *(const pg8::f32x4*)(gp + col);
                        const pg8::f32x4 o = *(const pg8::f32x4*)(src + (size_t)t * 1024 + col) + g * acc[ai][bj][m][n];
                        *(pg8::f32x4*)(dst + (size_t)t * 1024 + col) = o;
                        ss += o[0] * o[0] + o[1] * o[1] + o[2] * o[2] + o[3] * o[3];
                    }
                ss += sx_f<16>(ss); ss += sx_f<32>(ss);
                if (fq == 0) part[(size_t)t * 16 + u.pn * 4 + wc] = ss;
            }
    }
};


DI unsigned cvtpk(float lo, float hi) { return pk2(lo, hi); }
struct HybEpi8 {
    static constexpr bool PERM = true, AFTER_DRAIN = false;
    const Params* p; int j;
    __device__ __forceinline__ void operator()(const pg8::f32x4 (&acc)[2][2][4][2], const pg8::Unit& u, int wr, int wc, int fr, int fq) const {
        unsigned char* ws = p->ws;
        const int un = u.pn;
        if (un < 5 && !(un == 4 && (wc == 1 || wc == 3))) {
            const bool donorm = un < 2 || (un == 4 && wc == 0);
            bf16_t* ob; int ld, cb; const float* gam = p->hy_q_norm + j * 64;
            if (un < 2) { ob = (bf16_t*)(ws + WS_Q); ld = 512; cb = 64 * (4 * un + wc); }
            else if (un < 4) { ob = (bf16_t*)(ws + WS_IQ); ld = 512; cb = 64 * (4 * (un - 2) + wc); }
            else if (wc == 0) { ob = (bf16_t*)(ws + WS_K); ld = 64; cb = 0; gam = p->hy_k_norm + j * 64; }
            else { ob = (bf16_t*)(ws + WS_IK); ld = 64; cb = 0; }
            pg8::f32x4 g0[2], g1[2];
#pragma unroll
            for (int n = 0; n < 2; ++n) { g0[n] = donorm ? *(const pg8::f32x4*)(gam + 8 * fq + 4 * n) : (pg8::f32x4){1.f, 1.f, 1.f, 1.f}; g1[n] = donorm ? *(const pg8::f32x4*)(gam + 32 + 8 * fq + 4 * n) : (pg8::f32x4){1.f, 1.f, 1.f, 1.f}; }
            const float* ropec = (const float*)(ws + WS_ROPEC);
            const float* ropes = (const float*)(ws + WS_ROPES);
#pragma unroll
            for (int ai = 0; ai < 2; ++ai)
#pragma unroll
                for (int m = 0; m < 4; ++m) {
                    const int t = opq(u.pm * 256 + ai * 128 + wr * 64 + m * 16 + fr), pos = t & (S - 1);
                    float rstd = 1.f;
                    if (donorm) {
                        float ss = 0.f;
#pragma unroll
                        for (int bj = 0; bj < 2; ++bj)
#pragma unroll
                            for (int n = 0; n < 2; ++n) { const pg8::f32x4 x = acc[ai][bj][m][n]; ss += x[0] * x[0] + x[1] * x[1] + x[2] * x[2] + x[3] * x[3]; }
                        ss += sx_f<16>(ss); ss += sx_f<32>(ss);
                        rstd = rsqrtf(ss * (1.f / 64.f) + EPS);
                    }
                    u32x4 o1, o2;
#pragma unroll
                    for (int n = 0; n < 2; ++n) {
                        const pg8::f32x4 cs = *(const pg8::f32x4*)(ropec + pos * 32 + 8 * fq + 4 * n), sn = *(const pg8::f32x4*)(ropes + pos * 32 + 8 * fq + 4 * n);
                        const pg8::f32x4 x1 = acc[ai][0][m][n] * rstd * g0[n], x2 = acc[ai][1][m][n] * rstd * g1[n];
                        const pg8::f32x4 y1 = x1 * cs - x2 * sn, y2 = x2 * cs + x1 * sn;
                        o1[2 * n] = cvtpk(y1[0], y1[1]); o1[2 * n + 1] = cvtpk(y1[2], y1[3]);
                        o2[2 * n] = cvtpk(y2[0], y2[1]); o2[2 * n + 1] = cvtpk(y2[2], y2[3]);
                    }
                    *(u32x4*)(ob + (size_t)t * ld + cb + 8 * fq) = o1;
                    *(u32x4*)(ob + (size_t)t * ld + cb + 32 + 8 * fq) = o2;
                }
        } else if (un == 4 && wc == 1) {
            bf16_t* ob = (bf16_t*)(ws + WS_V);
#pragma unroll
            for (int ai = 0; ai < 2; ++ai)
#pragma unroll
                for (int m = 0; m < 4; ++m) {
                    const int t = opq(u.pm * 256 + ai * 128 + wr * 64 + m * 16 + fr), pos = t & (S - 1), bb = t >> 11;
#pragma unroll
                    for (int bj = 0; bj < 2; ++bj)
#pragma unroll
                        for (int n = 0; n < 2; ++n)
#pragma unroll
                            for (int e = 0; e < 4; ++e) ob[((size_t)(bb * 64 + 32 * bj + 8 * fq + 4 * n + e)) * S + pos] = f2bf(acc[ai][bj][m][n][e]);
                }
        } else if (un == 4) {
            float* ob = (float*)(ws + WS_IW);
            if (fq == 0) {
#pragma unroll
                for (int ai = 0; ai < 2; ++ai)
#pragma unroll
                    for (int m = 0; m < 4; ++m) {
                        const int t = u.pm * 256 + ai * 128 + wr * 64 + m * 16 + fr;
                        *(pg8::f32x4*)(ob + (size_t)t * 8) = acc[ai][0][m][0] * (0.125f * 0.35355339059327373f);
                        *(pg8::f32x4*)(ob + (size_t)t * 8 + 4) = acc[ai][0][m][1] * (0.125f * 0.35355339059327373f);
                    }
            }
        } else if (un < 7) {
            bf16_t* ob = (bf16_t*)(ws + WS_BG);
#pragma unroll
            for (int ai = 0; ai < 2; ++ai)
#pragma unroll
                for (int m = 0; m < 4; ++m) {
                    const int t = opq(u.pm * 256 + ai * 128 + wr * 64 + m * 16 + fr);
#pragma unroll
                    for (int bj = 0; bj < 2; ++bj) {
                        const pg8::f32x4 a = acc[ai][bj][m][0], b = acc[ai][bj][m][1];
                        u32x4 o = {cvtpk(a[0], a[1]), cvtpk(a[2], a[3]), cvtpk(b[0], b[1]), cvtpk(b[2], b[3])};
                        *(u32x4*)(ob + (size_t)t * 512 + (un - 5) * 256 + 128 * bj + 32 * wc + 8 * fq) = o;
                    }
                }
        } else {
            bf16_t* ob = (bf16_t*)(ws + WS_Z);
#pragma unroll
            for (int ai = 0; ai < 2; ++ai)
#pragma unroll
                for (int m = 0; m < 4; ++m) {
                    const int t = opq(u.pm * 256 + ai * 128 + wr * 64 + m * 16 + fr);
                    const pg8::f32x4 a = acc[ai][0][m][0] * acc[ai][1][m][0], b = acc[ai][0][m][1] * acc[ai][1][m][1];
                    u32x4 o = {cvtpk(a[0], a[1]), cvtpk(a[2], a[3]), cvtpk(b[0], b[1]), cvtpk(b[2], b[3])};
                    *(u32x4*)(ob + (size_t)t * 512 + (un - 7) * 128 + 32 * wc + 8 * fq) = o;
                }
        }
    }
};


struct MlEpi8 {
    static constexpr bool PERM = true, AFTER_DRAIN = false;
    const Params* p; int j;
    __device__ __forceinline__ void operator()(const pg8::f32x4 (&acc)[2][2][4][2], const pg8::Unit& u, int wr, int wc, int fr, int fq) const {
        unsigned char* ws = p->ws;
        const int un = u.pn;
        if (un < 4 || un >= 8) {
            bf16_t* ob; int ld, cb0; float sc = 1.f;
            if (un < 2) { ob = (bf16_t*)(ws + WS_MQ); ld = 512; cb0 = 64 * (4 * un + wc); sc = 0.125f; }
            else if (un < 4) { ob = (bf16_t*)(ws + WS_MK); ld = 512; cb0 = 64 * (4 * (un - 2) + wc); }
            else { ob = (bf16_t*)(ws + WS_MOG); ld = 1024; cb0 = (un - 8) * 256 + 32 * wc; }
            const int bstep = un < 4 ? 32 : 128;
#pragma unroll
            for (int ai = 0; ai < 2; ++ai)
#pragma unroll
                for (int m = 0; m < 4; ++m) {
                    const int t = opq(u.pm * 256 + ai * 128 + wr * 64 + m * 16 + fr);
#pragma unroll
                    for (int bj = 0; bj < 2; ++bj) {
                        pg8::f32x4 a = acc[ai][bj][m][0] * sc, b = acc[ai][bj][m][1] * sc;
                        if (un >= 8) { for (int e = 0; e < 4; ++e) { a[e] = sigmoidf_(a[e]); b[e] = sigmoidf_(b[e]); } }
                        u32x4 o = {cvtpk(a[0], a[1]), cvtpk(a[2], a[3]), cvtpk(b[0], b[1]), cvtpk(b[2], b[3])};
                        *(u32x4*)(ob + (size_t)t * ld + cb0 + bstep * bj + 8 * fq) = o;
                    }
                }
        }
        if (un >= 2 && un < 8) {
            bf16_t* ob = (bf16_t*)(ws + (un < 4 ? WS_MKT : WS_MV));
#pragma unroll
            for (int ai = 0; ai < 2; ++ai)
#pragma unroll
                for (int m = 0; m < 4; ++m) {
                    const int t = opq(u.pm * 256 + ai * 128 + wr * 64 + m * 16 + fr), pos = t & (S - 1), bb = t >> 11;
#pragma unroll
                    for (int bj = 0; bj < 2; ++bj) {
                        const size_t rowb = un < 4 ? (size_t)((bb * 8 + 4 * (un - 2) + wc) * 64 + 32 * bj + 8 * fq) : (size_t)((bb * 8 + 2 * (un - 4) + bj) * 128 + 32 * wc + 8 * fq);
#pragma unroll
                        for (int n = 0; n < 2; ++n)
#pragma unroll
                            for (int e = 0; e < 4; ++e) ob[(rowb + 4 * n + e) * S + pos] = f2bf(acc[ai][bj][m][n][e]);
                    }
                }
        }
    }
};


struct MoeOrder8 {
    static constexpr bool GATHER = true;
    const int* tab; const int* elist; int G, c, total, mode;
    __device__ __forceinline__ bool next(int i, pg8::Unit& u) const {
        const int L = i * G + c; if (L >= total) return false;
        const int ru = L >> 2; int e = 0;
        while (e < 31 && tab[e + 1] <= ru) ++e;
        u.pm = __builtin_amdgcn_readfirstlane((e << 8) | (ru - tab[e])); u.pn = __builtin_amdgcn_readfirstlane(e * 4 + (L & 3)); return true;
    }
    __device__ __forceinline__ unsigned a_off(const pg8::Unit& u, int row) const {
        const int e = u.pm >> 8, lr = (u.pm & 255) * 256 + row;
        if (lr >= tab[40 + e]) return 0u;
        if (mode == 1) return (unsigned)(elist[e * NASG + lr] >> 1) * 2048u;
        return (unsigned)(tab[80 + e] + lr) * 1024u;
    }
    __device__ __forceinline__ void a_ready(const pg8::Unit&) const {}
    __device__ __forceinline__ void done(const pg8::Unit&) const {}
};
struct Moe1Epi8 {
    static constexpr bool PERM = true, AFTER_DRAIN = false;
    const int* tab; bf16_t* h1;
    __device__ __forceinline__ void operator()(const pg8::f32x4 (&acc)[2][2][4][2], const pg8::Unit& u, int wr, int wc, int fr, int fq) const {
        const int e = u.pm >> 8, mu = u.pm & 255, nu = u.pn & 3, cnt = tab[40 + e], roff = tab[80 + e];
#pragma unroll
        for (int ai = 0; ai < 2; ++ai)
#pragma unroll
            for (int m = 0; m < 4; ++m) {
                const int lr = opq(mu * 256 + ai * 128 + wr * 64 + m * 16 + fr);
                if (lr < cnt) {
                    u32x4 o;
#pragma unroll
                    for (int n = 0; n < 2; ++n) {
                        const pg8::f32x4 g = acc[ai][0][m][n], up = acc[ai][1][m][n]; float h[4];
#pragma unroll
                        for (int x = 0; x < 4; ++x) h[x] = g[x] / (1.f + __expf(-g[x])) * up[x];
                        o[2 * n] = cvtpk(h[0], h[1]); o[2 * n + 1] = cvtpk(h[2], h[3]);
                    }
                    *(u32x4*)(h1 + (size_t)(roff + lr) * 512 + 128 * nu + 32 * wc + 8 * fq) = o;
                }
            }
    }
};
struct Moe2Epi8 {
    static constexpr bool PERM = true, AFTER_DRAIN = false;
    const int* tab; const int* elist; bf16_t* y;
    __device__ __forceinline__ void operator()(const pg8::f32x4 (&acc)[2][2][4][2], const pg8::Unit& u, int wr, int wc, int fr, int fq) const {
        const int e = u.pm >> 8, mu = u.pm & 255, nu = u.pn & 3, cnt = tab[40 + e];
#pragma unroll
        for (int ai = 0; ai < 2; ++ai)
#pragma unroll
            for (int m = 0; m < 4; ++m) {
                const int lr = opq(mu * 256 + ai * 128 + wr * 64 + m * 16 + fr);
                if (lr < cnt) {
                    const int a = elist[e * NASG + lr];
#pragma unroll
                    for (int bj = 0; bj < 2; ++bj) {
                        const pg8::f32x4 v0 = acc[ai][bj][m][0], v1 = acc[ai][bj][m][1];
                        u32x4 o = {cvtpk(v0[0], v0[1]), cvtpk(v0[2], v0[3]), cvtpk(v1[0], v1[1]), cvtpk(v1[2], v1[3])};
                        *(u32x4*)(y + (size_t)a * 1024 + 256 * nu + 128 * bj + 32 * wc + 8 * fq) = o;
                    }
                }
            }
    }
};

#define XB_TMO      128
#define XB_XCNT(j)  (256  + 64 * (j))
#define XB_XSUB(j)  (1280 + 64 * (j))
#define XB_XGEN(j)  (2304 + 64 * (j))
#define XB_TOP      3328
#define XB_TOPGEN   3392
#define XCD_BAR_WORDS 3456
#define XB_SPIN_CAP (1u << 22)
#define LAS __attribute__((address_space(3)))
DI unsigned xb_ld(unsigned* p) { return __hip_atomic_load(p, __ATOMIC_RELAXED, __HIP_MEMORY_SCOPE_AGENT); }
DI unsigned xb_add(unsigned* p, unsigned v) { return __hip_atomic_fetch_add(p, v, __ATOMIC_RELAXED, __HIP_MEMORY_SCOPE_AGENT); }
DI unsigned xb_xcc_id() { return (unsigned)__builtin_amdgcn_s_getreg((3 << 11) | 20) & 0xFu; }
#define XB_SPIN(cond, bar) do { unsigned _sp = 0; while (cond) { __builtin_amdgcn_s_sleep(1); \
    if ((++_sp & 255u) == 0u) { if (xb_ld(&(bar)[XB_TMO])) break; if (_sp > XB_SPIN_CAP) { atomicAdd(&(bar)[XB_TMO], 1u); break; } } } } while (0)
struct XcdBarrier { unsigned* bar; unsigned x; volatile LAS unsigned* st; };
DI XcdBarrier xcd_barrier_post(unsigned* bar, volatile LAS unsigned* st, bool leader) {
    XcdBarrier b; b.bar = bar; b.x = xb_xcc_id(); b.st = st;
    if (leader) (void)xb_add(&bar[XB_XCNT(b.x)], 1u);
    return b;
}
DI void xcd_barrier_complete(unsigned* bar, unsigned x, unsigned& nloc, unsigned& nx) {
    const unsigned G = gridDim.x * gridDim.y * gridDim.z;
    unsigned sum, cnt, mine, sp = 0u;
    for (;;) {
        sum = 0u; cnt = 0u; mine = 0u;
#pragma unroll
        for (unsigned j = 0; j < 16; ++j) { const unsigned c = xb_ld(&bar[XB_XCNT(j)]); sum += c; cnt += (c > 0u) ? 1u : 0u; mine = (j == x) ? c : mine; }
        if (sum == G) break;
        __builtin_amdgcn_s_sleep(1);
        if ((++sp & 255u) == 0u) { if (xb_ld(&bar[XB_TMO])) break; if (sp > XB_SPIN_CAP) { atomicAdd(&bar[XB_TMO], 1u); break; } }
    }
    nloc = mine > 0u ? mine : 1u; nx = cnt > 0u ? cnt : 1u;
}
DI void xcd_barrier(const XcdBarrier& b, bool leader) {
    asm volatile("s_waitcnt vmcnt(0)" ::: "memory");
    __syncthreads();
    if (leader) {
        unsigned* bar = b.bar;
        __builtin_amdgcn_s_waitcnt(0);
        unsigned nloc = b.st[0], nx = b.st[1];
        if (nloc == 0u) { xcd_barrier_complete(bar, b.x, nloc, nx); b.st[0] = nloc; b.st[1] = nx; }
        const unsigned old = xb_add(&bar[XB_XSUB(b.x)], 1u);
        const unsigned gen = old / nloc;
        if (old + 1u == (gen + 1u) * nloc) {
            __builtin_amdgcn_fence(__ATOMIC_RELEASE, "agent");
            asm volatile("s_waitcnt vmcnt(0)" ::: "memory");
            const unsigned og = xb_add(&bar[XB_TOP], 1u);
            const unsigned tg = og / nx;
            if (og + 1u == (tg + 1u) * nx) xb_add(&bar[XB_TOPGEN], 1u);
            else XB_SPIN(xb_ld(&bar[XB_TOPGEN]) == tg, bar);
            __builtin_amdgcn_fence(__ATOMIC_ACQUIRE, "agent");
            xb_add(&bar[XB_XGEN(b.x)], 1u);
            asm volatile("s_waitcnt vmcnt(0)" ::: "memory");
        } else {
            XB_SPIN(xb_ld(&bar[XB_XGEN(b.x)]) == gen, bar);
            __builtin_amdgcn_fence(__ATOMIC_ACQUIRE, "agent");
            asm volatile("s_waitcnt vmcnt(0)" ::: "memory");
        }
    }
    __syncthreads();
}

namespace cg = cooperative_groups;
constexpr int MEGA_LDS = 65536 + 256;

DI const Params& fresh(const Params* kp) { asm volatile("" : "+s"(kp)); return *kp; }

#ifndef PROBE_MASK
#define PROBE_MASK 0
#endif
__global__ void __launch_bounds__(512, 2) hybrid_fwd_megakernel(Params p_arg) {
    __shared__ __attribute__((aligned(16))) unsigned char smem_all[2 * MEGA_LDS + 1024];
    cg::grid_group grid = cg::this_grid();
    const Params* kp = (const Params*)__builtin_amdgcn_kernarg_segment_ptr();
    const int wave8 = __builtin_amdgcn_readfirstlane((int)(threadIdx.x >> 6));
    const int vb = wave8 >> 2;
#define tid0 ((wave8 & 3) * 64 + lane_id())
    unsigned char* smem = smem_all + vb * MEGA_LDS;
    const int bid0 = blockIdx.x * 2 + vb, nb = gridDim.x * 2;
    const int gx0 = blockIdx.x & 7, glb0 = (blockIdx.x >> 3) * 2 + vb, gnl = (gridDim.x >> 3) * 2;
#define bid opqs(bid0)
#define gx opqs(gx0)
#define glb opqs(glb0)
#define tid opq(tid0)
    volatile LAS unsigned* xst = (volatile LAS unsigned*)(smem_all + 2 * MEGA_LDS);
    if (wave8 == 0 && lane_id() == 0) { xst[0] = 0u; xst[1] = 0u; }
    __syncthreads();
    (void)xcd_barrier_post((unsigned*)(fresh(kp).ws + WS_BAR), xst, wave8 == 0 && lane_id() == 0);
    for (int rep = 0; rep < ((PROBE_MASK & 1) ? 2 : 1); ++rep) { phase_init(fresh(kp), smem, bid, nb, tid); }
#define GSYNC() do { XcdBarrier xb_; xb_.bar = (unsigned*)(fresh(kp).ws + WS_BAR); xb_.x = xb_xcc_id(); xb_.st = (volatile LAS unsigned*)(smem_all + 2 * MEGA_LDS); xcd_barrier(xb_, wave8 == 0 && lane_id() == 0); } while (0)
    if (fresh(kp).use_cg_sync) grid.sync();
    GSYNC();
#pragma unroll 1
    for (int layer = 0; layer < DEPTH; ++layer) {
        const int j = layer >> 1;
        if (layer == 0) { { const Params& p = fresh(kp); phase_norm(p, 0, p.x, bid, nb, tid); }
        GSYNC(); }
        if ((layer & 1) == 0) {
            for (int rep = 0; rep < ((PROBE_MASK & 4) ? 2 : 1); ++rep) { { const Params& p = fresh(kp);
              pg8::Gemm g8{(const pg8::bf16_t*)(p.ws + WS_H), (const pg8::bf16_t*)(p.ws + WS_WHYB) + (size_t)j * 2816 * 1024, T, 2816, 1024};
              pg8::StaticOrder S8; S8.init(T, 2816, (int)gridDim.x, (int)blockIdx.x);
              HybEpi8 E8{&p, j};
              pg8::gemm_phase<HybEpi8, pg8::StaticOrder, true, true>((PG8_LAS unsigned char*)smem_all, g8, S8, E8, wave8 * 64 + lane_id()); } }
            GSYNC();
            for (int rep = 0; rep < ((PROBE_MASK & 8) ? 2 : 1); ++rep) { phase_dsa(fresh(kp), j, smem, bid, nb, tid, layer == 0 ? 1 : 3, layer == 0 ? 3 : 4); }
            for (int rep = 0; rep < ((PROBE_MASK & 16) ? 2 : 1); ++rep) { phase_conv(fresh(kp), j, bid, nb, tid); }
            GSYNC();
            { const Params& p = fresh(kp);
              pg8::Gemm g8{(const pg8::bf16_t*)(p.ws + WS_YMIX), (const pg8::bf16_t*)(p.ws + WS_WOUT) + (size_t)layer * 1024 * 1024, T, 1024, 1024};
              pg8::StaticOrder S8; S8.init(T, 1024, (int)gridDim.x, (int)blockIdx.x);
              OutEpi8 E8{layer == 0 ? p.x : p.out, p.out, (const float*)(p.ws + WS_MOD) + (size_t)layer * 8 * 6144 + 2048, (float*)(p.ws + WS_PART)};
              pg8::gemm_phase<OutEpi8, pg8::StaticOrder, false, true>((PG8_LAS unsigned char*)smem_all, g8, S8, E8, wave8 * 64 + lane_id()); }
        } else {
            for (int rep = 0; rep < ((PROBE_MASK & 32) ? 2 : 1); ++rep) { { const Params& p = fresh(kp);
              pg8::Gemm g8{(const pg8::bf16_t*)(p.ws + WS_H), (const pg8::bf16_t*)(p.ws + WS_WML) + (size_t)j * 3200 * 1024, T, 3072, 1024};
              pg8::StaticOrder S8; S8.init(T, 3072, (int)gridDim.x, (int)blockIdx.x);
              MlEpi8 E8{&p, j};
              pg8::gemm_phase<MlEpi8, pg8::StaticOrder, true, true>((PG8_LAS unsigned char*)smem_all, g8, S8, E8, wave8 * 64 + lane_id());
              for (int gi = glb; gi < 16; gi += gnl) { MlGates pr{&p, j, gx * 16 + gi}; gemm_tile(pr, smem, tid); } } }
            GSYNC();
            for (int rep = 0; rep < ((PROBE_MASK & 64) ? 2 : 1); ++rep) { phase_ml1(fresh(kp), smem, bid, nb, tid); }
            GSYNC();
            for (int rep = 0; rep < ((PROBE_MASK & 128) ? 2 : 1); ++rep) { phase_ml2(fresh(kp), smem, bid, nb, tid); }
            GSYNC();
            for (int rep = 0; rep < ((PROBE_MASK & 256) ? 2 : 1); ++rep) { phase_ml3(fresh(kp), j, smem, bid, nb, tid); }
            GSYNC();
            { const Params& p = fresh(kp);
              pg8::Gemm g8{(const pg8::bf16_t*)(p.ws + WS_YMIX), (const pg8::bf16_t*)(p.ws + WS_WOUT) + (size_t)layer * 1024 * 1024, T, 1024, 1024};
              pg8::StaticOrder S8; S8.init(T, 1024, (int)gridDim.x, (int)blockIdx.x);
              OutEpi8 E8{p.out, p.out, (const float*)(p.ws + WS_MOD) + (size_t)layer * 8 * 6144 + 2048, (float*)(p.ws + WS_PART)};
              pg8::gemm_phase<OutEpi8, pg8::StaticOrder, false, true>((PG8_LAS unsigned char*)smem_all, g8, S8, E8, wave8 * 64 + lane_id()); }
        }
        GSYNC();
        phase_ffn_norm_router(fresh(kp), layer, smem, bid, nb, tid);
        GSYNC();
        { const Params& p = fresh(kp); unsigned char* wsu = uniform_ptr(p.ws);
          int* mtab = (int*)(smem_all + 2 * MEGA_LDS + 64);
          __syncthreads();
          if (wave8 == 0 && lane_id() == 0) {
              const int* ecnt = (const int*)(wsu + WS_ECNT) + layer * 32 * ECS; int ua = 0, ra = 0;
              for (int e = 0; e < 32; ++e) { const int cn = ecnt[e * ECS]; mtab[e] = ua; mtab[40 + e] = cn; mtab[80 + e] = ra; ua += (cn + 255) >> 8; ra += cn; }
              mtab[32] = ua;
          }
          __syncthreads();
          MoeOrder8 S8{mtab, (const int*)(wsu + WS_ELIST), (int)gridDim.x, (int)blockIdx.x, mtab[32] * 4, 1};
          pg8::Gemm g8{(const pg8::bf16_t*)(wsu + WS_H), (const pg8::bf16_t*)(wsu + WS_WM1) + (size_t)layer * 32 * 1024 * 1024, 0, 0, 1024};
          Moe1Epi8 E8{mtab, (bf16_t*)(wsu + WS_H1)};
          pg8::gemm_phase<Moe1Epi8, MoeOrder8, true, true>((PG8_LAS unsigned char*)smem_all, g8, S8, E8, wave8 * 64 + lane_id()); }
        GSYNC();
        { const Params& p = fresh(kp); unsigned char* wsu = uniform_ptr(p.ws);
          int* mtab = (int*)(smem_all + 2 * MEGA_LDS + 64);
          MoeOrder8 S8{mtab, (const int*)(wsu + WS_ELIST), (int)gridDim.x, (int)blockIdx.x, mtab[32] * 4, 2};
          pg8::Gemm g8{(const pg8::bf16_t*)(wsu + WS_H1), (const pg8::bf16_t*)(wsu + WS_WM2) + (size_t)layer * 32 * 1024 * 512, 0, 0, 512};
          Moe2Epi8 E8{mtab, (const int*)(wsu + WS_ELIST), (bf16_t*)(wsu + WS_Y)};
          pg8::gemm_phase<Moe2Epi8, MoeOrder8, true, true>((PG8_LAS unsigned char*)smem_all, g8, S8, E8, wave8 * 64 + lane_id()); }
        GSYNC();
        phase_combine_norm(fresh(kp), layer, bid, nb, tid);
        if (layer + 1 < DEPTH) GSYNC();
    }
}
#undef tid
#undef tid0
#undef bid
#undef gx
#undef glb
#undef GSYNC

extern "C" void kernel_launch(void* const* d_in, const int* in_sizes, int n_in, void* d_out, int out_size, void* d_ws, size_t ws_size, hipStream_t stream) {
    Params p{};
    const float** f = (const float**)&p;
    for (int i = 0; i < 22; ++i) f[i] = (const float*)d_in[i];
    p.out = (float*)d_out;
    p.ws = (unsigned char*)d_ws;
    if (ws_size < WS_END) { fprintf(stderr, "workspace too small: %zu < %zu\n", ws_size, (size_t)WS_END); return; }
    static int grid_blocks = 0;
    if (!grid_blocks) {
        int dev = 0, cus = 0, per_cu = 0;
        hipGetDevice(&dev);
        hipDeviceGetAttribute(&cus, hipDeviceAttributeMultiprocessorCount, dev);
        hipOccupancyMaxActiveBlocksPerMultiprocessor(&per_cu, hybrid_fwd_megakernel, 512, 0);
        if (per_cu > 1) per_cu = 1;
        grid_blocks = cus * per_cu;
    }
    (void)hipMemsetAsync((unsigned char*)d_ws + WS_BAR, 0, XCD_BAR_WORDS_C * 4, stream);
    void* args[] = {&p};
    hipError_t e = hipLaunchCooperativeKernel((void*)hybrid_fwd_megakernel, dim3(grid_blocks), dim3(512), args, 0, stream);
    if (e != hipSuccess) fprintf(stderr, "cooperative launch failed: %s (grid %d)\n", hipGetErrorString(e), grid_blocks);
}
```

```cpp
#include <hip/hip_runtime.h>
#include <hip/hip_cooperative_groups.h>
#include <stdint.h>
#include <cstdio>

#define DI __device__ __forceinline__
typedef unsigned short bf16_t;
typedef short bf16x8 __attribute__((ext_vector_type(8)));
typedef float f32x16 __attribute__((ext_vector_type(16)));
typedef float f32x4 __attribute__((ext_vector_type(4)));
typedef float f32x2 __attribute__((ext_vector_type(2)));
typedef unsigned u32x4 __attribute__((ext_vector_type(4)));
typedef unsigned u32x2 __attribute__((ext_vector_type(2)));
typedef __bf16 bf16x2_t __attribute__((ext_vector_type(2)));

constexpr int D = 1024, NB = 8, S = 2048, T = NB * S, DEPTH = 4;
constexpr int HYB_IN = 2760, ML_IN = 3088;
constexpr int NEXP = 32, DEXP = 512, NASG = T * 2;
constexpr float EPS = 1e-6f;
constexpr int XCD_BAR_WORDS_C = 3456;

constexpr size_t al256(size_t x) { return (x + 255) & ~(size_t)255; }
constexpr size_t WS_MOD = 0;
constexpr size_t WS_ROPEC = WS_MOD + al256((size_t)4 * 8 * 6144 * 4);
constexpr size_t WS_ROPES = WS_ROPEC + al256((size_t)2048 * 32 * 4);
constexpr size_t WS_ECNT = WS_ROPES + al256((size_t)2048 * 32 * 4);
constexpr int ECS = 64;
constexpr size_t WS_H = WS_ECNT + al256(4 * 32 * ECS * 4);
constexpr size_t WS_YMIX = WS_H + al256((size_t)T * 1024 * 2);
constexpr size_t WS_Q = WS_YMIX + al256((size_t)T * 1024 * 2);
constexpr size_t WS_K = WS_Q + al256((size_t)T * 512 * 2);
constexpr size_t WS_V = WS_K + al256((size_t)T * 64 * 2);
constexpr size_t WS_IQ = WS_V + al256((size_t)T * 64 * 2);
constexpr size_t WS_IK = WS_IQ + al256((size_t)T * 512 * 2);
constexpr size_t WS_IW = WS_IK + al256((size_t)T * 64 * 2);
constexpr size_t WS_BG = WS_IW + al256((size_t)T * 8 * 4);
constexpr size_t WS_Z = WS_BG + al256((size_t)T * 512 * 2);
constexpr size_t WS_MASK = WS_Z + al256((size_t)T * 512 * 2);
constexpr size_t WS_MQ = WS_MASK + al256((size_t)T * 64 * 4);
constexpr size_t WS_MK = WS_MQ + al256((size_t)T * 512 * 2);
constexpr size_t WS_MV = WS_MK + al256((size_t)T * 512 * 2);
constexpr size_t WS_MIG = WS_MV + al256((size_t)T * 1024 * 2);
constexpr size_t WS_MFG = WS_MIG + al256((size_t)T * 8 * 4);
constexpr size_t WS_MOG = WS_MFG + al256((size_t)T * 8 * 4);
constexpr size_t WS_EW = WS_MOG + al256((size_t)T * 1024 * 2);
constexpr size_t WS_ELIST = WS_EW + al256((size_t)NASG * 4);
constexpr size_t WS_H1 = WS_ELIST + al256((size_t)NEXP * NASG * 4);
constexpr size_t WS_Y = WS_H1 + al256((size_t)NASG * 512 * 2);
constexpr size_t WS_MKT = WS_Y + al256((size_t)NASG * 1024 * 2);
constexpr size_t WS_UBUF = WS_MKT + al256((size_t)64 * 64 * S * 2);
constexpr size_t WS_UNBUF = WS_UBUF + al256((size_t)64 * 32 * 8192 * 4);
constexpr size_t WS_MLOC = WS_UNBUF + al256((size_t)64 * 32 * 64 * 4);
constexpr size_t WS_CBUF = WS_MLOC + al256((size_t)64 * 32 * 2 * 4);
constexpr size_t WS_NBUF = WS_CBUF + al256((size_t)64 * 32 * 8192 * 2);
constexpr size_t WS_MST = WS_NBUF + al256((size_t)64 * 32 * 64 * 4);
constexpr size_t WS_PART = WS_MST + al256((size_t)64 * 32 * 4);
constexpr size_t WS_WHYB = WS_PART + al256((size_t)T * 16 * 4);
constexpr size_t WS_WML = WS_WHYB + al256((size_t)2 * 2816 * 1024 * 2);
constexpr size_t WS_WOUT = WS_WML + al256((size_t)2 * 3200 * 1024 * 2);
constexpr size_t WS_WM1 = WS_WOUT + al256((size_t)4 * 1024 * 1024 * 2);
constexpr size_t WS_WM2 = WS_WM1 + al256((size_t)4 * 32 * 1024 * 1024 * 2);
constexpr size_t WS_BAR = WS_WM2 + al256((size_t)4 * 32 * 1024 * 512 * 2);
constexpr size_t WS_END = WS_BAR + al256((size_t)XCD_BAR_WORDS_C * 4);

struct Params {
    const float *x, *c, *ada_w, *ada_b, *norm_mix, *norm_ffn, *hy_w_in, *hy_q_norm, *hy_k_norm, *hy_conv_w, *hy_w_out;
    const float *ml_w_in, *ml_b_gates, *ml_out_norm, *ml_w_out, *moe_w_group, *moe_b_group, *moe_w_expert, *moe_b_expert;
    const float *moe_w_gate, *moe_w_up, *moe_w_down;
    float* out;
    unsigned char* ws;
    unsigned long long use_cg_sync;
};

DI unsigned pk2(float lo, float hi) { f32x2 v = {lo, hi}; bf16x2_t b = __builtin_convertvector(v, bf16x2_t); return __builtin_bit_cast(unsigned, b); }
DI bf16_t f2bf(float x) { return (bf16_t)(pk2(x, 0.f) & 0xffffu); }
DI float bf2f(bf16_t h) { return __uint_as_float(((unsigned)h) << 16); }
DI float bflo(unsigned u) { return __uint_as_float(u << 16); }
DI float bfhi(unsigned u) { return __uint_as_float(u & 0xffff0000u); }
DI int lane_id() { int x; asm volatile("v_mbcnt_lo_u32_b32 %0, -1, 0\n\tv_mbcnt_hi_u32_b32 %0, -1, %0" : "=v"(x)); return x; }
template <int M> DI int sx_i(int v) {
    if constexpr (M < 32) return __builtin_amdgcn_ds_swizzle(v, (M << 10) | 0x1f);
    else return __builtin_amdgcn_ds_bpermute((lane_id() ^ 32) << 2, v);
}
template <int M> DI float sx_f(float v) { return __int_as_float(sx_i<M>(__float_as_int(v))); }
DI float lane_get_f(float v, int src) { return __int_as_float(__builtin_amdgcn_ds_bpermute(src << 2, __float_as_int(v))); }
DI float wave_sum(float v) { v += sx_f<32>(v); v += sx_f<16>(v); v += sx_f<8>(v); v += sx_f<4>(v); v += sx_f<2>(v); v += sx_f<1>(v); return v; }
DI float wave_max(float v) { v = fmaxf(v, sx_f<32>(v)); v = fmaxf(v, sx_f<16>(v)); v = fmaxf(v, sx_f<8>(v)); v = fmaxf(v, sx_f<4>(v)); v = fmaxf(v, sx_f<2>(v)); v = fmaxf(v, sx_f<1>(v)); return v; }
DI float half_sum(float v) { v += sx_f<16>(v); v += sx_f<8>(v); v += sx_f<4>(v); v += sx_f<2>(v); v += sx_f<1>(v); return v; }
DI float sigmoidf_(float x) { return 1.f / (1.f + __expf(-x)); }
DI unsigned char* uniform_ptr(unsigned char* q) {
    const unsigned long long w = (unsigned long long)q;
    const unsigned lo = __builtin_amdgcn_readfirstlane((unsigned)w), hi = __builtin_amdgcn_readfirstlane((unsigned)(w >> 32));
    return (unsigned char*)(((unsigned long long)hi << 32) | lo);
}
DI int opqs(int x) { asm volatile("" : "+s"(x)); return x; }
DI int opq(int x) { asm volatile("" : "+v"(x)); return x; }

DI int swz(int row, int slot) { return row * 128 + ((slot ^ ((row >> 1) & 7)) << 4); }
DI int crow(int reg, int lane) { return (reg & 3) + 8 * (reg >> 2) + 4 * (lane >> 5); }

template <class P>
DI void gemm_tile(const P& pr, unsigned char* smem, int tid) {
    const int lane = tid & 63, wid = tid >> 6, wr = wid >> 1, wc = wid & 1;
    const bf16_t* abase = pr.a_base();
    const bf16_t* bbase = pr.b_base();
    const int kdim = pr.kt() * 64;
    int gao[4], gbo[4];
#pragma unroll
    for (int i = 0; i < 4; ++i) {
        const int row = (tid >> 3) + 32 * i, sl = (tid & 7) ^ ((row >> 1) & 7);
        const int o = pr.a_off(row);
        gao[i] = (o >= 0 ? o : 0) + sl * 8; gbo[i] = row * kdim + sl * 8;
    }
#define GLDS(buf, kt) do { _Pragma("unroll") for (int i = 0; i < 4; ++i) { \
        __builtin_amdgcn_global_load_lds((const unsigned*)(abase + gao[i] + (kt) * 64), (__attribute__((address_space(3))) unsigned*)(smem + (buf) * 32768 + (i * 256 + wid * 64) * 16), 16, 0, 0); \
        __builtin_amdgcn_global_load_lds((const unsigned*)(bbase + gbo[i] + (kt) * 64), (__attribute__((address_space(3))) unsigned*)(smem + (buf) * 32768 + 16384 + (i * 256 + wid * 64) * 16), 16, 0, 0); } } while (0)
#define DMA_WAIT_SYNC() do { asm volatile("s_waitcnt vmcnt(0)" ::: "memory"); __syncthreads(); } while (0)
#define COMPUTE(buf) do { const unsigned char* As = smem + (buf) * 32768; const unsigned char* Bs = As + 16384; \
        _Pragma("unroll") for (int ks = 0; ks < 4; ++ks) { const int slot = ks * 2 + (lane >> 5); \
            const bf16x8 a0 = *(const bf16x8*)(As + swz(wr * 64 + (lane & 31), slot)); const bf16x8 a1 = *(const bf16x8*)(As + swz(wr * 64 + 32 + (lane & 31), slot)); \
            const bf16x8 b0 = *(const bf16x8*)(Bs + swz(wc * 64 + (lane & 31), slot)); const bf16x8 b1 = *(const bf16x8*)(Bs + swz(wc * 64 + 32 + (lane & 31), slot)); \
            acc[0][0] = __builtin_amdgcn_mfma_f32_32x32x16_bf16(a0, b0, acc[0][0], 0, 0, 0); acc[0][1] = __builtin_amdgcn_mfma_f32_32x32x16_bf16(a0, b1, acc[0][1], 0, 0, 0); \
            acc[1][0] = __builtin_amdgcn_mfma_f32_32x32x16_bf16(a1, b0, acc[1][0], 0, 0, 0); acc[1][1] = __builtin_amdgcn_mfma_f32_32x32x16_bf16(a1, b1, acc[1][1], 0, 0, 0); } } while (0)
    f32x16 acc[2][2];
#pragma unroll
    for (int a = 0; a < 2; ++a)
#pragma unroll
        for (int b = 0; b < 2; ++b)
#pragma unroll
            for (int r = 0; r < 16; ++r) acc[a][b][r] = 0.f;
    const int KT = pr.kt();
    __syncthreads();
    GLDS(0, 0);
    DMA_WAIT_SYNC();
    for (int kt = 0; kt < KT; kt += 2) {
        GLDS(1, kt + 1);
        COMPUTE(0);
        DMA_WAIT_SYNC();
        if (kt + 2 < KT) GLDS(0, kt + 2);
        COMPUTE(1);
        DMA_WAIT_SYNC();
    }
#undef GLDS
#undef DMA_WAIT_SYNC
#undef COMPUTE
    pr.epi(acc, wr, wc, lane, smem + wid * 8192);
}

template <class P>
DI void convert_tile(const P& pr, bf16_t* dst, int kdim, int kt, unsigned char* smem, int tid) {
    unsigned char* Bs = smem;
    const int ng = tid & 31, kg = tid >> 5;
    int width = 0;
    const float* bp = pr.b_col(ng >> 3, width);
    const int cig = (ng & 7) * 4;
    const bool bvalid = cig < width;
    const int ldb = pr.ldb();
    bp += cig + (size_t)(kt * 64 + kg * 8) * ldb;
    f32x4 rb[8];
#pragma unroll
    for (int kk = 0; kk < 8; ++kk) rb[kk] = bvalid ? *(const f32x4*)(bp + (size_t)kk * ldb) : (f32x4){0.f, 0.f, 0.f, 0.f};
    __syncthreads();
#pragma unroll
    for (int j = 0; j < 4; ++j) {
        u32x4 v = {pk2(rb[0][j], rb[1][j]), pk2(rb[2][j], rb[3][j]), pk2(rb[4][j], rb[5][j]), pk2(rb[6][j], rb[7][j])};
        *(u32x4*)(Bs + swz(ng * 4 + j, kg)) = v;
    }
    __syncthreads();
#pragma unroll
    for (int i = 0; i < 4; ++i) {
        const int n = (tid >> 3) + 32 * i;
        *(u32x4*)(dst + (size_t)n * kdim + kt * 64 + (tid & 7) * 8) = *(const u32x4*)(Bs + swz(n, tid & 7));
    }
}

template <int NC> DI void stage_put(unsigned char* wl, int mi, int ni, int r, int lane, float v) { *(bf16_t*)(wl + ((mi * 32 + crow(r, lane)) * NC + ni * 32 + (lane & 31)) * 2) = f2bf(v); }
template <int NC, class RowPtr> DI void stage_flush(unsigned char* wl, int lane, RowPtr rp) {
    constexpr int CH = NC / 8, RPI = 64 / CH, NIT = 64 / RPI;
#pragma unroll
    for (int i = 0; i < NIT; ++i) {
        const int row = lane / CH + RPI * i, ch = lane % CH;
        const u32x4 d = *(const u32x4*)(wl + (row * NC + ch * 8) * 2);
        bf16_t* dst = rp(row);
        if (dst) *(u32x4*)(dst + ch * 8) = d;
    }
}

struct HybIn {
    const Params* p; int j, tm, tn;
    DI int kt() const { return 16; }
    DI int ldb() const { return HYB_IN; }
    DI const bf16_t* a_base() const { return (const bf16_t*)(p->ws + WS_H); }
    DI int a_off(int r) const { return (tm * 128 + r) * 1024; }
    DI static void pair_cols(int pr, int ni, int& base, int& width) {
        width = 32;
        if (pr < 8) base = 64 * pr + 32 * ni;
        else if (pr == 8) base = 512 + 32 * ni;
        else if (pr == 9) base = 576 + 32 * ni;
        else if (pr < 18) base = 640 + 64 * (pr - 10) + 32 * ni;
        else if (pr == 18) base = 1152 + 32 * ni;
        else if (pr == 19) { base = 1216; width = ni == 0 ? 8 : 0; }
        else if (pr < 28) base = 1224 + 64 * (pr - 20) + 32 * ni;
        else base = (ni == 0 ? 1736 : 2248) + 32 * (pr - 28);
    }
    DI const float* b_col(int g, int& width) const { int base; pair_cols(tn * 2 + (g >> 1), g & 1, base, width); return p->hy_w_in + (size_t)j * 1024 * HYB_IN + base; }
    DI const bf16_t* b_base() const { return (const bf16_t*)(p->ws + WS_WHYB) + (size_t)(j * 22 + tn) * 128 * 1024; }
    DI void epi(f32x16 (&acc)[2][2], int wr, int wc, int lane, unsigned char* wl) const {
        const int pr = tn * 2 + wc, c = lane & 31;
        const int t0 = tm * 128 + wr * 64;
        unsigned char* ws = p->ws;
        const float* ropec = (const float*)(ws + WS_ROPEC);
        const float* ropes = (const float*)(ws + WS_ROPES);
        if (pr < 9 || (pr >= 10 && pr < 19)) {
            const bool donorm = pr < 9;
            const float* gam = pr < 8 ? p->hy_q_norm + j * 64 : p->hy_k_norm + j * 64;
            bf16_t* ob; int ld, cb;
            if (pr < 8) { ob = (bf16_t*)(ws + WS_Q); ld = 512; cb = 64 * pr; }
            else if (pr == 8) { ob = (bf16_t*)(ws + WS_K); ld = 64; cb = 0; }
            else if (pr < 18) { ob = (bf16_t*)(ws + WS_IQ); ld = 512; cb = 64 * (pr - 10); }
            else { ob = (bf16_t*)(ws + WS_IK); ld = 64; cb = 0; }
            float g1 = 1.f, g2 = 1.f;
            if (donorm) { g1 = gam[c]; g2 = gam[c + 32]; }
#pragma unroll
            for (int mi = 0; mi < 2; ++mi)
#pragma unroll
                for (int r = 0; r < 16; ++r) {
                    float x1 = acc[mi][0][r], x2 = acc[mi][1][r];
                    const int t = t0 + mi * 32 + crow(r, lane), pos = t & (S - 1);
                    if (donorm) { float ss = half_sum(x1 * x1 + x2 * x2); float rstd = rsqrtf(ss * (1.f / 64.f) + EPS); x1 *= rstd * g1; x2 *= rstd * g2; }
                    const float cs = ropec[pos * 32 + c], sn = ropes[pos * 32 + c];
                    stage_put<64>(wl, mi, 0, r, lane, x1 * cs - x2 * sn);
                    stage_put<64>(wl, mi, 1, r, lane, x2 * cs + x1 * sn);
                }
            stage_flush<64>(wl, lane, [&](int row) { return ob + (size_t)(t0 + row) * ld + cb; });
        } else if (pr == 9) {
            bf16_t* ob = (bf16_t*)(ws + WS_V);
#pragma unroll
            for (int mi = 0; mi < 2; ++mi)
#pragma unroll
                for (int ni = 0; ni < 2; ++ni)
#pragma unroll
                    for (int g4 = 0; g4 < 4; ++g4) {
                        const int t = t0 + mi * 32 + 8 * g4 + 4 * (lane >> 5), pos = t & (S - 1), bb = t >> 11;
                        u32x2 o = {pk2(acc[mi][ni][4 * g4], acc[mi][ni][4 * g4 + 1]), pk2(acc[mi][ni][4 * g4 + 2], acc[mi][ni][4 * g4 + 3])};
                        *(u32x2*)(ob + ((size_t)(bb * 64 + ni * 32 + c)) * S + pos) = o;
                    }
        } else if (pr == 19) {
            float* ob = (float*)(ws + WS_IW);
            if (c < 8) {
#pragma unroll
                for (int mi = 0; mi < 2; ++mi)
#pragma unroll
                    for (int r = 0; r < 16; ++r) { const int t = t0 + mi * 32 + crow(r, lane); ob[(size_t)t * 8 + c] = acc[mi][0][r] * (0.125f * 0.35355339059327373f); }
            }
        } else if (pr < 28) {
            bf16_t* ob = (bf16_t*)(ws + WS_BG); const int cb = 64 * (pr - 20);
#pragma unroll
            for (int mi = 0; mi < 2; ++mi)
#pragma unroll
                for (int r = 0; r < 16; ++r) { stage_put<64>(wl, mi, 0, r, lane, acc[mi][0][r]); stage_put<64>(wl, mi, 1, r, lane, acc[mi][1][r]); }
            stage_flush<64>(wl, lane, [&](int row) { return ob + (size_t)(t0 + row) * 512 + cb; });
        } else {
            bf16_t* ob = (bf16_t*)(ws + WS_Z); const int cb = 32 * (pr - 28);
#pragma unroll
            for (int mi = 0; mi < 2; ++mi)
#pragma unroll
                for (int r = 0; r < 16; ++r) stage_put<32>(wl, mi, 0, r, lane, acc[mi][0][r] * acc[mi][1][r]);
            stage_flush<32>(wl, lane, [&](int row) { return ob + (size_t)(t0 + row) * 512 + cb; });
        }
    }
};


struct HybCols8 {
    const Params* p; int j, tm, tn;
    DI int ldb() const { return HYB_IN; }
    DI const float* b_col(int g, int& width) const {
        const int u = tn >> 1, bj = tn & 1; int base; width = 32;
        if (u < 2) base = 64 * (4 * u + g) + 32 * bj;
        else if (u < 4) base = 640 + 64 * (4 * (u - 2) + g) + 32 * bj;
        else if (u == 4) { if (g == 0) base = 512 + 32 * bj; else if (g == 1) base = 576 + 32 * bj; else if (g == 2) base = 1152 + 32 * bj; else { base = 1216; width = bj == 0 ? 8 : 0; } }
        else if (u < 7) base = 1224 + (u - 5) * 256 + 128 * bj + 32 * g;
        else base = (bj == 0 ? 1736 : 2248) + (u - 7) * 128 + 32 * g;
        return p->hy_w_in + (size_t)j * 1024 * HYB_IN + base;
    }
};

struct MlIn {
    const Params* p; int j, tm, tn;
    DI int kt() const { return 16; }
    DI int ldb() const { return ML_IN; }
    DI const bf16_t* a_base() const { return (const bf16_t*)(p->ws + WS_H); }
    DI int a_off(int r) const { return (tm * 128 + r) * 1024; }
    DI const float* b_col(int g, int& width) const {
        const int pr = tn * 2 + (g >> 1), ni = g & 1; int base; width = 32;
        if (pr < 32) base = 64 * pr + 32 * ni;
        else if (pr == 32) { base = 2048 + 8 * ni; width = 8; }
        else if (pr < 49) base = 2064 + 64 * (pr - 33) + 32 * ni;
        else { base = 0; width = 0; }
        return p->ml_w_in + (size_t)j * 1024 * ML_IN + base;
    }
    DI const bf16_t* b_base() const { return (const bf16_t*)(p->ws + WS_WML) + (size_t)(j * 25 + tn) * 128 * 1024; }
    DI void epi(f32x16 (&acc)[2][2], int wr, int wc, int lane, unsigned char* wl) const {
        const int pr = tn * 2 + wc, c = lane & 31;
        const int t0 = tm * 128 + wr * 64;
        unsigned char* ws = p->ws;
        if (pr < 16) {
            bf16_t* ob; int cb; float sc = 1.f;
            if (pr < 8) { ob = (bf16_t*)(ws + WS_MQ); cb = 64 * pr; sc = 0.125f; }
            else { ob = (bf16_t*)(ws + WS_MK); cb = 64 * (pr - 8); }
#pragma unroll
            for (int mi = 0; mi < 2; ++mi)
#pragma unroll
                for (int r = 0; r < 16; ++r) { stage_put<64>(wl, mi, 0, r, lane, acc[mi][0][r] * sc); stage_put<64>(wl, mi, 1, r, lane, acc[mi][1][r] * sc); }
            stage_flush<64>(wl, lane, [&](int row) { return ob + (size_t)(t0 + row) * 512 + cb; });
        }
        if (pr >= 8 && pr < 32) {
            bf16_t* ob; int nrow, hd, r0;
            if (pr < 16) { ob = (bf16_t*)(ws + WS_MKT); nrow = 64; hd = pr - 8; r0 = 0; }
            else { ob = (bf16_t*)(ws + WS_MV); nrow = 128; hd = (pr - 16) >> 1; r0 = 64 * ((pr - 16) & 1); }
#pragma unroll
            for (int mi = 0; mi < 2; ++mi)
#pragma unroll
                for (int ni = 0; ni < 2; ++ni)
#pragma unroll
                    for (int g4 = 0; g4 < 4; ++g4) {
                        const int t = t0 + mi * 32 + 8 * g4 + 4 * (lane >> 5), pos = t & (S - 1), bb = t >> 11;
                        u32x2 o = {pk2(acc[mi][ni][4 * g4], acc[mi][ni][4 * g4 + 1]), pk2(acc[mi][ni][4 * g4 + 2], acc[mi][ni][4 * g4 + 3])};
                        *(u32x2*)(ob + ((size_t)((bb * 8 + hd) * nrow + r0 + ni * 32 + c)) * S + pos) = o;
                    }
        } else if (pr == 32) {
            if (c < 8) {
                float* oi = (float*)(ws + WS_MIG); float* of = (float*)(ws + WS_MFG);
                const float bi = p->ml_b_gates[j * 16 + c], bfg = p->ml_b_gates[j * 16 + 8 + c];
#pragma unroll
                for (int mi = 0; mi < 2; ++mi)
#pragma unroll
                    for (int r = 0; r < 16; ++r) {
                        const int t = t0 + mi * 32 + crow(r, lane);
                        oi[(size_t)t * 8 + c] = acc[mi][0][r] + bi;
                        const float f = acc[mi][1][r] + bfg;
                        of[(size_t)t * 8 + c] = fminf(f, 0.f) - log1pf(__expf(-fabsf(f)));
                    }
            }
        } else if (pr >= 33 && pr < 49) {
            bf16_t* ob = (bf16_t*)(ws + WS_MOG); const int cb = 64 * (pr - 33);
#pragma unroll
            for (int mi = 0; mi < 2; ++mi)
#pragma unroll
                for (int r = 0; r < 16; ++r) { stage_put<64>(wl, mi, 0, r, lane, sigmoidf_(acc[mi][0][r])); stage_put<64>(wl, mi, 1, r, lane, sigmoidf_(acc[mi][1][r])); }
            stage_flush<64>(wl, lane, [&](int row) { return ob + (size_t)(t0 + row) * 1024 + cb; });
        }
    }
};


struct MlCols8 {
    const Params* p; int j, tm, tn;
    DI int ldb() const { return ML_IN; }
    DI const float* b_col(int g, int& width) const {
        const int u = tn >> 1, bj = tn & 1; int base; width = 32;
        if (tn == 24) { base = 2048 + 8 * (g & 1); width = g < 2 ? 8 : 0; }
        else if (u < 2) base = 64 * (4 * u + g) + 32 * bj;
        else if (u < 4) base = 512 + 64 * (4 * (u - 2) + g) + 32 * bj;
        else if (u < 8) base = 1024 + (2 * (u - 4) + bj) * 128 + 32 * g;
        else base = 2064 + (u - 8) * 256 + 128 * bj + 32 * g;
        return p->ml_w_in + (size_t)j * 1024 * ML_IN + base;
    }
};
struct MlGates {
    const Params* p; int j, tm;
    DI int kt() const { return 16; }
    DI const bf16_t* a_base() const { return (const bf16_t*)(p->ws + WS_H); }
    DI int a_off(int r) const { return (tm * 128 + r) * 1024; }
    DI const bf16_t* b_base() const { return (const bf16_t*)(p->ws + WS_WML) + (size_t)(j * 25 + 24) * 128 * 1024; }
    DI void epi(f32x16 (&acc)[2][2], int wr, int wc, int lane, unsigned char* wl) const {
        const int c = lane & 31, t0 = tm * 128 + wr * 64;
        if (wc == 0 && c < 8) {
            float* oi = (float*)(p->ws + WS_MIG); float* of = (float*)(p->ws + WS_MFG);
            const float bi = p->ml_b_gates[j * 16 + c], bfg = p->ml_b_gates[j * 16 + 8 + c];
#pragma unroll
            for (int mi = 0; mi < 2; ++mi)
#pragma unroll
                for (int r = 0; r < 16; ++r) {
                    const int t = t0 + mi * 32 + crow(r, lane);
                    oi[(size_t)t * 8 + c] = acc[mi][0][r] + bi;
                    const float f = acc[mi][1][r] + bfg;
                    of[(size_t)t * 8 + c] = fminf(f, 0.f) - log1pf(__expf(-fabsf(f)));
                }
        }
    }
};

struct OutProj {
    const Params* p; const float* W; const float* src; int layer, tm, tn;
    DI int kt() const { return 16; }
    DI int ldb() const { return 1024; }
    DI const bf16_t* a_base() const { return (const bf16_t*)(p->ws + WS_YMIX); }
    DI int a_off(int r) const { return (tm * 128 + r) * 1024; }
    DI const float* b_col(int g, int& width) const { width = 32; return W + tn * 128 + g * 32; }
    DI const bf16_t* b_base() const { return (const bf16_t*)(p->ws + WS_WOUT) + (size_t)(layer * 8 + tn) * 128 * 1024; }
    DI void epi(f32x16 (&acc)[2][2], int wr, int wc, int lane, unsigned char* wl) const {
        const int c = lane & 31, t0 = tm * 128 + wr * 64, wid = wr * 2 + wc;
        float* fl = (float*)(wl + wid * 8192);
#pragma unroll
        for (int mi = 0; mi < 2; ++mi)
#pragma unroll
            for (int ni = 0; ni < 2; ++ni)
#pragma unroll
                for (int r = 0; r < 16; ++r) fl[(mi * 32 + crow(r, lane)) * 64 + ni * 32 + c] = acc[mi][ni][r];
        const float* mod = (const float*)(p->ws + WS_MOD) + (size_t)layer * 8 * 6144;
        const int ch = lane & 15, n = tn * 128 + wc * 64 + ch * 4;
        const f32x4 g = *(const f32x4*)(mod + (t0 >> 11) * 6144 + 2048 + n);
        float* part = (float*)(p->ws + WS_PART);
#pragma unroll 4
        for (int i = 0; i < 16; ++i) {
            const int row = (lane >> 4) + 4 * i, t = t0 + row;
            const f32x4 a = *(const f32x4*)(fl + row * 64 + ch * 4);
            const f32x4 o = *(const f32x4*)(src + (size_t)t * 1024 + n) + g * a;
            *(f32x4*)(p->out + (size_t)t * 1024 + n) = o;
            float ss = o[0] * o[0] + o[1] * o[1] + o[2] * o[2] + o[3] * o[3];
            ss += sx_f<1>(ss); ss += sx_f<2>(ss); ss += sx_f<4>(ss); ss += sx_f<8>(ss);
            if (ch == 0) part[(size_t)t * 16 + tn * 2 + wc] = ss;
        }
    }
};

struct Moe1 {
    const Params* p; int layer, e, mt, nt, cnt, roff;
    DI int kt() const { return 16; }
    DI int ldb() const { return DEXP; }
    DI const bf16_t* a_base() const { return (const bf16_t*)(p->ws + WS_H); }
    DI int a_off(int r) const {
        const int rr = mt * 128 + r; if (rr >= cnt) return -1;
        const int a = ((const int*)(p->ws + WS_ELIST))[(size_t)e * NASG + rr];
        return (a >> 1) * 1024;
    }
    DI const float* b_col(int g, int& width) const {
        width = 32;
        const float* base = (nt & 1) ? p->moe_w_up : p->moe_w_gate;
        return base + ((size_t)layer * NEXP + e) * (size_t)(D * DEXP) + 128 * (nt >> 1) + 32 * g;
    }
    DI const bf16_t* b_base() const { return (const bf16_t*)(p->ws + WS_WM1) + (size_t)((layer * NEXP + e) * 8 + nt) * 128 * 1024; }
    DI void epi(f32x16 (&acc)[2][2], int wr, int wc, int lane, unsigned char* wl) const {
        const int c = lane & 31, pr = nt * 2 + wc;
        bf16_t* ob = (bf16_t*)(p->ws + WS_H1);
#pragma unroll
        for (int mi = 0; mi < 2; ++mi)
#pragma unroll
            for (int r = 0; r < 16; ++r) {
                const float g = acc[mi][0][r], u = acc[mi][1][r];
                stage_put<32>(wl, mi, 0, r, lane, g / (1.f + __expf(-g)) * u);
            }
        const int rb = mt * 128 + wr * 64;
        stage_flush<32>(wl, lane, [&](int row) { return rb + row < cnt ? ob + (size_t)(roff + rb + row) * 512 + 32 * pr : (bf16_t*)nullptr; });
    }
};

struct Moe2 {
    const Params* p; int layer, e, mt, nt, cnt, roff;
    DI int kt() const { return 8; }
    DI int ldb() const { return D; }
    DI const bf16_t* a_base() const { return (const bf16_t*)(p->ws + WS_H1); }
    DI int a_off(int r) const { const int rr = mt * 128 + r; if (rr >= cnt) return -1; return (roff + rr) * 512; }
    DI const float* b_col(int g, int& width) const { width = 32; return p->moe_w_down + ((size_t)layer * NEXP + e) * (size_t)(DEXP * D) + nt * 128 + g * 32; }
    DI const bf16_t* b_base() const { return (const bf16_t*)(p->ws + WS_WM2) + (size_t)((layer * NEXP + e) * 8 + nt) * 128 * 512; }
    DI void epi(f32x16 (&acc)[2][2], int wr, int wc, int lane, unsigned char* wl) const {
        const int c = lane & 31;
        bf16_t* ob = (bf16_t*)(p->ws + WS_Y);
        const int* el = (const int*)(p->ws + WS_ELIST) + (size_t)e * NASG;
#pragma unroll
        for (int mi = 0; mi < 2; ++mi)
#pragma unroll
            for (int r = 0; r < 16; ++r) { stage_put<64>(wl, mi, 0, r, lane, acc[mi][0][r]); stage_put<64>(wl, mi, 1, r, lane, acc[mi][1][r]); }
        const int rb = mt * 128 + wr * 64;
        stage_flush<64>(wl, lane, [&](int row) { return rb + row < cnt ? ob + (size_t)el[rb + row] * 1024 + nt * 128 + wc * 64 : (bf16_t*)nullptr; });
    }
};

DI void convert_moe_layers(const Params& p, int l0, int l1, unsigned char* smem, int bid, int nb, int tid) {
    const int PER = 32 * 8 * 16 + 32 * 8 * 8, total = (l1 - l0) * PER;
    for (int item = bid; item < total; item += nb) {
        const int l = l0 + item / PER; int ci = item % PER;
        if (ci < 4096) { const int kt = ci & 15, nt = (ci >> 4) & 7, e = ci >> 7; Moe1 pr{&p, l, e, 0, nt, 0, 0}; convert_tile(pr, (bf16_t*)(p.ws + WS_WM1) + (size_t)((l * 32 + e) * 8 + nt) * 128 * 1024, 1024, kt, smem, tid); }
        else { ci -= 4096; const int kt = ci & 7, nt = (ci >> 3) & 7, e = ci >> 6; Moe2 pr{&p, l, e, 0, nt, 0, 0}; convert_tile(pr, (bf16_t*)(p.ws + WS_WM2) + (size_t)((l * 32 + e) * 8 + nt) * 128 * 512, 512, kt, smem, tid); }
    }
    __syncthreads();
}

DI void phase_init(const Params& p, unsigned char* smem, int bid, int nb, int tid) {
    float* sc = (float*)smem;
    float* red = (float*)(smem + 32768);
    const int NMOD = DEPTH * 96, NROPE = 256;
    const int C_HYB = 2 * 22 * 16, C_ML = 2 * 25 * 16, C_OUT = 4 * 8 * 16;
    for (int ci = bid; ci < C_HYB + C_ML + C_OUT; ci += nb) {
        int c2 = ci;
        if (c2 < C_HYB) { const int kt = c2 & 15, tn = (c2 >> 4) % 22, j = (c2 >> 4) / 22; HybCols8 pr{&p, j, 0, tn}; convert_tile(pr, (bf16_t*)(p.ws + WS_WHYB) + (size_t)(j * 22 + tn) * 128 * 1024, 1024, kt, smem, tid); continue; }
        c2 -= C_HYB;
        if (c2 < C_ML) { const int kt = c2 & 15, tn = (c2 >> 4) % 25, j = (c2 >> 4) / 25; MlCols8 pr{&p, j, 0, tn}; convert_tile(pr, (bf16_t*)(p.ws + WS_WML) + (size_t)(j * 25 + tn) * 128 * 1024, 1024, kt, smem, tid); continue; }
        c2 -= C_ML;
        { const int kt = c2 & 15, tn = (c2 >> 4) & 7, l = c2 >> 7; const float* W = ((l & 1) ? p.ml_w_out : p.hy_w_out) + (size_t)(l >> 1) * 1024 * 1024;
            OutProj pr{&p, W, nullptr, l, 0, tn}; convert_tile(pr, (bf16_t*)(p.ws + WS_WOUT) + (size_t)(l * 8 + tn) * 128 * 1024, 1024, kt, smem, tid); }
    }
    for (int item = bid; item < NMOD; item += nb) {
        __syncthreads();
        for (int i = tid; i < 8 * 1024; i += 256) { const float v = p.c[i]; sc[i] = v / (1.f + __expf(-v)); }
        __syncthreads();
        const int l = item / 96, jb = item % 96, cq = tid & 15, ksl = tid >> 4;
        const float* w = p.ada_w + (size_t)l * 1024 * 6144 + jb * 64 + cq * 4;
        f32x4 acc[8];
#pragma unroll
        for (int b = 0; b < 8; ++b) acc[b] = (f32x4){0.f, 0.f, 0.f, 0.f};
        for (int ii = 0; ii < 64; ++ii) {
            const int i = ksl * 64 + ii;
            const f32x4 wv = *(const f32x4*)(w + (size_t)i * 6144);
#pragma unroll
            for (int b = 0; b < 8; ++b) acc[b] += wv * sc[b * 1024 + i];
        }
#pragma unroll
        for (int b = 0; b < 8; ++b) *(f32x4*)(red + (ksl * 8 + b) * 64 + cq * 4) = acc[b];
        __syncthreads();
        for (int o = tid; o < 512; o += 256) {
            const int b = o >> 6, cc = o & 63; float s = 0.f;
            for (int k = 0; k < 16; ++k) s += red[(k * 8 + b) * 64 + cc];
            ((float*)(p.ws + WS_MOD))[((size_t)l * 8 + b) * 6144 + jb * 64 + cc] = s + p.ada_b[l * 6144 + jb * 64 + cc];
        }
    }
    for (int item = bid; item < NROPE + 1; item += nb) {
        if (item < NROPE) {
            const int idx = item * 256 + tid;
            const int pos = idx >> 5, i = idx & 31;
            const float inv = 1.0f / powf(10000.0f, (float)(2 * i) / 64.0f);
            const float ang = (float)pos * inv;
            ((float*)(p.ws + WS_ROPEC))[idx] = cosf(ang);
            ((float*)(p.ws + WS_ROPES))[idx] = sinf(ang);
        } else {
            if (tid < DEPTH * 32) ((int*)(p.ws + WS_ECNT))[tid * ECS] = 0;
        }
    }
    __syncthreads();
    convert_moe_layers(p, 0, 1, smem, bid, nb, tid);
}

DI void phase_norm(const Params& p, int layer, const float* src, int bid, int nb, int tid) {
    const int lane = tid & 63, wid = tid >> 6;
    const float* mod = (const float*)(p.ws + WS_MOD) + (size_t)layer * 8 * 6144;
    const float* gam = p.norm_mix + layer * 1024;
    bf16_t* H = (bf16_t*)(p.ws + WS_H);
    for (int item = bid; item < T / 4; item += nb) {
        const int t = item * 4 + wid, b = t >> 11;
        const float* xr = src + (size_t)t * 1024;
        f32x4 v[4]; float ss = 0.f;
#pragma unroll
        for (int i = 0; i < 4; ++i) { v[i] = *(const f32x4*)(xr + (lane + 64 * i) * 4); ss += v[i][0] * v[i][0] + v[i][1] * v[i][1] + v[i][2] * v[i][2] + v[i][3] * v[i][3]; }
        ss = wave_sum(ss);
        const float rstd = rsqrtf(ss * (1.f / 1024.f) + EPS);
#pragma unroll
        for (int i = 0; i < 4; ++i) {
            const int c0 = (lane + 64 * i) * 4;
            const f32x4 g = *(const f32x4*)(gam + c0), sh = *(const f32x4*)(mod + b * 6144 + c0), sc = *(const f32x4*)(mod + b * 6144 + 1024 + c0);
            f32x4 h = v[i] * rstd * g * (sc + 1.f) + sh;
            u32x2 o = {pk2(h[0], h[1]), pk2(h[2], h[3])};
            *(u32x2*)(H + (size_t)t * 1024 + c0) = o;
        }
    }
}

DI void phase_ffn_norm_router(const Params& p, int layer, unsigned char* smem, int bid, int nb, int tid) {
    float* rstd_s = (float*)smem;
    float* lg = (float*)(smem + 512);
    float* hs = (float*)(smem + 512 + 32 * 37 * 4);
    float* wcs = (float*)(smem + 5248 + 2 * 32 * 65 * 4);
    const int lane = tid & 63, og = __builtin_amdgcn_readfirstlane(tid >> 6), tok = lane & 31, kh = lane >> 5;
    const float* mod = (const float*)(p.ws + WS_MOD) + (size_t)layer * 8 * 6144;
    const float* gam = p.norm_ffn + layer * 1024;
    const float* wg = p.moe_w_group + (size_t)layer * 1024 * 4;
    const float* we = p.moe_w_expert + (size_t)layer * 1024 * 32;
    bf16_t* H = (bf16_t*)(p.ws + WS_H);
    int* ecnt = (int*)(p.ws + WS_ECNT) + layer * 32 * ECS;
    int* elist = (int*)(p.ws + WS_ELIST);
    float* ew = (float*)(p.ws + WS_EW);
    for (int item = bid; item < T / 32; item += nb) {
        const int t0 = item * 32, b = t0 >> 11;
        __syncthreads();
        if (tid < 32) {
            const f32x4* pp = (const f32x4*)((const float*)(p.ws + WS_PART) + (size_t)(t0 + tid) * 16);
            const f32x4 a = pp[0], b4 = pp[1], c4 = pp[2], d4 = pp[3];
            const float ss = ((a[0] + a[1]) + (a[2] + a[3])) + ((b4[0] + b4[1]) + (b4[2] + b4[3])) + ((c4[0] + c4[1]) + (c4[2] + c4[3])) + ((d4[0] + d4[1]) + (d4[2] + d4[3]));
            rstd_s[tid] = rsqrtf(ss * (1.f / 1024.f) + EPS);
        }
        const int stok = tid >> 3, sk0 = (tid & 7) * 8;
        const float* xrow = p.out + (size_t)(t0 + stok) * 1024 + sk0;
        const float* mrow = mod + b * 6144 + sk0;
        f32x4 xa[2], ga[2], sha[2], sca[2], wa[3], xb[2], gb2[2], shb[2], scb[2], wb2[3];
#define FFN_LOAD(xv, gv, shv, scv, wv, k0) do { _Pragma("unroll") for (int q = 0; q < 2; ++q) { xv[q] = *(const f32x4*)(xrow + (k0) + 4 * q); gv[q] = *(const f32x4*)(gam + sk0 + (k0) + 4 * q); \
            shv[q] = *(const f32x4*)(mrow + 3072 + (k0) + 4 * q); scv[q] = *(const f32x4*)(mrow + 4096 + (k0) + 4 * q); } \
            wv[0] = *(const f32x4*)(we + (k0) * 32 + tid * 4); wv[1] = *(const f32x4*)(we + (k0) * 32 + 1024 + tid * 4); wv[2] = *(const f32x4*)(wg + (k0) * 4 + (tid & 63) * 4); } while (0)
#define FFN_STEP(xv, gv, shv, scv, wv, kc) do { const int k0 = (kc) * 64; float* hb = hs + ((kc) & 1) * (32 * 65); float* wb = wcs + ((kc) & 1) * (64 * 40); u32x4 ho; \
            _Pragma("unroll") for (int q = 0; q < 2; ++q) { const f32x4 h = xv[q] * srstd * gv[q] * (scv[q] + 1.f) + shv[q]; ho[2 * q] = pk2(h[0], h[1]); ho[2 * q + 1] = pk2(h[2], h[3]); \
                float* hp = hb + stok * 65 + sk0 + 4 * q; hp[0] = h[0]; hp[1] = h[1]; hp[2] = h[2]; hp[3] = h[3]; } \
            *(u32x4*)(H + (size_t)(t0 + stok) * 1024 + k0 + sk0) = ho; \
            *(f32x4*)(wb + (tid >> 3) * 40 + 4 + (tid & 7) * 4) = wv[0]; *(f32x4*)(wb + (32 + (tid >> 3)) * 40 + 4 + (tid & 7) * 4) = wv[1]; if (tid < 64) *(f32x4*)(wb + tid * 40) = wv[2]; \
            if ((kc) + 2 < 16) FFN_LOAD(xv, gv, shv, scv, wv, k0 + 128); \
            __syncthreads(); \
            if (og < 3) { const float* hr = hb + tok * 65 + kh * 32; const float* wr_ = wb + kh * 32 * 40 + og * 12; \
                _Pragma("unroll 8") for (int kk = 0; kk < 32; ++kk) { const float hv = hr[kk]; \
                    acc[0] += *(const f32x4*)(wr_ + kk * 40) * hv; acc[1] += *(const f32x4*)(wr_ + kk * 40 + 4) * hv; acc[2] += *(const f32x4*)(wr_ + kk * 40 + 8) * hv; } } } while (0)
        FFN_LOAD(xa, ga, sha, sca, wa, 0);
        FFN_LOAD(xb, gb2, shb, scb, wb2, 64);
        __syncthreads();
        const float srstd = rstd_s[stok];
        f32x4 acc[3];
#pragma unroll
        for (int o = 0; o < 3; ++o) acc[o] = (f32x4){0.f, 0.f, 0.f, 0.f};
        for (int kc = 0; kc < 16; kc += 2) {
            FFN_STEP(xa, ga, sha, sca, wa, kc);
            FFN_STEP(xb, gb2, shb, scb, wb2, kc + 1);
        }
#undef FFN_STEP
#undef FFN_LOAD
        if (og < 3) {
#pragma unroll
            for (int o = 0; o < 3; ++o)
#pragma unroll
                for (int e = 0; e < 4; ++e) { const float v = acc[o][e] + sx_f<32>(acc[o][e]); if (kh == 0) lg[tok * 37 + og * 12 + 4 * o + e] = v; }
        }
        __syncthreads();
        if (tid < 32) {
            const int t = t0 + tid;
            float gl[4]; float gmax = -INFINITY; int gsel = 0;
#pragma unroll
            for (int g = 0; g < 4; ++g) { gl[g] = lg[tid * 37 + g] + p.moe_b_group[layer * 4 + g]; if (gl[g] > gmax) { gmax = gl[g]; gsel = g; } }
            float gsum = 0.f;
#pragma unroll
            for (int g = 0; g < 4; ++g) gsum += __expf(gl[g] - gmax);
            const float pg = 1.f / gsum;
            float v1 = -INFINITY, v2 = -INFINITY; int i1 = 0, i2 = 0;
            for (int jx = 0; jx < 8; ++jx) {
                const float v = lg[tid * 37 + 4 + gsel * 8 + jx] + p.moe_b_expert[layer * 32 + gsel * 8 + jx];
                if (v > v1) { v2 = v1; i2 = i1; v1 = v; i1 = jx; } else if (v > v2) { v2 = v; i2 = jx; }
            }
            const float e2 = __expf(v2 - v1), den = 1.f / (1.f + e2);
            const float w1 = pg * den, w2 = pg * e2 * den;
            const int ea = gsel * 8 + i1, eb = gsel * 8 + i2;
            int* cl = (int*)rstd_s + 32;
            cl[tid] = 0;
            const int la = atomicAdd(&cl[ea], 1);
            const int lb = atomicAdd(&cl[eb], 1);
            { const int n = cl[tid]; cl[32 + tid] = n > 0 ? atomicAdd(&ecnt[tid * ECS], n) : 0; }
            const int ra = cl[32 + ea] + la, rb = cl[32 + eb] + lb;
            elist[(size_t)ea * NASG + ra] = t * 2; ew[t * 2] = w1;
            elist[(size_t)eb * NASG + rb] = t * 2 + 1; ew[t * 2 + 1] = w2;
        }
    }
}

DI bool dense_item(int i, int NT, int xcd, int& tm, int& tn) {
    if (i >= 16 * NT) return false;
    const int mg = i / (8 * NT), r = i % (8 * NT);
    tn = r >> 3; tm = xcd * 16 + mg * 8 + (r & 7);
    return true;
}
template <class PR> DI void phase_hyb_in(const Params& p, int j, unsigned char* smem, int xcd, int lb, int nlb, int tid) {
    int tm, tn;
    for (int i = lb; dense_item(i, 22, xcd, tm, tn); i += nlb) { HybIn pr{&p, j, tm, tn}; gemm_tile(pr, smem, opq(tid)); }
}
DI void phase_ml_in(const Params& p, int j, unsigned char* smem, int xcd, int lb, int nlb, int tid) {
    int tm, tn;
    for (int i = lb; dense_item(i, 25, xcd, tm, tn); i += nlb) { MlIn pr{&p, j, tm, tn}; gemm_tile(pr, smem, opq(tid)); }
}
DI void phase_out_proj(const Params& p, int layer, const float* W, const float* src, unsigned char* smem, int xcd, int lb, int nlb, int tid) {
    int tm, tn;
    for (int i = lb; dense_item(i, 8, xcd, tm, tn); i += nlb) { OutProj pr{&p, W, src, layer, tm, tn}; gemm_tile(pr, smem, opq(tid)); }
}
template <int WHICH> DI void phase_moe(const Params& p, int layer, unsigned char* smem, int xcd, int lb, int nlb, int tid) {
    int* toff = (int*)(smem + 65600);
    __syncthreads();
    if (tid == 0) {
        const int* ecnt = (const int*)(p.ws + WS_ECNT) + layer * 32 * ECS;
        int ta = 0, ra = 0;
        for (int e = 0; e < 32; ++e) {
            const int c = ecnt[e * ECS];
            if ((e & 7) == xcd) { const int q = e >> 3; toff[q] = ta; toff[8 + q] = ra; toff[16 + q] = c; ta += (c + 127) >> 7; }
            ra += c;
        }
        toff[4] = ta;
    }
    __syncthreads();
    const int total = toff[4] * 8;
    for (int item = lb; item < total; item += nlb) {
        const int mg = item >> 3, nt = item & 7;
        int q = 0;
        while (q < 3 && toff[q + 1] <= mg) ++q;
        const int e = q * 8 + xcd, cnt = toff[16 + q], roff = toff[8 + q];
        if (WHICH == 1) { Moe1 pr{&p, layer, e, mg - toff[q], nt, cnt, roff}; gemm_tile(pr, smem, opq(tid)); }
        else { Moe2 pr{&p, layer, e, mg - toff[q], nt, cnt, roff}; gemm_tile(pr, smem, opq(tid)); }
    }
}

DI void phase_combine_norm(const Params& p, int layer, int bid, int nb, int tid) {
    const int lane = tid & 63, wid = tid >> 6;
    const float* mod = (const float*)(p.ws + WS_MOD) + (size_t)layer * 8 * 6144;
    const float* modn = mod + 8 * 6144;
    const float* gam = p.norm_mix + (layer + 1) * 1024;
    const bf16_t* Y = (const bf16_t*)(p.ws + WS_Y);
    const float* ew = (const float*)(p.ws + WS_EW);
    bf16_t* H = (bf16_t*)(p.ws + WS_H);
    const bool has_next = layer + 1 < DEPTH;
    for (int item = bid; item < T / 4; item += nb) {
        const int t = item * 4 + wid, b = t >> 11;
        const float w0 = ew[2 * t], w1 = ew[2 * t + 1];
        f32x4 v[4]; float ss = 0.f;
#pragma unroll
        for (int i = 0; i < 4; ++i) {
            const int c0 = (lane + 64 * i) * 4;
            v[i] = *(const f32x4*)(p.out + (size_t)t * 1024 + c0);
            const f32x4 g = *(const f32x4*)(mod + b * 6144 + 5120 + c0);
            const u32x2 y0 = *(const u32x2*)(Y + (size_t)(2 * t) * 1024 + c0), y1 = *(const u32x2*)(Y + (size_t)(2 * t + 1) * 1024 + c0);
            v[i][0] += g[0] * (w0 * bflo(y0[0]) + w1 * bflo(y1[0])); v[i][1] += g[1] * (w0 * bfhi(y0[0]) + w1 * bfhi(y1[0]));
            v[i][2] += g[2] * (w0 * bflo(y0[1]) + w1 * bflo(y1[1])); v[i][3] += g[3] * (w0 * bfhi(y0[1]) + w1 * bfhi(y1[1]));
            *(f32x4*)(p.out + (size_t)t * 1024 + c0) = v[i];
            ss += v[i][0] * v[i][0] + v[i][1] * v[i][1] + v[i][2] * v[i][2] + v[i][3] * v[i][3];
        }
        if (has_next) {
            ss = wave_sum(ss);
            const float rstd = rsqrtf(ss * (1.f / 1024.f) + EPS);
#pragma unroll
            for (int i = 0; i < 4; ++i) {
                const int c0 = (lane + 64 * i) * 4;
                const f32x4 g = *(const f32x4*)(gam + c0), sh = *(const f32x4*)(modn + b * 6144 + c0), sc = *(const f32x4*)(modn + b * 6144 + 1024 + c0);
                const f32x4 h = v[i] * rstd * g * (sc + 1.f) + sh;
                u32x2 o = {pk2(h[0], h[1]), pk2(h[2], h[3])};
                *(u32x2*)(H + (size_t)t * 1024 + c0) = o;
            }
        }
    }
}

DI unsigned sortable(float f) { const unsigned u = __float_as_uint(f); return (u & 0x80000000u) ? ~u : (u | 0x80000000u); }
DI int half_sum_i(int v) { v += sx_i<16>(v); v += sx_i<8>(v); v += sx_i<4>(v); v += sx_i<2>(v); v += sx_i<1>(v); return v; }

struct CvTask { const float* src; bf16_t* dst; int ldb, kdim; };
DI CvTask cv_task(const Params& p, int l0, int id) {
    const int PER = 32 * 8 * 16 * 4 + 32 * 8 * 8 * 4;
    const int l = l0 + id / PER; int ci = id % PER; CvTask t;
    if (ci < 16384) {
        const int g = ci & 3, kt = (ci >> 2) & 15, nt = (ci >> 6) & 7, e = ci >> 9; int w;
        Moe1 pr{&p, l, e, 0, nt, 0, 0};
        t.ldb = DEXP; t.kdim = 1024; t.src = pr.b_col(g, w) + (size_t)(kt * 64) * DEXP;
        t.dst = (bf16_t*)(p.ws + WS_WM1) + ((size_t)((l * 32 + e) * 8 + nt) * 128 + g * 32) * 1024 + kt * 64;
    } else {
        ci -= 16384;
        const int g = ci & 3, kt = (ci >> 2) & 7, nt = (ci >> 5) & 7, e = ci >> 8; int w;
        Moe2 pr{&p, l, e, 0, nt, 0, 0};
        t.ldb = D; t.kdim = 512; t.src = pr.b_col(g, w) + (size_t)(kt * 64) * D;
        t.dst = (bf16_t*)(p.ws + WS_WM2) + ((size_t)((l * 32 + e) * 8 + nt) * 128 + g * 32) * 512 + kt * 64;
    }
    return t;
}
DI void cv_issue(const CvTask& t, int lane, f32x4 (&rb)[8]) {
    const float* s = t.src + (size_t)((lane >> 3) * 8) * t.ldb + (lane & 7) * 4;
#pragma unroll
    for (int kk = 0; kk < 8; ++kk) rb[kk] = *(const f32x4*)(s + (size_t)kk * t.ldb);
}
DI void cv_finish(const CvTask& t, int lane, const f32x4 (&rb)[8]) {
    bf16_t* d = t.dst + (size_t)((lane & 7) * 4) * t.kdim + (lane >> 3) * 8;
#pragma unroll
    for (int jx = 0; jx < 4; ++jx) {
        u32x4 v = {pk2(rb[0][jx], rb[1][jx]), pk2(rb[2][jx], rb[3][jx]), pk2(rb[4][jx], rb[5][jx]), pk2(rb[6][jx], rb[7][jx])};
        *(u32x4*)(d + (size_t)jx * t.kdim) = v;
    }
}
DI void convert_moe_waves(const Params& p, int l0, int l1, int gwave, int nwaves, int lane) {
    const int total = (l1 - l0) * 24576;
    for (int id = gwave; id < total; id += 2 * nwaves) {
        f32x4 ra[8], rb[8];
        const CvTask t0 = cv_task(p, l0, id);
        cv_issue(t0, lane, ra);
        const bool two = id + nwaves < total;
        if (two) { const CvTask t1 = cv_task(p, l0, id + nwaves); cv_issue(t1, lane, rb); cv_finish(t0, lane, ra); cv_finish(t1, lane, rb); }
        else cv_finish(t0, lane, ra);
    }
}

DI void phase_dsa(const Params& p, int j, unsigned char* smem, int bid, int nb, int tid, int cv0 = 0, int cv1 = 0) {
    if (cv1 > cv0 && (bid & 1)) convert_moe_waves(p, cv0, cv1, bid * 4 + (tid >> 6), nb * 4, tid & 63);
    const int lane = tid & 63, wid = tid >> 6, c = lane & 31, hh = lane >> 5;
    unsigned* mw = (unsigned*)smem + wid * 256;
    const bf16_t* IQ = (const bf16_t*)(p.ws + WS_IQ);
    const bf16_t* IK = (const bf16_t*)(p.ws + WS_IK);
    const float* IW = (const float*)(p.ws + WS_IW);
    const bf16_t* Q = (const bf16_t*)(p.ws + WS_Q);
    const bf16_t* K = (const bf16_t*)(p.ws + WS_K);
    const bf16_t* VT = (const bf16_t*)(p.ws + WS_V);
    bf16_t* Y = (bf16_t*)(p.ws + WS_YMIX);
    const float gq = wave_max(fabsf(p.hy_q_norm[j * 64 + lane])), gk = wave_max(fabsf(p.hy_k_norm[j * 64 + lane]));
    const float LOG2E = 1.4426950408889634f;
    const float c1 = 0.125f * LOG2E, c2 = 8.f * gq * gk * LOG2E;
    const unsigned lt = (1u << c) - 1u;
    for (int it = bid, rnd = 0; it < 1024; it += nb, ++rnd) {
        const int item = (rnd & 1) ? (rnd + 1) * nb - 1 - bid : it;
        if (item >= 1024) continue;
        const int qt = 127 - (item >> 3), b = item & 7;
        const int pos0 = qt * 16 + 4 * wid;
        const size_t tb = (size_t)b * S, t0 = tb + pos0;
        const int tmax = (pos0 + 3) >> 5;
        if (pos0 >= 256) {
            bf16x8 iqf[4];
            {
                const int i = (c & 3) + 4 * (c >> 3), rh = (c >> 2) & 1, qq = 2 * rh + (i >> 3), hd = i & 7;
                const bf16_t* ip = IQ + (t0 + qq) * 512 + hd * 64 + 8 * hh;
#pragma unroll
                for (int ks = 0; ks < 4; ++ks) iqf[ks] = *(const bf16x8*)(ip + 16 * ks);
            }
            float* wl = (float*)(smem + 4096) + wid * 32 + hh * 16;
            if (c < 4) *(f32x4*)(wl + 4 * c) = *(const f32x4*)(IW + (t0 + 2 * hh) * 8 + 4 * c);
            unsigned sk[64][2];
            const bf16_t* kpi = IK + (tb + c) * 64 + 8 * hh;
            const int lim0 = pos0 + 2 * hh - c;
#pragma unroll
            for (int tile = 0; tile < 64; ++tile) {
                unsigned k0 = 0u, k1 = 0u;
                if (tile <= tmax) {
                    bf16x8 bk[4];
#pragma unroll
                    for (int ks = 0; ks < 4; ++ks) bk[ks] = *(const bf16x8*)(kpi + 16 * ks);
                    kpi += 32 * 64;
                    asm volatile("" : "+v"(kpi));
                    f32x16 acc;
#pragma unroll
                    for (int r = 0; r < 16; ++r) acc[r] = 0.f;
#pragma unroll
                    for (int ks = 0; ks < 4; ++ks) acc = __builtin_amdgcn_mfma_f32_32x32x16_bf16(iqf[ks], bk[ks], acc, 0, 0, 0);
                    float s0 = 0.f, s1 = 0.f;
#pragma unroll
                    for (int q4 = 0; q4 < 2; ++q4) {
                        const f32x4 wa = *(const f32x4*)(wl + 4 * q4), wb = *(const f32x4*)(wl + 8 + 4 * q4);
#pragma unroll
                        for (int e = 0; e < 4; ++e) { s0 += fmaxf(acc[4 * q4 + e], 0.f) * wa[e]; s1 += fmaxf(acc[8 + 4 * q4 + e], 0.f) * wb[e]; }
                    }
                    k0 = tile * 32 <= lim0 ? sortable(s0) : 0u;
                    k1 = tile * 32 <= lim0 + 1 ? sortable(s1) : 0u;
                }
                sk[tile][0] = k0; sk[tile][1] = k1;
            }
            unsigned v0 = 0u, v1 = 0u; bool d0 = false, d1 = false;
            const int tg = tmax >> 3;
            for (int bit = 31; bit >= 0; --bit) {
                const unsigned c0 = v0 | (1u << bit), c1b = v1 | (1u << bit);
                int n0 = 0, n1 = 0;
#pragma unroll
                for (int g = 0; g < 8; ++g) {
                    if (g <= tg) {
#pragma unroll
                        for (int u = 0; u < 8; ++u) { n0 += sk[g * 8 + u][0] >= c0 ? 1 : 0; n1 += sk[g * 8 + u][1] >= c1b ? 1 : 0; }
                    }
                }
                const int n01 = half_sum_i(n0 | (n1 << 16));
                n0 = n01 & 0xffff; n1 = n01 >> 16;
                if (!d0 && n0 >= 256) { v0 = c0; d0 = n0 == 256; }
                if (!d1 && n1 >= 256) { v1 = c1b; d1 = n1 == 256; }
                if (__all(d0 && d1)) break;
            }
            int g0 = 0, g1 = 0;
#pragma unroll
            for (int g = 0; g < 8; ++g) {
                if (g <= tg) {
#pragma unroll
                    for (int u = 0; u < 8; ++u) { g0 += sk[g * 8 + u][0] > v0 ? 1 : 0; g1 += sk[g * 8 + u][1] > v1 ? 1 : 0; }
                }
            }
            const int g01 = half_sum_i(g0 | (g1 << 16));
            const int need0 = 256 - (g01 & 0xffff), need1 = 256 - (g01 >> 16);
            int run0 = 0, run1 = 0;
#pragma unroll
            for (int tile = 0; tile < 64; ++tile) {
                if (tile <= tmax) {
                    const unsigned k0 = sk[tile][0], k1 = sk[tile][1];
                    const bool tie0 = k0 == v0, tie1 = k1 == v1;
                    const unsigned long long tb0 = __ballot(tie0), tb1 = __ballot(tie1);
                    const unsigned th0 = hh ? (unsigned)(tb0 >> 32) : (unsigned)tb0, th1 = hh ? (unsigned)(tb1 >> 32) : (unsigned)tb1;
                    const bool sel0 = k0 > v0 || (tie0 && run0 + __popc(th0 & lt) < need0);
                    const bool sel1 = k1 > v1 || (tie1 && run1 + __popc(th1 & lt) < need1);
                    run0 += __popc(th0); run1 += __popc(th1);
                    const unsigned long long sb0 = __ballot(sel0), sb1 = __ballot(sel1);
                    if (lane == 0) { u32x4 o = {(unsigned)sb0, (unsigned)sb1, (unsigned)(sb0 >> 32), (unsigned)(sb1 >> 32)}; *(u32x4*)(mw + tile * 4) = o; }
                }
            }
        } else {
            const int tile = lane >> 2, qq = lane & 3, pq = pos0 + qq;
            if (tile <= tmax) {
                unsigned m;
                if (32 * tile + 31 <= pq) m = 0xffffffffu; else if (32 * tile > pq) m = 0u; else m = (2u << (pq - 32 * tile)) - 1u;
                mw[tile * 4 + qq] = m;
            }
        }
        bf16x8 qf[4];
        {
            const bf16_t* qp = Q + (t0 + (c >> 3)) * 512 + (c & 7) * 64 + 8 * hh;
#pragma unroll
            for (int ks = 0; ks < 4; ++ks) qf[ks] = *(const bf16x8*)(qp + 16 * ks);
        }
        f32x16 o0, o1;
#pragma unroll
        for (int r = 0; r < 16; ++r) { o0[r] = 0.f; o1[r] = 0.f; }
        float lsum = 0.f;
        const int kperm = (c & ~12) | ((c & 4) << 1) | ((c & 8) >> 1);
        const bf16_t* kp = K + (tb + kperm) * 64 + 8 * hh;
        const bf16_t* vp = VT + ((size_t)(b * 64 + c)) * S + 8 * hh;
        bf16x8 kf[4], vf[4];
#pragma unroll
        for (int ks = 0; ks < 4; ++ks) kf[ks] = *(const bf16x8*)(kp + 16 * ks);
        vf[0] = *(const bf16x8*)(vp); vf[1] = *(const bf16x8*)(vp + (size_t)32 * S); vf[2] = *(const bf16x8*)(vp + 16); vf[3] = *(const bf16x8*)(vp + (size_t)32 * S + 16);
        for (int tile = 0; tile <= tmax; ++tile) {
            const unsigned mword = mw[tile * 4 + (c >> 3)];
            bf16x8 kc[4], vc[4];
#pragma unroll
            for (int ks = 0; ks < 4; ++ks) { kc[ks] = kf[ks]; vc[ks] = vf[ks]; }
            if (tile < tmax) {
                kp += 32 * 64; vp += 32;
#pragma unroll
                for (int ks = 0; ks < 4; ++ks) kf[ks] = *(const bf16x8*)(kp + 16 * ks);
                vf[0] = *(const bf16x8*)(vp); vf[1] = *(const bf16x8*)(vp + (size_t)32 * S); vf[2] = *(const bf16x8*)(vp + 16); vf[3] = *(const bf16x8*)(vp + (size_t)32 * S + 16);
            }
            f32x16 x;
#pragma unroll
            for (int r = 0; r < 16; ++r) x[r] = 0.f;
#pragma unroll
            for (int ks = 0; ks < 4; ++ks) x = __builtin_amdgcn_mfma_f32_32x32x16_bf16(kc[ks], qf[ks], x, 0, 0, 0);
#pragma unroll
            for (int s = 0; s < 2; ++s) {
                const unsigned bits = mword >> (16 * s + 8 * hh);
                float pr[8];
#pragma unroll
                for (int jx = 0; jx < 8; ++jx) {
                    const float e = __builtin_amdgcn_exp2f(x[8 * s + jx] * c1 - c2);
                    pr[jx] = __uint_as_float(__float_as_uint(e) & (unsigned)__builtin_amdgcn_sbfe((int)bits, jx, 1));
                    lsum += pr[jx];
                }
                u32x4 pk = {pk2(pr[0], pr[1]), pk2(pr[2], pr[3]), pk2(pr[4], pr[5]), pk2(pr[6], pr[7])};
                const bf16x8 pf = __builtin_bit_cast(bf16x8, pk);
                o0 = __builtin_amdgcn_mfma_f32_32x32x16_bf16(vc[2 * s], pf, o0, 0, 0, 0);
                o1 = __builtin_amdgcn_mfma_f32_32x32x16_bf16(vc[2 * s + 1], pf, o1, 0, 0, 0);
            }
        }
        lsum += sx_f<32>(lsum);
        const float inv = 1.f / lsum;
        bf16_t* yp = Y + (t0 + (c >> 3)) * 1024 + (c & 7) * 64 + 4 * hh;
#pragma unroll
        for (int g4 = 0; g4 < 4; ++g4) {
            u32x2 a = {pk2(o0[4 * g4] * inv, o0[4 * g4 + 1] * inv), pk2(o0[4 * g4 + 2] * inv, o0[4 * g4 + 3] * inv)};
            u32x2 bq = {pk2(o1[4 * g4] * inv, o1[4 * g4 + 1] * inv), pk2(o1[4 * g4 + 2] * inv, o1[4 * g4 + 3] * inv)};
            *(u32x2*)(yp + 8 * g4) = a;
            *(u32x2*)(yp + 32 + 8 * g4) = bq;
        }
    }
    if (cv1 > cv0 && !(bid & 1)) convert_moe_waves(p, cv0, cv1, bid * 4 + (tid >> 6), nb * 4, tid & 63);
}

DI void phase_conv(const Params& p, int j, int bid, int nb, int tid) {
    const bf16_t* Z = (const bf16_t*)(p.ws + WS_Z);
    const bf16_t* BG = (const bf16_t*)(p.ws + WS_BG);
    bf16_t* Y = (bf16_t*)(p.ws + WS_YMIX);
    const float* cw = p.hy_conv_w + (size_t)j * 3 * 512;
    for (int item = bid; item < T / 4; item += nb) {
        const int t = item * 4 + (tid >> 6), c0 = (tid & 63) * 8, pos = t & (S - 1);
        float acc[8];
#pragma unroll
        for (int e = 0; e < 8; ++e) acc[e] = 0.f;
#pragma unroll
        for (int jj = 0; jj < 3; ++jj) {
            const int dp = jj - 2;
            if (pos + dp >= 0) {
                const u32x4 z = *(const u32x4*)(Z + (size_t)(t + dp) * 512 + c0);
#pragma unroll
                for (int e = 0; e < 4; ++e) { acc[2 * e] += cw[jj * 512 + c0 + 2 * e] * bflo(z[e]); acc[2 * e + 1] += cw[jj * 512 + c0 + 2 * e + 1] * bfhi(z[e]); }
            }
        }
        const u32x4 g = *(const u32x4*)(BG + (size_t)t * 512 + c0);
        u32x4 o;
#pragma unroll
        for (int e = 0; e < 4; ++e) o[e] = pk2(acc[2 * e] * bflo(g[e]), acc[2 * e + 1] * bfhi(g[e]));
        *(u32x4*)(Y + (size_t)t * 1024 + 512 + c0) = o;
    }
}

DI float wave_incl_sum(float x, int lane) { for (int d = 1; d < 64; d <<= 1) { const float t = lane_get_f(x, lane >= d ? lane - d : lane); if (lane >= d) x += t; } return x; }
DI float wave_incl_max(float x, int lane) { for (int d = 1; d < 64; d <<= 1) { const float t = lane_get_f(x, lane >= d ? lane - d : lane); if (lane >= d) x = fmaxf(x, t); } return x; }
DI bf16x8 scale_frag(bf16x8 f, const float* w8) {
    const u32x4 u = __builtin_bit_cast(u32x4, f);
    u32x4 o;
#pragma unroll
    for (int e = 0; e < 4; ++e) o[e] = pk2(bflo(u[e]) * w8[2 * e], bfhi(u[e]) * w8[2 * e + 1]);
    return __builtin_bit_cast(bf16x8, o);
}

DI void phase_ml1(const Params& p, unsigned char* smem, int bid, int nb, int tid) {
    const int lane = tid & 63, wid = tid >> 6, c = lane & 31, hh = lane >> 5;
    float* wsl = (float*)smem + wid * 64;
    const bf16_t* KT = (const bf16_t*)(p.ws + WS_MKT);
    const bf16_t* VT = (const bf16_t*)(p.ws + WS_MV);
    const float* MIG = (const float*)(p.ws + WS_MIG);
    const float* MFG = (const float*)(p.ws + WS_MFG);
    float* UB = (float*)(p.ws + WS_UBUF);
    float* UN = (float*)(p.ws + WS_UNBUF);
    float* ML = (float*)(p.ws + WS_MLOC);
    for (int item = bid; item < 2048; item += nb) {
        const int bh = item >> 5, ch = item & 31, b = bh >> 3, h = bh & 7;
        const size_t tb = (size_t)b * S + ch * 64;
        const float lf = MFG[(tb + lane) * 8 + h], ig = MIG[(tb + lane) * 8 + h];
        const float bc = wave_incl_sum(lf, lane);
        const float blast = lane_get_f(bc, 63);
        const float g = blast - bc + ig;
        const float gmax = wave_max(g);
        wsl[lane] = __expf(g - gmax);
        if (wid == 0 && lane == 0) { ML[item * 2] = blast; ML[item * 2 + 1] = gmax; }
        f32x16 u0, u1;
#pragma unroll
        for (int r = 0; r < 16; ++r) { u0[r] = 0.f; u1[r] = 0.f; }
        const bf16_t* vp = VT + ((size_t)(bh * 128 + wid * 32 + c)) * S + ch * 64 + 8 * hh;
        const bf16_t* kp = KT + ((size_t)(bh * 64 + c)) * S + ch * 64 + 8 * hh;
#pragma unroll
        for (int ks = 0; ks < 4; ++ks) {
            float w8[8];
            const f32x4 wa = *(const f32x4*)(wsl + 16 * ks + 8 * hh), wb = *(const f32x4*)(wsl + 16 * ks + 8 * hh + 4);
            w8[0] = wa[0]; w8[1] = wa[1]; w8[2] = wa[2]; w8[3] = wa[3]; w8[4] = wb[0]; w8[5] = wb[1]; w8[6] = wb[2]; w8[7] = wb[3];
            const bf16x8 va = *(const bf16x8*)(vp + 16 * ks);
            const bf16x8 k0 = scale_frag(*(const bf16x8*)(kp + 16 * ks), w8);
            const bf16x8 k1 = scale_frag(*(const bf16x8*)(kp + (size_t)32 * S + 16 * ks), w8);
            u0 = __builtin_amdgcn_mfma_f32_32x32x16_bf16(va, k0, u0, 0, 0, 0);
            u1 = __builtin_amdgcn_mfma_f32_32x32x16_bf16(va, k1, u1, 0, 0, 0);
        }
        float* up = UB + ((size_t)item * 128 + wid * 32) * 64 + c;
#pragma unroll
        for (int r = 0; r < 16; ++r) { const int v = crow(r, lane); up[v * 64] = u0[r]; up[v * 64 + 32] = u1[r]; }
        if (wid == 0) {
            const u32x4* kr = (const u32x4*)(KT + ((size_t)(bh * 64 + lane)) * S + ch * 64);
            float a = 0.f;
#pragma unroll
            for (int q = 0; q < 8; ++q) { const u32x4 u = kr[q];
#pragma unroll
                for (int e = 0; e < 4; ++e) a += wsl[q * 8 + 2 * e] * bflo(u[e]) + wsl[q * 8 + 2 * e + 1] * bfhi(u[e]); }
            UN[(size_t)item * 64 + lane] = a;
        }
    }
}

DI void phase_ml2(const Params& p, unsigned char* smem, int bid, int nb, int tid) {
    float* dec = (float*)smem;
    float* scl = dec + 32;
    const float* UB = (const float*)(p.ws + WS_UBUF);
    const float* UN = (const float*)(p.ws + WS_UNBUF);
    const float* ML = (const float*)(p.ws + WS_MLOC);
    bf16_t* CB = (bf16_t*)(p.ws + WS_CBUF);
    float* NBF = (float*)(p.ws + WS_NBUF);
    float* MST = (float*)(p.ws + WS_MST);
    for (int item = bid; item < 512; item += nb) {
        const int bh = item >> 3, sl = item & 7;
        __syncthreads();
        if (tid == 0) {
            float m = 0.f;
            for (int ch = 0; ch < 32; ++ch) {
                const float bl = ML[(bh * 32 + ch) * 2], gm = ML[(bh * 32 + ch) * 2 + 1];
                const float mn = fmaxf(bl + m, gm);
                dec[ch] = __expf(bl + m - mn); scl[ch] = __expf(gm - mn);
                if (sl == 0) MST[bh * 32 + ch] = m;
                m = mn;
            }
        }
        __syncthreads();
        f32x4 st = {0.f, 0.f, 0.f, 0.f};
        const size_t e0 = (size_t)sl * 1024 + tid * 4;
        f32x4 ub[32];
#pragma unroll
        for (int ch = 0; ch < 32; ++ch) ub[ch] = *(const f32x4*)(UB + ((size_t)(bh * 32 + ch)) * 8192 + e0);
#pragma unroll
        for (int ch = 0; ch < 32; ++ch) {
            st = st * dec[ch] + ub[ch] * scl[ch];
            u32x2 o = {pk2(st[0], st[1]), pk2(st[2], st[3])};
            *(u32x2*)(CB + ((size_t)(bh * 32 + ch)) * 8192 + e0) = o;
        }
        if (sl == 0 && tid < 64) {
            float nst = 0.f, un[32];
#pragma unroll
            for (int ch = 0; ch < 32; ++ch) un[ch] = UN[(size_t)(bh * 32 + ch) * 64 + tid];
#pragma unroll
            for (int ch = 0; ch < 32; ++ch) { nst = nst * dec[ch] + un[ch] * scl[ch]; NBF[(size_t)(bh * 32 + ch) * 64 + tid] = nst; }
        }
    }
}

DI void phase_ml3(const Params& p, int j, unsigned char* smem, int bid, int nb, int tid) {
    const int lane = tid & 63, wid = tid >> 6, c = lane & 31, hh = lane >> 5;
    float* al = (float*)smem + wid * 64;
    float* ssum = (float*)smem + 256;
    const bf16_t* MQ = (const bf16_t*)(p.ws + WS_MQ);
    const bf16_t* MK = (const bf16_t*)(p.ws + WS_MK);
    const bf16_t* VT = (const bf16_t*)(p.ws + WS_MV);
    const float* MIG = (const float*)(p.ws + WS_MIG);
    const float* MFG = (const float*)(p.ws + WS_MFG);
    const bf16_t* MOG = (const bf16_t*)(p.ws + WS_MOG);
    const bf16_t* CB = (const bf16_t*)(p.ws + WS_CBUF);
    const float* NBF = (const float*)(p.ws + WS_NBUF);
    const float* MST = (const float*)(p.ws + WS_MST);
    bf16_t* Y = (bf16_t*)(p.ws + WS_YMIX);
    const int kperm = (c & ~12) | ((c & 4) << 1) | ((c & 8) >> 1);
    for (int item = bid; item < 2048; item += nb) {
        const int bh = item >> 5, ch = item & 31, b = bh >> 3, h = bh & 7;
        const size_t tb = (size_t)b * S + ch * 64;
        const float lf = MFG[(tb + lane) * 8 + h], ig = MIG[(tb + lane) * 8 + h];
        const float bc = wave_incl_sum(lf, lane);
        const float av = ig - bc;
        const float mprev = MST[item];
        const float Mv = fmaxf(mprev, wave_incl_max(av, lane));
        __syncthreads();
        al[lane] = av;
        float Mt[2], wint[2], emt[2];
#pragma unroll
        for (int tt = 0; tt < 2; ++tt) { Mt[tt] = lane_get_f(Mv, 32 * tt + c); wint[tt] = __expf(mprev - Mt[tt]); emt[tt] = __expf(-(lane_get_f(bc, 32 * tt + c) + Mt[tt])); }
        bf16x8 qf[2][4], kf[2][4];
#pragma unroll
        for (int tt = 0; tt < 2; ++tt) {
            const bf16_t* qp = MQ + (tb + 32 * tt + c) * 512 + h * 64 + 8 * hh;
            const bf16_t* kp = MK + (tb + 32 * tt + kperm) * 512 + h * 64 + 8 * hh;
#pragma unroll
            for (int ks = 0; ks < 4; ++ks) { qf[tt][ks] = *(const bf16x8*)(qp + 16 * ks); kf[tt][ks] = *(const bf16x8*)(kp + 16 * ks); }
        }
        f32x16 o[2];
#pragma unroll
        for (int tt = 0; tt < 2; ++tt)
#pragma unroll
            for (int r = 0; r < 16; ++r) o[tt][r] = 0.f;
        float nq[2] = {0.f, 0.f};
        if (ch > 0) {
            const bf16_t* cp = CB + ((size_t)(item - 1) * 128 + wid * 32 + c) * 64 + 8 * hh;
            const float* np = NBF + (size_t)(item - 1) * 64 + 8 * hh;
#pragma unroll
            for (int ks = 0; ks < 4; ++ks) {
                const bf16x8 cf = *(const bf16x8*)(cp + 16 * ks);
                o[0] = __builtin_amdgcn_mfma_f32_32x32x16_bf16(cf, qf[0][ks], o[0], 0, 0, 0);
                o[1] = __builtin_amdgcn_mfma_f32_32x32x16_bf16(cf, qf[1][ks], o[1], 0, 0, 0);
                const f32x4 n0 = *(const f32x4*)(np + 16 * ks), n1 = *(const f32x4*)(np + 16 * ks + 4);
#pragma unroll
                for (int tt = 0; tt < 2; ++tt) {
                    const u32x4 u = __builtin_bit_cast(u32x4, qf[tt][ks]);
                    nq[tt] += n0[0] * bflo(u[0]) + n0[1] * bfhi(u[0]) + n0[2] * bflo(u[1]) + n0[3] * bfhi(u[1]) + n1[0] * bflo(u[2]) + n1[1] * bfhi(u[2]) + n1[2] * bflo(u[3]) + n1[3] * bfhi(u[3]);
                }
            }
#pragma unroll
            for (int tt = 0; tt < 2; ++tt) {
                nq[tt] += sx_f<32>(nq[tt]);
#pragma unroll
                for (int r = 0; r < 16; ++r) o[tt][r] *= wint[tt];
            }
        }
        float csum[2] = {0.f, 0.f};
        const bf16_t* vp = VT + ((size_t)(bh * 128 + wid * 32 + c)) * S + ch * 64 + 8 * hh;
#pragma unroll
        for (int tt = 0; tt < 2; ++tt) {
#pragma unroll
            for (int st = 0; st <= tt; ++st) {
                f32x16 x;
#pragma unroll
                for (int r = 0; r < 16; ++r) x[r] = 0.f;
#pragma unroll
                for (int ks = 0; ks < 4; ++ks) x = __builtin_amdgcn_mfma_f32_32x32x16_bf16(kf[st][ks], qf[tt][ks], x, 0, 0, 0);
#pragma unroll
                for (int k2 = 0; k2 < 2; ++k2) {
                    const int s0 = 32 * st + 16 * k2 + 8 * hh;
                    const f32x4 a0 = *(const f32x4*)(al + s0), a1 = *(const f32x4*)(al + s0 + 4);
                    const float a8[8] = {a0[0], a0[1], a0[2], a0[3], a1[0], a1[1], a1[2], a1[3]};
                    float pr[8];
#pragma unroll
                    for (int jx = 0; jx < 8; ++jx) {
                        const float e = __expf(a8[jx] - Mt[tt]) * x[8 * k2 + jx];
                        pr[jx] = (st < tt || s0 + jx <= 32 * tt + c) ? e : 0.f;
                        csum[tt] += pr[jx];
                    }
                    u32x4 pk = {pk2(pr[0], pr[1]), pk2(pr[2], pr[3]), pk2(pr[4], pr[5]), pk2(pr[6], pr[7])};
                    const bf16x8 vf = *(const bf16x8*)(vp + 32 * st + 16 * k2);
                    o[tt] = __builtin_amdgcn_mfma_f32_32x32x16_bf16(vf, __builtin_bit_cast(bf16x8, pk), o[tt], 0, 0, 0);
                }
            }
        }
        float ss[2];
#pragma unroll
        for (int tt = 0; tt < 2; ++tt) {
            csum[tt] += sx_f<32>(csum[tt]);
            const float den = wint[tt] * nq[tt] + csum[tt];
            const float rd = 1.f / fmaxf(fabsf(den), emt[tt]);
            float s2 = 0.f;
#pragma unroll
            for (int r = 0; r < 16; ++r) { o[tt][r] *= rd; s2 += o[tt][r] * o[tt][r]; }
            s2 += sx_f<32>(s2);
            ss[tt] = s2;
            if (hh == 0) ssum[wid * 64 + 32 * tt + c] = s2;
        }
        __syncthreads();
#pragma unroll
        for (int tt = 0; tt < 2; ++tt) {
            const int tcol = 32 * tt + c;
            const float tot = ssum[tcol] + ssum[64 + tcol] + ssum[128 + tcol] + ssum[192 + tcol];
            const float rstd = rsqrtf(tot * (1.f / 128.f) + EPS);
            const size_t ro = (tb + tcol) * 1024 + h * 128 + wid * 32 + 4 * hh;
            const float* gp = p.ml_out_norm + j * 1024 + h * 128 + wid * 32 + 4 * hh;
#pragma unroll
            for (int g4 = 0; g4 < 4; ++g4) {
                const f32x4 gm = *(const f32x4*)(gp + 8 * g4);
                const u32x2 og = *(const u32x2*)(MOG + ro + 8 * g4);
                u32x2 ov = {pk2(o[tt][4 * g4] * rstd * gm[0] * bflo(og[0]), o[tt][4 * g4 + 1] * rstd * gm[1] * bfhi(og[0])),
                            pk2(o[tt][4 * g4 + 2] * rstd * gm[2] * bflo(og[1]), o[tt][4 * g4 + 3] * rstd * gm[3] * bfhi(og[1]))};
                *(u32x2*)(Y + ro + 8 * g4) = ov;
            }
        }
    }
}


namespace pg8 {
#define PG8_LAS __attribute__((address_space(3)))
typedef unsigned short bf16_t;
typedef short bf16x8 __attribute__((ext_vector_type(8)));
typedef float f32x4 __attribute__((ext_vector_type(4)));
typedef unsigned u32x4 __attribute__((ext_vector_type(4)));
constexpr int BM = 256, BK = 64, HALF = 128, HTB = HALF * BK * 2  , STAGE_BYTES = 8 * HTB, NXCD = 8, WGM = 8;

__host__ __device__ __forceinline__ int lds_byte(int r, int c) { const int st = (r >> 4) * 2 + (c >> 5), rr = r & 15, cc = c & 31, ob = rr * 64 + cc * 2; return st * 1024 + (ob ^ (((ob >> 9) & 1) << 5)); }
__host__ __device__ __forceinline__ void stage_rc(int b, int& R, int& C) { const int st = b / 1024, sb = b % 1024, swz = sb ^ (((sb >> 9) & 1) << 5); R = (st >> 1) * 16 + swz / 64; C = (st & 1) * 32 + (swz % 64) / 2; }
__host__ __device__ __forceinline__ int perm32(int rho) { const int n = rho >> 4, i = rho & 15; return 8 * (i >> 2) + 4 * n + (i & 3); }

struct Unit { int pm, pn; };
struct Gemm { const bf16_t* A; const bf16_t* Bt; int M, N, K; };

struct StaticOrder {
    int nM, nN, nwg, G, c;
    __host__ __device__ void init(int M, int N, int G_, int c_) { nM = M / BM; nN = N / BM; nwg = nM * nN; G = G_; c = c_; }
    __host__ __device__ bool next(int i, Unit& u) const {
        const long L = (long)i * G + c; if (L >= nwg) return false;
        int wgid = (int)L; { const int q = nwg / NXCD, r = nwg % NXCD, xcd = wgid % NXCD, off = wgid / NXCD; wgid = (xcd < r ? xcd * (q + 1) : r * (q + 1) + (xcd - r) * q) + off; }
        const int nig = WGM * nN, gid = wgid / nig, fm = gid * WGM, gsz = (nM - fm) < WGM ? (nM - fm) : WGM;
        u.pm = fm + ((wgid % nig) % gsz); u.pn = (wgid % nig) / gsz; return true;
    }
    static constexpr bool GATHER = false;
    __device__ __forceinline__ unsigned a_off(const Unit&, int) const { return 0u; }
    __device__ __forceinline__ void a_ready(const Unit&) const {}
    __device__ __forceinline__ void done(const Unit&) const {}
};


template <class Epi, class Sched, bool ALIGN_EPI = false, bool SP2 = false>
__device__ __forceinline__ void gemm_phase(PG8_LAS unsigned char* lds, const Gemm g, const Sched& S, const Epi& E, int tid512) {
    const int tid = opq(tid512), wid = __builtin_amdgcn_readfirstlane(tid >> 6), lane = tid & 63, wr = wid >> 2, wc = wid & 3, fr = lane & 15, fq = lane >> 4;
    const int K = g.K, nt = K / BK;
    unsigned voffA[2], voffB[2];
    int rowA[2];
#pragma unroll
    for (int i = 0; i < 2; ++i) { int R, C; stage_rc(tid * 16 + i * 8192, R, C); const int Rb = Epi::PERM ? ((R & ~31) + perm32(R & 31)) : R;
        voffA[i] = (unsigned)(R * K + C) * 2u; voffB[i] = (unsigned)(Rb * K + C) * 2u; rowA[i] = R; if (Sched::GATHER) voffA[i] = (unsigned)C * 2u; }
    const size_t kstep = (size_t)(BK * 2);
    const size_t hstep = (size_t)HALF * K * 2;
    const size_t tstep = 2 * hstep;
    const unsigned ldsw = (unsigned)wid * 1024u;
    const int aoff = lds_byte(wr * 64 + fr, fq * 8), boff = lds_byte(wc * 32 + fr, fq * 8);
#define PG8_SA(b, h) (((b) * 2 + (h)) * HTB)
#define PG8_SB(b, h) ((4 + (b) * 2 + (h)) * HTB)
#define PG8_STAGE(bufoff, gbase, voff) do { _Pragma("unroll") for (int _i = 0; _i < 2; ++_i) \
        __builtin_amdgcn_global_load_lds((const unsigned*)((const char*)(gbase) + (voff)[_i]), (PG8_LAS unsigned*)(lds + (bufoff) + ldsw + _i * 8192), 16, 0, 0); } while (0)
#define PG8_LDA(dst, b, h) do { _Pragma("unroll") for (int m = 0; m < 4; ++m) _Pragma("unroll") for (int k = 0; k < 2; ++k) dst[m][k] = *(const PG8_LAS bf16x8*)(lds + PG8_SA(b, h) + aoff + m * 2048 + k * 1024); } while (0)
#define PG8_LDB(dst, b, h) do { _Pragma("unroll") for (int n = 0; n < 2; ++n) _Pragma("unroll") for (int k = 0; k < 2; ++k) dst[n][k] = *(const PG8_LAS bf16x8*)(lds + PG8_SB(b, h) + boff + n * 2048 + k * 1024); } while (0)
#define PG8_MMA(ai, bj, At, Bt) do { __builtin_amdgcn_s_setprio(1); _Pragma("unroll") for (int m = 0; m < 4; ++m) _Pragma("unroll") for (int n = 0; n < 2; ++n) _Pragma("unroll") for (int k = 0; k < 2; ++k) \
        acc[ai][bj][m][n] = __builtin_amdgcn_mfma_f32_16x16x32_bf16(Bt[n][k], At[m][k], acc[ai][bj][m][n], 0, 0, 0); __builtin_amdgcn_s_setprio(0); } while (0)
#define PG8_WAIT_V(n) asm volatile("s_waitcnt vmcnt(" #n ")" ::: "memory")
#define PG8_WAIT_L(n) asm volatile("s_waitcnt lgkmcnt(" #n ")" ::: "memory")
#define PG8_BAR __builtin_amdgcn_s_barrier()
#define PG8_SCHED __builtin_amdgcn_sched_barrier(0)
    unsigned oaC[2][2], oaN[2][2];
#define PG8_GOFF(dst, unit) do { _Pragma("unroll") for (int _h = 0; _h < 2; ++_h) _Pragma("unroll") for (int _i = 0; _i < 2; ++_i) dst[_h][_i] = S.a_off(unit, _h * HALF + rowA[_i]) + voffA[_i]; } while (0)
#define PG8_STAGE_G(bufoff, offs, koff) do { _Pragma("unroll") for (int _i = 0; _i < 2; ++_i) \
        __builtin_amdgcn_global_load_lds((const unsigned*)(((const char*)g.A + (koff)) + (offs)[_i]), (PG8_LAS unsigned*)(lds + (bufoff) + ldsw + _i * 8192), 16, 0, 0); } while (0)
    Unit cur, nxt; int ui = 0;
    if (!S.next(0, cur)) return;
    if constexpr (Sched::GATHER) { PG8_GOFF(oaC, cur); PG8_GOFF(oaN, cur); }
    f32x4 acc[2][2][4][2];
#pragma unroll
    for (int a = 0; a < 2; ++a)
#pragma unroll
        for (int b = 0; b < 2; ++b)
#pragma unroll
            for (int m = 0; m < 4; ++m)
#pragma unroll
                for (int n = 0; n < 2; ++n) acc[a][b][m][n] = (f32x4){0.f, 0.f, 0.f, 0.f};
    bf16x8 At[4][2], B0[2][2], B1[2][2];
    const char* cA = (const char*)g.A + (size_t)cur.pm * tstep; const char* cB = (const char*)g.Bt + (size_t)cur.pn * tstep;
    S.a_ready(cur);
    if constexpr (SP2) {
        PG8_STAGE(PG8_SB(0, 0), cB, voffB); PG8_STAGE(PG8_SB(0, 1), cB + hstep, voffB);
        if constexpr (Sched::GATHER) { PG8_STAGE_G(PG8_SA(0, 0), oaC[0], 0); PG8_STAGE_G(PG8_SA(0, 1), oaC[1], 0); } else { PG8_STAGE(PG8_SA(0, 0), cA, voffA); PG8_STAGE(PG8_SA(0, 1), cA + hstep, voffA); }
        if (wr == 1) PG8_BAR;
        PG8_WAIT_V(2); PG8_BAR;
        PG8_STAGE(PG8_SB(1, 0), cB + kstep, voffB);
        if constexpr (Sched::GATHER) PG8_STAGE_G(PG8_SA(1, 0), oaC[0], kstep); else PG8_STAGE(PG8_SA(1, 0), cA + kstep, voffA);
        PG8_STAGE(PG8_SB(1, 1), cB + hstep + kstep, voffB);
        PG8_WAIT_V(6); PG8_BAR;
    } else {
        PG8_STAGE(PG8_SB(0, 0), cB, voffB); PG8_STAGE(PG8_SA(0, 0), cA, voffA); PG8_STAGE(PG8_SB(0, 1), cB + hstep, voffB); PG8_STAGE(PG8_SA(0, 1), cA + hstep, voffA);
        if (wr == 1) PG8_BAR;
        PG8_WAIT_V(4); PG8_BAR;
        PG8_STAGE(PG8_SB(1, 0), cB + kstep, voffB); PG8_STAGE(PG8_SA(1, 0), cA + kstep, voffA); PG8_STAGE(PG8_SB(1, 1), cB + hstep + kstep, voffB);
        PG8_WAIT_V(6); PG8_BAR;
    }
    for (;;) {
        const bool has_next = S.next(ui + 1, nxt);
        const char* nA = has_next ? (const char*)g.A + (size_t)nxt.pm * tstep : cA; const char* nB = has_next ? (const char*)g.Bt + (size_t)nxt.pn * tstep : cB;
        for (int t = 0; t < nt; t += 2) {
            const bool last = (t == nt - 2);
            const char* a1 = cA + (size_t)(t + 1) * kstep;
            const char* a2 = last ? nA : cA + (size_t)(t + 2) * kstep; const char* b2 = last ? nB : cB + (size_t)(t + 2) * kstep;
            const char* a3 = a2 + kstep; const char* b3 = b2 + kstep;
            if (last && has_next) S.a_ready(nxt);
            unsigned oaS[2][2]; size_t k2 = 0;
            if constexpr (Sched::GATHER) {
                if (last && has_next) PG8_GOFF(oaN, nxt);
                const bool fromN = last && has_next;
#pragma unroll
                for (int _h = 0; _h < 2; ++_h)
#pragma unroll
                    for (int _i = 0; _i < 2; ++_i) oaS[_h][_i] = fromN ? oaN[_h][_i] : oaC[_h][_i];
                k2 = last ? (size_t)0 : (size_t)(t + 2) * kstep;
            }
            if constexpr (SP2) {
            PG8_LDB(B0, 0, 0); PG8_LDB(B1, 0, 1); PG8_SCHED; PG8_LDA(At, 0, 0);
            if constexpr (Sched::GATHER) PG8_STAGE_G(PG8_SA(1, 1), oaC[1], (size_t)(t + 1) * kstep); else PG8_STAGE(PG8_SA(1, 1), a1 + hstep, voffA);
            PG8_WAIT_V(8); PG8_WAIT_L(0); PG8_BAR; PG8_MMA(0, 0, At, B0); PG8_MMA(0, 1, At, B1); PG8_BAR; PG8_SCHED;
            PG8_LDA(At, 0, 1); PG8_STAGE(PG8_SB(0, 0), b2, voffB); PG8_STAGE(PG8_SB(0, 1), b2 + hstep, voffB);
            if constexpr (Sched::GATHER) PG8_STAGE_G(PG8_SA(0, 0), oaS[0], k2); else PG8_STAGE(PG8_SA(0, 0), a2, voffA);
            PG8_WAIT_V(8); PG8_WAIT_L(0); PG8_BAR; PG8_MMA(1, 0, At, B0); PG8_MMA(1, 1, At, B1); PG8_BAR; PG8_SCHED;
            PG8_LDB(B0, 1, 0); PG8_LDB(B1, 1, 1); PG8_SCHED; PG8_LDA(At, 1, 0);
            if constexpr (Sched::GATHER) PG8_STAGE_G(PG8_SA(0, 1), oaS[1], k2); else PG8_STAGE(PG8_SA(0, 1), a2 + hstep, voffA);
            PG8_WAIT_V(8); PG8_WAIT_L(0); PG8_BAR; PG8_MMA(0, 0, At, B0); PG8_MMA(0, 1, At, B1); PG8_BAR; PG8_SCHED;
            PG8_LDA(At, 1, 1); PG8_STAGE(PG8_SB(1, 0), b3, voffB); PG8_STAGE(PG8_SB(1, 1), b3 + hstep, voffB);
            if constexpr (Sched::GATHER) PG8_STAGE_G(PG8_SA(1, 0), oaS[0], k2 + kstep); else PG8_STAGE(PG8_SA(1, 0), a3, voffA);
            PG8_WAIT_V(8); PG8_WAIT_L(0); PG8_BAR; PG8_MMA(1, 0, At, B0); PG8_MMA(1, 1, At, B1); PG8_BAR; PG8_SCHED;
            } else {
            PG8_LDB(B0, 0, 0); PG8_SCHED; PG8_LDA(At, 0, 0); PG8_STAGE(PG8_SA(1, 1), a1 + hstep, voffA);
            PG8_WAIT_L(8); PG8_BAR; PG8_WAIT_L(0); PG8_MMA(0, 0, At, B0); PG8_BAR; PG8_SCHED;
            PG8_LDB(B1, 0, 1); PG8_STAGE(PG8_SB(0, 0), b2, voffB);
            PG8_BAR; PG8_WAIT_L(0); PG8_MMA(0, 1, At, B1); PG8_BAR;
            PG8_LDA(At, 0, 1); PG8_STAGE(PG8_SA(0, 0), a2, voffA);
            PG8_BAR; PG8_WAIT_L(0); PG8_MMA(1, 0, At, B0); PG8_BAR; PG8_SCHED;
            PG8_STAGE(PG8_SB(0, 1), b2 + hstep, voffB);
            PG8_WAIT_V(6); PG8_BAR; PG8_MMA(1, 1, At, B1); PG8_BAR;
            PG8_LDB(B0, 1, 0); PG8_SCHED; PG8_LDA(At, 1, 0); PG8_STAGE(PG8_SA(0, 1), a2 + hstep, voffA);
            PG8_WAIT_L(8); PG8_BAR; PG8_WAIT_L(0); PG8_MMA(0, 0, At, B0); PG8_BAR; PG8_SCHED;
            PG8_LDB(B1, 1, 1); PG8_STAGE(PG8_SB(1, 0), b3, voffB);
            PG8_BAR; PG8_WAIT_L(0); PG8_MMA(0, 1, At, B1); PG8_BAR;
            PG8_LDA(At, 1, 1); PG8_STAGE(PG8_SA(1, 0), a3, voffA);
            PG8_BAR; PG8_WAIT_L(0); PG8_MMA(1, 0, At, B0); PG8_BAR; PG8_SCHED;
            PG8_STAGE(PG8_SB(1, 1), b3 + hstep, voffB);
            PG8_WAIT_V(6); PG8_BAR; PG8_MMA(1, 1, At, B1); PG8_BAR;
            }
        }
        if constexpr (ALIGN_EPI) { if (wr == 0) PG8_BAR; }
        if constexpr (!Epi::AFTER_DRAIN) { E(acc, cur, wr, wc, fr, fq); S.done(cur); }
        if (!has_next) break;
#pragma unroll
        for (int a = 0; a < 2; ++a)
#pragma unroll
            for (int b = 0; b < 2; ++b)
#pragma unroll
                for (int m = 0; m < 4; ++m)
#pragma unroll
                    for (int n = 0; n < 2; ++n) acc[a][b][m][n] = (f32x4){0.f, 0.f, 0.f, 0.f};
        cur = nxt; cA = nA; cB = nB; ++ui;
        if constexpr (Sched::GATHER) {
#pragma unroll
            for (int _h = 0; _h < 2; ++_h)
#pragma unroll
                for (int _i = 0; _i < 2; ++_i) oaC[_h][_i] = oaN[_h][_i];
        }
        if constexpr (ALIGN_EPI) { if (wr == 1) PG8_BAR; }
    }
    PG8_WAIT_V(0);
    if constexpr (!ALIGN_EPI) { if (wr == 0) PG8_BAR; }
    PG8_BAR;
    if constexpr (Epi::AFTER_DRAIN) { E.fused(acc, cur, wr, wc, fr, fq, lds, wid, lane); S.done(cur); }
#undef PG8_GOFF
#undef PG8_STAGE_G
#undef PG8_SA
#undef PG8_SB
#undef PG8_STAGE
#undef PG8_LDA
#undef PG8_LDB
#undef PG8_MMA
#undef PG8_WAIT_V
#undef PG8_WAIT_L
#undef PG8_BAR
#undef PG8_SCHED
}
}

struct OutEpi8 {
    static constexpr bool PERM = false, AFTER_DRAIN = false;
    const float* src; float* dst; const float* gate; float* part;
    __device__ __forceinline__ void operator()(const pg8::f32x4 (&acc)[2][2][4][2], const pg8::Unit& u, int wr, int wc, int fr, int fq) const {
#pragma unroll
        for (int ai = 0; ai < 2; ++ai)
#pragma unroll
            for (int m = 0; m < 4; ++m) {
                const int t = u.pm * 256 + ai * 128 + wr * 64 + m * 16 + fr;
                const float* gp = gate + (t >> 11) * 6144;
                float ss = 0.f;
#pragma unroll
                for (int bj = 0; bj < 2; ++bj)
#pragma unroll
                    for (int n = 0; n < 2; ++n) {
                        const int col = u.pn * 256 + bj * 128 + wc * 32 + n * 16 + fq * 4;
                        const pg8::f32x4 g = *(const pg8::f32x4*)(gp + col);
                        const pg8::f32x4 o = *(const pg8::f32x4*)(src + (size_t)t * 1024 + col) + g * acc[ai][bj][m][n];
                        *(pg8::f32x4*)(dst + (size_t)t * 1024 + col) = o;
                        ss += o[0] * o[0] + o[1] * o[1] + o[2] * o[2] + o[3] * o[3];
                    }
                ss += sx_f<16>(ss); ss += sx_f<32>(ss);
                if (fq == 0) part[(size_t)t * 16 + u.pn * 4 + wc] = ss;
            }
    }
};


DI unsigned cvtpk(float lo, float hi) { return pk2(lo, hi); }
struct HybEpi8 {
    static constexpr bool PERM = true, AFTER_DRAIN = false;
    const Params* p; int j;
    __device__ __forceinline__ void operator()(const pg8::f32x4 (&acc)[2][2][4][2], const pg8::Unit& u, int wr, int wc, int fr, int fq) const {
        unsigned char* ws = p->ws;
        const int un = u.pn;
        if (un < 5 && !(un == 4 && (wc == 1 || wc == 3))) {
            const bool donorm = un < 2 || (un == 4 && wc == 0);
            bf16_t* ob; int ld, cb; const float* gam = p->hy_q_norm + j * 64;
            if (un < 2) { ob = (bf16_t*)(ws + WS_Q); ld = 512; cb = 64 * (4 * un + wc); }
            else if (un < 4) { ob = (bf16_t*)(ws + WS_IQ); ld = 512; cb = 64 * (4 * (un - 2) + wc); }
            else if (wc == 0) { ob = (bf16_t*)(ws + WS_K); ld = 64; cb = 0; gam = p->hy_k_norm + j * 64; }
            else { ob = (bf16_t*)(ws + WS_IK); ld = 64; cb = 0; }
            pg8::f32x4 g0[2], g1[2];
#pragma unroll
            for (int n = 0; n < 2; ++n) { g0[n] = donorm ? *(const pg8::f32x4*)(gam + 8 * fq + 4 * n) : (pg8::f32x4){1.f, 1.f, 1.f, 1.f}; g1[n] = donorm ? *(const pg8::f32x4*)(gam + 32 + 8 * fq + 4 * n) : (pg8::f32x4){1.f, 1.f, 1.f, 1.f}; }
            const float* ropec = (const float*)(ws + WS_ROPEC);
            const float* ropes = (const float*)(ws + WS_ROPES);
#pragma unroll
            for (int ai = 0; ai < 2; ++ai)
#pragma unroll
                for (int m = 0; m < 4; ++m) {
                    const int t = opq(u.pm * 256 + ai * 128 + wr * 64 + m * 16 + fr), pos = t & (S - 1);
                    float rstd = 1.f;
                    if (donorm) {
                        float ss = 0.f;
#pragma unroll
                        for (int bj = 0; bj < 2; ++bj)
#pragma unroll
                            for (int n = 0; n < 2; ++n) { const pg8::f32x4 x = acc[ai][bj][m][n]; ss += x[0] * x[0] + x[1] * x[1] + x[2] * x[2] + x[3] * x[3]; }
                        ss += sx_f<16>(ss); ss += sx_f<32>(ss);
                        rstd = rsqrtf(ss * (1.f / 64.f) + EPS);
                    }
                    u32x4 o1, o2;
#pragma unroll
                    for (int n = 0; n < 2; ++n) {
                        const pg8::f32x4 cs = *(const pg8::f32x4*)(ropec + pos * 32 + 8 * fq + 4 * n), sn = *(const pg8::f32x4*)(ropes + pos * 32 + 8 * fq + 4 * n);
                        const pg8::f32x4 x1 = acc[ai][0][m][n] * rstd * g0[n], x2 = acc[ai][1][m][n] * rstd * g1[n];
                        const pg8::f32x4 y1 = x1 * cs - x2 * sn, y2 = x2 * cs + x1 * sn;
                        o1[2 * n] = cvtpk(y1[0], y1[1]); o1[2 * n + 1] = cvtpk(y1[2], y1[3]);
                        o2[2 * n] = cvtpk(y2[0], y2[1]); o2[2 * n + 1] = cvtpk(y2[2], y2[3]);
                    }
                    *(u32x4*)(ob + (size_t)t * ld + cb + 8 * fq) = o1;
                    *(u32x4*)(ob + (size_t)t * ld + cb + 32 + 8 * fq) = o2;
                }
        } else if (un == 4 && wc == 1) {
            bf16_t* ob = (bf16_t*)(ws + WS_V);
#pragma unroll
            for (int ai = 0; ai < 2; ++ai)
#pragma unroll
                for (int m = 0; m < 4; ++m) {
                    const int t = opq(u.pm * 256 + ai * 128 + wr * 64 + m * 16 + fr), pos = t & (S - 1), bb = t >> 11;
#pragma unroll
                    for (int bj = 0; bj < 2; ++bj)
#pragma unroll
                        for (int n = 0; n < 2; ++n)
#pragma unroll
                            for (int e = 0; e < 4; ++e) ob[((size_t)(bb * 64 + 32 * bj + 8 * fq + 4 * n + e)) * S + pos] = f2bf(acc[ai][bj][m][n][e]);
                }
        } else if (un == 4) {
            float* ob = (float*)(ws + WS_IW);
            if (fq == 0) {
#pragma unroll
                for (int ai = 0; ai < 2; ++ai)
#pragma unroll
                    for (int m = 0; m < 4; ++m) {
                        const int t = u.pm * 256 + ai * 128 + wr * 64 + m * 16 + fr;
                        *(pg8::f32x4*)(ob + (size_t)t * 8) = acc[ai][0][m][0] * (0.125f * 0.35355339059327373f);
                        *(pg8::f32x4*)(ob + (size_t)t * 8 + 4) = acc[ai][0][m][1] * (0.125f * 0.35355339059327373f);
                    }
            }
        } else if (un < 7) {
            bf16_t* ob = (bf16_t*)(ws + WS_BG);
#pragma unroll
            for (int ai = 0; ai < 2; ++ai)
#pragma unroll
                for (int m = 0; m < 4; ++m) {
                    const int t = opq(u.pm * 256 + ai * 128 + wr * 64 + m * 16 + fr);
#pragma unroll
                    for (int bj = 0; bj < 2; ++bj) {
                        const pg8::f32x4 a = acc[ai][bj][m][0], b = acc[ai][bj][m][1];
                        u32x4 o = {cvtpk(a[0], a[1]), cvtpk(a[2], a[3]), cvtpk(b[0], b[1]), cvtpk(b[2], b[3])};
                        *(u32x4*)(ob + (size_t)t * 512 + (un - 5) * 256 + 128 * bj + 32 * wc + 8 * fq) = o;
                    }
                }
        } else {
            bf16_t* ob = (bf16_t*)(ws + WS_Z);
#pragma unroll
            for (int ai = 0; ai < 2; ++ai)
#pragma unroll
                for (int m = 0; m < 4; ++m) {
                    const int t = opq(u.pm * 256 + ai * 128 + wr * 64 + m * 16 + fr);
                    const pg8::f32x4 a = acc[ai][0][m][0] * acc[ai][1][m][0], b = acc[ai][0][m][1] * acc[ai][1][m][1];
                    u32x4 o = {cvtpk(a[0], a[1]), cvtpk(a[2], a[3]), cvtpk(b[0], b[1]), cvtpk(b[2], b[3])};
                    *(u32x4*)(ob + (size_t)t * 512 + (un - 7) * 128 + 32 * wc + 8 * fq) = o;
                }
        }
    }
};


struct MlEpi8 {
    static constexpr bool PERM = true, AFTER_DRAIN = false;
    const Params* p; int j;
    __device__ __forceinline__ void operator()(const pg8::f32x4 (&acc)[2][2][4][2], const pg8::Unit& u, int wr, int wc, int fr, int fq) const {
        unsigned char* ws = p->ws;
        const int un = u.pn;
        if (un < 4 || un >= 8) {
            bf16_t* ob; int ld, cb0; float sc = 1.f;
            if (un < 2) { ob = (bf16_t*)(ws + WS_MQ); ld = 512; cb0 = 64 * (4 * un + wc); sc = 0.125f; }
            else if (un < 4) { ob = (bf16_t*)(ws + WS_MK); ld = 512; cb0 = 64 * (4 * (un - 2) + wc); }
            else { ob = (bf16_t*)(ws + WS_MOG); ld = 1024; cb0 = (un - 8) * 256 + 32 * wc; }
            const int bstep = un < 4 ? 32 : 128;
#pragma unroll
            for (int ai = 0; ai < 2; ++ai)
#pragma unroll
                for (int m = 0; m < 4; ++m) {
                    const int t = opq(u.pm * 256 + ai * 128 + wr * 64 + m * 16 + fr);
#pragma unroll
                    for (int bj = 0; bj < 2; ++bj) {
                        pg8::f32x4 a = acc[ai][bj][m][0] * sc, b = acc[ai][bj][m][1] * sc;
                        if (un >= 8) { for (int e = 0; e < 4; ++e) { a[e] = sigmoidf_(a[e]); b[e] = sigmoidf_(b[e]); } }
                        u32x4 o = {cvtpk(a[0], a[1]), cvtpk(a[2], a[3]), cvtpk(b[0], b[1]), cvtpk(b[2], b[3])};
                        *(u32x4*)(ob + (size_t)t * ld + cb0 + bstep * bj + 8 * fq) = o;
                    }
                }
        }
        if (un >= 2 && un < 8) {
            bf16_t* ob = (bf16_t*)(ws + (un < 4 ? WS_MKT : WS_MV));
#pragma unroll
            for (int ai = 0; ai < 2; ++ai)
#pragma unroll
                for (int m = 0; m < 4; ++m) {
                    const int t = opq(u.pm * 256 + ai * 128 + wr * 64 + m * 16 + fr), pos = t & (S - 1), bb = t >> 11;
#pragma unroll
                    for (int bj = 0; bj < 2; ++bj) {
                        const size_t rowb = un < 4 ? (size_t)((bb * 8 + 4 * (un - 2) + wc) * 64 + 32 * bj + 8 * fq) : (size_t)((bb * 8 + 2 * (un - 4) + bj) * 128 + 32 * wc + 8 * fq);
#pragma unroll
                        for (int n = 0; n < 2; ++n)
#pragma unroll
                            for (int e = 0; e < 4; ++e) ob[(rowb + 4 * n + e) * S + pos] = f2bf(acc[ai][bj][m][n][e]);
                    }
                }
        }
    }
};


struct MoeOrder8 {
    static constexpr bool GATHER = true;
    const int* tab; const int* elist; int G, c, total, mode;
    __device__ __forceinline__ bool next(int i, pg8::Unit& u) const {
        const int L = i * G + c; if (L >= total) return false;
        int wg = L; { const int q = total >> 3, r = total & 7, x = wg & 7, off = wg >> 3; wg = (x < r ? x * (q + 1) : r * (q + 1) + (x - r) * q) + off; }
        const int ru = wg >> 2; int e = 0;
        while (e < 31 && tab[e + 1] <= ru) ++e;
        u.pm = __builtin_amdgcn_readfirstlane((e << 8) | (ru - tab[e])); u.pn = __builtin_amdgcn_readfirstlane(e * 4 + (wg & 3)); return true;
    }
    __device__ __forceinline__ unsigned a_off(const pg8::Unit& u, int row) const {
        const int e = u.pm >> 8, lr = (u.pm & 255) * 256 + row;
        if (lr >= tab[40 + e]) return 0u;
        if (mode == 1) return (unsigned)(elist[e * NASG + lr] >> 1) * 2048u;
        return (unsigned)(tab[80 + e] + lr) * 1024u;
    }
    __device__ __forceinline__ void a_ready(const pg8::Unit&) const {}
    __device__ __forceinline__ void done(const pg8::Unit&) const {}
};
struct Moe1Epi8 {
    static constexpr bool PERM = true, AFTER_DRAIN = false;
    const int* tab; bf16_t* h1;
    __device__ __forceinline__ void operator()(const pg8::f32x4 (&acc)[2][2][4][2], const pg8::Unit& u, int wr, int wc, int fr, int fq) const {
        const int e = u.pm >> 8, mu = u.pm & 255, nu = u.pn & 3, cnt = tab[40 + e], roff = tab[80 + e];
#pragma unroll
        for (int ai = 0; ai < 2; ++ai)
#pragma unroll
            for (int m = 0; m < 4; ++m) {
                const int lr = opq(mu * 256 + ai * 128 + wr * 64 + m * 16 + fr);
                if (lr < cnt) {
                    u32x4 o;
#pragma unroll
                    for (int n = 0; n < 2; ++n) {
                        const pg8::f32x4 g = acc[ai][0][m][n], up = acc[ai][1][m][n]; float h[4];
#pragma unroll
                        for (int x = 0; x < 4; ++x) h[x] = g[x] / (1.f + __expf(-g[x])) * up[x];
                        o[2 * n] = cvtpk(h[0], h[1]); o[2 * n + 1] = cvtpk(h[2], h[3]);
                    }
                    *(u32x4*)(h1 + (size_t)(roff + lr) * 512 + 128 * nu + 32 * wc + 8 * fq) = o;
                }
            }
    }
};
struct Moe2Epi8 {
    static constexpr bool PERM = true, AFTER_DRAIN = false;
    const int* tab; const int* elist; bf16_t* y;
    __device__ __forceinline__ void operator()(const pg8::f32x4 (&acc)[2][2][4][2], const pg8::Unit& u, int wr, int wc, int fr, int fq) const {
        const int e = u.pm >> 8, mu = u.pm & 255, nu = u.pn & 3, cnt = tab[40 + e];
#pragma unroll
        for (int ai = 0; ai < 2; ++ai)
#pragma unroll
            for (int m = 0; m < 4; ++m) {
                const int lr = opq(mu * 256 + ai * 128 + wr * 64 + m * 16 + fr);
                if (lr < cnt) {
                    const int a = elist[e * NASG + lr];
#pragma unroll
                    for (int bj = 0; bj < 2; ++bj) {
                        const pg8::f32x4 v0 = acc[ai][bj][m][0], v1 = acc[ai][bj][m][1];
                        u32x4 o = {cvtpk(v0[0], v0[1]), cvtpk(v0[2], v0[3]), cvtpk(v1[0], v1[1]), cvtpk(v1[2], v1[3])};
                        *(u32x4*)(y + (size_t)a * 1024 + 256 * nu + 128 * bj + 32 * wc + 8 * fq) = o;
                    }
                }
            }
    }
};

#define XB_TMO      128
#define XB_XCNT(j)  (256  + 64 * (j))
#define XB_XSUB(j)  (1280 + 64 * (j))
#define XB_XGEN(j)  (2304 + 64 * (j))
#define XB_TOP      3328
#define XB_TOPGEN   3392
#define XCD_BAR_WORDS 3456
#define XB_SPIN_CAP (1u << 22)
#define LAS __attribute__((address_space(3)))
DI unsigned xb_ld(unsigned* p) { return __hip_atomic_load(p, __ATOMIC_RELAXED, __HIP_MEMORY_SCOPE_AGENT); }
DI unsigned xb_add(unsigned* p, unsigned v) { return __hip_atomic_fetch_add(p, v, __ATOMIC_RELAXED, __HIP_MEMORY_SCOPE_AGENT); }
DI unsigned xb_xcc_id() { return (unsigned)__builtin_amdgcn_s_getreg((3 << 11) | 20) & 0xFu; }
#define XB_SPIN(cond, bar) do { unsigned _sp = 0; while (cond) { __builtin_amdgcn_s_sleep(1); \
    if ((++_sp & 255u) == 0u) { if (xb_ld(&(bar)[XB_TMO])) break; if (_sp > XB_SPIN_CAP) { atomicAdd(&(bar)[XB_TMO], 1u); break; } } } } while (0)
struct XcdBarrier { unsigned* bar; unsigned x; volatile LAS unsigned* st; };
DI XcdBarrier xcd_barrier_post(unsigned* bar, volatile LAS unsigned* st, bool leader) {
    XcdBarrier b; b.bar = bar; b.x = xb_xcc_id(); b.st = st;
    if (leader) (void)xb_add(&bar[XB_XCNT(b.x)], 1u);
    return b;
}
DI void xcd_barrier_complete(unsigned* bar, unsigned x, unsigned& nloc, unsigned& nx) {
    const unsigned G = gridDim.x * gridDim.y * gridDim.z;
    unsigned sum, cnt, mine, sp = 0u;
    for (;;) {
        sum = 0u; cnt = 0u; mine = 0u;
#pragma unroll
        for (unsigned j = 0; j < 16; ++j) { const unsigned c = xb_ld(&bar[XB_XCNT(j)]); sum += c; cnt += (c > 0u) ? 1u : 0u; mine = (j == x) ? c : mine; }
        if (sum == G) break;
        __builtin_amdgcn_s_sleep(1);
        if ((++sp & 255u) == 0u) { if (xb_ld(&bar[XB_TMO])) break; if (sp > XB_SPIN_CAP) { atomicAdd(&bar[XB_TMO], 1u); break; } }
    }
    nloc = mine > 0u ? mine : 1u; nx = cnt > 0u ? cnt : 1u;
}
DI void xcd_barrier(const XcdBarrier& b, bool leader) {
    asm volatile("s_waitcnt vmcnt(0)" ::: "memory");
    __syncthreads();
    if (leader) {
        unsigned* bar = b.bar;
        __builtin_amdgcn_s_waitcnt(0);
        unsigned nloc = b.st[0], nx = b.st[1];
        if (nloc == 0u) { xcd_barrier_complete(bar, b.x, nloc, nx); b.st[0] = nloc; b.st[1] = nx; }
        const unsigned old = xb_add(&bar[XB_XSUB(b.x)], 1u);
        const unsigned gen = old / nloc;
        if (old + 1u == (gen + 1u) * nloc) {
            __builtin_amdgcn_fence(__ATOMIC_RELEASE, "agent");
            asm volatile("s_waitcnt vmcnt(0)" ::: "memory");
            const unsigned og = xb_add(&bar[XB_TOP], 1u);
            const unsigned tg = og / nx;
            if (og + 1u == (tg + 1u) * nx) xb_add(&bar[XB_TOPGEN], 1u);
            else XB_SPIN(xb_ld(&bar[XB_TOPGEN]) == tg, bar);
            __builtin_amdgcn_fence(__ATOMIC_ACQUIRE, "agent");
            xb_add(&bar[XB_XGEN(b.x)], 1u);
            asm volatile("s_waitcnt vmcnt(0)" ::: "memory");
        } else {
            XB_SPIN(xb_ld(&bar[XB_XGEN(b.x)]) == gen, bar);
            __builtin_amdgcn_fence(__ATOMIC_ACQUIRE, "agent");
            asm volatile("s_waitcnt vmcnt(0)" ::: "memory");
        }
    }
    __syncthreads();
}

namespace cg = cooperative_groups;
constexpr int MEGA_LDS = 65536 + 256;

DI const Params& fresh(const Params* kp) { asm volatile("" : "+s"(kp)); return *kp; }

#ifndef PROBE_MASK
#define PROBE_MASK 0
#endif
__global__ void __launch_bounds__(512, 2) hybrid_fwd_megakernel(Params p_arg) {
    __shared__ __attribute__((aligned(16))) unsigned char smem_all[2 * MEGA_LDS + 1024];
    cg::grid_group grid = cg::this_grid();
    const Params* kp = (const Params*)__builtin_amdgcn_kernarg_segment_ptr();
    const int wave8 = __builtin_amdgcn_readfirstlane((int)(threadIdx.x >> 6));
    const int vb = wave8 >> 2;
#define tid0 ((wave8 & 3) * 64 + lane_id())
    unsigned char* smem = smem_all + vb * MEGA_LDS;
    const int bid0 = blockIdx.x * 2 + vb, nb = gridDim.x * 2;
    const int gx0 = blockIdx.x & 7, glb0 = (blockIdx.x >> 3) * 2 + vb, gnl = (gridDim.x >> 3) * 2;
#define bid opqs(bid0)
#define gx opqs(gx0)
#define glb opqs(glb0)
#define tid opq(tid0)
    volatile LAS unsigned* xst = (volatile LAS unsigned*)(smem_all + 2 * MEGA_LDS);
    if (wave8 == 0 && lane_id() == 0) { xst[0] = 0u; xst[1] = 0u; }
    __syncthreads();
    (void)xcd_barrier_post((unsigned*)(fresh(kp).ws + WS_BAR), xst, wave8 == 0 && lane_id() == 0);
    for (int rep = 0; rep < ((PROBE_MASK & 1) ? 2 : 1); ++rep) { phase_init(fresh(kp), smem, bid, nb, tid); }
#define GSYNC() do { XcdBarrier xb_; xb_.bar = (unsigned*)(fresh(kp).ws + WS_BAR); xb_.x = xb_xcc_id(); xb_.st = (volatile LAS unsigned*)(smem_all + 2 * MEGA_LDS); xcd_barrier(xb_, wave8 == 0 && lane_id() == 0); } while (0)
    if (fresh(kp).use_cg_sync) grid.sync();
    GSYNC();
#pragma unroll 1
    for (int layer = 0; layer < DEPTH; ++layer) {
        const int j = layer >> 1;
        if (layer == 0) { { const Params& p = fresh(kp); phase_norm(p, 0, p.x, bid, nb, tid); }
        GSYNC(); }
        if ((layer & 1) == 0) {
            for (int rep = 0; rep < ((PROBE_MASK & 4) ? 2 : 1); ++rep) { { const Params& p = fresh(kp);
              pg8::Gemm g8{(const pg8::bf16_t*)(p.ws + WS_H), (const pg8::bf16_t*)(p.ws + WS_WHYB) + (size_t)j * 2816 * 1024, T, 2816, 1024};
              pg8::StaticOrder S8; S8.init(T, 2816, (int)gridDim.x, (int)blockIdx.x);
              HybEpi8 E8{&p, j};
              pg8::gemm_phase<HybEpi8, pg8::StaticOrder, true, true>((PG8_LAS unsigned char*)smem_all, g8, S8, E8, wave8 * 64 + lane_id()); } }
            GSYNC();
            for (int rep = 0; rep < ((PROBE_MASK & 8) ? 2 : 1); ++rep) { phase_dsa(fresh(kp), j, smem, bid, nb, tid, layer == 0 ? 1 : 3, layer == 0 ? 3 : 4); }
            for (int rep = 0; rep < ((PROBE_MASK & 16) ? 2 : 1); ++rep) { phase_conv(fresh(kp), j, bid, nb, tid); }
            GSYNC();
            { const Params& p = fresh(kp);
              pg8::Gemm g8{(const pg8::bf16_t*)(p.ws + WS_YMIX), (const pg8::bf16_t*)(p.ws + WS_WOUT) + (size_t)layer * 1024 * 1024, T, 1024, 1024};
              pg8::StaticOrder S8; S8.init(T, 1024, (int)gridDim.x, (int)blockIdx.x);
              OutEpi8 E8{layer == 0 ? p.x : p.out, p.out, (const float*)(p.ws + WS_MOD) + (size_t)layer * 8 * 6144 + 2048, (float*)(p.ws + WS_PART)};
              pg8::gemm_phase<OutEpi8, pg8::StaticOrder, true, true>((PG8_LAS unsigned char*)smem_all, g8, S8, E8, wave8 * 64 + lane_id()); }
        } else {
            for (int rep = 0; rep < ((PROBE_MASK & 32) ? 2 : 1); ++rep) { { const Params& p = fresh(kp);
              pg8::Gemm g8{(const pg8::bf16_t*)(p.ws + WS_H), (const pg8::bf16_t*)(p.ws + WS_WML) + (size_t)j * 3200 * 1024, T, 3072, 1024};
              pg8::StaticOrder S8; S8.init(T, 3072, (int)gridDim.x, (int)blockIdx.x);
              MlEpi8 E8{&p, j};
              pg8::gemm_phase<MlEpi8, pg8::StaticOrder, true, true>((PG8_LAS unsigned char*)smem_all, g8, S8, E8, wave8 * 64 + lane_id());
              for (int gi = glb; gi < 16; gi += gnl) { MlGates pr{&p, j, gx * 16 + gi}; gemm_tile(pr, smem, tid); } } }
            GSYNC();
            for (int rep = 0; rep < ((PROBE_MASK & 64) ? 2 : 1); ++rep) { phase_ml1(fresh(kp), smem, bid, nb, tid); }
            GSYNC();
            for (int rep = 0; rep < ((PROBE_MASK & 128) ? 2 : 1); ++rep) { phase_ml2(fresh(kp), smem, bid, nb, tid); }
            GSYNC();
            for (int rep = 0; rep < ((PROBE_MASK & 256) ? 2 : 1); ++rep) { phase_ml3(fresh(kp), j, smem, bid, nb, tid); }
            GSYNC();
            { const Params& p = fresh(kp);
              pg8::Gemm g8{(const pg8::bf16_t*)(p.ws + WS_YMIX), (const pg8::bf16_t*)(p.ws + WS_WOUT) + (size_t)layer * 1024 * 1024, T, 1024, 1024};
              pg8::StaticOrder S8; S8.init(T, 1024, (int)gridDim.x, (int)blockIdx.x);
              OutEpi8 E8{p.out, p.out, (const float*)(p.ws + WS_MOD) + (size_t)layer * 8 * 6144 + 2048, (float*)(p.ws + WS_PART)};
              pg8::gemm_phase<OutEpi8, pg8::StaticOrder, true, true>((PG8_LAS unsigned char*)smem_all, g8, S8, E8, wave8 * 64 + lane_id()); }
        }
        GSYNC();
        phase_ffn_norm_router(fresh(kp), layer, smem, bid, nb, tid);
        GSYNC();
        { const Params& p = fresh(kp); unsigned char* wsu = uniform_ptr(p.ws);
          int* mtab = (int*)(smem_all + 2 * MEGA_LDS + 64);
          __syncthreads();
          if (wave8 == 0 && lane_id() == 0) {
              const int* ecnt = (const int*)(wsu + WS_ECNT) + layer * 32 * ECS; int ua = 0, ra = 0;
              for (int e = 0; e < 32; ++e) { const int cn = ecnt[e * ECS]; mtab[e] = ua; mtab[40 + e] = cn; mtab[80 + e] = ra; ua += (cn + 255) >> 8; ra += cn; }
              mtab[32] = ua;
          }
          __syncthreads();
          MoeOrder8 S8{mtab, (const int*)(wsu + WS_ELIST), (int)gridDim.x, (int)blockIdx.x, mtab[32] * 4, 1};
          pg8::Gemm g8{(const pg8::bf16_t*)(wsu + WS_H), (const pg8::bf16_t*)(wsu + WS_WM1) + (size_t)layer * 32 * 1024 * 1024, 0, 0, 1024};
          Moe1Epi8 E8{mtab, (bf16_t*)(wsu + WS_H1)};
          pg8::gemm_phase<Moe1Epi8, MoeOrder8, true, true>((PG8_LAS unsigned char*)smem_all, g8, S8, E8, wave8 * 64 + lane_id()); }
        GSYNC();
        { const Params& p = fresh(kp); unsigned char* wsu = uniform_ptr(p.ws);
          int* mtab = (int*)(smem_all + 2 * MEGA_LDS + 64);
          MoeOrder8 S8{mtab, (const int*)(wsu + WS_ELIST), (int)gridDim.x, (int)blockIdx.x, mtab[32] * 4, 2};
          pg8::Gemm g8{(const pg8::bf16_t*)(wsu + WS_H1), (const pg8::bf16_t*)(wsu + WS_WM2) + (size_t)layer * 32 * 1024 * 512, 0, 0, 512};
          Moe2Epi8 E8{mtab, (const int*)(wsu + WS_ELIST), (bf16_t*)(wsu + WS_Y)};
          pg8::gemm_phase<Moe2Epi8, MoeOrder8, true, true>((PG8_LAS unsigned char*)smem_all, g8, S8, E8, wave8 * 64 + lane_id()); }
        GSYNC();
        phase_combine_norm(fresh(kp), layer, bid, nb, tid);
        if (layer + 1 < DEPTH) GSYNC();
    }
}
#undef tid
#undef tid0
#undef bid
#undef gx
#undef glb
#undef GSYNC

extern "C" void kernel_launch(void* const* d_in, const int* in_sizes, int n_in, void* d_out, int out_size, void* d_ws, size_t ws_size, hipStream_t stream) {
    Params p{};
    const float** f = (const float**)&p;
    for (int i = 0; i < 22; ++i) f[i] = (const float*)d_in[i];
    p.out = (float*)d_out;
    p.ws = (unsigned char*)d_ws;
    if (ws_size < WS_END) { fprintf(stderr, "workspace too small: %zu < %zu\n", ws_size, (size_t)WS_END); return; }
    static int grid_blocks = 0;
    if (!grid_blocks) {
        int dev = 0, cus = 0, per_cu = 0;
        hipGetDevice(&dev);
        hipDeviceGetAttribute(&cus, hipDeviceAttributeMultiprocessorCount, dev);
        hipOccupancyMaxActiveBlocksPerMultiprocessor(&per_cu, hybrid_fwd_megakernel, 512, 0);
        if (per_cu > 1) per_cu = 1;
        grid_blocks = cus * per_cu;
    }
    (void)hipMemsetAsync((unsigned char*)d_ws + WS_BAR, 0, XCD_BAR_WORDS_C * 4, stream);
    void* args[] = {&p};
    hipError_t e = hipLaunchCooperativeKernel((void*)hybrid_fwd_megakernel, dim3(grid_blocks), dim3(512), args, 0, stream);
    if (e != hipSuccess) fprintf(stderr, "cooperative launch failed: %s (grid %d)\n", hipGetErrorString(e), grid_blocks);
}
```

```cpp
#include <hip/hip_runtime.h>
#include <hip/hip_cooperative_groups.h>
#include <stdint.h>
#include <cstdio>

#define DI __device__ __forceinline__
typedef unsigned short bf16_t;
typedef short bf16x8 __attribute__((ext_vector_type(8)));
typedef float f32x16 __attribute__((ext_vector_type(16)));
typedef float f32x4 __attribute__((ext_vector_type(4)));
typedef float f32x2 __attribute__((ext_vector_type(2)));
typedef unsigned u32x4 __attribute__((ext_vector_type(4)));
typedef unsigned u32x2 __attribute__((ext_vector_type(2)));
typedef __bf16 bf16x2_t __attribute__((ext_vector_type(2)));

constexpr int D = 1024, NB = 8, S = 2048, T = NB * S, DEPTH = 4;
constexpr int HYB_IN = 2760, ML_IN = 3088;
constexpr int NEXP = 32, DEXP = 512, NASG = T * 2;
constexpr float EPS = 1e-6f;
constexpr int XCD_BAR_WORDS_C = 3456;

constexpr size_t al256(size_t x) { return (x + 255) & ~(size_t)255; }
constexpr size_t WS_MOD = 0;
constexpr size_t WS_ROPEC = WS_MOD + al256((size_t)4 * 8 * 6144 * 4);
constexpr size_t WS_ROPES = WS_ROPEC + al256((size_t)2048 * 32 * 4);
constexpr size_t WS_ECNT = WS_ROPES + al256((size_t)2048 * 32 * 4);
constexpr int ECS = 64;
constexpr size_t WS_H = WS_ECNT + al256(4 * 32 * ECS * 4);
constexpr size_t WS_YMIX = WS_H + al256((size_t)T * 1024 * 2);
constexpr size_t WS_Q = WS_YMIX + al256((size_t)T * 1024 * 2);
constexpr size_t WS_K = WS_Q + al256((size_t)T * 512 * 2);
constexpr size_t WS_V = WS_K + al256((size_t)T * 64 * 2);
constexpr size_t WS_IQ = WS_V + al256((size_t)T * 64 * 2);
constexpr size_t WS_IK = WS_IQ + al256((size_t)T * 512 * 2);
constexpr size_t WS_IW = WS_IK + al256((size_t)T * 64 * 2);
constexpr size_t WS_BG = WS_IW + al256((size_t)T * 8 * 4);
constexpr size_t WS_Z = WS_BG + al256((size_t)T * 512 * 2);
constexpr size_t WS_MASK = WS_Z + al256((size_t)T * 512 * 2);
constexpr size_t WS_MQ = WS_MASK + al256((size_t)T * 64 * 4);
constexpr size_t WS_MK = WS_MQ + al256((size_t)T * 512 * 2);
constexpr size_t WS_MV = WS_MK + al256((size_t)T * 512 * 2);
constexpr size_t WS_MIG = WS_MV + al256((size_t)T * 1024 * 2);
constexpr size_t WS_MFG = WS_MIG + al256((size_t)T * 8 * 4);
constexpr size_t WS_MOG = WS_MFG + al256((size_t)T * 8 * 4);
constexpr size_t WS_EW = WS_MOG + al256((size_t)T * 1024 * 2);
constexpr size_t WS_ELIST = WS_EW + al256((size_t)NASG * 4);
constexpr size_t WS_H1 = WS_ELIST + al256((size_t)NEXP * NASG * 4);
constexpr size_t WS_Y = WS_H1 + al256((size_t)NASG * 512 * 2);
constexpr size_t WS_MKT = WS_Y + al256((size_t)NASG * 1024 * 2);
constexpr size_t WS_UBUF = WS_MKT + al256((size_t)64 * 64 * S * 2);
constexpr size_t WS_UNBUF = WS_UBUF + al256((size_t)64 * 32 * 8192 * 4);
constexpr size_t WS_MLOC = WS_UNBUF + al256((size_t)64 * 32 * 64 * 4);
constexpr size_t WS_CBUF = WS_MLOC + al256((size_t)64 * 32 * 2 * 4);
constexpr size_t WS_NBUF = WS_CBUF + al256((size_t)64 * 32 * 8192 * 2);
constexpr size_t WS_MST = WS_NBUF + al256((size_t)64 * 32 * 64 * 4);
constexpr size_t WS_PART = WS_MST + al256((size_t)64 * 32 * 4);
constexpr size_t WS_WHYB = WS_PART + al256((size_t)T * 16 * 4);
constexpr size_t WS_WML = WS_WHYB + al256((size_t)2 * 2816 * 1024 * 2);
constexpr size_t WS_WOUT = WS_WML + al256((size_t)2 * 3200 * 1024 * 2);
constexpr size_t WS_WM1 = WS_WOUT + al256((size_t)4 * 1024 * 1024 * 2);
constexpr size_t WS_WM2 = WS_WM1 + al256((size_t)4 * 32 * 1024 * 1024 * 2);
constexpr size_t WS_BAR = WS_WM2 + al256((size_t)4 * 32 * 1024 * 512 * 2);
constexpr size_t WS_END = WS_BAR + al256((size_t)XCD_BAR_WORDS_C * 4);

struct Params {
    const float *x, *c, *ada_w, *ada_b, *norm_mix, *norm_ffn, *hy_w_in, *hy_q_norm, *hy_k_norm, *hy_conv_w, *hy_w_out;
    const float *ml_w_in, *ml_b_gates, *ml_out_norm, *ml_w_out, *moe_w_group, *moe_b_group, *moe_w_expert, *moe_b_expert;
    const float *moe_w_gate, *moe_w_up, *moe_w_down;
    float* out;
    unsigned char* ws;
    unsigned long long use_cg_sync;
};

DI unsigned pk2(float lo, float hi) { f32x2 v = {lo, hi}; bf16x2_t b = __builtin_convertvector(v, bf16x2_t); return __builtin_bit_cast(unsigned, b); }
DI bf16_t f2bf(float x) { return (bf16_t)(pk2(x, 0.f) & 0xffffu); }
DI float bf2f(bf16_t h) { return __uint_as_float(((unsigned)h) << 16); }
DI float bflo(unsigned u) { return __uint_as_float(u << 16); }
DI float bfhi(unsigned u) { return __uint_as_float(u & 0xffff0000u); }
DI int lane_id() { int x; asm volatile("v_mbcnt_lo_u32_b32 %0, -1, 0\n\tv_mbcnt_hi_u32_b32 %0, -1, %0" : "=v"(x)); return x; }
template <int M> DI int sx_i(int v) {
    if constexpr (M < 32) return __builtin_amdgcn_ds_swizzle(v, (M << 10) | 0x1f);
    else return __builtin_amdgcn_ds_bpermute((lane_id() ^ 32) << 2, v);
}
template <int M> DI float sx_f(float v) { return __int_as_float(sx_i<M>(__float_as_int(v))); }
DI float lane_get_f(float v, int src) { return __int_as_float(__builtin_amdgcn_ds_bpermute(src << 2, __float_as_int(v))); }
DI float wave_sum(float v) { v += sx_f<32>(v); v += sx_f<16>(v); v += sx_f<8>(v); v += sx_f<4>(v); v += sx_f<2>(v); v += sx_f<1>(v); return v; }
DI float wave_max(float v) { v = fmaxf(v, sx_f<32>(v)); v = fmaxf(v, sx_f<16>(v)); v = fmaxf(v, sx_f<8>(v)); v = fmaxf(v, sx_f<4>(v)); v = fmaxf(v, sx_f<2>(v)); v = fmaxf(v, sx_f<1>(v)); return v; }
DI float half_sum(float v) { v += sx_f<16>(v); v += sx_f<8>(v); v += sx_f<4>(v); v += sx_f<2>(v); v += sx_f<1>(v); return v; }
DI float sigmoidf_(float x) { return 1.f / (1.f + __expf(-x)); }
DI unsigned char* uniform_ptr(unsigned char* q) {
    const unsigned long long w = (unsigned long long)q;
    const unsigned lo = __builtin_amdgcn_readfirstlane((unsigned)w), hi = __builtin_amdgcn_readfirstlane((unsigned)(w >> 32));
    return (unsigned char*)(((unsigned long long)hi << 32) | lo);
}
DI int opqs(int x) { asm volatile("" : "+s"(x)); return x; }
DI int opq(int x) { asm volatile("" : "+v"(x)); return x; }

DI int swz(int row, int slot) { return row * 128 + ((slot ^ ((row >> 1) & 7)) << 4); }
DI int crow(int reg, int lane) { return (reg & 3) + 8 * (reg >> 2) + 4 * (lane >> 5); }

template <class P>
DI void gemm_tile(const P& pr, unsigned char* smem, int tid) {
    const int lane = tid & 63, wid = tid >> 6, wr = wid >> 1, wc = wid & 1;
    const bf16_t* abase = pr.a_base();
    const bf16_t* bbase = pr.b_base();
    const int kdim = pr.kt() * 64;
    int gao[4], gbo[4];
#pragma unroll
    for (int i = 0; i < 4; ++i) {
        const int row = (tid >> 3) + 32 * i, sl = (tid & 7) ^ ((row >> 1) & 7);
        const int o = pr.a_off(row);
        gao[i] = (o >= 0 ? o : 0) + sl * 8; gbo[i] = row * kdim + sl * 8;
    }
#define GLDS(buf, kt) do { _Pragma("unroll") for (int i = 0; i < 4; ++i) { \
        __builtin_amdgcn_global_load_lds((const unsigned*)(abase + gao[i] + (kt) * 64), (__attribute__((address_space(3))) unsigned*)(smem + (buf) * 32768 + (i * 256 + wid * 64) * 16), 16, 0, 0); \
        __builtin_amdgcn_global_load_lds((const unsigned*)(bbase + gbo[i] + (kt) * 64), (__attribute__((address_space(3))) unsigned*)(smem + (buf) * 32768 + 16384 + (i * 256 + wid * 64) * 16), 16, 0, 0); } } while (0)
#define DMA_WAIT_SYNC() do { asm volatile("s_waitcnt vmcnt(0)" ::: "memory"); __syncthreads(); } while (0)
#define COMPUTE(buf) do { const unsigned char* As = smem + (buf) * 32768; const unsigned char* Bs = As + 16384; \
        _Pragma("unroll") for (int ks = 0; ks < 4; ++ks) { const int slot = ks * 2 + (lane >> 5); \
            const bf16x8 a0 = *(const bf16x8*)(As + swz(wr * 64 + (lane & 31), slot)); const bf16x8 a1 = *(const bf16x8*)(As + swz(wr * 64 + 32 + (lane & 31), slot)); \
            const bf16x8 b0 = *(const bf16x8*)(Bs + swz(wc * 64 + (lane & 31), slot)); const bf16x8 b1 = *(const bf16x8*)(Bs + swz(wc * 64 + 32 + (lane & 31), slot)); \
            acc[0][0] = __builtin_amdgcn_mfma_f32_32x32x16_bf16(a0, b0, acc[0][0], 0, 0, 0); acc[0][1] = __builtin_amdgcn_mfma_f32_32x32x16_bf16(a0, b1, acc[0][1], 0, 0, 0); \
            acc[1][0] = __builtin_amdgcn_mfma_f32_32x32x16_bf16(a1, b0, acc[1][0], 0, 0, 0); acc[1][1] = __builtin_amdgcn_mfma_f32_32x32x16_bf16(a1, b1, acc[1][1], 0, 0, 0); } } while (0)
    f32x16 acc[2][2];
#pragma unroll
    for (int a = 0; a < 2; ++a)
#pragma unroll
        for (int b = 0; b < 2; ++b)
#pragma unroll
            for (int r = 0; r < 16; ++r) acc[a][b][r] = 0.f;
    const int KT = pr.kt();
    __syncthreads();
    GLDS(0, 0);
    DMA_WAIT_SYNC();
    for (int kt = 0; kt < KT; kt += 2) {
        GLDS(1, kt + 1);
        COMPUTE(0);
        DMA_WAIT_SYNC();
        if (kt + 2 < KT) GLDS(0, kt + 2);
        COMPUTE(1);
        DMA_WAIT_SYNC();
    }
#undef GLDS
#undef DMA_WAIT_SYNC
#undef COMPUTE
    pr.epi(acc, wr, wc, lane, smem + wid * 8192);
}

template <class P>
DI void convert_tile(const P& pr, bf16_t* dst, int kdim, int kt, unsigned char* smem, int tid) {
    unsigned char* Bs = smem;
    const int ng = tid & 31, kg = tid >> 5;
    int width = 0;
    const float* bp = pr.b_col(ng >> 3, width);
    const int cig = (ng & 7) * 4;
    const bool bvalid = cig < width;
    const int ldb = pr.ldb();
    bp += cig + (size_t)(kt * 64 + kg * 8) * ldb;
    f32x4 rb[8];
#pragma unroll
    for (int kk = 0; kk < 8; ++kk) rb[kk] = bvalid ? *(const f32x4*)(bp + (size_t)kk * ldb) : (f32x4){0.f, 0.f, 0.f, 0.f};
    __syncthreads();
#pragma unroll
    for (int j = 0; j < 4; ++j) {
        u32x4 v = {pk2(rb[0][j], rb[1][j]), pk2(rb[2][j], rb[3][j]), pk2(rb[4][j], rb[5][j]), pk2(rb[6][j], rb[7][j])};
        *(u32x4*)(Bs + swz(ng * 4 + j, kg)) = v;
    }
    __syncthreads();
#pragma unroll
    for (int i = 0; i < 4; ++i) {
        const int n = (tid >> 3) + 32 * i;
        *(u32x4*)(dst + (size_t)n * kdim + kt * 64 + (tid & 7) * 8) = *(const u32x4*)(Bs + swz(n, tid & 7));
    }
}

template <int NC> DI void stage_put(unsigned char* wl, int mi, int ni, int r, int lane, float v) { *(bf16_t*)(wl + ((mi * 32 + crow(r, lane)) * NC + ni * 32 + (lane & 31)) * 2) = f2bf(v); }
template <int NC, class RowPtr> DI void stage_flush(unsigned char* wl, int lane, RowPtr rp) {
    constexpr int CH = NC / 8, RPI = 64 / CH, NIT = 64 / RPI;
#pragma unroll
    for (int i = 0; i < NIT; ++i) {
        const int row = lane / CH + RPI * i, ch = lane % CH;
        const u32x4 d = *(const u32x4*)(wl + (row * NC + ch * 8) * 2);
        bf16_t* dst = rp(row);
        if (dst) *(u32x4*)(dst + ch * 8) = d;
    }
}

struct HybIn {
    const Params* p; int j, tm, tn;
    DI int kt() const { return 16; }
    DI int ldb() const { return HYB_IN; }
    DI const bf16_t* a_base() const { return (const bf16_t*)(p->ws + WS_H); }
    DI int a_off(int r) const { return (tm * 128 + r) * 1024; }
    DI static void pair_cols(int pr, int ni, int& base, int& width) {
        width = 32;
        if (pr < 8) base = 64 * pr + 32 * ni;
        else if (pr == 8) base = 512 + 32 * ni;
        else if (pr == 9) base = 576 + 32 * ni;
        else if (pr < 18) base = 640 + 64 * (pr - 10) + 32 * ni;
        else if (pr == 18) base = 1152 + 32 * ni;
        else if (pr == 19) { base = 1216; width = ni == 0 ? 8 : 0; }
        else if (pr < 28) base = 1224 + 64 * (pr - 20) + 32 * ni;
        else base = (ni == 0 ? 1736 : 2248) + 32 * (pr - 28);
    }
    DI const float* b_col(int g, int& width) const { int base; pair_cols(tn * 2 + (g >> 1), g & 1, base, width); return p->hy_w_in + (size_t)j * 1024 * HYB_IN + base; }
    DI const bf16_t* b_base() const { return (const bf16_t*)(p->ws + WS_WHYB) + (size_t)(j * 22 + tn) * 128 * 1024; }
    DI void epi(f32x16 (&acc)[2][2], int wr, int wc, int lane, unsigned char* wl) const {
        const int pr = tn * 2 + wc, c = lane & 31;
        const int t0 = tm * 128 + wr * 64;
        unsigned char* ws = p->ws;
        const float* ropec = (const float*)(ws + WS_ROPEC);
        const float* ropes = (const float*)(ws + WS_ROPES);
        if (pr < 9 || (pr >= 10 && pr < 19)) {
            const bool donorm = pr < 9;
            const float* gam = pr < 8 ? p->hy_q_norm + j * 64 : p->hy_k_norm + j * 64;
            bf16_t* ob; int ld, cb;
            if (pr < 8) { ob = (bf16_t*)(ws + WS_Q); ld = 512; cb = 64 * pr; }
            else if (pr == 8) { ob = (bf16_t*)(ws + WS_K); ld = 64; cb = 0; }
            else if (pr < 18) { ob = (bf16_t*)(ws + WS_IQ); ld = 512; cb = 64 * (pr - 10); }
            else { ob = (bf16_t*)(ws + WS_IK); ld = 64; cb = 0; }
            float g1 = 1.f, g2 = 1.f;
            if (donorm) { g1 = gam[c]; g2 = gam[c + 32]; }
#pragma unroll
            for (int mi = 0; mi < 2; ++mi)
#pragma unroll
                for (int r = 0; r < 16; ++r) {
                    float x1 = acc[mi][0][r], x2 = acc[mi][1][r];
                    const int t = t0 + mi * 32 + crow(r, lane), pos = t & (S - 1);
                    if (donorm) { float ss = half_sum(x1 * x1 + x2 * x2); float rstd = rsqrtf(ss * (1.f / 64.f) + EPS); x1 *= rstd * g1; x2 *= rstd * g2; }
                    const float cs = ropec[pos * 32 + c], sn = ropes[pos * 32 + c];
                    stage_put<64>(wl, mi, 0, r, lane, x1 * cs - x2 * sn);
                    stage_put<64>(wl, mi, 1, r, lane, x2 * cs + x1 * sn);
                }
            stage_flush<64>(wl, lane, [&](int row) { return ob + (size_t)(t0 + row) * ld + cb; });
        } else if (pr == 9) {
            bf16_t* ob = (bf16_t*)(ws + WS_V);
#pragma unroll
            for (int mi = 0; mi < 2; ++mi)
#pragma unroll
                for (int ni = 0; ni < 2; ++ni)
#pragma unroll
                    for (int g4 = 0; g4 < 4; ++g4) {
                        const int t = t0 + mi * 32 + 8 * g4 + 4 * (lane >> 5), pos = t & (S - 1), bb = t >> 11;
                        u32x2 o = {pk2(acc[mi][ni][4 * g4], acc[mi][ni][4 * g4 + 1]), pk2(acc[mi][ni][4 * g4 + 2], acc[mi][ni][4 * g4 + 3])};
                        *(u32x2*)(ob + ((size_t)(bb * 64 + ni * 32 + c)) * S + pos) = o;
                    }
        } else if (pr == 19) {
            float* ob = (float*)(ws + WS_IW);
            if (c < 8) {
#pragma unroll
                for (int mi = 0; mi < 2; ++mi)
#pragma unroll
                    for (int r = 0; r < 16; ++r) { const int t = t0 + mi * 32 + crow(r, lane); ob[(size_t)t * 8 + c] = acc[mi][0][r] * (0.125f * 0.35355339059327373f); }
            }
        } else if (pr < 28) {
            bf16_t* ob = (bf16_t*)(ws + WS_BG); const int cb = 64 * (pr - 20);
#pragma unroll
            for (int mi = 0; mi < 2; ++mi)
#pragma unroll
                for (int r = 0; r < 16; ++r) { stage_put<64>(wl, mi, 0, r, lane, acc[mi][0][r]); stage_put<64>(wl, mi, 1, r, lane, acc[mi][1][r]); }
            stage_flush<64>(wl, lane, [&](int row) { return ob + (size_t)(t0 + row) * 512 + cb; });
        } else {
            bf16_t* ob = (bf16_t*)(ws + WS_Z); const int cb = 32 * (pr - 28);
#pragma unroll
            for (int mi = 0; mi < 2; ++mi)
#pragma unroll
                for (int r = 0; r < 16; ++r) stage_put<32>(wl, mi, 0, r, lane, acc[mi][0][r] * acc[mi][1][r]);
            stage_flush<32>(wl, lane, [&](int row) { return ob + (size_t)(t0 + row) * 512 + cb; });
        }
    }
};


struct HybCols8 {
    const Params* p; int j, tm, tn;
    DI int ldb() const { return HYB_IN; }
    DI const float* b_col(int g, int& width) const {
        const int u = tn >> 1, bj = tn & 1; int base; width = 32;
        if (u < 2) base = 64 * (4 * u + g) + 32 * bj;
        else if (u < 4) base = 640 + 64 * (4 * (u - 2) + g) + 32 * bj;
        else if (u == 4) { if (g == 0) base = 512 + 32 * bj; else if (g == 1) base = 576 + 32 * bj; else if (g == 2) base = 1152 + 32 * bj; else { base = 1216; width = bj == 0 ? 8 : 0; } }
        else if (u < 7) base = 1224 + (u - 5) * 256 + 128 * bj + 32 * g;
        else base = (bj == 0 ? 1736 : 2248) + (u - 7) * 128 + 32 * g;
        return p->hy_w_in + (size_t)j * 1024 * HYB_IN + base;
    }
};

struct MlIn {
    const Params* p; int j, tm, tn;
    DI int kt() const { return 16; }
    DI int ldb() const { return ML_IN; }
    DI const bf16_t* a_base() const { return (const bf16_t*)(p->ws + WS_H); }
    DI int a_off(int r) const { return (tm * 128 + r) * 1024; }
    DI const float* b_col(int g, int& width) const {
        const int pr = tn * 2 + (g >> 1), ni = g & 1; int base; width = 32;
        if (pr < 32) base = 64 * pr + 32 * ni;
        else if (pr == 32) { base = 2048 + 8 * ni; width = 8; }
        else if (pr < 49) base = 2064 + 64 * (pr - 33) + 32 * ni;
        else { base = 0; width = 0; }
        return p->ml_w_in + (size_t)j * 1024 * ML_IN + base;
    }
    DI const bf16_t* b_base() const { return (const bf16_t*)(p->ws + WS_WML) + (size_t)(j * 25 + tn) * 128 * 1024; }
    DI void epi(f32x16 (&acc)[2][2], int wr, int wc, int lane, unsigned char* wl) const {
        const int pr = tn * 2 + wc, c = lane & 31;
        const int t0 = tm * 128 + wr * 64;
        unsigned char* ws = p->ws;
        if (pr < 16) {
            bf16_t* ob; int cb; float sc = 1.f;
            if (pr < 8) { ob = (bf16_t*)(ws + WS_MQ); cb = 64 * pr; sc = 0.125f; }
            else { ob = (bf16_t*)(ws + WS_MK); cb = 64 * (pr - 8); }
#pragma unroll
            for (int mi = 0; mi < 2; ++mi)
#pragma unroll
                for (int r = 0; r < 16; ++r) { stage_put<64>(wl, mi, 0, r, lane, acc[mi][0][r] * sc); stage_put<64>(wl, mi, 1, r, lane, acc[mi][1][r] * sc); }
            stage_flush<64>(wl, lane, [&](int row) { return ob + (size_t)(t0 + row) * 512 + cb; });
        }
        if (pr >= 8 && pr < 32) {
            bf16_t* ob; int nrow, hd, r0;
            if (pr < 16) { ob = (bf16_t*)(ws + WS_MKT); nrow = 64; hd = pr - 8; r0 = 0; }
            else { ob = (bf16_t*)(ws + WS_MV); nrow = 128; hd = (pr - 16) >> 1; r0 = 64 * ((pr - 16) & 1); }
#pragma unroll
            for (int mi = 0; mi < 2; ++mi)
#pragma unroll
                for (int ni = 0; ni < 2; ++ni)
#pragma unroll
                    for (int g4 = 0; g4 < 4; ++g4) {
                        const int t = t0 + mi * 32 + 8 * g4 + 4 * (lane >> 5), pos = t & (S - 1), bb = t >> 11;
                        u32x2 o = {pk2(acc[mi][ni][4 * g4], acc[mi][ni][4 * g4 + 1]), pk2(acc[mi][ni][4 * g4 + 2], acc[mi][ni][4 * g4 + 3])};
                        *(u32x2*)(ob + ((size_t)((bb * 8 + hd) * nrow + r0 + ni * 32 + c)) * S + pos) = o;
                    }
        } else if (pr == 32) {
            if (c < 8) {
                float* oi = (float*)(ws + WS_MIG); float* of = (float*)(ws + WS_MFG);
                const float bi = p->ml_b_gates[j * 16 + c], bfg = p->ml_b_gates[j * 16 + 8 + c];
#pragma unroll
                for (int mi = 0; mi < 2; ++mi)
#pragma unroll
                    for (int r = 0; r < 16; ++r) {
                        const int t = t0 + mi * 32 + crow(r, lane);
                        oi[(size_t)t * 8 + c] = acc[mi][0][r] + bi;
                        const float f = acc[mi][1][r] + bfg;
                        of[(size_t)t * 8 + c] = fminf(f, 0.f) - log1pf(__expf(-fabsf(f)));
                    }
            }
        } else if (pr >= 33 && pr < 49) {
            bf16_t* ob = (bf16_t*)(ws + WS_MOG); const int cb = 64 * (pr - 33);
#pragma unroll
            for (int mi = 0; mi < 2; ++mi)
#pragma unroll
                for (int r = 0; r < 16; ++r) { stage_put<64>(wl, mi, 0, r, lane, sigmoidf_(acc[mi][0][r])); stage_put<64>(wl, mi, 1, r, lane, sigmoidf_(acc[mi][1][r])); }
            stage_flush<64>(wl, lane, [&](int row) { return ob + (size_t)(t0 + row) * 1024 + cb; });
        }
    }
};


struct MlCols8 {
    const Params* p; int j, tm, tn;
    DI int ldb() const { return ML_IN; }
    DI const float* b_col(int g, int& width) const {
        const int u = tn >> 1, bj = tn & 1; int base; width = 32;
        if (tn == 24) { base = 2048 + 8 * (g & 1); width = g < 2 ? 8 : 0; }
        else if (u < 2) base = 64 * (4 * u + g) + 32 * bj;
        else if (u < 4) base = 512 + 64 * (4 * (u - 2) + g) + 32 * bj;
        else if (u < 8) base = 1024 + (2 * (u - 4) + bj) * 128 + 32 * g;
        else base = 2064 + (u - 8) * 256 + 128 * bj + 32 * g;
        return p->ml_w_in + (size_t)j * 1024 * ML_IN + base;
    }
};
struct MlGates {
    const Params* p; int j, tm;
    DI int kt() const { return 16; }
    DI const bf16_t* a_base() const { return (const bf16_t*)(p->ws + WS_H); }
    DI int a_off(int r) const { return (tm * 128 + r) * 1024; }
    DI const bf16_t* b_base() const { return (const bf16_t*)(p->ws + WS_WML) + (size_t)(j * 25 + 24) * 128 * 1024; }
    DI void epi(f32x16 (&acc)[2][2], int wr, int wc, int lane, unsigned char* wl) const {
        const int c = lane & 31, t0 = tm * 128 + wr * 64;
        if (wc == 0 && c < 8) {
            float* oi = (float*)(p->ws + WS_MIG); float* of = (float*)(p->ws + WS_MFG);
            const float bi = p->ml_b_gates[j * 16 + c], bfg = p->ml_b_gates[j * 16 + 8 + c];
#pragma unroll
            for (int mi = 0; mi < 2; ++mi)
#pragma unroll
                for (int r = 0; r < 16; ++r) {
                    const int t = t0 + mi * 32 + crow(r, lane);
                    oi[(size_t)t * 8 + c] = acc[mi][0][r] + bi;
                    const float f = acc[mi][1][r] + bfg;
                    of[(size_t)t * 8 + c] = fminf(f, 0.f) - log1pf(__expf(-fabsf(f)));
                }
        }
    }
};

struct OutProj {
    const Params* p; const float* W; const float* src; int layer, tm, tn;
    DI int kt() const { return 16; }
    DI int ldb() const { return 1024; }
    DI const bf16_t* a_base() const { return (const bf16_t*)(p->ws + WS_YMIX); }
    DI int a_off(int r) const { return (tm * 128 + r) * 1024; }
    DI const float* b_col(int g, int& width) const { width = 32; return W + tn * 128 + g * 32; }
    DI const bf16_t* b_base() const { return (const bf16_t*)(p->ws + WS_WOUT) + (size_t)(layer * 8 + tn) * 128 * 1024; }
    DI void epi(f32x16 (&acc)[2][2], int wr, int wc, int lane, unsigned char* wl) const {
        const int c = lane & 31, t0 = tm * 128 + wr * 64, wid = wr * 2 + wc;
        float* fl = (float*)(wl + wid * 8192);
#pragma unroll
        for (int mi = 0; mi < 2; ++mi)
#pragma unroll
            for (int ni = 0; ni < 2; ++ni)
#pragma unroll
                for (int r = 0; r < 16; ++r) fl[(mi * 32 + crow(r, lane)) * 64 + ni * 32 + c] = acc[mi][ni][r];
        const float* mod = (const float*)(p->ws + WS_MOD) + (size_t)layer * 8 * 6144;
        const int ch = lane & 15, n = tn * 128 + wc * 64 + ch * 4;
        const f32x4 g = *(const f32x4*)(mod + (t0 >> 11) * 6144 + 2048 + n);
        float* part = (float*)(p->ws + WS_PART);
#pragma unroll 4
        for (int i = 0; i < 16; ++i) {
            const int row = (lane >> 4) + 4 * i, t = t0 + row;
            const f32x4 a = *(const f32x4*)(fl + row * 64 + ch * 4);
            const f32x4 o = *(const f32x4*)(src + (size_t)t * 1024 + n) + g * a;
            *(f32x4*)(p->out + (size_t)t * 1024 + n) = o;
            float ss = o[0] * o[0] + o[1] * o[1] + o[2] * o[2] + o[3] * o[3];
            ss += sx_f<1>(ss); ss += sx_f<2>(ss); ss += sx_f<4>(ss); ss += sx_f<8>(ss);
            if (ch == 0) part[(size_t)t * 16 + tn * 2 + wc] = ss;
        }
    }
};

struct Moe1 {
    const Params* p; int layer, e, mt, nt, cnt, roff;
    DI int kt() const { return 16; }
    DI int ldb() const { return DEXP; }
    DI const bf16_t* a_base() const { return (const bf16_t*)(p->ws + WS_H); }
    DI int a_off(int r) const {
        const int rr = mt * 128 + r; if (rr >= cnt) return -1;
        const int a = ((const int*)(p->ws + WS_ELIST))[(size_t)e * NASG + rr];
        return (a >> 1) * 1024;
    }
    DI const float* b_col(int g, int& width) const {
        width = 32;
        const float* base = (nt & 1) ? p->moe_w_up : p->moe_w_gate;
        return base + ((size_t)layer * NEXP + e) * (size_t)(D * DEXP) + 128 * (nt >> 1) + 32 * g;
    }
    DI const bf16_t* b_base() const { return (const bf16_t*)(p->ws + WS_WM1) + (size_t)((layer * NEXP + e) * 8 + nt) * 128 * 1024; }
    DI void epi(f32x16 (&acc)[2][2], int wr, int wc, int lane, unsigned char* wl) const {
        const int c = lane & 31, pr = nt * 2 + wc;
        bf16_t* ob = (bf16_t*)(p->ws + WS_H1);
#pragma unroll
        for (int mi = 0; mi < 2; ++mi)
#pragma unroll
            for (int r = 0; r < 16; ++r) {
                const float g = acc[mi][0][r], u = acc[mi][1][r];
                stage_put<32>(wl, mi, 0, r, lane, g / (1.f + __expf(-g)) * u);
            }
        const int rb = mt * 128 + wr * 64;
        stage_flush<32>(wl, lane, [&](int row) { return rb + row < cnt ? ob + (size_t)(roff + rb + row) * 512 + 32 * pr : (bf16_t*)nullptr; });
    }
};

struct Moe2 {
    const Params* p; int layer, e, mt, nt, cnt, roff;
    DI int kt() const { return 8; }
    DI int ldb() const { return D; }
    DI const bf16_t* a_base() const { return (const bf16_t*)(p->ws + WS_H1); }
    DI int a_off(int r) const { const int rr = mt * 128 + r; if (rr >= cnt) return -1; return (roff + rr) * 512; }
    DI const float* b_col(int g, int& width) const { width = 32; return p->moe_w_down + ((size_t)layer * NEXP + e) * (size_t)(DEXP * D) + nt * 128 + g * 32; }
    DI const bf16_t* b_base() const { return (const bf16_t*)(p->ws + WS_WM2) + (size_t)((layer * NEXP + e) * 8 + nt) * 128 * 512; }
    DI void epi(f32x16 (&acc)[2][2], int wr, int wc, int lane, unsigned char* wl) const {
        const int c = lane & 31;
        bf16_t* ob = (bf16_t*)(p->ws + WS_Y);
        const int* el = (const int*)(p->ws + WS_ELIST) + (size_t)e * NASG;
#pragma unroll
        for (int mi = 0; mi < 2; ++mi)
#pragma unroll
            for (int r = 0; r < 16; ++r) { stage_put<64>(wl, mi, 0, r, lane, acc[mi][0][r]); stage_put<64>(wl, mi, 1, r, lane, acc[mi][1][r]); }
        const int rb = mt * 128 + wr * 64;
        stage_flush<64>(wl, lane, [&](int row) { return rb + row < cnt ? ob + (size_t)el[rb + row] * 1024 + nt * 128 + wc * 64 : (bf16_t*)nullptr; });
    }
};

DI void convert_moe_layers(const Params& p, int l0, int l1, unsigned char* smem, int bid, int nb, int tid) {
    const int PER = 32 * 8 * 16 + 32 * 8 * 8, total = (l1 - l0) * PER;
    for (int item = bid; item < total; item += nb) {
        const int l = l0 + item / PER; int ci = item % PER;
        if (ci < 4096) { const int kt = ci & 15, nt = (ci >> 4) & 7, e = ci >> 7; Moe1 pr{&p, l, e, 0, nt, 0, 0}; convert_tile(pr, (bf16_t*)(p.ws + WS_WM1) + (size_t)((l * 32 + e) * 8 + nt) * 128 * 1024, 1024, kt, smem, tid); }
        else { ci -= 4096; const int kt = ci & 7, nt = (ci >> 3) & 7, e = ci >> 6; Moe2 pr{&p, l, e, 0, nt, 0, 0}; convert_tile(pr, (bf16_t*)(p.ws + WS_WM2) + (size_t)((l * 32 + e) * 8 + nt) * 128 * 512, 512, kt, smem, tid); }
    }
    __syncthreads();
}

DI void phase_init(const Params& p, unsigned char* smem, int bid, int nb, int tid) {
    float* sc = (float*)smem;
    float* red = (float*)(smem + 32768);
    const int NMOD = DEPTH * 96, NROPE = 256;
    const int C_HYB = 2 * 22 * 16, C_ML = 2 * 25 * 16, C_OUT = 4 * 8 * 16;
    for (int ci = bid; ci < C_HYB + C_ML + C_OUT; ci += nb) {
        int c2 = ci;
        if (c2 < C_HYB) { const int kt = c2 & 15, tn = (c2 >> 4) % 22, j = (c2 >> 4) / 22; HybCols8 pr{&p, j, 0, tn}; convert_tile(pr, (bf16_t*)(p.ws + WS_WHYB) + (size_t)(j * 22 + tn) * 128 * 1024, 1024, kt, smem, tid); continue; }
        c2 -= C_HYB;
        if (c2 < C_ML) { const int kt = c2 & 15, tn = (c2 >> 4) % 25, j = (c2 >> 4) / 25; MlCols8 pr{&p, j, 0, tn}; convert_tile(pr, (bf16_t*)(p.ws + WS_WML) + (size_t)(j * 25 + tn) * 128 * 1024, 1024, kt, smem, tid); continue; }
        c2 -= C_ML;
        { const int kt = c2 & 15, tn = (c2 >> 4) & 7, l = c2 >> 7; const float* W = ((l & 1) ? p.ml_w_out : p.hy_w_out) + (size_t)(l >> 1) * 1024 * 1024;
            OutProj pr{&p, W, nullptr, l, 0, tn}; convert_tile(pr, (bf16_t*)(p.ws + WS_WOUT) + (size_t)(l * 8 + tn) * 128 * 1024, 1024, kt, smem, tid); }
    }
    for (int item = bid; item < NMOD; item += nb) {
        __syncthreads();
        for (int i = tid; i < 8 * 1024; i += 256) { const float v = p.c[i]; sc[i] = v / (1.f + __expf(-v)); }
        __syncthreads();
        const int l = item / 96, jb = item % 96, cq = tid & 15, ksl = tid >> 4;
        const float* w = p.ada_w + (size_t)l * 1024 * 6144 + jb * 64 + cq * 4;
        f32x4 acc[8];
#pragma unroll
        for (int b = 0; b < 8; ++b) acc[b] = (f32x4){0.f, 0.f, 0.f, 0.f};
        for (int ii = 0; ii < 64; ++ii) {
            const int i = ksl * 64 + ii;
            const f32x4 wv = *(const f32x4*)(w + (size_t)i * 6144);
#pragma unroll
            for (int b = 0; b < 8; ++b) acc[b] += wv * sc[b * 1024 + i];
        }
#pragma unroll
        for (int b = 0; b < 8; ++b) *(f32x4*)(red + (ksl * 8 + b) * 64 + cq * 4) = acc[b];
        __syncthreads();
        for (int o = tid; o < 512; o += 256) {
            const int b = o >> 6, cc = o & 63; float s = 0.f;
            for (int k = 0; k < 16; ++k) s += red[(k * 8 + b) * 64 + cc];
            ((float*)(p.ws + WS_MOD))[((size_t)l * 8 + b) * 6144 + jb * 64 + cc] = s + p.ada_b[l * 6144 + jb * 64 + cc];
        }
    }
    for (int item = bid; item < NROPE + 1; item += nb) {
        if (item < NROPE) {
            const int idx = item * 256 + tid;
            const int pos = idx >> 5, i = idx & 31;
            const float inv = 1.0f / powf(10000.0f, (float)(2 * i) / 64.0f);
            const float ang = (float)pos * inv;
            ((float*)(p.ws + WS_ROPEC))[idx] = cosf(ang);
            ((float*)(p.ws + WS_ROPES))[idx] = sinf(ang);
        } else {
            if (tid < DEPTH * 32) ((int*)(p.ws + WS_ECNT))[tid * ECS] = 0;
        }
    }
    __syncthreads();
    convert_moe_layers(p, 0, 1, smem, bid, nb, tid);
}

DI void phase_norm(const Params& p, int layer, const float* src, int bid, int nb, int tid) {
    const int lane = tid & 63, wid = tid >> 6;
    const float* mod = (const float*)(p.ws + WS_MOD) + (size_t)layer * 8 * 6144;
    const float* gam = p.norm_mix + layer * 1024;
    bf16_t* H = (bf16_t*)(p.ws + WS_H);
    for (int item = bid; item < T / 4; item += nb) {
        const int t = item * 4 + wid, b = t >> 11;
        const float* xr = src + (size_t)t * 1024;
        f32x4 v[4]; float ss = 0.f;
#pragma unroll
        for (int i = 0; i < 4; ++i) { v[i] = *(const f32x4*)(xr + (lane + 64 * i) * 4); ss += v[i][0] * v[i][0] + v[i][1] * v[i][1] + v[i][2] * v[i][2] + v[i][3] * v[i][3]; }
        ss = wave_sum(ss);
        const float rstd = rsqrtf(ss * (1.f / 1024.f) + EPS);
#pragma unroll
        for (int i = 0; i < 4; ++i) {
            const int c0 = (lane + 64 * i) * 4;
            const f32x4 g = *(const f32x4*)(gam + c0), sh = *(const f32x4*)(mod + b * 6144 + c0), sc = *(const f32x4*)(mod + b * 6144 + 1024 + c0);
            f32x4 h = v[i] * rstd * g * (sc + 1.f) + sh;
            u32x2 o = {pk2(h[0], h[1]), pk2(h[2], h[3])};
            *(u32x2*)(H + (size_t)t * 1024 + c0) = o;
        }
    }
}

DI void phase_ffn_norm_router(const Params& p, int layer, unsigned char* smem, int bid, int nb, int tid) {
    float* rstd_s = (float*)smem;
    float* lg = (float*)(smem + 512);
    float* hs = (float*)(smem + 512 + 32 * 37 * 4);
    float* wcs = (float*)(smem + 5248 + 2 * 32 * 65 * 4);
    const int lane = tid & 63, og = __builtin_amdgcn_readfirstlane(tid >> 6), tok = lane & 31, kh = lane >> 5;
    const float* mod = (const float*)(p.ws + WS_MOD) + (size_t)layer * 8 * 6144;
    const float* gam = p.norm_ffn + layer * 1024;
    const float* wg = p.moe_w_group + (size_t)layer * 1024 * 4;
    const float* we = p.moe_w_expert + (size_t)layer * 1024 * 32;
    bf16_t* H = (bf16_t*)(p.ws + WS_H);
    int* ecnt = (int*)(p.ws + WS_ECNT) + layer * 32 * ECS;
    int* elist = (int*)(p.ws + WS_ELIST);
    float* ew = (float*)(p.ws + WS_EW);
    for (int item = bid; item < T / 32; item += nb) {
        const int t0 = item * 32, b = t0 >> 11;
        __syncthreads();
        if (tid < 32) {
            const f32x4* pp = (const f32x4*)((const float*)(p.ws + WS_PART) + (size_t)(t0 + tid) * 16);
            const f32x4 a = pp[0], b4 = pp[1], c4 = pp[2], d4 = pp[3];
            const float ss = ((a[0] + a[1]) + (a[2] + a[3])) + ((b4[0] + b4[1]) + (b4[2] + b4[3])) + ((c4[0] + c4[1]) + (c4[2] + c4[3])) + ((d4[0] + d4[1]) + (d4[2] + d4[3]));
            rstd_s[tid] = rsqrtf(ss * (1.f / 1024.f) + EPS);
        }
        const int stok = tid >> 3, sk0 = (tid & 7) * 8;
        const float* xrow = p.out + (size_t)(t0 + stok) * 1024 + sk0;
        const float* mrow = mod + b * 6144 + sk0;
        f32x4 xa[2], ga[2], sha[2], sca[2], wa[3], xb[2], gb2[2], shb[2], scb[2], wb2[3];
#define FFN_LOAD(xv, gv, shv, scv, wv, k0) do { _Pragma("unroll") for (int q = 0; q < 2; ++q) { xv[q] = *(const f32x4*)(xrow + (k0) + 4 * q); gv[q] = *(const f32x4*)(gam + sk0 + (k0) + 4 * q); \
            shv[q] = *(const f32x4*)(mrow + 3072 + (k0) + 4 * q); scv[q] = *(const f32x4*)(mrow + 4096 + (k0) + 4 * q); } \
            wv[0] = *(const f32x4*)(we + (k0) * 32 + tid * 4); wv[1] = *(const f32x4*)(we + (k0) * 32 + 1024 + tid * 4); wv[2] = *(const f32x4*)(wg + (k0) * 4 + (tid & 63) * 4); } while (0)
#define FFN_STEP(xv, gv, shv, scv, wv, kc) do { const int k0 = (kc) * 64; float* hb = hs + ((kc) & 1) * (32 * 65); float* wb = wcs + ((kc) & 1) * (64 * 40); u32x4 ho; \
            _Pragma("unroll") for (int q = 0; q < 2; ++q) { const f32x4 h = xv[q] * srstd * gv[q] * (scv[q] + 1.f) + shv[q]; ho[2 * q] = pk2(h[0], h[1]); ho[2 * q + 1] = pk2(h[2], h[3]); \
                float* hp = hb + stok * 65 + sk0 + 4 * q; hp[0] = h[0]; hp[1] = h[1]; hp[2] = h[2]; hp[3] = h[3]; } \
            *(u32x4*)(H + (size_t)(t0 + stok) * 1024 + k0 + sk0) = ho; \
            *(f32x4*)(wb + (tid >> 3) * 40 + 4 + (tid & 7) * 4) = wv[0]; *(f32x4*)(wb + (32 + (tid >> 3)) * 40 + 4 + (tid & 7) * 4) = wv[1]; if (tid < 64) *(f32x4*)(wb + tid * 40) = wv[2]; \
            if ((kc) + 2 < 16) FFN_LOAD(xv, gv, shv, scv, wv, k0 + 128); \
            __syncthreads(); \
            if (og < 3) { const float* hr = hb + tok * 65 + kh * 32; const float* wr_ = wb + kh * 32 * 40 + og * 12; \
                _Pragma("unroll 8") for (int kk = 0; kk < 32; ++kk) { const float hv = hr[kk]; \
                    acc[0] += *(const f32x4*)(wr_ + kk * 40) * hv; acc[1] += *(const f32x4*)(wr_ + kk * 40 + 4) * hv; acc[2] += *(const f32x4*)(wr_ + kk * 40 + 8) * hv; } } } while (0)
        FFN_LOAD(xa, ga, sha, sca, wa, 0);
        FFN_LOAD(xb, gb2, shb, scb, wb2, 64);
        __syncthreads();
        const float srstd = rstd_s[stok];
        f32x4 acc[3];
#pragma unroll
        for (int o = 0; o < 3; ++o) acc[o] = (f32x4){0.f, 0.f, 0.f, 0.f};
        for (int kc = 0; kc < 16; kc += 2) {
            FFN_STEP(xa, ga, sha, sca, wa, kc);
            FFN_STEP(xb, gb2, shb, scb, wb2, kc + 1);
        }
#undef FFN_STEP
#undef FFN_LOAD
        if (og < 3) {
#pragma unroll
            for (int o = 0; o < 3; ++o)
#pragma unroll
                for (int e = 0; e < 4; ++e) { const float v = acc[o][e] + sx_f<32>(acc[o][e]); if (kh == 0) lg[tok * 37 + og * 12 + 4 * o + e] = v; }
        }
        __syncthreads();
        if (tid < 32) {
            const int t = t0 + tid;
            float gl[4]; float gmax = -INFINITY; int gsel = 0;
#pragma unroll
            for (int g = 0; g < 4; ++g) { gl[g] = lg[tid * 37 + g] + p.moe_b_group[layer * 4 + g]; if (gl[g] > gmax) { gmax = gl[g]; gsel = g; } }
            float gsum = 0.f;
#pragma unroll
            for (int g = 0; g < 4; ++g) gsum += __expf(gl[g] - gmax);
            const float pg = 1.f / gsum;
            float v1 = -INFINITY, v2 = -INFINITY; int i1 = 0, i2 = 0;
            for (int jx = 0; jx < 8; ++jx) {
                const float v = lg[tid * 37 + 4 + gsel * 8 + jx] + p.moe_b_expert[layer * 32 + gsel * 8 + jx];
                if (v > v1) { v2 = v1; i2 = i1; v1 = v; i1 = jx; } else if (v > v2) { v2 = v; i2 = jx; }
            }
            const float e2 = __expf(v2 - v1), den = 1.f / (1.f + e2);
            const float w1 = pg * den, w2 = pg * e2 * den;
            const int ea = gsel * 8 + i1, eb = gsel * 8 + i2;
            int* cl = (int*)rstd_s + 32;
            cl[tid] = 0;
            const int la = atomicAdd(&cl[ea], 1);
            const int lb = atomicAdd(&cl[eb], 1);
            { const int n = cl[tid]; cl[32 + tid] = n > 0 ? atomicAdd(&ecnt[tid * ECS], n) : 0; }
            const int ra = cl[32 + ea] + la, rb = cl[32 + eb] + lb;
            elist[(size_t)ea * NASG + ra] = t * 2; ew[t * 2] = w1;
            elist[(size_t)eb * NASG + rb] = t * 2 + 1; ew[t * 2 + 1] = w2;
        }
    }
}

DI bool dense_item(int i, int NT, int xcd, int& tm, int& tn) {
    if (i >= 16 * NT) return false;
    const int mg = i / (8 * NT), r = i % (8 * NT);
    tn = r >> 3; tm = xcd * 16 + mg * 8 + (r & 7);
    return true;
}
template <class PR> DI void phase_hyb_in(const Params& p, int j, unsigned char* smem, int xcd, int lb, int nlb, int tid) {
    int tm, tn;
    for (int i = lb; dense_item(i, 22, xcd, tm, tn); i += nlb) { HybIn pr{&p, j, tm, tn}; gemm_tile(pr, smem, opq(tid)); }
}
DI void phase_ml_in(const Params& p, int j, unsigned char* smem, int xcd, int lb, int nlb, int tid) {
    int tm, tn;
    for (int i = lb; dense_item(i, 25, xcd, tm, tn); i += nlb) { MlIn pr{&p, j, tm, tn}; gemm_tile(pr, smem, opq(tid)); }
}
DI void phase_out_proj(const Params& p, int layer, const float* W, const float* src, unsigned char* smem, int xcd, int lb, int nlb, int tid) {
    int tm, tn;
    for (int i = lb; dense_item(i, 8, xcd, tm, tn); i += nlb) { OutProj pr{&p, W, src, layer, tm, tn}; gemm_tile(pr, smem, opq(tid)); }
}
template <int WHICH> DI void phase_moe(const Params& p, int layer, unsigned char* smem, int xcd, int lb, int nlb, int tid) {
    int* toff = (int*)(smem + 65600);
    __syncthreads();
    if (tid == 0) {
        const int* ecnt = (const int*)(p.ws + WS_ECNT) + layer * 32 * ECS;
        int ta = 0, ra = 0;
        for (int e = 0; e < 32; ++e) {
            const int c = ecnt[e * ECS];
            if ((e & 7) == xcd) { const int q = e >> 3; toff[q] = ta; toff[8 + q] = ra; toff[16 + q] = c; ta += (c + 127) >> 7; }
            ra += c;
        }
        toff[4] = ta;
    }
    __syncthreads();
    const int total = toff[4] * 8;
    for (int item = lb; item < total; item += nlb) {
        const int mg = item >> 3, nt = item & 7;
        int q = 0;
        while (q < 3 && toff[q + 1] <= mg) ++q;
        const int e = q * 8 + xcd, cnt = toff[16 + q], roff = toff[8 + q];
        if (WHICH == 1) { Moe1 pr{&p, layer, e, mg - toff[q], nt, cnt, roff}; gemm_tile(pr, smem, opq(tid)); }
        else { Moe2 pr{&p, layer, e, mg - toff[q], nt, cnt, roff}; gemm_tile(pr, smem, opq(tid)); }
    }
}

DI void phase_combine_norm(const Params& p, int layer, int bid, int nb, int tid) {
    const int lane = tid & 63, wid = tid >> 6;
    const float* mod = (const float*)(p.ws + WS_MOD) + (size_t)layer * 8 * 6144;
    const float* modn = mod + 8 * 6144;
    const float* gam = p.norm_mix + (layer + 1) * 1024;
    const bf16_t* Y = (const bf16_t*)(p.ws + WS_Y);
    const float* ew = (const float*)(p.ws + WS_EW);
    bf16_t* H = (bf16_t*)(p.ws + WS_H);
    const bool has_next = layer + 1 < DEPTH;
    for (int item = bid; item < T / 4; item += nb) {
        const int t = item * 4 + wid, b = t >> 11;
        const float w0 = ew[2 * t], w1 = ew[2 * t + 1];
        f32x4 v[4]; float ss = 0.f;
#pragma unroll
        for (int i = 0; i < 4; ++i) {
            const int c0 = (lane + 64 * i) * 4;
            v[i] = *(const f32x4*)(p.out + (size_t)t * 1024 + c0);
            const f32x4 g = *(const f32x4*)(mod + b * 6144 + 5120 + c0);
            const u32x2 y0 = *(const u32x2*)(Y + (size_t)(2 * t) * 1024 + c0), y1 = *(const u32x2*)(Y + (size_t)(2 * t + 1) * 1024 + c0);
            v[i][0] += g[0] * (w0 * bflo(y0[0]) + w1 * bflo(y1[0])); v[i][1] += g[1] * (w0 * bfhi(y0[0]) + w1 * bfhi(y1[0]));
            v[i][2] += g[2] * (w0 * bflo(y0[1]) + w1 * bflo(y1[1])); v[i][3] += g[3] * (w0 * bfhi(y0[1]) + w1 * bfhi(y1[1]));
            *(f32x4*)(p.out + (size_t)t * 1024 + c0) = v[i];
            ss += v[i][0] * v[i][0] + v[i][1] * v[i][1] + v[i][2] * v[i][2] + v[i][3] * v[i][3];
        }
        if (has_next) {
            ss = wave_sum(ss);
            const float rstd = rsqrtf(ss * (1.f / 1024.f) + EPS);
#pragma unroll
            for (int i = 0; i < 4; ++i) {
                const int c0 = (lane + 64 * i) * 4;
                const f32x4 g = *(const f32x4*)(gam + c0), sh = *(const f32x4*)(modn + b * 6144 + c0), sc = *(const f32x4*)(modn + b * 6144 + 1024 + c0);
                const f32x4 h = v[i] * rstd * g * (sc + 1.f) + sh;
                u32x2 o = {pk2(h[0], h[1]), pk2(h[2], h[3])};
                *(u32x2*)(H + (size_t)t * 1024 + c0) = o;
            }
        }
    }
}

DI unsigned sortable(float f) { const unsigned u = __float_as_uint(f); return (u & 0x80000000u) ? ~u : (u | 0x80000000u); }
DI int half_sum_i(int v) { v += sx_i<16>(v); v += sx_i<8>(v); v += sx_i<4>(v); v += sx_i<2>(v); v += sx_i<1>(v); return v; }

struct CvTask { const float* src; bf16_t* dst; int ldb, kdim; };
DI CvTask cv_task(const Params& p, int l0, int id) {
    const int PER = 32 * 8 * 16 * 4 + 32 * 8 * 8 * 4;
    const int l = l0 + id / PER; int ci = id % PER; CvTask t;
    if (ci < 16384) {
        const int g = ci & 3, kt = (ci >> 2) & 15, nt = (ci >> 6) & 7, e = ci >> 9; int w;
        Moe1 pr{&p, l, e, 0, nt, 0, 0};
        t.ldb = DEXP; t.kdim = 1024; t.src = pr.b_col(g, w) + (size_t)(kt * 64) * DEXP;
        t.dst = (bf16_t*)(p.ws + WS_WM1) + ((size_t)((l * 32 + e) * 8 + nt) * 128 + g * 32) * 1024 + kt * 64;
    } else {
        ci -= 16384;
        const int g = ci & 3, kt = (ci >> 2) & 7, nt = (ci >> 5) & 7, e = ci >> 8; int w;
        Moe2 pr{&p, l, e, 0, nt, 0, 0};
        t.ldb = D; t.kdim = 512; t.src = pr.b_col(g, w) + (size_t)(kt * 64) * D;
        t.dst = (bf16_t*)(p.ws + WS_WM2) + ((size_t)((l * 32 + e) * 8 + nt) * 128 + g * 32) * 512 + kt * 64;
    }
    return t;
}
DI void cv_issue(const CvTask& t, int lane, f32x4 (&rb)[8]) {
    const float* s = t.src + (size_t)((lane >> 3) * 8) * t.ldb + (lane & 7) * 4;
#pragma unroll
    for (int kk = 0; kk < 8; ++kk) rb[kk] = *(const f32x4*)(s + (size_t)kk * t.ldb);
}
DI void cv_finish(const CvTask& t, int lane, const f32x4 (&rb)[8]) {
    bf16_t* d = t.dst + (size_t)((lane & 7) * 4) * t.kdim + (lane >> 3) * 8;
#pragma unroll
    for (int jx = 0; jx < 4; ++jx) {
        u32x4 v = {pk2(rb[0][jx], rb[1][jx]), pk2(rb[2][jx], rb[3][jx]), pk2(rb[4][jx], rb[5][jx]), pk2(rb[6][jx], rb[7][jx])};
        *(u32x4*)(d + (size_t)jx * t.kdim) = v;
    }
}
DI void convert_moe_waves(const Params& p, int l0, int l1, int gwave, int nwaves, int lane) {
    const int total = (l1 - l0) * 24576;
    for (int id = gwave; id < total; id += 2 * nwaves) {
        f32x4 ra[8], rb[8];
        const CvTask t0 = cv_task(p, l0, id);
        cv_issue(t0, lane, ra);
        const bool two = id + nwaves < total;
        if (two) { const CvTask t1 = cv_task(p, l0, id + nwaves); cv_issue(t1, lane, rb); cv_finish(t0, lane, ra); cv_finish(t1, lane, rb); }
        else cv_finish(t0, lane, ra);
    }
}

DI void phase_dsa(const Params& p, int j, unsigned char* smem, int bid, int nb, int tid, int cv0 = 0, int cv1 = 0) {
    if (cv1 > cv0 && (bid & 1)) convert_moe_waves(p, cv0, cv1, bid * 4 + (tid >> 6), nb * 4, tid & 63);
    const int lane = tid & 63, wid = tid >> 6, c = lane & 31, hh = lane >> 5;
    unsigned* mw = (unsigned*)smem + wid * 256;
    const bf16_t* IQ = (const bf16_t*)(p.ws + WS_IQ);
    const bf16_t* IK = (const bf16_t*)(p.ws + WS_IK);
    const float* IW = (const float*)(p.ws + WS_IW);
    const bf16_t* Q = (const bf16_t*)(p.ws + WS_Q);
    const bf16_t* K = (const bf16_t*)(p.ws + WS_K);
    const bf16_t* VT = (const bf16_t*)(p.ws + WS_V);
    bf16_t* Y = (bf16_t*)(p.ws + WS_YMIX);
    const float gq = wave_max(fabsf(p.hy_q_norm[j * 64 + lane])), gk = wave_max(fabsf(p.hy_k_norm[j * 64 + lane]));
    const float LOG2E = 1.4426950408889634f;
    const float c1 = 0.125f * LOG2E, c2 = 8.f * gq * gk * LOG2E;
    const unsigned lt = (1u << c) - 1u;
    for (int it = bid, rnd = 0; it < 1024; it += nb, ++rnd) {
        const int item = (rnd & 1) ? (rnd + 1) * nb - 1 - bid : it;
        if (item >= 1024) continue;
        const int qt = 127 - (item >> 3), b = item & 7;
        const int pos0 = qt * 16 + 4 * wid;
        const size_t tb = (size_t)b * S, t0 = tb + pos0;
        const int tmax = (pos0 + 3) >> 5;
        if (pos0 >= 256) {
            bf16x8 iqf[4];
            {
                const int i = (c & 3) + 4 * (c >> 3), rh = (c >> 2) & 1, qq = 2 * rh + (i >> 3), hd = i & 7;
                const bf16_t* ip = IQ + (t0 + qq) * 512 + hd * 64 + 8 * hh;
#pragma unroll
                for (int ks = 0; ks < 4; ++ks) iqf[ks] = *(const bf16x8*)(ip + 16 * ks);
            }
            float* wl = (float*)(smem + 4096) + wid * 32 + hh * 16;
            if (c < 4) *(f32x4*)(wl + 4 * c) = *(const f32x4*)(IW + (t0 + 2 * hh) * 8 + 4 * c);
            unsigned sk[64][2];
            const bf16_t* kpi = IK + ((tb >> 5) * 256 + hh * 32 + c) * 8;
            const int lim0 = pos0 + 2 * hh - c;
#pragma unroll
            for (int tile = 0; tile < 64; ++tile) {
                unsigned k0 = 0u, k1 = 0u;
                if (tile <= tmax) {
                    bf16x8 bk[4];
#pragma unroll
                    for (int ks = 0; ks < 4; ++ks) bk[ks] = *(const bf16x8*)(kpi + 512 * ks);
                    kpi += 32 * 64;
                    asm volatile("" : "+v"(kpi));
                    f32x16 acc;
#pragma unroll
                    for (int r = 0; r < 16; ++r) acc[r] = 0.f;
#pragma unroll
                    for (int ks = 0; ks < 4; ++ks) acc = __builtin_amdgcn_mfma_f32_32x32x16_bf16(iqf[ks], bk[ks], acc, 0, 0, 0);
                    float s0 = 0.f, s1 = 0.f;
#pragma unroll
                    for (int q4 = 0; q4 < 2; ++q4) {
                        const f32x4 wa = *(const f32x4*)(wl + 4 * q4), wb = *(const f32x4*)(wl + 8 + 4 * q4);
#pragma unroll
                        for (int e = 0; e < 4; ++e) { s0 += fmaxf(acc[4 * q4 + e], 0.f) * wa[e]; s1 += fmaxf(acc[8 + 4 * q4 + e], 0.f) * wb[e]; }
                    }
                    k0 = tile * 32 <= lim0 ? sortable(s0) : 0u;
                    k1 = tile * 32 <= lim0 + 1 ? sortable(s1) : 0u;
                }
                sk[tile][0] = k0; sk[tile][1] = k1;
            }
            unsigned v0 = 0u, v1 = 0u; bool d0 = false, d1 = false;
            const int tg = tmax >> 3;
            for (int bit = 31; bit >= 0; --bit) {
                const unsigned c0 = v0 | (1u << bit), c1b = v1 | (1u << bit);
                int n0 = 0, n1 = 0;
#pragma unroll
                for (int g = 0; g < 8; ++g) {
                    if (g <= tg) {
#pragma unroll
                        for (int u = 0; u < 8; ++u) { n0 += sk[g * 8 + u][0] >= c0 ? 1 : 0; n1 += sk[g * 8 + u][1] >= c1b ? 1 : 0; }
                    }
                }
                const int n01 = half_sum_i(n0 | (n1 << 16));
                n0 = n01 & 0xffff; n1 = n01 >> 16;
                if (!d0 && n0 >= 256) { v0 = c0; d0 = n0 == 256; }
                if (!d1 && n1 >= 256) { v1 = c1b; d1 = n1 == 256; }
                if (__all(d0 && d1)) break;
            }
            int g0 = 0, g1 = 0;
#pragma unroll
            for (int g = 0; g < 8; ++g) {
                if (g <= tg) {
#pragma unroll
                    for (int u = 0; u < 8; ++u) { g0 += sk[g * 8 + u][0] > v0 ? 1 : 0; g1 += sk[g * 8 + u][1] > v1 ? 1 : 0; }
                }
            }
            const int g01 = half_sum_i(g0 | (g1 << 16));
            const int need0 = 256 - (g01 & 0xffff), need1 = 256 - (g01 >> 16);
            int run0 = 0, run1 = 0;
#pragma unroll
            for (int tile = 0; tile < 64; ++tile) {
                if (tile <= tmax) {
                    const unsigned k0 = sk[tile][0], k1 = sk[tile][1];
                    const bool tie0 = k0 == v0, tie1 = k1 == v1;
                    const unsigned long long tb0 = __ballot(tie0), tb1 = __ballot(tie1);
                    const unsigned th0 = hh ? (unsigned)(tb0 >> 32) : (unsigned)tb0, th1 = hh ? (unsigned)(tb1 >> 32) : (unsigned)tb1;
                    const bool sel0 = k0 > v0 || (tie0 && run0 + __popc(th0 & lt) < need0);
                    const bool sel1 = k1 > v1 || (tie1 && run1 + __popc(th1 & lt) < need1);
                    run0 += __popc(th0); run1 += __popc(th1);
                    const unsigned long long sb0 = __ballot(sel0), sb1 = __ballot(sel1);
                    if (lane == 0) { u32x4 o = {(unsigned)sb0, (unsigned)sb1, (unsigned)(sb0 >> 32), (unsigned)(sb1 >> 32)}; *(u32x4*)(mw + tile * 4) = o; }
                }
            }
        } else {
            const int tile = lane >> 2, qq = lane & 3, pq = pos0 + qq;
            if (tile <= tmax) {
                unsigned m;
                if (32 * tile + 31 <= pq) m = 0xffffffffu; else if (32 * tile > pq) m = 0u; else m = (2u << (pq - 32 * tile)) - 1u;
                mw[tile * 4 + qq] = m;
            }
        }
        bf16x8 qf[4];
        {
            const bf16_t* qp = Q + (t0 + (c >> 3)) * 512 + (c & 7) * 64 + 8 * hh;
#pragma unroll
            for (int ks = 0; ks < 4; ++ks) qf[ks] = *(const bf16x8*)(qp + 16 * ks);
        }
        f32x16 o0, o1;
#pragma unroll
        for (int r = 0; r < 16; ++r) { o0[r] = 0.f; o1[r] = 0.f; }
        float lsum = 0.f;
        const bf16_t* kp = K + ((tb >> 5) * 256 + hh * 32 + c) * 8;
        const bf16_t* vp = VT + ((tb >> 5) * 256 + hh * 32 + c) * 8;
        bf16x8 kf[4], vf[4];
#pragma unroll
        for (int ks = 0; ks < 4; ++ks) { kf[ks] = *(const bf16x8*)(kp + 512 * ks); vf[ks] = *(const bf16x8*)(vp + 512 * ks); }
        for (int tile = 0; tile <= tmax; ++tile) {
            const unsigned mword = mw[tile * 4 + (c >> 3)];
            bf16x8 kc[4], vc[4];
#pragma unroll
            for (int ks = 0; ks < 4; ++ks) { kc[ks] = kf[ks]; vc[ks] = vf[ks]; }
            if (tile < tmax) {
                kp += 2048; vp += 2048;
#pragma unroll
                for (int ks = 0; ks < 4; ++ks) { kf[ks] = *(const bf16x8*)(kp + 512 * ks); vf[ks] = *(const bf16x8*)(vp + 512 * ks); }
            }
            f32x16 x;
#pragma unroll
            for (int r = 0; r < 16; ++r) x[r] = 0.f;
#pragma unroll
            for (int ks = 0; ks < 4; ++ks) x = __builtin_amdgcn_mfma_f32_32x32x16_bf16(kc[ks], qf[ks], x, 0, 0, 0);
#pragma unroll
            for (int s = 0; s < 2; ++s) {
                const unsigned bits = mword >> (16 * s + 8 * hh);
                float pr[8];
#pragma unroll
                for (int jx = 0; jx < 8; ++jx) {
                    const float e = __builtin_amdgcn_exp2f(x[8 * s + jx] * c1 - c2);
                    pr[jx] = __uint_as_float(__float_as_uint(e) & (unsigned)__builtin_amdgcn_sbfe((int)bits, jx, 1));
                    lsum += pr[jx];
                }
                u32x4 pk = {pk2(pr[0], pr[1]), pk2(pr[2], pr[3]), pk2(pr[4], pr[5]), pk2(pr[6], pr[7])};
                const bf16x8 pf = __builtin_bit_cast(bf16x8, pk);
                o0 = __builtin_amdgcn_mfma_f32_32x32x16_bf16(vc[2 * s], pf, o0, 0, 0, 0);
                o1 = __builtin_amdgcn_mfma_f32_32x32x16_bf16(vc[2 * s + 1], pf, o1, 0, 0, 0);
            }
        }
        lsum += sx_f<32>(lsum);
        const float inv = 1.f / lsum;
        bf16_t* yp = Y + (t0 + (c >> 3)) * 1024 + (c & 7) * 64 + 4 * hh;
#pragma unroll
        for (int g4 = 0; g4 < 4; ++g4) {
            u32x2 a = {pk2(o0[4 * g4] * inv, o0[4 * g4 + 1] * inv), pk2(o0[4 * g4 + 2] * inv, o0[4 * g4 + 3] * inv)};
            u32x2 bq = {pk2(o1[4 * g4] * inv, o1[4 * g4 + 1] * inv), pk2(o1[4 * g4 + 2] * inv, o1[4 * g4 + 3] * inv)};
            *(u32x2*)(yp + 8 * g4) = a;
            *(u32x2*)(yp + 32 + 8 * g4) = bq;
        }
    }
    if (cv1 > cv0 && !(bid & 1)) convert_moe_waves(p, cv0, cv1, bid * 4 + (tid >> 6), nb * 4, tid & 63);
}

DI void phase_conv(const Params& p, int j, int bid, int nb, int tid) {
    const bf16_t* Z = (const bf16_t*)(p.ws + WS_Z);
    const bf16_t* BG = (const bf16_t*)(p.ws + WS_BG);
    bf16_t* Y = (bf16_t*)(p.ws + WS_YMIX);
    const float* cw = p.hy_conv_w + (size_t)j * 3 * 512;
    for (int item = bid; item < T / 4; item += nb) {
        const int t = item * 4 + (tid >> 6), c0 = (tid & 63) * 8, pos = t & (S - 1);
        float acc[8];
#pragma unroll
        for (int e = 0; e < 8; ++e) acc[e] = 0.f;
#pragma unroll
        for (int jj = 0; jj < 3; ++jj) {
            const int dp = jj - 2;
            if (pos + dp >= 0) {
                const u32x4 z = *(const u32x4*)(Z + (size_t)(t + dp) * 512 + c0);
#pragma unroll
                for (int e = 0; e < 4; ++e) { acc[2 * e] += cw[jj * 512 + c0 + 2 * e] * bflo(z[e]); acc[2 * e + 1] += cw[jj * 512 + c0 + 2 * e + 1] * bfhi(z[e]); }
            }
        }
        const u32x4 g = *(const u32x4*)(BG + (size_t)t * 512 + c0);
        u32x4 o;
#pragma unroll
        for (int e = 0; e < 4; ++e) o[e] = pk2(acc[2 * e] * bflo(g[e]), acc[2 * e + 1] * bfhi(g[e]));
        *(u32x4*)(Y + (size_t)t * 1024 + 512 + c0) = o;
    }
}

DI float wave_incl_sum(float x, int lane) { for (int d = 1; d < 64; d <<= 1) { const float t = lane_get_f(x, lane >= d ? lane - d : lane); if (lane >= d) x += t; } return x; }
DI float wave_incl_max(float x, int lane) { for (int d = 1; d < 64; d <<= 1) { const float t = lane_get_f(x, lane >= d ? lane - d : lane); if (lane >= d) x = fmaxf(x, t); } return x; }
DI bf16x8 scale_frag(bf16x8 f, const float* w8) {
    const u32x4 u = __builtin_bit_cast(u32x4, f);
    u32x4 o;
#pragma unroll
    for (int e = 0; e < 4; ++e) o[e] = pk2(bflo(u[e]) * w8[2 * e], bfhi(u[e]) * w8[2 * e + 1]);
    return __builtin_bit_cast(bf16x8, o);
}

DI void phase_ml1(const Params& p, unsigned char* smem, int bid, int nb, int tid) {
    const int lane = tid & 63, wid = tid >> 6, c = lane & 31, hh = lane >> 5;
    float* wsl = (float*)smem + wid * 64;
    const bf16_t* KT = (const bf16_t*)(p.ws + WS_MKT);
    const bf16_t* VT = (const bf16_t*)(p.ws + WS_MV);
    const float* MIG = (const float*)(p.ws + WS_MIG);
    const float* MFG = (const float*)(p.ws + WS_MFG);
    float* UB = (float*)(p.ws + WS_UBUF);
    float* UN = (float*)(p.ws + WS_UNBUF);
    float* ML = (float*)(p.ws + WS_MLOC);
    for (int item = bid; item < 2048; item += nb) {
        const int bh = item >> 5, ch = item & 31, b = bh >> 3, h = bh & 7;
        const size_t tb = (size_t)b * S + ch * 64;
        const float lf = MFG[(tb + lane) * 8 + h], ig = MIG[(tb + lane) * 8 + h];
        const float bc = wave_incl_sum(lf, lane);
        const float blast = lane_get_f(bc, 63);
        const float g = blast - bc + ig;
        const float gmax = wave_max(g);
        wsl[lane] = __expf(g - gmax);
        if (wid == 0 && lane == 0) { ML[item * 2] = blast; ML[item * 2 + 1] = gmax; }
        f32x16 u0, u1;
#pragma unroll
        for (int r = 0; r < 16; ++r) { u0[r] = 0.f; u1[r] = 0.f; }
        const bf16_t* vp = VT + ((size_t)(bh * 128 + wid * 32 + c)) * S + ch * 64 + 8 * hh;
        const bf16_t* kp = KT + ((size_t)(bh * 64 + c)) * S + ch * 64 + 8 * hh;
#pragma unroll
        for (int ks = 0; ks < 4; ++ks) {
            float w8[8];
            const f32x4 wa = *(const f32x4*)(wsl + 16 * ks + 8 * hh), wb = *(const f32x4*)(wsl + 16 * ks + 8 * hh + 4);
            w8[0] = wa[0]; w8[1] = wa[1]; w8[2] = wa[2]; w8[3] = wa[3]; w8[4] = wb[0]; w8[5] = wb[1]; w8[6] = wb[2]; w8[7] = wb[3];
            const bf16x8 va = *(const bf16x8*)(vp + 16 * ks);
            const bf16x8 k0 = scale_frag(*(const bf16x8*)(kp + 16 * ks), w8);
            const bf16x8 k1 = scale_frag(*(const bf16x8*)(kp + (size_t)32 * S + 16 * ks), w8);
            u0 = __builtin_amdgcn_mfma_f32_32x32x16_bf16(va, k0, u0, 0, 0, 0);
            u1 = __builtin_amdgcn_mfma_f32_32x32x16_bf16(va, k1, u1, 0, 0, 0);
        }
        float* up = UB + ((size_t)item * 128 + wid * 32) * 64 + c;
#pragma unroll
        for (int r = 0; r < 16; ++r) { const int v = crow(r, lane); up[v * 64] = u0[r]; up[v * 64 + 32] = u1[r]; }
        if (wid == 0) {
            const u32x4* kr = (const u32x4*)(KT + ((size_t)(bh * 64 + lane)) * S + ch * 64);
            float a = 0.f;
#pragma unroll
            for (int q = 0; q < 8; ++q) { const u32x4 u = kr[q];
#pragma unroll
                for (int e = 0; e < 4; ++e) a += wsl[q * 8 + 2 * e] * bflo(u[e]) + wsl[q * 8 + 2 * e + 1] * bfhi(u[e]); }
            UN[(size_t)item * 64 + lane] = a;
        }
    }
}

DI void phase_ml2(const Params& p, unsigned char* smem, int bid, int nb, int tid) {
    float* dec = (float*)smem;
    float* scl = dec + 32;
    const float* UB = (const float*)(p.ws + WS_UBUF);
    const float* UN = (const float*)(p.ws + WS_UNBUF);
    const float* ML = (const float*)(p.ws + WS_MLOC);
    bf16_t* CB = (bf16_t*)(p.ws + WS_CBUF);
    float* NBF = (float*)(p.ws + WS_NBUF);
    float* MST = (float*)(p.ws + WS_MST);
    for (int item = bid; item < 512; item += nb) {
        const int bh = item >> 3, sl = item & 7;
        __syncthreads();
        if (tid == 0) {
            float m = 0.f;
            for (int ch = 0; ch < 32; ++ch) {
                const float bl = ML[(bh * 32 + ch) * 2], gm = ML[(bh * 32 + ch) * 2 + 1];
                const float mn = fmaxf(bl + m, gm);
                dec[ch] = __expf(bl + m - mn); scl[ch] = __expf(gm - mn);
                if (sl == 0) MST[bh * 32 + ch] = m;
                m = mn;
            }
        }
        __syncthreads();
        f32x4 st = {0.f, 0.f, 0.f, 0.f};
        const size_t e0 = (size_t)sl * 1024 + tid * 4;
        f32x4 ub[32];
#pragma unroll
        for (int ch = 0; ch < 32; ++ch) ub[ch] = *(const f32x4*)(UB + ((size_t)(bh * 32 + ch)) * 8192 + e0);
#pragma unroll
        for (int ch = 0; ch < 32; ++ch) {
            st = st * dec[ch] + ub[ch] * scl[ch];
            u32x2 o = {pk2(st[0], st[1]), pk2(st[2], st[3])};
            *(u32x2*)(CB + ((size_t)(bh * 32 + ch)) * 8192 + e0) = o;
        }
        if (sl == 0 && tid < 64) {
            float nst = 0.f, un[32];
#pragma unroll
            for (int ch = 0; ch < 32; ++ch) un[ch] = UN[(size_t)(bh * 32 + ch) * 64 + tid];
#pragma unroll
            for (int ch = 0; ch < 32; ++ch) { nst = nst * dec[ch] + un[ch] * scl[ch]; NBF[(size_t)(bh * 32 + ch) * 64 + tid] = nst; }
        }
    }
}

DI void phase_ml3(const Params& p, int j, unsigned char* smem, int bid, int nb, int tid) {
    const int lane = tid & 63, wid = tid >> 6, c = lane & 31, hh = lane >> 5;
    float* al = (float*)smem + wid * 64;
    float* ssum = (float*)smem + 256;
    const bf16_t* MQ = (const bf16_t*)(p.ws + WS_MQ);
    const bf16_t* MK = (const bf16_t*)(p.ws + WS_MK);
    const bf16_t* VT = (const bf16_t*)(p.ws + WS_MV);
    const float* MIG = (const float*)(p.ws + WS_MIG);
    const float* MFG = (const float*)(p.ws + WS_MFG);
    const bf16_t* MOG = (const bf16_t*)(p.ws + WS_MOG);
    const bf16_t* CB = (const bf16_t*)(p.ws + WS_CBUF);
    const float* NBF = (const float*)(p.ws + WS_NBUF);
    const float* MST = (const float*)(p.ws + WS_MST);
    bf16_t* Y = (bf16_t*)(p.ws + WS_YMIX);
    const int kperm = (c & ~12) | ((c & 4) << 1) | ((c & 8) >> 1);
    for (int item = bid; item < 2048; item += nb) {
        const int bh = item >> 5, ch = item & 31, b = bh >> 3, h = bh & 7;
        const size_t tb = (size_t)b * S + ch * 64;
        const float lf = MFG[(tb + lane) * 8 + h], ig = MIG[(tb + lane) * 8 + h];
        const float bc = wave_incl_sum(lf, lane);
        const float av = ig - bc;
        const float mprev = MST[item];
        const float Mv = fmaxf(mprev, wave_incl_max(av, lane));
        __syncthreads();
        al[lane] = av;
        float Mt[2], wint[2], emt[2];
#pragma unroll
        for (int tt = 0; tt < 2; ++tt) { Mt[tt] = lane_get_f(Mv, 32 * tt + c); wint[tt] = __expf(mprev - Mt[tt]); emt[tt] = __expf(-(lane_get_f(bc, 32 * tt + c) + Mt[tt])); }
        bf16x8 qf[2][4], kf[2][4];
#pragma unroll
        for (int tt = 0; tt < 2; ++tt) {
            const bf16_t* qp = MQ + (tb + 32 * tt + c) * 512 + h * 64 + 8 * hh;
            const bf16_t* kp = MK + (tb + 32 * tt + kperm) * 512 + h * 64 + 8 * hh;
#pragma unroll
            for (int ks = 0; ks < 4; ++ks) { qf[tt][ks] = *(const bf16x8*)(qp + 16 * ks); kf[tt][ks] = *(const bf16x8*)(kp + 16 * ks); }
        }
        f32x16 o[2];
#pragma unroll
        for (int tt = 0; tt < 2; ++tt)
#pragma unroll
            for (int r = 0; r < 16; ++r) o[tt][r] = 0.f;
        float nq[2] = {0.f, 0.f};
        if (ch > 0) {
            const bf16_t* cp = CB + ((size_t)(item - 1) * 128 + wid * 32 + c) * 64 + 8 * hh;
            const float* np = NBF + (size_t)(item - 1) * 64 + 8 * hh;
#pragma unroll
            for (int ks = 0; ks < 4; ++ks) {
                const bf16x8 cf = *(const bf16x8*)(cp + 16 * ks);
                o[0] = __builtin_amdgcn_mfma_f32_32x32x16_bf16(cf, qf[0][ks], o[0], 0, 0, 0);
                o[1] = __builtin_amdgcn_mfma_f32_32x32x16_bf16(cf, qf[1][ks], o[1], 0, 0, 0);
                const f32x4 n0 = *(const f32x4*)(np + 16 * ks), n1 = *(const f32x4*)(np + 16 * ks + 4);
#pragma unroll
                for (int tt = 0; tt < 2; ++tt) {
                    const u32x4 u = __builtin_bit_cast(u32x4, qf[tt][ks]);
                    nq[tt] += n0[0] * bflo(u[0]) + n0[1] * bfhi(u[0]) + n0[2] * bflo(u[1]) + n0[3] * bfhi(u[1]) + n1[0] * bflo(u[2]) + n1[1] * bfhi(u[2]) + n1[2] * bflo(u[3]) + n1[3] * bfhi(u[3]);
                }
            }
#pragma unroll
            for (int tt = 0; tt < 2; ++tt) {
                nq[tt] += sx_f<32>(nq[tt]);
#pragma unroll
                for (int r = 0; r < 16; ++r) o[tt][r] *= wint[tt];
            }
        }
        float csum[2] = {0.f, 0.f};
        const bf16_t* vp = VT + ((size_t)(bh * 128 + wid * 32 + c)) * S + ch * 64 + 8 * hh;
#pragma unroll
        for (int tt = 0; tt < 2; ++tt) {
#pragma unroll
            for (int st = 0; st <= tt; ++st) {
                f32x16 x;
#pragma unroll
                for (int r = 0; r < 16; ++r) x[r] = 0.f;
#pragma unroll
                for (int ks = 0; ks < 4; ++ks) x = __builtin_amdgcn_mfma_f32_32x32x16_bf16(kf[st][ks], qf[tt][ks], x, 0, 0, 0);
#pragma unroll
                for (int k2 = 0; k2 < 2; ++k2) {
                    const int s0 = 32 * st + 16 * k2 + 8 * hh;
                    const f32x4 a0 = *(const f32x4*)(al + s0), a1 = *(const f32x4*)(al + s0 + 4);
                    const float a8[8] = {a0[0], a0[1], a0[2], a0[3], a1[0], a1[1], a1[2], a1[3]};
                    float pr[8];
#pragma unroll
                    for (int jx = 0; jx < 8; ++jx) {
                        const float e = __expf(a8[jx] - Mt[tt]) * x[8 * k2 + jx];
                        pr[jx] = (st < tt || s0 + jx <= 32 * tt + c) ? e : 0.f;
                        csum[tt] += pr[jx];
                    }
                    u32x4 pk = {pk2(pr[0], pr[1]), pk2(pr[2], pr[3]), pk2(pr[4], pr[5]), pk2(pr[6], pr[7])};
                    const bf16x8 vf = *(const bf16x8*)(vp + 32 * st + 16 * k2);
                    o[tt] = __builtin_amdgcn_mfma_f32_32x32x16_bf16(vf, __builtin_bit_cast(bf16x8, pk), o[tt], 0, 0, 0);
                }
            }
        }
        float ss[2];
#pragma unroll
        for (int tt = 0; tt < 2; ++tt) {
            csum[tt] += sx_f<32>(csum[tt]);
            const float den = wint[tt] * nq[tt] + csum[tt];
            const float rd = 1.f / fmaxf(fabsf(den), emt[tt]);
            float s2 = 0.f;
#pragma unroll
            for (int r = 0; r < 16; ++r) { o[tt][r] *= rd; s2 += o[tt][r] * o[tt][r]; }
            s2 += sx_f<32>(s2);
            ss[tt] = s2;
            if (hh == 0) ssum[wid * 64 + 32 * tt + c] = s2;
        }
        __syncthreads();
#pragma unroll
        for (int tt = 0; tt < 2; ++tt) {
            const int tcol = 32 * tt + c;
            const float tot = ssum[tcol] + ssum[64 + tcol] + ssum[128 + tcol] + ssum[192 + tcol];
            const float rstd = rsqrtf(tot * (1.f / 128.f) + EPS);
            const size_t ro = (tb + tcol) * 1024 + h * 128 + wid * 32 + 4 * hh;
            const float* gp = p.ml_out_norm + j * 1024 + h * 128 + wid * 32 + 4 * hh;
#pragma unroll
            for (int g4 = 0; g4 < 4; ++g4) {
                const f32x4 gm = *(const f32x4*)(gp + 8 * g4);
                const u32x2 og = *(const u32x2*)(MOG + ro + 8 * g4);
                u32x2 ov = {pk2(o[tt][4 * g4] * rstd * gm[0] * bflo(og[0]), o[tt][4 * g4 + 1] * rstd * gm[1] * bfhi(og[0])),
                            pk2(o[tt][4 * g4 + 2] * rstd * gm[2] * bflo(og[1]), o[tt][4 * g4 + 3] * rstd * gm[3] * bfhi(og[1]))};
                *(u32x2*)(Y + ro + 8 * g4) = ov;
            }
        }
    }
}


namespace pg8 {
#define PG8_LAS __attribute__((address_space(3)))
typedef unsigned short bf16_t;
typedef short bf16x8 __attribute__((ext_vector_type(8)));
typedef float f32x4 __attribute__((ext_vector_type(4)));
typedef unsigned u32x4 __attribute__((ext_vector_type(4)));
constexpr int BM = 256, BK = 64, HALF = 128, HTB = HALF * BK * 2  , STAGE_BYTES = 8 * HTB, NXCD = 8, WGM = 8;

__host__ __device__ __forceinline__ int lds_byte(int r, int c) { const int st = (r >> 4) * 2 + (c >> 5), rr = r & 15, cc = c & 31, ob = rr * 64 + cc * 2; return st * 1024 + (ob ^ (((ob >> 9) & 1) << 5)); }
__host__ __device__ __forceinline__ void stage_rc(int b, int& R, int& C) { const int st = b / 1024, sb = b % 1024, swz = sb ^ (((sb >> 9) & 1) << 5); R = (st >> 1) * 16 + swz / 64; C = (st & 1) * 32 + (swz % 64) / 2; }
__host__ __device__ __forceinline__ int perm32(int rho) { const int n = rho >> 4, i = rho & 15; return 8 * (i >> 2) + 4 * n + (i & 3); }

struct Unit { int pm, pn; };
struct Gemm { const bf16_t* A; const bf16_t* Bt; int M, N, K; };

struct StaticOrder {
    int nM, nN, nwg, G, c;
    __host__ __device__ void init(int M, int N, int G_, int c_) { nM = M / BM; nN = N / BM; nwg = nM * nN; G = G_; c = c_; }
    __host__ __device__ bool next(int i, Unit& u) const {
        const long L = (long)i * G + c; if (L >= nwg) return false;
        int wgid = (int)L; { const int q = nwg / NXCD, r = nwg % NXCD, xcd = wgid % NXCD, off = wgid / NXCD; wgid = (xcd < r ? xcd * (q + 1) : r * (q + 1) + (xcd - r) * q) + off; }
        const int nig = WGM * nN, gid = wgid / nig, fm = gid * WGM, gsz = (nM - fm) < WGM ? (nM - fm) : WGM;
        u.pm = fm + ((wgid % nig) % gsz); u.pn = (wgid % nig) / gsz; return true;
    }
    static constexpr bool GATHER = false;
    __device__ __forceinline__ unsigned a_off(const Unit&, int) const { return 0u; }
    __device__ __forceinline__ void a_ready(const Unit&) const {}
    __device__ __forceinline__ void done(const Unit&) const {}
};


template <class Epi, class Sched, bool ALIGN_EPI = false, bool SP2 = false>
__device__ __forceinline__ void gemm_phase(PG8_LAS unsigned char* lds, const Gemm g, const Sched& S, const Epi& E, int tid512) {
    const int tid = opq(tid512), wid = __builtin_amdgcn_readfirstlane(tid >> 6), lane = tid & 63, wr = wid >> 2, wc = wid & 3, fr = lane & 15, fq = lane >> 4;
    const int K = g.K, nt = K / BK;
    unsigned voffA[2], voffB[2];
    int rowA[2];
#pragma unroll
    for (int i = 0; i < 2; ++i) { int R, C; stage_rc(tid * 16 + i * 8192, R, C); const int Rb = Epi::PERM ? ((R & ~31) + perm32(R & 31)) : R;
        voffA[i] = (unsigned)(R * K + C) * 2u; voffB[i] = (unsigned)(Rb * K + C) * 2u; rowA[i] = R; if (Sched::GATHER) voffA[i] = (unsigned)C * 2u; }
    const size_t kstep = (size_t)(BK * 2);
    const size_t hstep = (size_t)HALF * K * 2;
    const size_t tstep = 2 * hstep;
    const unsigned ldsw = (unsigned)wid * 1024u;
    const int aoff = lds_byte(wr * 64 + fr, fq * 8), boff = lds_byte(wc * 32 + fr, fq * 8);
#define PG8_SA(b, h) (((b) * 2 + (h)) * HTB)
#define PG8_SB(b, h) ((4 + (b) * 2 + (h)) * HTB)
#define PG8_STAGE(bufoff, gbase, voff) do { _Pragma("unroll") for (int _i = 0; _i < 2; ++_i) \
        __builtin_amdgcn_global_load_lds((const unsigned*)((const char*)(gbase) + (voff)[_i]), (PG8_LAS unsigned*)(lds + (bufoff) + ldsw + _i * 8192), 16, 0, 0); } while (0)
#define PG8_LDA(dst, b, h) do { _Pragma("unroll") for (int m = 0; m < 4; ++m) _Pragma("unroll") for (int k = 0; k < 2; ++k) dst[m][k] = *(const PG8_LAS bf16x8*)(lds + PG8_SA(b, h) + aoff + m * 2048 + k * 1024); } while (0)
#define PG8_LDB(dst, b, h) do { _Pragma("unroll") for (int n = 0; n < 2; ++n) _Pragma("unroll") for (int k = 0; k < 2; ++k) dst[n][k] = *(const PG8_LAS bf16x8*)(lds + PG8_SB(b, h) + boff + n * 2048 + k * 1024); } while (0)
#define PG8_MMA(ai, bj, At, Bt) do { __builtin_amdgcn_s_setprio(1); _Pragma("unroll") for (int m = 0; m < 4; ++m) _Pragma("unroll") for (int n = 0; n < 2; ++n) _Pragma("unroll") for (int k = 0; k < 2; ++k) \
        acc[ai][bj][m][n] = __builtin_amdgcn_mfma_f32_16x16x32_bf16(Bt[n][k], At[m][k], acc[ai][bj][m][n], 0, 0, 0); __builtin_amdgcn_s_setprio(0); } while (0)
#define PG8_WAIT_V(n) asm volatile("s_waitcnt vmcnt(" #n ")" ::: "memory")
#define PG8_WAIT_L(n) asm volatile("s_waitcnt lgkmcnt(" #n ")" ::: "memory")
#define PG8_BAR __builtin_amdgcn_s_barrier()
#define PG8_SCHED __builtin_amdgcn_sched_barrier(0)
    unsigned oaC[2][2], oaN[2][2];
#define PG8_GOFF(dst, unit) do { _Pragma("unroll") for (int _h = 0; _h < 2; ++_h) _Pragma("unroll") for (int _i = 0; _i < 2; ++_i) dst[_h][_i] = S.a_off(unit, _h * HALF + rowA[_i]) + voffA[_i]; } while (0)
#define PG8_STAGE_G(bufoff, offs, koff) do { _Pragma("unroll") for (int _i = 0; _i < 2; ++_i) \
        __builtin_amdgcn_global_load_lds((const unsigned*)(((const char*)g.A + (koff)) + (offs)[_i]), (PG8_LAS unsigned*)(lds + (bufoff) + ldsw + _i * 8192), 16, 0, 0); } while (0)
    Unit cur, nxt; int ui = 0;
    if (!S.next(0, cur)) return;
    if constexpr (Sched::GATHER) { PG8_GOFF(oaC, cur); PG8_GOFF(oaN, cur); }
    f32x4 acc[2][2][4][2];
#pragma unroll
    for (int a = 0; a < 2; ++a)
#pragma unroll
        for (int b = 0; b < 2; ++b)
#pragma unroll
            for (int m = 0; m < 4; ++m)
#pragma unroll
                for (int n = 0; n < 2; ++n) acc[a][b][m][n] = (f32x4){0.f, 0.f, 0.f, 0.f};
    bf16x8 At[4][2], B0[2][2], B1[2][2];
    const char* cA = (const char*)g.A + (size_t)cur.pm * tstep; const char* cB = (const char*)g.Bt + (size_t)cur.pn * tstep;
    S.a_ready(cur);
    if constexpr (SP2) {
        PG8_STAGE(PG8_SB(0, 0), cB, voffB); PG8_STAGE(PG8_SB(0, 1), cB + hstep, voffB);
        if constexpr (Sched::GATHER) { PG8_STAGE_G(PG8_SA(0, 0), oaC[0], 0); PG8_STAGE_G(PG8_SA(0, 1), oaC[1], 0); } else { PG8_STAGE(PG8_SA(0, 0), cA, voffA); PG8_STAGE(PG8_SA(0, 1), cA + hstep, voffA); }
        if (wr == 1) PG8_BAR;
        PG8_WAIT_V(2); PG8_BAR;
        PG8_STAGE(PG8_SB(1, 0), cB + kstep, voffB);
        if constexpr (Sched::GATHER) PG8_STAGE_G(PG8_SA(1, 0), oaC[0], kstep); else PG8_STAGE(PG8_SA(1, 0), cA + kstep, voffA);
        PG8_STAGE(PG8_SB(1, 1), cB + hstep + kstep, voffB);
        PG8_WAIT_V(6); PG8_BAR;
    } else {
        PG8_STAGE(PG8_SB(0, 0), cB, voffB); PG8_STAGE(PG8_SA(0, 0), cA, voffA); PG8_STAGE(PG8_SB(0, 1), cB + hstep, voffB); PG8_STAGE(PG8_SA(0, 1), cA + hstep, voffA);
        if (wr == 1) PG8_BAR;
        PG8_WAIT_V(4); PG8_BAR;
        PG8_STAGE(PG8_SB(1, 0), cB + kstep, voffB); PG8_STAGE(PG8_SA(1, 0), cA + kstep, voffA); PG8_STAGE(PG8_SB(1, 1), cB + hstep + kstep, voffB);
        PG8_WAIT_V(6); PG8_BAR;
    }
    for (;;) {
        const bool has_next = S.next(ui + 1, nxt);
        const char* nA = has_next ? (const char*)g.A + (size_t)nxt.pm * tstep : cA; const char* nB = has_next ? (const char*)g.Bt + (size_t)nxt.pn * tstep : cB;
        for (int t = 0; t < nt; t += 2) {
            const bool last = (t == nt - 2);
            const char* a1 = cA + (size_t)(t + 1) * kstep;
            const char* a2 = last ? nA : cA + (size_t)(t + 2) * kstep; const char* b2 = last ? nB : cB + (size_t)(t + 2) * kstep;
            const char* a3 = a2 + kstep; const char* b3 = b2 + kstep;
            if (last && has_next) S.a_ready(nxt);
            unsigned oaS[2][2]; size_t k2 = 0;
            if constexpr (Sched::GATHER) {
                if (last && has_next) PG8_GOFF(oaN, nxt);
                const bool fromN = last && has_next;
#pragma unroll
                for (int _h = 0; _h < 2; ++_h)
#pragma unroll
                    for (int _i = 0; _i < 2; ++_i) oaS[_h][_i] = fromN ? oaN[_h][_i] : oaC[_h][_i];
                k2 = last ? (size_t)0 : (size_t)(t + 2) * kstep;
            }
            if constexpr (SP2) {
            PG8_LDB(B0, 0, 0); PG8_LDB(B1, 0, 1); PG8_SCHED; PG8_LDA(At, 0, 0);
            if constexpr (Sched::GATHER) PG8_STAGE_G(PG8_SA(1, 1), oaC[1], (size_t)(t + 1) * kstep); else PG8_STAGE(PG8_SA(1, 1), a1 + hstep, voffA);
            PG8_WAIT_V(8); PG8_WAIT_L(0); PG8_BAR; PG8_MMA(0, 0, At, B0); PG8_MMA(0, 1, At, B1); PG8_BAR; PG8_SCHED;
            PG8_LDA(At, 0, 1); PG8_STAGE(PG8_SB(0, 0), b2, voffB); PG8_STAGE(PG8_SB(0, 1), b2 + hstep, voffB);
            if constexpr (Sched::GATHER) PG8_STAGE_G(PG8_SA(0, 0), oaS[0], k2); else PG8_STAGE(PG8_SA(0, 0), a2, voffA);
            PG8_WAIT_V(8); PG8_WAIT_L(0); PG8_BAR; PG8_MMA(1, 0, At, B0); PG8_MMA(1, 1, At, B1); PG8_BAR; PG8_SCHED;
            PG8_LDB(B0, 1, 0); PG8_LDB(B1, 1, 1); PG8_SCHED; PG8_LDA(At, 1, 0);
            if constexpr (Sched::GATHER) PG8_STAGE_G(PG8_SA(0, 1), oaS[1], k2); else PG8_STAGE(PG8_SA(0, 1), a2 + hstep, voffA);
            PG8_WAIT_V(8); PG8_WAIT_L(0); PG8_BAR; PG8_MMA(0, 0, At, B0); PG8_MMA(0, 1, At, B1); PG8_BAR; PG8_SCHED;
            PG8_LDA(At, 1, 1); PG8_STAGE(PG8_SB(1, 0), b3, voffB); PG8_STAGE(PG8_SB(1, 1), b3 + hstep, voffB);
            if constexpr (Sched::GATHER) PG8_STAGE_G(PG8_SA(1, 0), oaS[0], k2 + kstep); else PG8_STAGE(PG8_SA(1, 0), a3, voffA);
            PG8_WAIT_V(8); PG8_WAIT_L(0); PG8_BAR; PG8_MMA(1, 0, At, B0); PG8_MMA(1, 1, At, B1); PG8_BAR; PG8_SCHED;
            } else {
            PG8_LDB(B0, 0, 0); PG8_SCHED; PG8_LDA(At, 0, 0); PG8_STAGE(PG8_SA(1, 1), a1 + hstep, voffA);
            PG8_WAIT_L(8); PG8_BAR; PG8_WAIT_L(0); PG8_MMA(0, 0, At, B0); PG8_BAR; PG8_SCHED;
            PG8_LDB(B1, 0, 1); PG8_STAGE(PG8_SB(0, 0), b2, voffB);
            PG8_BAR; PG8_WAIT_L(0); PG8_MMA(0, 1, At, B1); PG8_BAR;
            PG8_LDA(At, 0, 1); PG8_STAGE(PG8_SA(0, 0), a2, voffA);
            PG8_BAR; PG8_WAIT_L(0); PG8_MMA(1, 0, At, B0); PG8_BAR; PG8_SCHED;
            PG8_STAGE(PG8_SB(0, 1), b2 + hstep, voffB);
            PG8_WAIT_V(6); PG8_BAR; PG8_MMA(1, 1, At, B1); PG8_BAR;
            PG8_LDB(B0, 1, 0); PG8_SCHED; PG8_LDA(At, 1, 0); PG8_STAGE(PG8_SA(0, 1), a2 + hstep, voffA);
            PG8_WAIT_L(8); PG8_BAR; PG8_WAIT_L(0); PG8_MMA(0, 0, At, B0); PG8_BAR; PG8_SCHED;
            PG8_LDB(B1, 1, 1); PG8_STAGE(PG8_SB(1, 0), b3, voffB);
            PG8_BAR; PG8_WAIT_L(0); PG8_MMA(0, 1, At, B1); PG8_BAR;
            PG8_LDA(At, 1, 1); PG8_STAGE(PG8_SA(1, 0), a3, voffA);
            PG8_BAR; PG8_WAIT_L(0); PG8_MMA(1, 0, At, B0); PG8_BAR; PG8_SCHED;
            PG8_STAGE(PG8_SB(1, 1), b3 + hstep, voffB);
            PG8_WAIT_V(6); PG8_BAR; PG8_MMA(1, 1, At, B1); PG8_BAR;
            }
        }
        if constexpr (ALIGN_EPI) { if (wr == 0) PG8_BAR; }
        if constexpr (!Epi::AFTER_DRAIN) { E(acc, cur, wr, wc, fr, fq); S.done(cur); }
        if (!has_next) break;
#pragma unroll
        for (int a = 0; a < 2; ++a)
#pragma unroll
            for (int b = 0; b < 2; ++b)
#pragma unroll
                for (int m = 0; m < 4; ++m)
#pragma unroll
                    for (int n = 0; n < 2; ++n) acc[a][b][m][n] = (f32x4){0.f, 0.f, 0.f, 0.f};
        cur = nxt; cA = nA; cB = nB; ++ui;
        if constexpr (Sched::GATHER) {
#pragma unroll
            for (int _h = 0; _h < 2; ++_h)
#pragma unroll
                for (int _i = 0; _i < 2; ++_i) oaC[_h][_i] = oaN[_h][_i];
        }
        if constexpr (ALIGN_EPI) { if (wr == 1) PG8_BAR; }
    }
    PG8_WAIT_V(0);
    if constexpr (!ALIGN_EPI) { if (wr == 0) PG8_BAR; }
    PG8_BAR;
    if constexpr (Epi::AFTER_DRAIN) { E.fused(acc, cur, wr, wc, fr, fq, lds, wid, lane); S.done(cur); }
#undef PG8_GOFF
#undef PG8_STAGE_G
#undef PG8_SA
#undef PG8_SB
#undef PG8_STAGE
#undef PG8_LDA
#undef PG8_LDB
#undef PG8_MMA
#undef PG8_WAIT_V
#undef PG8_WAIT_L
#undef PG8_BAR
#undef PG8_SCHED
}
}

struct OutEpi8 {
    static constexpr bool PERM = false, AFTER_DRAIN = false;
    const float* src; float* dst; const float* gate; float* part;
    __device__ __forceinline__ void operator()(const pg8::f32x4 (&acc)[2][2][4][2], const pg8::Unit& u, int wr, int wc, int fr, int fq) const {
#pragma unroll
        for (int ai = 0; ai < 2; ++ai)
#pragma unroll
            for (int m = 0; m < 4; ++m) {
                const int t = u.pm * 256 + ai * 128 + wr * 64 + m * 16 + fr;
                const float* gp = gate + (t >> 11) * 6144;
                float ss = 0.f;
#pragma unroll
                for (int bj = 0; bj < 2; ++bj)
#pragma unroll
                    for (int n = 0; n < 2; ++n) {
                        const int col = u.pn * 256 + bj * 128 + wc * 32 + n * 16 + fq * 4;
                        const pg8::f32x4 g = *(const pg8::f32x4*)(gp + col);
                        const pg8::f32x4 o = *(const pg8::f32x4*)(src + (size_t)t * 1024 + col) + g * acc[ai][bj][m][n];
                        *(pg8::f32x4*)(dst + (size_t)t * 1024 + col) = o;
                        ss += o[0] * o[0] + o[1] * o[1] + o[2] * o[2] + o[3] * o[3];
                    }
                ss += sx_f<16>(ss); ss += sx_f<32>(ss);
                if (fq == 0) part[(size_t)t * 16 + u.pn * 4 + wc] = ss;
            }
    }
};


DI unsigned cvtpk(float lo, float hi) { return pk2(lo, hi); }
struct HybEpi8 {
    static constexpr bool PERM = true, AFTER_DRAIN = false;
    const Params* p; int j;
    __device__ __forceinline__ void operator()(const pg8::f32x4 (&acc)[2][2][4][2], const pg8::Unit& u, int wr, int wc, int fr, int fq) const {
        unsigned char* ws = p->ws;
        const int un = u.pn;
        if (un < 5 && !(un == 4 && (wc == 1 || wc == 3))) {
            const bool donorm = un < 2 || (un == 4 && wc == 0);
            bf16_t* ob; int ld, cb; const float* gam = p->hy_q_norm + j * 64;
            if (un < 2) { ob = (bf16_t*)(ws + WS_Q); ld = 512; cb = 64 * (4 * un + wc); }
            else if (un < 4) { ob = (bf16_t*)(ws + WS_IQ); ld = 512; cb = 64 * (4 * (un - 2) + wc); }
            else if (wc == 0) { ob = (bf16_t*)(ws + WS_K); ld = 64; cb = 0; gam = p->hy_k_norm + j * 64; }
            else { ob = (bf16_t*)(ws + WS_IK); ld = 64; cb = 0; }
            pg8::f32x4 g0[2], g1[2];
#pragma unroll
            for (int n = 0; n < 2; ++n) { g0[n] = donorm ? *(const pg8::f32x4*)(gam + 8 * fq + 4 * n) : (pg8::f32x4){1.f, 1.f, 1.f, 1.f}; g1[n] = donorm ? *(const pg8::f32x4*)(gam + 32 + 8 * fq + 4 * n) : (pg8::f32x4){1.f, 1.f, 1.f, 1.f}; }
            const float* ropec = (const float*)(ws + WS_ROPEC);
            const float* ropes = (const float*)(ws + WS_ROPES);
#pragma unroll
            for (int ai = 0; ai < 2; ++ai)
#pragma unroll
                for (int m = 0; m < 4; ++m) {
                    const int t = opq(u.pm * 256 + ai * 128 + wr * 64 + m * 16 + fr), pos = t & (S - 1);
                    float rstd = 1.f;
                    if (donorm) {
                        float ss = 0.f;
#pragma unroll
                        for (int bj = 0; bj < 2; ++bj)
#pragma unroll
                            for (int n = 0; n < 2; ++n) { const pg8::f32x4 x = acc[ai][bj][m][n]; ss += x[0] * x[0] + x[1] * x[1] + x[2] * x[2] + x[3] * x[3]; }
                        ss += sx_f<16>(ss); ss += sx_f<32>(ss);
                        rstd = rsqrtf(ss * (1.f / 64.f) + EPS);
                    }
                    u32x4 o1, o2;
#pragma unroll
                    for (int n = 0; n < 2; ++n) {
                        const pg8::f32x4 cs = *(const pg8::f32x4*)(ropec + pos * 32 + 8 * fq + 4 * n), sn = *(const pg8::f32x4*)(ropes + pos * 32 + 8 * fq + 4 * n);
                        const pg8::f32x4 x1 = acc[ai][0][m][n] * rstd * g0[n], x2 = acc[ai][1][m][n] * rstd * g1[n];
                        const pg8::f32x4 y1 = x1 * cs - x2 * sn, y2 = x2 * cs + x1 * sn;
                        o1[2 * n] = cvtpk(y1[0], y1[1]); o1[2 * n + 1] = cvtpk(y1[2], y1[3]);
                        o2[2 * n] = cvtpk(y2[0], y2[1]); o2[2 * n + 1] = cvtpk(y2[2], y2[3]);
                    }
                    if (un == 4) {
                        const int kk = t & 31, cs_ = (wc == 0) ? ((kk & ~12) | ((kk & 4) << 1) | ((kk & 8) >> 1)) : kk;
                        bf16_t* fb = ob + ((size_t)(t >> 5) * 256 + (fq >> 1) * 64 + (fq & 1) * 32 + cs_) * 8;
                        *(u32x4*)fb = o1; *(u32x4*)(fb + 128 * 8) = o2;
                    } else {
                    *(u32x4*)(ob + (size_t)t * ld + cb + 8 * fq) = o1;
                    *(u32x4*)(ob + (size_t)t * ld + cb + 32 + 8 * fq) = o2;
                    }
                }
        } else if (un == 4 && wc == 1) {
            bf16_t* ob = (bf16_t*)(ws + WS_V);
#pragma unroll
            for (int ai = 0; ai < 2; ++ai)
#pragma unroll
                for (int m = 0; m < 4; ++m) {
                    const int t = opq(u.pm * 256 + ai * 128 + wr * 64 + m * 16 + fr), pos = t & (S - 1);
#pragma unroll
                    for (int bj = 0; bj < 2; ++bj)
#pragma unroll
                        for (int n = 0; n < 2; ++n)
#pragma unroll
                            for (int e = 0; e < 4; ++e) ob[((((size_t)(t >> 5) * 4 + bj + ((pos >> 4) & 1) * 2) * 2 + ((pos >> 3) & 1)) * 32 + 8 * fq + 4 * n + e) * 8 + (pos & 7)] = f2bf(acc[ai][bj][m][n][e]);
                }
        } else if (un == 4) {
            float* ob = (float*)(ws + WS_IW);
            if (fq == 0) {
#pragma unroll
                for (int ai = 0; ai < 2; ++ai)
#pragma unroll
                    for (int m = 0; m < 4; ++m) {
                        const int t = u.pm * 256 + ai * 128 + wr * 64 + m * 16 + fr;
                        *(pg8::f32x4*)(ob + (size_t)t * 8) = acc[ai][0][m][0] * (0.125f * 0.35355339059327373f);
                        *(pg8::f32x4*)(ob + (size_t)t * 8 + 4) = acc[ai][0][m][1] * (0.125f * 0.35355339059327373f);
                    }
            }
        } else if (un < 7) {
            bf16_t* ob = (bf16_t*)(ws + WS_BG);
#pragma unroll
            for (int ai = 0; ai < 2; ++ai)
#pragma unroll
                for (int m = 0; m < 4; ++m) {
                    const int t = opq(u.pm * 256 + ai * 128 + wr * 64 + m * 16 + fr);
#pragma unroll
                    for (int bj = 0; bj < 2; ++bj) {
                        const pg8::f32x4 a = acc[ai][bj][m][0], b = acc[ai][bj][m][1];
                        u32x4 o = {cvtpk(a[0], a[1]), cvtpk(a[2], a[3]), cvtpk(b[0], b[1]), cvtpk(b[2], b[3])};
                        *(u32x4*)(ob + (size_t)t * 512 + (un - 5) * 256 + 128 * bj + 32 * wc + 8 * fq) = o;
                    }
                }
        } else {
            bf16_t* ob = (bf16_t*)(ws + WS_Z);
#pragma unroll
            for (int ai = 0; ai < 2; ++ai)
#pragma unroll
                for (int m = 0; m < 4; ++m) {
                    const int t = opq(u.pm * 256 + ai * 128 + wr * 64 + m * 16 + fr);
                    const pg8::f32x4 a = acc[ai][0][m][0] * acc[ai][1][m][0], b = acc[ai][0][m][1] * acc[ai][1][m][1];
                    u32x4 o = {cvtpk(a[0], a[1]), cvtpk(a[2], a[3]), cvtpk(b[0], b[1]), cvtpk(b[2], b[3])};
                    *(u32x4*)(ob + (size_t)t * 512 + (un - 7) * 128 + 32 * wc + 8 * fq) = o;
                }
        }
    }
};


struct MlEpi8 {
    static constexpr bool PERM = true, AFTER_DRAIN = false;
    const Params* p; int j;
    __device__ __forceinline__ void operator()(const pg8::f32x4 (&acc)[2][2][4][2], const pg8::Unit& u, int wr, int wc, int fr, int fq) const {
        unsigned char* ws = p->ws;
        const int un = u.pn;
        if (un < 4 || un >= 8) {
            bf16_t* ob; int ld, cb0; float sc = 1.f;
            if (un < 2) { ob = (bf16_t*)(ws + WS_MQ); ld = 512; cb0 = 64 * (4 * un + wc); sc = 0.125f; }
            else if (un < 4) { ob = (bf16_t*)(ws + WS_MK); ld = 512; cb0 = 64 * (4 * (un - 2) + wc); }
            else { ob = (bf16_t*)(ws + WS_MOG); ld = 1024; cb0 = (un - 8) * 256 + 32 * wc; }
            const int bstep = un < 4 ? 32 : 128;
#pragma unroll
            for (int ai = 0; ai < 2; ++ai)
#pragma unroll
                for (int m = 0; m < 4; ++m) {
                    const int t = opq(u.pm * 256 + ai * 128 + wr * 64 + m * 16 + fr);
#pragma unroll
                    for (int bj = 0; bj < 2; ++bj) {
                        pg8::f32x4 a = acc[ai][bj][m][0] * sc, b = acc[ai][bj][m][1] * sc;
                        if (un >= 8) { for (int e = 0; e < 4; ++e) { a[e] = sigmoidf_(a[e]); b[e] = sigmoidf_(b[e]); } }
                        u32x4 o = {cvtpk(a[0], a[1]), cvtpk(a[2], a[3]), cvtpk(b[0], b[1]), cvtpk(b[2], b[3])};
                        *(u32x4*)(ob + (size_t)t * ld + cb0 + bstep * bj + 8 * fq) = o;
                    }
                }
        }
        if (un >= 2 && un < 8) {
            bf16_t* ob = (bf16_t*)(ws + (un < 4 ? WS_MKT : WS_MV));
#pragma unroll
            for (int ai = 0; ai < 2; ++ai)
#pragma unroll
                for (int m = 0; m < 4; ++m) {
                    const int t = opq(u.pm * 256 + ai * 128 + wr * 64 + m * 16 + fr), pos = t & (S - 1), bb = t >> 11;
#pragma unroll
                    for (int bj = 0; bj < 2; ++bj) {
                        const size_t rowb = un < 4 ? (size_t)((bb * 8 + 4 * (un - 2) + wc) * 64 + 32 * bj + 8 * fq) : (size_t)((bb * 8 + 2 * (un - 4) + bj) * 128 + 32 * wc + 8 * fq);
#pragma unroll
                        for (int n = 0; n < 2; ++n)
#pragma unroll
                            for (int e = 0; e < 4; ++e) ob[(rowb + 4 * n + e) * S + pos] = f2bf(acc[ai][bj][m][n][e]);
                    }
                }
        }
    }
};


struct MoeOrder8 {
    static constexpr bool GATHER = true;
    const int* tab; const int* elist; int G, c, total, mode;
    __device__ __forceinline__ bool next(int i, pg8::Unit& u) const {
        const int L = i * G + c; if (L >= total) return false;
        int wg = L; { const int q = total >> 3, r = total & 7, x = wg & 7, off = wg >> 3; wg = (x < r ? x * (q + 1) : r * (q + 1) + (x - r) * q) + off; }
        const int ru = wg >> 2; int e = 0;
        while (e < 31 && tab[e + 1] <= ru) ++e;
        u.pm = __builtin_amdgcn_readfirstlane((e << 8) | (ru - tab[e])); u.pn = __builtin_amdgcn_readfirstlane(e * 4 + (wg & 3)); return true;
    }
    __device__ __forceinline__ unsigned a_off(const pg8::Unit& u, int row) const {
        const int e = u.pm >> 8, lr = (u.pm & 255) * 256 + row;
        if (lr >= tab[40 + e]) return 0u;
        if (mode == 1) return (unsigned)(elist[e * NASG + lr] >> 1) * 2048u;
        return (unsigned)(tab[80 + e] + lr) * 1024u;
    }
    __device__ __forceinline__ void a_ready(const pg8::Unit&) const {}
    __device__ __forceinline__ void done(const pg8::Unit&) const {}
};
struct Moe1Epi8 {
    static constexpr bool PERM = true, AFTER_DRAIN = false;
    const int* tab; bf16_t* h1;
    __device__ __forceinline__ void operator()(const pg8::f32x4 (&acc)[2][2][4][2], const pg8::Unit& u, int wr, int wc, int fr, int fq) const {
        const int e = u.pm >> 8, mu = u.pm & 255, nu = u.pn & 3, cnt = tab[40 + e], roff = tab[80 + e];
#pragma unroll
        for (int ai = 0; ai < 2; ++ai)
#pragma unroll
            for (int m = 0; m < 4; ++m) {
                const int lr = opq(mu * 256 + ai * 128 + wr * 64 + m * 16 + fr);
                if (lr < cnt) {
                    u32x4 o;
#pragma unroll
                    for (int n = 0; n < 2; ++n) {
                        const pg8::f32x4 g = acc[ai][0][m][n], up = acc[ai][1][m][n]; float h[4];
#pragma unroll
                        for (int x = 0; x < 4; ++x) h[x] = g[x] / (1.f + __expf(-g[x])) * up[x];
                        o[2 * n] = cvtpk(h[0], h[1]); o[2 * n + 1] = cvtpk(h[2], h[3]);
                    }
                    *(u32x4*)(h1 + (size_t)(roff + lr) * 512 + 128 * nu + 32 * wc + 8 * fq) = o;
                }
            }
    }
};
struct Moe2Epi8 {
    static constexpr bool PERM = true, AFTER_DRAIN = false;
    const int* tab; const int* elist; bf16_t* y;
    __device__ __forceinline__ void operator()(const pg8::f32x4 (&acc)[2][2][4][2], const pg8::Unit& u, int wr, int wc, int fr, int fq) const {
        const int e = u.pm >> 8, mu = u.pm & 255, nu = u.pn & 3, cnt = tab[40 + e];
#pragma unroll
        for (int ai = 0; ai < 2; ++ai)
#pragma unroll
            for (int m = 0; m < 4; ++m) {
                const int lr = opq(mu * 256 + ai * 128 + wr * 64 + m * 16 + fr);
                if (lr < cnt) {
                    const int a = elist[e * NASG + lr];
#pragma unroll
                    for (int bj = 0; bj < 2; ++bj) {
                        const pg8::f32x4 v0 = acc[ai][bj][m][0], v1 = acc[ai][bj][m][1];
                        u32x4 o = {cvtpk(v0[0], v0[1]), cvtpk(v0[2], v0[3]), cvtpk(v1[0], v1[1]), cvtpk(v1[2], v1[3])};
                        *(u32x4*)(y + (size_t)a * 1024 + 256 * nu + 128 * bj + 32 * wc + 8 * fq) = o;
                    }
                }
            }
    }
};

#define XB_TMO      128
#define XB_XCNT(j)  (256  + 64 * (j))
#define XB_XSUB(j)  (1280 + 64 * (j))
#define XB_XGEN(j)  (2304 + 64 * (j))
#define XB_TOP      3328
#define XB_TOPGEN   3392
#define XCD_BAR_WORDS 3456
#define XB_SPIN_CAP (1u << 22)
#define LAS __attribute__((address_space(3)))
DI unsigned xb_ld(unsigned* p) { return __hip_atomic_load(p, __ATOMIC_RELAXED, __HIP_MEMORY_SCOPE_AGENT); }
DI unsigned xb_add(unsigned* p, unsigned v) { return __hip_atomic_fetch_add(p, v, __ATOMIC_RELAXED, __HIP_MEMORY_SCOPE_AGENT); }
DI unsigned xb_xcc_id() { return (unsigned)__builtin_amdgcn_s_getreg((3 << 11) | 20) & 0xFu; }
#define XB_SPIN(cond, bar) do { unsigned _sp = 0; while (cond) { __builtin_amdgcn_s_sleep(1); \
    if ((++_sp & 255u) == 0u) { if (xb_ld(&(bar)[XB_TMO])) break; if (_sp > XB_SPIN_CAP) { atomicAdd(&(bar)[XB_TMO], 1u); break; } } } } while (0)
struct XcdBarrier { unsigned* bar; unsigned x; volatile LAS unsigned* st; };
DI XcdBarrier xcd_barrier_post(unsigned* bar, volatile LAS unsigned* st, bool leader) {
    XcdBarrier b; b.bar = bar; b.x = xb_xcc_id(); b.st = st;
    if (leader) (void)xb_add(&bar[XB_XCNT(b.x)], 1u);
    return b;
}
DI void xcd_barrier_complete(unsigned* bar, unsigned x, unsigned& nloc, unsigned& nx) {
    const unsigned G = gridDim.x * gridDim.y * gridDim.z;
    unsigned sum, cnt, mine, sp = 0u;
    for (;;) {
        sum = 0u; cnt = 0u; mine = 0u;
#pragma unroll
        for (unsigned j = 0; j < 16; ++j) { const unsigned c = xb_ld(&bar[XB_XCNT(j)]); sum += c; cnt += (c > 0u) ? 1u : 0u; mine = (j == x) ? c : mine; }
        if (sum == G) break;
        __builtin_amdgcn_s_sleep(1);
        if ((++sp & 255u) == 0u) { if (xb_ld(&bar[XB_TMO])) break; if (sp > XB_SPIN_CAP) { atomicAdd(&bar[XB_TMO], 1u); break; } }
    }
    nloc = mine > 0u ? mine : 1u; nx = cnt > 0u ? cnt : 1u;
}
DI void xcd_barrier(const XcdBarrier& b, bool leader) {
    asm volatile("s_waitcnt vmcnt(0)" ::: "memory");
    __syncthreads();
    if (leader) {
        unsigned* bar = b.bar;
        __builtin_amdgcn_s_waitcnt(0);
        unsigned nloc = b.st[0], nx = b.st[1];
        if (nloc == 0u) { xcd_barrier_complete(bar, b.x, nloc, nx); b.st[0] = nloc; b.st[1] = nx; }
        const unsigned old = xb_add(&bar[XB_XSUB(b.x)], 1u);
        const unsigned gen = old / nloc;
        if (old + 1u == (gen + 1u) * nloc) {
            __builtin_amdgcn_fence(__ATOMIC_RELEASE, "agent");
            asm volatile("s_waitcnt vmcnt(0)" ::: "memory");
            const unsigned og = xb_add(&bar[XB_TOP], 1u);
            const unsigned tg = og / nx;
            if (og + 1u == (tg + 1u) * nx) xb_add(&bar[XB_TOPGEN], 1u);
            else XB_SPIN(xb_ld(&bar[XB_TOPGEN]) == tg, bar);
            __builtin_amdgcn_fence(__ATOMIC_ACQUIRE, "agent");
            xb_add(&bar[XB_XGEN(b.x)], 1u);
            asm volatile("s_waitcnt vmcnt(0)" ::: "memory");
        } else {
            XB_SPIN(xb_ld(&bar[XB_XGEN(b.x)]) == gen, bar);
            __builtin_amdgcn_fence(__ATOMIC_ACQUIRE, "agent");
            asm volatile("s_waitcnt vmcnt(0)" ::: "memory");
        }
    }
    __syncthreads();
}

namespace cg = cooperative_groups;
constexpr int MEGA_LDS = 65536 + 256;

DI const Params& fresh(const Params* kp) { asm volatile("" : "+s"(kp)); return *kp; }

#ifndef PROBE_MASK
#define PROBE_MASK 0
#endif
__global__ void __launch_bounds__(512, 2) hybrid_fwd_megakernel(Params p_arg) {
    __shared__ __attribute__((aligned(16))) unsigned char smem_all[2 * MEGA_LDS + 1024];
    cg::grid_group grid = cg::this_grid();
    const Params* kp = (const Params*)__builtin_amdgcn_kernarg_segment_ptr();
    const int wave8 = __builtin_amdgcn_readfirstlane((int)(threadIdx.x >> 6));
    const int vb = wave8 >> 2;
#define tid0 ((wave8 & 3) * 64 + lane_id())
    unsigned char* smem = smem_all + vb * MEGA_LDS;
    const int bid0 = blockIdx.x * 2 + vb, nb = gridDim.x * 2;
    const int gx0 = blockIdx.x & 7, glb0 = (blockIdx.x >> 3) * 2 + vb, gnl = (gridDim.x >> 3) * 2;
#define bid opqs(bid0)
#define gx opqs(gx0)
#define glb opqs(glb0)
#define tid opq(tid0)
    volatile LAS unsigned* xst = (volatile LAS unsigned*)(smem_all + 2 * MEGA_LDS);
    if (wave8 == 0 && lane_id() == 0) { xst[0] = 0u; xst[1] = 0u; }
    __syncthreads();
    (void)xcd_barrier_post((unsigned*)(fresh(kp).ws + WS_BAR), xst, wave8 == 0 && lane_id() == 0);
    for (int rep = 0; rep < ((PROBE_MASK & 1) ? 2 : 1); ++rep) { phase_init(fresh(kp), smem, bid, nb, tid); }
#define GSYNC() do { XcdBarrier xb_; xb_.bar = (unsigned*)(fresh(kp).ws + WS_BAR); xb_.x = xb_xcc_id(); xb_.st = (volatile LAS unsigned*)(smem_all + 2 * MEGA_LDS); xcd_barrier(xb_, wave8 == 0 && lane_id() == 0); } while (0)
    if (fresh(kp).use_cg_sync) grid.sync();
    GSYNC();
#pragma unroll 1
    for (int layer = 0; layer < DEPTH; ++layer) {
        const int j = layer >> 1;
        if (layer == 0) { { const Params& p = fresh(kp); phase_norm(p, 0, p.x, bid, nb, tid); }
        GSYNC(); }
        if ((layer & 1) == 0) {
            for (int rep = 0; rep < ((PROBE_MASK & 4) ? 2 : 1); ++rep) { { const Params& p = fresh(kp);
              pg8::Gemm g8{(const pg8::bf16_t*)(p.ws + WS_H), (const pg8::bf16_t*)(p.ws + WS_WHYB) + (size_t)j * 2816 * 1024, T, 2816, 1024};
              pg8::StaticOrder S8; S8.init(T, 2816, (int)gridDim.x, (int)blockIdx.x);
              HybEpi8 E8{&p, j};
              pg8::gemm_phase<HybEpi8, pg8::StaticOrder, true, true>((PG8_LAS unsigned char*)smem_all, g8, S8, E8, wave8 * 64 + lane_id()); } }
            GSYNC();
            for (int rep = 0; rep < ((PROBE_MASK & 8) ? 2 : 1); ++rep) { phase_dsa(fresh(kp), j, smem, bid, nb, tid, layer == 0 ? 1 : 3, layer == 0 ? 3 : 4); }
            for (int rep = 0; rep < ((PROBE_MASK & 16) ? 2 : 1); ++rep) { phase_conv(fresh(kp), j, bid, nb, tid); }
            GSYNC();
            { const Params& p = fresh(kp);
              pg8::Gemm g8{(const pg8::bf16_t*)(p.ws + WS_YMIX), (const pg8::bf16_t*)(p.ws + WS_WOUT) + (size_t)layer * 1024 * 1024, T, 1024, 1024};
              pg8::StaticOrder S8; S8.init(T, 1024, (int)gridDim.x, (int)blockIdx.x);
              OutEpi8 E8{layer == 0 ? p.x : p.out, p.out, (const float*)(p.ws + WS_MOD) + (size_t)layer * 8 * 6144 + 2048, (float*)(p.ws + WS_PART)};
              pg8::gemm_phase<OutEpi8, pg8::StaticOrder, true, true>((PG8_LAS unsigned char*)smem_all, g8, S8, E8, wave8 * 64 + lane_id()); }
        } else {
            for (int rep = 0; rep < ((PROBE_MASK & 32) ? 2 : 1); ++rep) { { const Params& p = fresh(kp);
              pg8::Gemm g8{(const pg8::bf16_t*)(p.ws + WS_H), (const pg8::bf16_t*)(p.ws + WS_WML) + (size_t)j * 3200 * 1024, T, 3072, 1024};
              pg8::StaticOrder S8; S8.init(T, 3072, (int)gridDim.x, (int)blockIdx.x);
              MlEpi8 E8{&p, j};
              pg8::gemm_phase<MlEpi8, pg8::StaticOrder, true, true>((PG8_LAS unsigned char*)smem_all, g8, S8, E8, wave8 * 64 + lane_id());
              for (int gi = glb; gi < 16; gi += gnl) { MlGates pr{&p, j, gx * 16 + gi}; gemm_tile(pr, smem, tid); } } }
            GSYNC();
            for (int rep = 0; rep < ((PROBE_MASK & 64) ? 2 : 1); ++rep) { phase_ml1(fresh(kp), smem, bid, nb, tid); }
            GSYNC();
            for (int rep = 0; rep < ((PROBE_MASK & 128) ? 2 : 1); ++rep) { phase_ml2(fresh(kp), smem, bid, nb, tid); }
            GSYNC();
            for (int rep = 0; rep < ((PROBE_MASK & 256) ? 2 : 1); ++rep) { phase_ml3(fresh(kp), j, smem, bid, nb, tid); }
            GSYNC();
            { const Params& p = fresh(kp);
              pg8::Gemm g8{(const pg8::bf16_t*)(p.ws + WS_YMIX), (const pg8::bf16_t*)(p.ws + WS_WOUT) + (size_t)layer * 1024 * 1024, T, 1024, 1024};
              pg8::StaticOrder S8; S8.init(T, 1024, (int)gridDim.x, (int)blockIdx.x);
              OutEpi8 E8{p.out, p.out, (const float*)(p.ws + WS_MOD) + (size_t)layer * 8 * 6144 + 2048, (float*)(p.ws + WS_PART)};
              pg8::gemm_phase<OutEpi8, pg8::StaticOrder, true, true>((PG8_LAS unsigned char*)smem_all, g8, S8, E8, wave8 * 64 + lane_id()); }
        }
        GSYNC();
        phase_ffn_norm_router(fresh(kp), layer, smem, bid, nb, tid);
        GSYNC();
        { const Params& p = fresh(kp); unsigned char* wsu = uniform_ptr(p.ws);
          int* mtab = (int*)(smem_all + 2 * MEGA_LDS + 64);
          __syncthreads();
          if (wave8 == 0 && lane_id() == 0) {
              const int* ecnt = (const int*)(wsu + WS_ECNT) + layer * 32 * ECS; int ua = 0, ra = 0;
              for (int e = 0; e < 32; ++e) { const int cn = ecnt[e * ECS]; mtab[e] = ua; mtab[40 + e] = cn; mtab[80 + e] = ra; ua += (cn + 255) >> 8; ra += cn; }
              mtab[32] = ua;
          }
          __syncthreads();
          MoeOrder8 S8{mtab, (const int*)(wsu + WS_ELIST), (int)gridDim.x, (int)blockIdx.x, mtab[32] * 4, 1};
          pg8::Gemm g8{(const pg8::bf16_t*)(wsu + WS_H), (const pg8::bf16_t*)(wsu + WS_WM1) + (size_t)layer * 32 * 1024 * 1024, 0, 0, 1024};
          Moe1Epi8 E8{mtab, (bf16_t*)(wsu + WS_H1)};
          pg8::gemm_phase<Moe1Epi8, MoeOrder8, true, true>((PG8_LAS unsigned char*)smem_all, g8, S8, E8, wave8 * 64 + lane_id()); }
        GSYNC();
        { const Params& p = fresh(kp); unsigned char* wsu = uniform_ptr(p.ws);
          int* mtab = (int*)(smem_all + 2 * MEGA_LDS + 64);
          MoeOrder8 S8{mtab, (const int*)(wsu + WS_ELIST), (int)gridDim.x, (int)blockIdx.x, mtab[32] * 4, 2};
          pg8::Gemm g8{(const pg8::bf16_t*)(wsu + WS_H1), (const pg8::bf16_t*)(wsu + WS_WM2) + (size_t)layer * 32 * 1024 * 512, 0, 0, 512};
          Moe2Epi8 E8{mtab, (const int*)(wsu + WS_ELIST), (bf16_t*)(wsu + WS_Y)};
          pg8::gemm_phase<Moe2Epi8, MoeOrder8, true, true>((PG8_LAS unsigned char*)smem_all, g8, S8, E8, wave8 * 64 + lane_id()); }
        GSYNC();
        phase_combine_norm(fresh(kp), layer, bid, nb, tid);
        if (layer + 1 < DEPTH) GSYNC();
    }
}
#undef tid
#undef tid0
#undef bid
#undef gx
#undef glb
#undef GSYNC

extern "C" void kernel_launch(void* const* d_in, const int* in_sizes, int n_in, void* d_out, int out_size, void* d_ws, size_t ws_size, hipStream_t stream) {
    Params p{};
    const float** f = (const float**)&p;
    for (int i = 0; i < 22; ++i) f[i] = (const float*)d_in[i];
    p.out = (float*)d_out;
    p.ws = (unsigned char*)d_ws;
    if (ws_size < WS_END) { fprintf(stderr, "workspace too small: %zu < %zu\n", ws_size, (size_t)WS_END); return; }
    static int grid_blocks = 0;
    if (!grid_blocks) {
        int dev = 0, cus = 0, per_cu = 0;
        hipGetDevice(&dev);
        hipDeviceGetAttribute(&cus, hipDeviceAttributeMultiprocessorCount, dev);
        hipOccupancyMaxActiveBlocksPerMultiprocessor(&per_cu, hybrid_fwd_megakernel, 512, 0);
        if (per_cu > 1) per_cu = 1;
        grid_blocks = cus * per_cu;
    }
    (void)hipMemsetAsync((unsigned char*)d_ws + WS_BAR, 0, XCD_BAR_WORDS_C * 4, stream);
    void* args[] = {&p};
    hipError_t e = hipLaunchCooperativeKernel((void*)hybrid_fwd_megakernel, dim3(grid_blocks), dim3(512), args, 0, stream);
    if (e != hipSuccess) fprintf(stderr, "cooperative launch failed: %s (grid %d)\n", hipGetErrorString(e), grid_blocks);
}
```

```cpp
#include <hip/hip_runtime.h>
#include <hip/hip_cooperative_groups.h>
#include <stdint.h>
#include <cstdio>

#define DI __device__ __forceinline__
typedef unsigned short bf16_t;
typedef short bf16x8 __attribute__((ext_vector_type(8)));
typedef float f32x16 __attribute__((ext_vector_type(16)));
typedef float f32x4 __attribute__((ext_vector_type(4)));
typedef float f32x2 __attribute__((ext_vector_type(2)));
typedef unsigned u32x4 __attribute__((ext_vector_type(4)));
typedef unsigned u32x2 __attribute__((ext_vector_type(2)));
typedef __bf16 bf16x2_t __attribute__((ext_vector_type(2)));

constexpr int D = 1024, NB = 8, S = 2048, T = NB * S, DEPTH = 4;
constexpr int HYB_IN = 2760, ML_IN = 3088;
constexpr int NEXP = 32, DEXP = 512, NASG = T * 2;
constexpr float EPS = 1e-6f;
constexpr int XCD_BAR_WORDS_C = 3456;

constexpr size_t al256(size_t x) { return (x + 255) & ~(size_t)255; }
constexpr size_t WS_MOD = 0;
constexpr size_t WS_ROPEC = WS_MOD + al256((size_t)4 * 8 * 6144 * 4);
constexpr size_t WS_ROPES = WS_ROPEC + al256((size_t)2048 * 32 * 4);
constexpr size_t WS_ECNT = WS_ROPES + al256((size_t)2048 * 32 * 4);
constexpr int ECS = 64;
constexpr size_t WS_H = WS_ECNT + al256(4 * 32 * ECS * 4);
constexpr size_t WS_YMIX = WS_H + al256((size_t)T * 1024 * 2);
constexpr size_t WS_Q = WS_YMIX + al256((size_t)T * 1024 * 2);
constexpr size_t WS_K = WS_Q + al256((size_t)T * 512 * 2);
constexpr size_t WS_V = WS_K + al256((size_t)T * 64 * 2);
constexpr size_t WS_IQ = WS_V + al256((size_t)T * 64 * 2);
constexpr size_t WS_IK = WS_IQ + al256((size_t)T * 512 * 2);
constexpr size_t WS_IW = WS_IK + al256((size_t)T * 64 * 2);
constexpr size_t WS_BG = WS_IW + al256((size_t)T * 8 * 4);
constexpr size_t WS_Z = WS_BG + al256((size_t)T * 512 * 2);
constexpr size_t WS_MASK = WS_Z + al256((size_t)T * 512 * 2);
constexpr size_t WS_MQ = WS_MASK + al256((size_t)T * 64 * 4);
constexpr size_t WS_MK = WS_MQ + al256((size_t)T * 512 * 2);
constexpr size_t WS_MV = WS_MK + al256((size_t)T * 512 * 2);
constexpr size_t WS_MIG = WS_MV + al256((size_t)T * 1024 * 2);
constexpr size_t WS_MFG = WS_MIG + al256((size_t)T * 8 * 4);
constexpr size_t WS_MOG = WS_MFG + al256((size_t)T * 8 * 4);
constexpr size_t WS_EW = WS_MOG + al256((size_t)T * 1024 * 2);
constexpr size_t WS_ELIST = WS_EW + al256((size_t)NASG * 4);
constexpr size_t WS_H1 = WS_ELIST + al256((size_t)NEXP * NASG * 4);
constexpr size_t WS_Y = WS_H1 + al256((size_t)NASG * 512 * 2);
constexpr size_t WS_MKT = WS_Y + al256((size_t)NASG * 1024 * 2);
constexpr size_t WS_UBUF = WS_MKT + al256((size_t)64 * 64 * S * 2);
constexpr size_t WS_UNBUF = WS_UBUF + al256((size_t)64 * 32 * 8192 * 4);
constexpr size_t WS_MLOC = WS_UNBUF + al256((size_t)64 * 32 * 64 * 4);
constexpr size_t WS_CBUF = WS_MLOC + al256((size_t)64 * 32 * 2 * 4);
constexpr size_t WS_NBUF = WS_CBUF + al256((size_t)64 * 32 * 8192 * 2);
constexpr size_t WS_MST = WS_NBUF + al256((size_t)64 * 32 * 64 * 4);
constexpr size_t WS_PART = WS_MST + al256((size_t)64 * 32 * 4);
constexpr size_t WS_WHYB = WS_PART + al256((size_t)T * 16 * 4);
constexpr size_t WS_WML = WS_WHYB + al256((size_t)2 * 2816 * 1024 * 2);
constexpr size_t WS_WOUT = WS_WML + al256((size_t)2 * 3200 * 1024 * 2);
constexpr size_t WS_WM1 = WS_WOUT + al256((size_t)4 * 1024 * 1024 * 2);
constexpr size_t WS_WM2 = WS_WM1 + al256((size_t)4 * 32 * 1024 * 1024 * 2);
constexpr size_t WS_BAR = WS_WM2 + al256((size_t)4 * 32 * 1024 * 512 * 2);
constexpr size_t WS_END = WS_BAR + al256((size_t)XCD_BAR_WORDS_C * 4);

struct Params {
    const float *x, *c, *ada_w, *ada_b, *norm_mix, *norm_ffn, *hy_w_in, *hy_q_norm, *hy_k_norm, *hy_conv_w, *hy_w_out;
    const float *ml_w_in, *ml_b_gates, *ml_out_norm, *ml_w_out, *moe_w_group, *moe_b_group, *moe_w_expert, *moe_b_expert;
    const float *moe_w_gate, *moe_w_up, *moe_w_down;
    float* out;
    unsigned char* ws;
    unsigned long long use_cg_sync;
};

DI unsigned pk2(float lo, float hi) { f32x2 v = {lo, hi}; bf16x2_t b = __builtin_convertvector(v, bf16x2_t); return __builtin_bit_cast(unsigned, b); }
DI bf16_t f2bf(float x) { return (bf16_t)(pk2(x, 0.f) & 0xffffu); }
DI float bf2f(bf16_t h) { return __uint_as_float(((unsigned)h) << 16); }
DI float bflo(unsigned u) { return __uint_as_float(u << 16); }
DI float bfhi(unsigned u) { return __uint_as_float(u & 0xffff0000u); }
DI int lane_id() { int x; asm volatile("v_mbcnt_lo_u32_b32 %0, -1, 0\n\tv_mbcnt_hi_u32_b32 %0, -1, %0" : "=v"(x)); return x; }
template <int M> DI int sx_i(int v) {
    if constexpr (M < 32) return __builtin_amdgcn_ds_swizzle(v, (M << 10) | 0x1f);
    else return __builtin_amdgcn_ds_bpermute((lane_id() ^ 32) << 2, v);
}
template <int M> DI float sx_f(float v) { return __int_as_float(sx_i<M>(__float_as_int(v))); }
DI float lane_get_f(float v, int src) { return __int_as_float(__builtin_amdgcn_ds_bpermute(src << 2, __float_as_int(v))); }
DI float wave_sum(float v) { v += sx_f<32>(v); v += sx_f<16>(v); v += sx_f<8>(v); v += sx_f<4>(v); v += sx_f<2>(v); v += sx_f<1>(v); return v; }
DI float wave_max(float v) { v = fmaxf(v, sx_f<32>(v)); v = fmaxf(v, sx_f<16>(v)); v = fmaxf(v, sx_f<8>(v)); v = fmaxf(v, sx_f<4>(v)); v = fmaxf(v, sx_f<2>(v)); v = fmaxf(v, sx_f<1>(v)); return v; }
DI float half_sum(float v) { v += sx_f<16>(v); v += sx_f<8>(v); v += sx_f<4>(v); v += sx_f<2>(v); v += sx_f<1>(v); return v; }
DI float sigmoidf_(float x) { return 1.f / (1.f + __expf(-x)); }
DI unsigned char* uniform_ptr(unsigned char* q) {
    const unsigned long long w = (unsigned long long)q;
    const unsigned lo = __builtin_amdgcn_readfirstlane((unsigned)w), hi = __builtin_amdgcn_readfirstlane((unsigned)(w >> 32));
    return (unsigned char*)(((unsigned long long)hi << 32) | lo);
}
DI int opqs(int x) { asm volatile("" : "+s"(x)); return x; }
DI int opq(int x) { asm volatile("" : "+v"(x)); return x; }

DI int swz(int row, int slot) { return row * 128 + ((slot ^ ((row >> 1) & 7)) << 4); }
DI int crow(int reg, int lane) { return (reg & 3) + 8 * (reg >> 2) + 4 * (lane >> 5); }

template <class P>
DI void gemm_tile(const P& pr, unsigned char* smem, int tid) {
    const int lane = tid & 63, wid = tid >> 6, wr = wid >> 1, wc = wid & 1;
    const bf16_t* abase = pr.a_base();
    const bf16_t* bbase = pr.b_base();
    const int kdim = pr.kt() * 64;
    int gao[4], gbo[4];
#pragma unroll
    for (int i = 0; i < 4; ++i) {
        const int row = (tid >> 3) + 32 * i, sl = (tid & 7) ^ ((row >> 1) & 7);
        const int o = pr.a_off(row);
        gao[i] = (o >= 0 ? o : 0) + sl * 8; gbo[i] = row * kdim + sl * 8;
    }
#define GLDS(buf, kt) do { _Pragma("unroll") for (int i = 0; i < 4; ++i) { \
        __builtin_amdgcn_global_load_lds((const unsigned*)(abase + gao[i] + (kt) * 64), (__attribute__((address_space(3))) unsigned*)(smem + (buf) * 32768 + (i * 256 + wid * 64) * 16), 16, 0, 0); \
        __builtin_amdgcn_global_load_lds((const unsigned*)(bbase + gbo[i] + (kt) * 64), (__attribute__((address_space(3))) unsigned*)(smem + (buf) * 32768 + 16384 + (i * 256 + wid * 64) * 16), 16, 0, 0); } } while (0)
#define DMA_WAIT_SYNC() do { asm volatile("s_waitcnt vmcnt(0)" ::: "memory"); __syncthreads(); } while (0)
#define COMPUTE(buf) do { const unsigned char* As = smem + (buf) * 32768; const unsigned char* Bs = As + 16384; \
        _Pragma("unroll") for (int ks = 0; ks < 4; ++ks) { const int slot = ks * 2 + (lane >> 5); \
            const bf16x8 a0 = *(const bf16x8*)(As + swz(wr * 64 + (lane & 31), slot)); const bf16x8 a1 = *(const bf16x8*)(As + swz(wr * 64 + 32 + (lane & 31), slot)); \
            const bf16x8 b0 = *(const bf16x8*)(Bs + swz(wc * 64 + (lane & 31), slot)); const bf16x8 b1 = *(const bf16x8*)(Bs + swz(wc * 64 + 32 + (lane & 31), slot)); \
            acc[0][0] = __builtin_amdgcn_mfma_f32_32x32x16_bf16(a0, b0, acc[0][0], 0, 0, 0); acc[0][1] = __builtin_amdgcn_mfma_f32_32x32x16_bf16(a0, b1, acc[0][1], 0, 0, 0); \
            acc[1][0] = __builtin_amdgcn_mfma_f32_32x32x16_bf16(a1, b0, acc[1][0], 0, 0, 0); acc[1][1] = __builtin_amdgcn_mfma_f32_32x32x16_bf16(a1, b1, acc[1][1], 0, 0, 0); } } while (0)
    f32x16 acc[2][2];
#pragma unroll
    for (int a = 0; a < 2; ++a)
#pragma unroll
        for (int b = 0; b < 2; ++b)
#pragma unroll
            for (int r = 0; r < 16; ++r) acc[a][b][r] = 0.f;
    const int KT = pr.kt();
    __syncthreads();
    GLDS(0, 0);
    DMA_WAIT_SYNC();
    for (int kt = 0; kt < KT; kt += 2) {
        GLDS(1, kt + 1);
        COMPUTE(0);
        DMA_WAIT_SYNC();
        if (kt + 2 < KT) GLDS(0, kt + 2);
        COMPUTE(1);
        DMA_WAIT_SYNC();
    }
#undef GLDS
#undef DMA_WAIT_SYNC
#undef COMPUTE
    pr.epi(acc, wr, wc, lane, smem + wid * 8192);
}

template <class P>
DI void convert_tile(const P& pr, bf16_t* dst, int kdim, int kt, unsigned char* smem, int tid) {
    unsigned char* Bs = smem;
    const int ng = tid & 31, kg = tid >> 5;
    int width = 0;
    const float* bp = pr.b_col(ng >> 3, width);
    const int cig = (ng & 7) * 4;
    const bool bvalid = cig < width;
    const int ldb = pr.ldb();
    bp += cig + (size_t)(kt * 64 + kg * 8) * ldb;
    f32x4 rb[8];
#pragma unroll
    for (int kk = 0; kk < 8; ++kk) rb[kk] = bvalid ? *(const f32x4*)(bp + (size_t)kk * ldb) : (f32x4){0.f, 0.f, 0.f, 0.f};
    __syncthreads();
#pragma unroll
    for (int j = 0; j < 4; ++j) {
        u32x4 v = {pk2(rb[0][j], rb[1][j]), pk2(rb[2][j], rb[3][j]), pk2(rb[4][j], rb[5][j]), pk2(rb[6][j], rb[7][j])};
        *(u32x4*)(Bs + swz(ng * 4 + j, kg)) = v;
    }
    __syncthreads();
#pragma unroll
    for (int i = 0; i < 4; ++i) {
        const int n = (tid >> 3) + 32 * i;
        *(u32x4*)(dst + (size_t)n * kdim + kt * 64 + (tid & 7) * 8) = *(const u32x4*)(Bs + swz(n, tid & 7));
    }
}

template <int NC> DI void stage_put(unsigned char* wl, int mi, int ni, int r, int lane, float v) { *(bf16_t*)(wl + ((mi * 32 + crow(r, lane)) * NC + ni * 32 + (lane & 31)) * 2) = f2bf(v); }
template <int NC, class RowPtr> DI void stage_flush(unsigned char* wl, int lane, RowPtr rp) {
    constexpr int CH = NC / 8, RPI = 64 / CH, NIT = 64 / RPI;
#pragma unroll
    for (int i = 0; i < NIT; ++i) {
        const int row = lane / CH + RPI * i, ch = lane % CH;
        const u32x4 d = *(const u32x4*)(wl + (row * NC + ch * 8) * 2);
        bf16_t* dst = rp(row);
        if (dst) *(u32x4*)(dst + ch * 8) = d;
    }
}

struct HybIn {
    const Params* p; int j, tm, tn;
    DI int kt() const { return 16; }
    DI int ldb() const { return HYB_IN; }
    DI const bf16_t* a_base() const { return (const bf16_t*)(p->ws + WS_H); }
    DI int a_off(int r) const { return (tm * 128 + r) * 1024; }
    DI static void pair_cols(int pr, int ni, int& base, int& width) {
        width = 32;
        if (pr < 8) base = 64 * pr + 32 * ni;
        else if (pr == 8) base = 512 + 32 * ni;
        else if (pr == 9) base = 576 + 32 * ni;
        else if (pr < 18) base = 640 + 64 * (pr - 10) + 32 * ni;
        else if (pr == 18) base = 1152 + 32 * ni;
        else if (pr == 19) { base = 1216; width = ni == 0 ? 8 : 0; }
        else if (pr < 28) base = 1224 + 64 * (pr - 20) + 32 * ni;
        else base = (ni == 0 ? 1736 : 2248) + 32 * (pr - 28);
    }
    DI const float* b_col(int g, int& width) const { int base; pair_cols(tn * 2 + (g >> 1), g & 1, base, width); return p->hy_w_in + (size_t)j * 1024 * HYB_IN + base; }
    DI const bf16_t* b_base() const { return (const bf16_t*)(p->ws + WS_WHYB) + (size_t)(j * 22 + tn) * 128 * 1024; }
    DI void epi(f32x16 (&acc)[2][2], int wr, int wc, int lane, unsigned char* wl) const {
        const int pr = tn * 2 + wc, c = lane & 31;
        const int t0 = tm * 128 + wr * 64;
        unsigned char* ws = p->ws;
        const float* ropec = (const float*)(ws + WS_ROPEC);
        const float* ropes = (const float*)(ws + WS_ROPES);
        if (pr < 9 || (pr >= 10 && pr < 19)) {
            const bool donorm = pr < 9;
            const float* gam = pr < 8 ? p->hy_q_norm + j * 64 : p->hy_k_norm + j * 64;
            bf16_t* ob; int ld, cb;
            if (pr < 8) { ob = (bf16_t*)(ws + WS_Q); ld = 512; cb = 64 * pr; }
            else if (pr == 8) { ob = (bf16_t*)(ws + WS_K); ld = 64; cb = 0; }
            else if (pr < 18) { ob = (bf16_t*)(ws + WS_IQ); ld = 512; cb = 64 * (pr - 10); }
            else { ob = (bf16_t*)(ws + WS_IK); ld = 64; cb = 0; }
            float g1 = 1.f, g2 = 1.f;
            if (donorm) { g1 = gam[c]; g2 = gam[c + 32]; }
#pragma unroll
            for (int mi = 0; mi < 2; ++mi)
#pragma unroll
                for (int r = 0; r < 16; ++r) {
                    float x1 = acc[mi][0][r], x2 = acc[mi][1][r];
                    const int t = t0 + mi * 32 + crow(r, lane), pos = t & (S - 1);
                    if (donorm) { float ss = half_sum(x1 * x1 + x2 * x2); float rstd = rsqrtf(ss * (1.f / 64.f) + EPS); x1 *= rstd * g1; x2 *= rstd * g2; }
                    const float cs = ropec[pos * 32 + c], sn = ropes[pos * 32 + c];
                    stage_put<64>(wl, mi, 0, r, lane, x1 * cs - x2 * sn);
                    stage_put<64>(wl, mi, 1, r, lane, x2 * cs + x1 * sn);
                }
            stage_flush<64>(wl, lane, [&](int row) { return ob + (size_t)(t0 + row) * ld + cb; });
        } else if (pr == 9) {
            bf16_t* ob = (bf16_t*)(ws + WS_V);
#pragma unroll
            for (int mi = 0; mi < 2; ++mi)
#pragma unroll
                for (int ni = 0; ni < 2; ++ni)
#pragma unroll
                    for (int g4 = 0; g4 < 4; ++g4) {
                        const int t = t0 + mi * 32 + 8 * g4 + 4 * (lane >> 5), pos = t & (S - 1), bb = t >> 11;
                        u32x2 o = {pk2(acc[mi][ni][4 * g4], acc[mi][ni][4 * g4 + 1]), pk2(acc[mi][ni][4 * g4 + 2], acc[mi][ni][4 * g4 + 3])};
                        *(u32x2*)(ob + ((size_t)(bb * 64 + ni * 32 + c)) * S + pos) = o;
                    }
        } else if (pr == 19) {
            float* ob = (float*)(ws + WS_IW);
            if (c < 8) {
#pragma unroll
                for (int mi = 0; mi < 2; ++mi)
#pragma unroll
                    for (int r = 0; r < 16; ++r) { const int t = t0 + mi * 32 + crow(r, lane); ob[(size_t)t * 8 + c] = acc[mi][0][r] * (0.125f * 0.35355339059327373f); }
            }
        } else if (pr < 28) {
            bf16_t* ob = (bf16_t*)(ws + WS_BG); const int cb = 64 * (pr - 20);
#pragma unroll
            for (int mi = 0; mi < 2; ++mi)
#pragma unroll
                for (int r = 0; r < 16; ++r) { stage_put<64>(wl, mi, 0, r, lane, acc[mi][0][r]); stage_put<64>(wl, mi, 1, r, lane, acc[mi][1][r]); }
            stage_flush<64>(wl, lane, [&](int row) { return ob + (size_t)(t0 + row) * 512 + cb; });
        } else {
            bf16_t* ob = (bf16_t*)(ws + WS_Z); const int cb = 32 * (pr - 28);
#pragma unroll
            for (int mi = 0; mi < 2; ++mi)
#pragma unroll
                for (int r = 0; r < 16; ++r) stage_put<32>(wl, mi, 0, r, lane, acc[mi][0][r] * acc[mi][1][r]);
            stage_flush<32>(wl, lane, [&](int row) { return ob + (size_t)(t0 + row) * 512 + cb; });
        }
    }
};


struct HybCols8 {
    const Params* p; int j, tm, tn;
    DI int ldb() const { return HYB_IN; }
    DI const float* b_col(int g, int& width) const {
        const int u = tn >> 1, bj = tn & 1; int base; width = 32;
        if (u < 2) base = 64 * (4 * u + g) + 32 * bj;
        else if (u < 4) base = 640 + 64 * (4 * (u - 2) + g) + 32 * bj;
        else if (u == 4) { if (g == 0) base = 512 + 32 * bj; else if (g == 1) base = 576 + 32 * bj; else if (g == 2) base = 1152 + 32 * bj; else { base = 1216; width = bj == 0 ? 8 : 0; } }
        else if (u < 7) base = 1224 + (u - 5) * 256 + 128 * bj + 32 * g;
        else base = (bj == 0 ? 1736 : 2248) + (u - 7) * 128 + 32 * g;
        return p->hy_w_in + (size_t)j * 1024 * HYB_IN + base;
    }
};

struct MlIn {
    const Params* p; int j, tm, tn;
    DI int kt() const { return 16; }
    DI int ldb() const { return ML_IN; }
    DI const bf16_t* a_base() const { return (const bf16_t*)(p->ws + WS_H); }
    DI int a_off(int r) const { return (tm * 128 + r) * 1024; }
    DI const float* b_col(int g, int& width) const {
        const int pr = tn * 2 + (g >> 1), ni = g & 1; int base; width = 32;
        if (pr < 32) base = 64 * pr + 32 * ni;
        else if (pr == 32) { base = 2048 + 8 * ni; width = 8; }
        else if (pr < 49) base = 2064 + 64 * (pr - 33) + 32 * ni;
        else { base = 0; width = 0; }
        return p->ml_w_in + (size_t)j * 1024 * ML_IN + base;
    }
    DI const bf16_t* b_base() const { return (const bf16_t*)(p->ws + WS_WML) + (size_t)(j * 25 + tn) * 128 * 1024; }
    DI void epi(f32x16 (&acc)[2][2], int wr, int wc, int lane, unsigned char* wl) const {
        const int pr = tn * 2 + wc, c = lane & 31;
        const int t0 = tm * 128 + wr * 64;
        unsigned char* ws = p->ws;
        if (pr < 16) {
            bf16_t* ob; int cb; float sc = 1.f;
            if (pr < 8) { ob = (bf16_t*)(ws + WS_MQ); cb = 64 * pr; sc = 0.125f; }
            else { ob = (bf16_t*)(ws + WS_MK); cb = 64 * (pr - 8); }
#pragma unroll
            for (int mi = 0; mi < 2; ++mi)
#pragma unroll
                for (int r = 0; r < 16; ++r) { stage_put<64>(wl, mi, 0, r, lane, acc[mi][0][r] * sc); stage_put<64>(wl, mi, 1, r, lane, acc[mi][1][r] * sc); }
            stage_flush<64>(wl, lane, [&](int row) { return ob + (size_t)(t0 + row) * 512 + cb; });
        }
        if (pr >= 8 && pr < 32) {
            bf16_t* ob; int nrow, hd, r0;
            if (pr < 16) { ob = (bf16_t*)(ws + WS_MKT); nrow = 64; hd = pr - 8; r0 = 0; }
            else { ob = (bf16_t*)(ws + WS_MV); nrow = 128; hd = (pr - 16) >> 1; r0 = 64 * ((pr - 16) & 1); }
#pragma unroll
            for (int mi = 0; mi < 2; ++mi)
#pragma unroll
                for (int ni = 0; ni < 2; ++ni)
#pragma unroll
                    for (int g4 = 0; g4 < 4; ++g4) {
                        const int t = t0 + mi * 32 + 8 * g4 + 4 * (lane >> 5), pos = t & (S - 1), bb = t >> 11;
                        u32x2 o = {pk2(acc[mi][ni][4 * g4], acc[mi][ni][4 * g4 + 1]), pk2(acc[mi][ni][4 * g4 + 2], acc[mi][ni][4 * g4 + 3])};
                        *(u32x2*)(ob + ((size_t)((bb * 8 + hd) * nrow + r0 + ni * 32 + c)) * S + pos) = o;
                    }
        } else if (pr == 32) {
            if (c < 8) {
                float* oi = (float*)(ws + WS_MIG); float* of = (float*)(ws + WS_MFG);
                const float bi = p->ml_b_gates[j * 16 + c], bfg = p->ml_b_gates[j * 16 + 8 + c];
#pragma unroll
                for (int mi = 0; mi < 2; ++mi)
#pragma unroll
                    for (int r = 0; r < 16; ++r) {
                        const int t = t0 + mi * 32 + crow(r, lane);
                        oi[(size_t)t * 8 + c] = acc[mi][0][r] + bi;
                        const float f = acc[mi][1][r] + bfg;
                        of[(size_t)t * 8 + c] = fminf(f, 0.f) - log1pf(__expf(-fabsf(f)));
                    }
            }
        } else if (pr >= 33 && pr < 49) {
            bf16_t* ob = (bf16_t*)(ws + WS_MOG); const int cb = 64 * (pr - 33);
#pragma unroll
            for (int mi = 0; mi < 2; ++mi)
#pragma unroll
                for (int r = 0; r < 16; ++r) { stage_put<64>(wl, mi, 0, r, lane, sigmoidf_(acc[mi][0][r])); stage_put<64>(wl, mi, 1, r, lane, sigmoidf_(acc[mi][1][r])); }
            stage_flush<64>(wl, lane, [&](int row) { return ob + (size_t)(t0 + row) * 1024 + cb; });
        }
    }
};


struct MlCols8 {
    const Params* p; int j, tm, tn;
    DI int ldb() const { return ML_IN; }
    DI const float* b_col(int g, int& width) const {
        const int u = tn >> 1, bj = tn & 1; int base; width = 32;
        if (tn == 24) { base = 2048 + 8 * (g & 1); width = g < 2 ? 8 : 0; }
        else if (u < 2) base = 64 * (4 * u + g) + 32 * bj;
        else if (u < 4) base = 512 + 64 * (4 * (u - 2) + g) + 32 * bj;
        else if (u < 8) base = 1024 + (2 * (u - 4) + bj) * 128 + 32 * g;
        else base = 2064 + (u - 8) * 256 + 128 * bj + 32 * g;
        return p->ml_w_in + (size_t)j * 1024 * ML_IN + base;
    }
};
struct MlGates {
    const Params* p; int j, tm;
    DI int kt() const { return 16; }
    DI const bf16_t* a_base() const { return (const bf16_t*)(p->ws + WS_H); }
    DI int a_off(int r) const { return (tm * 128 + r) * 1024; }
    DI const bf16_t* b_base() const { return (const bf16_t*)(p->ws + WS_WML) + (size_t)(j * 25 + 24) * 128 * 1024; }
    DI void epi(f32x16 (&acc)[2][2], int wr, int wc, int lane, unsigned char* wl) const {
        const int c = lane & 31, t0 = tm * 128 + wr * 64;
        if (wc == 0 && c < 8) {
            float* oi = (float*)(p->ws + WS_MIG); float* of = (float*)(p->ws + WS_MFG);
            const float bi = p->ml_b_gates[j * 16 + c], bfg = p->ml_b_gates[j * 16 + 8 + c];
#pragma unroll
            for (int mi = 0; mi < 2; ++mi)
#pragma unroll
                for (int r = 0; r < 16; ++r) {
                    const int t = t0 + mi * 32 + crow(r, lane);
                    oi[(size_t)t * 8 + c] = acc[mi][0][r] + bi;
                    const float f = acc[mi][1][r] + bfg;
                    of[(size_t)t * 8 + c] = fminf(f, 0.f) - log1pf(__expf(-fabsf(f)));
                }
        }
    }
};

struct OutProj {
    const Params* p; const float* W; const float* src; int layer, tm, tn;
    DI int kt() const { return 16; }
    DI int ldb() const { return 1024; }
    DI const bf16_t* a_base() const { return (const bf16_t*)(p->ws + WS_YMIX); }
    DI int a_off(int r) const { return (tm * 128 + r) * 1024; }
    DI const float* b_col(int g, int& width) const { width = 32; return W + tn * 128 + g * 32; }
    DI const bf16_t* b_base() const { return (const bf16_t*)(p->ws + WS_WOUT) + (size_t)(layer * 8 + tn) * 128 * 1024; }
    DI void epi(f32x16 (&acc)[2][2], int wr, int wc, int lane, unsigned char* wl) const {
        const int c = lane & 31, t0 = tm * 128 + wr * 64, wid = wr * 2 + wc;
        float* fl = (float*)(wl + wid * 8192);
#pragma unroll
        for (int mi = 0; mi < 2; ++mi)
#pragma unroll
            for (int ni = 0; ni < 2; ++ni)
#pragma unroll
                for (int r = 0; r < 16; ++r) fl[(mi * 32 + crow(r, lane)) * 64 + ni * 32 + c] = acc[mi][ni][r];
        const float* mod = (const float*)(p->ws + WS_MOD) + (size_t)layer * 8 * 6144;
        const int ch = lane & 15, n = tn * 128 + wc * 64 + ch * 4;
        const f32x4 g = *(const f32x4*)(mod + (t0 >> 11) * 6144 + 2048 + n);
        float* part = (float*)(p->ws + WS_PART);
#pragma unroll 4
        for (int i = 0; i < 16; ++i) {
            const int row = (lane >> 4) + 4 * i, t = t0 + row;
            const f32x4 a = *(const f32x4*)(fl + row * 64 + ch * 4);
            const f32x4 o = *(const f32x4*)(src + (size_t)t * 1024 + n) + g * a;
            *(f32x4*)(p->out + (size_t)t * 1024 + n) = o;
            float ss = o[0] * o[0] + o[1] * o[1] + o[2] * o[2] + o[3] * o[3];
            ss += sx_f<1>(ss); ss += sx_f<2>(ss); ss += sx_f<4>(ss); ss += sx_f<8>(ss);
            if (ch == 0) part[(size_t)t * 16 + tn * 2 + wc] = ss;
        }
    }
};

struct Moe1 {
    const Params* p; int layer, e, mt, nt, cnt, roff;
    DI int kt() const { return 16; }
    DI int ldb() const { return DEXP; }
    DI const bf16_t* a_base() const { return (const bf16_t*)(p->ws + WS_H); }
    DI int a_off(int r) const {
        const int rr = mt * 128 + r; if (rr >= cnt) return -1;
        const int a = ((const int*)(p->ws + WS_ELIST))[(size_t)e * NASG + rr];
        return (a >> 1) * 1024;
    }
    DI const float* b_col(int g, int& width) const {
        width = 32;
        const float* base = (nt & 1) ? p->moe_w_up : p->moe_w_gate;
        return base + ((size_t)layer * NEXP + e) * (size_t)(D * DEXP) + 128 * (nt >> 1) + 32 * g;
    }
    DI const bf16_t* b_base() const { return (const bf16_t*)(p->ws + WS_WM1) + (size_t)((layer * NEXP + e) * 8 + nt) * 128 * 1024; }
    DI void epi(f32x16 (&acc)[2][2], int wr, int wc, int lane, unsigned char* wl) const {
        const int c = lane & 31, pr = nt * 2 + wc;
        bf16_t* ob = (bf16_t*)(p->ws + WS_H1);
#pragma unroll
        for (int mi = 0; mi < 2; ++mi)
#pragma unroll
            for (int r = 0; r < 16; ++r) {
                const float g = acc[mi][0][r], u = acc[mi][1][r];
                stage_put<32>(wl, mi, 0, r, lane, g / (1.f + __expf(-g)) * u);
            }
        const int rb = mt * 128 + wr * 64;
        stage_flush<32>(wl, lane, [&](int row) { return rb + row < cnt ? ob + (size_t)(roff + rb + row) * 512 + 32 * pr : (bf16_t*)nullptr; });
    }
};

struct Moe2 {
    const Params* p; int layer, e, mt, nt, cnt, roff;
    DI int kt() const { return 8; }
    DI int ldb() const { return D; }
    DI const bf16_t* a_base() const { return (const bf16_t*)(p->ws + WS_H1); }
    DI int a_off(int r) const { const int rr = mt * 128 + r; if (rr >= cnt) return -1; return (roff + rr) * 512; }
    DI const float* b_col(int g, int& width) const { width = 32; return p->moe_w_down + ((size_t)layer * NEXP + e) * (size_t)(DEXP * D) + nt * 128 + g * 32; }
    DI const bf16_t* b_base() const { return (const bf16_t*)(p->ws + WS_WM2) + (size_t)((layer * NEXP + e) * 8 + nt) * 128 * 512; }
    DI void epi(f32x16 (&acc)[2][2], int wr, int wc, int lane, unsigned char* wl) const {
        const int c = lane & 31;
        bf16_t* ob = (bf16_t*)(p->ws + WS_Y);
        const int* el = (const int*)(p->ws + WS_ELIST) + (size_t)e * NASG;
#pragma unroll
        for (int mi = 0; mi < 2; ++mi)
#pragma unroll
            for (int r = 0; r < 16; ++r) { stage_put<64>(wl, mi, 0, r, lane, acc[mi][0][r]); stage_put<64>(wl, mi, 1, r, lane, acc[mi][1][r]); }
        const int rb = mt * 128 + wr * 64;
        stage_flush<64>(wl, lane, [&](int row) { return rb + row < cnt ? ob + (size_t)el[rb + row] * 1024 + nt * 128 + wc * 64 : (bf16_t*)nullptr; });
    }
};

DI void convert_moe_layers(const Params& p, int l0, int l1, unsigned char* smem, int bid, int nb, int tid) {
    const int PER = 32 * 8 * 16 + 32 * 8 * 8, total = (l1 - l0) * PER;
    for (int item = bid; item < total; item += nb) {
        const int l = l0 + item / PER; int ci = item % PER;
        if (ci < 4096) { const int kt = ci & 15, nt = (ci >> 4) & 7, e = ci >> 7; Moe1 pr{&p, l, e, 0, nt, 0, 0}; convert_tile(pr, (bf16_t*)(p.ws + WS_WM1) + (size_t)((l * 32 + e) * 8 + nt) * 128 * 1024, 1024, kt, smem, tid); }
        else { ci -= 4096; const int kt = ci & 7, nt = (ci >> 3) & 7, e = ci >> 6; Moe2 pr{&p, l, e, 0, nt, 0, 0}; convert_tile(pr, (bf16_t*)(p.ws + WS_WM2) + (size_t)((l * 32 + e) * 8 + nt) * 128 * 512, 512, kt, smem, tid); }
    }
    __syncthreads();
}

DI void phase_init(const Params& p, unsigned char* smem, int bid, int nb, int tid) {
    float* sc = (float*)smem;
    float* red = (float*)(smem + 32768);
    const int NMOD = DEPTH * 96, NROPE = 256;
    const int C_HYB = 2 * 22 * 16, C_ML = 2 * 25 * 16, C_OUT = 4 * 8 * 16;
    for (int ci = bid; ci < C_HYB + C_ML + C_OUT; ci += nb) {
        int c2 = ci;
        if (c2 < C_HYB) { const int kt = c2 & 15, tn = (c2 >> 4) % 22, j = (c2 >> 4) / 22; HybCols8 pr{&p, j, 0, tn}; convert_tile(pr, (bf16_t*)(p.ws + WS_WHYB) + (size_t)(j * 22 + tn) * 128 * 1024, 1024, kt, smem, tid); continue; }
        c2 -= C_HYB;
        if (c2 < C_ML) { const int kt = c2 & 15, tn = (c2 >> 4) % 25, j = (c2 >> 4) / 25; MlCols8 pr{&p, j, 0, tn}; convert_tile(pr, (bf16_t*)(p.ws + WS_WML) + (size_t)(j * 25 + tn) * 128 * 1024, 1024, kt, smem, tid); continue; }
        c2 -= C_ML;
        { const int kt = c2 & 15, tn = (c2 >> 4) & 7, l = c2 >> 7; const float* W = ((l & 1) ? p.ml_w_out : p.hy_w_out) + (size_t)(l >> 1) * 1024 * 1024;
            OutProj pr{&p, W, nullptr, l, 0, tn}; convert_tile(pr, (bf16_t*)(p.ws + WS_WOUT) + (size_t)(l * 8 + tn) * 128 * 1024, 1024, kt, smem, tid); }
    }
    for (int item = bid; item < NMOD; item += nb) {
        __syncthreads();
        for (int i = tid; i < 8 * 1024; i += 256) { const float v = p.c[i]; sc[i] = v / (1.f + __expf(-v)); }
        __syncthreads();
        const int l = item / 96, jb = item % 96, cq = tid & 15, ksl = tid >> 4;
        const float* w = p.ada_w + (size_t)l * 1024 * 6144 + jb * 64 + cq * 4;
        f32x4 acc[8];
#pragma unroll
        for (int b = 0; b < 8; ++b) acc[b] = (f32x4){0.f, 0.f, 0.f, 0.f};
        for (int ii = 0; ii < 64; ++ii) {
            const int i = ksl * 64 + ii;
            const f32x4 wv = *(const f32x4*)(w + (size_t)i * 6144);
#pragma unroll
            for (int b = 0; b < 8; ++b) acc[b] += wv * sc[b * 1024 + i];
        }
#pragma unroll
        for (int b = 0; b < 8; ++b) *(f32x4*)(red + (ksl * 8 + b) * 64 + cq * 4) = acc[b];
        __syncthreads();
        for (int o = tid; o < 512; o += 256) {
            const int b = o >> 6, cc = o & 63; float s = 0.f;
            for (int k = 0; k < 16; ++k) s += red[(k * 8 + b) * 64 + cc];
            ((float*)(p.ws + WS_MOD))[((size_t)l * 8 + b) * 6144 + jb * 64 + cc] = s + p.ada_b[l * 6144 + jb * 64 + cc];
        }
    }
    for (int item = bid; item < NROPE + 1; item += nb) {
        if (item < NROPE) {
            const int idx = item * 256 + tid;
            const int pos = idx >> 5, i = idx & 31;
            const float inv = 1.0f / powf(10000.0f, (float)(2 * i) / 64.0f);
            const float ang = (float)pos * inv;
            ((float*)(p.ws + WS_ROPEC))[idx] = cosf(ang);
            ((float*)(p.ws + WS_ROPES))[idx] = sinf(ang);
        } else {
            if (tid < DEPTH * 32) ((int*)(p.ws + WS_ECNT))[tid * ECS] = 0;
        }
    }
    __syncthreads();
    convert_moe_layers(p, 0, 1, smem, bid, nb, tid);
}

DI void phase_norm(const Params& p, int layer, const float* src, int bid, int nb, int tid) {
    const int lane = tid & 63, wid = tid >> 6;
    const float* mod = (const float*)(p.ws + WS_MOD) + (size_t)layer * 8 * 6144;
    const float* gam = p.norm_mix + layer * 1024;
    bf16_t* H = (bf16_t*)(p.ws + WS_H);
    for (int item = bid; item < T / 4; item += nb) {
        const int t = item * 4 + wid, b = t >> 11;
        const float* xr = src + (size_t)t * 1024;
        f32x4 v[4]; float ss = 0.f;
#pragma unroll
        for (int i = 0; i < 4; ++i) { v[i] = *(const f32x4*)(xr + (lane + 64 * i) * 4); ss += v[i][0] * v[i][0] + v[i][1] * v[i][1] + v[i][2] * v[i][2] + v[i][3] * v[i][3]; }
        ss = wave_sum(ss);
        const float rstd = rsqrtf(ss * (1.f / 1024.f) + EPS);
#pragma unroll
        for (int i = 0; i < 4; ++i) {
            const int c0 = (lane + 64 * i) * 4;
            const f32x4 g = *(const f32x4*)(gam + c0), sh = *(const f32x4*)(mod + b * 6144 + c0), sc = *(const f32x4*)(mod + b * 6144 + 1024 + c0);
            f32x4 h = v[i] * rstd * g * (sc + 1.f) + sh;
            u32x2 o = {pk2(h[0], h[1]), pk2(h[2], h[3])};
            *(u32x2*)(H + (size_t)t * 1024 + c0) = o;
        }
    }
}

DI void phase_ffn_norm_router(const Params& p, int layer, unsigned char* smem, int bid, int nb, int tid) {
    float* rstd_s = (float*)smem;
    float* lg = (float*)(smem + 512);
    float* hs = (float*)(smem + 512 + 32 * 37 * 4);
    float* wcs = (float*)(smem + 5248 + 2 * 32 * 65 * 4);
    float* part = (float*)(smem + 42368);
    float* gpart = (float*)(smem + 59264);
    const int lane = tid & 63, og = __builtin_amdgcn_readfirstlane(tid >> 6), tok = lane & 31, kh = lane >> 5;
    const float* mod = (const float*)(p.ws + WS_MOD) + (size_t)layer * 8 * 6144;
    const float* gam = p.norm_ffn + layer * 1024;
    const float* wg = p.moe_w_group + (size_t)layer * 1024 * 4;
    const float* we = p.moe_w_expert + (size_t)layer * 1024 * 32;
    bf16_t* H = (bf16_t*)(p.ws + WS_H);
    int* ecnt = (int*)(p.ws + WS_ECNT) + layer * 32 * ECS;
    int* elist = (int*)(p.ws + WS_ELIST);
    float* ew = (float*)(p.ws + WS_EW);
    for (int item = bid; item < T / 32; item += nb) {
        const int t0 = item * 32, b = t0 >> 11;
        __syncthreads();
        if (tid < 32) {
            const f32x4* pp = (const f32x4*)((const float*)(p.ws + WS_PART) + (size_t)(t0 + tid) * 16);
            const f32x4 a = pp[0], b4 = pp[1], c4 = pp[2], d4 = pp[3];
            const float ss = ((a[0] + a[1]) + (a[2] + a[3])) + ((b4[0] + b4[1]) + (b4[2] + b4[3])) + ((c4[0] + c4[1]) + (c4[2] + c4[3])) + ((d4[0] + d4[1]) + (d4[2] + d4[3]));
            rstd_s[tid] = rsqrtf(ss * (1.f / 1024.f) + EPS);
        }
        const int stok = tid >> 3, sk0 = (tid & 7) * 8;
        const float* xrow = p.out + (size_t)(t0 + stok) * 1024 + sk0;
        const float* mrow = mod + b * 6144 + sk0;
        f32x4 xa[2], ga[2], sha[2], sca[2], wa[3], xb[2], gb2[2], shb[2], scb[2], wb2[3];
#define FFN_LOAD(xv, gv, shv, scv, wv, k0) do { _Pragma("unroll") for (int q = 0; q < 2; ++q) { xv[q] = *(const f32x4*)(xrow + (k0) + 4 * q); gv[q] = *(const f32x4*)(gam + sk0 + (k0) + 4 * q); \
            shv[q] = *(const f32x4*)(mrow + 3072 + (k0) + 4 * q); scv[q] = *(const f32x4*)(mrow + 4096 + (k0) + 4 * q); } \
            wv[0] = *(const f32x4*)(we + (k0) * 32 + tid * 4); wv[1] = *(const f32x4*)(we + (k0) * 32 + 1024 + tid * 4); wv[2] = *(const f32x4*)(wg + (k0) * 4 + (tid & 63) * 4); } while (0)
#define FFN_STEP(xv, gv, shv, scv, wv, kc) do { const int k0 = (kc) * 64; float* hb = hs + ((kc) & 1) * (32 * 65); float* wb = wcs + ((kc) & 1) * (64 * 40); u32x4 ho; \
            _Pragma("unroll") for (int q = 0; q < 2; ++q) { const f32x4 h = xv[q] * srstd * gv[q] * (scv[q] + 1.f) + shv[q]; ho[2 * q] = pk2(h[0], h[1]); ho[2 * q + 1] = pk2(h[2], h[3]); \
                float* hp = hb + stok * 65 + sk0 + 4 * q; hp[0] = h[0]; hp[1] = h[1]; hp[2] = h[2]; hp[3] = h[3]; } \
            *(u32x4*)(H + (size_t)(t0 + stok) * 1024 + k0 + sk0) = ho; \
            *(f32x4*)(wb + (tid >> 3) * 40 + 4 + (tid & 7) * 4) = wv[0]; *(f32x4*)(wb + (32 + (tid >> 3)) * 40 + 4 + (tid & 7) * 4) = wv[1]; if (tid < 64) *(f32x4*)(wb + tid * 40) = wv[2]; \
            if ((kc) + 2 < 16) FFN_LOAD(xv, gv, shv, scv, wv, k0 + 128); \
            __syncthreads(); \
            { const float* ha = hb + tok * 65 + og * 16 + kh; const float* wbp = wb + (og * 16 + kh) * 40 + 4 + tok; float av[8], bv[8]; \
              _Pragma("unroll") for (int m = 0; m < 8; ++m) { av[m] = ha[2 * m]; bv[m] = wbp[2 * m * 40]; } \
              const float* hg = hb + tok * 65 + og * 16 + kh * 8; const float* wgp = wb + (og * 16 + kh * 8) * 40; \
              _Pragma("unroll") for (int i = 0; i < 8; ++i) { const float hv = hg[i]; gacc += *(const f32x4*)(wgp + i * 40) * hv; } \
              _Pragma("unroll") for (int m = 0; m < 8; ++m) eacc = __builtin_amdgcn_mfma_f32_32x32x2f32(av[m], bv[m], eacc, 0, 0, 0); } } while (0)
        FFN_LOAD(xa, ga, sha, sca, wa, 0);
        FFN_LOAD(xb, gb2, shb, scb, wb2, 64);
        __syncthreads();
        const float srstd = rstd_s[stok];
        f32x16 eacc; f32x4 gacc = {0.f, 0.f, 0.f, 0.f};
#pragma unroll
        for (int r = 0; r < 16; ++r) eacc[r] = 0.f;
        for (int kc = 0; kc < 16; kc += 2) {
            FFN_STEP(xa, ga, sha, sca, wa, kc);
            FFN_STEP(xb, gb2, shb, scb, wb2, kc + 1);
        }
#undef FFN_STEP
#undef FFN_LOAD
#pragma unroll
        for (int r = 0; r < 16; ++r) part[(og * 32 + crow(r, lane)) * 33 + tok] = eacc[r];
#pragma unroll
        for (int e = 0; e < 4; ++e) { const float v = gacc[e] + sx_f<32>(gacc[e]); if (kh == 0) gpart[(og * 32 + tok) * 4 + e] = v; }
        __syncthreads();
        { const int tk = tid >> 3, c4 = (tid & 7) * 4;
#pragma unroll
          for (int e = 0; e < 4; ++e) lg[tk * 37 + 4 + c4 + e] = (part[tk * 33 + c4 + e] + part[(32 + tk) * 33 + c4 + e]) + (part[(64 + tk) * 33 + c4 + e] + part[(96 + tk) * 33 + c4 + e]);
          if (tid < 128) lg[(tid >> 2) * 37 + (tid & 3)] = (gpart[tid] + gpart[128 + tid]) + (gpart[256 + tid] + gpart[384 + tid]); }
        __syncthreads();
        if (tid < 32) {
            const int t = t0 + tid;
            float gl[4]; float gmax = -INFINITY; int gsel = 0;
#pragma unroll
            for (int g = 0; g < 4; ++g) { gl[g] = lg[tid * 37 + g] + p.moe_b_group[layer * 4 + g]; if (gl[g] > gmax) { gmax = gl[g]; gsel = g; } }
            float gsum = 0.f;
#pragma unroll
            for (int g = 0; g < 4; ++g) gsum += __expf(gl[g] - gmax);
            const float pg = 1.f / gsum;
            float v1 = -INFINITY, v2 = -INFINITY; int i1 = 0, i2 = 0;
            for (int jx = 0; jx < 8; ++jx) {
                const float v = lg[tid * 37 + 4 + gsel * 8 + jx] + p.moe_b_expert[layer * 32 + gsel * 8 + jx];
                if (v > v1) { v2 = v1; i2 = i1; v1 = v; i1 = jx; } else if (v > v2) { v2 = v; i2 = jx; }
            }
            const float e2 = __expf(v2 - v1), den = 1.f / (1.f + e2);
            const float w1 = pg * den, w2 = pg * e2 * den;
            const int ea = gsel * 8 + i1, eb = gsel * 8 + i2;
            int* cl = (int*)rstd_s + 32;
            cl[tid] = 0;
            const int la = atomicAdd(&cl[ea], 1);
            const int lb = atomicAdd(&cl[eb], 1);
            { const int n = cl[tid]; cl[32 + tid] = n > 0 ? atomicAdd(&ecnt[tid * ECS], n) : 0; }
            const int ra = cl[32 + ea] + la, rb = cl[32 + eb] + lb;
            elist[(size_t)ea * NASG + ra] = t * 2; ew[t * 2] = w1;
            elist[(size_t)eb * NASG + rb] = t * 2 + 1; ew[t * 2 + 1] = w2;
        }
    }
}

DI bool dense_item(int i, int NT, int xcd, int& tm, int& tn) {
    if (i >= 16 * NT) return false;
    const int mg = i / (8 * NT), r = i % (8 * NT);
    tn = r >> 3; tm = xcd * 16 + mg * 8 + (r & 7);
    return true;
}
template <class PR> DI void phase_hyb_in(const Params& p, int j, unsigned char* smem, int xcd, int lb, int nlb, int tid) {
    int tm, tn;
    for (int i = lb; dense_item(i, 22, xcd, tm, tn); i += nlb) { HybIn pr{&p, j, tm, tn}; gemm_tile(pr, smem, opq(tid)); }
}
DI void phase_ml_in(const Params& p, int j, unsigned char* smem, int xcd, int lb, int nlb, int tid) {
    int tm, tn;
    for (int i = lb; dense_item(i, 25, xcd, tm, tn); i += nlb) { MlIn pr{&p, j, tm, tn}; gemm_tile(pr, smem, opq(tid)); }
}
DI void phase_out_proj(const Params& p, int layer, const float* W, const float* src, unsigned char* smem, int xcd, int lb, int nlb, int tid) {
    int tm, tn;
    for (int i = lb; dense_item(i, 8, xcd, tm, tn); i += nlb) { OutProj pr{&p, W, src, layer, tm, tn}; gemm_tile(pr, smem, opq(tid)); }
}
template <int WHICH> DI void phase_moe(const Params& p, int layer, unsigned char* smem, int xcd, int lb, int nlb, int tid) {
    int* toff = (int*)(smem + 65600);
    __syncthreads();
    if (tid == 0) {
        const int* ecnt = (const int*)(p.ws + WS_ECNT) + layer * 32 * ECS;
        int ta = 0, ra = 0;
        for (int e = 0; e < 32; ++e) {
            const int c = ecnt[e * ECS];
            if ((e & 7) == xcd) { const int q = e >> 3; toff[q] = ta; toff[8 + q] = ra; toff[16 + q] = c; ta += (c + 127) >> 7; }
            ra += c;
        }
        toff[4] = ta;
    }
    __syncthreads();
    const int total = toff[4] * 8;
    for (int item = lb; item < total; item += nlb) {
        const int mg = item >> 3, nt = item & 7;
        int q = 0;
        while (q < 3 && toff[q + 1] <= mg) ++q;
        const int e = q * 8 + xcd, cnt = toff[16 + q], roff = toff[8 + q];
        if (WHICH == 1) { Moe1 pr{&p, layer, e, mg - toff[q], nt, cnt, roff}; gemm_tile(pr, smem, opq(tid)); }
        else { Moe2 pr{&p, layer, e, mg - toff[q], nt, cnt, roff}; gemm_tile(pr, smem, opq(tid)); }
    }
}

DI void phase_combine_norm(const Params& p, int layer, int bid, int nb, int tid) {
    const int lane = tid & 63, wid = tid >> 6;
    const float* mod = (const float*)(p.ws + WS_MOD) + (size_t)layer * 8 * 6144;
    const float* modn = mod + 8 * 6144;
    const float* gam = p.norm_mix + (layer + 1) * 1024;
    const bf16_t* Y = (const bf16_t*)(p.ws + WS_Y);
    const float* ew = (const float*)(p.ws + WS_EW);
    bf16_t* H = (bf16_t*)(p.ws + WS_H);
    const bool has_next = layer + 1 < DEPTH;
    for (int item = bid; item < T / 4; item += nb) {
        const int t = item * 4 + wid, b = t >> 11;
        const float w0 = ew[2 * t], w1 = ew[2 * t + 1];
        f32x4 v[4]; float ss = 0.f;
#pragma unroll
        for (int i = 0; i < 4; ++i) {
            const int c0 = (lane + 64 * i) * 4;
            v[i] = *(const f32x4*)(p.out + (size_t)t * 1024 + c0);
            const f32x4 g = *(const f32x4*)(mod + b * 6144 + 5120 + c0);
            const u32x2 y0 = *(const u32x2*)(Y + (size_t)(2 * t) * 1024 + c0), y1 = *(const u32x2*)(Y + (size_t)(2 * t + 1) * 1024 + c0);
            v[i][0] += g[0] * (w0 * bflo(y0[0]) + w1 * bflo(y1[0])); v[i][1] += g[1] * (w0 * bfhi(y0[0]) + w1 * bfhi(y1[0]));
            v[i][2] += g[2] * (w0 * bflo(y0[1]) + w1 * bflo(y1[1])); v[i][3] += g[3] * (w0 * bfhi(y0[1]) + w1 * bfhi(y1[1]));
            *(f32x4*)(p.out + (size_t)t * 1024 + c0) = v[i];
            ss += v[i][0] * v[i][0] + v[i][1] * v[i][1] + v[i][2] * v[i][2] + v[i][3] * v[i][3];
        }
        if (has_next) {
            ss = wave_sum(ss);
            const float rstd = rsqrtf(ss * (1.f / 1024.f) + EPS);
#pragma unroll
            for (int i = 0; i < 4; ++i) {
                const int c0 = (lane + 64 * i) * 4;
                const f32x4 g = *(const f32x4*)(gam + c0), sh = *(const f32x4*)(modn + b * 6144 + c0), sc = *(const f32x4*)(modn + b * 6144 + 1024 + c0);
                const f32x4 h = v[i] * rstd * g * (sc + 1.f) + sh;
                u32x2 o = {pk2(h[0], h[1]), pk2(h[2], h[3])};
                *(u32x2*)(H + (size_t)t * 1024 + c0) = o;
            }
        }
    }
}

DI unsigned sortable(float f) { const unsigned u = __float_as_uint(f); return (u & 0x80000000u) ? ~u : (u | 0x80000000u); }
DI int half_sum_i(int v) { v += sx_i<16>(v); v += sx_i<8>(v); v += sx_i<4>(v); v += sx_i<2>(v); v += sx_i<1>(v); return v; }

struct CvTask { const float* src; bf16_t* dst; int ldb, kdim; };
DI CvTask cv_task(const Params& p, int l0, int id) {
    const int PER = 32 * 8 * 16 * 4 + 32 * 8 * 8 * 4;
    const int l = l0 + id / PER; int ci = id % PER; CvTask t;
    if (ci < 16384) {
        const int g = ci & 3, kt = (ci >> 2) & 15, nt = (ci >> 6) & 7, e = ci >> 9; int w;
        Moe1 pr{&p, l, e, 0, nt, 0, 0};
        t.ldb = DEXP; t.kdim = 1024; t.src = pr.b_col(g, w) + (size_t)(kt * 64) * DEXP;
        t.dst = (bf16_t*)(p.ws + WS_WM1) + ((size_t)((l * 32 + e) * 8 + nt) * 128 + g * 32) * 1024 + kt * 64;
    } else {
        ci -= 16384;
        const int g = ci & 3, kt = (ci >> 2) & 7, nt = (ci >> 5) & 7, e = ci >> 8; int w;
        Moe2 pr{&p, l, e, 0, nt, 0, 0};
        t.ldb = D; t.kdim = 512; t.src = pr.b_col(g, w) + (size_t)(kt * 64) * D;
        t.dst = (bf16_t*)(p.ws + WS_WM2) + ((size_t)((l * 32 + e) * 8 + nt) * 128 + g * 32) * 512 + kt * 64;
    }
    return t;
}
DI void cv_issue(const CvTask& t, int lane, f32x4 (&rb)[8]) {
    const float* s = t.src + (size_t)((lane >> 3) * 8) * t.ldb + (lane & 7) * 4;
#pragma unroll
    for (int kk = 0; kk < 8; ++kk) rb[kk] = *(const f32x4*)(s + (size_t)kk * t.ldb);
}
DI void cv_finish(const CvTask& t, int lane, const f32x4 (&rb)[8]) {
    bf16_t* d = t.dst + (size_t)((lane & 7) * 4) * t.kdim + (lane >> 3) * 8;
#pragma unroll
    for (int jx = 0; jx < 4; ++jx) {
        u32x4 v = {pk2(rb[0][jx], rb[1][jx]), pk2(rb[2][jx], rb[3][jx]), pk2(rb[4][jx], rb[5][jx]), pk2(rb[6][jx], rb[7][jx])};
        *(u32x4*)(d + (size_t)jx * t.kdim) = v;
    }
}
DI void convert_moe_waves(const Params& p, int l0, int l1, int gwave, int nwaves, int lane) {
    const int total = (l1 - l0) * 24576;
    for (int id = gwave; id < total; id += 2 * nwaves) {
        f32x4 ra[8], rb[8];
        const CvTask t0 = cv_task(p, l0, id);
        cv_issue(t0, lane, ra);
        const bool two = id + nwaves < total;
        if (two) { const CvTask t1 = cv_task(p, l0, id + nwaves); cv_issue(t1, lane, rb); cv_finish(t0, lane, ra); cv_finish(t1, lane, rb); }
        else cv_finish(t0, lane, ra);
    }
}

DI void phase_dsa(const Params& p, int j, unsigned char* smem, int bid, int nb, int tid, int cv0 = 0, int cv1 = 0) {
    if (cv1 > cv0 && (bid & 1)) convert_moe_waves(p, cv0, cv1, bid * 4 + (tid >> 6), nb * 4, tid & 63);
    const int lane = tid & 63, wid = tid >> 6, c = lane & 31, hh = lane >> 5;
    unsigned* mw = (unsigned*)smem + wid * 256;
    const bf16_t* IQ = (const bf16_t*)(p.ws + WS_IQ);
    const bf16_t* IK = (const bf16_t*)(p.ws + WS_IK);
    const float* IW = (const float*)(p.ws + WS_IW);
    const bf16_t* Q = (const bf16_t*)(p.ws + WS_Q);
    const bf16_t* K = (const bf16_t*)(p.ws + WS_K);
    const bf16_t* VT = (const bf16_t*)(p.ws + WS_V);
    bf16_t* Y = (bf16_t*)(p.ws + WS_YMIX);
    const float gq = wave_max(fabsf(p.hy_q_norm[j * 64 + lane])), gk = wave_max(fabsf(p.hy_k_norm[j * 64 + lane]));
    const float LOG2E = 1.4426950408889634f;
    const float c1 = 0.125f * LOG2E, c2 = 8.f * gq * gk * LOG2E;
    const unsigned lt = (1u << c) - 1u;
    for (int it = bid, rnd = 0; it < 1024; it += nb, ++rnd) {
        const int item = (rnd & 1) ? (rnd + 1) * nb - 1 - bid : it;
        if (item >= 1024) continue;
        const int qt = 127 - (item >> 3), b = item & 7;
        const int pos0 = qt * 16 + 4 * wid;
        const size_t tb = (size_t)b * S, t0 = tb + pos0;
        const int tmax = (pos0 + 3) >> 5;
        if (pos0 >= 256) {
            bf16x8 iqf[4];
            {
                const int i = (c & 3) + 4 * (c >> 3), rh = (c >> 2) & 1, qq = 2 * rh + (i >> 3), hd = i & 7;
                const bf16_t* ip = IQ + (t0 + qq) * 512 + hd * 64 + 8 * hh;
#pragma unroll
                for (int ks = 0; ks < 4; ++ks) iqf[ks] = *(const bf16x8*)(ip + 16 * ks);
            }
            float* wl = (float*)(smem + 4096) + wid * 32 + hh * 16;
            if (c < 4) *(f32x4*)(wl + 4 * c) = *(const f32x4*)(IW + (t0 + 2 * hh) * 8 + 4 * c);
            unsigned sk[64][2];
            const bf16_t* kpi = IK + ((tb >> 5) * 256 + hh * 32 + c) * 8;
            const int lim0 = pos0 + 2 * hh - c;
#pragma unroll
            for (int tile = 0; tile < 64; ++tile) {
                unsigned k0 = 0u, k1 = 0u;
                if (tile <= tmax) {
                    bf16x8 bk[4];
#pragma unroll
                    for (int ks = 0; ks < 4; ++ks) bk[ks] = *(const bf16x8*)(kpi + 512 * ks);
                    kpi += 32 * 64;
                    asm volatile("" : "+v"(kpi));
                    f32x16 acc;
#pragma unroll
                    for (int r = 0; r < 16; ++r) acc[r] = 0.f;
#pragma unroll
                    for (int ks = 0; ks < 4; ++ks) acc = __builtin_amdgcn_mfma_f32_32x32x16_bf16(iqf[ks], bk[ks], acc, 0, 0, 0);
                    float s0 = 0.f, s1 = 0.f;
#pragma unroll
                    for (int q4 = 0; q4 < 2; ++q4) {
                        const f32x4 wa = *(const f32x4*)(wl + 4 * q4), wb = *(const f32x4*)(wl + 8 + 4 * q4);
#pragma unroll
                        for (int e = 0; e < 4; ++e) { s0 += fmaxf(acc[4 * q4 + e], 0.f) * wa[e]; s1 += fmaxf(acc[8 + 4 * q4 + e], 0.f) * wb[e]; }
                    }
                    k0 = tile * 32 <= lim0 ? sortable(s0) : 0u;
                    k1 = tile * 32 <= lim0 + 1 ? sortable(s1) : 0u;
                }
                sk[tile][0] = k0; sk[tile][1] = k1;
            }
            unsigned v0 = 0u, v1 = 0u; bool d0 = false, d1 = false;
            const int tg = tmax >> 3;
            for (int bit = 31; bit >= 0; --bit) {
                const unsigned c0 = v0 | (1u << bit), c1b = v1 | (1u << bit);
                int n0 = 0, n1 = 0;
#pragma unroll
                for (int g = 0; g < 8; ++g) {
                    if (g <= tg) {
#pragma unroll
                        for (int u = 0; u < 8; ++u) { n0 += sk[g * 8 + u][0] >= c0 ? 1 : 0; n1 += sk[g * 8 + u][1] >= c1b ? 1 : 0; }
                    }
                }
                const int n01 = half_sum_i(n0 | (n1 << 16));
                n0 = n01 & 0xffff; n1 = n01 >> 16;
                if (!d0 && n0 >= 256) { v0 = c0; d0 = n0 == 256; }
                if (!d1 && n1 >= 256) { v1 = c1b; d1 = n1 == 256; }
                if (__all(d0 && d1)) break;
            }
            int g0 = 0, g1 = 0;
#pragma unroll
            for (int g = 0; g < 8; ++g) {
                if (g <= tg) {
#pragma unroll
                    for (int u = 0; u < 8; ++u) { g0 += sk[g * 8 + u][0] > v0 ? 1 : 0; g1 += sk[g * 8 + u][1] > v1 ? 1 : 0; }
                }
            }
            const int g01 = half_sum_i(g0 | (g1 << 16));
            const int need0 = 256 - (g01 & 0xffff), need1 = 256 - (g01 >> 16);
            int run0 = 0, run1 = 0;
#pragma unroll
            for (int tile = 0; tile < 64; ++tile) {
                if (tile <= tmax) {
                    const unsigned k0 = sk[tile][0], k1 = sk[tile][1];
                    const bool tie0 = k0 == v0, tie1 = k1 == v1;
                    const unsigned long long tb0 = __ballot(tie0), tb1 = __ballot(tie1);
                    const unsigned th0 = hh ? (unsigned)(tb0 >> 32) : (unsigned)tb0, th1 = hh ? (unsigned)(tb1 >> 32) : (unsigned)tb1;
                    const bool sel0 = k0 > v0 || (tie0 && run0 + __popc(th0 & lt) < need0);
                    const bool sel1 = k1 > v1 || (tie1 && run1 + __popc(th1 & lt) < need1);
                    run0 += __popc(th0); run1 += __popc(th1);
                    const unsigned long long sb0 = __ballot(sel0), sb1 = __ballot(sel1);
                    if (lane == 0) { u32x4 o = {(unsigned)sb0, (unsigned)sb1, (unsigned)(sb0 >> 32), (unsigned)(sb1 >> 32)}; *(u32x4*)(mw + tile * 4) = o; }
                }
            }
        } else {
            const int tile = lane >> 2, qq = lane & 3, pq = pos0 + qq;
            if (tile <= tmax) {
                unsigned m;
                if (32 * tile + 31 <= pq) m = 0xffffffffu; else if (32 * tile > pq) m = 0u; else m = (2u << (pq - 32 * tile)) - 1u;
                mw[tile * 4 + qq] = m;
            }
        }
        bf16x8 qf[4];
        {
            const bf16_t* qp = Q + (t0 + (c >> 3)) * 512 + (c & 7) * 64 + 8 * hh;
#pragma unroll
            for (int ks = 0; ks < 4; ++ks) qf[ks] = *(const bf16x8*)(qp + 16 * ks);
        }
        f32x16 o0, o1;
#pragma unroll
        for (int r = 0; r < 16; ++r) { o0[r] = 0.f; o1[r] = 0.f; }
        float lsum = 0.f;
        const bf16_t* kp = K + ((tb >> 5) * 256 + hh * 32 + c) * 8;
        const bf16_t* vp = VT + ((tb >> 5) * 256 + hh * 32 + c) * 8;
        bf16x8 kf[4], vf[4];
#pragma unroll
        for (int ks = 0; ks < 4; ++ks) { kf[ks] = *(const bf16x8*)(kp + 512 * ks); vf[ks] = *(const bf16x8*)(vp + 512 * ks); }
        for (int tile = 0; tile <= tmax; ++tile) {
            const unsigned mword = mw[tile * 4 + (c >> 3)];
            bf16x8 kc[4], vc[4];
#pragma unroll
            for (int ks = 0; ks < 4; ++ks) { kc[ks] = kf[ks]; vc[ks] = vf[ks]; }
            if (tile < tmax) {
                kp += 2048; vp += 2048;
#pragma unroll
                for (int ks = 0; ks < 4; ++ks) { kf[ks] = *(const bf16x8*)(kp + 512 * ks); vf[ks] = *(const bf16x8*)(vp + 512 * ks); }
            }
            f32x16 x;
#pragma unroll
            for (int r = 0; r < 16; ++r) x[r] = 0.f;
#pragma unroll
            for (int ks = 0; ks < 4; ++ks) x = __builtin_amdgcn_mfma_f32_32x32x16_bf16(kc[ks], qf[ks], x, 0, 0, 0);
#pragma unroll
            for (int s = 0; s < 2; ++s) {
                const unsigned bits = mword >> (16 * s + 8 * hh);
                float pr[8];
#pragma unroll
                for (int jx = 0; jx < 8; ++jx) {
                    const float e = __builtin_amdgcn_exp2f(x[8 * s + jx] * c1 - c2);
                    pr[jx] = __uint_as_float(__float_as_uint(e) & (unsigned)__builtin_amdgcn_sbfe((int)bits, jx, 1));
                    lsum += pr[jx];
                }
                u32x4 pk = {pk2(pr[0], pr[1]), pk2(pr[2], pr[3]), pk2(pr[4], pr[5]), pk2(pr[6], pr[7])};
                const bf16x8 pf = __builtin_bit_cast(bf16x8, pk);
                o0 = __builtin_amdgcn_mfma_f32_32x32x16_bf16(vc[2 * s], pf, o0, 0, 0, 0);
                o1 = __builtin_amdgcn_mfma_f32_32x32x16_bf16(vc[2 * s + 1], pf, o1, 0, 0, 0);
            }
        }
        lsum += sx_f<32>(lsum);
        const float inv = 1.f / lsum;
        bf16_t* yp = Y + (t0 + (c >> 3)) * 1024 + (c & 7) * 64 + 4 * hh;
#pragma unroll
        for (int g4 = 0; g4 < 4; ++g4) {
            u32x2 a = {pk2(o0[4 * g4] * inv, o0[4 * g4 + 1] * inv), pk2(o0[4 * g4 + 2] * inv, o0[4 * g4 + 3] * inv)};
            u32x2 bq = {pk2(o1[4 * g4] * inv, o1[4 * g4 + 1] * inv), pk2(o1[4 * g4 + 2] * inv, o1[4 * g4 + 3] * inv)};
            *(u32x2*)(yp + 8 * g4) = a;
            *(u32x2*)(yp + 32 + 8 * g4) = bq;
        }
    }
    if (cv1 > cv0 && !(bid & 1)) convert_moe_waves(p, cv0, cv1, bid * 4 + (tid >> 6), nb * 4, tid & 63);
}

DI void phase_conv(const Params& p, int j, int bid, int nb, int tid) {
    const bf16_t* Z = (const bf16_t*)(p.ws + WS_Z);
    const bf16_t* BG = (const bf16_t*)(p.ws + WS_BG);
    bf16_t* Y = (bf16_t*)(p.ws + WS_YMIX);
    const float* cw = p.hy_conv_w + (size_t)j * 3 * 512;
    for (int item = bid; item < T / 4; item += nb) {
        const int t = item * 4 + (tid >> 6), c0 = (tid & 63) * 8, pos = t & (S - 1);
        float acc[8];
#pragma unroll
        for (int e = 0; e < 8; ++e) acc[e] = 0.f;
#pragma unroll
        for (int jj = 0; jj < 3; ++jj) {
            const int dp = jj - 2;
            if (pos + dp >= 0) {
                const u32x4 z = *(const u32x4*)(Z + (size_t)(t + dp) * 512 + c0);
#pragma unroll
                for (int e = 0; e < 4; ++e) { acc[2 * e] += cw[jj * 512 + c0 + 2 * e] * bflo(z[e]); acc[2 * e + 1] += cw[jj * 512 + c0 + 2 * e + 1] * bfhi(z[e]); }
            }
        }
        const u32x4 g = *(const u32x4*)(BG + (size_t)t * 512 + c0);
        u32x4 o;
#pragma unroll
        for (int e = 0; e < 4; ++e) o[e] = pk2(acc[2 * e] * bflo(g[e]), acc[2 * e + 1] * bfhi(g[e]));
        *(u32x4*)(Y + (size_t)t * 1024 + 512 + c0) = o;
    }
}

DI float wave_incl_sum(float x, int lane) { for (int d = 1; d < 64; d <<= 1) { const float t = lane_get_f(x, lane >= d ? lane - d : lane); if (lane >= d) x += t; } return x; }
DI float wave_incl_max(float x, int lane) { for (int d = 1; d < 64; d <<= 1) { const float t = lane_get_f(x, lane >= d ? lane - d : lane); if (lane >= d) x = fmaxf(x, t); } return x; }
DI bf16x8 scale_frag(bf16x8 f, const float* w8) {
    const u32x4 u = __builtin_bit_cast(u32x4, f);
    u32x4 o;
#pragma unroll
    for (int e = 0; e < 4; ++e) o[e] = pk2(bflo(u[e]) * w8[2 * e], bfhi(u[e]) * w8[2 * e + 1]);
    return __builtin_bit_cast(bf16x8, o);
}

DI void phase_ml1(const Params& p, unsigned char* smem, int bid, int nb, int tid) {
    const int lane = tid & 63, wid = tid >> 6, c = lane & 31, hh = lane >> 5;
    float* wsl = (float*)smem + wid * 64;
    const bf16_t* KT = (const bf16_t*)(p.ws + WS_MKT);
    const bf16_t* VT = (const bf16_t*)(p.ws + WS_MV);
    const float* MIG = (const float*)(p.ws + WS_MIG);
    const float* MFG = (const float*)(p.ws + WS_MFG);
    float* UB = (float*)(p.ws + WS_UBUF);
    float* UN = (float*)(p.ws + WS_UNBUF);
    float* ML = (float*)(p.ws + WS_MLOC);
    for (int item = bid; item < 2048; item += nb) {
        const int bh = item >> 5, ch = item & 31, b = bh >> 3, h = bh & 7;
        const size_t tb = (size_t)b * S + ch * 64;
        const float lf = MFG[(tb + lane) * 8 + h], ig = MIG[(tb + lane) * 8 + h];
        const float bc = wave_incl_sum(lf, lane);
        const float blast = lane_get_f(bc, 63);
        const float g = blast - bc + ig;
        const float gmax = wave_max(g);
        wsl[lane] = __expf(g - gmax);
        if (wid == 0 && lane == 0) { ML[item * 2] = blast; ML[item * 2 + 1] = gmax; }
        f32x16 u0, u1;
#pragma unroll
        for (int r = 0; r < 16; ++r) { u0[r] = 0.f; u1[r] = 0.f; }
        const bf16_t* vp = VT + ((size_t)(bh * 128 + wid * 32 + c)) * S + ch * 64 + 8 * hh;
        const bf16_t* kp = KT + ((size_t)(bh * 64 + c)) * S + ch * 64 + 8 * hh;
#pragma unroll
        for (int ks = 0; ks < 4; ++ks) {
            float w8[8];
            const f32x4 wa = *(const f32x4*)(wsl + 16 * ks + 8 * hh), wb = *(const f32x4*)(wsl + 16 * ks + 8 * hh + 4);
            w8[0] = wa[0]; w8[1] = wa[1]; w8[2] = wa[2]; w8[3] = wa[3]; w8[4] = wb[0]; w8[5] = wb[1]; w8[6] = wb[2]; w8[7] = wb[3];
            const bf16x8 va = *(const bf16x8*)(vp + 16 * ks);
            const bf16x8 k0 = scale_frag(*(const bf16x8*)(kp + 16 * ks), w8);
            const bf16x8 k1 = scale_frag(*(const bf16x8*)(kp + (size_t)32 * S + 16 * ks), w8);
            u0 = __builtin_amdgcn_mfma_f32_32x32x16_bf16(va, k0, u0, 0, 0, 0);
            u1 = __builtin_amdgcn_mfma_f32_32x32x16_bf16(va, k1, u1, 0, 0, 0);
        }
        float* up = UB + ((size_t)item * 128 + wid * 32) * 64 + c;
#pragma unroll
        for (int r = 0; r < 16; ++r) { const int v = crow(r, lane); up[v * 64] = u0[r]; up[v * 64 + 32] = u1[r]; }
        if (wid == 0) {
            const u32x4* kr = (const u32x4*)(KT + ((size_t)(bh * 64 + lane)) * S + ch * 64);
            float a = 0.f;
#pragma unroll
            for (int q = 0; q < 8; ++q) { const u32x4 u = kr[q];
#pragma unroll
                for (int e = 0; e < 4; ++e) a += wsl[q * 8 + 2 * e] * bflo(u[e]) + wsl[q * 8 + 2 * e + 1] * bfhi(u[e]); }
            UN[(size_t)item * 64 + lane] = a;
        }
    }
}

DI void phase_ml2(const Params& p, unsigned char* smem, int bid, int nb, int tid) {
    float* dec = (float*)smem;
    float* scl = dec + 32;
    const float* UB = (const float*)(p.ws + WS_UBUF);
    const float* UN = (const float*)(p.ws + WS_UNBUF);
    const float* ML = (const float*)(p.ws + WS_MLOC);
    bf16_t* CB = (bf16_t*)(p.ws + WS_CBUF);
    float* NBF = (float*)(p.ws + WS_NBUF);
    float* MST = (float*)(p.ws + WS_MST);
    for (int item = bid; item < 512; item += nb) {
        const int bh = item >> 3, sl = item & 7;
        __syncthreads();
        if (tid == 0) {
            float m = 0.f;
            for (int ch = 0; ch < 32; ++ch) {
                const float bl = ML[(bh * 32 + ch) * 2], gm = ML[(bh * 32 + ch) * 2 + 1];
                const float mn = fmaxf(bl + m, gm);
                dec[ch] = __expf(bl + m - mn); scl[ch] = __expf(gm - mn);
                if (sl == 0) MST[bh * 32 + ch] = m;
                m = mn;
            }
        }
        __syncthreads();
        f32x4 st = {0.f, 0.f, 0.f, 0.f};
        const size_t e0 = (size_t)sl * 1024 + tid * 4;
        f32x4 ub[32];
#pragma unroll
        for (int ch = 0; ch < 32; ++ch) ub[ch] = *(const f32x4*)(UB + ((size_t)(bh * 32 + ch)) * 8192 + e0);
#pragma unroll
        for (int ch = 0; ch < 32; ++ch) {
            st = st * dec[ch] + ub[ch] * scl[ch];
            u32x2 o = {pk2(st[0], st[1]), pk2(st[2], st[3])};
            *(u32x2*)(CB + ((size_t)(bh * 32 + ch)) * 8192 + e0) = o;
        }
        if (sl == 0 && tid < 64) {
            float nst = 0.f, un[32];
#pragma unroll
            for (int ch = 0; ch < 32; ++ch) un[ch] = UN[(size_t)(bh * 32 + ch) * 64 + tid];
#pragma unroll
            for (int ch = 0; ch < 32; ++ch) { nst = nst * dec[ch] + un[ch] * scl[ch]; NBF[(size_t)(bh * 32 + ch) * 64 + tid] = nst; }
        }
    }
}

DI void phase_ml3(const Params& p, int j, unsigned char* smem, int bid, int nb, int tid) {
    const int lane = tid & 63, wid = tid >> 6, c = lane & 31, hh = lane >> 5;
    float* al = (float*)smem + wid * 64;
    float* ssum = (float*)smem + 256;
    const bf16_t* MQ = (const bf16_t*)(p.ws + WS_MQ);
    const bf16_t* MK = (const bf16_t*)(p.ws + WS_MK);
    const bf16_t* VT = (const bf16_t*)(p.ws + WS_MV);
    const float* MIG = (const float*)(p.ws + WS_MIG);
    const float* MFG = (const float*)(p.ws + WS_MFG);
    const bf16_t* MOG = (const bf16_t*)(p.ws + WS_MOG);
    const bf16_t* CB = (const bf16_t*)(p.ws + WS_CBUF);
    const float* NBF = (const float*)(p.ws + WS_NBUF);
    const float* MST = (const float*)(p.ws + WS_MST);
    bf16_t* Y = (bf16_t*)(p.ws + WS_YMIX);
    const int kperm = (c & ~12) | ((c & 4) << 1) | ((c & 8) >> 1);
    for (int item = bid; item < 2048; item += nb) {
        const int bh = item >> 5, ch = item & 31, b = bh >> 3, h = bh & 7;
        const size_t tb = (size_t)b * S + ch * 64;
        const float lf = MFG[(tb + lane) * 8 + h], ig = MIG[(tb + lane) * 8 + h];
        const float bc = wave_incl_sum(lf, lane);
        const float av = ig - bc;
        const float mprev = MST[item];
        const float Mv = fmaxf(mprev, wave_incl_max(av, lane));
        __syncthreads();
        al[lane] = av;
        float Mt[2], wint[2], emt[2];
#pragma unroll
        for (int tt = 0; tt < 2; ++tt) { Mt[tt] = lane_get_f(Mv, 32 * tt + c); wint[tt] = __expf(mprev - Mt[tt]); emt[tt] = __expf(-(lane_get_f(bc, 32 * tt + c) + Mt[tt])); }
        bf16x8 qf[2][4], kf[2][4];
#pragma unroll
        for (int tt = 0; tt < 2; ++tt) {
            const bf16_t* qp = MQ + (tb + 32 * tt + c) * 512 + h * 64 + 8 * hh;
            const bf16_t* kp = MK + (tb + 32 * tt + kperm) * 512 + h * 64 + 8 * hh;
#pragma unroll
            for (int ks = 0; ks < 4; ++ks) { qf[tt][ks] = *(const bf16x8*)(qp + 16 * ks); kf[tt][ks] = *(const bf16x8*)(kp + 16 * ks); }
        }
        f32x16 o[2];
#pragma unroll
        for (int tt = 0; tt < 2; ++tt)
#pragma unroll
            for (int r = 0; r < 16; ++r) o[tt][r] = 0.f;
        float nq[2] = {0.f, 0.f};
        if (ch > 0) {
            const bf16_t* cp = CB + ((size_t)(item - 1) * 128 + wid * 32 + c) * 64 + 8 * hh;
            const float* np = NBF + (size_t)(item - 1) * 64 + 8 * hh;
#pragma unroll
            for (int ks = 0; ks < 4; ++ks) {
                const bf16x8 cf = *(const bf16x8*)(cp + 16 * ks);
                o[0] = __builtin_amdgcn_mfma_f32_32x32x16_bf16(cf, qf[0][ks], o[0], 0, 0, 0);
                o[1] = __builtin_amdgcn_mfma_f32_32x32x16_bf16(cf, qf[1][ks], o[1], 0, 0, 0);
                const f32x4 n0 = *(const f32x4*)(np + 16 * ks), n1 = *(const f32x4*)(np + 16 * ks + 4);
#pragma unroll
                for (int tt = 0; tt < 2; ++tt) {
                    const u32x4 u = __builtin_bit_cast(u32x4, qf[tt][ks]);
                    nq[tt] += n0[0] * bflo(u[0]) + n0[1] * bfhi(u[0]) + n0[2] * bflo(u[1]) + n0[3] * bfhi(u[1]) + n1[0] * bflo(u[2]) + n1[1] * bfhi(u[2]) + n1[2] * bflo(u[3]) + n1[3] * bfhi(u[3]);
                }
            }
#pragma unroll
            for (int tt = 0; tt < 2; ++tt) {
                nq[tt] += sx_f<32>(nq[tt]);
#pragma unroll
                for (int r = 0; r < 16; ++r) o[tt][r] *= wint[tt];
            }
        }
        float csum[2] = {0.f, 0.f};
        const bf16_t* vp = VT + ((size_t)(bh * 128 + wid * 32 + c)) * S + ch * 64 + 8 * hh;
#pragma unroll
        for (int tt = 0; tt < 2; ++tt) {
#pragma unroll
            for (int st = 0; st <= tt; ++st) {
                f32x16 x;
#pragma unroll
                for (int r = 0; r < 16; ++r) x[r] = 0.f;
#pragma unroll
                for (int ks = 0; ks < 4; ++ks) x = __builtin_amdgcn_mfma_f32_32x32x16_bf16(kf[st][ks], qf[tt][ks], x, 0, 0, 0);
#pragma unroll
                for (int k2 = 0; k2 < 2; ++k2) {
                    const int s0 = 32 * st + 16 * k2 + 8 * hh;
                    const f32x4 a0 = *(const f32x4*)(al + s0), a1 = *(const f32x4*)(al + s0 + 4);
                    const float a8[8] = {a0[0], a0[1], a0[2], a0[3], a1[0], a1[1], a1[2], a1[3]};
                    float pr[8];
#pragma unroll
                    for (int jx = 0; jx < 8; ++jx) {
                        const float e = __expf(a8[jx] - Mt[tt]) * x[8 * k2 + jx];
                        pr[jx] = (st < tt || s0 + jx <= 32 * tt + c) ? e : 0.f;
                        csum[tt] += pr[jx];
                    }
                    u32x4 pk = {pk2(pr[0], pr[1]), pk2(pr[2], pr[3]), pk2(pr[4], pr[5]), pk2(pr[6], pr[7])};
                    const bf16x8 vf = *(const bf16x8*)(vp + 32 * st + 16 * k2);
                    o[tt] = __builtin_amdgcn_mfma_f32_32x32x16_bf16(vf, __builtin_bit_cast(bf16x8, pk), o[tt], 0, 0, 0);
                }
            }
        }
        float ss[2];
#pragma unroll
        for (int tt = 0; tt < 2; ++tt) {
            csum[tt] += sx_f<32>(csum[tt]);
            const float den = wint[tt] * nq[tt] + csum[tt];
            const float rd = 1.f / fmaxf(fabsf(den), emt[tt]);
            float s2 = 0.f;
#pragma unroll
            for (int r = 0; r < 16; ++r) { o[tt][r] *= rd; s2 += o[tt][r] * o[tt][r]; }
            s2 += sx_f<32>(s2);
            ss[tt] = s2;
            if (hh == 0) ssum[wid * 64 + 32 * tt + c] = s2;
        }
        __syncthreads();
#pragma unroll
        for (int tt = 0; tt < 2; ++tt) {
            const int tcol = 32 * tt + c;
            const float tot = ssum[tcol] + ssum[64 + tcol] + ssum[128 + tcol] + ssum[192 + tcol];
            const float rstd = rsqrtf(tot * (1.f / 128.f) + EPS);
            const size_t ro = (tb + tcol) * 1024 + h * 128 + wid * 32 + 4 * hh;
            const float* gp = p.ml_out_norm + j * 1024 + h * 128 + wid * 32 + 4 * hh;
#pragma unroll
            for (int g4 = 0; g4 < 4; ++g4) {
                const f32x4 gm = *(const f32x4*)(gp + 8 * g4);
                const u32x2 og = *(const u32x2*)(MOG + ro + 8 * g4);
                u32x2 ov = {pk2(o[tt][4 * g4] * rstd * gm[0] * bflo(og[0]), o[tt][4 * g4 + 1] * rstd * gm[1] * bfhi(og[0])),
                            pk2(o[tt][4 * g4 + 2] * rstd * gm[2] * bflo(og[1]), o[tt][4 * g4 + 3] * rstd * gm[3] * bfhi(og[1]))};
                *(u32x2*)(Y + ro + 8 * g4) = ov;
            }
        }
    }
}


namespace pg8 {
#define PG8_LAS __attribute__((address_space(3)))
typedef unsigned short bf16_t;
typedef short bf16x8 __attribute__((ext_vector_type(8)));
typedef float f32x4 __attribute__((ext_vector_type(4)));
typedef unsigned u32x4 __attribute__((ext_vector_type(4)));
constexpr int BM = 256, BK = 64, HALF = 128, HTB = HALF * BK * 2  , STAGE_BYTES = 8 * HTB, NXCD = 8, WGM = 8;

__host__ __device__ __forceinline__ int lds_byte(int r, int c) { const int st = (r >> 4) * 2 + (c >> 5), rr = r & 15, cc = c & 31, ob = rr * 64 + cc * 2; return st * 1024 + (ob ^ (((ob >> 9) & 1) << 5)); }
__host__ __device__ __forceinline__ void stage_rc(int b, int& R, int& C) { const int st = b / 1024, sb = b % 1024, swz = sb ^ (((sb >> 9) & 1) << 5); R = (st >> 1) * 16 + swz / 64; C = (st & 1) * 32 + (swz % 64) / 2; }
__host__ __device__ __forceinline__ int perm32(int rho) { const int n = rho >> 4, i = rho & 15; return 8 * (i >> 2) + 4 * n + (i & 3); }

struct Unit { int pm, pn; };
struct Gemm { const bf16_t* A; const bf16_t* Bt; int M, N, K; };

struct StaticOrder {
    int nM, nN, nwg, G, c;
    __host__ __device__ void init(int M, int N, int G_, int c_) { nM = M / BM; nN = N / BM; nwg = nM * nN; G = G_; c = c_; }
    __host__ __device__ bool next(int i, Unit& u) const {
        const long L = (long)i * G + c; if (L >= nwg) return false;
        int wgid = (int)L; { const int q = nwg / NXCD, r = nwg % NXCD, xcd = wgid % NXCD, off = wgid / NXCD; wgid = (xcd < r ? xcd * (q + 1) : r * (q + 1) + (xcd - r) * q) + off; }
        const int nig = WGM * nN, gid = wgid / nig, fm = gid * WGM, gsz = (nM - fm) < WGM ? (nM - fm) : WGM;
        u.pm = fm + ((wgid % nig) % gsz); u.pn = (wgid % nig) / gsz; return true;
    }
    static constexpr bool GATHER = false;
    __device__ __forceinline__ unsigned a_off(const Unit&, int) const { return 0u; }
    __device__ __forceinline__ void a_ready(const Unit&) const {}
    __device__ __forceinline__ void done(const Unit&) const {}
};


template <class Epi, class Sched, bool ALIGN_EPI = false, bool SP2 = false>
__device__ __forceinline__ void gemm_phase(PG8_LAS unsigned char* lds, const Gemm g, const Sched& S, const Epi& E, int tid512) {
    const int tid = opq(tid512), wid = __builtin_amdgcn_readfirstlane(tid >> 6), lane = tid & 63, wr = wid >> 2, wc = wid & 3, fr = lane & 15, fq = lane >> 4;
    const int K = g.K, nt = K / BK;
    unsigned voffA[2], voffB[2];
    int rowA[2];
#pragma unroll
    for (int i = 0; i < 2; ++i) { int R, C; stage_rc(tid * 16 + i * 8192, R, C); const int Rb = Epi::PERM ? ((R & ~31) + perm32(R & 31)) : R;
        voffA[i] = (unsigned)(R * K + C) * 2u; voffB[i] = (unsigned)(Rb * K + C) * 2u; rowA[i] = R; if (Sched::GATHER) voffA[i] = (unsigned)C * 2u; }
    const size_t kstep = (size_t)(BK * 2);
    const size_t hstep = (size_t)HALF * K * 2;
    const size_t tstep = 2 * hstep;
    const unsigned ldsw = (unsigned)wid * 1024u;
    const int aoff = lds_byte(wr * 64 + fr, fq * 8), boff = lds_byte(wc * 32 + fr, fq * 8);
#define PG8_SA(b, h) (((b) * 2 + (h)) * HTB)
#define PG8_SB(b, h) ((4 + (b) * 2 + (h)) * HTB)
#define PG8_STAGE(bufoff, gbase, voff) do { _Pragma("unroll") for (int _i = 0; _i < 2; ++_i) \
        __builtin_amdgcn_global_load_lds((const unsigned*)((const char*)(gbase) + (voff)[_i]), (PG8_LAS unsigned*)(lds + (bufoff) + ldsw + _i * 8192), 16, 0, 0); } while (0)
#define PG8_LDA(dst, b, h) do { _Pragma("unroll") for (int m = 0; m < 4; ++m) _Pragma("unroll") for (int k = 0; k < 2; ++k) dst[m][k] = *(const PG8_LAS bf16x8*)(lds + PG8_SA(b, h) + aoff + m * 2048 + k * 1024); } while (0)
#define PG8_LDB(dst, b, h) do { _Pragma("unroll") for (int n = 0; n < 2; ++n) _Pragma("unroll") for (int k = 0; k < 2; ++k) dst[n][k] = *(const PG8_LAS bf16x8*)(lds + PG8_SB(b, h) + boff + n * 2048 + k * 1024); } while (0)
#define PG8_MMA(ai, bj, At, Bt) do { __builtin_amdgcn_s_setprio(1); _Pragma("unroll") for (int m = 0; m < 4; ++m) _Pragma("unroll") for (int n = 0; n < 2; ++n) _Pragma("unroll") for (int k = 0; k < 2; ++k) \
        acc[ai][bj][m][n] = __builtin_amdgcn_mfma_f32_16x16x32_bf16(Bt[n][k], At[m][k], acc[ai][bj][m][n], 0, 0, 0); __builtin_amdgcn_s_setprio(0); } while (0)
#define PG8_WAIT_V(n) asm volatile("s_waitcnt vmcnt(" #n ")" ::: "memory")
#define PG8_WAIT_L(n) asm volatile("s_waitcnt lgkmcnt(" #n ")" ::: "memory")
#define PG8_BAR __builtin_amdgcn_s_barrier()
#define PG8_SCHED __builtin_amdgcn_sched_barrier(0)
    unsigned oaC[2][2], oaN[2][2];
#define PG8_GOFF(dst, unit) do { _Pragma("unroll") for (int _h = 0; _h < 2; ++_h) _Pragma("unroll") for (int _i = 0; _i < 2; ++_i) dst[_h][_i] = S.a_off(unit, _h * HALF + rowA[_i]) + voffA[_i]; } while (0)
#define PG8_STAGE_G(bufoff, offs, koff) do { _Pragma("unroll") for (int _i = 0; _i < 2; ++_i) \
        __builtin_amdgcn_global_load_lds((const unsigned*)(((const char*)g.A + (koff)) + (offs)[_i]), (PG8_LAS unsigned*)(lds + (bufoff) + ldsw + _i * 8192), 16, 0, 0); } while (0)
    Unit cur, nxt; int ui = 0;
    if (!S.next(0, cur)) return;
    if constexpr (Sched::GATHER) { PG8_GOFF(oaC, cur); PG8_GOFF(oaN, cur); }
    f32x4 acc[2][2][4][2];
#pragma unroll
    for (int a = 0; a < 2; ++a)
#pragma unroll
        for (int b = 0; b < 2; ++b)
#pragma unroll
            for (int m = 0; m < 4; ++m)
#pragma unroll
                for (int n = 0; n < 2; ++n) acc[a][b][m][n] = (f32x4){0.f, 0.f, 0.f, 0.f};
    bf16x8 At[4][2], B0[2][2], B1[2][2];
    const char* cA = (const char*)g.A + (size_t)cur.pm * tstep; const char* cB = (const char*)g.Bt + (size_t)cur.pn * tstep;
    S.a_ready(cur);
    if constexpr (SP2) {
        PG8_STAGE(PG8_SB(0, 0), cB, voffB); PG8_STAGE(PG8_SB(0, 1), cB + hstep, voffB);
        if constexpr (Sched::GATHER) { PG8_STAGE_G(PG8_SA(0, 0), oaC[0], 0); PG8_STAGE_G(PG8_SA(0, 1), oaC[1], 0); } else { PG8_STAGE(PG8_SA(0, 0), cA, voffA); PG8_STAGE(PG8_SA(0, 1), cA + hstep, voffA); }
        if (wr == 1) PG8_BAR;
        PG8_WAIT_V(2); PG8_BAR;
        PG8_STAGE(PG8_SB(1, 0), cB + kstep, voffB);
        if constexpr (Sched::GATHER) PG8_STAGE_G(PG8_SA(1, 0), oaC[0], kstep); else PG8_STAGE(PG8_SA(1, 0), cA + kstep, voffA);
        PG8_STAGE(PG8_SB(1, 1), cB + hstep + kstep, voffB);
        PG8_WAIT_V(6); PG8_BAR;
    } else {
        PG8_STAGE(PG8_SB(0, 0), cB, voffB); PG8_STAGE(PG8_SA(0, 0), cA, voffA); PG8_STAGE(PG8_SB(0, 1), cB + hstep, voffB); PG8_STAGE(PG8_SA(0, 1), cA + hstep, voffA);
        if (wr == 1) PG8_BAR;
        PG8_WAIT_V(4); PG8_BAR;
        PG8_STAGE(PG8_SB(1, 0), cB + kstep, voffB); PG8_STAGE(PG8_SA(1, 0), cA + kstep, voffA); PG8_STAGE(PG8_SB(1, 1), cB + hstep + kstep, voffB);
        PG8_WAIT_V(6); PG8_BAR;
    }
    for (;;) {
        const bool has_next = S.next(ui + 1, nxt);
        const char* nA = has_next ? (const char*)g.A + (size_t)nxt.pm * tstep : cA; const char* nB = has_next ? (const char*)g.Bt + (size_t)nxt.pn * tstep : cB;
        for (int t = 0; t < nt; t += 2) {
            const bool last = (t == nt - 2);
            const char* a1 = cA + (size_t)(t + 1) * kstep;
            const char* a2 = last ? nA : cA + (size_t)(t + 2) * kstep; const char* b2 = last ? nB : cB + (size_t)(t + 2) * kstep;
            const char* a3 = a2 + kstep; const char* b3 = b2 + kstep;
            if (last && has_next) S.a_ready(nxt);
            unsigned oaS[2][2]; size_t k2 = 0;
            if constexpr (Sched::GATHER) {
                if (last && has_next) PG8_GOFF(oaN, nxt);
                const bool fromN = last && has_next;
#pragma unroll
                for (int _h = 0; _h < 2; ++_h)
#pragma unroll
                    for (int _i = 0; _i < 2; ++_i) oaS[_h][_i] = fromN ? oaN[_h][_i] : oaC[_h][_i];
                k2 = last ? (size_t)0 : (size_t)(t + 2) * kstep;
            }
            if constexpr (SP2) {
            PG8_LDB(B0, 0, 0); PG8_LDB(B1, 0, 1); PG8_SCHED; PG8_LDA(At, 0, 0);
            if constexpr (Sched::GATHER) PG8_STAGE_G(PG8_SA(1, 1), oaC[1], (size_t)(t + 1) * kstep); else PG8_STAGE(PG8_SA(1, 1), a1 + hstep, voffA);
            PG8_WAIT_V(8); PG8_WAIT_L(0); PG8_BAR; PG8_MMA(0, 0, At, B0); PG8_MMA(0, 1, At, B1); PG8_BAR; PG8_SCHED;
            PG8_LDA(At, 0, 1); PG8_STAGE(PG8_SB(0, 0), b2, voffB); PG8_STAGE(PG8_SB(0, 1), b2 + hstep, voffB);
            if constexpr (Sched::GATHER) PG8_STAGE_G(PG8_SA(0, 0), oaS[0], k2); else PG8_STAGE(PG8_SA(0, 0), a2, voffA);
            PG8_WAIT_V(8); PG8_WAIT_L(0); PG8_BAR; PG8_MMA(1, 0, At, B0); PG8_MMA(1, 1, At, B1); PG8_BAR; PG8_SCHED;
            PG8_LDB(B0, 1, 0); PG8_LDB(B1, 1, 1); PG8_SCHED; PG8_LDA(At, 1, 0);
            if constexpr (Sched::GATHER) PG8_STAGE_G(PG8_SA(0, 1), oaS[1], k2); else PG8_STAGE(PG8_SA(0, 1), a2 + hstep, voffA);
            PG8_WAIT_V(8); PG8_WAIT_L(0); PG8_BAR; PG8_MMA(0, 0, At, B0); PG8_MMA(0, 1, At, B1); PG8_BAR; PG8_SCHED;
            PG8_LDA(At, 1, 1); PG8_STAGE(PG8_SB(1, 0), b3, voffB); PG8_STAGE(PG8_SB(1, 1), b3 + hstep, voffB);
            if constexpr (Sched::GATHER) PG8_STAGE_G(PG8_SA(1, 0), oaS[0], k2 + kstep); else PG8_STAGE(PG8_SA(1, 0), a3, voffA);
            PG8_WAIT_V(8); PG8_WAIT_L(0); PG8_BAR; PG8_MMA(1, 0, At, B0); PG8_MMA(1, 1, At, B1); PG8_BAR; PG8_SCHED;
            } else {
            PG8_LDB(B0, 0, 0); PG8_SCHED; PG8_LDA(At, 0, 0); PG8_STAGE(PG8_SA(1, 1), a1 + hstep, voffA);
            PG8_WAIT_L(8); PG8_BAR; PG8_WAIT_L(0); PG8_MMA(0, 0, At, B0); PG8_BAR; PG8_SCHED;
            PG8_LDB(B1, 0, 1); PG8_STAGE(PG8_SB(0, 0), b2, voffB);
            PG8_BAR; PG8_WAIT_L(0); PG8_MMA(0, 1, At, B1); PG8_BAR;
            PG8_LDA(At, 0, 1); PG8_STAGE(PG8_SA(0, 0), a2, voffA);
            PG8_BAR; PG8_WAIT_L(0); PG8_MMA(1, 0, At, B0); PG8_BAR; PG8_SCHED;
            PG8_STAGE(PG8_SB(0, 1), b2 + hstep, voffB);
            PG8_WAIT_V(6); PG8_BAR; PG8_MMA(1, 1, At, B1); PG8_BAR;
            PG8_LDB(B0, 1, 0); PG8_SCHED; PG8_LDA(At, 1, 0); PG8_STAGE(PG8_SA(0, 1), a2 + hstep, voffA);
            PG8_WAIT_L(8); PG8_BAR; PG8_WAIT_L(0); PG8_MMA(0, 0, At, B0); PG8_BAR; PG8_SCHED;
            PG8_LDB(B1, 1, 1); PG8_STAGE(PG8_SB(1, 0), b3, voffB);
            PG8_BAR; PG8_WAIT_L(0); PG8_MMA(0, 1, At, B1); PG8_BAR;
            PG8_LDA(At, 1, 1); PG8_STAGE(PG8_SA(1, 0), a3, voffA);
            PG8_BAR; PG8_WAIT_L(0); PG8_MMA(1, 0, At, B0); PG8_BAR; PG8_SCHED;
            PG8_STAGE(PG8_SB(1, 1), b3 + hstep, voffB);
            PG8_WAIT_V(6); PG8_BAR; PG8_MMA(1, 1, At, B1); PG8_BAR;
            }
        }
        if constexpr (ALIGN_EPI) { if (wr == 0) PG8_BAR; }
        if constexpr (!Epi::AFTER_DRAIN) { E(acc, cur, wr, wc, fr, fq); S.done(cur); }
        if (!has_next) break;
#pragma unroll
        for (int a = 0; a < 2; ++a)
#pragma unroll
            for (int b = 0; b < 2; ++b)
#pragma unroll
                for (int m = 0; m < 4; ++m)
#pragma unroll
                    for (int n = 0; n < 2; ++n) acc[a][b][m][n] = (f32x4){0.f, 0.f, 0.f, 0.f};
        cur = nxt; cA = nA; cB = nB; ++ui;
        if constexpr (Sched::GATHER) {
#pragma unroll
            for (int _h = 0; _h < 2; ++_h)
#pragma unroll
                for (int _i = 0; _i < 2; ++_i) oaC[_h][_i] = oaN[_h][_i];
        }
        if constexpr (ALIGN_EPI) { if (wr == 1) PG8_BAR; }
    }
    PG8_WAIT_V(0);
    if constexpr (!ALIGN_EPI) { if (wr == 0) PG8_BAR; }
    PG8_BAR;
    if constexpr (Epi::AFTER_DRAIN) { E.fused(acc, cur, wr, wc, fr, fq, lds, wid, lane); S.done(cur); }
#undef PG8_GOFF
#undef PG8_STAGE_G
#undef PG8_SA
#undef PG8_SB
#undef PG8_STAGE
#undef PG8_LDA
#undef PG8_LDB
#undef PG8_MMA
#undef PG8_WAIT_V
#undef PG8_WAIT_L
#undef PG8_BAR
#undef PG8_SCHED
}
}

struct OutEpi8 {
    static constexpr bool PERM = false, AFTER_DRAIN = false;
    const float* src; float* dst; const float* gate; float* part;
    __device__ __forceinline__ void operator()(const pg8::f32x4 (&acc)[2][2][4][2], const pg8::Unit& u, int wr, int wc, int fr, int fq) const {
#pragma unroll
        for (int ai = 0; ai < 2; ++ai)
#pragma unroll
            for (int m = 0; m < 4; ++m) {
                const int t = u.pm * 256 + ai * 128 + wr * 64 + m * 16 + fr;
                const float* gp = gate + (t >> 11) * 6144;
                float ss = 0.f;
#pragma unroll
                for (int bj = 0; bj < 2; ++bj)
#pragma unroll
                    for (int n = 0; n < 2; ++n) {
                        const int col = u.pn * 256 + bj * 128 + wc * 32 + n * 16 + fq * 4;
                        const pg8::f32x4 g = *(const pg8::f32x4*)(gp + col);
                        const pg8::f32x4 o = *(const pg8::f32x4*)(src + (size_t)t * 1024 + col) + g * acc[ai][bj][m][n];
                        *(pg8::f32x4*)(dst + (size_t)t * 1024 + col) = o;
                        ss += o[0] * o[0] + o[1] * o[1] + o[2] * o[2] + o[3] * o[3];
                    }
                ss += sx_f<16>(ss); ss += sx_f<32>(ss);
                if (fq == 0) part[(size_t)t * 16 + u.pn * 4 + wc] = ss;
            }
    }
};


DI unsigned cvtpk(float lo, float hi) { return pk2(lo, hi); }
struct HybEpi8 {
    static constexpr bool PERM = true, AFTER_DRAIN = false;
    const Params* p; int j;
    __device__ __forceinline__ void operator()(const pg8::f32x4 (&acc)[2][2][4][2], const pg8::Unit& u, int wr, int wc, int fr, int fq) const {
        unsigned char* ws = p->ws;
        const int un = u.pn;
        if (un < 5 && !(un == 4 && (wc == 1 || wc == 3))) {
            const bool donorm = un < 2 || (un == 4 && wc == 0);
            bf16_t* ob; int ld, cb; const float* gam = p->hy_q_norm + j * 64;
            if (un < 2) { ob = (bf16_t*)(ws + WS_Q); ld = 512; cb = 64 * (4 * un + wc); }
            else if (un < 4) { ob = (bf16_t*)(ws + WS_IQ); ld = 512; cb = 64 * (4 * (un - 2) + wc); }
            else if (wc == 0) { ob = (bf16_t*)(ws + WS_K); ld = 64; cb = 0; gam = p->hy_k_norm + j * 64; }
            else { ob = (bf16_t*)(ws + WS_IK); ld = 64; cb = 0; }
            pg8::f32x4 g0[2], g1[2];
#pragma unroll
            for (int n = 0; n < 2; ++n) { g0[n] = donorm ? *(const pg8::f32x4*)(gam + 8 * fq + 4 * n) : (pg8::f32x4){1.f, 1.f, 1.f, 1.f}; g1[n] = donorm ? *(const pg8::f32x4*)(gam + 32 + 8 * fq + 4 * n) : (pg8::f32x4){1.f, 1.f, 1.f, 1.f}; }
            const float* ropec = (const float*)(ws + WS_ROPEC);
            const float* ropes = (const float*)(ws + WS_ROPES);
#pragma unroll
            for (int ai = 0; ai < 2; ++ai)
#pragma unroll
                for (int m = 0; m < 4; ++m) {
                    const int t = opq(u.pm * 256 + ai * 128 + wr * 64 + m * 16 + fr), pos = t & (S - 1);
                    float rstd = 1.f;
                    if (donorm) {
                        float ss = 0.f;
#pragma unroll
                        for (int bj = 0; bj < 2; ++bj)
#pragma unroll
                            for (int n = 0; n < 2; ++n) { const pg8::f32x4 x = acc[ai][bj][m][n]; ss += x[0] * x[0] + x[1] * x[1] + x[2] * x[2] + x[3] * x[3]; }
                        ss += sx_f<16>(ss); ss += sx_f<32>(ss);
                        rstd = rsqrtf(ss * (1.f / 64.f) + EPS);
                    }
                    u32x4 o1, o2;
#pragma unroll
                    for (int n = 0; n < 2; ++n) {
                        const pg8::f32x4 cs = *(const pg8::f32x4*)(ropec + pos * 32 + 8 * fq + 4 * n), sn = *(const pg8::f32x4*)(ropes + pos * 32 + 8 * fq + 4 * n);
                        const pg8::f32x4 x1 = acc[ai][0][m][n] * rstd * g0[n], x2 = acc[ai][1][m][n] * rstd * g1[n];
                        const pg8::f32x4 y1 = x1 * cs - x2 * sn, y2 = x2 * cs + x1 * sn;
                        o1[2 * n] = cvtpk(y1[0], y1[1]); o1[2 * n + 1] = cvtpk(y1[2], y1[3]);
                        o2[2 * n] = cvtpk(y2[0], y2[1]); o2[2 * n + 1] = cvtpk(y2[2], y2[3]);
                    }
                    if (un == 4) {
                        const int kk = t & 31, cs_ = (wc == 0) ? ((kk & ~12) | ((kk & 4) << 1) | ((kk & 8) >> 1)) : kk;
                        bf16_t* fb = ob + ((size_t)(t >> 5) * 256 + (fq >> 1) * 64 + (fq & 1) * 32 + cs_) * 8;
                        *(u32x4*)fb = o1; *(u32x4*)(fb + 128 * 8) = o2;
                    } else {
                    *(u32x4*)(ob + (size_t)t * ld + cb + 8 * fq) = o1;
                    *(u32x4*)(ob + (size_t)t * ld + cb + 32 + 8 * fq) = o2;
                    }
                }
        } else if (un == 4 && wc == 1) {
            bf16_t* ob = (bf16_t*)(ws + WS_V);
#pragma unroll
            for (int ai = 0; ai < 2; ++ai)
#pragma unroll
                for (int m = 0; m < 4; ++m) {
                    const int t = opq(u.pm * 256 + ai * 128 + wr * 64 + m * 16 + fr), pos = t & (S - 1);
#pragma unroll
                    for (int bj = 0; bj < 2; ++bj)
#pragma unroll
                        for (int n = 0; n < 2; ++n)
#pragma unroll
                            for (int e = 0; e < 4; ++e) ob[((((size_t)(t >> 5) * 4 + bj + ((pos >> 4) & 1) * 2) * 2 + ((pos >> 3) & 1)) * 32 + 8 * fq + 4 * n + e) * 8 + (pos & 7)] = f2bf(acc[ai][bj][m][n][e]);
                }
        } else if (un == 4) {
            float* ob = (float*)(ws + WS_IW);
            if (fq == 0) {
#pragma unroll
                for (int ai = 0; ai < 2; ++ai)
#pragma unroll
                    for (int m = 0; m < 4; ++m) {
                        const int t = u.pm * 256 + ai * 128 + wr * 64 + m * 16 + fr;
                        *(pg8::f32x4*)(ob + (size_t)t * 8) = acc[ai][0][m][0] * (0.125f * 0.35355339059327373f);
                        *(pg8::f32x4*)(ob + (size_t)t * 8 + 4) = acc[ai][0][m][1] * (0.125f * 0.35355339059327373f);
                    }
            }
        } else if (un < 7) {
            bf16_t* ob = (bf16_t*)(ws + WS_BG);
#pragma unroll
            for (int ai = 0; ai < 2; ++ai)
#pragma unroll
                for (int m = 0; m < 4; ++m) {
                    const int t = opq(u.pm * 256 + ai * 128 + wr * 64 + m * 16 + fr);
#pragma unroll
                    for (int bj = 0; bj < 2; ++bj) {
                        const pg8::f32x4 a = acc[ai][bj][m][0], b = acc[ai][bj][m][1];
                        u32x4 o = {cvtpk(a[0], a[1]), cvtpk(a[2], a[3]), cvtpk(b[0], b[1]), cvtpk(b[2], b[3])};
                        *(u32x4*)(ob + (size_t)t * 512 + (un - 5) * 256 + 128 * bj + 32 * wc + 8 * fq) = o;
                    }
                }
        } else {
            bf16_t* ob = (bf16_t*)(ws + WS_Z);
#pragma unroll
            for (int ai = 0; ai < 2; ++ai)
#pragma unroll
                for (int m = 0; m < 4; ++m) {
                    const int t = opq(u.pm * 256 + ai * 128 + wr * 64 + m * 16 + fr);
                    const pg8::f32x4 a = acc[ai][0][m][0] * acc[ai][1][m][0], b = acc[ai][0][m][1] * acc[ai][1][m][1];
                    u32x4 o = {cvtpk(a[0], a[1]), cvtpk(a[2], a[3]), cvtpk(b[0], b[1]), cvtpk(b[2], b[3])};
                    *(u32x4*)(ob + (size_t)t * 512 + (un - 7) * 128 + 32 * wc + 8 * fq) = o;
                }
        }
    }
};


struct MlEpi8 {
    static constexpr bool PERM = true, AFTER_DRAIN = false;
    const Params* p; int j;
    __device__ __forceinline__ void operator()(const pg8::f32x4 (&acc)[2][2][4][2], const pg8::Unit& u, int wr, int wc, int fr, int fq) const {
        unsigned char* ws = p->ws;
        const int un = u.pn;
        if (un < 4 || un >= 8) {
            bf16_t* ob; int ld, cb0; float sc = 1.f;
            if (un < 2) { ob = (bf16_t*)(ws + WS_MQ); ld = 512; cb0 = 64 * (4 * un + wc); sc = 0.125f; }
            else if (un < 4) { ob = (bf16_t*)(ws + WS_MK); ld = 512; cb0 = 64 * (4 * (un - 2) + wc); }
            else { ob = (bf16_t*)(ws + WS_MOG); ld = 1024; cb0 = (un - 8) * 256 + 32 * wc; }
            const int bstep = un < 4 ? 32 : 128;
#pragma unroll
            for (int ai = 0; ai < 2; ++ai)
#pragma unroll
                for (int m = 0; m < 4; ++m) {
                    const int t = opq(u.pm * 256 + ai * 128 + wr * 64 + m * 16 + fr);
#pragma unroll
                    for (int bj = 0; bj < 2; ++bj) {
                        pg8::f32x4 a = acc[ai][bj][m][0] * sc, b = acc[ai][bj][m][1] * sc;
                        if (un >= 8) { for (int e = 0; e < 4; ++e) { a[e] = sigmoidf_(a[e]); b[e] = sigmoidf_(b[e]); } }
                        u32x4 o = {cvtpk(a[0], a[1]), cvtpk(a[2], a[3]), cvtpk(b[0], b[1]), cvtpk(b[2], b[3])};
                        *(u32x4*)(ob + (size_t)t * ld + cb0 + bstep * bj + 8 * fq) = o;
                    }
                }
        }
        if (un >= 2 && un < 8) {
            bf16_t* ob = (bf16_t*)(ws + (un < 4 ? WS_MKT : WS_MV));
#pragma unroll
            for (int ai = 0; ai < 2; ++ai)
#pragma unroll
                for (int m = 0; m < 4; ++m) {
                    const int t = opq(u.pm * 256 + ai * 128 + wr * 64 + m * 16 + fr), pos = t & (S - 1), bb = t >> 11;
#pragma unroll
                    for (int bj = 0; bj < 2; ++bj) {
                        const size_t rowb = un < 4 ? (size_t)((bb * 8 + 4 * (un - 2) + wc) * 64 + 32 * bj + 8 * fq) : (size_t)((bb * 8 + 2 * (un - 4) + bj) * 128 + 32 * wc + 8 * fq);
#pragma unroll
                        for (int n = 0; n < 2; ++n)
#pragma unroll
                            for (int e = 0; e < 4; ++e) ob[(rowb + 4 * n + e) * S + pos] = f2bf(acc[ai][bj][m][n][e]);
                    }
                }
        }
    }
};


struct MoeOrder8 {
    static constexpr bool GATHER = true;
    const int* tab; const int* elist; int G, c, total, mode;
    __device__ __forceinline__ bool next(int i, pg8::Unit& u) const {
        const int L = i * G + c; if (L >= total) return false;
        int wg = L; { const int q = total >> 3, r = total & 7, x = wg & 7, off = wg >> 3; wg = (x < r ? x * (q + 1) : r * (q + 1) + (x - r) * q) + off; }
        const int ru = wg >> 2; int e = 0;
        while (e < 31 && tab[e + 1] <= ru) ++e;
        u.pm = __builtin_amdgcn_readfirstlane((e << 8) | (ru - tab[e])); u.pn = __builtin_amdgcn_readfirstlane(e * 4 + (wg & 3)); return true;
    }
    __device__ __forceinline__ unsigned a_off(const pg8::Unit& u, int row) const {
        const int e = u.pm >> 8, lr = (u.pm & 255) * 256 + row;
        if (lr >= tab[40 + e]) return 0u;
        if (mode == 1) return (unsigned)(elist[e * NASG + lr] >> 1) * 2048u;
        return (unsigned)(tab[80 + e] + lr) * 1024u;
    }
    __device__ __forceinline__ void a_ready(const pg8::Unit&) const {}
    __device__ __forceinline__ void done(const pg8::Unit&) const {}
};
struct Moe1Epi8 {
    static constexpr bool PERM = true, AFTER_DRAIN = false;
    const int* tab; bf16_t* h1;
    __device__ __forceinline__ void operator()(const pg8::f32x4 (&acc)[2][2][4][2], const pg8::Unit& u, int wr, int wc, int fr, int fq) const {
        const int e = u.pm >> 8, mu = u.pm & 255, nu = u.pn & 3, cnt = tab[40 + e], roff = tab[80 + e];
#pragma unroll
        for (int ai = 0; ai < 2; ++ai)
#pragma unroll
            for (int m = 0; m < 4; ++m) {
                const int lr = opq(mu * 256 + ai * 128 + wr * 64 + m * 16 + fr);
                if (lr < cnt) {
                    u32x4 o;
#pragma unroll
                    for (int n = 0; n < 2; ++n) {
                        const pg8::f32x4 g = acc[ai][0][m][n], up = acc[ai][1][m][n]; float h[4];
#pragma unroll
                        for (int x = 0; x < 4; ++x) h[x] = g[x] / (1.f + __expf(-g[x])) * up[x];
                        o[2 * n] = cvtpk(h[0], h[1]); o[2 * n + 1] = cvtpk(h[2], h[3]);
                    }
                    *(u32x4*)(h1 + (size_t)(roff + lr) * 512 + 128 * nu + 32 * wc + 8 * fq) = o;
                }
            }
    }
};
struct Moe2Epi8 {
    static constexpr bool PERM = true, AFTER_DRAIN = false;
    const int* tab; const int* elist; bf16_t* y;
    __device__ __forceinline__ void operator()(const pg8::f32x4 (&acc)[2][2][4][2], const pg8::Unit& u, int wr, int wc, int fr, int fq) const {
        const int e = u.pm >> 8, mu = u.pm & 255, nu = u.pn & 3, cnt = tab[40 + e];
#pragma unroll
        for (int ai = 0; ai < 2; ++ai)
#pragma unroll
            for (int m = 0; m < 4; ++m) {
                const int lr = opq(mu * 256 + ai * 128 + wr * 64 + m * 16 + fr);
                if (lr < cnt) {
                    const int a = elist[e * NASG + lr];
#pragma unroll
                    for (int bj = 0; bj < 2; ++bj) {
                        const pg8::f32x4 v0 = acc[ai][bj][m][0], v1 = acc[ai][bj][m][1];
                        u32x4 o = {cvtpk(v0[0], v0[1]), cvtpk(v0[2], v0[3]), cvtpk(v1[0], v1[1]), cvtpk(v1[2], v1[3])};
                        *(u32x4*)(y + (size_t)a * 1024 + 256 * nu + 128 * bj + 32 * wc + 8 * fq) = o;
                    }
                }
            }
    }
};

#define XB_TMO      128
#define XB_XCNT(j)  (256  + 64 * (j))
#define XB_XSUB(j)  (1280 + 64 * (j))
#define XB_XGEN(j)  (2304 + 64 * (j))
#define XB_TOP      3328
#define XB_TOPGEN   3392
#define XCD_BAR_WORDS 3456
#define XB_SPIN_CAP (1u << 22)
#define LAS __attribute__((address_space(3)))
DI unsigned xb_ld(unsigned* p) { return __hip_atomic_load(p, __ATOMIC_RELAXED, __HIP_MEMORY_SCOPE_AGENT); }
DI unsigned xb_add(unsigned* p, unsigned v) { return __hip_atomic_fetch_add(p, v, __ATOMIC_RELAXED, __HIP_MEMORY_SCOPE_AGENT); }
DI unsigned xb_xcc_id() { return (unsigned)__builtin_amdgcn_s_getreg((3 << 11) | 20) & 0xFu; }
#define XB_SPIN(cond, bar) do { unsigned _sp = 0; while (cond) { __builtin_amdgcn_s_sleep(1); \
    if ((++_sp & 255u) == 0u) { if (xb_ld(&(bar)[XB_TMO])) break; if (_sp > XB_SPIN_CAP) { atomicAdd(&(bar)[XB_TMO], 1u); break; } } } } while (0)
struct XcdBarrier { unsigned* bar; unsigned x; volatile LAS unsigned* st; };
DI XcdBarrier xcd_barrier_post(unsigned* bar, volatile LAS unsigned* st, bool leader) {
    XcdBarrier b; b.bar = bar; b.x = xb_xcc_id(); b.st = st;
    if (leader) (void)xb_add(&bar[XB_XCNT(b.x)], 1u);
    return b;
}
DI void xcd_barrier_complete(unsigned* bar, unsigned x, unsigned& nloc, unsigned& nx) {
    const unsigned G = gridDim.x * gridDim.y * gridDim.z;
    unsigned sum, cnt, mine, sp = 0u;
    for (;;) {
        sum = 0u; cnt = 0u; mine = 0u;
#pragma unroll
        for (unsigned j = 0; j < 16; ++j) { const unsigned c = xb_ld(&bar[XB_XCNT(j)]); sum += c; cnt += (c > 0u) ? 1u : 0u; mine = (j == x) ? c : mine; }
        if (sum == G) break;
        __builtin_amdgcn_s_sleep(1);
        if ((++sp & 255u) == 0u) { if (xb_ld(&bar[XB_TMO])) break; if (sp > XB_SPIN_CAP) { atomicAdd(&bar[XB_TMO], 1u); break; } }
    }
    nloc = mine > 0u ? mine : 1u; nx = cnt > 0u ? cnt : 1u;
}
DI void xcd_barrier(const XcdBarrier& b, bool leader) {
    asm volatile("s_waitcnt vmcnt(0)" ::: "memory");
    __syncthreads();
    if (leader) {
        unsigned* bar = b.bar;
        __builtin_amdgcn_s_waitcnt(0);
        unsigned nloc = b.st[0], nx = b.st[1];
        if (nloc == 0u) { xcd_barrier_complete(bar, b.x, nloc, nx); b.st[0] = nloc; b.st[1] = nx; }
        const unsigned old = xb_add(&bar[XB_XSUB(b.x)], 1u);
        const unsigned gen = old / nloc;
        if (old + 1u == (gen + 1u) * nloc) {
            __builtin_amdgcn_fence(__ATOMIC_RELEASE, "agent");
            asm volatile("s_waitcnt vmcnt(0)" ::: "memory");
            const unsigned og = xb_add(&bar[XB_TOP], 1u);
            const unsigned tg = og / nx;
            if (og + 1u == (tg + 1u) * nx) xb_add(&bar[XB_TOPGEN], 1u);
            else XB_SPIN(xb_ld(&bar[XB_TOPGEN]) == tg, bar);
            __builtin_amdgcn_fence(__ATOMIC_ACQUIRE, "agent");
            xb_add(&bar[XB_XGEN(b.x)], 1u);
            asm volatile("s_waitcnt vmcnt(0)" ::: "memory");
        } else {
            XB_SPIN(xb_ld(&bar[XB_XGEN(b.x)]) == gen, bar);
            __builtin_amdgcn_fence(__ATOMIC_ACQUIRE, "agent");
            asm volatile("s_waitcnt vmcnt(0)" ::: "memory");
        }
    }
    __syncthreads();
}

namespace cg = cooperative_groups;
constexpr int MEGA_LDS = 65536 + 256;

DI const Params& fresh(const Params* kp) { asm volatile("" : "+s"(kp)); return *kp; }

#ifndef PROBE_MASK
#define PROBE_MASK 0
#endif
__global__ void __launch_bounds__(512, 2) hybrid_fwd_megakernel(Params p_arg) {
    __shared__ __attribute__((aligned(16))) unsigned char smem_all[2 * MEGA_LDS + 1024];
    cg::grid_group grid = cg::this_grid();
    const Params* kp = (const Params*)__builtin_amdgcn_kernarg_segment_ptr();
    const int wave8 = __builtin_amdgcn_readfirstlane((int)(threadIdx.x >> 6));
    const int vb = wave8 >> 2;
#define tid0 ((wave8 & 3) * 64 + lane_id())
    unsigned char* smem = smem_all + vb * MEGA_LDS;
    const int bid0 = blockIdx.x * 2 + vb, nb = gridDim.x * 2;
    const int gx0 = blockIdx.x & 7, glb0 = (blockIdx.x >> 3) * 2 + vb, gnl = (gridDim.x >> 3) * 2;
#define bid opqs(bid0)
#define gx opqs(gx0)
#define glb opqs(glb0)
#define tid opq(tid0)
    volatile LAS unsigned* xst = (volatile LAS unsigned*)(smem_all + 2 * MEGA_LDS);
    if (wave8 == 0 && lane_id() == 0) { xst[0] = 0u; xst[1] = 0u; }
    __syncthreads();
    (void)xcd_barrier_post((unsigned*)(fresh(kp).ws + WS_BAR), xst, wave8 == 0 && lane_id() == 0);
    for (int rep = 0; rep < ((PROBE_MASK & 1) ? 2 : 1); ++rep) { phase_init(fresh(kp), smem, bid, nb, tid); }
#define GSYNC() do { XcdBarrier xb_; xb_.bar = (unsigned*)(fresh(kp).ws + WS_BAR); xb_.x = xb_xcc_id(); xb_.st = (volatile LAS unsigned*)(smem_all + 2 * MEGA_LDS); xcd_barrier(xb_, wave8 == 0 && lane_id() == 0); } while (0)
    if (fresh(kp).use_cg_sync) grid.sync();
    GSYNC();
#pragma unroll 1
    for (int layer = 0; layer < DEPTH; ++layer) {
        const int j = layer >> 1;
        if (layer == 0) { { const Params& p = fresh(kp); phase_norm(p, 0, p.x, bid, nb, tid); }
        GSYNC(); }
        if ((layer & 1) == 0) {
            for (int rep = 0; rep < ((PROBE_MASK & 4) ? 2 : 1); ++rep) { { const Params& p = fresh(kp);
              pg8::Gemm g8{(const pg8::bf16_t*)(p.ws + WS_H), (const pg8::bf16_t*)(p.ws + WS_WHYB) + (size_t)j * 2816 * 1024, T, 2816, 1024};
              pg8::StaticOrder S8; S8.init(T, 2816, (int)gridDim.x, (int)blockIdx.x);
              HybEpi8 E8{&p, j};
              pg8::gemm_phase<HybEpi8, pg8::StaticOrder, true, true>((PG8_LAS unsigned char*)smem_all, g8, S8, E8, wave8 * 64 + lane_id()); } }
            GSYNC();
            for (int rep = 0; rep < ((PROBE_MASK & 8) ? 2 : 1); ++rep) { phase_dsa(fresh(kp), j, smem, bid, nb, tid, layer == 0 ? 1 : 3, layer == 0 ? 3 : 4); }
            for (int rep = 0; rep < ((PROBE_MASK & 16) ? 2 : 1); ++rep) { phase_conv(fresh(kp), j, bid, nb, tid); }
            GSYNC();
            { const Params& p = fresh(kp);
              pg8::Gemm g8{(const pg8::bf16_t*)(p.ws + WS_YMIX), (const pg8::bf16_t*)(p.ws + WS_WOUT) + (size_t)layer * 1024 * 1024, T, 1024, 1024};
              pg8::StaticOrder S8; S8.init(T, 1024, (int)gridDim.x, (int)blockIdx.x);
              OutEpi8 E8{layer == 0 ? p.x : p.out, p.out, (const float*)(p.ws + WS_MOD) + (size_t)layer * 8 * 6144 + 2048, (float*)(p.ws + WS_PART)};
              pg8::gemm_phase<OutEpi8, pg8::StaticOrder, true, true>((PG8_LAS unsigned char*)smem_all, g8, S8, E8, wave8 * 64 + lane_id()); }
        } else {
            for (int rep = 0; rep < ((PROBE_MASK & 32) ? 2 : 1); ++rep) { { const Params& p = fresh(kp);
              pg8::Gemm g8{(const pg8::bf16_t*)(p.ws + WS_H), (const pg8::bf16_t*)(p.ws + WS_WML) + (size_t)j * 3200 * 1024, T, 3072, 1024};
              pg8::StaticOrder S8; S8.init(T, 3072, (int)gridDim.x, (int)blockIdx.x);
              MlEpi8 E8{&p, j};
              pg8::gemm_phase<MlEpi8, pg8::StaticOrder, true, true>((PG8_LAS unsigned char*)smem_all, g8, S8, E8, wave8 * 64 + lane_id());
              for (int gi = glb; gi < 16; gi += gnl) { MlGates pr{&p, j, gx * 16 + gi}; gemm_tile(pr, smem, tid); } } }
            GSYNC();
            for (int rep = 0; rep < ((PROBE_MASK & 64) ? 2 : 1); ++rep) { phase_ml1(fresh(kp), smem, bid, nb, tid); }
            GSYNC();
            for (int rep = 0; rep < ((PROBE_MASK & 128) ? 2 : 1); ++rep) { phase_ml2(fresh(kp), smem, bid, nb, tid); }
            GSYNC();
            for (int rep = 0; rep < ((PROBE_MASK & 256) ? 2 : 1); ++rep) { phase_ml3(fresh(kp), j, smem, bid, nb, tid); }
            GSYNC();
            { const Params& p = fresh(kp);
              pg8::Gemm g8{(const pg8::bf16_t*)(p.ws + WS_YMIX), (const pg8::bf16_t*)(p.ws + WS_WOUT) + (size_t)layer * 1024 * 1024, T, 1024, 1024};
              pg8::StaticOrder S8; S8.init(T, 1024, (int)gridDim.x, (int)blockIdx.x);
              OutEpi8 E8{p.out, p.out, (const float*)(p.ws + WS_MOD) + (size_t)layer * 8 * 6144 + 2048, (float*)(p.ws + WS_PART)};
              pg8::gemm_phase<OutEpi8, pg8::StaticOrder, true, true>((PG8_LAS unsigned char*)smem_all, g8, S8, E8, wave8 * 64 + lane_id()); }
        }
        GSYNC();
        phase_ffn_norm_router(fresh(kp), layer, smem, bid, nb, tid);
        GSYNC();
        { const Params& p = fresh(kp); unsigned char* wsu = uniform_ptr(p.ws);
          int* mtab = (int*)(smem_all + 2 * MEGA_LDS + 64);
          __syncthreads();
          if (wave8 == 0 && lane_id() == 0) {
              const int* ecnt = (const int*)(wsu + WS_ECNT) + layer * 32 * ECS; int ua = 0, ra = 0;
              for (int e = 0; e < 32; ++e) { const int cn = ecnt[e * ECS]; mtab[e] = ua; mtab[40 + e] = cn; mtab[80 + e] = ra; ua += (cn + 255) >> 8; ra += cn; }
              mtab[32] = ua;
          }
          __syncthreads();
          MoeOrder8 S8{mtab, (const int*)(wsu + WS_ELIST), (int)gridDim.x, (int)blockIdx.x, mtab[32] * 4, 1};
          pg8::Gemm g8{(const pg8::bf16_t*)(wsu + WS_H), (const pg8::bf16_t*)(wsu + WS_WM1) + (size_t)layer * 32 * 1024 * 1024, 0, 0, 1024};
          Moe1Epi8 E8{mtab, (bf16_t*)(wsu + WS_H1)};
          pg8::gemm_phase<Moe1Epi8, MoeOrder8, true, true>((PG8_LAS unsigned char*)smem_all, g8, S8, E8, wave8 * 64 + lane_id()); }
        GSYNC();
        { const Params& p = fresh(kp); unsigned char* wsu = uniform_ptr(p.ws);
          int* mtab = (int*)(smem_all + 2 * MEGA_LDS + 64);
          MoeOrder8 S8{mtab, (const int*)(wsu + WS_ELIST), (int)gridDim.x, (int)blockIdx.x, mtab[32] * 4, 2};
          pg8::Gemm g8{(const pg8::bf16_t*)(wsu + WS_H1), (const pg8::bf16_t*)(wsu + WS_WM2) + (size_t)layer * 32 * 1024 * 512, 0, 0, 512};
          Moe2Epi8 E8{mtab, (const int*)(wsu + WS_ELIST), (bf16_t*)(wsu + WS_Y)};
          pg8::gemm_phase<Moe2Epi8, MoeOrder8, true, true>((PG8_LAS unsigned char*)smem_all, g8, S8, E8, wave8 * 64 + lane_id()); }
        GSYNC();
        phase_combine_norm(fresh(kp), layer, bid, nb, tid);
        if (layer + 1 < DEPTH) GSYNC();
    }
}
#undef tid
#undef tid0
#undef bid
#undef gx
#undef glb
#undef GSYNC

extern "C" void kernel_launch(void* const* d_in, const int* in_sizes, int n_in, void* d_out, int out_size, void* d_ws, size_t ws_size, hipStream_t stream) {
    Params p{};
    const float** f = (const float**)&p;
    for (int i = 0; i < 22; ++i) f[i] = (const float*)d_in[i];
    p.out = (float*)d_out;
    p.ws = (unsigned char*)d_ws;
    if (ws_size < WS_END) { fprintf(stderr, "workspace too small: %zu < %zu\n", ws_size, (size_t)WS_END); return; }
    static int grid_blocks = 0;
    if (!grid_blocks) {
        int dev = 0, cus = 0, per_cu = 0;
        hipGetDevice(&dev);
        hipDeviceGetAttribute(&cus, hipDeviceAttributeMultiprocessorCount, dev);
        hipOccupancyMaxActiveBlocksPerMultiprocessor(&per_cu, hybrid_fwd_megakernel, 512, 0);
        if (per_cu > 1) per_cu = 1;
        grid_blocks = cus * per_cu;
    }
    (void)hipMemsetAsync((unsigned char*)d_ws + WS_BAR, 0, XCD_BAR_WORDS_C * 4, stream);
    void* args[] = {&p};
    hipError_t e = hipLaunchCooperativeKernel((void*)hybrid_fwd_megakernel, dim3(grid_blocks), dim3(512), args, 0, stream);
    if (e != hipSuccess) fprintf(stderr, "cooperative launch failed: %s (grid %d)\n", hipGetErrorString(e), grid_blocks);
}
```

```cpp
#include <hip/hip_runtime.h>
#include <hip/hip_cooperative_groups.h>
#include <stdint.h>
#include <cstdio>

#define DI __device__ __forceinline__
typedef unsigned short bf16_t;
typedef short bf16x8 __attribute__((ext_vector_type(8)));
typedef float f32x16 __attribute__((ext_vector_type(16)));
typedef float f32x4 __attribute__((ext_vector_type(4)));
typedef float f32x2 __attribute__((ext_vector_type(2)));
typedef unsigned u32x4 __attribute__((ext_vector_type(4)));
typedef unsigned u32x2 __attribute__((ext_vector_type(2)));
typedef __bf16 bf16x2_t __attribute__((ext_vector_type(2)));

constexpr int D = 1024, NB = 8, S = 2048, T = NB * S, DEPTH = 4;
constexpr int HYB_IN = 2760, ML_IN = 3088;
constexpr int NEXP = 32, DEXP = 512, NASG = T * 2;
constexpr float EPS = 1e-6f;
constexpr int XCD_BAR_WORDS_C = 3456;

constexpr size_t al256(size_t x) { return (x + 255) & ~(size_t)255; }
constexpr size_t WS_MOD = 0;
constexpr size_t WS_ROPEC = WS_MOD + al256((size_t)4 * 8 * 6144 * 4);
constexpr size_t WS_ROPES = WS_ROPEC + al256((size_t)2048 * 32 * 4);
constexpr size_t WS_ECNT = WS_ROPES + al256((size_t)2048 * 32 * 4);
constexpr int ECS = 64;
constexpr size_t WS_H = WS_ECNT + al256(4 * 32 * ECS * 4);
constexpr size_t WS_YMIX = WS_H + al256((size_t)T * 1024 * 2);
constexpr size_t WS_Q = WS_YMIX + al256((size_t)T * 1024 * 2);
constexpr size_t WS_K = WS_Q + al256((size_t)T * 512 * 2);
constexpr size_t WS_V = WS_K + al256((size_t)T * 64 * 2);
constexpr size_t WS_IQ = WS_V + al256((size_t)T * 64 * 2);
constexpr size_t WS_IK = WS_IQ + al256((size_t)T * 512 * 2);
constexpr size_t WS_IW = WS_IK + al256((size_t)T * 64 * 2);
constexpr size_t WS_BG = WS_IW + al256((size_t)T * 8 * 4);
constexpr size_t WS_Z = WS_BG + al256((size_t)T * 512 * 2);
constexpr size_t WS_MASK = WS_Z + al256((size_t)T * 512 * 2);
constexpr size_t WS_MQ = WS_MASK + al256((size_t)T * 64 * 4);
constexpr size_t WS_MK = WS_MQ + al256((size_t)T * 512 * 2);
constexpr size_t WS_MV = WS_MK + al256((size_t)T * 512 * 2);
constexpr size_t WS_MIG = WS_MV + al256((size_t)T * 1024 * 2);
constexpr size_t WS_MFG = WS_MIG + al256((size_t)T * 8 * 4);
constexpr size_t WS_MOG = WS_MFG + al256((size_t)T * 8 * 4);
constexpr size_t WS_EW = WS_MOG + al256((size_t)T * 1024 * 2);
constexpr size_t WS_ELIST = WS_EW + al256((size_t)NASG * 4);
constexpr size_t WS_H1 = WS_ELIST + al256((size_t)NEXP * NASG * 4);
constexpr size_t WS_Y = WS_H1 + al256((size_t)NASG * 512 * 2);
constexpr size_t WS_MKT = WS_Y + al256((size_t)NASG * 1024 * 2);
constexpr size_t WS_UBUF = WS_MKT + al256((size_t)64 * 64 * S * 2);
constexpr size_t WS_UNBUF = WS_UBUF + al256((size_t)64 * 32 * 8192 * 4);
constexpr size_t WS_MLOC = WS_UNBUF + al256((size_t)64 * 32 * 64 * 4);
constexpr size_t WS_CBUF = WS_MLOC + al256((size_t)64 * 32 * 2 * 4);
constexpr size_t WS_NBUF = WS_CBUF + al256((size_t)64 * 32 * 8192 * 2);
constexpr size_t WS_MST = WS_NBUF + al256((size_t)64 * 32 * 64 * 4);
constexpr size_t WS_PART = WS_MST + al256((size_t)64 * 32 * 4);
constexpr size_t WS_WHYB = WS_PART + al256((size_t)T * 16 * 4);
constexpr size_t WS_WML = WS_WHYB + al256((size_t)2 * 2816 * 1024 * 2);
constexpr size_t WS_WOUT = WS_WML + al256((size_t)2 * 3200 * 1024 * 2);
constexpr size_t WS_WM1 = WS_WOUT + al256((size_t)4 * 1024 * 1024 * 2);
constexpr size_t WS_WM2 = WS_WM1 + al256((size_t)4 * 32 * 1024 * 1024 * 2);
constexpr size_t WS_BAR = WS_WM2 + al256((size_t)4 * 32 * 1024 * 512 * 2);
constexpr size_t WS_END = WS_BAR + al256((size_t)XCD_BAR_WORDS_C * 4);

struct Params {
    const float *x, *c, *ada_w, *ada_b, *norm_mix, *norm_ffn, *hy_w_in, *hy_q_norm, *hy_k_norm, *hy_conv_w, *hy_w_out;
    const float *ml_w_in, *ml_b_gates, *ml_out_norm, *ml_w_out, *moe_w_group, *moe_b_group, *moe_w_expert, *moe_b_expert;
    const float *moe_w_gate, *moe_w_up, *moe_w_down;
    float* out;
    unsigned char* ws;
    unsigned long long use_cg_sync;
};

DI unsigned pk2(float lo, float hi) { f32x2 v = {lo, hi}; bf16x2_t b = __builtin_convertvector(v, bf16x2_t); return __builtin_bit_cast(unsigned, b); }
DI bf16_t f2bf(float x) { return (bf16_t)(pk2(x, 0.f) & 0xffffu); }
DI float bf2f(bf16_t h) { return __uint_as_float(((unsigned)h) << 16); }
DI float bflo(unsigned u) { return __uint_as_float(u << 16); }
DI float bfhi(unsigned u) { return __uint_as_float(u & 0xffff0000u); }
DI int lane_id() { int x; asm volatile("v_mbcnt_lo_u32_b32 %0, -1, 0\n\tv_mbcnt_hi_u32_b32 %0, -1, %0" : "=v"(x)); return x; }
template <int M> DI int sx_i(int v) {
    if constexpr (M < 32) return __builtin_amdgcn_ds_swizzle(v, (M << 10) | 0x1f);
    else return __builtin_amdgcn_ds_bpermute((lane_id() ^ 32) << 2, v);
}
template <int M> DI float sx_f(float v) { return __int_as_float(sx_i<M>(__float_as_int(v))); }
DI float lane_get_f(float v, int src) { return __int_as_float(__builtin_amdgcn_ds_bpermute(src << 2, __float_as_int(v))); }
DI float wave_sum(float v) { v += sx_f<32>(v); v += sx_f<16>(v); v += sx_f<8>(v); v += sx_f<4>(v); v += sx_f<2>(v); v += sx_f<1>(v); return v; }
DI float wave_max(float v) { v = fmaxf(v, sx_f<32>(v)); v = fmaxf(v, sx_f<16>(v)); v = fmaxf(v, sx_f<8>(v)); v = fmaxf(v, sx_f<4>(v)); v = fmaxf(v, sx_f<2>(v)); v = fmaxf(v, sx_f<1>(v)); return v; }
DI float half_sum(float v) { v += sx_f<16>(v); v += sx_f<8>(v); v += sx_f<4>(v); v += sx_f<2>(v); v += sx_f<1>(v); return v; }
DI float sigmoidf_(float x) { return 1.f / (1.f + __expf(-x)); }
DI unsigned char* uniform_ptr(unsigned char* q) {
    const unsigned long long w = (unsigned long long)q;
    const unsigned lo = __builtin_amdgcn_readfirstlane((unsigned)w), hi = __builtin_amdgcn_readfirstlane((unsigned)(w >> 32));
    return (unsigned char*)(((unsigned long long)hi << 32) | lo);
}
DI int opqs(int x) { asm volatile("" : "+s"(x)); return x; }
DI int opq(int x) { asm volatile("" : "+v"(x)); return x; }

DI int swz(int row, int slot) { return row * 128 + ((slot ^ ((row >> 1) & 7)) << 4); }
DI int crow(int reg, int lane) { return (reg & 3) + 8 * (reg >> 2) + 4 * (lane >> 5); }

template <class P>
DI void gemm_tile(const P& pr, unsigned char* smem, int tid) {
    const int lane = tid & 63, wid = tid >> 6, wr = wid >> 1, wc = wid & 1;
    const bf16_t* abase = pr.a_base();
    const bf16_t* bbase = pr.b_base();
    const int kdim = pr.kt() * 64;
    int gao[4], gbo[4];
#pragma unroll
    for (int i = 0; i < 4; ++i) {
        const int row = (tid >> 3) + 32 * i, sl = (tid & 7) ^ ((row >> 1) & 7);
        const int o = pr.a_off(row);
        gao[i] = (o >= 0 ? o : 0) + sl * 8; gbo[i] = row * kdim + sl * 8;
    }
#define GLDS(buf, kt) do { _Pragma("unroll") for (int i = 0; i < 4; ++i) { \
        __builtin_amdgcn_global_load_lds((const unsigned*)(abase + gao[i] + (kt) * 64), (__attribute__((address_space(3))) unsigned*)(smem + (buf) * 32768 + (i * 256 + wid * 64) * 16), 16, 0, 0); \
        __builtin_amdgcn_global_load_lds((const unsigned*)(bbase + gbo[i] + (kt) * 64), (__attribute__((address_space(3))) unsigned*)(smem + (buf) * 32768 + 16384 + (i * 256 + wid * 64) * 16), 16, 0, 0); } } while (0)
#define DMA_WAIT_SYNC() do { asm volatile("s_waitcnt vmcnt(0)" ::: "memory"); __syncthreads(); } while (0)
#define COMPUTE(buf) do { const unsigned char* As = smem + (buf) * 32768; const unsigned char* Bs = As + 16384; \
        _Pragma("unroll") for (int ks = 0; ks < 4; ++ks) { const int slot = ks * 2 + (lane >> 5); \
            const bf16x8 a0 = *(const bf16x8*)(As + swz(wr * 64 + (lane & 31), slot)); const bf16x8 a1 = *(const bf16x8*)(As + swz(wr * 64 + 32 + (lane & 31), slot)); \
            const bf16x8 b0 = *(const bf16x8*)(Bs + swz(wc * 64 + (lane & 31), slot)); const bf16x8 b1 = *(const bf16x8*)(Bs + swz(wc * 64 + 32 + (lane & 31), slot)); \
            acc[0][0] = __builtin_amdgcn_mfma_f32_32x32x16_bf16(a0, b0, acc[0][0], 0, 0, 0); acc[0][1] = __builtin_amdgcn_mfma_f32_32x32x16_bf16(a0, b1, acc[0][1], 0, 0, 0); \
            acc[1][0] = __builtin_amdgcn_mfma_f32_32x32x16_bf16(a1, b0, acc[1][0], 0, 0, 0); acc[1][1] = __builtin_amdgcn_mfma_f32_32x32x16_bf16(a1, b1, acc[1][1], 0, 0, 0); } } while (0)
    f32x16 acc[2][2];
#pragma unroll
    for (int a = 0; a < 2; ++a)
#pragma unroll
        for (int b = 0; b < 2; ++b)
#pragma unroll
            for (int r = 0; r < 16; ++r) acc[a][b][r] = 0.f;
    const int KT = pr.kt();
    __syncthreads();
    GLDS(0, 0);
    DMA_WAIT_SYNC();
    for (int kt = 0; kt < KT; kt += 2) {
        GLDS(1, kt + 1);
        COMPUTE(0);
        DMA_WAIT_SYNC();
        if (kt + 2 < KT) GLDS(0, kt + 2);
        COMPUTE(1);
        DMA_WAIT_SYNC();
    }
#undef GLDS
#undef DMA_WAIT_SYNC
#undef COMPUTE
    pr.epi(acc, wr, wc, lane, smem + wid * 8192);
}

template <class P>
DI void convert_tile(const P& pr, bf16_t* dst, int kdim, int kt, unsigned char* smem, int tid) {
    unsigned char* Bs = smem;
    const int ng = tid & 31, kg = tid >> 5;
    int width = 0;
    const float* bp = pr.b_col(ng >> 3, width);
    const int cig = (ng & 7) * 4;
    const bool bvalid = cig < width;
    const int ldb = pr.ldb();
    bp += cig + (size_t)(kt * 64 + kg * 8) * ldb;
    f32x4 rb[8];
#pragma unroll
    for (int kk = 0; kk < 8; ++kk) rb[kk] = bvalid ? *(const f32x4*)(bp + (size_t)kk * ldb) : (f32x4){0.f, 0.f, 0.f, 0.f};
    __syncthreads();
#pragma unroll
    for (int j = 0; j < 4; ++j) {
        u32x4 v = {pk2(rb[0][j], rb[1][j]), pk2(rb[2][j], rb[3][j]), pk2(rb[4][j], rb[5][j]), pk2(rb[6][j], rb[7][j])};
        *(u32x4*)(Bs + swz(ng * 4 + j, kg)) = v;
    }
    __syncthreads();
#pragma unroll
    for (int i = 0; i < 4; ++i) {
        const int n = (tid >> 3) + 32 * i;
        *(u32x4*)(dst + (size_t)n * kdim + kt * 64 + (tid & 7) * 8) = *(const u32x4*)(Bs + swz(n, tid & 7));
    }
}

template <int NC> DI void stage_put(unsigned char* wl, int mi, int ni, int r, int lane, float v) { *(bf16_t*)(wl + ((mi * 32 + crow(r, lane)) * NC + ni * 32 + (lane & 31)) * 2) = f2bf(v); }
template <int NC, class RowPtr> DI void stage_flush(unsigned char* wl, int lane, RowPtr rp) {
    constexpr int CH = NC / 8, RPI = 64 / CH, NIT = 64 / RPI;
#pragma unroll
    for (int i = 0; i < NIT; ++i) {
        const int row = lane / CH + RPI * i, ch = lane % CH;
        const u32x4 d = *(const u32x4*)(wl + (row * NC + ch * 8) * 2);
        bf16_t* dst = rp(row);
        if (dst) *(u32x4*)(dst + ch * 8) = d;
    }
}

struct HybIn {
    const Params* p; int j, tm, tn;
    DI int kt() const { return 16; }
    DI int ldb() const { return HYB_IN; }
    DI const bf16_t* a_base() const { return (const bf16_t*)(p->ws + WS_H); }
    DI int a_off(int r) const { return (tm * 128 + r) * 1024; }
    DI static void pair_cols(int pr, int ni, int& base, int& width) {
        width = 32;
        if (pr < 8) base = 64 * pr + 32 * ni;
        else if (pr == 8) base = 512 + 32 * ni;
        else if (pr == 9) base = 576 + 32 * ni;
        else if (pr < 18) base = 640 + 64 * (pr - 10) + 32 * ni;
        else if (pr == 18) base = 1152 + 32 * ni;
        else if (pr == 19) { base = 1216; width = ni == 0 ? 8 : 0; }
        else if (pr < 28) base = 1224 + 64 * (pr - 20) + 32 * ni;
        else base = (ni == 0 ? 1736 : 2248) + 32 * (pr - 28);
    }
    DI const float* b_col(int g, int& width) const { int base; pair_cols(tn * 2 + (g >> 1), g & 1, base, width); return p->hy_w_in + (size_t)j * 1024 * HYB_IN + base; }
    DI const bf16_t* b_base() const { return (const bf16_t*)(p->ws + WS_WHYB) + (size_t)(j * 22 + tn) * 128 * 1024; }
    DI void epi(f32x16 (&acc)[2][2], int wr, int wc, int lane, unsigned char* wl) const {
        const int pr = tn * 2 + wc, c = lane & 31;
        const int t0 = tm * 128 + wr * 64;
        unsigned char* ws = p->ws;
        const float* ropec = (const float*)(ws + WS_ROPEC);
        const float* ropes = (const float*)(ws + WS_ROPES);
        if (pr < 9 || (pr >= 10 && pr < 19)) {
            const bool donorm = pr < 9;
            const float* gam = pr < 8 ? p->hy_q_norm + j * 64 : p->hy_k_norm + j * 64;
            bf16_t* ob; int ld, cb;
            if (pr < 8) { ob = (bf16_t*)(ws + WS_Q); ld = 512; cb = 64 * pr; }
            else if (pr == 8) { ob = (bf16_t*)(ws + WS_K); ld = 64; cb = 0; }
            else if (pr < 18) { ob = (bf16_t*)(ws + WS_IQ); ld = 512; cb = 64 * (pr - 10); }
            else { ob = (bf16_t*)(ws + WS_IK); ld = 64; cb = 0; }
            float g1 = 1.f, g2 = 1.f;
            if (donorm) { g1 = gam[c]; g2 = gam[c + 32]; }
#pragma unroll
            for (int mi = 0; mi < 2; ++mi)
#pragma unroll
                for (int r = 0; r < 16; ++r) {
                    float x1 = acc[mi][0][r], x2 = acc[mi][1][r];
                    const int t = t0 + mi * 32 + crow(r, lane), pos = t & (S - 1);
                    if (donorm) { float ss = half_sum(x1 * x1 + x2 * x2); float rstd = rsqrtf(ss * (1.f / 64.f) + EPS); x1 *= rstd * g1; x2 *= rstd * g2; }
                    const float cs = ropec[pos * 32 + c], sn = ropes[pos * 32 + c];
                    stage_put<64>(wl, mi, 0, r, lane, x1 * cs - x2 * sn);
                    stage_put<64>(wl, mi, 1, r, lane, x2 * cs + x1 * sn);
                }
            stage_flush<64>(wl, lane, [&](int row) { return ob + (size_t)(t0 + row) * ld + cb; });
        } else if (pr == 9) {
            bf16_t* ob = (bf16_t*)(ws + WS_V);
#pragma unroll
            for (int mi = 0; mi < 2; ++mi)
#pragma unroll
                for (int ni = 0; ni < 2; ++ni)
#pragma unroll
                    for (int g4 = 0; g4 < 4; ++g4) {
                        const int t = t0 + mi * 32 + 8 * g4 + 4 * (lane >> 5), pos = t & (S - 1), bb = t >> 11;
                        u32x2 o = {pk2(acc[mi][ni][4 * g4], acc[mi][ni][4 * g4 + 1]), pk2(acc[mi][ni][4 * g4 + 2], acc[mi][ni][4 * g4 + 3])};
                        *(u32x2*)(ob + ((size_t)(bb * 64 + ni * 32 + c)) * S + pos) = o;
                    }
        } else if (pr == 19) {
            float* ob = (float*)(ws + WS_IW);
            if (c < 8) {
#pragma unroll
                for (int mi = 0; mi < 2; ++mi)
#pragma unroll
                    for (int r = 0; r < 16; ++r) { const int t = t0 + mi * 32 + crow(r, lane); ob[(size_t)t * 8 + c] = acc[mi][0][r] * (0.125f * 0.35355339059327373f); }
            }
        } else if (pr < 28) {
            bf16_t* ob = (bf16_t*)(ws + WS_BG); const int cb = 64 * (pr - 20);
#pragma unroll
            for (int mi = 0; mi < 2; ++mi)
#pragma unroll
                for (int r = 0; r < 16; ++r) { stage_put<64>(wl, mi, 0, r, lane, acc[mi][0][r]); stage_put<64>(wl, mi, 1, r, lane, acc[mi][1][r]); }
            stage_flush<64>(wl, lane, [&](int row) { return ob + (size_t)(t0 + row) * 512 + cb; });
        } else {
            bf16_t* ob = (bf16_t*)(ws + WS_Z); const int cb = 32 * (pr - 28);
#pragma unroll
            for (int mi = 0; mi < 2; ++mi)
#pragma unroll
                for (int r = 0; r < 16; ++r) stage_put<32>(wl, mi, 0, r, lane, acc[mi][0][r] * acc[mi][1][r]);
            stage_flush<32>(wl, lane, [&](int row) { return ob + (size_t)(t0 + row) * 512 + cb; });
        }
    }
};


struct HybCols8 {
    const Params* p; int j, tm, tn;
    DI int ldb() const { return HYB_IN; }
    DI const float* b_col(int g, int& width) const {
        const int u = tn >> 1, bj = tn & 1; int base; width = 32;
        if (u < 2) base = 64 * (4 * u + g) + 32 * bj;
        else if (u < 4) base = 640 + 64 * (4 * (u - 2) + g) + 32 * bj;
        else if (u == 4) { if (g == 0) base = 512 + 32 * bj; else if (g == 1) base = 576 + 32 * bj; else if (g == 2) base = 1152 + 32 * bj; else { base = 1216; width = bj == 0 ? 8 : 0; } }
        else if (u < 7) base = 1224 + (u - 5) * 256 + 128 * bj + 32 * g;
        else base = (bj == 0 ? 1736 : 2248) + (u - 7) * 128 + 32 * g;
        return p->hy_w_in + (size_t)j * 1024 * HYB_IN + base;
    }
};

struct MlIn {
    const Params* p; int j, tm, tn;
    DI int kt() const { return 16; }
    DI int ldb() const { return ML_IN; }
    DI const bf16_t* a_base() const { return (const bf16_t*)(p->ws + WS_H); }
    DI int a_off(int r) const { return (tm * 128 + r) * 1024; }
    DI const float* b_col(int g, int& width) const {
        const int pr = tn * 2 + (g >> 1), ni = g & 1; int base; width = 32;
        if (pr < 32) base = 64 * pr + 32 * ni;
        else if (pr == 32) { base = 2048 + 8 * ni; width = 8; }
        else if (pr < 49) base = 2064 + 64 * (pr - 33) + 32 * ni;
        else { base = 0; width = 0; }
        return p->ml_w_in + (size_t)j * 1024 * ML_IN + base;
    }
    DI const bf16_t* b_base() const { return (const bf16_t*)(p->ws + WS_WML) + (size_t)(j * 25 + tn) * 128 * 1024; }
    DI void epi(f32x16 (&acc)[2][2], int wr, int wc, int lane, unsigned char* wl) const {
        const int pr = tn * 2 + wc, c = lane & 31;
        const int t0 = tm * 128 + wr * 64;
        unsigned char* ws = p->ws;
        if (pr < 16) {
            bf16_t* ob; int cb; float sc = 1.f;
            if (pr < 8) { ob = (bf16_t*)(ws + WS_MQ); cb = 64 * pr; sc = 0.125f; }
            else { ob = (bf16_t*)(ws + WS_MK); cb = 64 * (pr - 8); }
#pragma unroll
            for (int mi = 0; mi < 2; ++mi)
#pragma unroll
                for (int r = 0; r < 16; ++r) { stage_put<64>(wl, mi, 0, r, lane, acc[mi][0][r] * sc); stage_put<64>(wl, mi, 1, r, lane, acc[mi][1][r] * sc); }
            stage_flush<64>(wl, lane, [&](int row) { return ob + (size_t)(t0 + row) * 512 + cb; });
        }
        if (pr >= 8 && pr < 32) {
            bf16_t* ob; int nrow, hd, r0;
            if (pr < 16) { ob = (bf16_t*)(ws + WS_MKT); nrow = 64; hd = pr - 8; r0 = 0; }
            else { ob = (bf16_t*)(ws + WS_MV); nrow = 128; hd = (pr - 16) >> 1; r0 = 64 * ((pr - 16) & 1); }
#pragma unroll
            for (int mi = 0; mi < 2; ++mi)
#pragma unroll
                for (int ni = 0; ni < 2; ++ni)
#pragma unroll
                    for (int g4 = 0; g4 < 4; ++g4) {
                        const int t = t0 + mi * 32 + 8 * g4 + 4 * (lane >> 5), pos = t & (S - 1), bb = t >> 11;
                        u32x2 o = {pk2(acc[mi][ni][4 * g4], acc[mi][ni][4 * g4 + 1]), pk2(acc[mi][ni][4 * g4 + 2], acc[mi][ni][4 * g4 + 3])};
                        *(u32x2*)(ob + ((size_t)((bb * 8 + hd) * nrow + r0 + ni * 32 + c)) * S + pos) = o;
                    }
        } else if (pr == 32) {
            if (c < 8) {
                float* oi = (float*)(ws + WS_MIG); float* of = (float*)(ws + WS_MFG);
                const float bi = p->ml_b_gates[j * 16 + c], bfg = p->ml_b_gates[j * 16 + 8 + c];
#pragma unroll
                for (int mi = 0; mi < 2; ++mi)
#pragma unroll
                    for (int r = 0; r < 16; ++r) {
                        const int t = t0 + mi * 32 + crow(r, lane);
                        oi[(size_t)t * 8 + c] = acc[mi][0][r] + bi;
                        const float f = acc[mi][1][r] + bfg;
                        of[(size_t)t * 8 + c] = fminf(f, 0.f) - log1pf(__expf(-fabsf(f)));
                    }
            }
        } else if (pr >= 33 && pr < 49) {
            bf16_t* ob = (bf16_t*)(ws + WS_MOG); const int cb = 64 * (pr - 33);
#pragma unroll
            for (int mi = 0; mi < 2; ++mi)
#pragma unroll
                for (int r = 0; r < 16; ++r) { stage_put<64>(wl, mi, 0, r, lane, sigmoidf_(acc[mi][0][r])); stage_put<64>(wl, mi, 1, r, lane, sigmoidf_(acc[mi][1][r])); }
            stage_flush<64>(wl, lane, [&](int row) { return ob + (size_t)(t0 + row) * 1024 + cb; });
        }
    }
};


struct MlCols8 {
    const Params* p; int j, tm, tn;
    DI int ldb() const { return ML_IN; }
    DI const float* b_col(int g, int& width) const {
        const int u = tn >> 1, bj = tn & 1; int base; width = 32;
        if (tn == 24) { base = 2048 + 8 * (g & 1); width = g < 2 ? 8 : 0; }
        else if (u < 2) base = 64 * (4 * u + g) + 32 * bj;
        else if (u < 4) base = 512 + 64 * (4 * (u - 2) + g) + 32 * bj;
        else if (u < 8) base = 1024 + (2 * (u - 4) + bj) * 128 + 32 * g;
        else base = 2064 + (u - 8) * 256 + 128 * bj + 32 * g;
        return p->ml_w_in + (size_t)j * 1024 * ML_IN + base;
    }
};
struct MlGates {
    const Params* p; int j, tm;
    DI int kt() const { return 16; }
    DI const bf16_t* a_base() const { return (const bf16_t*)(p->ws + WS_H); }
    DI int a_off(int r) const { return (tm * 128 + r) * 1024; }
    DI const bf16_t* b_base() const { return (const bf16_t*)(p->ws + WS_WML) + (size_t)(j * 25 + 24) * 128 * 1024; }
    DI void epi(f32x16 (&acc)[2][2], int wr, int wc, int lane, unsigned char* wl) const {
        const int c = lane & 31, t0 = tm * 128 + wr * 64;
        if (wc == 0 && c < 8) {
            float* oi = (float*)(p->ws + WS_MIG); float* of = (float*)(p->ws + WS_MFG);
            const float bi = p->ml_b_gates[j * 16 + c], bfg = p->ml_b_gates[j * 16 + 8 + c];
#pragma unroll
            for (int mi = 0; mi < 2; ++mi)
#pragma unroll
                for (int r = 0; r < 16; ++r) {
                    const int t = t0 + mi * 32 + crow(r, lane);
                    oi[(size_t)t * 8 + c] = acc[mi][0][r] + bi;
                    const float f = acc[mi][1][r] + bfg;
                    of[(size_t)t * 8 + c] = fminf(f, 0.f) - log1pf(__expf(-fabsf(f)));
                }
        }
    }
};

struct OutProj {
    const Params* p; const float* W; const float* src; int layer, tm, tn;
    DI int kt() const { return 16; }
    DI int ldb() const { return 1024; }
    DI const bf16_t* a_base() const { return (const bf16_t*)(p->ws + WS_YMIX); }
    DI int a_off(int r) const { return (tm * 128 + r) * 1024; }
    DI const float* b_col(int g, int& width) const { width = 32; return W + tn * 128 + g * 32; }
    DI const bf16_t* b_base() const { return (const bf16_t*)(p->ws + WS_WOUT) + (size_t)(layer * 8 + tn) * 128 * 1024; }
    DI void epi(f32x16 (&acc)[2][2], int wr, int wc, int lane, unsigned char* wl) const {
        const int c = lane & 31, t0 = tm * 128 + wr * 64, wid = wr * 2 + wc;
        float* fl = (float*)(wl + wid * 8192);
#pragma unroll
        for (int mi = 0; mi < 2; ++mi)
#pragma unroll
            for (int ni = 0; ni < 2; ++ni)
#pragma unroll
                for (int r = 0; r < 16; ++r) fl[(mi * 32 + crow(r, lane)) * 64 + ni * 32 + c] = acc[mi][ni][r];
        const float* mod = (const float*)(p->ws + WS_MOD) + (size_t)layer * 8 * 6144;
        const int ch = lane & 15, n = tn * 128 + wc * 64 + ch * 4;
        const f32x4 g = *(const f32x4*)(mod + (t0 >> 11) * 6144 + 2048 + n);
        float* part = (float*)(p->ws + WS_PART);
#pragma unroll 4
        for (int i = 0; i < 16; ++i) {
            const int row = (lane >> 4) + 4 * i, t = t0 + row;
            const f32x4 a = *(const f32x4*)(fl + row * 64 + ch * 4);
            const f32x4 o = *(const f32x4*)(src + (size_t)t * 1024 + n) + g * a;
            *(f32x4*)(p->out + (size_t)t * 1024 + n) = o;
            float ss = o[0] * o[0] + o[1] * o[1] + o[2] * o[2] + o[3] * o[3];
            ss += sx_f<1>(ss); ss += sx_f<2>(ss); ss += sx_f<4>(ss); ss += sx_f<8>(ss);
            if (ch == 0) part[(size_t)t * 16 + tn * 2 + wc] = ss;
        }
    }
};

struct Moe1 {
    const Params* p; int layer, e, mt, nt, cnt, roff;
    DI int kt() const { return 16; }
    DI int ldb() const { return DEXP; }
    DI const bf16_t* a_base() const { return (const bf16_t*)(p->ws + WS_H); }
    DI int a_off(int r) const {
        const int rr = mt * 128 + r; if (rr >= cnt) return -1;
        const int a = ((const int*)(p->ws + WS_ELIST))[(size_t)e * NASG + rr];
        return (a >> 1) * 1024;
    }
    DI const float* b_col(int g, int& width) const {
        width = 32;
        const float* base = (nt & 1) ? p->moe_w_up : p->moe_w_gate;
        return base + ((size_t)layer * NEXP + e) * (size_t)(D * DEXP) + 128 * (nt >> 1) + 32 * g;
    }
    DI const bf16_t* b_base() const { return (const bf16_t*)(p->ws + WS_WM1) + (size_t)((layer * NEXP + e) * 8 + nt) * 128 * 1024; }
    DI void epi(f32x16 (&acc)[2][2], int wr, int wc, int lane, unsigned char* wl) const {
        const int c = lane & 31, pr = nt * 2 + wc;
        bf16_t* ob = (bf16_t*)(p->ws + WS_H1);
#pragma unroll
        for (int mi = 0; mi < 2; ++mi)
#pragma unroll
            for (int r = 0; r < 16; ++r) {
                const float g = acc[mi][0][r], u = acc[mi][1][r];
                stage_put<32>(wl, mi, 0, r, lane, g / (1.f + __expf(-g)) * u);
            }
        const int rb = mt * 128 + wr * 64;
        stage_flush<32>(wl, lane, [&](int row) { return rb + row < cnt ? ob + (size_t)(roff + rb + row) * 512 + 32 * pr : (bf16_t*)nullptr; });
    }
};

struct Moe2 {
    const Params* p; int layer, e, mt, nt, cnt, roff;
    DI int kt() const { return 8; }
    DI int ldb() const { return D; }
    DI const bf16_t* a_base() const { return (const bf16_t*)(p->ws + WS_H1); }
    DI int a_off(int r) const { const int rr = mt * 128 + r; if (rr >= cnt) return -1; return (roff + rr) * 512; }
    DI const float* b_col(int g, int& width) const { width = 32; return p->moe_w_down + ((size_t)layer * NEXP + e) * (size_t)(DEXP * D) + nt * 128 + g * 32; }
    DI const bf16_t* b_base() const { return (const bf16_t*)(p->ws + WS_WM2) + (size_t)((layer * NEXP + e) * 8 + nt) * 128 * 512; }
    DI void epi(f32x16 (&acc)[2][2], int wr, int wc, int lane, unsigned char* wl) const {
        const int c = lane & 31;
        bf16_t* ob = (bf16_t*)(p->ws + WS_Y);
        const int* el = (const int*)(p->ws + WS_ELIST) + (size_t)e * NASG;
#pragma unroll
        for (int mi = 0; mi < 2; ++mi)
#pragma unroll
            for (int r = 0; r < 16; ++r) { stage_put<64>(wl, mi, 0, r, lane, acc[mi][0][r]); stage_put<64>(wl, mi, 1, r, lane, acc[mi][1][r]); }
        const int rb = mt * 128 + wr * 64;
        stage_flush<64>(wl, lane, [&](int row) { return rb + row < cnt ? ob + (size_t)el[rb + row] * 1024 + nt * 128 + wc * 64 : (bf16_t*)nullptr; });
    }
};

DI void convert_moe_layers(const Params& p, int l0, int l1, unsigned char* smem, int bid, int nb, int tid) {
    const int PER = 32 * 8 * 16 + 32 * 8 * 8, total = (l1 - l0) * PER;
    for (int item = bid; item < total; item += nb) {
        const int l = l0 + item / PER; int ci = item % PER;
        if (ci < 4096) { const int kt = ci & 15, nt = (ci >> 4) & 7, e = ci >> 7; Moe1 pr{&p, l, e, 0, nt, 0, 0}; convert_tile(pr, (bf16_t*)(p.ws + WS_WM1) + (size_t)((l * 32 + e) * 8 + nt) * 128 * 1024, 1024, kt, smem, tid); }
        else { ci -= 4096; const int kt = ci & 7, nt = (ci >> 3) & 7, e = ci >> 6; Moe2 pr{&p, l, e, 0, nt, 0, 0}; convert_tile(pr, (bf16_t*)(p.ws + WS_WM2) + (size_t)((l * 32 + e) * 8 + nt) * 128 * 512, 512, kt, smem, tid); }
    }
    __syncthreads();
}

DI void phase_init(const Params& p, unsigned char* smem, int bid, int nb, int tid) {
    float* sc = (float*)smem;
    float* red = (float*)(smem + 32768);
    const int NMOD = DEPTH * 96, NROPE = 256;
    const int C_HYB = 2 * 22 * 16, C_ML = 2 * 25 * 16, C_OUT = 4 * 8 * 16;
    for (int ci = bid; ci < C_HYB + C_ML + C_OUT; ci += nb) {
        int c2 = ci;
        if (c2 < C_HYB) { const int kt = c2 & 15, tn = (c2 >> 4) % 22, j = (c2 >> 4) / 22; HybCols8 pr{&p, j, 0, tn}; convert_tile(pr, (bf16_t*)(p.ws + WS_WHYB) + (size_t)(j * 22 + tn) * 128 * 1024, 1024, kt, smem, tid); continue; }
        c2 -= C_HYB;
        if (c2 < C_ML) { const int kt = c2 & 15, tn = (c2 >> 4) % 25, j = (c2 >> 4) / 25; MlCols8 pr{&p, j, 0, tn}; convert_tile(pr, (bf16_t*)(p.ws + WS_WML) + (size_t)(j * 25 + tn) * 128 * 1024, 1024, kt, smem, tid); continue; }
        c2 -= C_ML;
        { const int kt = c2 & 15, tn = (c2 >> 4) & 7, l = c2 >> 7; const float* W = ((l & 1) ? p.ml_w_out : p.hy_w_out) + (size_t)(l >> 1) * 1024 * 1024;
            OutProj pr{&p, W, nullptr, l, 0, tn}; convert_tile(pr, (bf16_t*)(p.ws + WS_WOUT) + (size_t)(l * 8 + tn) * 128 * 1024, 1024, kt, smem, tid); }
    }
    for (int item = bid; item < NMOD; item += nb) {
        __syncthreads();
        for (int i = tid; i < 8 * 1024; i += 256) { const float v = p.c[i]; sc[i] = v / (1.f + __expf(-v)); }
        __syncthreads();
        const int l = item / 96, jb = item % 96, cq = tid & 15, ksl = tid >> 4;
        const float* w = p.ada_w + (size_t)l * 1024 * 6144 + jb * 64 + cq * 4;
        f32x4 acc[8];
#pragma unroll
        for (int b = 0; b < 8; ++b) acc[b] = (f32x4){0.f, 0.f, 0.f, 0.f};
        for (int ii = 0; ii < 64; ++ii) {
            const int i = ksl * 64 + ii;
            const f32x4 wv = *(const f32x4*)(w + (size_t)i * 6144);
#pragma unroll
            for (int b = 0; b < 8; ++b) acc[b] += wv * sc[b * 1024 + i];
        }
#pragma unroll
        for (int b = 0; b < 8; ++b) *(f32x4*)(red + (ksl * 8 + b) * 64 + cq * 4) = acc[b];
        __syncthreads();
        for (int o = tid; o < 512; o += 256) {
            const int b = o >> 6, cc = o & 63; float s = 0.f;
            for (int k = 0; k < 16; ++k) s += red[(k * 8 + b) * 64 + cc];
            ((float*)(p.ws + WS_MOD))[((size_t)l * 8 + b) * 6144 + jb * 64 + cc] = s + p.ada_b[l * 6144 + jb * 64 + cc];
        }
    }
    for (int item = bid; item < NROPE + 1; item += nb) {
        if (item < NROPE) {
            const int idx = item * 256 + tid;
            const int pos = idx >> 5, i = idx & 31;
            const float inv = 1.0f / powf(10000.0f, (float)(2 * i) / 64.0f);
            const float ang = (float)pos * inv;
            ((float*)(p.ws + WS_ROPEC))[idx] = cosf(ang);
            ((float*)(p.ws + WS_ROPES))[idx] = sinf(ang);
        } else {
            if (tid < DEPTH * 32) ((int*)(p.ws + WS_ECNT))[tid * ECS] = 0;
        }
    }
    __syncthreads();
    convert_moe_layers(p, 0, 1, smem, bid, nb, tid);
}

DI void phase_norm(const Params& p, int layer, const float* src, int bid, int nb, int tid) {
    const int lane = tid & 63, wid = tid >> 6;
    const float* mod = (const float*)(p.ws + WS_MOD) + (size_t)layer * 8 * 6144;
    const float* gam = p.norm_mix + layer * 1024;
    bf16_t* H = (bf16_t*)(p.ws + WS_H);
    for (int item = bid; item < T / 4; item += nb) {
        const int t = item * 4 + wid, b = t >> 11;
        const float* xr = src + (size_t)t * 1024;
        f32x4 v[4]; float ss = 0.f;
#pragma unroll
        for (int i = 0; i < 4; ++i) { v[i] = *(const f32x4*)(xr + (lane + 64 * i) * 4); ss += v[i][0] * v[i][0] + v[i][1] * v[i][1] + v[i][2] * v[i][2] + v[i][3] * v[i][3]; }
        ss = wave_sum(ss);
        const float rstd = rsqrtf(ss * (1.f / 1024.f) + EPS);
#pragma unroll
        for (int i = 0; i < 4; ++i) {
            const int c0 = (lane + 64 * i) * 4;
            const f32x4 g = *(const f32x4*)(gam + c0), sh = *(const f32x4*)(mod + b * 6144 + c0), sc = *(const f32x4*)(mod + b * 6144 + 1024 + c0);
            f32x4 h = v[i] * rstd * g * (sc + 1.f) + sh;
            u32x2 o = {pk2(h[0], h[1]), pk2(h[2], h[3])};
            *(u32x2*)(H + (size_t)t * 1024 + c0) = o;
        }
    }
}

DI void phase_ffn_norm_router(const Params& p, int layer, unsigned char* smem, int bid, int nb, int tid) {
    float* rstd_s = (float*)smem;
    float* lg = (float*)(smem + 512);
    float* hs = (float*)(smem + 512 + 32 * 37 * 4);
    float* wcs = (float*)(smem + 5248 + 2 * 32 * 65 * 4);
    float* part = (float*)(smem + 42368);
    float* gpart = (float*)(smem + 59264);
    const int lane = tid & 63, og = __builtin_amdgcn_readfirstlane(tid >> 6), tok = lane & 31, kh = lane >> 5;
    const float* mod = (const float*)(p.ws + WS_MOD) + (size_t)layer * 8 * 6144;
    const float* gam = p.norm_ffn + layer * 1024;
    const float* wg = p.moe_w_group + (size_t)layer * 1024 * 4;
    const float* we = p.moe_w_expert + (size_t)layer * 1024 * 32;
    bf16_t* H = (bf16_t*)(p.ws + WS_H);
    int* ecnt = (int*)(p.ws + WS_ECNT) + layer * 32 * ECS;
    int* elist = (int*)(p.ws + WS_ELIST);
    float* ew = (float*)(p.ws + WS_EW);
    for (int item = bid; item < T / 32; item += nb) {
        const int t0 = item * 32, b = t0 >> 11;
        __syncthreads();
        if (tid < 32) {
            const f32x4* pp = (const f32x4*)((const float*)(p.ws + WS_PART) + (size_t)(t0 + tid) * 16);
            const f32x4 a = pp[0], b4 = pp[1], c4 = pp[2], d4 = pp[3];
            const float ss = ((a[0] + a[1]) + (a[2] + a[3])) + ((b4[0] + b4[1]) + (b4[2] + b4[3])) + ((c4[0] + c4[1]) + (c4[2] + c4[3])) + ((d4[0] + d4[1]) + (d4[2] + d4[3]));
            rstd_s[tid] = rsqrtf(ss * (1.f / 1024.f) + EPS);
        }
        const int stok = tid >> 3, sk0 = (tid & 7) * 8;
        const float* xrow = p.out + (size_t)(t0 + stok) * 1024 + sk0;
        const float* mrow = mod + b * 6144 + sk0;
        f32x4 xa[2], ga[2], sha[2], sca[2], wa[3], xb[2], gb2[2], shb[2], scb[2], wb2[3];
#define FFN_LOAD(xv, gv, shv, scv, wv, k0) do { _Pragma("unroll") for (int q = 0; q < 2; ++q) { xv[q] = *(const f32x4*)(xrow + (k0) + 4 * q); gv[q] = *(const f32x4*)(gam + sk0 + (k0) + 4 * q); \
            shv[q] = *(const f32x4*)(mrow + 3072 + (k0) + 4 * q); scv[q] = *(const f32x4*)(mrow + 4096 + (k0) + 4 * q); } \
            wv[0] = *(const f32x4*)(we + (k0) * 32 + tid * 4); wv[1] = *(const f32x4*)(we + (k0) * 32 + 1024 + tid * 4); wv[2] = *(const f32x4*)(wg + (k0) * 4 + (tid & 63) * 4); } while (0)
#define FFN_STEP(xv, gv, shv, scv, wv, kc) do { const int k0 = (kc) * 64; float* hb = hs + ((kc) & 1) * (32 * 65); float* wb = wcs + ((kc) & 1) * (64 * 40); u32x4 ho; \
            _Pragma("unroll") for (int q = 0; q < 2; ++q) { const f32x4 h = xv[q] * srstd * gv[q] * (scv[q] + 1.f) + shv[q]; ho[2 * q] = pk2(h[0], h[1]); ho[2 * q + 1] = pk2(h[2], h[3]); \
                float* hp = hb + stok * 65 + sk0 + 4 * q; hp[0] = h[0]; hp[1] = h[1]; hp[2] = h[2]; hp[3] = h[3]; } \
            *(u32x4*)(H + (size_t)(t0 + stok) * 1024 + k0 + sk0) = ho; \
            *(f32x4*)(wb + (tid >> 3) * 40 + 4 + (tid & 7) * 4) = wv[0]; *(f32x4*)(wb + (32 + (tid >> 3)) * 40 + 4 + (tid & 7) * 4) = wv[1]; if (tid < 64) *(f32x4*)(wb + tid * 40) = wv[2]; \
            if ((kc) + 2 < 16) FFN_LOAD(xv, gv, shv, scv, wv, k0 + 128); \
            __syncthreads(); \
            { const float* ha = hb + tok * 65 + og * 16 + kh; const float* wbp = wb + (og * 16 + kh) * 40 + 4 + tok; float av[8], bv[8]; \
              _Pragma("unroll") for (int m = 0; m < 8; ++m) { av[m] = ha[2 * m]; bv[m] = wbp[2 * m * 40]; } \
              const float* hg = hb + tok * 65 + og * 16 + kh * 8; const float* wgp = wb + (og * 16 + kh * 8) * 40; \
              _Pragma("unroll") for (int i = 0; i < 8; ++i) { const float hv = hg[i]; gacc += *(const f32x4*)(wgp + i * 40) * hv; } \
              _Pragma("unroll") for (int m = 0; m < 8; ++m) eacc = __builtin_amdgcn_mfma_f32_32x32x2f32(av[m], bv[m], eacc, 0, 0, 0); } } while (0)
        FFN_LOAD(xa, ga, sha, sca, wa, 0);
        FFN_LOAD(xb, gb2, shb, scb, wb2, 64);
        __syncthreads();
        const float srstd = rstd_s[stok];
        f32x16 eacc; f32x4 gacc = {0.f, 0.f, 0.f, 0.f};
#pragma unroll
        for (int r = 0; r < 16; ++r) eacc[r] = 0.f;
        for (int kc = 0; kc < 16; kc += 2) {
            FFN_STEP(xa, ga, sha, sca, wa, kc);
            FFN_STEP(xb, gb2, shb, scb, wb2, kc + 1);
        }
#undef FFN_STEP
#undef FFN_LOAD
#pragma unroll
        for (int r = 0; r < 16; ++r) part[(og * 32 + crow(r, lane)) * 33 + tok] = eacc[r];
#pragma unroll
        for (int e = 0; e < 4; ++e) { const float v = gacc[e] + sx_f<32>(gacc[e]); if (kh == 0) gpart[(og * 32 + tok) * 4 + e] = v; }
        __syncthreads();
        { const int tk = tid >> 3, c4 = (tid & 7) * 4;
#pragma unroll
          for (int e = 0; e < 4; ++e) lg[tk * 37 + 4 + c4 + e] = (part[tk * 33 + c4 + e] + part[(32 + tk) * 33 + c4 + e]) + (part[(64 + tk) * 33 + c4 + e] + part[(96 + tk) * 33 + c4 + e]);
          if (tid < 128) lg[(tid >> 2) * 37 + (tid & 3)] = (gpart[tid] + gpart[128 + tid]) + (gpart[256 + tid] + gpart[384 + tid]); }
        __syncthreads();
        if (tid < 32) {
            const int t = t0 + tid;
            float gl[4]; float gmax = -INFINITY; int gsel = 0;
#pragma unroll
            for (int g = 0; g < 4; ++g) { gl[g] = lg[tid * 37 + g] + p.moe_b_group[layer * 4 + g]; if (gl[g] > gmax) { gmax = gl[g]; gsel = g; } }
            float gsum = 0.f;
#pragma unroll
            for (int g = 0; g < 4; ++g) gsum += __expf(gl[g] - gmax);
            const float pg = 1.f / gsum;
            float v1 = -INFINITY, v2 = -INFINITY; int i1 = 0, i2 = 0;
            for (int jx = 0; jx < 8; ++jx) {
                const float v = lg[tid * 37 + 4 + gsel * 8 + jx] + p.moe_b_expert[layer * 32 + gsel * 8 + jx];
                if (v > v1) { v2 = v1; i2 = i1; v1 = v; i1 = jx; } else if (v > v2) { v2 = v; i2 = jx; }
            }
            const float e2 = __expf(v2 - v1), den = 1.f / (1.f + e2);
            const float w1 = pg * den, w2 = pg * e2 * den;
            const int ea = gsel * 8 + i1, eb = gsel * 8 + i2;
            int* cl = (int*)rstd_s + 32;
            cl[tid] = 0;
            const int la = atomicAdd(&cl[ea], 1);
            const int lb = atomicAdd(&cl[eb], 1);
            { const int n = cl[tid]; cl[32 + tid] = n > 0 ? atomicAdd(&ecnt[tid * ECS], n) : 0; }
            const int ra = cl[32 + ea] + la, rb = cl[32 + eb] + lb;
            elist[(size_t)ea * NASG + ra] = t * 2; ew[t * 2] = w1;
            elist[(size_t)eb * NASG + rb] = t * 2 + 1; ew[t * 2 + 1] = w2;
        }
    }
}

DI bool dense_item(int i, int NT, int xcd, int& tm, int& tn) {
    if (i >= 16 * NT) return false;
    const int mg = i / (8 * NT), r = i % (8 * NT);
    tn = r >> 3; tm = xcd * 16 + mg * 8 + (r & 7);
    return true;
}
template <class PR> DI void phase_hyb_in(const Params& p, int j, unsigned char* smem, int xcd, int lb, int nlb, int tid) {
    int tm, tn;
    for (int i = lb; dense_item(i, 22, xcd, tm, tn); i += nlb) { HybIn pr{&p, j, tm, tn}; gemm_tile(pr, smem, opq(tid)); }
}
DI void phase_ml_in(const Params& p, int j, unsigned char* smem, int xcd, int lb, int nlb, int tid) {
    int tm, tn;
    for (int i = lb; dense_item(i, 25, xcd, tm, tn); i += nlb) { MlIn pr{&p, j, tm, tn}; gemm_tile(pr, smem, opq(tid)); }
}
DI void phase_out_proj(const Params& p, int layer, const float* W, const float* src, unsigned char* smem, int xcd, int lb, int nlb, int tid) {
    int tm, tn;
    for (int i = lb; dense_item(i, 8, xcd, tm, tn); i += nlb) { OutProj pr{&p, W, src, layer, tm, tn}; gemm_tile(pr, smem, opq(tid)); }
}
template <int WHICH> DI void phase_moe(const Params& p, int layer, unsigned char* smem, int xcd, int lb, int nlb, int tid) {
    int* toff = (int*)(smem + 65600);
    __syncthreads();
    if (tid == 0) {
        const int* ecnt = (const int*)(p.ws + WS_ECNT) + layer * 32 * ECS;
        int ta = 0, ra = 0;
        for (int e = 0; e < 32; ++e) {
            const int c = ecnt[e * ECS];
            if ((e & 7) == xcd) { const int q = e >> 3; toff[q] = ta; toff[8 + q] = ra; toff[16 + q] = c; ta += (c + 127) >> 7; }
            ra += c;
        }
        toff[4] = ta;
    }
    __syncthreads();
    const int total = toff[4] * 8;
    for (int item = lb; item < total; item += nlb) {
        const int mg = item >> 3, nt = item & 7;
        int q = 0;
        while (q < 3 && toff[q + 1] <= mg) ++q;
        const int e = q * 8 + xcd, cnt = toff[16 + q], roff = toff[8 + q];
        if (WHICH == 1) { Moe1 pr{&p, layer, e, mg - toff[q], nt, cnt, roff}; gemm_tile(pr, smem, opq(tid)); }
        else { Moe2 pr{&p, layer, e, mg - toff[q], nt, cnt, roff}; gemm_tile(pr, smem, opq(tid)); }
    }
}

DI void phase_combine_norm(const Params& p, int layer, int bid, int nb, int tid) {
    const int lane = tid & 63, wid = tid >> 6;
    const float* mod = (const float*)(p.ws + WS_MOD) + (size_t)layer * 8 * 6144;
    const float* modn = mod + 8 * 6144;
    const float* gam = p.norm_mix + (layer + 1) * 1024;
    const bf16_t* Y = (const bf16_t*)(p.ws + WS_Y);
    const float* ew = (const float*)(p.ws + WS_EW);
    bf16_t* H = (bf16_t*)(p.ws + WS_H);
    const bool has_next = layer + 1 < DEPTH;
    for (int item = bid; item < T / 4; item += nb) {
        const int t = item * 4 + wid, b = t >> 11;
        const float w0 = ew[2 * t], w1 = ew[2 * t + 1];
        f32x4 v[4]; float ss = 0.f;
#pragma unroll
        for (int i = 0; i < 4; ++i) {
            const int c0 = (lane + 64 * i) * 4;
            v[i] = *(const f32x4*)(p.out + (size_t)t * 1024 + c0);
            const f32x4 g = *(const f32x4*)(mod + b * 6144 + 5120 + c0);
            const u32x2 y0 = *(const u32x2*)(Y + (size_t)(2 * t) * 1024 + c0), y1 = *(const u32x2*)(Y + (size_t)(2 * t + 1) * 1024 + c0);
            v[i][0] += g[0] * (w0 * bflo(y0[0]) + w1 * bflo(y1[0])); v[i][1] += g[1] * (w0 * bfhi(y0[0]) + w1 * bfhi(y1[0]));
            v[i][2] += g[2] * (w0 * bflo(y0[1]) + w1 * bflo(y1[1])); v[i][3] += g[3] * (w0 * bfhi(y0[1]) + w1 * bfhi(y1[1]));
            *(f32x4*)(p.out + (size_t)t * 1024 + c0) = v[i];
            ss += v[i][0] * v[i][0] + v[i][1] * v[i][1] + v[i][2] * v[i][2] + v[i][3] * v[i][3];
        }
        if (has_next) {
            ss = wave_sum(ss);
            const float rstd = rsqrtf(ss * (1.f / 1024.f) + EPS);
#pragma unroll
            for (int i = 0; i < 4; ++i) {
                const int c0 = (lane + 64 * i) * 4;
                const f32x4 g = *(const f32x4*)(gam + c0), sh = *(const f32x4*)(modn + b * 6144 + c0), sc = *(const f32x4*)(modn + b * 6144 + 1024 + c0);
                const f32x4 h = v[i] * rstd * g * (sc + 1.f) + sh;
                u32x2 o = {pk2(h[0], h[1]), pk2(h[2], h[3])};
                *(u32x2*)(H + (size_t)t * 1024 + c0) = o;
            }
        }
    }
}

DI unsigned sortable(float f) { const unsigned u = __float_as_uint(f); return (u & 0x80000000u) ? ~u : (u | 0x80000000u); }
DI int half_sum_i(int v) { v += sx_i<16>(v); v += sx_i<8>(v); v += sx_i<4>(v); v += sx_i<2>(v); v += sx_i<1>(v); return v; }

struct CvTask { const float* src; bf16_t* dst; int ldb, kdim; };
DI CvTask cv_task(const Params& p, int l0, int id) {
    const int PER = 32 * 8 * 16 * 4 + 32 * 8 * 8 * 4;
    const int l = l0 + id / PER; int ci = id % PER; CvTask t;
    if (ci < 16384) {
        const int g = ci & 3, kt = (ci >> 2) & 15, nt = (ci >> 6) & 7, e = ci >> 9; int w;
        Moe1 pr{&p, l, e, 0, nt, 0, 0};
        t.ldb = DEXP; t.kdim = 1024; t.src = pr.b_col(g, w) + (size_t)(kt * 64) * DEXP;
        t.dst = (bf16_t*)(p.ws + WS_WM1) + ((size_t)((l * 32 + e) * 8 + nt) * 128 + g * 32) * 1024 + kt * 64;
    } else {
        ci -= 16384;
        const int g = ci & 3, kt = (ci >> 2) & 7, nt = (ci >> 5) & 7, e = ci >> 8; int w;
        Moe2 pr{&p, l, e, 0, nt, 0, 0};
        t.ldb = D; t.kdim = 512; t.src = pr.b_col(g, w) + (size_t)(kt * 64) * D;
        t.dst = (bf16_t*)(p.ws + WS_WM2) + ((size_t)((l * 32 + e) * 8 + nt) * 128 + g * 32) * 512 + kt * 64;
    }
    return t;
}
DI void cv_issue(const CvTask& t, int lane, f32x4 (&rb)[8]) {
    const float* s = t.src + (size_t)((lane >> 3) * 8) * t.ldb + (lane & 7) * 4;
#pragma unroll
    for (int kk = 0; kk < 8; ++kk) rb[kk] = *(const f32x4*)(s + (size_t)kk * t.ldb);
}
DI void cv_finish(const CvTask& t, int lane, const f32x4 (&rb)[8]) {
    bf16_t* d = t.dst + (size_t)((lane & 7) * 4) * t.kdim + (lane >> 3) * 8;
#pragma unroll
    for (int jx = 0; jx < 4; ++jx) {
        u32x4 v = {pk2(rb[0][jx], rb[1][jx]), pk2(rb[2][jx], rb[3][jx]), pk2(rb[4][jx], rb[5][jx]), pk2(rb[6][jx], rb[7][jx])};
        *(u32x4*)(d + (size_t)jx * t.kdim) = v;
    }
}
DI void convert_moe_waves(const Params& p, int l0, int l1, int gwave, int nwaves, int lane) {
    const int total = (l1 - l0) * 24576;
    for (int id = gwave; id < total; id += 2 * nwaves) {
        f32x4 ra[8], rb[8];
        const CvTask t0 = cv_task(p, l0, id);
        cv_issue(t0, lane, ra);
        const bool two = id + nwaves < total;
        if (two) { const CvTask t1 = cv_task(p, l0, id + nwaves); cv_issue(t1, lane, rb); cv_finish(t0, lane, ra); cv_finish(t1, lane, rb); }
        else cv_finish(t0, lane, ra);
    }
}

DI void phase_dsa(const Params& p, int j, unsigned char* smem, int bid, int nb, int tid, int cv0 = 0, int cv1 = 0) {
    if (cv1 > cv0 && (bid & 1)) convert_moe_waves(p, cv0, cv1, bid * 4 + (tid >> 6), nb * 4, tid & 63);
    const int lane = tid & 63, wid = tid >> 6, c = lane & 31, hh = lane >> 5;
    unsigned* mw = (unsigned*)smem + wid * 256;
    const bf16_t* IQ = (const bf16_t*)(p.ws + WS_IQ);
    const bf16_t* IK = (const bf16_t*)(p.ws + WS_IK);
    const float* IW = (const float*)(p.ws + WS_IW);
    const bf16_t* Q = (const bf16_t*)(p.ws + WS_Q);
    const bf16_t* K = (const bf16_t*)(p.ws + WS_K);
    const bf16_t* VT = (const bf16_t*)(p.ws + WS_V);
    bf16_t* Y = (bf16_t*)(p.ws + WS_YMIX);
    const float gq = wave_max(fabsf(p.hy_q_norm[j * 64 + lane])), gk = wave_max(fabsf(p.hy_k_norm[j * 64 + lane]));
    const float LOG2E = 1.4426950408889634f;
    const float c1 = 0.125f * LOG2E, c2 = 8.f * gq * gk * LOG2E;
    const unsigned lt = (1u << c) - 1u;
    for (int it = bid, rnd = 0; it < 1024; it += nb, ++rnd) {
        const int item = (rnd & 1) ? (rnd + 1) * nb - 1 - bid : it;
        if (item >= 1024) continue;
        const int qt = 127 - (item >> 3), b = item & 7;
        const int pos0 = qt * 16 + 4 * wid;
        const size_t tb = (size_t)b * S, t0 = tb + pos0;
        const int tmax = (pos0 + 3) >> 5;
        if (pos0 >= 256) {
            bf16x8 iqf[4];
            {
                const int i = (c & 3) + 4 * (c >> 3), rh = (c >> 2) & 1, qq = 2 * rh + (i >> 3), hd = i & 7;
                const bf16_t* ip = IQ + (t0 + qq) * 512 + hd * 64 + 8 * hh;
#pragma unroll
                for (int ks = 0; ks < 4; ++ks) iqf[ks] = *(const bf16x8*)(ip + 16 * ks);
            }
            float* wl = (float*)(smem + 4096) + wid * 32 + hh * 16;
            if (c < 4) *(f32x4*)(wl + 4 * c) = *(const f32x4*)(IW + (t0 + 2 * hh) * 8 + 4 * c);
            unsigned sk[64][2];
            const bf16_t* kpi = IK + ((tb >> 5) * 256 + hh * 32 + c) * 8;
            const int lim0 = pos0 + 2 * hh - c;
#pragma unroll
            for (int tile = 0; tile < 64; ++tile) {
                unsigned k0 = 0u, k1 = 0u;
                if (tile <= tmax) {
                    bf16x8 bk[4];
#pragma unroll
                    for (int ks = 0; ks < 4; ++ks) bk[ks] = *(const bf16x8*)(kpi + 512 * ks);
                    kpi += 32 * 64;
                    asm volatile("" : "+v"(kpi));
                    f32x16 acc;
#pragma unroll
                    for (int r = 0; r < 16; ++r) acc[r] = 0.f;
#pragma unroll
                    for (int ks = 0; ks < 4; ++ks) acc = __builtin_amdgcn_mfma_f32_32x32x16_bf16(iqf[ks], bk[ks], acc, 0, 0, 0);
                    float s0 = 0.f, s1 = 0.f;
#pragma unroll
                    for (int q4 = 0; q4 < 2; ++q4) {
                        const f32x4 wa = *(const f32x4*)(wl + 4 * q4), wb = *(const f32x4*)(wl + 8 + 4 * q4);
#pragma unroll
                        for (int e = 0; e < 4; ++e) { s0 += fmaxf(acc[4 * q4 + e], 0.f) * wa[e]; s1 += fmaxf(acc[8 + 4 * q4 + e], 0.f) * wb[e]; }
                    }
                    k0 = tile * 32 <= lim0 ? sortable(s0) : 0u;
                    k1 = tile * 32 <= lim0 + 1 ? sortable(s1) : 0u;
                }
                sk[tile][0] = k0; sk[tile][1] = k1;
            }
            unsigned v0 = 0u, v1 = 0u; bool d0 = false, d1 = false;
            const int tg = tmax >> 3;
            for (int bit = 31; bit >= 0; --bit) {
                const unsigned c0 = v0 | (1u << bit), c1b = v1 | (1u << bit);
                int n0 = 0, n1 = 0;
#pragma unroll
                for (int g = 0; g < 8; ++g) {
                    if (g <= tg) {
#pragma unroll
                        for (int u = 0; u < 8; ++u) { n0 += sk[g * 8 + u][0] >= c0 ? 1 : 0; n1 += sk[g * 8 + u][1] >= c1b ? 1 : 0; }
                    }
                }
                const int n01 = half_sum_i(n0 | (n1 << 16));
                n0 = n01 & 0xffff; n1 = n01 >> 16;
                if (!d0 && n0 >= 256) { v0 = c0; d0 = n0 == 256; }
                if (!d1 && n1 >= 256) { v1 = c1b; d1 = n1 == 256; }
                if (__all(d0 && d1)) break;
            }
            int g0 = 0, g1 = 0;
#pragma unroll
            for (int g = 0; g < 8; ++g) {
                if (g <= tg) {
#pragma unroll
                    for (int u = 0; u < 8; ++u) { g0 += sk[g * 8 + u][0] > v0 ? 1 : 0; g1 += sk[g * 8 + u][1] > v1 ? 1 : 0; }
                }
            }
            const int g01 = half_sum_i(g0 | (g1 << 16));
            const int need0 = 256 - (g01 & 0xffff), need1 = 256 - (g01 >> 16);
            int run0 = 0, run1 = 0;
#pragma unroll
            for (int tile = 0; tile < 64; ++tile) {
                if (tile <= tmax) {
                    const unsigned k0 = sk[tile][0], k1 = sk[tile][1];
                    const bool tie0 = k0 == v0, tie1 = k1 == v1;
                    const unsigned long long tb0 = __ballot(tie0), tb1 = __ballot(tie1);
                    const unsigned th0 = hh ? (unsigned)(tb0 >> 32) : (unsigned)tb0, th1 = hh ? (unsigned)(tb1 >> 32) : (unsigned)tb1;
                    const bool sel0 = k0 > v0 || (tie0 && run0 + __popc(th0 & lt) < need0);
                    const bool sel1 = k1 > v1 || (tie1 && run1 + __popc(th1 & lt) < need1);
                    run0 += __popc(th0); run1 += __popc(th1);
                    const unsigned long long sb0 = __ballot(sel0), sb1 = __ballot(sel1);
                    if (lane == 0) { u32x4 o = {(unsigned)sb0, (unsigned)sb1, (unsigned)(sb0 >> 32), (unsigned)(sb1 >> 32)}; *(u32x4*)(mw + tile * 4) = o; }
                }
            }
        } else {
            const int tile = lane >> 2, qq = lane & 3, pq = pos0 + qq;
            if (tile <= tmax) {
                unsigned m;
                if (32 * tile + 31 <= pq) m = 0xffffffffu; else if (32 * tile > pq) m = 0u; else m = (2u << (pq - 32 * tile)) - 1u;
                mw[tile * 4 + qq] = m;
            }
        }
        bf16x8 qf[4];
        {
            const bf16_t* qp = Q + (t0 + (c >> 3)) * 512 + (c & 7) * 64 + 8 * hh;
#pragma unroll
            for (int ks = 0; ks < 4; ++ks) qf[ks] = *(const bf16x8*)(qp + 16 * ks);
        }
        f32x16 o0, o1;
#pragma unroll
        for (int r = 0; r < 16; ++r) { o0[r] = 0.f; o1[r] = 0.f; }
        float lsum = 0.f;
        const bf16_t* kp = K + ((tb >> 5) * 256 + hh * 32 + c) * 8;
        const bf16_t* vp = VT + ((tb >> 5) * 256 + hh * 32 + c) * 8;
        bf16x8 kf[4], vf[4];
#pragma unroll
        for (int ks = 0; ks < 4; ++ks) { kf[ks] = *(const bf16x8*)(kp + 512 * ks); vf[ks] = *(const bf16x8*)(vp + 512 * ks); }
        for (int tile = 0; tile <= tmax; ++tile) {
            const unsigned mword = mw[tile * 4 + (c >> 3)];
            bf16x8 kc[4], vc[4];
#pragma unroll
            for (int ks = 0; ks < 4; ++ks) { kc[ks] = kf[ks]; vc[ks] = vf[ks]; }
            if (tile < tmax) {
                kp += 2048; vp += 2048;
#pragma unroll
                for (int ks = 0; ks < 4; ++ks) { kf[ks] = *(const bf16x8*)(kp + 512 * ks); vf[ks] = *(const bf16x8*)(vp + 512 * ks); }
            }
            f32x16 x;
#pragma unroll
            for (int r = 0; r < 16; ++r) x[r] = 0.f;
#pragma unroll
            for (int ks = 0; ks < 4; ++ks) x = __builtin_amdgcn_mfma_f32_32x32x16_bf16(kc[ks], qf[ks], x, 0, 0, 0);
#pragma unroll
            for (int s = 0; s < 2; ++s) {
                const unsigned bits = mword >> (16 * s + 8 * hh);
                float pr[8];
#pragma unroll
                for (int jx = 0; jx < 8; ++jx) {
                    const float e = __builtin_amdgcn_exp2f(x[8 * s + jx] * c1 - c2);
                    pr[jx] = __uint_as_float(__float_as_uint(e) & (unsigned)__builtin_amdgcn_sbfe((int)bits, jx, 1));
                    lsum += pr[jx];
                }
                u32x4 pk = {pk2(pr[0], pr[1]), pk2(pr[2], pr[3]), pk2(pr[4], pr[5]), pk2(pr[6], pr[7])};
                const bf16x8 pf = __builtin_bit_cast(bf16x8, pk);
                o0 = __builtin_amdgcn_mfma_f32_32x32x16_bf16(vc[2 * s], pf, o0, 0, 0, 0);
                o1 = __builtin_amdgcn_mfma_f32_32x32x16_bf16(vc[2 * s + 1], pf, o1, 0, 0, 0);
            }
        }
        lsum += sx_f<32>(lsum);
        const float inv = 1.f / lsum;
        bf16_t* yp = Y + (t0 + (c >> 3)) * 1024 + (c & 7) * 64 + 4 * hh;
#pragma unroll
        for (int g4 = 0; g4 < 4; ++g4) {
            u32x2 a = {pk2(o0[4 * g4] * inv, o0[4 * g4 + 1] * inv), pk2(o0[4 * g4 + 2] * inv, o0[4 * g4 + 3] * inv)};
            u32x2 bq = {pk2(o1[4 * g4] * inv, o1[4 * g4 + 1] * inv), pk2(o1[4 * g4 + 2] * inv, o1[4 * g4 + 3] * inv)};
            *(u32x2*)(yp + 8 * g4) = a;
            *(u32x2*)(yp + 32 + 8 * g4) = bq;
        }
    }
    if (cv1 > cv0 && !(bid & 1)) convert_moe_waves(p, cv0, cv1, bid * 4 + (tid >> 6), nb * 4, tid & 63);
}

DI void phase_conv(const Params& p, int j, int bid, int nb, int tid) {
    const bf16_t* Z = (const bf16_t*)(p.ws + WS_Z);
    const bf16_t* BG = (const bf16_t*)(p.ws + WS_BG);
    bf16_t* Y = (bf16_t*)(p.ws + WS_YMIX);
    const float* cw = p.hy_conv_w + (size_t)j * 3 * 512;
    for (int item = bid; item < T / 4; item += nb) {
        const int t = item * 4 + (tid >> 6), c0 = (tid & 63) * 8, pos = t & (S - 1);
        float acc[8];
#pragma unroll
        for (int e = 0; e < 8; ++e) acc[e] = 0.f;
#pragma unroll
        for (int jj = 0; jj < 3; ++jj) {
            const int dp = jj - 2;
            if (pos + dp >= 0) {
                const u32x4 z = *(const u32x4*)(Z + (size_t)(t + dp) * 512 + c0);
#pragma unroll
                for (int e = 0; e < 4; ++e) { acc[2 * e] += cw[jj * 512 + c0 + 2 * e] * bflo(z[e]); acc[2 * e + 1] += cw[jj * 512 + c0 + 2 * e + 1] * bfhi(z[e]); }
            }
        }
        const u32x4 g = *(const u32x4*)(BG + (size_t)t * 512 + c0);
        u32x4 o;
#pragma unroll
        for (int e = 0; e < 4; ++e) o[e] = pk2(acc[2 * e] * bflo(g[e]), acc[2 * e + 1] * bfhi(g[e]));
        *(u32x4*)(Y + (size_t)t * 1024 + 512 + c0) = o;
    }
}

DI float wave_incl_sum(float x, int lane) { for (int d = 1; d < 64; d <<= 1) { const float t = lane_get_f(x, lane >= d ? lane - d : lane); if (lane >= d) x += t; } return x; }
DI float wave_incl_max(float x, int lane) { for (int d = 1; d < 64; d <<= 1) { const float t = lane_get_f(x, lane >= d ? lane - d : lane); if (lane >= d) x = fmaxf(x, t); } return x; }
DI bf16x8 scale_frag(bf16x8 f, const float* w8) {
    const u32x4 u = __builtin_bit_cast(u32x4, f);
    u32x4 o;
#pragma unroll
    for (int e = 0; e < 4; ++e) o[e] = pk2(bflo(u[e]) * w8[2 * e], bfhi(u[e]) * w8[2 * e + 1]);
    return __builtin_bit_cast(bf16x8, o);
}

DI void phase_ml1(const Params& p, unsigned char* smem, int bid, int nb, int tid) {
    const int lane = tid & 63, wid = tid >> 6, c = lane & 31, hh = lane >> 5;
    float* wsl = (float*)smem + wid * 64;
    const bf16_t* KT = (const bf16_t*)(p.ws + WS_MKT);
    const bf16_t* VT = (const bf16_t*)(p.ws + WS_MV);
    const float* MIG = (const float*)(p.ws + WS_MIG);
    const float* MFG = (const float*)(p.ws + WS_MFG);
    float* UB = (float*)(p.ws + WS_UBUF);
    float* UN = (float*)(p.ws + WS_UNBUF);
    float* ML = (float*)(p.ws + WS_MLOC);
    for (int item = bid; item < 2048; item += nb) {
        const int bh = item >> 5, ch = item & 31, b = bh >> 3, h = bh & 7;
        const size_t tb = (size_t)b * S + ch * 64;
        const float lf = MFG[(tb + lane) * 8 + h], ig = MIG[(tb + lane) * 8 + h];
        const float bc = wave_incl_sum(lf, lane);
        const float blast = lane_get_f(bc, 63);
        const float g = blast - bc + ig;
        const float gmax = wave_max(g);
        wsl[lane] = __expf(g - gmax);
        if (wid == 0 && lane == 0) { ML[item * 2] = blast; ML[item * 2 + 1] = gmax; }
        f32x16 u0, u1;
#pragma unroll
        for (int r = 0; r < 16; ++r) { u0[r] = 0.f; u1[r] = 0.f; }
        const bf16_t* vp = VT + ((size_t)(bh * 128 + wid * 32 + c)) * S + ch * 64 + 8 * hh;
        const bf16_t* kp = KT + ((size_t)(bh * 64 + c)) * S + ch * 64 + 8 * hh;
#pragma unroll
        for (int ks = 0; ks < 4; ++ks) {
            float w8[8];
            const f32x4 wa = *(const f32x4*)(wsl + 16 * ks + 8 * hh), wb = *(const f32x4*)(wsl + 16 * ks + 8 * hh + 4);
            w8[0] = wa[0]; w8[1] = wa[1]; w8[2] = wa[2]; w8[3] = wa[3]; w8[4] = wb[0]; w8[5] = wb[1]; w8[6] = wb[2]; w8[7] = wb[3];
            const bf16x8 va = *(const bf16x8*)(vp + 16 * ks);
            const bf16x8 k0 = scale_frag(*(const bf16x8*)(kp + 16 * ks), w8);
            const bf16x8 k1 = scale_frag(*(const bf16x8*)(kp + (size_t)32 * S + 16 * ks), w8);
            u0 = __builtin_amdgcn_mfma_f32_32x32x16_bf16(va, k0, u0, 0, 0, 0);
            u1 = __builtin_amdgcn_mfma_f32_32x32x16_bf16(va, k1, u1, 0, 0, 0);
        }
        float* up = UB + ((size_t)item * 128 + wid * 32) * 64 + c;
#pragma unroll
        for (int r = 0; r < 16; ++r) { const int v = crow(r, lane); up[v * 64] = u0[r]; up[v * 64 + 32] = u1[r]; }
        if (wid == 0) {
            const u32x4* kr = (const u32x4*)(KT + ((size_t)(bh * 64 + lane)) * S + ch * 64);
            float a = 0.f;
#pragma unroll
            for (int q = 0; q < 8; ++q) { const u32x4 u = kr[q];
#pragma unroll
                for (int e = 0; e < 4; ++e) a += wsl[q * 8 + 2 * e] * bflo(u[e]) + wsl[q * 8 + 2 * e + 1] * bfhi(u[e]); }
            UN[(size_t)item * 64 + lane] = a;
        }
    }
}

DI void phase_ml2(const Params& p, unsigned char* smem, int bid, int nb, int tid) {
    float* dec = (float*)smem;
    float* scl = dec + 32;
    const float* UB = (const float*)(p.ws + WS_UBUF);
    const float* UN = (const float*)(p.ws + WS_UNBUF);
    const float* ML = (const float*)(p.ws + WS_MLOC);
    bf16_t* CB = (bf16_t*)(p.ws + WS_CBUF);
    float* NBF = (float*)(p.ws + WS_NBUF);
    float* MST = (float*)(p.ws + WS_MST);
    for (int item = bid; item < 512; item += nb) {
        const int bh = item >> 3, sl = item & 7;
        __syncthreads();
        if (tid == 0) {
            float m = 0.f;
            for (int ch = 0; ch < 32; ++ch) {
                const float bl = ML[(bh * 32 + ch) * 2], gm = ML[(bh * 32 + ch) * 2 + 1];
                const float mn = fmaxf(bl + m, gm);
                dec[ch] = __expf(bl + m - mn); scl[ch] = __expf(gm - mn);
                if (sl == 0) MST[bh * 32 + ch] = m;
                m = mn;
            }
        }
        __syncthreads();
        f32x4 st = {0.f, 0.f, 0.f, 0.f};
        const size_t e0 = (size_t)sl * 1024 + tid * 4;
        f32x4 ub[32];
#pragma unroll
        for (int ch = 0; ch < 32; ++ch) ub[ch] = *(const f32x4*)(UB + ((size_t)(bh * 32 + ch)) * 8192 + e0);
#pragma unroll
        for (int ch = 0; ch < 32; ++ch) {
            st = st * dec[ch] + ub[ch] * scl[ch];
            u32x2 o = {pk2(st[0], st[1]), pk2(st[2], st[3])};
            *(u32x2*)(CB + ((size_t)(bh * 32 + ch)) * 8192 + e0) = o;
        }
        if (sl == 0 && tid < 64) {
            float nst = 0.f, un[32];
#pragma unroll
            for (int ch = 0; ch < 32; ++ch) un[ch] = UN[(size_t)(bh * 32 + ch) * 64 + tid];
#pragma unroll
            for (int ch = 0; ch < 32; ++ch) { nst = nst * dec[ch] + un[ch] * scl[ch]; NBF[(size_t)(bh * 32 + ch) * 64 + tid] = nst; }
        }
    }
}

DI void phase_ml3(const Params& p, int j, unsigned char* smem, int bid, int nb, int tid) {
    const int lane = tid & 63, wid = tid >> 6, c = lane & 31, hh = lane >> 5;
    float* al = (float*)smem + wid * 64;
    float* ssum = (float*)smem + 256;
    const bf16_t* MQ = (const bf16_t*)(p.ws + WS_MQ);
    const bf16_t* MK = (const bf16_t*)(p.ws + WS_MK);
    const bf16_t* VT = (const bf16_t*)(p.ws + WS_MV);
    const float* MIG = (const float*)(p.ws + WS_MIG);
    const float* MFG = (const float*)(p.ws + WS_MFG);
    const bf16_t* MOG = (const bf16_t*)(p.ws + WS_MOG);
    const bf16_t* CB = (const bf16_t*)(p.ws + WS_CBUF);
    const float* NBF = (const float*)(p.ws + WS_NBUF);
    const float* MST = (const float*)(p.ws + WS_MST);
    bf16_t* Y = (bf16_t*)(p.ws + WS_YMIX);
    const int kperm = (c & ~12) | ((c & 4) << 1) | ((c & 8) >> 1);
    for (int item = bid; item < 2048; item += nb) {
        const int bh = item >> 5, ch = item & 31, b = bh >> 3, h = bh & 7;
        const size_t tb = (size_t)b * S + ch * 64;
        const float lf = MFG[(tb + lane) * 8 + h], ig = MIG[(tb + lane) * 8 + h];
        const float bc = wave_incl_sum(lf, lane);
        const float av = ig - bc;
        const float mprev = MST[item];
        const float Mv = fmaxf(mprev, wave_incl_max(av, lane));
        __syncthreads();
        al[lane] = av;
        float Mt[2], wint[2], emt[2];
#pragma unroll
        for (int tt = 0; tt < 2; ++tt) { Mt[tt] = lane_get_f(Mv, 32 * tt + c); wint[tt] = __expf(mprev - Mt[tt]); emt[tt] = __expf(-(lane_get_f(bc, 32 * tt + c) + Mt[tt])); }
        bf16x8 qf[2][4], kf[2][4];
#pragma unroll
        for (int tt = 0; tt < 2; ++tt) {
            const bf16_t* qp = MQ + (tb + 32 * tt + c) * 512 + h * 64 + 8 * hh;
            const bf16_t* kp = MK + (tb + 32 * tt + kperm) * 512 + h * 64 + 8 * hh;
#pragma unroll
            for (int ks = 0; ks < 4; ++ks) { qf[tt][ks] = *(const bf16x8*)(qp + 16 * ks); kf[tt][ks] = *(const bf16x8*)(kp + 16 * ks); }
        }
        f32x16 o[2];
#pragma unroll
        for (int tt = 0; tt < 2; ++tt)
#pragma unroll
            for (int r = 0; r < 16; ++r) o[tt][r] = 0.f;
        float nq[2] = {0.f, 0.f};
        if (ch > 0) {
            const bf16_t* cp = CB + ((size_t)(item - 1) * 128 + wid * 32 + c) * 64 + 8 * hh;
            const float* np = NBF + (size_t)(item - 1) * 64 + 8 * hh;
#pragma unroll
            for (int ks = 0; ks < 4; ++ks) {
                const bf16x8 cf = *(const bf16x8*)(cp + 16 * ks);
                o[0] = __builtin_amdgcn_mfma_f32_32x32x16_bf16(cf, qf[0][ks], o[0], 0, 0, 0);
                o[1] = __builtin_amdgcn_mfma_f32_32x32x16_bf16(cf, qf[1][ks], o[1], 0, 0, 0);
                const f32x4 n0 = *(const f32x4*)(np + 16 * ks), n1 = *(const f32x4*)(np + 16 * ks + 4);
#pragma unroll
                for (int tt = 0; tt < 2; ++tt) {
                    const u32x4 u = __builtin_bit_cast(u32x4, qf[tt][ks]);
                    nq[tt] += n0[0] * bflo(u[0]) + n0[1] * bfhi(u[0]) + n0[2] * bflo(u[1]) + n0[3] * bfhi(u[1]) + n1[0] * bflo(u[2]) + n1[1] * bfhi(u[2]) + n1[2] * bflo(u[3]) + n1[3] * bfhi(u[3]);
                }
            }
#pragma unroll
            for (int tt = 0; tt < 2; ++tt) {
                nq[tt] += sx_f<32>(nq[tt]);
#pragma unroll
                for (int r = 0; r < 16; ++r) o[tt][r] *= wint[tt];
            }
        }
        float csum[2] = {0.f, 0.f};
        const bf16_t* vp = VT + ((size_t)(bh * 128 + wid * 32 + c)) * S + ch * 64 + 8 * hh;
#pragma unroll
        for (int tt = 0; tt < 2; ++tt) {
#pragma unroll
            for (int st = 0; st <= tt; ++st) {
                f32x16 x;
#pragma unroll
                for (int r = 0; r < 16; ++r) x[r] = 0.f;
#pragma unroll
                for (int ks = 0; ks < 4; ++ks) x = __builtin_amdgcn_mfma_f32_32x32x16_bf16(kf[st][ks], qf[tt][ks], x, 0, 0, 0);
#pragma unroll
                for (int k2 = 0; k2 < 2; ++k2) {
                    const int s0 = 32 * st + 16 * k2 + 8 * hh;
                    const f32x4 a0 = *(const f32x4*)(al + s0), a1 = *(const f32x4*)(al + s0 + 4);
                    const float a8[8] = {a0[0], a0[1], a0[2], a0[3], a1[0], a1[1], a1[2], a1[3]};
                    float pr[8];
#pragma unroll
                    for (int jx = 0; jx < 8; ++jx) {
                        const float e = __expf(a8[jx] - Mt[tt]) * x[8 * k2 + jx];
                        pr[jx] = (st < tt || s0 + jx <= 32 * tt + c) ? e : 0.f;
                        csum[tt] += pr[jx];
                    }
                    u32x4 pk = {pk2(pr[0], pr[1]), pk2(pr[2], pr[3]), pk2(pr[4], pr[5]), pk2(pr[6], pr[7])};
                    const bf16x8 vf = *(const bf16x8*)(vp + 32 * st + 16 * k2);
                    o[tt] = __builtin_amdgcn_mfma_f32_32x32x16_bf16(vf, __builtin_bit_cast(bf16x8, pk), o[tt], 0, 0, 0);
                }
            }
        }
        float ss[2];
#pragma unroll
        for (int tt = 0; tt < 2; ++tt) {
            csum[tt] += sx_f<32>(csum[tt]);
            const float den = wint[tt] * nq[tt] + csum[tt];
            const float rd = 1.f / fmaxf(fabsf(den), emt[tt]);
            float s2 = 0.f;
#pragma unroll
            for (int r = 0; r < 16; ++r) { o[tt][r] *= rd; s2 += o[tt][r] * o[tt][r]; }
            s2 += sx_f<32>(s2);
            ss[tt] = s2;
            if (hh == 0) ssum[wid * 64 + 32 * tt + c] = s2;
        }
        __syncthreads();
#pragma unroll
        for (int tt = 0; tt < 2; ++tt) {
            const int tcol = 32 * tt + c;
            const float tot = ssum[tcol] + ssum[64 + tcol] + ssum[128 + tcol] + ssum[192 + tcol];
            const float rstd = rsqrtf(tot * (1.f / 128.f) + EPS);
            const size_t ro = (tb + tcol) * 1024 + h * 128 + wid * 32 + 4 * hh;
            const float* gp = p.ml_out_norm + j * 1024 + h * 128 + wid * 32 + 4 * hh;
#pragma unroll
            for (int g4 = 0; g4 < 4; ++g4) {
                const f32x4 gm = *(const f32x4*)(gp + 8 * g4);
                const u32x2 og = *(const u32x2*)(MOG + ro + 8 * g4);
                u32x2 ov = {pk2(o[tt][4 * g4] * rstd * gm[0] * bflo(og[0]), o[tt][4 * g4 + 1] * rstd * gm[1] * bfhi(og[0])),
                            pk2(o[tt][4 * g4 + 2] * rstd * gm[2] * bflo(og[1]), o[tt][4 * g4 + 3] * rstd * gm[3] * bfhi(og[1]))};
                *(u32x2*)(Y + ro + 8 * g4) = ov;
            }
        }
    }
}


namespace pg8 {
#define PG8_LAS __attribute__((address_space(3)))
typedef unsigned short bf16_t;
typedef short bf16x8 __attribute__((ext_vector_type(8)));
typedef float f32x4 __attribute__((ext_vector_type(4)));
typedef unsigned u32x4 __attribute__((ext_vector_type(4)));
constexpr int BM = 256, BK = 64, HALF = 128, HTB = HALF * BK * 2  , STAGE_BYTES = 8 * HTB, NXCD = 8, WGM = 8;

__host__ __device__ __forceinline__ int lds_byte(int r, int c) { const int st = (r >> 4) * 2 + (c >> 5), rr = r & 15, cc = c & 31, ob = rr * 64 + cc * 2; return st * 1024 + (ob ^ (((ob >> 9) & 1) << 5)); }
__host__ __device__ __forceinline__ void stage_rc(int b, int& R, int& C) { const int st = b / 1024, sb = b % 1024, swz = sb ^ (((sb >> 9) & 1) << 5); R = (st >> 1) * 16 + swz / 64; C = (st & 1) * 32 + (swz % 64) / 2; }
__host__ __device__ __forceinline__ int perm32(int rho) { const int n = rho >> 4, i = rho & 15; return 8 * (i >> 2) + 4 * n + (i & 3); }

struct Unit { int pm, pn; };
struct Gemm { const bf16_t* A; const bf16_t* Bt; int M, N, K; };

struct StaticOrder {
    int nM, nN, nwg, G, c;
    __host__ __device__ void init(int M, int N, int G_, int c_) { nM = M / BM; nN = N / BM; nwg = nM * nN; G = G_; c = c_; }
    __host__ __device__ bool next(int i, Unit& u) const {
        const long L = (long)i * G + c; if (L >= nwg) return false;
        int wgid = (int)L; { const int q = nwg / NXCD, r = nwg % NXCD, xcd = wgid % NXCD, off = wgid / NXCD; wgid = (xcd < r ? xcd * (q + 1) : r * (q + 1) + (xcd - r) * q) + off; }
        const int nig = WGM * nN, gid = wgid / nig, fm = gid * WGM, gsz = (nM - fm) < WGM ? (nM - fm) : WGM;
        u.pm = fm + ((wgid % nig) % gsz); u.pn = (wgid % nig) / gsz; return true;
    }
    static constexpr bool GATHER = false;
    __device__ __forceinline__ unsigned a_off(const Unit&, int) const { return 0u; }
    __device__ __forceinline__ int rows(const Unit&) const { return BM; }
    __device__ __forceinline__ void a_ready(const Unit&) const {}
    __device__ __forceinline__ void done(const Unit&) const {}
};


template <class Epi, class Sched, bool ALIGN_EPI = false, bool SP2 = false>
__device__ __forceinline__ void gemm_phase(PG8_LAS unsigned char* lds, const Gemm g, const Sched& S, const Epi& E, int tid512) {
    const int tid = opq(tid512), wid = __builtin_amdgcn_readfirstlane(tid >> 6), lane = tid & 63, wr = wid >> 2, wc = wid & 3, fr = lane & 15, fq = lane >> 4;
    const int K = g.K, nt = K / BK;
    unsigned voffA[2], voffB[2];
    int rowA[2];
#pragma unroll
    for (int i = 0; i < 2; ++i) { int R, C; stage_rc(tid * 16 + i * 8192, R, C); const int Rb = Epi::PERM ? ((R & ~31) + perm32(R & 31)) : R;
        voffA[i] = (unsigned)(R * K + C) * 2u; voffB[i] = (unsigned)(Rb * K + C) * 2u; rowA[i] = R; if (Sched::GATHER) voffA[i] = (unsigned)C * 2u; }
    const size_t kstep = (size_t)(BK * 2);
    const size_t hstep = (size_t)HALF * K * 2;
    const size_t tstep = 2 * hstep;
    const unsigned ldsw = (unsigned)wid * 1024u;
    const int aoff = lds_byte(wr * 64 + fr, fq * 8), boff = lds_byte(wc * 32 + fr, fq * 8);
#define PG8_SA(b, h) (((b) * 2 + (h)) * HTB)
#define PG8_SB(b, h) ((4 + (b) * 2 + (h)) * HTB)
#define PG8_STAGE(bufoff, gbase, voff) do { _Pragma("unroll") for (int _i = 0; _i < 2; ++_i) \
        __builtin_amdgcn_global_load_lds((const unsigned*)((const char*)(gbase) + (voff)[_i]), (PG8_LAS unsigned*)(lds + (bufoff) + ldsw + _i * 8192), 16, 0, 0); } while (0)
#define PG8_LDA(dst, b, h) do { _Pragma("unroll") for (int m = 0; m < 4; ++m) _Pragma("unroll") for (int k = 0; k < 2; ++k) dst[m][k] = *(const PG8_LAS bf16x8*)(lds + PG8_SA(b, h) + aoff + m * 2048 + k * 1024); } while (0)
#define PG8_LDB(dst, b, h) do { _Pragma("unroll") for (int n = 0; n < 2; ++n) _Pragma("unroll") for (int k = 0; k < 2; ++k) dst[n][k] = *(const PG8_LAS bf16x8*)(lds + PG8_SB(b, h) + boff + n * 2048 + k * 1024); } while (0)
#define PG8_MMA(ai, bj, At, Bt) do { __builtin_amdgcn_s_setprio(1); _Pragma("unroll") for (int m = 0; m < 4; ++m) _Pragma("unroll") for (int n = 0; n < 2; ++n) _Pragma("unroll") for (int k = 0; k < 2; ++k) \
        acc[ai][bj][m][n] = __builtin_amdgcn_mfma_f32_16x16x32_bf16(Bt[n][k], At[m][k], acc[ai][bj][m][n], 0, 0, 0); __builtin_amdgcn_s_setprio(0); } while (0)
#define PG8_WAIT_V(n) asm volatile("s_waitcnt vmcnt(" #n ")" ::: "memory")
#define PG8_WAIT_L(n) asm volatile("s_waitcnt lgkmcnt(" #n ")" ::: "memory")
#define PG8_BAR __builtin_amdgcn_s_barrier()
#define PG8_SCHED __builtin_amdgcn_sched_barrier(0)
    unsigned oaC[2][2], oaN[2][2];
#define PG8_GOFF(dst, unit) do { _Pragma("unroll") for (int _h = 0; _h < 2; ++_h) _Pragma("unroll") for (int _i = 0; _i < 2; ++_i) dst[_h][_i] = S.a_off(unit, _h * HALF + rowA[_i]) + voffA[_i]; } while (0)
#define PG8_STAGE_G(bufoff, offs, koff) do { _Pragma("unroll") for (int _i = 0; _i < 2; ++_i) \
        __builtin_amdgcn_global_load_lds((const unsigned*)(((const char*)g.A + (koff)) + (offs)[_i]), (PG8_LAS unsigned*)(lds + (bufoff) + ldsw + _i * 8192), 16, 0, 0); } while (0)
    Unit cur, nxt; int ui = 0;
    if (!S.next(0, cur)) return;
    if constexpr (Sched::GATHER) { PG8_GOFF(oaC, cur); PG8_GOFF(oaN, cur); }
    bool mm0 = true, mm1 = true;
    if constexpr (Sched::GATHER) { const int rws = S.rows(cur); mm0 = 64 * wr < rws; mm1 = 128 + 64 * wr < rws; }
    f32x4 acc[2][2][4][2];
#pragma unroll
    for (int a = 0; a < 2; ++a)
#pragma unroll
        for (int b = 0; b < 2; ++b)
#pragma unroll
            for (int m = 0; m < 4; ++m)
#pragma unroll
                for (int n = 0; n < 2; ++n) acc[a][b][m][n] = (f32x4){0.f, 0.f, 0.f, 0.f};
    bf16x8 At[4][2], B0[2][2], B1[2][2];
    const char* cA = (const char*)g.A + (size_t)cur.pm * tstep; const char* cB = (const char*)g.Bt + (size_t)cur.pn * tstep;
    S.a_ready(cur);
    if constexpr (SP2) {
        PG8_STAGE(PG8_SB(0, 0), cB, voffB); PG8_STAGE(PG8_SB(0, 1), cB + hstep, voffB);
        if constexpr (Sched::GATHER) { PG8_STAGE_G(PG8_SA(0, 0), oaC[0], 0); PG8_STAGE_G(PG8_SA(0, 1), oaC[1], 0); } else { PG8_STAGE(PG8_SA(0, 0), cA, voffA); PG8_STAGE(PG8_SA(0, 1), cA + hstep, voffA); }
        if (wr == 1) PG8_BAR;
        PG8_WAIT_V(2); PG8_BAR;
        PG8_STAGE(PG8_SB(1, 0), cB + kstep, voffB);
        if constexpr (Sched::GATHER) PG8_STAGE_G(PG8_SA(1, 0), oaC[0], kstep); else PG8_STAGE(PG8_SA(1, 0), cA + kstep, voffA);
        PG8_STAGE(PG8_SB(1, 1), cB + hstep + kstep, voffB);
        PG8_WAIT_V(6); PG8_BAR;
    } else {
        PG8_STAGE(PG8_SB(0, 0), cB, voffB); PG8_STAGE(PG8_SA(0, 0), cA, voffA); PG8_STAGE(PG8_SB(0, 1), cB + hstep, voffB); PG8_STAGE(PG8_SA(0, 1), cA + hstep, voffA);
        if (wr == 1) PG8_BAR;
        PG8_WAIT_V(4); PG8_BAR;
        PG8_STAGE(PG8_SB(1, 0), cB + kstep, voffB); PG8_STAGE(PG8_SA(1, 0), cA + kstep, voffA); PG8_STAGE(PG8_SB(1, 1), cB + hstep + kstep, voffB);
        PG8_WAIT_V(6); PG8_BAR;
    }
    for (;;) {
        const bool has_next = S.next(ui + 1, nxt);
        const char* nA = has_next ? (const char*)g.A + (size_t)nxt.pm * tstep : cA; const char* nB = has_next ? (const char*)g.Bt + (size_t)nxt.pn * tstep : cB;
        for (int t = 0; t < nt; t += 2) {
            const bool last = (t == nt - 2);
            const char* a1 = cA + (size_t)(t + 1) * kstep;
            const char* a2 = last ? nA : cA + (size_t)(t + 2) * kstep; const char* b2 = last ? nB : cB + (size_t)(t + 2) * kstep;
            const char* a3 = a2 + kstep; const char* b3 = b2 + kstep;
            if (last && has_next) S.a_ready(nxt);
            unsigned oaS[2][2]; size_t k2 = 0;
            if constexpr (Sched::GATHER) {
                if (last && has_next) PG8_GOFF(oaN, nxt);
                const bool fromN = last && has_next;
#pragma unroll
                for (int _h = 0; _h < 2; ++_h)
#pragma unroll
                    for (int _i = 0; _i < 2; ++_i) oaS[_h][_i] = fromN ? oaN[_h][_i] : oaC[_h][_i];
                k2 = last ? (size_t)0 : (size_t)(t + 2) * kstep;
            }
            if constexpr (SP2) {
            PG8_LDB(B0, 0, 0); PG8_LDB(B1, 0, 1); PG8_SCHED; PG8_LDA(At, 0, 0);
            if constexpr (Sched::GATHER) PG8_STAGE_G(PG8_SA(1, 1), oaC[1], (size_t)(t + 1) * kstep); else PG8_STAGE(PG8_SA(1, 1), a1 + hstep, voffA);
            PG8_WAIT_V(8); PG8_WAIT_L(0); PG8_BAR; if (!Sched::GATHER || mm0) { PG8_MMA(0, 0, At, B0); PG8_MMA(0, 1, At, B1); } PG8_BAR; PG8_SCHED;
            PG8_LDA(At, 0, 1); PG8_STAGE(PG8_SB(0, 0), b2, voffB); PG8_STAGE(PG8_SB(0, 1), b2 + hstep, voffB);
            if constexpr (Sched::GATHER) PG8_STAGE_G(PG8_SA(0, 0), oaS[0], k2); else PG8_STAGE(PG8_SA(0, 0), a2, voffA);
            PG8_WAIT_V(8); PG8_WAIT_L(0); PG8_BAR; if (!Sched::GATHER || mm1) { PG8_MMA(1, 0, At, B0); PG8_MMA(1, 1, At, B1); } PG8_BAR; PG8_SCHED;
            PG8_LDB(B0, 1, 0); PG8_LDB(B1, 1, 1); PG8_SCHED; PG8_LDA(At, 1, 0);
            if constexpr (Sched::GATHER) PG8_STAGE_G(PG8_SA(0, 1), oaS[1], k2); else PG8_STAGE(PG8_SA(0, 1), a2 + hstep, voffA);
            PG8_WAIT_V(8); PG8_WAIT_L(0); PG8_BAR; if (!Sched::GATHER || mm0) { PG8_MMA(0, 0, At, B0); PG8_MMA(0, 1, At, B1); } PG8_BAR; PG8_SCHED;
            PG8_LDA(At, 1, 1); PG8_STAGE(PG8_SB(1, 0), b3, voffB); PG8_STAGE(PG8_SB(1, 1), b3 + hstep, voffB);
            if constexpr (Sched::GATHER) PG8_STAGE_G(PG8_SA(1, 0), oaS[0], k2 + kstep); else PG8_STAGE(PG8_SA(1, 0), a3, voffA);
            PG8_WAIT_V(8); PG8_WAIT_L(0); PG8_BAR; if (!Sched::GATHER || mm1) { PG8_MMA(1, 0, At, B0); PG8_MMA(1, 1, At, B1); } PG8_BAR; PG8_SCHED;
            } else {
            PG8_LDB(B0, 0, 0); PG8_SCHED; PG8_LDA(At, 0, 0); PG8_STAGE(PG8_SA(1, 1), a1 + hstep, voffA);
            PG8_WAIT_L(8); PG8_BAR; PG8_WAIT_L(0); PG8_MMA(0, 0, At, B0); PG8_BAR; PG8_SCHED;
            PG8_LDB(B1, 0, 1); PG8_STAGE(PG8_SB(0, 0), b2, voffB);
            PG8_BAR; PG8_WAIT_L(0); PG8_MMA(0, 1, At, B1); PG8_BAR;
            PG8_LDA(At, 0, 1); PG8_STAGE(PG8_SA(0, 0), a2, voffA);
            PG8_BAR; PG8_WAIT_L(0); PG8_MMA(1, 0, At, B0); PG8_BAR; PG8_SCHED;
            PG8_STAGE(PG8_SB(0, 1), b2 + hstep, voffB);
            PG8_WAIT_V(6); PG8_BAR; PG8_MMA(1, 1, At, B1); PG8_BAR;
            PG8_LDB(B0, 1, 0); PG8_SCHED; PG8_LDA(At, 1, 0); PG8_STAGE(PG8_SA(0, 1), a2 + hstep, voffA);
            PG8_WAIT_L(8); PG8_BAR; PG8_WAIT_L(0); PG8_MMA(0, 0, At, B0); PG8_BAR; PG8_SCHED;
            PG8_LDB(B1, 1, 1); PG8_STAGE(PG8_SB(1, 0), b3, voffB);
            PG8_BAR; PG8_WAIT_L(0); PG8_MMA(0, 1, At, B1); PG8_BAR;
            PG8_LDA(At, 1, 1); PG8_STAGE(PG8_SA(1, 0), a3, voffA);
            PG8_BAR; PG8_WAIT_L(0); PG8_MMA(1, 0, At, B0); PG8_BAR; PG8_SCHED;
            PG8_STAGE(PG8_SB(1, 1), b3 + hstep, voffB);
            PG8_WAIT_V(6); PG8_BAR; PG8_MMA(1, 1, At, B1); PG8_BAR;
            }
        }
        if constexpr (ALIGN_EPI) { if (wr == 0) PG8_BAR; }
        if constexpr (!Epi::AFTER_DRAIN) { E(acc, cur, wr, wc, fr, fq); S.done(cur); }
        if (!has_next) break;
#pragma unroll
        for (int a = 0; a < 2; ++a)
#pragma unroll
            for (int b = 0; b < 2; ++b)
#pragma unroll
                for (int m = 0; m < 4; ++m)
#pragma unroll
                    for (int n = 0; n < 2; ++n) acc[a][b][m][n] = (f32x4){0.f, 0.f, 0.f, 0.f};
        cur = nxt; cA = nA; cB = nB; ++ui;
        if constexpr (Sched::GATHER) { const int rws = S.rows(cur); mm0 = 64 * wr < rws; mm1 = 128 + 64 * wr < rws; }
        if constexpr (Sched::GATHER) {
#pragma unroll
            for (int _h = 0; _h < 2; ++_h)
#pragma unroll
                for (int _i = 0; _i < 2; ++_i) oaC[_h][_i] = oaN[_h][_i];
        }
        if constexpr (ALIGN_EPI) { if (wr == 1) PG8_BAR; }
    }
    PG8_WAIT_V(0);
    if constexpr (!ALIGN_EPI) { if (wr == 0) PG8_BAR; }
    PG8_BAR;
    if constexpr (Epi::AFTER_DRAIN) { E.fused(acc, cur, wr, wc, fr, fq, lds, wid, lane); S.done(cur); }
#undef PG8_GOFF
#undef PG8_STAGE_G
#undef PG8_SA
#undef PG8_SB
#undef PG8_STAGE
#undef PG8_LDA
#undef PG8_LDB
#undef PG8_MMA
#undef PG8_WAIT_V
#undef PG8_WAIT_L
#undef PG8_BAR
#undef PG8_SCHED
}
}

struct OutEpi8 {
    static constexpr bool PERM = false, AFTER_DRAIN = false;
    const float* src; float* dst; const float* gate; float* part;
    __device__ __forceinline__ void operator()(const pg8::f32x4 (&acc)[2][2][4][2], const pg8::Unit& u, int wr, int wc, int fr, int fq) const {
#pragma unroll
        for (int ai = 0; ai < 2; ++ai)
#pragma unroll
            for (int m = 0; m < 4; ++m) {
                const int t = u.pm * 256 + ai * 128 + wr * 64 + m * 16 + fr;
                const float* gp = gate + (t >> 11) * 6144;
                float ss = 0.f;
#pragma unroll
                for (int bj = 0; bj < 2; ++bj)
#pragma unroll
                    for (int n = 0; n < 2; ++n) {
                        const int col = u.pn * 256 + bj * 128 + wc * 32 + n * 16 + fq * 4;
                        const pg8::f32x4 g = *(const pg8::f32x4*)(gp + col);
                        const pg8::f32x4 o = *(const pg8::f32x4*)(src + (size_t)t * 1024 + col) + g * acc[ai][bj][m][n];
                        *(pg8::f32x4*)(dst + (size_t)t * 1024 + col) = o;
                        ss += o[0] * o[0] + o[1] * o[1] + o[2] * o[2] + o[3] * o[3];
                    }
                ss += sx_f<16>(ss); ss += sx_f<32>(ss);
                if (fq == 0) part[(size_t)t * 16 + u.pn * 4 + wc] = ss;
            }
    }
};


DI unsigned cvtpk(float lo, float hi) { return pk2(lo, hi); }
struct HybEpi8 {
    static constexpr bool PERM = true, AFTER_DRAIN = false;
    const Params* p; int j;
    __device__ __forceinline__ void operator()(const pg8::f32x4 (&acc)[2][2][4][2], const pg8::Unit& u, int wr, int wc, int fr, int fq) const {
        unsigned char* ws = p->ws;
        const int un = u.pn;
        if (un < 5 && !(un == 4 && (wc == 1 || wc == 3))) {
            const bool donorm = un < 2 || (un == 4 && wc == 0);
            bf16_t* ob; int ld, cb; const float* gam = p->hy_q_norm + j * 64;
            if (un < 2) { ob = (bf16_t*)(ws + WS_Q); ld = 512; cb = 64 * (4 * un + wc); }
            else if (un < 4) { ob = (bf16_t*)(ws + WS_IQ); ld = 512; cb = 64 * (4 * (un - 2) + wc); }
            else if (wc == 0) { ob = (bf16_t*)(ws + WS_K); ld = 64; cb = 0; gam = p->hy_k_norm + j * 64; }
            else { ob = (bf16_t*)(ws + WS_IK); ld = 64; cb = 0; }
            pg8::f32x4 g0[2], g1[2];
#pragma unroll
            for (int n = 0; n < 2; ++n) { g0[n] = donorm ? *(const pg8::f32x4*)(gam + 8 * fq + 4 * n) : (pg8::f32x4){1.f, 1.f, 1.f, 1.f}; g1[n] = donorm ? *(const pg8::f32x4*)(gam + 32 + 8 * fq + 4 * n) : (pg8::f32x4){1.f, 1.f, 1.f, 1.f}; }
            const float* ropec = (const float*)(ws + WS_ROPEC);
            const float* ropes = (const float*)(ws + WS_ROPES);
#pragma unroll
            for (int ai = 0; ai < 2; ++ai)
#pragma unroll
                for (int m = 0; m < 4; ++m) {
                    const int t = opq(u.pm * 256 + ai * 128 + wr * 64 + m * 16 + fr), pos = t & (S - 1);
                    float rstd = 1.f;
                    if (donorm) {
                        float ss = 0.f;
#pragma unroll
                        for (int bj = 0; bj < 2; ++bj)
#pragma unroll
                            for (int n = 0; n < 2; ++n) { const pg8::f32x4 x = acc[ai][bj][m][n]; ss += x[0] * x[0] + x[1] * x[1] + x[2] * x[2] + x[3] * x[3]; }
                        ss += sx_f<16>(ss); ss += sx_f<32>(ss);
                        rstd = rsqrtf(ss * (1.f / 64.f) + EPS);
                    }
                    u32x4 o1, o2;
#pragma unroll
                    for (int n = 0; n < 2; ++n) {
                        const pg8::f32x4 cs = *(const pg8::f32x4*)(ropec + pos * 32 + 8 * fq + 4 * n), sn = *(const pg8::f32x4*)(ropes + pos * 32 + 8 * fq + 4 * n);
                        const pg8::f32x4 x1 = acc[ai][0][m][n] * rstd * g0[n], x2 = acc[ai][1][m][n] * rstd * g1[n];
                        const pg8::f32x4 y1 = x1 * cs - x2 * sn, y2 = x2 * cs + x1 * sn;
                        o1[2 * n] = cvtpk(y1[0], y1[1]); o1[2 * n + 1] = cvtpk(y1[2], y1[3]);
                        o2[2 * n] = cvtpk(y2[0], y2[1]); o2[2 * n + 1] = cvtpk(y2[2], y2[3]);
                    }
                    if (un == 4) {
                        const int kk = t & 31, cs_ = (wc == 0) ? ((kk & ~12) | ((kk & 4) << 1) | ((kk & 8) >> 1)) : kk;
                        bf16_t* fb = ob + ((size_t)(t >> 5) * 256 + (fq >> 1) * 64 + (fq & 1) * 32 + cs_) * 8;
                        *(u32x4*)fb = o1; *(u32x4*)(fb + 128 * 8) = o2;
                    } else {
                    *(u32x4*)(ob + (size_t)t * ld + cb + 8 * fq) = o1;
                    *(u32x4*)(ob + (size_t)t * ld + cb + 32 + 8 * fq) = o2;
                    }
                }
        } else if (un == 4 && wc == 1) {
            bf16_t* ob = (bf16_t*)(ws + WS_V);
#pragma unroll
            for (int ai = 0; ai < 2; ++ai)
#pragma unroll
                for (int m = 0; m < 4; ++m) {
                    const int t = opq(u.pm * 256 + ai * 128 + wr * 64 + m * 16 + fr), pos = t & (S - 1);
#pragma unroll
                    for (int bj = 0; bj < 2; ++bj)
#pragma unroll
                        for (int n = 0; n < 2; ++n)
#pragma unroll
                            for (int e = 0; e < 4; ++e) ob[((((size_t)(t >> 5) * 4 + bj + ((pos >> 4) & 1) * 2) * 2 + ((pos >> 3) & 1)) * 32 + 8 * fq + 4 * n + e) * 8 + (pos & 7)] = f2bf(acc[ai][bj][m][n][e]);
                }
        } else if (un == 4) {
            float* ob = (float*)(ws + WS_IW);
            if (fq == 0) {
#pragma unroll
                for (int ai = 0; ai < 2; ++ai)
#pragma unroll
                    for (int m = 0; m < 4; ++m) {
                        const int t = u.pm * 256 + ai * 128 + wr * 64 + m * 16 + fr;
                        *(pg8::f32x4*)(ob + (size_t)t * 8) = acc[ai][0][m][0] * (0.125f * 0.35355339059327373f);
                        *(pg8::f32x4*)(ob + (size_t)t * 8 + 4) = acc[ai][0][m][1] * (0.125f * 0.35355339059327373f);
                    }
            }
        } else if (un < 7) {
            bf16_t* ob = (bf16_t*)(ws + WS_BG);
#pragma unroll
            for (int ai = 0; ai < 2; ++ai)
#pragma unroll
                for (int m = 0; m < 4; ++m) {
                    const int t = opq(u.pm * 256 + ai * 128 + wr * 64 + m * 16 + fr);
#pragma unroll
                    for (int bj = 0; bj < 2; ++bj) {
                        const pg8::f32x4 a = acc[ai][bj][m][0], b = acc[ai][bj][m][1];
                        u32x4 o = {cvtpk(a[0], a[1]), cvtpk(a[2], a[3]), cvtpk(b[0], b[1]), cvtpk(b[2], b[3])};
                        *(u32x4*)(ob + (size_t)t * 512 + (un - 5) * 256 + 128 * bj + 32 * wc + 8 * fq) = o;
                    }
                }
        } else {
            bf16_t* ob = (bf16_t*)(ws + WS_Z);
#pragma unroll
            for (int ai = 0; ai < 2; ++ai)
#pragma unroll
                for (int m = 0; m < 4; ++m) {
                    const int t = opq(u.pm * 256 + ai * 128 + wr * 64 + m * 16 + fr);
                    const pg8::f32x4 a = acc[ai][0][m][0] * acc[ai][1][m][0], b = acc[ai][0][m][1] * acc[ai][1][m][1];
                    u32x4 o = {cvtpk(a[0], a[1]), cvtpk(a[2], a[3]), cvtpk(b[0], b[1]), cvtpk(b[2], b[3])};
                    *(u32x4*)(ob + (size_t)t * 512 + (un - 7) * 128 + 32 * wc + 8 * fq) = o;
                }
        }
    }
};


struct MlEpi8 {
    static constexpr bool PERM = true, AFTER_DRAIN = false;
    const Params* p; int j;
    __device__ __forceinline__ void operator()(const pg8::f32x4 (&acc)[2][2][4][2], const pg8::Unit& u, int wr, int wc, int fr, int fq) const {
        unsigned char* ws = p->ws;
        const int un = u.pn;
        if (un < 4 || un >= 8) {
            bf16_t* ob; int ld, cb0; float sc = 1.f;
            if (un < 2) { ob = (bf16_t*)(ws + WS_MQ); ld = 512; cb0 = 64 * (4 * un + wc); sc = 0.125f; }
            else if (un < 4) { ob = (bf16_t*)(ws + WS_MK); ld = 512; cb0 = 64 * (4 * (un - 2) + wc); }
            else { ob = (bf16_t*)(ws + WS_MOG); ld = 1024; cb0 = (un - 8) * 256 + 32 * wc; }
            const int bstep = un < 4 ? 32 : 128;
#pragma unroll
            for (int ai = 0; ai < 2; ++ai)
#pragma unroll
                for (int m = 0; m < 4; ++m) {
                    const int t = opq(u.pm * 256 + ai * 128 + wr * 64 + m * 16 + fr);
#pragma unroll
                    for (int bj = 0; bj < 2; ++bj) {
                        pg8::f32x4 a = acc[ai][bj][m][0] * sc, b = acc[ai][bj][m][1] * sc;
                        if (un >= 8) { for (int e = 0; e < 4; ++e) { a[e] = sigmoidf_(a[e]); b[e] = sigmoidf_(b[e]); } }
                        u32x4 o = {cvtpk(a[0], a[1]), cvtpk(a[2], a[3]), cvtpk(b[0], b[1]), cvtpk(b[2], b[3])};
                        *(u32x4*)(ob + (size_t)t * ld + cb0 + bstep * bj + 8 * fq) = o;
                    }
                }
        }
        if (un >= 2 && un < 8) {
            bf16_t* ob = (bf16_t*)(ws + (un < 4 ? WS_MKT : WS_MV));
#pragma unroll
            for (int ai = 0; ai < 2; ++ai)
#pragma unroll
                for (int m = 0; m < 4; ++m) {
                    const int t = opq(u.pm * 256 + ai * 128 + wr * 64 + m * 16 + fr), pos = t & (S - 1), bb = t >> 11;
#pragma unroll
                    for (int bj = 0; bj < 2; ++bj) {
                        const size_t rowb = un < 4 ? (size_t)((bb * 8 + 4 * (un - 2) + wc) * 64 + 32 * bj + 8 * fq) : (size_t)((bb * 8 + 2 * (un - 4) + bj) * 128 + 32 * wc + 8 * fq);
#pragma unroll
                        for (int n = 0; n < 2; ++n)
#pragma unroll
                            for (int e = 0; e < 4; ++e) ob[(rowb + 4 * n + e) * S + pos] = f2bf(acc[ai][bj][m][n][e]);
                    }
                }
        }
    }
};


struct MoeOrder8 {
    static constexpr bool GATHER = true;
    const int* tab; const int* elist; int G, c, total, mode;
    __device__ __forceinline__ bool next(int i, pg8::Unit& u) const {
        const int cl = (G & 7) ? c : (c & 7) * (G >> 3) + (c >> 3);
        const int wg = i * G + cl; if (wg >= total) return false;
        u.pm = __builtin_amdgcn_readfirstlane(tab[wg >> 2]); u.pn = __builtin_amdgcn_readfirstlane((u.pm >> 8) * 4 + (wg & 3)); return true;
    }
    __device__ __forceinline__ int rows(const pg8::Unit& u) const { const int r = tab[168 + (u.pm >> 8)] - (u.pm & 255) * 256; return __builtin_amdgcn_readfirstlane(r < 256 ? r : 256); }
    __device__ __forceinline__ unsigned a_off(const pg8::Unit& u, int row) const {
        const int e = u.pm >> 8, lr = (u.pm & 255) * 256 + row;
        if (lr >= tab[168 + e]) return 0u;
        if (mode == 1) return (unsigned)(elist[e * NASG + lr] >> 1) * 2048u;
        return (unsigned)(tab[200 + e] + lr) * 1024u;
    }
    __device__ __forceinline__ void a_ready(const pg8::Unit&) const {}
    __device__ __forceinline__ void done(const pg8::Unit&) const {}
};
struct Moe1Epi8 {
    static constexpr bool PERM = true, AFTER_DRAIN = false;
    const int* tab; bf16_t* h1;
    __device__ __forceinline__ void operator()(const pg8::f32x4 (&acc)[2][2][4][2], const pg8::Unit& u, int wr, int wc, int fr, int fq) const {
        const int e = u.pm >> 8, mu = u.pm & 255, nu = u.pn & 3, cnt = tab[168 + e], roff = tab[200 + e];
#pragma unroll
        for (int ai = 0; ai < 2; ++ai)
#pragma unroll
            for (int m = 0; m < 4; ++m) {
                const int lr = opq(mu * 256 + ai * 128 + wr * 64 + m * 16 + fr);
                if (lr < cnt) {
                    u32x4 o;
#pragma unroll
                    for (int n = 0; n < 2; ++n) {
                        const pg8::f32x4 g = acc[ai][0][m][n], up = acc[ai][1][m][n]; float h[4];
#pragma unroll
                        for (int x = 0; x < 4; ++x) h[x] = g[x] / (1.f + __expf(-g[x])) * up[x];
                        o[2 * n] = cvtpk(h[0], h[1]); o[2 * n + 1] = cvtpk(h[2], h[3]);
                    }
                    *(u32x4*)(h1 + (size_t)(roff + lr) * 512 + 128 * nu + 32 * wc + 8 * fq) = o;
                }
            }
    }
};
struct Moe2Epi8 {
    static constexpr bool PERM = true, AFTER_DRAIN = false;
    const int* tab; const int* elist; bf16_t* y;
    __device__ __forceinline__ void operator()(const pg8::f32x4 (&acc)[2][2][4][2], const pg8::Unit& u, int wr, int wc, int fr, int fq) const {
        const int e = u.pm >> 8, mu = u.pm & 255, nu = u.pn & 3, cnt = tab[168 + e];
#pragma unroll
        for (int ai = 0; ai < 2; ++ai)
#pragma unroll
            for (int m = 0; m < 4; ++m) {
                const int lr = opq(mu * 256 + ai * 128 + wr * 64 + m * 16 + fr);
                if (lr < cnt) {
                    const int a = elist[e * NASG + lr];
#pragma unroll
                    for (int bj = 0; bj < 2; ++bj) {
                        const pg8::f32x4 v0 = acc[ai][bj][m][0], v1 = acc[ai][bj][m][1];
                        u32x4 o = {cvtpk(v0[0], v0[1]), cvtpk(v0[2], v0[3]), cvtpk(v1[0], v1[1]), cvtpk(v1[2], v1[3])};
                        *(u32x4*)(y + (size_t)a * 1024 + 256 * nu + 128 * bj + 32 * wc + 8 * fq) = o;
                    }
                }
            }
    }
};

#define XB_TMO      128
#define XB_XCNT(j)  (256  + 64 * (j))
#define XB_XSUB(j)  (1280 + 64 * (j))
#define XB_XGEN(j)  (2304 + 64 * (j))
#define XB_TOP      3328
#define XB_TOPGEN   3392
#define XCD_BAR_WORDS 3456
#define XB_SPIN_CAP (1u << 22)
#define LAS __attribute__((address_space(3)))
DI unsigned xb_ld(unsigned* p) { return __hip_atomic_load(p, __ATOMIC_RELAXED, __HIP_MEMORY_SCOPE_AGENT); }
DI unsigned xb_add(unsigned* p, unsigned v) { return __hip_atomic_fetch_add(p, v, __ATOMIC_RELAXED, __HIP_MEMORY_SCOPE_AGENT); }
DI unsigned xb_xcc_id() { return (unsigned)__builtin_amdgcn_s_getreg((3 << 11) | 20) & 0xFu; }
#define XB_SPIN(cond, bar) do { unsigned _sp = 0; while (cond) { __builtin_amdgcn_s_sleep(1); \
    if ((++_sp & 255u) == 0u) { if (xb_ld(&(bar)[XB_TMO])) break; if (_sp > XB_SPIN_CAP) { atomicAdd(&(bar)[XB_TMO], 1u); break; } } } } while (0)
struct XcdBarrier { unsigned* bar; unsigned x; volatile LAS unsigned* st; };
DI XcdBarrier xcd_barrier_post(unsigned* bar, volatile LAS unsigned* st, bool leader) {
    XcdBarrier b; b.bar = bar; b.x = xb_xcc_id(); b.st = st;
    if (leader) (void)xb_add(&bar[XB_XCNT(b.x)], 1u);
    return b;
}
DI void xcd_barrier_complete(unsigned* bar, unsigned x, unsigned& nloc, unsigned& nx) {
    const unsigned G = gridDim.x * gridDim.y * gridDim.z;
    unsigned sum, cnt, mine, sp = 0u;
    for (;;) {
        sum = 0u; cnt = 0u; mine = 0u;
#pragma unroll
        for (unsigned j = 0; j < 16; ++j) { const unsigned c = xb_ld(&bar[XB_XCNT(j)]); sum += c; cnt += (c > 0u) ? 1u : 0u; mine = (j == x) ? c : mine; }
        if (sum == G) break;
        __builtin_amdgcn_s_sleep(1);
        if ((++sp & 255u) == 0u) { if (xb_ld(&bar[XB_TMO])) break; if (sp > XB_SPIN_CAP) { atomicAdd(&bar[XB_TMO], 1u); break; } }
    }
    nloc = mine > 0u ? mine : 1u; nx = cnt > 0u ? cnt : 1u;
}
DI void xcd_barrier(const XcdBarrier& b, bool leader) {
    asm volatile("s_waitcnt vmcnt(0)" ::: "memory");
    __syncthreads();
    if (leader) {
        unsigned* bar = b.bar;
        __builtin_amdgcn_s_waitcnt(0);
        unsigned nloc = b.st[0], nx = b.st[1];
        if (nloc == 0u) { xcd_barrier_complete(bar, b.x, nloc, nx); b.st[0] = nloc; b.st[1] = nx; }
        const unsigned old = xb_add(&bar[XB_XSUB(b.x)], 1u);
        const unsigned gen = old / nloc;
        if (old + 1u == (gen + 1u) * nloc) {
            __builtin_amdgcn_fence(__ATOMIC_RELEASE, "agent");
            asm volatile("s_waitcnt vmcnt(0)" ::: "memory");
            const unsigned og = xb_add(&bar[XB_TOP], 1u);
            const unsigned tg = og / nx;
            if (og + 1u == (tg + 1u) * nx) xb_add(&bar[XB_TOPGEN], 1u);
            else XB_SPIN(xb_ld(&bar[XB_TOPGEN]) == tg, bar);
            __builtin_amdgcn_fence(__ATOMIC_ACQUIRE, "agent");
            xb_add(&bar[XB_XGEN(b.x)], 1u);
            asm volatile("s_waitcnt vmcnt(0)" ::: "memory");
        } else {
            XB_SPIN(xb_ld(&bar[XB_XGEN(b.x)]) == gen, bar);
            __builtin_amdgcn_fence(__ATOMIC_ACQUIRE, "agent");
            asm volatile("s_waitcnt vmcnt(0)" ::: "memory");
        }
    }
    __syncthreads();
}

namespace cg = cooperative_groups;
constexpr int MEGA_LDS = 65536 + 256;

DI const Params& fresh(const Params* kp) { asm volatile("" : "+s"(kp)); return *kp; }

#ifndef PROBE_MASK
#define PROBE_MASK 0
#endif
__global__ void __launch_bounds__(512, 2) hybrid_fwd_megakernel(Params p_arg) {
    __shared__ __attribute__((aligned(16))) unsigned char smem_all[2 * MEGA_LDS + 1024];
    cg::grid_group grid = cg::this_grid();
    const Params* kp = (const Params*)__builtin_amdgcn_kernarg_segment_ptr();
    const int wave8 = __builtin_amdgcn_readfirstlane((int)(threadIdx.x >> 6));
    const int vb = wave8 >> 2;
#define tid0 ((wave8 & 3) * 64 + lane_id())
    unsigned char* smem = smem_all + vb * MEGA_LDS;
    const int bid0 = blockIdx.x * 2 + vb, nb = gridDim.x * 2;
    const int gx0 = blockIdx.x & 7, glb0 = (blockIdx.x >> 3) * 2 + vb, gnl = (gridDim.x >> 3) * 2;
#define bid opqs(bid0)
#define gx opqs(gx0)
#define glb opqs(glb0)
#define tid opq(tid0)
    volatile LAS unsigned* xst = (volatile LAS unsigned*)(smem_all + 2 * MEGA_LDS);
    if (wave8 == 0 && lane_id() == 0) { xst[0] = 0u; xst[1] = 0u; }
    __syncthreads();
    (void)xcd_barrier_post((unsigned*)(fresh(kp).ws + WS_BAR), xst, wave8 == 0 && lane_id() == 0);
    for (int rep = 0; rep < ((PROBE_MASK & 1) ? 2 : 1); ++rep) { phase_init(fresh(kp), smem, bid, nb, tid); }
#define GSYNC() do { XcdBarrier xb_; xb_.bar = (unsigned*)(fresh(kp).ws + WS_BAR); xb_.x = xb_xcc_id(); xb_.st = (volatile LAS unsigned*)(smem_all + 2 * MEGA_LDS); xcd_barrier(xb_, wave8 == 0 && lane_id() == 0); } while (0)
    if (fresh(kp).use_cg_sync) grid.sync();
    GSYNC();
#pragma unroll 1
    for (int layer = 0; layer < DEPTH; ++layer) {
        const int j = layer >> 1;
        if (layer == 0) { { const Params& p = fresh(kp); phase_norm(p, 0, p.x, bid, nb, tid); }
        GSYNC(); }
        if ((layer & 1) == 0) {
            for (int rep = 0; rep < ((PROBE_MASK & 4) ? 2 : 1); ++rep) { { const Params& p = fresh(kp);
              pg8::Gemm g8{(const pg8::bf16_t*)(p.ws + WS_H), (const pg8::bf16_t*)(p.ws + WS_WHYB) + (size_t)j * 2816 * 1024, T, 2816, 1024};
              pg8::StaticOrder S8; S8.init(T, 2816, (int)gridDim.x, (int)blockIdx.x);
              HybEpi8 E8{&p, j};
              pg8::gemm_phase<HybEpi8, pg8::StaticOrder, true, true>((PG8_LAS unsigned char*)smem_all, g8, S8, E8, wave8 * 64 + lane_id()); } }
            GSYNC();
            for (int rep = 0; rep < ((PROBE_MASK & 8) ? 2 : 1); ++rep) { phase_dsa(fresh(kp), j, smem, bid, nb, tid, layer == 0 ? 1 : 3, layer == 0 ? 3 : 4); }
            for (int rep = 0; rep < ((PROBE_MASK & 16) ? 2 : 1); ++rep) { phase_conv(fresh(kp), j, bid, nb, tid); }
            GSYNC();
            { const Params& p = fresh(kp);
              pg8::Gemm g8{(const pg8::bf16_t*)(p.ws + WS_YMIX), (const pg8::bf16_t*)(p.ws + WS_WOUT) + (size_t)layer * 1024 * 1024, T, 1024, 1024};
              pg8::StaticOrder S8; S8.init(T, 1024, (int)gridDim.x, (int)blockIdx.x);
              OutEpi8 E8{layer == 0 ? p.x : p.out, p.out, (const float*)(p.ws + WS_MOD) + (size_t)layer * 8 * 6144 + 2048, (float*)(p.ws + WS_PART)};
              pg8::gemm_phase<OutEpi8, pg8::StaticOrder, true, true>((PG8_LAS unsigned char*)smem_all, g8, S8, E8, wave8 * 64 + lane_id()); }
        } else {
            for (int rep = 0; rep < ((PROBE_MASK & 32) ? 2 : 1); ++rep) { { const Params& p = fresh(kp);
              pg8::Gemm g8{(const pg8::bf16_t*)(p.ws + WS_H), (const pg8::bf16_t*)(p.ws + WS_WML) + (size_t)j * 3200 * 1024, T, 3072, 1024};
              pg8::StaticOrder S8; S8.init(T, 3072, (int)gridDim.x, (int)blockIdx.x);
              MlEpi8 E8{&p, j};
              pg8::gemm_phase<MlEpi8, pg8::StaticOrder, true, true>((PG8_LAS unsigned char*)smem_all, g8, S8, E8, wave8 * 64 + lane_id());
              for (int gi = glb; gi < 16; gi += gnl) { MlGates pr{&p, j, gx * 16 + gi}; gemm_tile(pr, smem, tid); } } }
            GSYNC();
            for (int rep = 0; rep < ((PROBE_MASK & 64) ? 2 : 1); ++rep) { phase_ml1(fresh(kp), smem, bid, nb, tid); }
            GSYNC();
            for (int rep = 0; rep < ((PROBE_MASK & 128) ? 2 : 1); ++rep) { phase_ml2(fresh(kp), smem, bid, nb, tid); }
            GSYNC();
            for (int rep = 0; rep < ((PROBE_MASK & 256) ? 2 : 1); ++rep) { phase_ml3(fresh(kp), j, smem, bid, nb, tid); }
            GSYNC();
            { const Params& p = fresh(kp);
              pg8::Gemm g8{(const pg8::bf16_t*)(p.ws + WS_YMIX), (const pg8::bf16_t*)(p.ws + WS_WOUT) + (size_t)layer * 1024 * 1024, T, 1024, 1024};
              pg8::StaticOrder S8; S8.init(T, 1024, (int)gridDim.x, (int)blockIdx.x);
              OutEpi8 E8{p.out, p.out, (const float*)(p.ws + WS_MOD) + (size_t)layer * 8 * 6144 + 2048, (float*)(p.ws + WS_PART)};
              pg8::gemm_phase<OutEpi8, pg8::StaticOrder, true, true>((PG8_LAS unsigned char*)smem_all, g8, S8, E8, wave8 * 64 + lane_id()); }
        }
        GSYNC();
        phase_ffn_norm_router(fresh(kp), layer, smem, bid, nb, tid);
        GSYNC();
        { const Params& p = fresh(kp); unsigned char* wsu = uniform_ptr(p.ws);
          int* mtab = (int*)(smem_all + 2 * MEGA_LDS + 64);
          __syncthreads();
          if (wave8 == 0) {
              const int e = lane_id(); const int cn = e < 32 ? ((const int*)(wsu + WS_ECNT))[(layer * 32 + e) * ECS] : 0;
              const int nf = cn >> 8, r = cn & 255;
              if (e < 32) { mtab[168 + e] = cn; mtab[112 + e] = nf; }
              __builtin_amdgcn_wave_barrier();
              int fx = 0, sx = 0, nF = 0;
#pragma unroll
              for (int k = 0; k < 32; ++k) { const int ck = mtab[168 + k], fk = mtab[112 + k]; fx += k < e ? fk : 0; sx += k < e ? ck : 0; nF += fk; }
              __builtin_amdgcn_wave_barrier();
              const int cls = r == 0 ? 3 : (r > 128 ? 0 : (r > 64 ? 1 : 2));
              const unsigned long long b0 = __ballot(e < 32 && cls == 0), b1 = __ballot(e < 32 && cls == 1), b2 = __ballot(e < 32 && cls == 2);
              const unsigned long long lt = (1ull << e) - 1ull;
              const int pos = cls == 0 ? __popcll(b0 & lt) : cls == 1 ? __popcll(b0) + __popcll(b1 & lt) : __popcll(b0) + __popcll(b1) + __popcll(b2 & lt);
              if (e < 32) {
                  mtab[200 + e] = sx;
                  for (int mu = 0; mu < nf; ++mu) mtab[fx + mu] = (e << 8) | mu;
                  if (cls < 3) mtab[nF + pos] = (e << 8) | nf;
              }
              if (e == 0) mtab[160] = nF + __popcll(b0 | b1 | b2);
          }
          __syncthreads();
          MoeOrder8 S8{mtab, (const int*)(wsu + WS_ELIST), (int)gridDim.x, (int)blockIdx.x, mtab[160] * 4, 1};
          pg8::Gemm g8{(const pg8::bf16_t*)(wsu + WS_H), (const pg8::bf16_t*)(wsu + WS_WM1) + (size_t)layer * 32 * 1024 * 1024, 0, 0, 1024};
          Moe1Epi8 E8{mtab, (bf16_t*)(wsu + WS_H1)};
          pg8::gemm_phase<Moe1Epi8, MoeOrder8, true, true>((PG8_LAS unsigned char*)smem_all, g8, S8, E8, wave8 * 64 + lane_id()); }
        GSYNC();
        { const Params& p = fresh(kp); unsigned char* wsu = uniform_ptr(p.ws);
          int* mtab = (int*)(smem_all + 2 * MEGA_LDS + 64);
          MoeOrder8 S8{mtab, (const int*)(wsu + WS_ELIST), (int)gridDim.x, (int)blockIdx.x, mtab[160] * 4, 2};
          pg8::Gemm g8{(const pg8::bf16_t*)(wsu + WS_H1), (const pg8::bf16_t*)(wsu + WS_WM2) + (size_t)layer * 32 * 1024 * 512, 0, 0, 512};
          Moe2Epi8 E8{mtab, (const int*)(wsu + WS_ELIST), (bf16_t*)(wsu + WS_Y)};
          pg8::gemm_phase<Moe2Epi8, MoeOrder8, true, true>((PG8_LAS unsigned char*)smem_all, g8, S8, E8, wave8 * 64 + lane_id()); }
        GSYNC();
        phase_combine_norm(fresh(kp), layer, bid, nb, tid);
        if (layer + 1 < DEPTH) GSYNC();
    }
}
#undef tid
#undef tid0
#undef bid
#undef gx
#undef glb
#undef GSYNC

extern "C" void kernel_launch(void* const* d_in, const int* in_sizes, int n_in, void* d_out, int out_size, void* d_ws, size_t ws_size, hipStream_t stream) {
    Params p{};
    const float** f = (const float**)&p;
    for (int i = 0; i < 22; ++i) f[i] = (const float*)d_in[i];
    p.out = (float*)d_out;
    p.ws = (unsigned char*)d_ws;
    if (ws_size < WS_END) { fprintf(stderr, "workspace too small: %zu < %zu\n", ws_size, (size_t)WS_END); return; }
    static int grid_blocks = 0;
    if (!grid_blocks) {
        int dev = 0, cus = 0, per_cu = 0;
        hipGetDevice(&dev);
        hipDeviceGetAttribute(&cus, hipDeviceAttributeMultiprocessorCount, dev);
        hipOccupancyMaxActiveBlocksPerMultiprocessor(&per_cu, hybrid_fwd_megakernel, 512, 0);
        if (per_cu > 1) per_cu = 1;
        grid_blocks = cus * per_cu;
    }
    (void)hipMemsetAsync((unsigned char*)d_ws + WS_BAR, 0, XCD_BAR_WORDS_C * 4, stream);
    void* args[] = {&p};
    hipError_t e = hipLaunchCooperativeKernel((void*)hybrid_fwd_megakernel, dim3(grid_blocks), dim3(512), args, 0, stream);
    if (e != hipSuccess) fprintf(stderr, "cooperative launch failed: %s (grid %d)\n", hipGetErrorString(e), grid_blocks);
}
```

```cpp
#include <hip/hip_runtime.h>
#include <hip/hip_cooperative_groups.h>
#include <stdint.h>
#include <cstdio>

#define DI __device__ __forceinline__
typedef unsigned short bf16_t;
typedef short bf16x8 __attribute__((ext_vector_type(8)));
typedef float f32x16 __attribute__((ext_vector_type(16)));
typedef float f32x4 __attribute__((ext_vector_type(4)));
typedef float f32x2 __attribute__((ext_vector_type(2)));
typedef unsigned u32x4 __attribute__((ext_vector_type(4)));
typedef unsigned u32x2 __attribute__((ext_vector_type(2)));
typedef __bf16 bf16x2_t __attribute__((ext_vector_type(2)));

constexpr int D = 1024, NB = 8, S = 2048, T = NB * S, DEPTH = 4;
constexpr int HYB_IN = 2760, ML_IN = 3088;
constexpr int NEXP = 32, DEXP = 512, NASG = T * 2;
constexpr float EPS = 1e-6f;
constexpr int XCD_BAR_WORDS_C = 3456;

constexpr size_t al256(size_t x) { return (x + 255) & ~(size_t)255; }
constexpr size_t WS_MOD = 0;
constexpr size_t WS_ROPEC = WS_MOD + al256((size_t)4 * 8 * 6144 * 4);
constexpr size_t WS_ROPES = WS_ROPEC + al256((size_t)2048 * 32 * 4);
constexpr size_t WS_ECNT = WS_ROPES + al256((size_t)2048 * 32 * 4);
constexpr int ECS = 64;
constexpr size_t WS_H = WS_ECNT + al256(4 * 32 * ECS * 4);
constexpr size_t WS_YMIX = WS_H + al256((size_t)T * 1024 * 2);
constexpr size_t WS_Q = WS_YMIX + al256((size_t)T * 1024 * 2);
constexpr size_t WS_K = WS_Q + al256((size_t)T * 512 * 2);
constexpr size_t WS_V = WS_K + al256((size_t)T * 64 * 2);
constexpr size_t WS_IQ = WS_V + al256((size_t)T * 64 * 2);
constexpr size_t WS_IK = WS_IQ + al256((size_t)T * 512 * 2);
constexpr size_t WS_IW = WS_IK + al256((size_t)T * 64 * 2);
constexpr size_t WS_BG = WS_IW + al256((size_t)T * 8 * 4);
constexpr size_t WS_Z = WS_BG + al256((size_t)T * 512 * 2);
constexpr size_t WS_MASK = WS_Z + al256((size_t)T * 512 * 2);
constexpr size_t WS_MQ = WS_MASK + al256((size_t)T * 64 * 4);
constexpr size_t WS_MK = WS_MQ + al256((size_t)T * 512 * 2);
constexpr size_t WS_MV = WS_MK + al256((size_t)T * 512 * 2);
constexpr size_t WS_MIG = WS_MV + al256((size_t)T * 1024 * 2);
constexpr size_t WS_MFG = WS_MIG + al256((size_t)T * 8 * 4);
constexpr size_t WS_MOG = WS_MFG + al256((size_t)T * 8 * 4);
constexpr size_t WS_EW = WS_MOG + al256((size_t)T * 1024 * 2);
constexpr size_t WS_ELIST = WS_EW + al256((size_t)NASG * 4);
constexpr size_t WS_H1 = WS_ELIST + al256((size_t)NEXP * NASG * 4);
constexpr size_t WS_Y = WS_H1 + al256((size_t)NASG * 512 * 2);
constexpr size_t WS_MKT = WS_Y + al256((size_t)NASG * 1024 * 2);
constexpr size_t WS_UBUF = WS_MKT + al256((size_t)64 * 64 * S * 2);
constexpr size_t WS_UNBUF = WS_UBUF + al256((size_t)64 * 32 * 8192 * 4);
constexpr size_t WS_MLOC = WS_UNBUF + al256((size_t)64 * 32 * 64 * 4);
constexpr size_t WS_CBUF = WS_MLOC + al256((size_t)64 * 32 * 2 * 4);
constexpr size_t WS_NBUF = WS_CBUF + al256((size_t)64 * 32 * 8192 * 2);
constexpr size_t WS_MST = WS_NBUF + al256((size_t)64 * 32 * 64 * 4);
constexpr size_t WS_PART = WS_MST + al256((size_t)64 * 32 * 4);
constexpr size_t WS_WHYB = WS_PART + al256((size_t)T * 16 * 4);
constexpr size_t WS_WML = WS_WHYB + al256((size_t)2 * 2816 * 1024 * 2);
constexpr size_t WS_WOUT = WS_WML + al256((size_t)2 * 3200 * 1024 * 2);
constexpr size_t WS_WM1 = WS_WOUT + al256((size_t)4 * 1024 * 1024 * 2);
constexpr size_t WS_WM2 = WS_WM1 + al256((size_t)4 * 32 * 1024 * 1024 * 2);
constexpr size_t WS_BAR = WS_WM2 + al256((size_t)4 * 32 * 1024 * 512 * 2);
constexpr size_t WS_END = WS_BAR + al256((size_t)XCD_BAR_WORDS_C * 4);

struct Params {
    const float *x, *c, *ada_w, *ada_b, *norm_mix, *norm_ffn, *hy_w_in, *hy_q_norm, *hy_k_norm, *hy_conv_w, *hy_w_out;
    const float *ml_w_in, *ml_b_gates, *ml_out_norm, *ml_w_out, *moe_w_group, *moe_b_group, *moe_w_expert, *moe_b_expert;
    const float *moe_w_gate, *moe_w_up, *moe_w_down;
    float* out;
    unsigned char* ws;
    unsigned long long use_cg_sync;
};

DI unsigned pk2(float lo, float hi) { f32x2 v = {lo, hi}; bf16x2_t b = __builtin_convertvector(v, bf16x2_t); return __builtin_bit_cast(unsigned, b); }
DI bf16_t f2bf(float x) { return (bf16_t)(pk2(x, 0.f) & 0xffffu); }
DI float bf2f(bf16_t h) { return __uint_as_float(((unsigned)h) << 16); }
DI float bflo(unsigned u) { return __uint_as_float(u << 16); }
DI float bfhi(unsigned u) { return __uint_as_float(u & 0xffff0000u); }
DI int lane_id() { int x; asm volatile("v_mbcnt_lo_u32_b32 %0, -1, 0\n\tv_mbcnt_hi_u32_b32 %0, -1, %0" : "=v"(x)); return x; }
template <int M> DI int sx_i(int v) {
    if constexpr (M < 32) return __builtin_amdgcn_ds_swizzle(v, (M << 10) | 0x1f);
    else return __builtin_amdgcn_ds_bpermute((lane_id() ^ 32) << 2, v);
}
template <int M> DI float sx_f(float v) { return __int_as_float(sx_i<M>(__float_as_int(v))); }
DI float lane_get_f(float v, int src) { return __int_as_float(__builtin_amdgcn_ds_bpermute(src << 2, __float_as_int(v))); }
DI float wave_sum(float v) { v += sx_f<32>(v); v += sx_f<16>(v); v += sx_f<8>(v); v += sx_f<4>(v); v += sx_f<2>(v); v += sx_f<1>(v); return v; }
DI float wave_max(float v) { v = fmaxf(v, sx_f<32>(v)); v = fmaxf(v, sx_f<16>(v)); v = fmaxf(v, sx_f<8>(v)); v = fmaxf(v, sx_f<4>(v)); v = fmaxf(v, sx_f<2>(v)); v = fmaxf(v, sx_f<1>(v)); return v; }
DI float half_sum(float v) { v += sx_f<16>(v); v += sx_f<8>(v); v += sx_f<4>(v); v += sx_f<2>(v); v += sx_f<1>(v); return v; }
DI float sigmoidf_(float x) { return __builtin_amdgcn_rcpf(1.f + __expf(-x)); }
DI unsigned char* uniform_ptr(unsigned char* q) {
    const unsigned long long w = (unsigned long long)q;
    const unsigned lo = __builtin_amdgcn_readfirstlane((unsigned)w), hi = __builtin_amdgcn_readfirstlane((unsigned)(w >> 32));
    return (unsigned char*)(((unsigned long long)hi << 32) | lo);
}
DI int opqs(int x) { asm volatile("" : "+s"(x)); return x; }
DI int opq(int x) { asm volatile("" : "+v"(x)); return x; }

DI int swz(int row, int slot) { return row * 128 + ((slot ^ ((row >> 1) & 7)) << 4); }
DI int crow(int reg, int lane) { return (reg & 3) + 8 * (reg >> 2) + 4 * (lane >> 5); }

template <class P>
DI void gemm_tile(const P& pr, unsigned char* smem, int tid) {
    const int lane = tid & 63, wid = tid >> 6, wr = wid >> 1, wc = wid & 1;
    const bf16_t* abase = pr.a_base();
    const bf16_t* bbase = pr.b_base();
    const int kdim = pr.kt() * 64;
    int gao[4], gbo[4];
#pragma unroll
    for (int i = 0; i < 4; ++i) {
        const int row = (tid >> 3) + 32 * i, sl = (tid & 7) ^ ((row >> 1) & 7);
        const int o = pr.a_off(row);
        gao[i] = (o >= 0 ? o : 0) + sl * 8; gbo[i] = row * kdim + sl * 8;
    }
#define GLDS(buf, kt) do { _Pragma("unroll") for (int i = 0; i < 4; ++i) { \
        __builtin_amdgcn_global_load_lds((const unsigned*)(abase + gao[i] + (kt) * 64), (__attribute__((address_space(3))) unsigned*)(smem + (buf) * 32768 + (i * 256 + wid * 64) * 16), 16, 0, 0); \
        __builtin_amdgcn_global_load_lds((const unsigned*)(bbase + gbo[i] + (kt) * 64), (__attribute__((address_space(3))) unsigned*)(smem + (buf) * 32768 + 16384 + (i * 256 + wid * 64) * 16), 16, 0, 0); } } while (0)
#define DMA_WAIT_SYNC() do { asm volatile("s_waitcnt vmcnt(0)" ::: "memory"); __syncthreads(); } while (0)
#define COMPUTE(buf) do { const unsigned char* As = smem + (buf) * 32768; const unsigned char* Bs = As + 16384; \
        _Pragma("unroll") for (int ks = 0; ks < 4; ++ks) { const int slot = ks * 2 + (lane >> 5); \
            const bf16x8 a0 = *(const bf16x8*)(As + swz(wr * 64 + (lane & 31), slot)); const bf16x8 a1 = *(const bf16x8*)(As + swz(wr * 64 + 32 + (lane & 31), slot)); \
            const bf16x8 b0 = *(const bf16x8*)(Bs + swz(wc * 64 + (lane & 31), slot)); const bf16x8 b1 = *(const bf16x8*)(Bs + swz(wc * 64 + 32 + (lane & 31), slot)); \
            acc[0][0] = __builtin_amdgcn_mfma_f32_32x32x16_bf16(a0, b0, acc[0][0], 0, 0, 0); acc[0][1] = __builtin_amdgcn_mfma_f32_32x32x16_bf16(a0, b1, acc[0][1], 0, 0, 0); \
            acc[1][0] = __builtin_amdgcn_mfma_f32_32x32x16_bf16(a1, b0, acc[1][0], 0, 0, 0); acc[1][1] = __builtin_amdgcn_mfma_f32_32x32x16_bf16(a1, b1, acc[1][1], 0, 0, 0); } } while (0)
    f32x16 acc[2][2];
#pragma unroll
    for (int a = 0; a < 2; ++a)
#pragma unroll
        for (int b = 0; b < 2; ++b)
#pragma unroll
            for (int r = 0; r < 16; ++r) acc[a][b][r] = 0.f;
    const int KT = pr.kt();
    __syncthreads();
    GLDS(0, 0);
    DMA_WAIT_SYNC();
    for (int kt = 0; kt < KT; kt += 2) {
        GLDS(1, kt + 1);
        COMPUTE(0);
        DMA_WAIT_SYNC();
        if (kt + 2 < KT) GLDS(0, kt + 2);
        COMPUTE(1);
        DMA_WAIT_SYNC();
    }
#undef GLDS
#undef DMA_WAIT_SYNC
#undef COMPUTE
    pr.epi(acc, wr, wc, lane, smem + wid * 8192);
}

template <class P>
DI void convert_tile(const P& pr, bf16_t* dst, int kdim, int kt, unsigned char* smem, int tid) {
    unsigned char* Bs = smem;
    const int ng = tid & 31, kg = tid >> 5;
    int width = 0;
    const float* bp = pr.b_col(ng >> 3, width);
    const int cig = (ng & 7) * 4;
    const bool bvalid = cig < width;
    const int ldb = pr.ldb();
    bp += cig + (size_t)(kt * 64 + kg * 8) * ldb;
    f32x4 rb[8];
#pragma unroll
    for (int kk = 0; kk < 8; ++kk) rb[kk] = bvalid ? *(const f32x4*)(bp + (size_t)kk * ldb) : (f32x4){0.f, 0.f, 0.f, 0.f};
    __syncthreads();
#pragma unroll
    for (int j = 0; j < 4; ++j) {
        u32x4 v = {pk2(rb[0][j], rb[1][j]), pk2(rb[2][j], rb[3][j]), pk2(rb[4][j], rb[5][j]), pk2(rb[6][j], rb[7][j])};
        *(u32x4*)(Bs + swz(ng * 4 + j, kg)) = v;
    }
    __syncthreads();
#pragma unroll
    for (int i = 0; i < 4; ++i) {
        const int n = (tid >> 3) + 32 * i;
        *(u32x4*)(dst + (size_t)n * kdim + kt * 64 + (tid & 7) * 8) = *(const u32x4*)(Bs + swz(n, tid & 7));
    }
}

template <int NC> DI void stage_put(unsigned char* wl, int mi, int ni, int r, int lane, float v) { *(bf16_t*)(wl + ((mi * 32 + crow(r, lane)) * NC + ni * 32 + (lane & 31)) * 2) = f2bf(v); }
template <int NC, class RowPtr> DI void stage_flush(unsigned char* wl, int lane, RowPtr rp) {
    constexpr int CH = NC / 8, RPI = 64 / CH, NIT = 64 / RPI;
#pragma unroll
    for (int i = 0; i < NIT; ++i) {
        const int row = lane / CH + RPI * i, ch = lane % CH;
        const u32x4 d = *(const u32x4*)(wl + (row * NC + ch * 8) * 2);
        bf16_t* dst = rp(row);
        if (dst) *(u32x4*)(dst + ch * 8) = d;
    }
}

struct HybIn {
    const Params* p; int j, tm, tn;
    DI int kt() const { return 16; }
    DI int ldb() const { return HYB_IN; }
    DI const bf16_t* a_base() const { return (const bf16_t*)(p->ws + WS_H); }
    DI int a_off(int r) const { return (tm * 128 + r) * 1024; }
    DI static void pair_cols(int pr, int ni, int& base, int& width) {
        width = 32;
        if (pr < 8) base = 64 * pr + 32 * ni;
        else if (pr == 8) base = 512 + 32 * ni;
        else if (pr == 9) base = 576 + 32 * ni;
        else if (pr < 18) base = 640 + 64 * (pr - 10) + 32 * ni;
        else if (pr == 18) base = 1152 + 32 * ni;
        else if (pr == 19) { base = 1216; width = ni == 0 ? 8 : 0; }
        else if (pr < 28) base = 1224 + 64 * (pr - 20) + 32 * ni;
        else base = (ni == 0 ? 1736 : 2248) + 32 * (pr - 28);
    }
    DI const float* b_col(int g, int& width) const { int base; pair_cols(tn * 2 + (g >> 1), g & 1, base, width); return p->hy_w_in + (size_t)j * 1024 * HYB_IN + base; }
    DI const bf16_t* b_base() const { return (const bf16_t*)(p->ws + WS_WHYB) + (size_t)(j * 22 + tn) * 128 * 1024; }
    DI void epi(f32x16 (&acc)[2][2], int wr, int wc, int lane, unsigned char* wl) const {
        const int pr = tn * 2 + wc, c = lane & 31;
        const int t0 = tm * 128 + wr * 64;
        unsigned char* ws = p->ws;
        const float* ropec = (const float*)(ws + WS_ROPEC);
        const float* ropes = (const float*)(ws + WS_ROPES);
        if (pr < 9 || (pr >= 10 && pr < 19)) {
            const bool donorm = pr < 9;
            const float* gam = pr < 8 ? p->hy_q_norm + j * 64 : p->hy_k_norm + j * 64;
            bf16_t* ob; int ld, cb;
            if (pr < 8) { ob = (bf16_t*)(ws + WS_Q); ld = 512; cb = 64 * pr; }
            else if (pr == 8) { ob = (bf16_t*)(ws + WS_K); ld = 64; cb = 0; }
            else if (pr < 18) { ob = (bf16_t*)(ws + WS_IQ); ld = 512; cb = 64 * (pr - 10); }
            else { ob = (bf16_t*)(ws + WS_IK); ld = 64; cb = 0; }
            float g1 = 1.f, g2 = 1.f;
            if (donorm) { g1 = gam[c]; g2 = gam[c + 32]; }
#pragma unroll
            for (int mi = 0; mi < 2; ++mi)
#pragma unroll
                for (int r = 0; r < 16; ++r) {
                    float x1 = acc[mi][0][r], x2 = acc[mi][1][r];
                    const int t = t0 + mi * 32 + crow(r, lane), pos = t & (S - 1);
                    if (donorm) { float ss = half_sum(x1 * x1 + x2 * x2); float rstd = rsqrtf(ss * (1.f / 64.f) + EPS); x1 *= rstd * g1; x2 *= rstd * g2; }
                    const float cs = ropec[pos * 32 + c], sn = ropes[pos * 32 + c];
                    stage_put<64>(wl, mi, 0, r, lane, x1 * cs - x2 * sn);
                    stage_put<64>(wl, mi, 1, r, lane, x2 * cs + x1 * sn);
                }
            stage_flush<64>(wl, lane, [&](int row) { return ob + (size_t)(t0 + row) * ld + cb; });
        } else if (pr == 9) {
            bf16_t* ob = (bf16_t*)(ws + WS_V);
#pragma unroll
            for (int mi = 0; mi < 2; ++mi)
#pragma unroll
                for (int ni = 0; ni < 2; ++ni)
#pragma unroll
                    for (int g4 = 0; g4 < 4; ++g4) {
                        const int t = t0 + mi * 32 + 8 * g4 + 4 * (lane >> 5), pos = t & (S - 1), bb = t >> 11;
                        u32x2 o = {pk2(acc[mi][ni][4 * g4], acc[mi][ni][4 * g4 + 1]), pk2(acc[mi][ni][4 * g4 + 2], acc[mi][ni][4 * g4 + 3])};
                        *(u32x2*)(ob + ((size_t)(bb * 64 + ni * 32 + c)) * S + pos) = o;
                    }
        } else if (pr == 19) {
            float* ob = (float*)(ws + WS_IW);
            if (c < 8) {
#pragma unroll
                for (int mi = 0; mi < 2; ++mi)
#pragma unroll
                    for (int r = 0; r < 16; ++r) { const int t = t0 + mi * 32 + crow(r, lane); ob[(size_t)t * 8 + c] = acc[mi][0][r] * (0.125f * 0.35355339059327373f); }
            }
        } else if (pr < 28) {
            bf16_t* ob = (bf16_t*)(ws + WS_BG); const int cb = 64 * (pr - 20);
#pragma unroll
            for (int mi = 0; mi < 2; ++mi)
#pragma unroll
                for (int r = 0; r < 16; ++r) { stage_put<64>(wl, mi, 0, r, lane, acc[mi][0][r]); stage_put<64>(wl, mi, 1, r, lane, acc[mi][1][r]); }
            stage_flush<64>(wl, lane, [&](int row) { return ob + (size_t)(t0 + row) * 512 + cb; });
        } else {
            bf16_t* ob = (bf16_t*)(ws + WS_Z); const int cb = 32 * (pr - 28);
#pragma unroll
            for (int mi = 0; mi < 2; ++mi)
#pragma unroll
                for (int r = 0; r < 16; ++r) stage_put<32>(wl, mi, 0, r, lane, acc[mi][0][r] * acc[mi][1][r]);
            stage_flush<32>(wl, lane, [&](int row) { return ob + (size_t)(t0 + row) * 512 + cb; });
        }
    }
};


struct HybCols8 {
    const Params* p; int j, tm, tn;
    DI int ldb() const { return HYB_IN; }
    DI const float* b_col(int g, int& width) const {
        const int u = tn >> 1, bj = tn & 1; int base; width = 32;
        if (u < 2) base = 64 * (4 * u + g) + 32 * bj;
        else if (u < 4) base = 640 + 64 * (4 * (u - 2) + g) + 32 * bj;
        else if (u == 4) { if (g == 0) base = 512 + 32 * bj; else if (g == 1) base = 576 + 32 * bj; else if (g == 2) base = 1152 + 32 * bj; else { base = 1216; width = bj == 0 ? 8 : 0; } }
        else if (u < 7) base = 1224 + (u - 5) * 256 + 128 * bj + 32 * g;
        else base = (bj == 0 ? 1736 : 2248) + (u - 7) * 128 + 32 * g;
        return p->hy_w_in + (size_t)j * 1024 * HYB_IN + base;
    }
};

struct MlIn {
    const Params* p; int j, tm, tn;
    DI int kt() const { return 16; }
    DI int ldb() const { return ML_IN; }
    DI const bf16_t* a_base() const { return (const bf16_t*)(p->ws + WS_H); }
    DI int a_off(int r) const { return (tm * 128 + r) * 1024; }
    DI const float* b_col(int g, int& width) const {
        const int pr = tn * 2 + (g >> 1), ni = g & 1; int base; width = 32;
        if (pr < 32) base = 64 * pr + 32 * ni;
        else if (pr == 32) { base = 2048 + 8 * ni; width = 8; }
        else if (pr < 49) base = 2064 + 64 * (pr - 33) + 32 * ni;
        else { base = 0; width = 0; }
        return p->ml_w_in + (size_t)j * 1024 * ML_IN + base;
    }
    DI const bf16_t* b_base() const { return (const bf16_t*)(p->ws + WS_WML) + (size_t)(j * 25 + tn) * 128 * 1024; }
    DI void epi(f32x16 (&acc)[2][2], int wr, int wc, int lane, unsigned char* wl) const {
        const int pr = tn * 2 + wc, c = lane & 31;
        const int t0 = tm * 128 + wr * 64;
        unsigned char* ws = p->ws;
        if (pr < 16) {
            bf16_t* ob; int cb; float sc = 1.f;
            if (pr < 8) { ob = (bf16_t*)(ws + WS_MQ); cb = 64 * pr; sc = 0.125f; }
            else { ob = (bf16_t*)(ws + WS_MK); cb = 64 * (pr - 8); }
#pragma unroll
            for (int mi = 0; mi < 2; ++mi)
#pragma unroll
                for (int r = 0; r < 16; ++r) { stage_put<64>(wl, mi, 0, r, lane, acc[mi][0][r] * sc); stage_put<64>(wl, mi, 1, r, lane, acc[mi][1][r] * sc); }
            stage_flush<64>(wl, lane, [&](int row) { return ob + (size_t)(t0 + row) * 512 + cb; });
        }
        if (pr >= 8 && pr < 32) {
            bf16_t* ob; int nrow, hd, r0;
            if (pr < 16) { ob = (bf16_t*)(ws + WS_MKT); nrow = 64; hd = pr - 8; r0 = 0; }
            else { ob = (bf16_t*)(ws + WS_MV); nrow = 128; hd = (pr - 16) >> 1; r0 = 64 * ((pr - 16) & 1); }
#pragma unroll
            for (int mi = 0; mi < 2; ++mi)
#pragma unroll
                for (int ni = 0; ni < 2; ++ni)
#pragma unroll
                    for (int g4 = 0; g4 < 4; ++g4) {
                        const int t = t0 + mi * 32 + 8 * g4 + 4 * (lane >> 5), pos = t & (S - 1), bb = t >> 11;
                        u32x2 o = {pk2(acc[mi][ni][4 * g4], acc[mi][ni][4 * g4 + 1]), pk2(acc[mi][ni][4 * g4 + 2], acc[mi][ni][4 * g4 + 3])};
                        *(u32x2*)(ob + ((size_t)((bb * 8 + hd) * nrow + r0 + ni * 32 + c)) * S + pos) = o;
                    }
        } else if (pr == 32) {
            if (c < 8) {
                float* oi = (float*)(ws + WS_MIG); float* of = (float*)(ws + WS_MFG);
                const float bi = p->ml_b_gates[j * 16 + c], bfg = p->ml_b_gates[j * 16 + 8 + c];
#pragma unroll
                for (int mi = 0; mi < 2; ++mi)
#pragma unroll
                    for (int r = 0; r < 16; ++r) {
                        const int t = t0 + mi * 32 + crow(r, lane);
                        oi[(size_t)t * 8 + c] = acc[mi][0][r] + bi;
                        const float f = acc[mi][1][r] + bfg;
                        of[(size_t)t * 8 + c] = fminf(f, 0.f) - log1pf(__expf(-fabsf(f)));
                    }
            }
        } else if (pr >= 33 && pr < 49) {
            bf16_t* ob = (bf16_t*)(ws + WS_MOG); const int cb = 64 * (pr - 33);
#pragma unroll
            for (int mi = 0; mi < 2; ++mi)
#pragma unroll
                for (int r = 0; r < 16; ++r) { stage_put<64>(wl, mi, 0, r, lane, sigmoidf_(acc[mi][0][r])); stage_put<64>(wl, mi, 1, r, lane, sigmoidf_(acc[mi][1][r])); }
            stage_flush<64>(wl, lane, [&](int row) { return ob + (size_t)(t0 + row) * 1024 + cb; });
        }
    }
};


struct MlCols8 {
    const Params* p; int j, tm, tn;
    DI int ldb() const { return ML_IN; }
    DI const float* b_col(int g, int& width) const {
        const int u = tn >> 1, bj = tn & 1; int base; width = 32;
        if (tn == 24) { base = 2048 + 8 * (g & 1); width = g < 2 ? 8 : 0; }
        else if (u < 2) base = 64 * (4 * u + g) + 32 * bj;
        else if (u < 4) base = 512 + 64 * (4 * (u - 2) + g) + 32 * bj;
        else if (u < 8) base = 1024 + (2 * (u - 4) + bj) * 128 + 32 * g;
        else base = 2064 + (u - 8) * 256 + 128 * bj + 32 * g;
        return p->ml_w_in + (size_t)j * 1024 * ML_IN + base;
    }
};
struct MlGates {
    const Params* p; int j, tm;
    DI int kt() const { return 16; }
    DI const bf16_t* a_base() const { return (const bf16_t*)(p->ws + WS_H); }
    DI int a_off(int r) const { return (tm * 128 + r) * 1024; }
    DI const bf16_t* b_base() const { return (const bf16_t*)(p->ws + WS_WML) + (size_t)(j * 25 + 24) * 128 * 1024; }
    DI void epi(f32x16 (&acc)[2][2], int wr, int wc, int lane, unsigned char* wl) const {
        const int c = lane & 31, t0 = tm * 128 + wr * 64;
        if (wc == 0 && c < 8) {
            float* oi = (float*)(p->ws + WS_MIG); float* of = (float*)(p->ws + WS_MFG);
            const float bi = p->ml_b_gates[j * 16 + c], bfg = p->ml_b_gates[j * 16 + 8 + c];
#pragma unroll
            for (int mi = 0; mi < 2; ++mi)
#pragma unroll
                for (int r = 0; r < 16; ++r) {
                    const int t = t0 + mi * 32 + crow(r, lane);
                    oi[(size_t)t * 8 + c] = acc[mi][0][r] + bi;
                    const float f = acc[mi][1][r] + bfg;
                    of[(size_t)t * 8 + c] = fminf(f, 0.f) - log1pf(__expf(-fabsf(f)));
                }
        }
    }
};

struct OutProj {
    const Params* p; const float* W; const float* src; int layer, tm, tn;
    DI int kt() const { return 16; }
    DI int ldb() const { return 1024; }
    DI const bf16_t* a_base() const { return (const bf16_t*)(p->ws + WS_YMIX); }
    DI int a_off(int r) const { return (tm * 128 + r) * 1024; }
    DI const float* b_col(int g, int& width) const { width = 32; return W + tn * 128 + g * 32; }
    DI const bf16_t* b_base() const { return (const bf16_t*)(p->ws + WS_WOUT) + (size_t)(layer * 8 + tn) * 128 * 1024; }
    DI void epi(f32x16 (&acc)[2][2], int wr, int wc, int lane, unsigned char* wl) const {
        const int c = lane & 31, t0 = tm * 128 + wr * 64, wid = wr * 2 + wc;
        float* fl = (float*)(wl + wid * 8192);
#pragma unroll
        for (int mi = 0; mi < 2; ++mi)
#pragma unroll
            for (int ni = 0; ni < 2; ++ni)
#pragma unroll
                for (int r = 0; r < 16; ++r) fl[(mi * 32 + crow(r, lane)) * 64 + ni * 32 + c] = acc[mi][ni][r];
        const float* mod = (const float*)(p->ws + WS_MOD) + (size_t)layer * 8 * 6144;
        const int ch = lane & 15, n = tn * 128 + wc * 64 + ch * 4;
        const f32x4 g = *(const f32x4*)(mod + (t0 >> 11) * 6144 + 2048 + n);
        float* part = (float*)(p->ws + WS_PART);
#pragma unroll 4
        for (int i = 0; i < 16; ++i) {
            const int row = (lane >> 4) + 4 * i, t = t0 + row;
            const f32x4 a = *(const f32x4*)(fl + row * 64 + ch * 4);
            const f32x4 o = *(const f32x4*)(src + (size_t)t * 1024 + n) + g * a;
            *(f32x4*)(p->out + (size_t)t * 1024 + n) = o;
            float ss = o[0] * o[0] + o[1] * o[1] + o[2] * o[2] + o[3] * o[3];
            ss += sx_f<1>(ss); ss += sx_f<2>(ss); ss += sx_f<4>(ss); ss += sx_f<8>(ss);
            if (ch == 0) part[(size_t)t * 16 + tn * 2 + wc] = ss;
        }
    }
};

struct Moe1 {
    const Params* p; int layer, e, mt, nt, cnt, roff;
    DI int kt() const { return 16; }
    DI int ldb() const { return DEXP; }
    DI const bf16_t* a_base() const { return (const bf16_t*)(p->ws + WS_H); }
    DI int a_off(int r) const {
        const int rr = mt * 128 + r; if (rr >= cnt) return -1;
        const int a = ((const int*)(p->ws + WS_ELIST))[(size_t)e * NASG + rr];
        return (a >> 1) * 1024;
    }
    DI const float* b_col(int g, int& width) const {
        width = 32;
        const float* base = (nt & 1) ? p->moe_w_up : p->moe_w_gate;
        return base + ((size_t)layer * NEXP + e) * (size_t)(D * DEXP) + 128 * (nt >> 1) + 32 * g;
    }
    DI const bf16_t* b_base() const { return (const bf16_t*)(p->ws + WS_WM1) + (size_t)((layer * NEXP + e) * 8 + nt) * 128 * 1024; }
    DI void epi(f32x16 (&acc)[2][2], int wr, int wc, int lane, unsigned char* wl) const {
        const int c = lane & 31, pr = nt * 2 + wc;
        bf16_t* ob = (bf16_t*)(p->ws + WS_H1);
#pragma unroll
        for (int mi = 0; mi < 2; ++mi)
#pragma unroll
            for (int r = 0; r < 16; ++r) {
                const float g = acc[mi][0][r], u = acc[mi][1][r];
                stage_put<32>(wl, mi, 0, r, lane, g / (1.f + __expf(-g)) * u);
            }
        const int rb = mt * 128 + wr * 64;
        stage_flush<32>(wl, lane, [&](int row) { return rb + row < cnt ? ob + (size_t)(roff + rb + row) * 512 + 32 * pr : (bf16_t*)nullptr; });
    }
};

struct Moe2 {
    const Params* p; int layer, e, mt, nt, cnt, roff;
    DI int kt() const { return 8; }
    DI int ldb() const { return D; }
    DI const bf16_t* a_base() const { return (const bf16_t*)(p->ws + WS_H1); }
    DI int a_off(int r) const { const int rr = mt * 128 + r; if (rr >= cnt) return -1; return (roff + rr) * 512; }
    DI const float* b_col(int g, int& width) const { width = 32; return p->moe_w_down + ((size_t)layer * NEXP + e) * (size_t)(DEXP * D) + nt * 128 + g * 32; }
    DI const bf16_t* b_base() const { return (const bf16_t*)(p->ws + WS_WM2) + (size_t)((layer * NEXP + e) * 8 + nt) * 128 * 512; }
    DI void epi(f32x16 (&acc)[2][2], int wr, int wc, int lane, unsigned char* wl) const {
        const int c = lane & 31;
        bf16_t* ob = (bf16_t*)(p->ws + WS_Y);
        const int* el = (const int*)(p->ws + WS_ELIST) + (size_t)e * NASG;
#pragma unroll
        for (int mi = 0; mi < 2; ++mi)
#pragma unroll
            for (int r = 0; r < 16; ++r) { stage_put<64>(wl, mi, 0, r, lane, acc[mi][0][r]); stage_put<64>(wl, mi, 1, r, lane, acc[mi][1][r]); }
        const int rb = mt * 128 + wr * 64;
        stage_flush<64>(wl, lane, [&](int row) { return rb + row < cnt ? ob + (size_t)el[rb + row] * 1024 + nt * 128 + wc * 64 : (bf16_t*)nullptr; });
    }
};

DI void convert_moe_layers(const Params& p, int l0, int l1, unsigned char* smem, int bid, int nb, int tid) {
    const int PER = 32 * 8 * 16 + 32 * 8 * 8, total = (l1 - l0) * PER;
    for (int item = bid; item < total; item += nb) {
        const int l = l0 + item / PER; int ci = item % PER;
        if (ci < 4096) { const int kt = ci & 15, nt = (ci >> 4) & 7, e = ci >> 7; Moe1 pr{&p, l, e, 0, nt, 0, 0}; convert_tile(pr, (bf16_t*)(p.ws + WS_WM1) + (size_t)((l * 32 + e) * 8 + nt) * 128 * 1024, 1024, kt, smem, tid); }
        else { ci -= 4096; const int kt = ci & 7, nt = (ci >> 3) & 7, e = ci >> 6; Moe2 pr{&p, l, e, 0, nt, 0, 0}; convert_tile(pr, (bf16_t*)(p.ws + WS_WM2) + (size_t)((l * 32 + e) * 8 + nt) * 128 * 512, 512, kt, smem, tid); }
    }
    __syncthreads();
}

DI void phase_init(const Params& p, unsigned char* smem, int bid, int nb, int tid) {
    float* sc = (float*)smem;
    float* red = (float*)(smem + 32768);
    const int NMOD = DEPTH * 96, NROPE = 256;
    const int C_HYB = 2 * 22 * 16, C_ML = 2 * 25 * 16, C_OUT = 4 * 8 * 16;
    for (int ci = bid; ci < C_HYB + C_ML + C_OUT; ci += nb) {
        int c2 = ci;
        if (c2 < C_HYB) { const int kt = c2 & 15, tn = (c2 >> 4) % 22, j = (c2 >> 4) / 22; HybCols8 pr{&p, j, 0, tn}; convert_tile(pr, (bf16_t*)(p.ws + WS_WHYB) + (size_t)(j * 22 + tn) * 128 * 1024, 1024, kt, smem, tid); continue; }
        c2 -= C_HYB;
        if (c2 < C_ML) { const int kt = c2 & 15, tn = (c2 >> 4) % 25, j = (c2 >> 4) / 25; MlCols8 pr{&p, j, 0, tn}; convert_tile(pr, (bf16_t*)(p.ws + WS_WML) + (size_t)(j * 25 + tn) * 128 * 1024, 1024, kt, smem, tid); continue; }
        c2 -= C_ML;
        { const int kt = c2 & 15, tn = (c2 >> 4) & 7, l = c2 >> 7; const float* W = ((l & 1) ? p.ml_w_out : p.hy_w_out) + (size_t)(l >> 1) * 1024 * 1024;
            OutProj pr{&p, W, nullptr, l, 0, tn}; convert_tile(pr, (bf16_t*)(p.ws + WS_WOUT) + (size_t)(l * 8 + tn) * 128 * 1024, 1024, kt, smem, tid); }
    }
    for (int item = bid; item < NMOD; item += nb) {
        __syncthreads();
        for (int i = tid; i < 8 * 1024; i += 256) { const float v = p.c[i]; sc[i] = v / (1.f + __expf(-v)); }
        __syncthreads();
        const int l = item / 96, jb = item % 96, cq = tid & 15, ksl = tid >> 4;
        const float* w = p.ada_w + (size_t)l * 1024 * 6144 + jb * 64 + cq * 4;
        f32x4 acc[8];
#pragma unroll
        for (int b = 0; b < 8; ++b) acc[b] = (f32x4){0.f, 0.f, 0.f, 0.f};
        for (int ii = 0; ii < 64; ++ii) {
            const int i = ksl * 64 + ii;
            const f32x4 wv = *(const f32x4*)(w + (size_t)i * 6144);
#pragma unroll
            for (int b = 0; b < 8; ++b) acc[b] += wv * sc[b * 1024 + i];
        }
#pragma unroll
        for (int b = 0; b < 8; ++b) *(f32x4*)(red + (ksl * 8 + b) * 64 + cq * 4) = acc[b];
        __syncthreads();
        for (int o = tid; o < 512; o += 256) {
            const int b = o >> 6, cc = o & 63; float s = 0.f;
            for (int k = 0; k < 16; ++k) s += red[(k * 8 + b) * 64 + cc];
            ((float*)(p.ws + WS_MOD))[((size_t)l * 8 + b) * 6144 + jb * 64 + cc] = s + p.ada_b[l * 6144 + jb * 64 + cc];
        }
    }
    for (int item = bid; item < NROPE + 1; item += nb) {
        if (item < NROPE) {
            const int idx = item * 256 + tid;
            const int pos = idx >> 5, i = idx & 31;
            const float inv = 1.0f / powf(10000.0f, (float)(2 * i) / 64.0f);
            const float ang = (float)pos * inv;
            ((float*)(p.ws + WS_ROPEC))[idx] = cosf(ang);
            ((float*)(p.ws + WS_ROPES))[idx] = sinf(ang);
        } else {
            if (tid < DEPTH * 32) ((int*)(p.ws + WS_ECNT))[tid * ECS] = 0;
        }
    }
    __syncthreads();
    convert_moe_layers(p, 0, 1, smem, bid, nb, tid);
}

DI void phase_norm(const Params& p, int layer, const float* src, int bid, int nb, int tid) {
    const int lane = tid & 63, wid = tid >> 6;
    const float* mod = (const float*)(p.ws + WS_MOD) + (size_t)layer * 8 * 6144;
    const float* gam = p.norm_mix + layer * 1024;
    bf16_t* H = (bf16_t*)(p.ws + WS_H);
    for (int item = bid; item < T / 4; item += nb) {
        const int t = item * 4 + wid, b = t >> 11;
        const float* xr = src + (size_t)t * 1024;
        f32x4 v[4]; float ss = 0.f;
#pragma unroll
        for (int i = 0; i < 4; ++i) { v[i] = *(const f32x4*)(xr + (lane + 64 * i) * 4); ss += v[i][0] * v[i][0] + v[i][1] * v[i][1] + v[i][2] * v[i][2] + v[i][3] * v[i][3]; }
        ss = wave_sum(ss);
        const float rstd = rsqrtf(ss * (1.f / 1024.f) + EPS);
#pragma unroll
        for (int i = 0; i < 4; ++i) {
            const int c0 = (lane + 64 * i) * 4;
            const f32x4 g = *(const f32x4*)(gam + c0), sh = *(const f32x4*)(mod + b * 6144 + c0), sc = *(const f32x4*)(mod + b * 6144 + 1024 + c0);
            f32x4 h = v[i] * rstd * g * (sc + 1.f) + sh;
            u32x2 o = {pk2(h[0], h[1]), pk2(h[2], h[3])};
            *(u32x2*)(H + (size_t)t * 1024 + c0) = o;
        }
    }
}

DI void phase_ffn_norm_router(const Params& p, int layer, unsigned char* smem, int bid, int nb, int tid) {
    float* rstd_s = (float*)smem;
    float* lg = (float*)(smem + 512);
    float* hs = (float*)(smem + 512 + 32 * 37 * 4);
    float* wcs = (float*)(smem + 5248 + 2 * 32 * 65 * 4);
    float* part = (float*)(smem + 42368);
    float* gpart = (float*)(smem + 59264);
    const int lane = tid & 63, og = __builtin_amdgcn_readfirstlane(tid >> 6), tok = lane & 31, kh = lane >> 5;
    const float* mod = (const float*)(p.ws + WS_MOD) + (size_t)layer * 8 * 6144;
    const float* gam = p.norm_ffn + layer * 1024;
    const float* wg = p.moe_w_group + (size_t)layer * 1024 * 4;
    const float* we = p.moe_w_expert + (size_t)layer * 1024 * 32;
    bf16_t* H = (bf16_t*)(p.ws + WS_H);
    int* ecnt = (int*)(p.ws + WS_ECNT) + layer * 32 * ECS;
    int* elist = (int*)(p.ws + WS_ELIST);
    float* ew = (float*)(p.ws + WS_EW);
    for (int item = bid; item < T / 32; item += nb) {
        const int t0 = item * 32, b = t0 >> 11;
        __syncthreads();
        if (tid < 32) {
            const f32x4* pp = (const f32x4*)((const float*)(p.ws + WS_PART) + (size_t)(t0 + tid) * 16);
            const f32x4 a = pp[0], b4 = pp[1], c4 = pp[2], d4 = pp[3];
            const float ss = ((a[0] + a[1]) + (a[2] + a[3])) + ((b4[0] + b4[1]) + (b4[2] + b4[3])) + ((c4[0] + c4[1]) + (c4[2] + c4[3])) + ((d4[0] + d4[1]) + (d4[2] + d4[3]));
            rstd_s[tid] = rsqrtf(ss * (1.f / 1024.f) + EPS);
        }
        const int stok = tid >> 3, sk0 = (tid & 7) * 8;
        const float* xrow = p.out + (size_t)(t0 + stok) * 1024 + sk0;
        const float* mrow = mod + b * 6144 + sk0;
        f32x4 xa[2], ga[2], sha[2], sca[2], wa[3], xb[2], gb2[2], shb[2], scb[2], wb2[3];
#define FFN_LOAD(xv, gv, shv, scv, wv, k0) do { _Pragma("unroll") for (int q = 0; q < 2; ++q) { xv[q] = *(const f32x4*)(xrow + (k0) + 4 * q); gv[q] = *(const f32x4*)(gam + sk0 + (k0) + 4 * q); \
            shv[q] = *(const f32x4*)(mrow + 3072 + (k0) + 4 * q); scv[q] = *(const f32x4*)(mrow + 4096 + (k0) + 4 * q); } \
            wv[0] = *(const f32x4*)(we + (k0) * 32 + tid * 4); wv[1] = *(const f32x4*)(we + (k0) * 32 + 1024 + tid * 4); wv[2] = *(const f32x4*)(wg + (k0) * 4 + (tid & 63) * 4); } while (0)
#define FFN_STEP(xv, gv, shv, scv, wv, kc) do { const int k0 = (kc) * 64; float* hb = hs + ((kc) & 1) * (32 * 65); float* wb = wcs + ((kc) & 1) * (64 * 40); u32x4 ho; \
            _Pragma("unroll") for (int q = 0; q < 2; ++q) { const f32x4 h = xv[q] * srstd * gv[q] * (scv[q] + 1.f) + shv[q]; ho[2 * q] = pk2(h[0], h[1]); ho[2 * q + 1] = pk2(h[2], h[3]); \
                float* hp = hb + stok * 65 + sk0 + 4 * q; hp[0] = h[0]; hp[1] = h[1]; hp[2] = h[2]; hp[3] = h[3]; } \
            *(u32x4*)(H + (size_t)(t0 + stok) * 1024 + k0 + sk0) = ho; \
            *(f32x4*)(wb + (tid >> 3) * 40 + 4 + (tid & 7) * 4) = wv[0]; *(f32x4*)(wb + (32 + (tid >> 3)) * 40 + 4 + (tid & 7) * 4) = wv[1]; if (tid < 64) *(f32x4*)(wb + tid * 40) = wv[2]; \
            if ((kc) + 2 < 16) FFN_LOAD(xv, gv, shv, scv, wv, k0 + 128); \
            __syncthreads(); \
            { const float* ha = hb + tok * 65 + og * 16 + kh; const float* wbp = wb + (og * 16 + kh) * 40 + 4 + tok; float av[8], bv[8]; \
              _Pragma("unroll") for (int m = 0; m < 8; ++m) { av[m] = ha[2 * m]; bv[m] = wbp[2 * m * 40]; } \
              const float* hg = hb + tok * 65 + og * 16 + kh * 8; const float* wgp = wb + (og * 16 + kh * 8) * 40; \
              _Pragma("unroll") for (int i = 0; i < 8; ++i) { const float hv = hg[i]; gacc += *(const f32x4*)(wgp + i * 40) * hv; } \
              _Pragma("unroll") for (int m = 0; m < 8; ++m) eacc = __builtin_amdgcn_mfma_f32_32x32x2f32(av[m], bv[m], eacc, 0, 0, 0); } } while (0)
        FFN_LOAD(xa, ga, sha, sca, wa, 0);
        FFN_LOAD(xb, gb2, shb, scb, wb2, 64);
        __syncthreads();
        const float srstd = rstd_s[stok];
        f32x16 eacc; f32x4 gacc = {0.f, 0.f, 0.f, 0.f};
#pragma unroll
        for (int r = 0; r < 16; ++r) eacc[r] = 0.f;
        for (int kc = 0; kc < 16; kc += 2) {
            FFN_STEP(xa, ga, sha, sca, wa, kc);
            FFN_STEP(xb, gb2, shb, scb, wb2, kc + 1);
        }
#undef FFN_STEP
#undef FFN_LOAD
#pragma unroll
        for (int r = 0; r < 16; ++r) part[(og * 32 + crow(r, lane)) * 33 + tok] = eacc[r];
#pragma unroll
        for (int e = 0; e < 4; ++e) { const float v = gacc[e] + sx_f<32>(gacc[e]); if (kh == 0) gpart[(og * 32 + tok) * 4 + e] = v; }
        __syncthreads();
        { const int tk = tid >> 3, c4 = (tid & 7) * 4;
#pragma unroll
          for (int e = 0; e < 4; ++e) lg[tk * 37 + 4 + c4 + e] = (part[tk * 33 + c4 + e] + part[(32 + tk) * 33 + c4 + e]) + (part[(64 + tk) * 33 + c4 + e] + part[(96 + tk) * 33 + c4 + e]);
          if (tid < 128) lg[(tid >> 2) * 37 + (tid & 3)] = (gpart[tid] + gpart[128 + tid]) + (gpart[256 + tid] + gpart[384 + tid]); }
        __syncthreads();
        if (tid < 32) {
            const int t = t0 + tid;
            float gl[4]; float gmax = -INFINITY; int gsel = 0;
#pragma unroll
            for (int g = 0; g < 4; ++g) { gl[g] = lg[tid * 37 + g] + p.moe_b_group[layer * 4 + g]; if (gl[g] > gmax) { gmax = gl[g]; gsel = g; } }
            float gsum = 0.f;
#pragma unroll
            for (int g = 0; g < 4; ++g) gsum += __expf(gl[g] - gmax);
            const float pg = 1.f / gsum;
            float v1 = -INFINITY, v2 = -INFINITY; int i1 = 0, i2 = 0;
            for (int jx = 0; jx < 8; ++jx) {
                const float v = lg[tid * 37 + 4 + gsel * 8 + jx] + p.moe_b_expert[layer * 32 + gsel * 8 + jx];
                if (v > v1) { v2 = v1; i2 = i1; v1 = v; i1 = jx; } else if (v > v2) { v2 = v; i2 = jx; }
            }
            const float e2 = __expf(v2 - v1), den = 1.f / (1.f + e2);
            const float w1 = pg * den, w2 = pg * e2 * den;
            const int ea = gsel * 8 + i1, eb = gsel * 8 + i2;
            int* cl = (int*)rstd_s + 32;
            cl[tid] = 0;
            const int la = atomicAdd(&cl[ea], 1);
            const int lb = atomicAdd(&cl[eb], 1);
            { const int n = cl[tid]; cl[32 + tid] = n > 0 ? atomicAdd(&ecnt[tid * ECS], n) : 0; }
            const int ra = cl[32 + ea] + la, rb = cl[32 + eb] + lb;
            elist[(size_t)ea * NASG + ra] = t * 2; ew[t * 2] = w1;
            elist[(size_t)eb * NASG + rb] = t * 2 + 1; ew[t * 2 + 1] = w2;
        }
    }
}

DI bool dense_item(int i, int NT, int xcd, int& tm, int& tn) {
    if (i >= 16 * NT) return false;
    const int mg = i / (8 * NT), r = i % (8 * NT);
    tn = r >> 3; tm = xcd * 16 + mg * 8 + (r & 7);
    return true;
}
template <class PR> DI void phase_hyb_in(const Params& p, int j, unsigned char* smem, int xcd, int lb, int nlb, int tid) {
    int tm, tn;
    for (int i = lb; dense_item(i, 22, xcd, tm, tn); i += nlb) { HybIn pr{&p, j, tm, tn}; gemm_tile(pr, smem, opq(tid)); }
}
DI void phase_ml_in(const Params& p, int j, unsigned char* smem, int xcd, int lb, int nlb, int tid) {
    int tm, tn;
    for (int i = lb; dense_item(i, 25, xcd, tm, tn); i += nlb) { MlIn pr{&p, j, tm, tn}; gemm_tile(pr, smem, opq(tid)); }
}
DI void phase_out_proj(const Params& p, int layer, const float* W, const float* src, unsigned char* smem, int xcd, int lb, int nlb, int tid) {
    int tm, tn;
    for (int i = lb; dense_item(i, 8, xcd, tm, tn); i += nlb) { OutProj pr{&p, W, src, layer, tm, tn}; gemm_tile(pr, smem, opq(tid)); }
}
template <int WHICH> DI void phase_moe(const Params& p, int layer, unsigned char* smem, int xcd, int lb, int nlb, int tid) {
    int* toff = (int*)(smem + 65600);
    __syncthreads();
    if (tid == 0) {
        const int* ecnt = (const int*)(p.ws + WS_ECNT) + layer * 32 * ECS;
        int ta = 0, ra = 0;
        for (int e = 0; e < 32; ++e) {
            const int c = ecnt[e * ECS];
            if ((e & 7) == xcd) { const int q = e >> 3; toff[q] = ta; toff[8 + q] = ra; toff[16 + q] = c; ta += (c + 127) >> 7; }
            ra += c;
        }
        toff[4] = ta;
    }
    __syncthreads();
    const int total = toff[4] * 8;
    for (int item = lb; item < total; item += nlb) {
        const int mg = item >> 3, nt = item & 7;
        int q = 0;
        while (q < 3 && toff[q + 1] <= mg) ++q;
        const int e = q * 8 + xcd, cnt = toff[16 + q], roff = toff[8 + q];
        if (WHICH == 1) { Moe1 pr{&p, layer, e, mg - toff[q], nt, cnt, roff}; gemm_tile(pr, smem, opq(tid)); }
        else { Moe2 pr{&p, layer, e, mg - toff[q], nt, cnt, roff}; gemm_tile(pr, smem, opq(tid)); }
    }
}

DI void phase_combine_norm(const Params& p, int layer, int bid, int nb, int tid) {
    const int lane = tid & 63, wid = tid >> 6;
    const float* mod = (const float*)(p.ws + WS_MOD) + (size_t)layer * 8 * 6144;
    const float* modn = mod + 8 * 6144;
    const float* gam = p.norm_mix + (layer + 1) * 1024;
    const bf16_t* Y = (const bf16_t*)(p.ws + WS_Y);
    const float* ew = (const float*)(p.ws + WS_EW);
    bf16_t* H = (bf16_t*)(p.ws + WS_H);
    const bool has_next = layer + 1 < DEPTH;
    for (int item = bid; item < T / 4; item += nb) {
        const int t = item * 4 + wid, b = t >> 11;
        const float w0 = ew[2 * t], w1 = ew[2 * t + 1];
        f32x4 v[4]; float ss = 0.f;
#pragma unroll
        for (int i = 0; i < 4; ++i) {
            const int c0 = (lane + 64 * i) * 4;
            v[i] = *(const f32x4*)(p.out + (size_t)t * 1024 + c0);
            const f32x4 g = *(const f32x4*)(mod + b * 6144 + 5120 + c0);
            const u32x2 y0 = *(const u32x2*)(Y + (size_t)(2 * t) * 1024 + c0), y1 = *(const u32x2*)(Y + (size_t)(2 * t + 1) * 1024 + c0);
            v[i][0] += g[0] * (w0 * bflo(y0[0]) + w1 * bflo(y1[0])); v[i][1] += g[1] * (w0 * bfhi(y0[0]) + w1 * bfhi(y1[0]));
            v[i][2] += g[2] * (w0 * bflo(y0[1]) + w1 * bflo(y1[1])); v[i][3] += g[3] * (w0 * bfhi(y0[1]) + w1 * bfhi(y1[1]));
            *(f32x4*)(p.out + (size_t)t * 1024 + c0) = v[i];
            ss += v[i][0] * v[i][0] + v[i][1] * v[i][1] + v[i][2] * v[i][2] + v[i][3] * v[i][3];
        }
        if (has_next) {
            ss = wave_sum(ss);
            const float rstd = rsqrtf(ss * (1.f / 1024.f) + EPS);
#pragma unroll
            for (int i = 0; i < 4; ++i) {
                const int c0 = (lane + 64 * i) * 4;
                const f32x4 g = *(const f32x4*)(gam + c0), sh = *(const f32x4*)(modn + b * 6144 + c0), sc = *(const f32x4*)(modn + b * 6144 + 1024 + c0);
                const f32x4 h = v[i] * rstd * g * (sc + 1.f) + sh;
                u32x2 o = {pk2(h[0], h[1]), pk2(h[2], h[3])};
                *(u32x2*)(H + (size_t)t * 1024 + c0) = o;
            }
        }
    }
}

DI unsigned sortable(float f) { const unsigned u = __float_as_uint(f); return (u & 0x80000000u) ? ~u : (u | 0x80000000u); }
DI int half_sum_i(int v) { v += sx_i<16>(v); v += sx_i<8>(v); v += sx_i<4>(v); v += sx_i<2>(v); v += sx_i<1>(v); return v; }

struct CvTask { const float* src; bf16_t* dst; int ldb, kdim; };
DI CvTask cv_task(const Params& p, int l0, int id) {
    const int PER = 32 * 8 * 16 * 4 + 32 * 8 * 8 * 4;
    const int l = l0 + id / PER; int ci = id % PER; CvTask t;
    if (ci < 16384) {
        const int g = ci & 3, kt = (ci >> 2) & 15, nt = (ci >> 6) & 7, e = ci >> 9; int w;
        Moe1 pr{&p, l, e, 0, nt, 0, 0};
        t.ldb = DEXP; t.kdim = 1024; t.src = pr.b_col(g, w) + (size_t)(kt * 64) * DEXP;
        t.dst = (bf16_t*)(p.ws + WS_WM1) + ((size_t)((l * 32 + e) * 8 + nt) * 128 + g * 32) * 1024 + kt * 64;
    } else {
        ci -= 16384;
        const int g = ci & 3, kt = (ci >> 2) & 7, nt = (ci >> 5) & 7, e = ci >> 8; int w;
        Moe2 pr{&p, l, e, 0, nt, 0, 0};
        t.ldb = D; t.kdim = 512; t.src = pr.b_col(g, w) + (size_t)(kt * 64) * D;
        t.dst = (bf16_t*)(p.ws + WS_WM2) + ((size_t)((l * 32 + e) * 8 + nt) * 128 + g * 32) * 512 + kt * 64;
    }
    return t;
}
DI void cv_issue(const CvTask& t, int lane, f32x4 (&rb)[8]) {
    const float* s = t.src + (size_t)((lane >> 3) * 8) * t.ldb + (lane & 7) * 4;
#pragma unroll
    for (int kk = 0; kk < 8; ++kk) rb[kk] = *(const f32x4*)(s + (size_t)kk * t.ldb);
}
DI void cv_finish(const CvTask& t, int lane, const f32x4 (&rb)[8]) {
    bf16_t* d = t.dst + (size_t)((lane & 7) * 4) * t.kdim + (lane >> 3) * 8;
#pragma unroll
    for (int jx = 0; jx < 4; ++jx) {
        u32x4 v = {pk2(rb[0][jx], rb[1][jx]), pk2(rb[2][jx], rb[3][jx]), pk2(rb[4][jx], rb[5][jx]), pk2(rb[6][jx], rb[7][jx])};
        *(u32x4*)(d + (size_t)jx * t.kdim) = v;
    }
}
DI void convert_moe_waves(const Params& p, int l0, int l1, int gwave, int nwaves, int lane) {
    const int total = (l1 - l0) * 24576;
    for (int id = gwave; id < total; id += 2 * nwaves) {
        f32x4 ra[8], rb[8];
        const CvTask t0 = cv_task(p, l0, id);
        cv_issue(t0, lane, ra);
        const bool two = id + nwaves < total;
        if (two) { const CvTask t1 = cv_task(p, l0, id + nwaves); cv_issue(t1, lane, rb); cv_finish(t0, lane, ra); cv_finish(t1, lane, rb); }
        else cv_finish(t0, lane, ra);
    }
}

DI void phase_dsa(const Params& p, int j, unsigned char* smem, int bid, int nb, int tid, int cv0 = 0, int cv1 = 0) {
    if (cv1 > cv0 && (bid & 1)) convert_moe_waves(p, cv0, cv1, bid * 4 + (tid >> 6), nb * 4, tid & 63);
    const int lane = tid & 63, wid = tid >> 6, c = lane & 31, hh = lane >> 5;
    unsigned* mw = (unsigned*)smem + wid * 256;
    const bf16_t* IQ = (const bf16_t*)(p.ws + WS_IQ);
    const bf16_t* IK = (const bf16_t*)(p.ws + WS_IK);
    const float* IW = (const float*)(p.ws + WS_IW);
    const bf16_t* Q = (const bf16_t*)(p.ws + WS_Q);
    const bf16_t* K = (const bf16_t*)(p.ws + WS_K);
    const bf16_t* VT = (const bf16_t*)(p.ws + WS_V);
    bf16_t* Y = (bf16_t*)(p.ws + WS_YMIX);
    const float gq = wave_max(fabsf(p.hy_q_norm[j * 64 + lane])), gk = wave_max(fabsf(p.hy_k_norm[j * 64 + lane]));
    const float LOG2E = 1.4426950408889634f;
    const float c1 = 0.125f * LOG2E, c2 = 8.f * gq * gk * LOG2E;
    const unsigned lt = (1u << c) - 1u;
    for (int it = bid, rnd = 0; it < 1024; it += nb, ++rnd) {
        const int item = (rnd & 1) ? (rnd + 1) * nb - 1 - bid : it;
        if (item >= 1024) continue;
        const int qt = 127 - (item >> 3), b = item & 7;
        const int pos0 = qt * 16 + 4 * wid;
        const size_t tb = (size_t)b * S, t0 = tb + pos0;
        const int tmax = (pos0 + 3) >> 5;
        if (pos0 >= 256) {
            bf16x8 iqf[4];
            {
                const int i = (c & 3) + 4 * (c >> 3), rh = (c >> 2) & 1, qq = 2 * rh + (i >> 3), hd = i & 7;
                const bf16_t* ip = IQ + (t0 + qq) * 512 + hd * 64 + 8 * hh;
#pragma unroll
                for (int ks = 0; ks < 4; ++ks) iqf[ks] = *(const bf16x8*)(ip + 16 * ks);
            }
            float* wl = (float*)(smem + 4096) + wid * 32 + hh * 16;
            if (c < 4) *(f32x4*)(wl + 4 * c) = *(const f32x4*)(IW + (t0 + 2 * hh) * 8 + 4 * c);
            unsigned sk[64][2];
            const bf16_t* kpi = IK + ((tb >> 5) * 256 + hh * 32 + c) * 8;
            const int lim0 = pos0 + 2 * hh - c;
#pragma unroll
            for (int tile = 0; tile < 64; ++tile) {
                unsigned k0 = 0u, k1 = 0u;
                if (tile <= tmax) {
                    bf16x8 bk[4];
#pragma unroll
                    for (int ks = 0; ks < 4; ++ks) bk[ks] = *(const bf16x8*)(kpi + 512 * ks);
                    kpi += 32 * 64;
                    asm volatile("" : "+v"(kpi));
                    f32x16 acc;
#pragma unroll
                    for (int r = 0; r < 16; ++r) acc[r] = 0.f;
#pragma unroll
                    for (int ks = 0; ks < 4; ++ks) acc = __builtin_amdgcn_mfma_f32_32x32x16_bf16(iqf[ks], bk[ks], acc, 0, 0, 0);
                    float s0 = 0.f, s1 = 0.f;
#pragma unroll
                    for (int q4 = 0; q4 < 2; ++q4) {
                        const f32x4 wa = *(const f32x4*)(wl + 4 * q4), wb = *(const f32x4*)(wl + 8 + 4 * q4);
#pragma unroll
                        for (int e = 0; e < 4; ++e) { s0 += fmaxf(acc[4 * q4 + e], 0.f) * wa[e]; s1 += fmaxf(acc[8 + 4 * q4 + e], 0.f) * wb[e]; }
                    }
                    k0 = tile * 32 <= lim0 ? sortable(s0) : 0u;
                    k1 = tile * 32 <= lim0 + 1 ? sortable(s1) : 0u;
                }
                sk[tile][0] = k0; sk[tile][1] = k1;
            }
            unsigned v0 = 0u, v1 = 0u; bool d0 = false, d1 = false;
            const int tg = tmax >> 3;
            for (int bit = 31; bit >= 0; --bit) {
                const unsigned c0 = v0 | (1u << bit), c1b = v1 | (1u << bit);
                int n0 = 0, n1 = 0;
#pragma unroll
                for (int g = 0; g < 8; ++g) {
                    if (g <= tg) {
#pragma unroll
                        for (int u = 0; u < 8; ++u) { n0 += sk[g * 8 + u][0] >= c0 ? 1 : 0; n1 += sk[g * 8 + u][1] >= c1b ? 1 : 0; }
                    }
                }
                const int n01 = half_sum_i(n0 | (n1 << 16));
                n0 = n01 & 0xffff; n1 = n01 >> 16;
                if (!d0 && n0 >= 256) { v0 = c0; d0 = n0 == 256; }
                if (!d1 && n1 >= 256) { v1 = c1b; d1 = n1 == 256; }
                if (__all(d0 && d1)) break;
            }
            int g0 = 0, g1 = 0;
#pragma unroll
            for (int g = 0; g < 8; ++g) {
                if (g <= tg) {
#pragma unroll
                    for (int u = 0; u < 8; ++u) { g0 += sk[g * 8 + u][0] > v0 ? 1 : 0; g1 += sk[g * 8 + u][1] > v1 ? 1 : 0; }
                }
            }
            const int g01 = half_sum_i(g0 | (g1 << 16));
            const int need0 = 256 - (g01 & 0xffff), need1 = 256 - (g01 >> 16);
            int run0 = 0, run1 = 0;
#pragma unroll
            for (int tile = 0; tile < 64; ++tile) {
                if (tile <= tmax) {
                    const unsigned k0 = sk[tile][0], k1 = sk[tile][1];
                    const bool tie0 = k0 == v0, tie1 = k1 == v1;
                    const unsigned long long tb0 = __ballot(tie0), tb1 = __ballot(tie1);
                    const unsigned th0 = hh ? (unsigned)(tb0 >> 32) : (unsigned)tb0, th1 = hh ? (unsigned)(tb1 >> 32) : (unsigned)tb1;
                    const bool sel0 = k0 > v0 || (tie0 && run0 + __popc(th0 & lt) < need0);
                    const bool sel1 = k1 > v1 || (tie1 && run1 + __popc(th1 & lt) < need1);
                    run0 += __popc(th0); run1 += __popc(th1);
                    const unsigned long long sb0 = __ballot(sel0), sb1 = __ballot(sel1);
                    if (lane == 0) { u32x4 o = {(unsigned)sb0, (unsigned)sb1, (unsigned)(sb0 >> 32), (unsigned)(sb1 >> 32)}; *(u32x4*)(mw + tile * 4) = o; }
                }
            }
        } else {
            const int tile = lane >> 2, qq = lane & 3, pq = pos0 + qq;
            if (tile <= tmax) {
                unsigned m;
                if (32 * tile + 31 <= pq) m = 0xffffffffu; else if (32 * tile > pq) m = 0u; else m = (2u << (pq - 32 * tile)) - 1u;
                mw[tile * 4 + qq] = m;
            }
        }
        bf16x8 qf[4];
        {
            const bf16_t* qp = Q + (t0 + (c >> 3)) * 512 + (c & 7) * 64 + 8 * hh;
#pragma unroll
            for (int ks = 0; ks < 4; ++ks) qf[ks] = *(const bf16x8*)(qp + 16 * ks);
        }
        f32x16 o0, o1;
#pragma unroll
        for (int r = 0; r < 16; ++r) { o0[r] = 0.f; o1[r] = 0.f; }
        float lsum = 0.f;
        const bf16_t* kp = K + ((tb >> 5) * 256 + hh * 32 + c) * 8;
        const bf16_t* vp = VT + ((tb >> 5) * 256 + hh * 32 + c) * 8;
        bf16x8 kf[4], vf[4];
#pragma unroll
        for (int ks = 0; ks < 4; ++ks) { kf[ks] = *(const bf16x8*)(kp + 512 * ks); vf[ks] = *(const bf16x8*)(vp + 512 * ks); }
        for (int tile = 0; tile <= tmax; ++tile) {
            const unsigned mword = mw[tile * 4 + (c >> 3)];
            bf16x8 kc[4], vc[4];
#pragma unroll
            for (int ks = 0; ks < 4; ++ks) { kc[ks] = kf[ks]; vc[ks] = vf[ks]; }
            if (tile < tmax) {
                kp += 2048; vp += 2048;
#pragma unroll
                for (int ks = 0; ks < 4; ++ks) { kf[ks] = *(const bf16x8*)(kp + 512 * ks); vf[ks] = *(const bf16x8*)(vp + 512 * ks); }
            }
            f32x16 x;
#pragma unroll
            for (int r = 0; r < 16; ++r) x[r] = 0.f;
#pragma unroll
            for (int ks = 0; ks < 4; ++ks) x = __builtin_amdgcn_mfma_f32_32x32x16_bf16(kc[ks], qf[ks], x, 0, 0, 0);
#pragma unroll
            for (int s = 0; s < 2; ++s) {
                const unsigned bits = mword >> (16 * s + 8 * hh);
                float pr[8];
#pragma unroll
                for (int jx = 0; jx < 8; ++jx) {
                    const float e = __builtin_amdgcn_exp2f(x[8 * s + jx] * c1 - c2);
                    pr[jx] = __uint_as_float(__float_as_uint(e) & (unsigned)__builtin_amdgcn_sbfe((int)bits, jx, 1));
                    lsum += pr[jx];
                }
                u32x4 pk = {pk2(pr[0], pr[1]), pk2(pr[2], pr[3]), pk2(pr[4], pr[5]), pk2(pr[6], pr[7])};
                const bf16x8 pf = __builtin_bit_cast(bf16x8, pk);
                o0 = __builtin_amdgcn_mfma_f32_32x32x16_bf16(vc[2 * s], pf, o0, 0, 0, 0);
                o1 = __builtin_amdgcn_mfma_f32_32x32x16_bf16(vc[2 * s + 1], pf, o1, 0, 0, 0);
            }
        }
        lsum += sx_f<32>(lsum);
        const float inv = 1.f / lsum;
        bf16_t* yp = Y + (t0 + (c >> 3)) * 1024 + (c & 7) * 64 + 4 * hh;
#pragma unroll
        for (int g4 = 0; g4 < 4; ++g4) {
            u32x2 a = {pk2(o0[4 * g4] * inv, o0[4 * g4 + 1] * inv), pk2(o0[4 * g4 + 2] * inv, o0[4 * g4 + 3] * inv)};
            u32x2 bq = {pk2(o1[4 * g4] * inv, o1[4 * g4 + 1] * inv), pk2(o1[4 * g4 + 2] * inv, o1[4 * g4 + 3] * inv)};
            *(u32x2*)(yp + 8 * g4) = a;
            *(u32x2*)(yp + 32 + 8 * g4) = bq;
        }
    }
    if (cv1 > cv0 && !(bid & 1)) convert_moe_waves(p, cv0, cv1, bid * 4 + (tid >> 6), nb * 4, tid & 63);
}

DI void phase_conv(const Params& p, int j, int bid, int nb, int tid) {
    const bf16_t* Z = (const bf16_t*)(p.ws + WS_Z);
    const bf16_t* BG = (const bf16_t*)(p.ws + WS_BG);
    bf16_t* Y = (bf16_t*)(p.ws + WS_YMIX);
    const float* cw = p.hy_conv_w + (size_t)j * 3 * 512;
    for (int item = bid; item < T / 4; item += nb) {
        const int t = item * 4 + (tid >> 6), c0 = (tid & 63) * 8, pos = t & (S - 1);
        float acc[8];
#pragma unroll
        for (int e = 0; e < 8; ++e) acc[e] = 0.f;
#pragma unroll
        for (int jj = 0; jj < 3; ++jj) {
            const int dp = jj - 2;
            if (pos + dp >= 0) {
                const u32x4 z = *(const u32x4*)(Z + (size_t)(t + dp) * 512 + c0);
#pragma unroll
                for (int e = 0; e < 4; ++e) { acc[2 * e] += cw[jj * 512 + c0 + 2 * e] * bflo(z[e]); acc[2 * e + 1] += cw[jj * 512 + c0 + 2 * e + 1] * bfhi(z[e]); }
            }
        }
        const u32x4 g = *(const u32x4*)(BG + (size_t)t * 512 + c0);
        u32x4 o;
#pragma unroll
        for (int e = 0; e < 4; ++e) o[e] = pk2(acc[2 * e] * bflo(g[e]), acc[2 * e + 1] * bfhi(g[e]));
        *(u32x4*)(Y + (size_t)t * 1024 + 512 + c0) = o;
    }
}

DI float wave_incl_sum(float x, int lane) { for (int d = 1; d < 64; d <<= 1) { const float t = lane_get_f(x, lane >= d ? lane - d : lane); if (lane >= d) x += t; } return x; }
DI float wave_incl_max(float x, int lane) { for (int d = 1; d < 64; d <<= 1) { const float t = lane_get_f(x, lane >= d ? lane - d : lane); if (lane >= d) x = fmaxf(x, t); } return x; }
DI bf16x8 scale_frag(bf16x8 f, const float* w8) {
    const u32x4 u = __builtin_bit_cast(u32x4, f);
    u32x4 o;
#pragma unroll
    for (int e = 0; e < 4; ++e) o[e] = pk2(bflo(u[e]) * w8[2 * e], bfhi(u[e]) * w8[2 * e + 1]);
    return __builtin_bit_cast(bf16x8, o);
}

DI void phase_ml1(const Params& p, unsigned char* smem, int bid, int nb, int tid) {
    const int lane = tid & 63, wid = tid >> 6, c = lane & 31, hh = lane >> 5;
    float* wsl = (float*)smem + wid * 64;
    const bf16_t* KT = (const bf16_t*)(p.ws + WS_MKT);
    const bf16_t* VT = (const bf16_t*)(p.ws + WS_MV);
    const float* MIG = (const float*)(p.ws + WS_MIG);
    const float* MFG = (const float*)(p.ws + WS_MFG);
    float* UB = (float*)(p.ws + WS_UBUF);
    float* UN = (float*)(p.ws + WS_UNBUF);
    float* ML = (float*)(p.ws + WS_MLOC);
    for (int item = bid; item < 2048; item += nb) {
        const int bh = item >> 5, ch = item & 31, b = bh >> 3, h = bh & 7;
        const size_t tb = (size_t)b * S + ch * 64;
        const float lf = MFG[(tb + lane) * 8 + h], ig = MIG[(tb + lane) * 8 + h];
        const float bc = wave_incl_sum(lf, lane);
        const float blast = lane_get_f(bc, 63);
        const float g = blast - bc + ig;
        const float gmax = wave_max(g);
        wsl[lane] = __expf(g - gmax);
        if (wid == 0 && lane == 0) { ML[item * 2] = blast; ML[item * 2 + 1] = gmax; }
        f32x16 u0, u1;
#pragma unroll
        for (int r = 0; r < 16; ++r) { u0[r] = 0.f; u1[r] = 0.f; }
        const bf16_t* vp = VT + ((size_t)(bh * 128 + wid * 32 + c)) * S + ch * 64 + 8 * hh;
        const bf16_t* kp = KT + ((size_t)(bh * 64 + c)) * S + ch * 64 + 8 * hh;
#pragma unroll
        for (int ks = 0; ks < 4; ++ks) {
            float w8[8];
            const f32x4 wa = *(const f32x4*)(wsl + 16 * ks + 8 * hh), wb = *(const f32x4*)(wsl + 16 * ks + 8 * hh + 4);
            w8[0] = wa[0]; w8[1] = wa[1]; w8[2] = wa[2]; w8[3] = wa[3]; w8[4] = wb[0]; w8[5] = wb[1]; w8[6] = wb[2]; w8[7] = wb[3];
            const bf16x8 va = *(const bf16x8*)(vp + 16 * ks);
            const bf16x8 k0 = scale_frag(*(const bf16x8*)(kp + 16 * ks), w8);
            const bf16x8 k1 = scale_frag(*(const bf16x8*)(kp + (size_t)32 * S + 16 * ks), w8);
            u0 = __builtin_amdgcn_mfma_f32_32x32x16_bf16(va, k0, u0, 0, 0, 0);
            u1 = __builtin_amdgcn_mfma_f32_32x32x16_bf16(va, k1, u1, 0, 0, 0);
        }
        float* up = UB + ((size_t)item * 128 + wid * 32) * 64 + c;
#pragma unroll
        for (int r = 0; r < 16; ++r) { const int v = crow(r, lane); up[v * 64] = u0[r]; up[v * 64 + 32] = u1[r]; }
        if (wid == 0) {
            const u32x4* kr = (const u32x4*)(KT + ((size_t)(bh * 64 + lane)) * S + ch * 64);
            float a = 0.f;
#pragma unroll
            for (int q = 0; q < 8; ++q) { const u32x4 u = kr[q];
#pragma unroll
                for (int e = 0; e < 4; ++e) a += wsl[q * 8 + 2 * e] * bflo(u[e]) + wsl[q * 8 + 2 * e + 1] * bfhi(u[e]); }
            UN[(size_t)item * 64 + lane] = a;
        }
    }
}

DI void phase_ml2(const Params& p, unsigned char* smem, int bid, int nb, int tid) {
    float* dec = (float*)smem;
    float* scl = dec + 32;
    const float* UB = (const float*)(p.ws + WS_UBUF);
    const float* UN = (const float*)(p.ws + WS_UNBUF);
    const float* ML = (const float*)(p.ws + WS_MLOC);
    bf16_t* CB = (bf16_t*)(p.ws + WS_CBUF);
    float* NBF = (float*)(p.ws + WS_NBUF);
    float* MST = (float*)(p.ws + WS_MST);
    for (int item = bid; item < 512; item += nb) {
        const int bh = item >> 3, sl = item & 7;
        __syncthreads();
        if (tid == 0) {
            float m = 0.f;
            for (int ch = 0; ch < 32; ++ch) {
                const float bl = ML[(bh * 32 + ch) * 2], gm = ML[(bh * 32 + ch) * 2 + 1];
                const float mn = fmaxf(bl + m, gm);
                dec[ch] = __expf(bl + m - mn); scl[ch] = __expf(gm - mn);
                if (sl == 0) MST[bh * 32 + ch] = m;
                m = mn;
            }
        }
        __syncthreads();
        f32x4 st = {0.f, 0.f, 0.f, 0.f};
        const size_t e0 = (size_t)sl * 1024 + tid * 4;
        f32x4 ub[32];
#pragma unroll
        for (int ch = 0; ch < 32; ++ch) ub[ch] = *(const f32x4*)(UB + ((size_t)(bh * 32 + ch)) * 8192 + e0);
#pragma unroll
        for (int ch = 0; ch < 32; ++ch) {
            st = st * dec[ch] + ub[ch] * scl[ch];
            u32x2 o = {pk2(st[0], st[1]), pk2(st[2], st[3])};
            *(u32x2*)(CB + ((size_t)(bh * 32 + ch)) * 8192 + e0) = o;
        }
        if (sl == 0 && tid < 64) {
            float nst = 0.f, un[32];
#pragma unroll
            for (int ch = 0; ch < 32; ++ch) un[ch] = UN[(size_t)(bh * 32 + ch) * 64 + tid];
#pragma unroll
            for (int ch = 0; ch < 32; ++ch) { nst = nst * dec[ch] + un[ch] * scl[ch]; NBF[(size_t)(bh * 32 + ch) * 64 + tid] = nst; }
        }
    }
}

DI void phase_ml3(const Params& p, int j, unsigned char* smem, int bid, int nb, int tid) {
    const int lane = tid & 63, wid = tid >> 6, c = lane & 31, hh = lane >> 5;
    float* al = (float*)smem + wid * 64;
    float* ssum = (float*)smem + 256;
    const bf16_t* MQ = (const bf16_t*)(p.ws + WS_MQ);
    const bf16_t* MK = (const bf16_t*)(p.ws + WS_MK);
    const bf16_t* VT = (const bf16_t*)(p.ws + WS_MV);
    const float* MIG = (const float*)(p.ws + WS_MIG);
    const float* MFG = (const float*)(p.ws + WS_MFG);
    const bf16_t* MOG = (const bf16_t*)(p.ws + WS_MOG);
    const bf16_t* CB = (const bf16_t*)(p.ws + WS_CBUF);
    const float* NBF = (const float*)(p.ws + WS_NBUF);
    const float* MST = (const float*)(p.ws + WS_MST);
    bf16_t* Y = (bf16_t*)(p.ws + WS_YMIX);
    const int kperm = (c & ~12) | ((c & 4) << 1) | ((c & 8) >> 1);
    for (int item = bid; item < 2048; item += nb) {
        const int bh = item >> 5, ch = item & 31, b = bh >> 3, h = bh & 7;
        const size_t tb = (size_t)b * S + ch * 64;
        const float lf = MFG[(tb + lane) * 8 + h], ig = MIG[(tb + lane) * 8 + h];
        const float bc = wave_incl_sum(lf, lane);
        const float av = ig - bc;
        const float mprev = MST[item];
        const float Mv = fmaxf(mprev, wave_incl_max(av, lane));
        __syncthreads();
        al[lane] = av;
        float Mt[2], wint[2], emt[2];
#pragma unroll
        for (int tt = 0; tt < 2; ++tt) { Mt[tt] = lane_get_f(Mv, 32 * tt + c); wint[tt] = __expf(mprev - Mt[tt]); emt[tt] = __expf(-(lane_get_f(bc, 32 * tt + c) + Mt[tt])); }
        bf16x8 qf[2][4], kf[2][4];
#pragma unroll
        for (int tt = 0; tt < 2; ++tt) {
            const bf16_t* qp = MQ + (tb + 32 * tt + c) * 512 + h * 64 + 8 * hh;
            const bf16_t* kp = MK + (tb + 32 * tt + kperm) * 512 + h * 64 + 8 * hh;
#pragma unroll
            for (int ks = 0; ks < 4; ++ks) { qf[tt][ks] = *(const bf16x8*)(qp + 16 * ks); kf[tt][ks] = *(const bf16x8*)(kp + 16 * ks); }
        }
        f32x16 o[2];
#pragma unroll
        for (int tt = 0; tt < 2; ++tt)
#pragma unroll
            for (int r = 0; r < 16; ++r) o[tt][r] = 0.f;
        float nq[2] = {0.f, 0.f};
        if (ch > 0) {
            const bf16_t* cp = CB + ((size_t)(item - 1) * 128 + wid * 32 + c) * 64 + 8 * hh;
            const float* np = NBF + (size_t)(item - 1) * 64 + 8 * hh;
#pragma unroll
            for (int ks = 0; ks < 4; ++ks) {
                const bf16x8 cf = *(const bf16x8*)(cp + 16 * ks);
                o[0] = __builtin_amdgcn_mfma_f32_32x32x16_bf16(cf, qf[0][ks], o[0], 0, 0, 0);
                o[1] = __builtin_amdgcn_mfma_f32_32x32x16_bf16(cf, qf[1][ks], o[1], 0, 0, 0);
                const f32x4 n0 = *(const f32x4*)(np + 16 * ks), n1 = *(const f32x4*)(np + 16 * ks + 4);
#pragma unroll
                for (int tt = 0; tt < 2; ++tt) {
                    const u32x4 u = __builtin_bit_cast(u32x4, qf[tt][ks]);
                    nq[tt] += n0[0] * bflo(u[0]) + n0[1] * bfhi(u[0]) + n0[2] * bflo(u[1]) + n0[3] * bfhi(u[1]) + n1[0] * bflo(u[2]) + n1[1] * bfhi(u[2]) + n1[2] * bflo(u[3]) + n1[3] * bfhi(u[3]);
                }
            }
#pragma unroll
            for (int tt = 0; tt < 2; ++tt) {
                nq[tt] += sx_f<32>(nq[tt]);
#pragma unroll
                for (int r = 0; r < 16; ++r) o[tt][r] *= wint[tt];
            }
        }
        float csum[2] = {0.f, 0.f};
        const bf16_t* vp = VT + ((size_t)(bh * 128 + wid * 32 + c)) * S + ch * 64 + 8 * hh;
#pragma unroll
        for (int tt = 0; tt < 2; ++tt) {
#pragma unroll
            for (int st = 0; st <= tt; ++st) {
                f32x16 x;
#pragma unroll
                for (int r = 0; r < 16; ++r) x[r] = 0.f;
#pragma unroll
                for (int ks = 0; ks < 4; ++ks) x = __builtin_amdgcn_mfma_f32_32x32x16_bf16(kf[st][ks], qf[tt][ks], x, 0, 0, 0);
#pragma unroll
                for (int k2 = 0; k2 < 2; ++k2) {
                    const int s0 = 32 * st + 16 * k2 + 8 * hh;
                    const f32x4 a0 = *(const f32x4*)(al + s0), a1 = *(const f32x4*)(al + s0 + 4);
                    const float a8[8] = {a0[0], a0[1], a0[2], a0[3], a1[0], a1[1], a1[2], a1[3]};
                    float pr[8];
#pragma unroll
                    for (int jx = 0; jx < 8; ++jx) {
                        const float e = __expf(a8[jx] - Mt[tt]) * x[8 * k2 + jx];
                        pr[jx] = (st < tt || s0 + jx <= 32 * tt + c) ? e : 0.f;
                        csum[tt] += pr[jx];
                    }
                    u32x4 pk = {pk2(pr[0], pr[1]), pk2(pr[2], pr[3]), pk2(pr[4], pr[5]), pk2(pr[6], pr[7])};
                    const bf16x8 vf = *(const bf16x8*)(vp + 32 * st + 16 * k2);
                    o[tt] = __builtin_amdgcn_mfma_f32_32x32x16_bf16(vf, __builtin_bit_cast(bf16x8, pk), o[tt], 0, 0, 0);
                }
            }
        }
        float ss[2];
#pragma unroll
        for (int tt = 0; tt < 2; ++tt) {
            csum[tt] += sx_f<32>(csum[tt]);
            const float den = wint[tt] * nq[tt] + csum[tt];
            const float rd = 1.f / fmaxf(fabsf(den), emt[tt]);
            float s2 = 0.f;
#pragma unroll
            for (int r = 0; r < 16; ++r) { o[tt][r] *= rd; s2 += o[tt][r] * o[tt][r]; }
            s2 += sx_f<32>(s2);
            ss[tt] = s2;
            if (hh == 0) ssum[wid * 64 + 32 * tt + c] = s2;
        }
        __syncthreads();
#pragma unroll
        for (int tt = 0; tt < 2; ++tt) {
            const int tcol = 32 * tt + c;
            const float tot = ssum[tcol] + ssum[64 + tcol] + ssum[128 + tcol] + ssum[192 + tcol];
            const float rstd = rsqrtf(tot * (1.f / 128.f) + EPS);
            const size_t ro = (tb + tcol) * 1024 + h * 128 + wid * 32 + 4 * hh;
            const float* gp = p.ml_out_norm + j * 1024 + h * 128 + wid * 32 + 4 * hh;
#pragma unroll
            for (int g4 = 0; g4 < 4; ++g4) {
                const f32x4 gm = *(const f32x4*)(gp + 8 * g4);
                const u32x2 og = *(const u32x2*)(MOG + ro + 8 * g4);
                u32x2 ov = {pk2(o[tt][4 * g4] * rstd * gm[0] * bflo(og[0]), o[tt][4 * g4 + 1] * rstd * gm[1] * bfhi(og[0])),
                            pk2(o[tt][4 * g4 + 2] * rstd * gm[2] * bflo(og[1]), o[tt][4 * g4 + 3] * rstd * gm[3] * bfhi(og[1]))};
                *(u32x2*)(Y + ro + 8 * g4) = ov;
            }
        }
    }
}


namespace pg8 {
#define PG8_LAS __attribute__((address_space(3)))
typedef unsigned short bf16_t;
typedef short bf16x8 __attribute__((ext_vector_type(8)));
typedef float f32x4 __attribute__((ext_vector_type(4)));
typedef unsigned u32x4 __attribute__((ext_vector_type(4)));
constexpr int BM = 256, BK = 64, HALF = 128, HTB = HALF * BK * 2  , STAGE_BYTES = 8 * HTB, NXCD = 8, WGM = 8;

__host__ __device__ __forceinline__ int lds_byte(int r, int c) { const int st = (r >> 4) * 2 + (c >> 5), rr = r & 15, cc = c & 31, ob = rr * 64 + cc * 2; return st * 1024 + (ob ^ (((ob >> 9) & 1) << 5)); }
__host__ __device__ __forceinline__ void stage_rc(int b, int& R, int& C) { const int st = b / 1024, sb = b % 1024, swz = sb ^ (((sb >> 9) & 1) << 5); R = (st >> 1) * 16 + swz / 64; C = (st & 1) * 32 + (swz % 64) / 2; }
__host__ __device__ __forceinline__ int perm32(int rho) { const int n = rho >> 4, i = rho & 15; return 8 * (i >> 2) + 4 * n + (i & 3); }

struct Unit { int pm, pn; };
struct Gemm { const bf16_t* A; const bf16_t* Bt; int M, N, K; };

struct StaticOrder {
    int nM, nN, nwg, G, c;
    __host__ __device__ void init(int M, int N, int G_, int c_) { nM = M / BM; nN = N / BM; nwg = nM * nN; G = G_; c = c_; }
    __host__ __device__ bool next(int i, Unit& u) const {
        const long L = (long)i * G + c; if (L >= nwg) return false;
        int wgid = (int)L; { const int q = nwg / NXCD, r = nwg % NXCD, xcd = wgid % NXCD, off = wgid / NXCD; wgid = (xcd < r ? xcd * (q + 1) : r * (q + 1) + (xcd - r) * q) + off; }
        const int nig = WGM * nN, gid = wgid / nig, fm = gid * WGM, gsz = (nM - fm) < WGM ? (nM - fm) : WGM;
        u.pm = fm + ((wgid % nig) % gsz); u.pn = (wgid % nig) / gsz; return true;
    }
    static constexpr bool GATHER = false;
    __device__ __forceinline__ unsigned a_off(const Unit&, int) const { return 0u; }
    __device__ __forceinline__ int rows(const Unit&) const { return BM; }
    __device__ __forceinline__ void a_ready(const Unit&) const {}
    __device__ __forceinline__ void done(const Unit&) const {}
};


template <class Epi, class Sched, bool ALIGN_EPI = false, bool SP2 = false>
__device__ __forceinline__ void gemm_phase(PG8_LAS unsigned char* lds, const Gemm g, const Sched& S, const Epi& E, int tid512) {
    const int tid = opq(tid512), wid = __builtin_amdgcn_readfirstlane(tid >> 6), lane = tid & 63, wr = wid >> 2, wc = wid & 3, fr = lane & 15, fq = lane >> 4;
    const int K = g.K, nt = K / BK;
    unsigned voffA[2], voffB[2];
    int rowA[2];
#pragma unroll
    for (int i = 0; i < 2; ++i) { int R, C; stage_rc(tid * 16 + i * 8192, R, C); const int Rb = Epi::PERM ? ((R & ~31) + perm32(R & 31)) : R;
        voffA[i] = (unsigned)(R * K + C) * 2u; voffB[i] = (unsigned)(Rb * K + C) * 2u; rowA[i] = R; if (Sched::GATHER) voffA[i] = (unsigned)C * 2u; }
    const size_t kstep = (size_t)(BK * 2);
    const size_t hstep = (size_t)HALF * K * 2;
    const size_t tstep = 2 * hstep;
    const unsigned ldsw = (unsigned)wid * 1024u;
    const int aoff = lds_byte(wr * 64 + fr, fq * 8), boff = lds_byte(wc * 32 + fr, fq * 8);
#define PG8_SA(b, h) (((b) * 2 + (h)) * HTB)
#define PG8_SB(b, h) ((4 + (b) * 2 + (h)) * HTB)
#define PG8_STAGE(bufoff, gbase, voff) do { _Pragma("unroll") for (int _i = 0; _i < 2; ++_i) \
        __builtin_amdgcn_global_load_lds((const unsigned*)((const char*)(gbase) + (voff)[_i]), (PG8_LAS unsigned*)(lds + (bufoff) + ldsw + _i * 8192), 16, 0, 0); } while (0)
#define PG8_LDA(dst, b, h) do { _Pragma("unroll") for (int m = 0; m < 4; ++m) _Pragma("unroll") for (int k = 0; k < 2; ++k) dst[m][k] = *(const PG8_LAS bf16x8*)(lds + PG8_SA(b, h) + aoff + m * 2048 + k * 1024); } while (0)
#define PG8_LDB(dst, b, h) do { _Pragma("unroll") for (int n = 0; n < 2; ++n) _Pragma("unroll") for (int k = 0; k < 2; ++k) dst[n][k] = *(const PG8_LAS bf16x8*)(lds + PG8_SB(b, h) + boff + n * 2048 + k * 1024); } while (0)
#define PG8_MMA(ai, bj, At, Bt) do { __builtin_amdgcn_s_setprio(1); _Pragma("unroll") for (int m = 0; m < 4; ++m) _Pragma("unroll") for (int n = 0; n < 2; ++n) _Pragma("unroll") for (int k = 0; k < 2; ++k) \
        acc[ai][bj][m][n] = __builtin_amdgcn_mfma_f32_16x16x32_bf16(Bt[n][k], At[m][k], acc[ai][bj][m][n], 0, 0, 0); __builtin_amdgcn_s_setprio(0); } while (0)
#define PG8_WAIT_V(n) asm volatile("s_waitcnt vmcnt(" #n ")" ::: "memory")
#define PG8_WAIT_L(n) asm volatile("s_waitcnt lgkmcnt(" #n ")" ::: "memory")
#define PG8_BAR __builtin_amdgcn_s_barrier()
#define PG8_SCHED __builtin_amdgcn_sched_barrier(0)
    unsigned oaC[2][2], oaN[2][2];
#define PG8_GOFF(dst, unit) do { _Pragma("unroll") for (int _h = 0; _h < 2; ++_h) _Pragma("unroll") for (int _i = 0; _i < 2; ++_i) dst[_h][_i] = S.a_off(unit, _h * HALF + rowA[_i]) + voffA[_i]; } while (0)
#define PG8_STAGE_G(bufoff, offs, koff) do { _Pragma("unroll") for (int _i = 0; _i < 2; ++_i) \
        __builtin_amdgcn_global_load_lds((const unsigned*)(((const char*)g.A + (koff)) + (offs)[_i]), (PG8_LAS unsigned*)(lds + (bufoff) + ldsw + _i * 8192), 16, 0, 0); } while (0)
    Unit cur, nxt; int ui = 0;
    if (!S.next(0, cur)) return;
    if constexpr (Sched::GATHER) { PG8_GOFF(oaC, cur); PG8_GOFF(oaN, cur); }
    bool mm0 = true, mm1 = true;
    if constexpr (Sched::GATHER) { const int rws = S.rows(cur); mm0 = 64 * wr < rws; mm1 = 128 + 64 * wr < rws; }
    f32x4 acc[2][2][4][2];
#pragma unroll
    for (int a = 0; a < 2; ++a)
#pragma unroll
        for (int b = 0; b < 2; ++b)
#pragma unroll
            for (int m = 0; m < 4; ++m)
#pragma unroll
                for (int n = 0; n < 2; ++n) acc[a][b][m][n] = (f32x4){0.f, 0.f, 0.f, 0.f};
    bf16x8 At[4][2], B0[2][2], B1[2][2];
    const char* cA = (const char*)g.A + (size_t)cur.pm * tstep; const char* cB = (const char*)g.Bt + (size_t)cur.pn * tstep;
    S.a_ready(cur);
    if constexpr (SP2) {
        PG8_STAGE(PG8_SB(0, 0), cB, voffB); PG8_STAGE(PG8_SB(0, 1), cB + hstep, voffB);
        if constexpr (Sched::GATHER) { PG8_STAGE_G(PG8_SA(0, 0), oaC[0], 0); PG8_STAGE_G(PG8_SA(0, 1), oaC[1], 0); } else { PG8_STAGE(PG8_SA(0, 0), cA, voffA); PG8_STAGE(PG8_SA(0, 1), cA + hstep, voffA); }
        if (wr == 1) PG8_BAR;
        PG8_WAIT_V(2); PG8_BAR;
        PG8_STAGE(PG8_SB(1, 0), cB + kstep, voffB);
        if constexpr (Sched::GATHER) PG8_STAGE_G(PG8_SA(1, 0), oaC[0], kstep); else PG8_STAGE(PG8_SA(1, 0), cA + kstep, voffA);
        PG8_STAGE(PG8_SB(1, 1), cB + hstep + kstep, voffB);
        PG8_WAIT_V(6); PG8_BAR;
    } else {
        PG8_STAGE(PG8_SB(0, 0), cB, voffB); PG8_STAGE(PG8_SA(0, 0), cA, voffA); PG8_STAGE(PG8_SB(0, 1), cB + hstep, voffB); PG8_STAGE(PG8_SA(0, 1), cA + hstep, voffA);
        if (wr == 1) PG8_BAR;
        PG8_WAIT_V(4); PG8_BAR;
        PG8_STAGE(PG8_SB(1, 0), cB + kstep, voffB); PG8_STAGE(PG8_SA(1, 0), cA + kstep, voffA); PG8_STAGE(PG8_SB(1, 1), cB + hstep + kstep, voffB);
        PG8_WAIT_V(6); PG8_BAR;
    }
    for (;;) {
        const bool has_next = S.next(ui + 1, nxt);
        const char* nA = has_next ? (const char*)g.A + (size_t)nxt.pm * tstep : cA; const char* nB = has_next ? (const char*)g.Bt + (size_t)nxt.pn * tstep : cB;
        for (int t = 0; t < nt; t += 2) {
            const bool last = (t == nt - 2);
            const char* a1 = cA + (size_t)(t + 1) * kstep;
            const char* a2 = last ? nA : cA + (size_t)(t + 2) * kstep; const char* b2 = last ? nB : cB + (size_t)(t + 2) * kstep;
            const char* a3 = a2 + kstep; const char* b3 = b2 + kstep;
            if (last && has_next) S.a_ready(nxt);
            unsigned oaS[2][2]; size_t k2 = 0;
            if constexpr (Sched::GATHER) {
                if (last && has_next) PG8_GOFF(oaN, nxt);
                const bool fromN = last && has_next;
#pragma unroll
                for (int _h = 0; _h < 2; ++_h)
#pragma unroll
                    for (int _i = 0; _i < 2; ++_i) oaS[_h][_i] = fromN ? oaN[_h][_i] : oaC[_h][_i];
                k2 = last ? (size_t)0 : (size_t)(t + 2) * kstep;
            }
            if constexpr (SP2) {
            PG8_LDB(B0, 0, 0); PG8_LDB(B1, 0, 1); PG8_SCHED; PG8_LDA(At, 0, 0);
            if constexpr (Sched::GATHER) PG8_STAGE_G(PG8_SA(1, 1), oaC[1], (size_t)(t + 1) * kstep); else PG8_STAGE(PG8_SA(1, 1), a1 + hstep, voffA);
            PG8_WAIT_V(8); PG8_WAIT_L(0); PG8_BAR; if (!Sched::GATHER || mm0) { PG8_MMA(0, 0, At, B0); PG8_MMA(0, 1, At, B1); } PG8_BAR; PG8_SCHED;
            PG8_LDA(At, 0, 1); PG8_STAGE(PG8_SB(0, 0), b2, voffB); PG8_STAGE(PG8_SB(0, 1), b2 + hstep, voffB);
            if constexpr (Sched::GATHER) PG8_STAGE_G(PG8_SA(0, 0), oaS[0], k2); else PG8_STAGE(PG8_SA(0, 0), a2, voffA);
            PG8_WAIT_V(8); PG8_WAIT_L(0); PG8_BAR; if (!Sched::GATHER || mm1) { PG8_MMA(1, 0, At, B0); PG8_MMA(1, 1, At, B1); } PG8_BAR; PG8_SCHED;
            PG8_LDB(B0, 1, 0); PG8_LDB(B1, 1, 1); PG8_SCHED; PG8_LDA(At, 1, 0);
            if constexpr (Sched::GATHER) PG8_STAGE_G(PG8_SA(0, 1), oaS[1], k2); else PG8_STAGE(PG8_SA(0, 1), a2 + hstep, voffA);
            PG8_WAIT_V(8); PG8_WAIT_L(0); PG8_BAR; if (!Sched::GATHER || mm0) { PG8_MMA(0, 0, At, B0); PG8_MMA(0, 1, At, B1); } PG8_BAR; PG8_SCHED;
            PG8_LDA(At, 1, 1); PG8_STAGE(PG8_SB(1, 0), b3, voffB); PG8_STAGE(PG8_SB(1, 1), b3 + hstep, voffB);
            if constexpr (Sched::GATHER) PG8_STAGE_G(PG8_SA(1, 0), oaS[0], k2 + kstep); else PG8_STAGE(PG8_SA(1, 0), a3, voffA);
            PG8_WAIT_V(8); PG8_WAIT_L(0); PG8_BAR; if (!Sched::GATHER || mm1) { PG8_MMA(1, 0, At, B0); PG8_MMA(1, 1, At, B1); } PG8_BAR; PG8_SCHED;
            } else {
            PG8_LDB(B0, 0, 0); PG8_SCHED; PG8_LDA(At, 0, 0); PG8_STAGE(PG8_SA(1, 1), a1 + hstep, voffA);
            PG8_WAIT_L(8); PG8_BAR; PG8_WAIT_L(0); PG8_MMA(0, 0, At, B0); PG8_BAR; PG8_SCHED;
            PG8_LDB(B1, 0, 1); PG8_STAGE(PG8_SB(0, 0), b2, voffB);
            PG8_BAR; PG8_WAIT_L(0); PG8_MMA(0, 1, At, B1); PG8_BAR;
            PG8_LDA(At, 0, 1); PG8_STAGE(PG8_SA(0, 0), a2, voffA);
            PG8_BAR; PG8_WAIT_L(0); PG8_MMA(1, 0, At, B0); PG8_BAR; PG8_SCHED;
            PG8_STAGE(PG8_SB(0, 1), b2 + hstep, voffB);
            PG8_WAIT_V(6); PG8_BAR; PG8_MMA(1, 1, At, B1); PG8_BAR;
            PG8_LDB(B0, 1, 0); PG8_SCHED; PG8_LDA(At, 1, 0); PG8_STAGE(PG8_SA(0, 1), a2 + hstep, voffA);
            PG8_WAIT_L(8); PG8_BAR; PG8_WAIT_L(0); PG8_MMA(0, 0, At, B0); PG8_BAR; PG8_SCHED;
            PG8_LDB(B1, 1, 1); PG8_STAGE(PG8_SB(1, 0), b3, voffB);
            PG8_BAR; PG8_WAIT_L(0); PG8_MMA(0, 1, At, B1); PG8_BAR;
            PG8_LDA(At, 1, 1); PG8_STAGE(PG8_SA(1, 0), a3, voffA);
            PG8_BAR; PG8_WAIT_L(0); PG8_MMA(1, 0, At, B0); PG8_BAR; PG8_SCHED;
            PG8_STAGE(PG8_SB(1, 1), b3 + hstep, voffB);
            PG8_WAIT_V(6); PG8_BAR; PG8_MMA(1, 1, At, B1); PG8_BAR;
            }
        }
        if constexpr (ALIGN_EPI) { if (wr == 0) PG8_BAR; }
        if constexpr (!Epi::AFTER_DRAIN) { E(acc, cur, wr, wc, fr, fq); S.done(cur); }
        if (!has_next) break;
#pragma unroll
        for (int a = 0; a < 2; ++a)
#pragma unroll
            for (int b = 0; b < 2; ++b)
#pragma unroll
                for (int m = 0; m < 4; ++m)
#pragma unroll
                    for (int n = 0; n < 2; ++n) acc[a][b][m][n] = (f32x4){0.f, 0.f, 0.f, 0.f};
        cur = nxt; cA = nA; cB = nB; ++ui;
        if constexpr (Sched::GATHER) { const int rws = S.rows(cur); mm0 = 64 * wr < rws; mm1 = 128 + 64 * wr < rws; }
        if constexpr (Sched::GATHER) {
#pragma unroll
            for (int _h = 0; _h < 2; ++_h)
#pragma unroll
                for (int _i = 0; _i < 2; ++_i) oaC[_h][_i] = oaN[_h][_i];
        }
        if constexpr (ALIGN_EPI) { if (wr == 1) PG8_BAR; }
    }
    PG8_WAIT_V(0);
    if constexpr (!ALIGN_EPI) { if (wr == 0) PG8_BAR; }
    PG8_BAR;
    if constexpr (Epi::AFTER_DRAIN) { E.fused(acc, cur, wr, wc, fr, fq, lds, wid, lane); S.done(cur); }
#undef PG8_GOFF
#undef PG8_STAGE_G
#undef PG8_SA
#undef PG8_SB
#undef PG8_STAGE
#undef PG8_LDA
#undef PG8_LDB
#undef PG8_MMA
#undef PG8_WAIT_V
#undef PG8_WAIT_L
#undef PG8_BAR
#undef PG8_SCHED
}
}

struct OutEpi8 {
    static constexpr bool PERM = false, AFTER_DRAIN = false;
    const float* src; float* dst; const float* gate; float* part;
    __device__ __forceinline__ void operator()(const pg8::f32x4 (&acc)[2][2][4][2], const pg8::Unit& u, int wr, int wc, int fr, int fq) const {
#pragma unroll
        for (int ai = 0; ai < 2; ++ai)
#pragma unroll
            for (int m = 0; m < 4; ++m) {
                const int t = u.pm * 256 + ai * 128 + wr * 64 + m * 16 + fr;
                const float* gp = gate + (t >> 11) * 6144;
                float ss = 0.f;
#pragma unroll
                for (int bj = 0; bj < 2; ++bj)
#pragma unroll
                    for (int n = 0; n < 2; ++n) {
                        const int col = u.pn * 256 + bj * 128 + wc * 32 + n * 16 + fq * 4;
                        const pg8::f32x4 g = *(const pg8::f32x4*)(gp + col);
                        const pg8::f32x4 o = *(const pg8::f32x4*)(src + (size_t)t * 1024 + col) + g * acc[ai][bj][m][n];
                        *(pg8::f32x4*)(dst + (size_t)t * 1024 + col) = o;
                        ss += o[0] * o[0] + o[1] * o[1] + o[2] * o[2] + o[3] * o[3];
                    }
                ss += sx_f<16>(ss); ss += sx_f<32>(ss);
                if (fq == 0) part[(size_t)t * 16 + u.pn * 4 + wc] = ss;
            }
    }
};


DI unsigned cvtpk(float lo, float hi) { return pk2(lo, hi); }
struct HybEpi8 {
    static constexpr bool PERM = true, AFTER_DRAIN = false;
    const Params* p; int j;
    __device__ __forceinline__ void operator()(const pg8::f32x4 (&acc)[2][2][4][2], const pg8::Unit& u, int wr, int wc, int fr, int fq) const {
        unsigned char* ws = p->ws;
        const int un = u.pn;
        if (un < 5 && !(un == 4 && (wc == 1 || wc == 3))) {
            const bool donorm = un < 2 || (un == 4 && wc == 0);
            bf16_t* ob; int ld, cb; const float* gam = p->hy_q_norm + j * 64;
            if (un < 2) { ob = (bf16_t*)(ws + WS_Q); ld = 512; cb = 64 * (4 * un + wc); }
            else if (un < 4) { ob = (bf16_t*)(ws + WS_IQ); ld = 512; cb = 64 * (4 * (un - 2) + wc); }
            else if (wc == 0) { ob = (bf16_t*)(ws + WS_K); ld = 64; cb = 0; gam = p->hy_k_norm + j * 64; }
            else { ob = (bf16_t*)(ws + WS_IK); ld = 64; cb = 0; }
            pg8::f32x4 g0[2], g1[2];
#pragma unroll
            for (int n = 0; n < 2; ++n) { g0[n] = donorm ? *(const pg8::f32x4*)(gam + 8 * fq + 4 * n) : (pg8::f32x4){1.f, 1.f, 1.f, 1.f}; g1[n] = donorm ? *(const pg8::f32x4*)(gam + 32 + 8 * fq + 4 * n) : (pg8::f32x4){1.f, 1.f, 1.f, 1.f}; }
            const float* ropec = (const float*)(ws + WS_ROPEC);
            const float* ropes = (const float*)(ws + WS_ROPES);
            pg8::f32x4 rc[2][2], rs[2][2];
#define HYB_ROPE_LD(buf, st) do { const int t_ = opq(u.pm * 256 + ((st) >> 2) * 128 + wr * 64 + ((st) & 3) * 16 + fr), pos_ = t_ & (S - 1); _Pragma("unroll") for (int n = 0; n < 2; ++n) { \
                rc[buf][n] = *(const pg8::f32x4*)(ropec + pos_ * 32 + 8 * fq + 4 * n); rs[buf][n] = *(const pg8::f32x4*)(ropes + pos_ * 32 + 8 * fq + 4 * n); } } while (0)
            HYB_ROPE_LD(0, 0);
#pragma unroll
            for (int ai = 0; ai < 2; ++ai)
#pragma unroll
                for (int m = 0; m < 4; ++m) {
                    const int st = ai * 4 + m, cb_ = st & 1;
                    if (st < 7) { if (cb_) HYB_ROPE_LD(0, st + 1); else HYB_ROPE_LD(1, st + 1); }
                    const int t = opq(u.pm * 256 + ai * 128 + wr * 64 + m * 16 + fr);
                    float rstd = 1.f;
                    if (donorm) {
                        float ss = 0.f;
#pragma unroll
                        for (int bj = 0; bj < 2; ++bj)
#pragma unroll
                            for (int n = 0; n < 2; ++n) { const pg8::f32x4 x = acc[ai][bj][m][n]; ss += x[0] * x[0] + x[1] * x[1] + x[2] * x[2] + x[3] * x[3]; }
                        ss += sx_f<16>(ss); ss += sx_f<32>(ss);
                        rstd = rsqrtf(ss * (1.f / 64.f) + EPS);
                    }
                    u32x4 o1, o2;
#pragma unroll
                    for (int n = 0; n < 2; ++n) {
                        const pg8::f32x4 cs = rc[cb_][n], sn = rs[cb_][n];
                        const pg8::f32x4 x1 = acc[ai][0][m][n] * rstd * g0[n], x2 = acc[ai][1][m][n] * rstd * g1[n];
                        const pg8::f32x4 y1 = x1 * cs - x2 * sn, y2 = x2 * cs + x1 * sn;
                        o1[2 * n] = cvtpk(y1[0], y1[1]); o1[2 * n + 1] = cvtpk(y1[2], y1[3]);
                        o2[2 * n] = cvtpk(y2[0], y2[1]); o2[2 * n + 1] = cvtpk(y2[2], y2[3]);
                    }
                    if (un == 4) {
                        const int kk = t & 31, cs_ = (wc == 0) ? ((kk & ~12) | ((kk & 4) << 1) | ((kk & 8) >> 1)) : kk;
                        bf16_t* fb = ob + ((size_t)(t >> 5) * 256 + (fq >> 1) * 64 + (fq & 1) * 32 + cs_) * 8;
                        *(u32x4*)fb = o1; *(u32x4*)(fb + 128 * 8) = o2;
                    } else {
                    *(u32x4*)(ob + (size_t)t * ld + cb + 8 * fq) = o1;
                    *(u32x4*)(ob + (size_t)t * ld + cb + 32 + 8 * fq) = o2;
                    }
                }
#undef HYB_ROPE_LD
        } else if (un == 4 && wc == 1) {
            bf16_t* ob = (bf16_t*)(ws + WS_V);
#pragma unroll
            for (int ai = 0; ai < 2; ++ai)
#pragma unroll
                for (int m = 0; m < 4; ++m) {
                    const int t = opq(u.pm * 256 + ai * 128 + wr * 64 + m * 16 + fr), pos = t & (S - 1);
#pragma unroll
                    for (int bj = 0; bj < 2; ++bj)
#pragma unroll
                        for (int n = 0; n < 2; ++n)
#pragma unroll
                            for (int e = 0; e < 4; ++e) ob[((((size_t)(t >> 5) * 4 + bj + ((pos >> 4) & 1) * 2) * 2 + ((pos >> 3) & 1)) * 32 + 8 * fq + 4 * n + e) * 8 + (pos & 7)] = f2bf(acc[ai][bj][m][n][e]);
                }
        } else if (un == 4) {
            float* ob = (float*)(ws + WS_IW);
            if (fq == 0) {
#pragma unroll
                for (int ai = 0; ai < 2; ++ai)
#pragma unroll
                    for (int m = 0; m < 4; ++m) {
                        const int t = u.pm * 256 + ai * 128 + wr * 64 + m * 16 + fr;
                        *(pg8::f32x4*)(ob + (size_t)t * 8) = acc[ai][0][m][0] * (0.125f * 0.35355339059327373f);
                        *(pg8::f32x4*)(ob + (size_t)t * 8 + 4) = acc[ai][0][m][1] * (0.125f * 0.35355339059327373f);
                    }
            }
        } else if (un < 7) {
            bf16_t* ob = (bf16_t*)(ws + WS_BG);
#pragma unroll
            for (int ai = 0; ai < 2; ++ai)
#pragma unroll
                for (int m = 0; m < 4; ++m) {
                    const int t = opq(u.pm * 256 + ai * 128 + wr * 64 + m * 16 + fr);
#pragma unroll
                    for (int bj = 0; bj < 2; ++bj) {
                        const pg8::f32x4 a = acc[ai][bj][m][0], b = acc[ai][bj][m][1];
                        u32x4 o = {cvtpk(a[0], a[1]), cvtpk(a[2], a[3]), cvtpk(b[0], b[1]), cvtpk(b[2], b[3])};
                        *(u32x4*)(ob + (size_t)t * 512 + (un - 5) * 256 + 128 * bj + 32 * wc + 8 * fq) = o;
                    }
                }
        } else {
            bf16_t* ob = (bf16_t*)(ws + WS_Z);
#pragma unroll
            for (int ai = 0; ai < 2; ++ai)
#pragma unroll
                for (int m = 0; m < 4; ++m) {
                    const int t = opq(u.pm * 256 + ai * 128 + wr * 64 + m * 16 + fr);
                    const pg8::f32x4 a = acc[ai][0][m][0] * acc[ai][1][m][0], b = acc[ai][0][m][1] * acc[ai][1][m][1];
                    u32x4 o = {cvtpk(a[0], a[1]), cvtpk(a[2], a[3]), cvtpk(b[0], b[1]), cvtpk(b[2], b[3])};
                    *(u32x4*)(ob + (size_t)t * 512 + (un - 7) * 128 + 32 * wc + 8 * fq) = o;
                }
        }
    }
};


struct MlEpi8 {
    static constexpr bool PERM = true, AFTER_DRAIN = false;
    const Params* p; int j;
    __device__ __forceinline__ void operator()(const pg8::f32x4 (&acc)[2][2][4][2], const pg8::Unit& u, int wr, int wc, int fr, int fq) const {
        unsigned char* ws = p->ws;
        const int un = u.pn;
        if (un < 4 || un >= 8) {
            bf16_t* ob; int ld, cb0; float sc = 1.f;
            if (un < 2) { ob = (bf16_t*)(ws + WS_MQ); ld = 512; cb0 = 64 * (4 * un + wc); sc = 0.125f; }
            else if (un < 4) { ob = (bf16_t*)(ws + WS_MK); ld = 512; cb0 = 64 * (4 * (un - 2) + wc); }
            else { ob = (bf16_t*)(ws + WS_MOG); ld = 1024; cb0 = (un - 8) * 256 + 32 * wc; }
            const int bstep = un < 4 ? 32 : 128;
#pragma unroll
            for (int ai = 0; ai < 2; ++ai)
#pragma unroll
                for (int m = 0; m < 4; ++m) {
                    const int t = opq(u.pm * 256 + ai * 128 + wr * 64 + m * 16 + fr);
#pragma unroll
                    for (int bj = 0; bj < 2; ++bj) {
                        pg8::f32x4 a = acc[ai][bj][m][0] * sc, b = acc[ai][bj][m][1] * sc;
                        if (un >= 8) { for (int e = 0; e < 4; ++e) { a[e] = sigmoidf_(a[e]); b[e] = sigmoidf_(b[e]); } }
                        u32x4 o = {cvtpk(a[0], a[1]), cvtpk(a[2], a[3]), cvtpk(b[0], b[1]), cvtpk(b[2], b[3])};
                        *(u32x4*)(ob + (size_t)t * ld + cb0 + bstep * bj + 8 * fq) = o;
                    }
                }
        }
        if (un >= 2 && un < 8) {
            bf16_t* ob = (bf16_t*)(ws + (un < 4 ? WS_MKT : WS_MV));
#pragma unroll
            for (int ai = 0; ai < 2; ++ai)
#pragma unroll
                for (int m = 0; m < 4; ++m) {
                    const int t = opq(u.pm * 256 + ai * 128 + wr * 64 + m * 16 + fr), pos = t & (S - 1), bb = t >> 11;
#pragma unroll
                    for (int bj = 0; bj < 2; ++bj) {
                        const size_t rowb = un < 4 ? (size_t)((bb * 8 + 4 * (un - 2) + wc) * 64 + 32 * bj + 8 * fq) : (size_t)((bb * 8 + 2 * (un - 4) + bj) * 128 + 32 * wc + 8 * fq);
#pragma unroll
                        for (int n = 0; n < 2; ++n)
#pragma unroll
                            for (int e = 0; e < 4; ++e) ob[(rowb + 4 * n + e) * S + pos] = f2bf(acc[ai][bj][m][n][e]);
                    }
                }
        }
    }
};


struct MoeOrder8 {
    static constexpr bool GATHER = true;
    const int* tab; const int* elist; int G, c, total, mode;
    __device__ __forceinline__ bool next(int i, pg8::Unit& u) const {
        const int cl = (G & 7) ? c : (c & 7) * (G >> 3) + (c >> 3);
        const int wg = i * G + cl; if (wg >= total) return false;
        u.pm = __builtin_amdgcn_readfirstlane(tab[wg >> 2]); u.pn = __builtin_amdgcn_readfirstlane((u.pm >> 8) * 4 + (wg & 3)); return true;
    }
    __device__ __forceinline__ int rows(const pg8::Unit& u) const { const int r = tab[168 + (u.pm >> 8)] - (u.pm & 255) * 256; return __builtin_amdgcn_readfirstlane(r < 256 ? r : 256); }
    __device__ __forceinline__ unsigned a_off(const pg8::Unit& u, int row) const {
        const int e = u.pm >> 8, lr = (u.pm & 255) * 256 + row;
        if (lr >= tab[168 + e]) return 0u;
        if (mode == 1) return (unsigned)(elist[e * NASG + lr] >> 1) * 2048u;
        return (unsigned)(tab[200 + e] + lr) * 1024u;
    }
    __device__ __forceinline__ void a_ready(const pg8::Unit&) const {}
    __device__ __forceinline__ void done(const pg8::Unit&) const {}
};
struct Moe1Epi8 {
    static constexpr bool PERM = true, AFTER_DRAIN = false;
    const int* tab; bf16_t* h1;
    __device__ __forceinline__ void operator()(const pg8::f32x4 (&acc)[2][2][4][2], const pg8::Unit& u, int wr, int wc, int fr, int fq) const {
        const int e = u.pm >> 8, mu = u.pm & 255, nu = u.pn & 3, cnt = tab[168 + e], roff = tab[200 + e];
#pragma unroll
        for (int ai = 0; ai < 2; ++ai)
#pragma unroll
            for (int m = 0; m < 4; ++m) {
                const int lr = opq(mu * 256 + ai * 128 + wr * 64 + m * 16 + fr);
                if (lr < cnt) {
                    u32x4 o;
#pragma unroll
                    for (int n = 0; n < 2; ++n) {
                        const pg8::f32x4 g = acc[ai][0][m][n], up = acc[ai][1][m][n]; float h[4];
#pragma unroll
                        for (int x = 0; x < 4; ++x) h[x] = g[x] * __builtin_amdgcn_rcpf(1.f + __expf(-g[x])) * up[x];
                        o[2 * n] = cvtpk(h[0], h[1]); o[2 * n + 1] = cvtpk(h[2], h[3]);
                    }
                    *(u32x4*)(h1 + (size_t)(roff + lr) * 512 + 128 * nu + 32 * wc + 8 * fq) = o;
                }
            }
    }
};
struct Moe2Epi8 {
    static constexpr bool PERM = true, AFTER_DRAIN = false;
    const int* tab; const int* elist; bf16_t* y;
    __device__ __forceinline__ void operator()(const pg8::f32x4 (&acc)[2][2][4][2], const pg8::Unit& u, int wr, int wc, int fr, int fq) const {
        const int e = u.pm >> 8, mu = u.pm & 255, nu = u.pn & 3, cnt = tab[168 + e];
#pragma unroll
        for (int ai = 0; ai < 2; ++ai)
#pragma unroll
            for (int m = 0; m < 4; ++m) {
                const int lr = opq(mu * 256 + ai * 128 + wr * 64 + m * 16 + fr);
                if (lr < cnt) {
                    const int a = elist[e * NASG + lr];
#pragma unroll
                    for (int bj = 0; bj < 2; ++bj) {
                        const pg8::f32x4 v0 = acc[ai][bj][m][0], v1 = acc[ai][bj][m][1];
                        u32x4 o = {cvtpk(v0[0], v0[1]), cvtpk(v0[2], v0[3]), cvtpk(v1[0], v1[1]), cvtpk(v1[2], v1[3])};
                        *(u32x4*)(y + (size_t)a * 1024 + 256 * nu + 128 * bj + 32 * wc + 8 * fq) = o;
                    }
                }
            }
    }
};

#define XB_TMO      128
#define XB_XCNT(j)  (256  + 64 * (j))
#define XB_XSUB(j)  (1280 + 64 * (j))
#define XB_XGEN(j)  (2304 + 64 * (j))
#define XB_TOP      3328
#define XB_TOPGEN   3392
#define XCD_BAR_WORDS 3456
#define XB_SPIN_CAP (1u << 22)
#define LAS __attribute__((address_space(3)))
DI unsigned xb_ld(unsigned* p) { return __hip_atomic_load(p, __ATOMIC_RELAXED, __HIP_MEMORY_SCOPE_AGENT); }
DI unsigned xb_add(unsigned* p, unsigned v) { return __hip_atomic_fetch_add(p, v, __ATOMIC_RELAXED, __HIP_MEMORY_SCOPE_AGENT); }
DI unsigned xb_xcc_id() { return (unsigned)__builtin_amdgcn_s_getreg((3 << 11) | 20) & 0xFu; }
#define XB_SPIN(cond, bar) do { unsigned _sp = 0; while (cond) { __builtin_amdgcn_s_sleep(1); \
    if ((++_sp & 255u) == 0u) { if (xb_ld(&(bar)[XB_TMO])) break; if (_sp > XB_SPIN_CAP) { atomicAdd(&(bar)[XB_TMO], 1u); break; } } } } while (0)
struct XcdBarrier { unsigned* bar; unsigned x; volatile LAS unsigned* st; };
DI XcdBarrier xcd_barrier_post(unsigned* bar, volatile LAS unsigned* st, bool leader) {
    XcdBarrier b; b.bar = bar; b.x = xb_xcc_id(); b.st = st;
    if (leader) (void)xb_add(&bar[XB_XCNT(b.x)], 1u);
    return b;
}
DI void xcd_barrier_complete(unsigned* bar, unsigned x, unsigned& nloc, unsigned& nx) {
    const unsigned G = gridDim.x * gridDim.y * gridDim.z;
    unsigned sum, cnt, mine, sp = 0u;
    for (;;) {
        sum = 0u; cnt = 0u; mine = 0u;
#pragma unroll
        for (unsigned j = 0; j < 16; ++j) { const unsigned c = xb_ld(&bar[XB_XCNT(j)]); sum += c; cnt += (c > 0u) ? 1u : 0u; mine = (j == x) ? c : mine; }
        if (sum == G) break;
        __builtin_amdgcn_s_sleep(1);
        if ((++sp & 255u) == 0u) { if (xb_ld(&bar[XB_TMO])) break; if (sp > XB_SPIN_CAP) { atomicAdd(&bar[XB_TMO], 1u); break; } }
    }
    nloc = mine > 0u ? mine : 1u; nx = cnt > 0u ? cnt : 1u;
}
DI void xcd_barrier(const XcdBarrier& b, bool leader) {
    asm volatile("s_waitcnt vmcnt(0)" ::: "memory");
    __syncthreads();
    if (leader) {
        unsigned* bar = b.bar;
        __builtin_amdgcn_s_waitcnt(0);
        unsigned nloc = b.st[0], nx = b.st[1];
        if (nloc == 0u) { xcd_barrier_complete(bar, b.x, nloc, nx); b.st[0] = nloc; b.st[1] = nx; }
        const unsigned old = xb_add(&bar[XB_XSUB(b.x)], 1u);
        const unsigned gen = old / nloc;
        if (old + 1u == (gen + 1u) * nloc) {
            __builtin_amdgcn_fence(__ATOMIC_RELEASE, "agent");
            asm volatile("s_waitcnt vmcnt(0)" ::: "memory");
            const unsigned og = xb_add(&bar[XB_TOP], 1u);
            const unsigned tg = og / nx;
            if (og + 1u == (tg + 1u) * nx) xb_add(&bar[XB_TOPGEN], 1u);
            else XB_SPIN(xb_ld(&bar[XB_TOPGEN]) == tg, bar);
            __builtin_amdgcn_fence(__ATOMIC_ACQUIRE, "agent");
            xb_add(&bar[XB_XGEN(b.x)], 1u);
            asm volatile("s_waitcnt vmcnt(0)" ::: "memory");
        } else {
            XB_SPIN(xb_ld(&bar[XB_XGEN(b.x)]) == gen, bar);
            __builtin_amdgcn_fence(__ATOMIC_ACQUIRE, "agent");
            asm volatile("s_waitcnt vmcnt(0)" ::: "memory");
        }
    }
    __syncthreads();
}

namespace cg = cooperative_groups;
constexpr int MEGA_LDS = 65536 + 256;

DI const Params& fresh(const Params* kp) { asm volatile("" : "+s"(kp)); return *kp; }

#ifndef PROBE_MASK
#define PROBE_MASK 0
#endif
__global__ void __launch_bounds__(512, 2) hybrid_fwd_megakernel(Params p_arg) {
    __shared__ __attribute__((aligned(16))) unsigned char smem_all[2 * MEGA_LDS + 1024];
    cg::grid_group grid = cg::this_grid();
    const Params* kp = (const Params*)__builtin_amdgcn_kernarg_segment_ptr();
    const int wave8 = __builtin_amdgcn_readfirstlane((int)(threadIdx.x >> 6));
    const int vb = wave8 >> 2;
#define tid0 ((wave8 & 3) * 64 + lane_id())
    unsigned char* smem = smem_all + vb * MEGA_LDS;
    const int bid0 = blockIdx.x * 2 + vb, nb = gridDim.x * 2;
    const int gx0 = blockIdx.x & 7, glb0 = (blockIdx.x >> 3) * 2 + vb, gnl = (gridDim.x >> 3) * 2;
#define bid opqs(bid0)
#define gx opqs(gx0)
#define glb opqs(glb0)
#define tid opq(tid0)
    volatile LAS unsigned* xst = (volatile LAS unsigned*)(smem_all + 2 * MEGA_LDS);
    if (wave8 == 0 && lane_id() == 0) { xst[0] = 0u; xst[1] = 0u; }
    __syncthreads();
    (void)xcd_barrier_post((unsigned*)(fresh(kp).ws + WS_BAR), xst, wave8 == 0 && lane_id() == 0);
    for (int rep = 0; rep < ((PROBE_MASK & 1) ? 2 : 1); ++rep) { phase_init(fresh(kp), smem, bid, nb, tid); }
#define GSYNC() do { XcdBarrier xb_; xb_.bar = (unsigned*)(fresh(kp).ws + WS_BAR); xb_.x = xb_xcc_id(); xb_.st = (volatile LAS unsigned*)(smem_all + 2 * MEGA_LDS); xcd_barrier(xb_, wave8 == 0 && lane_id() == 0); } while (0)
    if (fresh(kp).use_cg_sync) grid.sync();
    GSYNC();
#pragma unroll 1
    for (int layer = 0; layer < DEPTH; ++layer) {
        const int j = layer >> 1;
        if (layer == 0) { { const Params& p = fresh(kp); phase_norm(p, 0, p.x, bid, nb, tid); }
        GSYNC(); }
        if ((layer & 1) == 0) {
            for (int rep = 0; rep < ((PROBE_MASK & 4) ? 2 : 1); ++rep) { { const Params& p = fresh(kp);
              pg8::Gemm g8{(const pg8::bf16_t*)(p.ws + WS_H), (const pg8::bf16_t*)(p.ws + WS_WHYB) + (size_t)j * 2816 * 1024, T, 2816, 1024};
              pg8::StaticOrder S8; S8.init(T, 2816, (int)gridDim.x, (int)blockIdx.x);
              HybEpi8 E8{&p, j};
              pg8::gemm_phase<HybEpi8, pg8::StaticOrder, true, true>((PG8_LAS unsigned char*)smem_all, g8, S8, E8, wave8 * 64 + lane_id()); } }
            GSYNC();
            for (int rep = 0; rep < ((PROBE_MASK & 8) ? 2 : 1); ++rep) { phase_dsa(fresh(kp), j, smem, bid, nb, tid, layer == 0 ? 1 : 3, layer == 0 ? 3 : 4); }
            for (int rep = 0; rep < ((PROBE_MASK & 16) ? 2 : 1); ++rep) { phase_conv(fresh(kp), j, bid, nb, tid); }
            GSYNC();
            { const Params& p = fresh(kp);
              pg8::Gemm g8{(const pg8::bf16_t*)(p.ws + WS_YMIX), (const pg8::bf16_t*)(p.ws + WS_WOUT) + (size_t)layer * 1024 * 1024, T, 1024, 1024};
              pg8::StaticOrder S8; S8.init(T, 1024, (int)gridDim.x, (int)blockIdx.x);
              OutEpi8 E8{layer == 0 ? p.x : p.out, p.out, (const float*)(p.ws + WS_MOD) + (size_t)layer * 8 * 6144 + 2048, (float*)(p.ws + WS_PART)};
              pg8::gemm_phase<OutEpi8, pg8::StaticOrder, true, true>((PG8_LAS unsigned char*)smem_all, g8, S8, E8, wave8 * 64 + lane_id()); }
        } else {
            for (int rep = 0; rep < ((PROBE_MASK & 32) ? 2 : 1); ++rep) { { const Params& p = fresh(kp);
              pg8::Gemm g8{(const pg8::bf16_t*)(p.ws + WS_H), (const pg8::bf16_t*)(p.ws + WS_WML) + (size_t)j * 3200 * 1024, T, 3072, 1024};
              pg8::StaticOrder S8; S8.init(T, 3072, (int)gridDim.x, (int)blockIdx.x);
              MlEpi8 E8{&p, j};
              pg8::gemm_phase<MlEpi8, pg8::StaticOrder, true, true>((PG8_LAS unsigned char*)smem_all, g8, S8, E8, wave8 * 64 + lane_id());
              for (int gi = glb; gi < 16; gi += gnl) { MlGates pr{&p, j, gx * 16 + gi}; gemm_tile(pr, smem, tid); } } }
            GSYNC();
            for (int rep = 0; rep < ((PROBE_MASK & 64) ? 2 : 1); ++rep) { phase_ml1(fresh(kp), smem, bid, nb, tid); }
            GSYNC();
            for (int rep = 0; rep < ((PROBE_MASK & 128) ? 2 : 1); ++rep) { phase_ml2(fresh(kp), smem, bid, nb, tid); }
            GSYNC();
            for (int rep = 0; rep < ((PROBE_MASK & 256) ? 2 : 1); ++rep) { phase_ml3(fresh(kp), j, smem, bid, nb, tid); }
            GSYNC();
            { const Params& p = fresh(kp);
              pg8::Gemm g8{(const pg8::bf16_t*)(p.ws + WS_YMIX), (const pg8::bf16_t*)(p.ws + WS_WOUT) + (size_t)layer * 1024 * 1024, T, 1024, 1024};
              pg8::StaticOrder S8; S8.init(T, 1024, (int)gridDim.x, (int)blockIdx.x);
              OutEpi8 E8{p.out, p.out, (const float*)(p.ws + WS_MOD) + (size_t)layer * 8 * 6144 + 2048, (float*)(p.ws + WS_PART)};
              pg8::gemm_phase<OutEpi8, pg8::StaticOrder, true, true>((PG8_LAS unsigned char*)smem_all, g8, S8, E8, wave8 * 64 + lane_id()); }
        }
        GSYNC();
        phase_ffn_norm_router(fresh(kp), layer, smem, bid, nb, tid);
        GSYNC();
        { const Params& p = fresh(kp); unsigned char* wsu = uniform_ptr(p.ws);
          int* mtab = (int*)(smem_all + 2 * MEGA_LDS + 64);
          __syncthreads();
          if (wave8 == 0) {
              const int e = lane_id(); const int cn = e < 32 ? ((const int*)(wsu + WS_ECNT))[(layer * 32 + e) * ECS] : 0;
              const int nf = cn >> 8, r = cn & 255;
              if (e < 32) { mtab[168 + e] = cn; mtab[112 + e] = nf; }
              __builtin_amdgcn_wave_barrier();
              int fx = 0, sx = 0, nF = 0;
#pragma unroll
              for (int k = 0; k < 32; ++k) { const int ck = mtab[168 + k], fk = mtab[112 + k]; fx += k < e ? fk : 0; sx += k < e ? ck : 0; nF += fk; }
              __builtin_amdgcn_wave_barrier();
              const int cls = r == 0 ? 3 : (r > 128 ? 0 : (r > 64 ? 1 : 2));
              const unsigned long long b0 = __ballot(e < 32 && cls == 0), b1 = __ballot(e < 32 && cls == 1), b2 = __ballot(e < 32 && cls == 2);
              const unsigned long long lt = (1ull << e) - 1ull;
              const int pos = cls == 0 ? __popcll(b0 & lt) : cls == 1 ? __popcll(b0) + __popcll(b1 & lt) : __popcll(b0) + __popcll(b1) + __popcll(b2 & lt);
              if (e < 32) {
                  mtab[200 + e] = sx;
                  for (int mu = 0; mu < nf; ++mu) mtab[fx + mu] = (e << 8) | mu;
                  if (cls < 3) mtab[nF + pos] = (e << 8) | nf;
              }
              if (e == 0) mtab[160] = nF + __popcll(b0 | b1 | b2);
          }
          __syncthreads();
          MoeOrder8 S8{mtab, (const int*)(wsu + WS_ELIST), (int)gridDim.x, (int)blockIdx.x, mtab[160] * 4, 1};
          pg8::Gemm g8{(const pg8::bf16_t*)(wsu + WS_H), (const pg8::bf16_t*)(wsu + WS_WM1) + (size_t)layer * 32 * 1024 * 1024, 0, 0, 1024};
          Moe1Epi8 E8{mtab, (bf16_t*)(wsu + WS_H1)};
          pg8::gemm_phase<Moe1Epi8, MoeOrder8, true, true>((PG8_LAS unsigned char*)smem_all, g8, S8, E8, wave8 * 64 + lane_id()); }
        GSYNC();
        { const Params& p = fresh(kp); unsigned char* wsu = uniform_ptr(p.ws);
          int* mtab = (int*)(smem_all + 2 * MEGA_LDS + 64);
          MoeOrder8 S8{mtab, (const int*)(wsu + WS_ELIST), (int)gridDim.x, (int)blockIdx.x, mtab[160] * 4, 2};
          pg8::Gemm g8{(const pg8::bf16_t*)(wsu + WS_H1), (const pg8::bf16_t*)(wsu + WS_WM2) + (size_t)layer * 32 * 1024 * 512, 0, 0, 512};
          Moe2Epi8 E8{mtab, (const int*)(wsu + WS_ELIST), (bf16_t*)(wsu + WS_Y)};
          pg8::gemm_phase<Moe2Epi8, MoeOrder8, true, true>((PG8_LAS unsigned char*)smem_all, g8, S8, E8, wave8 * 64 + lane_id()); }
        GSYNC();
        phase_combine_norm(fresh(kp), layer, bid, nb, tid);
        if (layer + 1 < DEPTH) GSYNC();
    }
}
#undef tid
#undef tid0
#undef bid
#undef gx
#undef glb
#undef GSYNC

extern "C" void kernel_launch(void* const* d_in, const int* in_sizes, int n_in, void* d_out, int out_size, void* d_ws, size_t ws_size, hipStream_t stream) {
    Params p{};
    const float** f = (const float**)&p;
    for (int i = 0; i < 22; ++i) f[i] = (const float*)d_in[i];
    p.out = (float*)d_out;
    p.ws = (unsigned char*)d_ws;
    if (ws_size < WS_END) { fprintf(stderr, "workspace too small: %zu < %zu\n", ws_size, (size_t)WS_END); return; }
    static int grid_blocks = 0;
    if (!grid_blocks) {
        int dev = 0, cus = 0, per_cu = 0;
        hipGetDevice(&dev);
        hipDeviceGetAttribute(&cus, hipDeviceAttributeMultiprocessorCount, dev);
        hipOccupancyMaxActiveBlocksPerMultiprocessor(&per_cu, hybrid_fwd_megakernel, 512, 0);
        if (per_cu > 1) per_cu = 1;
        grid_blocks = cus * per_cu;
    }
    (void)hipMemsetAsync((unsigned char*)d_ws + WS_BAR, 0, XCD_BAR_WORDS_C * 4, stream);
    void* args[] = {&p};
    hipError_t e = hipLaunchCooperativeKernel((void*)hybrid_fwd_megakernel, dim3(grid_blocks), dim3(512), args, 0, stream);
    if (e != hipSuccess) fprintf(stderr, "cooperative launch failed: %s (grid %d)\n", hipGetErrorString(e), grid_blocks);
}
```

```cpp
#include <hip/hip_runtime.h>
#include <hip/hip_cooperative_groups.h>
#include <stdint.h>
#include <cstdio>

#define DI __device__ __forceinline__
typedef unsigned short bf16_t;
typedef short bf16x8 __attribute__((ext_vector_type(8)));
typedef float f32x16 __attribute__((ext_vector_type(16)));
typedef float f32x4 __attribute__((ext_vector_type(4)));
typedef float f32x2 __attribute__((ext_vector_type(2)));
typedef unsigned u32x4 __attribute__((ext_vector_type(4)));
typedef unsigned u32x2 __attribute__((ext_vector_type(2)));
typedef __bf16 bf16x2_t __attribute__((ext_vector_type(2)));

constexpr int D = 1024, NB = 8, S = 2048, T = NB * S, DEPTH = 4;
constexpr int HYB_IN = 2760, ML_IN = 3088;
constexpr int NEXP = 32, DEXP = 512, NASG = T * 2;
constexpr float EPS = 1e-6f;
constexpr int XCD_BAR_WORDS_C = 3456;

constexpr size_t al256(size_t x) { return (x + 255) & ~(size_t)255; }
constexpr size_t WS_MOD = 0;
constexpr size_t WS_ROPEC = WS_MOD + al256((size_t)4 * 8 * 6144 * 4);
constexpr size_t WS_ROPES = WS_ROPEC + al256((size_t)2048 * 32 * 4);
constexpr size_t WS_ECNT = WS_ROPES + al256((size_t)2048 * 32 * 4);
constexpr int ECS = 64;
constexpr size_t WS_H = WS_ECNT + al256(4 * 32 * ECS * 4);
constexpr size_t WS_YMIX = WS_H + al256((size_t)T * 1024 * 2);
constexpr size_t WS_Q = WS_YMIX + al256((size_t)T * 1024 * 2);
constexpr size_t WS_K = WS_Q + al256((size_t)T * 512 * 2);
constexpr size_t WS_V = WS_K + al256((size_t)T * 64 * 2);
constexpr size_t WS_IQ = WS_V + al256((size_t)T * 64 * 2);
constexpr size_t WS_IK = WS_IQ + al256((size_t)T * 512 * 2);
constexpr size_t WS_IW = WS_IK + al256((size_t)T * 64 * 2);
constexpr size_t WS_BG = WS_IW + al256((size_t)T * 8 * 4);
constexpr size_t WS_Z = WS_BG + al256((size_t)T * 512 * 2);
constexpr size_t WS_MASK = WS_Z + al256((size_t)T * 512 * 2);
constexpr size_t WS_MQ = WS_MASK + al256((size_t)T * 64 * 4);
constexpr size_t WS_MK = WS_MQ + al256((size_t)T * 512 * 2);
constexpr size_t WS_MV = WS_MK + al256((size_t)T * 512 * 2);
constexpr size_t WS_MIG = WS_MV + al256((size_t)T * 1024 * 2);
constexpr size_t WS_MFG = WS_MIG + al256((size_t)T * 8 * 4);
constexpr size_t WS_MOG = WS_MFG + al256((size_t)T * 8 * 4);
constexpr size_t WS_EW = WS_MOG + al256((size_t)T * 1024 * 2);
constexpr size_t WS_ELIST = WS_EW + al256((size_t)NASG * 4);
constexpr size_t WS_H1 = WS_ELIST + al256((size_t)NEXP * NASG * 4);
constexpr size_t WS_Y = WS_H1 + al256((size_t)NASG * 512 * 2);
constexpr size_t WS_MKT = WS_Y + al256((size_t)NASG * 1024 * 2);
constexpr size_t WS_UBUF = WS_MKT + al256((size_t)64 * 64 * S * 2);
constexpr size_t WS_UNBUF = WS_UBUF + al256((size_t)64 * 32 * 8192 * 4);
constexpr size_t WS_MLOC = WS_UNBUF + al256((size_t)64 * 32 * 64 * 4);
constexpr size_t WS_CBUF = WS_MLOC + al256((size_t)64 * 32 * 2 * 4);
constexpr size_t WS_NBUF = WS_CBUF + al256((size_t)64 * 32 * 8192 * 2);
constexpr size_t WS_MST = WS_NBUF + al256((size_t)64 * 32 * 64 * 4);
constexpr size_t WS_PART = WS_MST + al256((size_t)64 * 32 * 4);
constexpr size_t WS_WHYB = WS_PART + al256((size_t)T * 16 * 4);
constexpr size_t WS_WML = WS_WHYB + al256((size_t)2 * 2816 * 1024 * 2);
constexpr size_t WS_WOUT = WS_WML + al256((size_t)2 * 3200 * 1024 * 2);
constexpr size_t WS_WM1 = WS_WOUT + al256((size_t)4 * 1024 * 1024 * 2);
constexpr size_t WS_WM2 = WS_WM1 + al256((size_t)4 * 32 * 1024 * 1024 * 2);
constexpr size_t WS_BAR = WS_WM2 + al256((size_t)4 * 32 * 1024 * 512 * 2);
constexpr size_t WS_END = WS_BAR + al256((size_t)XCD_BAR_WORDS_C * 4);

struct Params {
    const float *x, *c, *ada_w, *ada_b, *norm_mix, *norm_ffn, *hy_w_in, *hy_q_norm, *hy_k_norm, *hy_conv_w, *hy_w_out;
    const float *ml_w_in, *ml_b_gates, *ml_out_norm, *ml_w_out, *moe_w_group, *moe_b_group, *moe_w_expert, *moe_b_expert;
    const float *moe_w_gate, *moe_w_up, *moe_w_down;
    float* out;
    unsigned char* ws;
    unsigned long long use_cg_sync;
};

DI unsigned pk2(float lo, float hi) { f32x2 v = {lo, hi}; bf16x2_t b = __builtin_convertvector(v, bf16x2_t); return __builtin_bit_cast(unsigned, b); }
DI bf16_t f2bf(float x) { return (bf16_t)(pk2(x, 0.f) & 0xffffu); }
DI float bf2f(bf16_t h) { return __uint_as_float(((unsigned)h) << 16); }
DI float bflo(unsigned u) { return __uint_as_float(u << 16); }
DI float bfhi(unsigned u) { return __uint_as_float(u & 0xffff0000u); }
DI int lane_id() { int x; asm volatile("v_mbcnt_lo_u32_b32 %0, -1, 0\n\tv_mbcnt_hi_u32_b32 %0, -1, %0" : "=v"(x)); return x; }
template <int M> DI int sx_i(int v) {
    if constexpr (M < 32) return __builtin_amdgcn_ds_swizzle(v, (M << 10) | 0x1f);
    else return __builtin_amdgcn_ds_bpermute((lane_id() ^ 32) << 2, v);
}
template <int M> DI float sx_f(float v) { return __int_as_float(sx_i<M>(__float_as_int(v))); }
DI float lane_get_f(float v, int src) { return __int_as_float(__builtin_amdgcn_ds_bpermute(src << 2, __float_as_int(v))); }
DI float wave_sum(float v) { v += sx_f<32>(v); v += sx_f<16>(v); v += sx_f<8>(v); v += sx_f<4>(v); v += sx_f<2>(v); v += sx_f<1>(v); return v; }
DI float wave_max(float v) { v = fmaxf(v, sx_f<32>(v)); v = fmaxf(v, sx_f<16>(v)); v = fmaxf(v, sx_f<8>(v)); v = fmaxf(v, sx_f<4>(v)); v = fmaxf(v, sx_f<2>(v)); v = fmaxf(v, sx_f<1>(v)); return v; }
DI float half_sum(float v) { v += sx_f<16>(v); v += sx_f<8>(v); v += sx_f<4>(v); v += sx_f<2>(v); v += sx_f<1>(v); return v; }
DI float sigmoidf_(float x) { return __builtin_amdgcn_rcpf(1.f + __expf(-x)); }
DI unsigned char* uniform_ptr(unsigned char* q) {
    const unsigned long long w = (unsigned long long)q;
    const unsigned lo = __builtin_amdgcn_readfirstlane((unsigned)w), hi = __builtin_amdgcn_readfirstlane((unsigned)(w >> 32));
    return (unsigned char*)(((unsigned long long)hi << 32) | lo);
}
DI int opqs(int x) { asm volatile("" : "+s"(x)); return x; }
DI int opq(int x) { asm volatile("" : "+v"(x)); return x; }

DI int swz(int row, int slot) { return row * 128 + ((slot ^ ((row >> 1) & 7)) << 4); }
DI int crow(int reg, int lane) { return (reg & 3) + 8 * (reg >> 2) + 4 * (lane >> 5); }

template <class P>
DI void gemm_tile(const P& pr, unsigned char* smem, int tid) {
    const int lane = tid & 63, wid = tid >> 6, wr = wid >> 1, wc = wid & 1;
    const bf16_t* abase = pr.a_base();
    const bf16_t* bbase = pr.b_base();
    const int kdim = pr.kt() * 64;
    int gao[4], gbo[4];
#pragma unroll
    for (int i = 0; i < 4; ++i) {
        const int row = (tid >> 3) + 32 * i, sl = (tid & 7) ^ ((row >> 1) & 7);
        const int o = pr.a_off(row);
        gao[i] = (o >= 0 ? o : 0) + sl * 8; gbo[i] = row * kdim + sl * 8;
    }
#define GLDS(buf, kt) do { _Pragma("unroll") for (int i = 0; i < 4; ++i) { \
        __builtin_amdgcn_global_load_lds((const unsigned*)(abase + gao[i] + (kt) * 64), (__attribute__((address_space(3))) unsigned*)(smem + (buf) * 32768 + (i * 256 + wid * 64) * 16), 16, 0, 0); \
        __builtin_amdgcn_global_load_lds((const unsigned*)(bbase + gbo[i] + (kt) * 64), (__attribute__((address_space(3))) unsigned*)(smem + (buf) * 32768 + 16384 + (i * 256 + wid * 64) * 16), 16, 0, 0); } } while (0)
#define DMA_WAIT_SYNC() do { asm volatile("s_waitcnt vmcnt(0)" ::: "memory"); __syncthreads(); } while (0)
#define COMPUTE(buf) do { const unsigned char* As = smem + (buf) * 32768; const unsigned char* Bs = As + 16384; \
        _Pragma("unroll") for (int ks = 0; ks < 4; ++ks) { const int slot = ks * 2 + (lane >> 5); \
            const bf16x8 a0 = *(const bf16x8*)(As + swz(wr * 64 + (lane & 31), slot)); const bf16x8 a1 = *(const bf16x8*)(As + swz(wr * 64 + 32 + (lane & 31), slot)); \
            const bf16x8 b0 = *(const bf16x8*)(Bs + swz(wc * 64 + (lane & 31), slot)); const bf16x8 b1 = *(const bf16x8*)(Bs + swz(wc * 64 + 32 + (lane & 31), slot)); \
            acc[0][0] = __builtin_amdgcn_mfma_f32_32x32x16_bf16(a0, b0, acc[0][0], 0, 0, 0); acc[0][1] = __builtin_amdgcn_mfma_f32_32x32x16_bf16(a0, b1, acc[0][1], 0, 0, 0); \
            acc[1][0] = __builtin_amdgcn_mfma_f32_32x32x16_bf16(a1, b0, acc[1][0], 0, 0, 0); acc[1][1] = __builtin_amdgcn_mfma_f32_32x32x16_bf16(a1, b1, acc[1][1], 0, 0, 0); } } while (0)
    f32x16 acc[2][2];
#pragma unroll
    for (int a = 0; a < 2; ++a)
#pragma unroll
        for (int b = 0; b < 2; ++b)
#pragma unroll
            for (int r = 0; r < 16; ++r) acc[a][b][r] = 0.f;
    const int KT = pr.kt();
    __syncthreads();
    GLDS(0, 0);
    DMA_WAIT_SYNC();
    for (int kt = 0; kt < KT; kt += 2) {
        GLDS(1, kt + 1);
        COMPUTE(0);
        DMA_WAIT_SYNC();
        if (kt + 2 < KT) GLDS(0, kt + 2);
        COMPUTE(1);
        DMA_WAIT_SYNC();
    }
#undef GLDS
#undef DMA_WAIT_SYNC
#undef COMPUTE
    pr.epi(acc, wr, wc, lane, smem + wid * 8192);
}

template <class P>
DI void convert_tile(const P& pr, bf16_t* dst, int kdim, int kt, unsigned char* smem, int tid) {
    unsigned char* Bs = smem;
    const int ng = tid & 31, kg = tid >> 5;
    int width = 0;
    const float* bp = pr.b_col(ng >> 3, width);
    const int cig = (ng & 7) * 4;
    const bool bvalid = cig < width;
    const int ldb = pr.ldb();
    bp += cig + (size_t)(kt * 64 + kg * 8) * ldb;
    f32x4 rb[8];
#pragma unroll
    for (int kk = 0; kk < 8; ++kk) rb[kk] = bvalid ? *(const f32x4*)(bp + (size_t)kk * ldb) : (f32x4){0.f, 0.f, 0.f, 0.f};
    __syncthreads();
#pragma unroll
    for (int j = 0; j < 4; ++j) {
        u32x4 v = {pk2(rb[0][j], rb[1][j]), pk2(rb[2][j], rb[3][j]), pk2(rb[4][j], rb[5][j]), pk2(rb[6][j], rb[7][j])};
        *(u32x4*)(Bs + swz(ng * 4 + j, kg)) = v;
    }
    __syncthreads();
#pragma unroll
    for (int i = 0; i < 4; ++i) {
        const int n = (tid >> 3) + 32 * i;
        *(u32x4*)(dst + (size_t)n * kdim + kt * 64 + (tid & 7) * 8) = *(const u32x4*)(Bs + swz(n, tid & 7));
    }
}

template <int NC> DI void stage_put(unsigned char* wl, int mi, int ni, int r, int lane, float v) { *(bf16_t*)(wl + ((mi * 32 + crow(r, lane)) * NC + ni * 32 + (lane & 31)) * 2) = f2bf(v); }
template <int NC, class RowPtr> DI void stage_flush(unsigned char* wl, int lane, RowPtr rp) {
    constexpr int CH = NC / 8, RPI = 64 / CH, NIT = 64 / RPI;
#pragma unroll
    for (int i = 0; i < NIT; ++i) {
        const int row = lane / CH + RPI * i, ch = lane % CH;
        const u32x4 d = *(const u32x4*)(wl + (row * NC + ch * 8) * 2);
        bf16_t* dst = rp(row);
        if (dst) *(u32x4*)(dst + ch * 8) = d;
    }
}

struct HybIn {
    const Params* p; int j, tm, tn;
    DI int kt() const { return 16; }
    DI int ldb() const { return HYB_IN; }
    DI const bf16_t* a_base() const { return (const bf16_t*)(p->ws + WS_H); }
    DI int a_off(int r) const { return (tm * 128 + r) * 1024; }
    DI static void pair_cols(int pr, int ni, int& base, int& width) {
        width = 32;
        if (pr < 8) base = 64 * pr + 32 * ni;
        else if (pr == 8) base = 512 + 32 * ni;
        else if (pr == 9) base = 576 + 32 * ni;
        else if (pr < 18) base = 640 + 64 * (pr - 10) + 32 * ni;
        else if (pr == 18) base = 1152 + 32 * ni;
        else if (pr == 19) { base = 1216; width = ni == 0 ? 8 : 0; }
        else if (pr < 28) base = 1224 + 64 * (pr - 20) + 32 * ni;
        else base = (ni == 0 ? 1736 : 2248) + 32 * (pr - 28);
    }
    DI const float* b_col(int g, int& width) const { int base; pair_cols(tn * 2 + (g >> 1), g & 1, base, width); return p->hy_w_in + (size_t)j * 1024 * HYB_IN + base; }
    DI const bf16_t* b_base() const { return (const bf16_t*)(p->ws + WS_WHYB) + (size_t)(j * 22 + tn) * 128 * 1024; }
    DI void epi(f32x16 (&acc)[2][2], int wr, int wc, int lane, unsigned char* wl) const {
        const int pr = tn * 2 + wc, c = lane & 31;
        const int t0 = tm * 128 + wr * 64;
        unsigned char* ws = p->ws;
        const float* ropec = (const float*)(ws + WS_ROPEC);
        const float* ropes = (const float*)(ws + WS_ROPES);
        if (pr < 9 || (pr >= 10 && pr < 19)) {
            const bool donorm = pr < 9;
            const float* gam = pr < 8 ? p->hy_q_norm + j * 64 : p->hy_k_norm + j * 64;
            bf16_t* ob; int ld, cb;
            if (pr < 8) { ob = (bf16_t*)(ws + WS_Q); ld = 512; cb = 64 * pr; }
            else if (pr == 8) { ob = (bf16_t*)(ws + WS_K); ld = 64; cb = 0; }
            else if (pr < 18) { ob = (bf16_t*)(ws + WS_IQ); ld = 512; cb = 64 * (pr - 10); }
            else { ob = (bf16_t*)(ws + WS_IK); ld = 64; cb = 0; }
            float g1 = 1.f, g2 = 1.f;
            if (donorm) { g1 = gam[c]; g2 = gam[c + 32]; }
#pragma unroll
            for (int mi = 0; mi < 2; ++mi)
#pragma unroll
                for (int r = 0; r < 16; ++r) {
                    float x1 = acc[mi][0][r], x2 = acc[mi][1][r];
                    const int t = t0 + mi * 32 + crow(r, lane), pos = t & (S - 1);
                    if (donorm) { float ss = half_sum(x1 * x1 + x2 * x2); float rstd = rsqrtf(ss * (1.f / 64.f) + EPS); x1 *= rstd * g1; x2 *= rstd * g2; }
                    const float cs = ropec[pos * 32 + c], sn = ropes[pos * 32 + c];
                    stage_put<64>(wl, mi, 0, r, lane, x1 * cs - x2 * sn);
                    stage_put<64>(wl, mi, 1, r, lane, x2 * cs + x1 * sn);
                }
            stage_flush<64>(wl, lane, [&](int row) { return ob + (size_t)(t0 + row) * ld + cb; });
        } else if (pr == 9) {
            bf16_t* ob = (bf16_t*)(ws + WS_V);
#pragma unroll
            for (int mi = 0; mi < 2; ++mi)
#pragma unroll
                for (int ni = 0; ni < 2; ++ni)
#pragma unroll
                    for (int g4 = 0; g4 < 4; ++g4) {
                        const int t = t0 + mi * 32 + 8 * g4 + 4 * (lane >> 5), pos = t & (S - 1), bb = t >> 11;
                        u32x2 o = {pk2(acc[mi][ni][4 * g4], acc[mi][ni][4 * g4 + 1]), pk2(acc[mi][ni][4 * g4 + 2], acc[mi][ni][4 * g4 + 3])};
                        *(u32x2*)(ob + ((size_t)(bb * 64 + ni * 32 + c)) * S + pos) = o;
                    }
        } else if (pr == 19) {
            float* ob = (float*)(ws + WS_IW);
            if (c < 8) {
#pragma unroll
                for (int mi = 0; mi < 2; ++mi)
#pragma unroll
                    for (int r = 0; r < 16; ++r) { const int t = t0 + mi * 32 + crow(r, lane); ob[(size_t)t * 8 + c] = acc[mi][0][r] * (0.125f * 0.35355339059327373f); }
            }
        } else if (pr < 28) {
            bf16_t* ob = (bf16_t*)(ws + WS_BG); const int cb = 64 * (pr - 20);
#pragma unroll
            for (int mi = 0; mi < 2; ++mi)
#pragma unroll
                for (int r = 0; r < 16; ++r) { stage_put<64>(wl, mi, 0, r, lane, acc[mi][0][r]); stage_put<64>(wl, mi, 1, r, lane, acc[mi][1][r]); }
            stage_flush<64>(wl, lane, [&](int row) { return ob + (size_t)(t0 + row) * 512 + cb; });
        } else {
            bf16_t* ob = (bf16_t*)(ws + WS_Z); const int cb = 32 * (pr - 28);
#pragma unroll
            for (int mi = 0; mi < 2; ++mi)
#pragma unroll
                for (int r = 0; r < 16; ++r) stage_put<32>(wl, mi, 0, r, lane, acc[mi][0][r] * acc[mi][1][r]);
            stage_flush<32>(wl, lane, [&](int row) { return ob + (size_t)(t0 + row) * 512 + cb; });
        }
    }
};


struct HybCols8 {
    const Params* p; int j, tm, tn;
    DI int ldb() const { return HYB_IN; }
    DI const float* b_col(int g, int& width) const {
        const int u = tn >> 1, bj = tn & 1; int base; width = 32;
        if (u < 2) base = 64 * (4 * u + g) + 32 * bj;
        else if (u < 4) base = 640 + 64 * (4 * (u - 2) + g) + 32 * bj;
        else if (u == 4) { if (g == 0) base = 512 + 32 * bj; else if (g == 1) base = 576 + 32 * bj; else if (g == 2) base = 1152 + 32 * bj; else { base = 1216; width = bj == 0 ? 8 : 0; } }
        else if (u < 7) base = 1224 + (u - 5) * 256 + 128 * bj + 32 * g;
        else base = (bj == 0 ? 1736 : 2248) + (u - 7) * 128 + 32 * g;
        return p->hy_w_in + (size_t)j * 1024 * HYB_IN + base;
    }
};

struct MlIn {
    const Params* p; int j, tm, tn;
    DI int kt() const { return 16; }
    DI int ldb() const { return ML_IN; }
    DI const bf16_t* a_base() const { return (const bf16_t*)(p->ws + WS_H); }
    DI int a_off(int r) const { return (tm * 128 + r) * 1024; }
    DI const float* b_col(int g, int& width) const {
        const int pr = tn * 2 + (g >> 1), ni = g & 1; int base; width = 32;
        if (pr < 32) base = 64 * pr + 32 * ni;
        else if (pr == 32) { base = 2048 + 8 * ni; width = 8; }
        else if (pr < 49) base = 2064 + 64 * (pr - 33) + 32 * ni;
        else { base = 0; width = 0; }
        return p->ml_w_in + (size_t)j * 1024 * ML_IN + base;
    }
    DI const bf16_t* b_base() const { return (const bf16_t*)(p->ws + WS_WML) + (size_t)(j * 25 + tn) * 128 * 1024; }
    DI void epi(f32x16 (&acc)[2][2], int wr, int wc, int lane, unsigned char* wl) const {
        const int pr = tn * 2 + wc, c = lane & 31;
        const int t0 = tm * 128 + wr * 64;
        unsigned char* ws = p->ws;
        if (pr < 16) {
            bf16_t* ob; int cb; float sc = 1.f;
            if (pr < 8) { ob = (bf16_t*)(ws + WS_MQ); cb = 64 * pr; sc = 0.125f; }
            else { ob = (bf16_t*)(ws + WS_MK); cb = 64 * (pr - 8); }
#pragma unroll
            for (int mi = 0; mi < 2; ++mi)
#pragma unroll
                for (int r = 0; r < 16; ++r) { stage_put<64>(wl, mi, 0, r, lane, acc[mi][0][r] * sc); stage_put<64>(wl, mi, 1, r, lane, acc[mi][1][r] * sc); }
            stage_flush<64>(wl, lane, [&](int row) { return ob + (size_t)(t0 + row) * 512 + cb; });
        }
        if (pr >= 8 && pr < 32) {
            bf16_t* ob; int nrow, hd, r0;
            if (pr < 16) { ob = (bf16_t*)(ws + WS_MKT); nrow = 64; hd = pr - 8; r0 = 0; }
            else { ob = (bf16_t*)(ws + WS_MV); nrow = 128; hd = (pr - 16) >> 1; r0 = 64 * ((pr - 16) & 1); }
#pragma unroll
            for (int mi = 0; mi < 2; ++mi)
#pragma unroll
                for (int ni = 0; ni < 2; ++ni)
#pragma unroll
                    for (int g4 = 0; g4 < 4; ++g4) {
                        const int t = t0 + mi * 32 + 8 * g4 + 4 * (lane >> 5), pos = t & (S - 1), bb = t >> 11;
                        u32x2 o = {pk2(acc[mi][ni][4 * g4], acc[mi][ni][4 * g4 + 1]), pk2(acc[mi][ni][4 * g4 + 2], acc[mi][ni][4 * g4 + 3])};
                        *(u32x2*)(ob + ((size_t)((bb * 8 + hd) * nrow + r0 + ni * 32 + c)) * S + pos) = o;
                    }
        } else if (pr == 32) {
            if (c < 8) {
                float* oi = (float*)(ws + WS_MIG); float* of = (float*)(ws + WS_MFG);
                const float bi = p->ml_b_gates[j * 16 + c], bfg = p->ml_b_gates[j * 16 + 8 + c];
#pragma unroll
                for (int mi = 0; mi < 2; ++mi)
#pragma unroll
                    for (int r = 0; r < 16; ++r) {
                        const int t = t0 + mi * 32 + crow(r, lane);
                        oi[(size_t)t * 8 + c] = acc[mi][0][r] + bi;
                        const float f = acc[mi][1][r] + bfg;
                        of[(size_t)t * 8 + c] = fminf(f, 0.f) - log1pf(__expf(-fabsf(f)));
                    }
            }
        } else if (pr >= 33 && pr < 49) {
            bf16_t* ob = (bf16_t*)(ws + WS_MOG); const int cb = 64 * (pr - 33);
#pragma unroll
            for (int mi = 0; mi < 2; ++mi)
#pragma unroll
                for (int r = 0; r < 16; ++r) { stage_put<64>(wl, mi, 0, r, lane, sigmoidf_(acc[mi][0][r])); stage_put<64>(wl, mi, 1, r, lane, sigmoidf_(acc[mi][1][r])); }
            stage_flush<64>(wl, lane, [&](int row) { return ob + (size_t)(t0 + row) * 1024 + cb; });
        }
    }
};


struct MlCols8 {
    const Params* p; int j, tm, tn;
    DI int ldb() const { return ML_IN; }
    DI const float* b_col(int g, int& width) const {
        const int u = tn >> 1, bj = tn & 1; int base; width = 32;
        if (tn == 24) { base = 2048 + 8 * (g & 1); width = g < 2 ? 8 : 0; }
        else if (u < 2) base = 64 * (4 * u + g) + 32 * bj;
        else if (u < 4) base = 512 + 64 * (4 * (u - 2) + g) + 32 * bj;
        else if (u < 8) base = 1024 + (2 * (u - 4) + bj) * 128 + 32 * g;
        else base = 2064 + (u - 8) * 256 + 128 * bj + 32 * g;
        return p->ml_w_in + (size_t)j * 1024 * ML_IN + base;
    }
};
struct MlGates {
    const Params* p; int j, tm;
    DI int kt() const { return 16; }
    DI const bf16_t* a_base() const { return (const bf16_t*)(p->ws + WS_H); }
    DI int a_off(int r) const { return (tm * 128 + r) * 1024; }
    DI const bf16_t* b_base() const { return (const bf16_t*)(p->ws + WS_WML) + (size_t)(j * 25 + 24) * 128 * 1024; }
    DI void epi(f32x16 (&acc)[2][2], int wr, int wc, int lane, unsigned char* wl) const {
        const int c = lane & 31, t0 = tm * 128 + wr * 64;
        if (wc == 0 && c < 8) {
            float* oi = (float*)(p->ws + WS_MIG); float* of = (float*)(p->ws + WS_MFG);
            const float bi = p->ml_b_gates[j * 16 + c], bfg = p->ml_b_gates[j * 16 + 8 + c];
#pragma unroll
            for (int mi = 0; mi < 2; ++mi)
#pragma unroll
                for (int r = 0; r < 16; ++r) {
                    const int t = t0 + mi * 32 + crow(r, lane);
                    oi[(size_t)t * 8 + c] = acc[mi][0][r] + bi;
                    const float f = acc[mi][1][r] + bfg;
                    of[(size_t)t * 8 + c] = fminf(f, 0.f) - log1pf(__expf(-fabsf(f)));
                }
        }
    }
};

struct OutProj {
    const Params* p; const float* W; const float* src; int layer, tm, tn;
    DI int kt() const { return 16; }
    DI int ldb() const { return 1024; }
    DI const bf16_t* a_base() const { return (const bf16_t*)(p->ws + WS_YMIX); }
    DI int a_off(int r) const { return (tm * 128 + r) * 1024; }
    DI const float* b_col(int g, int& width) const { width = 32; return W + tn * 128 + g * 32; }
    DI const bf16_t* b_base() const { return (const bf16_t*)(p->ws + WS_WOUT) + (size_t)(layer * 8 + tn) * 128 * 1024; }
    DI void epi(f32x16 (&acc)[2][2], int wr, int wc, int lane, unsigned char* wl) const {
        const int c = lane & 31, t0 = tm * 128 + wr * 64, wid = wr * 2 + wc;
        float* fl = (float*)(wl + wid * 8192);
#pragma unroll
        for (int mi = 0; mi < 2; ++mi)
#pragma unroll
            for (int ni = 0; ni < 2; ++ni)
#pragma unroll
                for (int r = 0; r < 16; ++r) fl[(mi * 32 + crow(r, lane)) * 64 + ni * 32 + c] = acc[mi][ni][r];
        const float* mod = (const float*)(p->ws + WS_MOD) + (size_t)layer * 8 * 6144;
        const int ch = lane & 15, n = tn * 128 + wc * 64 + ch * 4;
        const f32x4 g = *(const f32x4*)(mod + (t0 >> 11) * 6144 + 2048 + n);
        float* part = (float*)(p->ws + WS_PART);
#pragma unroll 4
        for (int i = 0; i < 16; ++i) {
            const int row = (lane >> 4) + 4 * i, t = t0 + row;
            const f32x4 a = *(const f32x4*)(fl + row * 64 + ch * 4);
            const f32x4 o = *(const f32x4*)(src + (size_t)t * 1024 + n) + g * a;
            *(f32x4*)(p->out + (size_t)t * 1024 + n) = o;
            float ss = o[0] * o[0] + o[1] * o[1] + o[2] * o[2] + o[3] * o[3];
            ss += sx_f<1>(ss); ss += sx_f<2>(ss); ss += sx_f<4>(ss); ss += sx_f<8>(ss);
            if (ch == 0) part[(size_t)t * 16 + tn * 2 + wc] = ss;
        }
    }
};

struct Moe1 {
    const Params* p; int layer, e, mt, nt, cnt, roff;
    DI int kt() const { return 16; }
    DI int ldb() const { return DEXP; }
    DI const bf16_t* a_base() const { return (const bf16_t*)(p->ws + WS_H); }
    DI int a_off(int r) const {
        const int rr = mt * 128 + r; if (rr >= cnt) return -1;
        const int a = ((const int*)(p->ws + WS_ELIST))[(size_t)e * NASG + rr];
        return (a >> 1) * 1024;
    }
    DI const float* b_col(int g, int& width) const {
        width = 32;
        const float* base = (nt & 1) ? p->moe_w_up : p->moe_w_gate;
        return base + ((size_t)layer * NEXP + e) * (size_t)(D * DEXP) + 128 * (nt >> 1) + 32 * g;
    }
    DI const bf16_t* b_base() const { return (const bf16_t*)(p->ws + WS_WM1) + (size_t)((layer * NEXP + e) * 8 + nt) * 128 * 1024; }
    DI void epi(f32x16 (&acc)[2][2], int wr, int wc, int lane, unsigned char* wl) const {
        const int c = lane & 31, pr = nt * 2 + wc;
        bf16_t* ob = (bf16_t*)(p->ws + WS_H1);
#pragma unroll
        for (int mi = 0; mi < 2; ++mi)
#pragma unroll
            for (int r = 0; r < 16; ++r) {
                const float g = acc[mi][0][r], u = acc[mi][1][r];
                stage_put<32>(wl, mi, 0, r, lane, g / (1.f + __expf(-g)) * u);
            }
        const int rb = mt * 128 + wr * 64;
        stage_flush<32>(wl, lane, [&](int row) { return rb + row < cnt ? ob + (size_t)(roff + rb + row) * 512 + 32 * pr : (bf16_t*)nullptr; });
    }
};

struct Moe2 {
    const Params* p; int layer, e, mt, nt, cnt, roff;
    DI int kt() const { return 8; }
    DI int ldb() const { return D; }
    DI const bf16_t* a_base() const { return (const bf16_t*)(p->ws + WS_H1); }
    DI int a_off(int r) const { const int rr = mt * 128 + r; if (rr >= cnt) return -1; return (roff + rr) * 512; }
    DI const float* b_col(int g, int& width) const { width = 32; return p->moe_w_down + ((size_t)layer * NEXP + e) * (size_t)(DEXP * D) + nt * 128 + g * 32; }
    DI const bf16_t* b_base() const { return (const bf16_t*)(p->ws + WS_WM2) + (size_t)((layer * NEXP + e) * 8 + nt) * 128 * 512; }
    DI void epi(f32x16 (&acc)[2][2], int wr, int wc, int lane, unsigned char* wl) const {
        const int c = lane & 31;
        bf16_t* ob = (bf16_t*)(p->ws + WS_Y);
        const int* el = (const int*)(p->ws + WS_ELIST) + (size_t)e * NASG;
#pragma unroll
        for (int mi = 0; mi < 2; ++mi)
#pragma unroll
            for (int r = 0; r < 16; ++r) { stage_put<64>(wl, mi, 0, r, lane, acc[mi][0][r]); stage_put<64>(wl, mi, 1, r, lane, acc[mi][1][r]); }
        const int rb = mt * 128 + wr * 64;
        stage_flush<64>(wl, lane, [&](int row) { return rb + row < cnt ? ob + (size_t)el[rb + row] * 1024 + nt * 128 + wc * 64 : (bf16_t*)nullptr; });
    }
};

DI void convert_moe_layers(const Params& p, int l0, int l1, unsigned char* smem, int bid, int nb, int tid) {
    const int PER = 32 * 8 * 16 + 32 * 8 * 8, total = (l1 - l0) * PER;
    for (int item = bid; item < total; item += nb) {
        const int l = l0 + item / PER; int ci = item % PER;
        if (ci < 4096) { const int kt = ci & 15, nt = (ci >> 4) & 7, e = ci >> 7; Moe1 pr{&p, l, e, 0, nt, 0, 0}; convert_tile(pr, (bf16_t*)(p.ws + WS_WM1) + (size_t)((l * 32 + e) * 8 + nt) * 128 * 1024, 1024, kt, smem, tid); }
        else { ci -= 4096; const int kt = ci & 7, nt = (ci >> 3) & 7, e = ci >> 6; Moe2 pr{&p, l, e, 0, nt, 0, 0}; convert_tile(pr, (bf16_t*)(p.ws + WS_WM2) + (size_t)((l * 32 + e) * 8 + nt) * 128 * 512, 512, kt, smem, tid); }
    }
    __syncthreads();
}

DI void phase_init(const Params& p, unsigned char* smem, int bid, int nb, int tid) {
    float* sc = (float*)smem;
    float* red = (float*)(smem + 32768);
    const int NMOD = DEPTH * 96, NROPE = 256;
    const int C_HYB = 2 * 22 * 16, C_ML = 2 * 25 * 16, C_OUT = 4 * 8 * 16;
    for (int ci = bid; ci < C_HYB + C_ML + C_OUT; ci += nb) {
        int c2 = ci;
        if (c2 < C_HYB) { const int kt = c2 & 15, tn = (c2 >> 4) % 22, j = (c2 >> 4) / 22; HybCols8 pr{&p, j, 0, tn}; convert_tile(pr, (bf16_t*)(p.ws + WS_WHYB) + (size_t)(j * 22 + tn) * 128 * 1024, 1024, kt, smem, tid); continue; }
        c2 -= C_HYB;
        if (c2 < C_ML) { const int kt = c2 & 15, tn = (c2 >> 4) % 25, j = (c2 >> 4) / 25; MlCols8 pr{&p, j, 0, tn}; convert_tile(pr, (bf16_t*)(p.ws + WS_WML) + (size_t)(j * 25 + tn) * 128 * 1024, 1024, kt, smem, tid); continue; }
        c2 -= C_ML;
        { const int kt = c2 & 15, tn = (c2 >> 4) & 7, l = c2 >> 7; const float* W = ((l & 1) ? p.ml_w_out : p.hy_w_out) + (size_t)(l >> 1) * 1024 * 1024;
            OutProj pr{&p, W, nullptr, l, 0, tn}; convert_tile(pr, (bf16_t*)(p.ws + WS_WOUT) + (size_t)(l * 8 + tn) * 128 * 1024, 1024, kt, smem, tid); }
    }
    for (int item = bid; item < NMOD; item += nb) {
        __syncthreads();
        for (int i = tid; i < 8 * 1024; i += 256) { const float v = p.c[i]; sc[i] = v / (1.f + __expf(-v)); }
        __syncthreads();
        const int l = item / 96, jb = item % 96, cq = tid & 15, ksl = tid >> 4;
        const float* w = p.ada_w + (size_t)l * 1024 * 6144 + jb * 64 + cq * 4;
        f32x4 acc[8];
#pragma unroll
        for (int b = 0; b < 8; ++b) acc[b] = (f32x4){0.f, 0.f, 0.f, 0.f};
        for (int ii = 0; ii < 64; ++ii) {
            const int i = ksl * 64 + ii;
            const f32x4 wv = *(const f32x4*)(w + (size_t)i * 6144);
#pragma unroll
            for (int b = 0; b < 8; ++b) acc[b] += wv * sc[b * 1024 + i];
        }
#pragma unroll
        for (int b = 0; b < 8; ++b) *(f32x4*)(red + (ksl * 8 + b) * 64 + cq * 4) = acc[b];
        __syncthreads();
        for (int o = tid; o < 512; o += 256) {
            const int b = o >> 6, cc = o & 63; float s = 0.f;
            for (int k = 0; k < 16; ++k) s += red[(k * 8 + b) * 64 + cc];
            ((float*)(p.ws + WS_MOD))[((size_t)l * 8 + b) * 6144 + jb * 64 + cc] = s + p.ada_b[l * 6144 + jb * 64 + cc];
        }
    }
    for (int item = bid; item < NROPE + 1; item += nb) {
        if (item < NROPE) {
            const int idx = item * 256 + tid;
            const int pos = idx >> 5, i = idx & 31;
            const float inv = 1.0f / powf(10000.0f, (float)(2 * i) / 64.0f);
            const float ang = (float)pos * inv;
            ((float*)(p.ws + WS_ROPEC))[idx] = cosf(ang);
            ((float*)(p.ws + WS_ROPES))[idx] = sinf(ang);
        } else {
            if (tid < DEPTH * 32) ((int*)(p.ws + WS_ECNT))[tid * ECS] = 0;
        }
    }
    __syncthreads();
    convert_moe_layers(p, 0, 1, smem, bid, nb, tid);
}

DI void phase_norm(const Params& p, int layer, const float* src, int bid, int nb, int tid) {
    const int lane = tid & 63, wid = tid >> 6;
    const float* mod = (const float*)(p.ws + WS_MOD) + (size_t)layer * 8 * 6144;
    const float* gam = p.norm_mix + layer * 1024;
    bf16_t* H = (bf16_t*)(p.ws + WS_H);
    for (int item = bid; item < T / 4; item += nb) {
        const int t = item * 4 + wid, b = t >> 11;
        const float* xr = src + (size_t)t * 1024;
        f32x4 v[4]; float ss = 0.f;
#pragma unroll
        for (int i = 0; i < 4; ++i) { v[i] = *(const f32x4*)(xr + (lane + 64 * i) * 4); ss += v[i][0] * v[i][0] + v[i][1] * v[i][1] + v[i][2] * v[i][2] + v[i][3] * v[i][3]; }
        ss = wave_sum(ss);
        const float rstd = rsqrtf(ss * (1.f / 1024.f) + EPS);
#pragma unroll
        for (int i = 0; i < 4; ++i) {
            const int c0 = (lane + 64 * i) * 4;
            const f32x4 g = *(const f32x4*)(gam + c0), sh = *(const f32x4*)(mod + b * 6144 + c0), sc = *(const f32x4*)(mod + b * 6144 + 1024 + c0);
            f32x4 h = v[i] * rstd * g * (sc + 1.f) + sh;
            u32x2 o = {pk2(h[0], h[1]), pk2(h[2], h[3])};
            *(u32x2*)(H + (size_t)t * 1024 + c0) = o;
        }
    }
}

DI void phase_ffn_norm_router(const Params& p, int layer, unsigned char* smem, int bid, int nb, int tid) {
    float* rstd_s = (float*)smem;
    float* lg = (float*)(smem + 512);
    float* hs = (float*)(smem + 512 + 32 * 37 * 4);
    float* wcs = (float*)(smem + 5248 + 2 * 32 * 65 * 4);
    float* part = (float*)(smem + 42368);
    float* gpart = (float*)(smem + 59264);
    const int lane = tid & 63, og = __builtin_amdgcn_readfirstlane(tid >> 6), tok = lane & 31, kh = lane >> 5;
    const float* mod = (const float*)(p.ws + WS_MOD) + (size_t)layer * 8 * 6144;
    const float* gam = p.norm_ffn + layer * 1024;
    const float* wg = p.moe_w_group + (size_t)layer * 1024 * 4;
    const float* we = p.moe_w_expert + (size_t)layer * 1024 * 32;
    bf16_t* H = (bf16_t*)(p.ws + WS_H);
    int* ecnt = (int*)(p.ws + WS_ECNT) + layer * 32 * ECS;
    int* elist = (int*)(p.ws + WS_ELIST);
    float* ew = (float*)(p.ws + WS_EW);
    for (int item = bid; item < T / 32; item += nb) {
        const int t0 = item * 32, b = t0 >> 11;
        __syncthreads();
        if (tid < 32) {
            const f32x4* pp = (const f32x4*)((const float*)(p.ws + WS_PART) + (size_t)(t0 + tid) * 16);
            const f32x4 a = pp[0], b4 = pp[1], c4 = pp[2], d4 = pp[3];
            const float ss = ((a[0] + a[1]) + (a[2] + a[3])) + ((b4[0] + b4[1]) + (b4[2] + b4[3])) + ((c4[0] + c4[1]) + (c4[2] + c4[3])) + ((d4[0] + d4[1]) + (d4[2] + d4[3]));
            rstd_s[tid] = rsqrtf(ss * (1.f / 1024.f) + EPS);
        }
        const int stok = tid >> 3, sk0 = (tid & 7) * 8;
        const float* xrow = p.out + (size_t)(t0 + stok) * 1024 + sk0;
        const float* mrow = mod + b * 6144 + sk0;
        f32x4 xa[2], ga[2], sha[2], sca[2], wa[3], xb[2], gb2[2], shb[2], scb[2], wb2[3];
#define FFN_LOAD(xv, gv, shv, scv, wv, k0) do { _Pragma("unroll") for (int q = 0; q < 2; ++q) { xv[q] = *(const f32x4*)(xrow + (k0) + 4 * q); gv[q] = *(const f32x4*)(gam + sk0 + (k0) + 4 * q); \
            shv[q] = *(const f32x4*)(mrow + 3072 + (k0) + 4 * q); scv[q] = *(const f32x4*)(mrow + 4096 + (k0) + 4 * q); } \
            wv[0] = *(const f32x4*)(we + (k0) * 32 + tid * 4); wv[1] = *(const f32x4*)(we + (k0) * 32 + 1024 + tid * 4); wv[2] = *(const f32x4*)(wg + (k0) * 4 + (tid & 63) * 4); } while (0)
#define FFN_STEP(xv, gv, shv, scv, wv, kc) do { const int k0 = (kc) * 64; float* hb = hs + ((kc) & 1) * (32 * 65); float* wb = wcs + ((kc) & 1) * (64 * 40); u32x4 ho; \
            _Pragma("unroll") for (int q = 0; q < 2; ++q) { const f32x4 h = xv[q] * srstd * gv[q] * (scv[q] + 1.f) + shv[q]; ho[2 * q] = pk2(h[0], h[1]); ho[2 * q + 1] = pk2(h[2], h[3]); \
                float* hp = hb + stok * 65 + sk0 + 4 * q; hp[0] = h[0]; hp[1] = h[1]; hp[2] = h[2]; hp[3] = h[3]; } \
            *(u32x4*)(H + (size_t)(t0 + stok) * 1024 + k0 + sk0) = ho; \
            *(f32x4*)(wb + (tid >> 3) * 40 + 4 + (tid & 7) * 4) = wv[0]; *(f32x4*)(wb + (32 + (tid >> 3)) * 40 + 4 + (tid & 7) * 4) = wv[1]; if (tid < 64) *(f32x4*)(wb + tid * 40) = wv[2]; \
            if ((kc) + 2 < 16) FFN_LOAD(xv, gv, shv, scv, wv, k0 + 128); \
            __syncthreads(); \
            { const float* ha = hb + tok * 65 + og * 16 + kh; const float* wbp = wb + (og * 16 + kh) * 40 + 4 + tok; float av[8], bv[8]; \
              _Pragma("unroll") for (int m = 0; m < 8; ++m) { av[m] = ha[2 * m]; bv[m] = wbp[2 * m * 40]; } \
              const float* hg = hb + tok * 65 + og * 16 + kh * 8; const float* wgp = wb + (og * 16 + kh * 8) * 40; \
              _Pragma("unroll") for (int i = 0; i < 8; ++i) { const float hv = hg[i]; gacc += *(const f32x4*)(wgp + i * 40) * hv; } \
              _Pragma("unroll") for (int m = 0; m < 8; ++m) eacc = __builtin_amdgcn_mfma_f32_32x32x2f32(av[m], bv[m], eacc, 0, 0, 0); } } while (0)
        FFN_LOAD(xa, ga, sha, sca, wa, 0);
        FFN_LOAD(xb, gb2, shb, scb, wb2, 64);
        __syncthreads();
        const float srstd = rstd_s[stok];
        f32x16 eacc; f32x4 gacc = {0.f, 0.f, 0.f, 0.f};
#pragma unroll
        for (int r = 0; r < 16; ++r) eacc[r] = 0.f;
        for (int kc = 0; kc < 16; kc += 2) {
            FFN_STEP(xa, ga, sha, sca, wa, kc);
            FFN_STEP(xb, gb2, shb, scb, wb2, kc + 1);
        }
#undef FFN_STEP
#undef FFN_LOAD
#pragma unroll
        for (int r = 0; r < 16; ++r) part[(og * 32 + crow(r, lane)) * 33 + tok] = eacc[r];
#pragma unroll
        for (int e = 0; e < 4; ++e) { const float v = gacc[e] + sx_f<32>(gacc[e]); if (kh == 0) gpart[(og * 32 + tok) * 4 + e] = v; }
        __syncthreads();
        { const int tk = tid >> 3, c4 = (tid & 7) * 4;
#pragma unroll
          for (int e = 0; e < 4; ++e) lg[tk * 37 + 4 + c4 + e] = (part[tk * 33 + c4 + e] + part[(32 + tk) * 33 + c4 + e]) + (part[(64 + tk) * 33 + c4 + e] + part[(96 + tk) * 33 + c4 + e]);
          if (tid < 128) lg[(tid >> 2) * 37 + (tid & 3)] = (gpart[tid] + gpart[128 + tid]) + (gpart[256 + tid] + gpart[384 + tid]); }
        __syncthreads();
        if (tid < 32) {
            const int t = t0 + tid;
            float gl[4]; float gmax = -INFINITY; int gsel = 0;
#pragma unroll
            for (int g = 0; g < 4; ++g) { gl[g] = lg[tid * 37 + g] + p.moe_b_group[layer * 4 + g]; if (gl[g] > gmax) { gmax = gl[g]; gsel = g; } }
            float gsum = 0.f;
#pragma unroll
            for (int g = 0; g < 4; ++g) gsum += __expf(gl[g] - gmax);
            const float pg = 1.f / gsum;
            float v1 = -INFINITY, v2 = -INFINITY; int i1 = 0, i2 = 0;
            for (int jx = 0; jx < 8; ++jx) {
                const float v = lg[tid * 37 + 4 + gsel * 8 + jx] + p.moe_b_expert[layer * 32 + gsel * 8 + jx];
                if (v > v1) { v2 = v1; i2 = i1; v1 = v; i1 = jx; } else if (v > v2) { v2 = v; i2 = jx; }
            }
            const float e2 = __expf(v2 - v1), den = 1.f / (1.f + e2);
            const float w1 = pg * den, w2 = pg * e2 * den;
            const int ea = gsel * 8 + i1, eb = gsel * 8 + i2;
            int* cl = (int*)rstd_s + 32;
            cl[tid] = 0;
            const int la = atomicAdd(&cl[ea], 1);
            const int lb = atomicAdd(&cl[eb], 1);
            { const int n = cl[tid]; cl[32 + tid] = n > 0 ? atomicAdd(&ecnt[tid * ECS], n) : 0; }
            const int ra = cl[32 + ea] + la, rb = cl[32 + eb] + lb;
            elist[(size_t)ea * NASG + ra] = t * 2; ew[t * 2] = w1;
            elist[(size_t)eb * NASG + rb] = t * 2 + 1; ew[t * 2 + 1] = w2;
        }
    }
}

DI bool dense_item(int i, int NT, int xcd, int& tm, int& tn) {
    if (i >= 16 * NT) return false;
    const int mg = i / (8 * NT), r = i % (8 * NT);
    tn = r >> 3; tm = xcd * 16 + mg * 8 + (r & 7);
    return true;
}
template <class PR> DI void phase_hyb_in(const Params& p, int j, unsigned char* smem, int xcd, int lb, int nlb, int tid) {
    int tm, tn;
    for (int i = lb; dense_item(i, 22, xcd, tm, tn); i += nlb) { HybIn pr{&p, j, tm, tn}; gemm_tile(pr, smem, opq(tid)); }
}
DI void phase_ml_in(const Params& p, int j, unsigned char* smem, int xcd, int lb, int nlb, int tid) {
    int tm, tn;
    for (int i = lb; dense_item(i, 25, xcd, tm, tn); i += nlb) { MlIn pr{&p, j, tm, tn}; gemm_tile(pr, smem, opq(tid)); }
}
DI void phase_out_proj(const Params& p, int layer, const float* W, const float* src, unsigned char* smem, int xcd, int lb, int nlb, int tid) {
    int tm, tn;
    for (int i = lb; dense_item(i, 8, xcd, tm, tn); i += nlb) { OutProj pr{&p, W, src, layer, tm, tn}; gemm_tile(pr, smem, opq(tid)); }
}
template <int WHICH> DI void phase_moe(const Params& p, int layer, unsigned char* smem, int xcd, int lb, int nlb, int tid) {
    int* toff = (int*)(smem + 65600);
    __syncthreads();
    if (tid == 0) {
        const int* ecnt = (const int*)(p.ws + WS_ECNT) + layer * 32 * ECS;
        int ta = 0, ra = 0;
        for (int e = 0; e < 32; ++e) {
            const int c = ecnt[e * ECS];
            if ((e & 7) == xcd) { const int q = e >> 3; toff[q] = ta; toff[8 + q] = ra; toff[16 + q] = c; ta += (c + 127) >> 7; }
            ra += c;
        }
        toff[4] = ta;
    }
    __syncthreads();
    const int total = toff[4] * 8;
    for (int item = lb; item < total; item += nlb) {
        const int mg = item >> 3, nt = item & 7;
        int q = 0;
        while (q < 3 && toff[q + 1] <= mg) ++q;
        const int e = q * 8 + xcd, cnt = toff[16 + q], roff = toff[8 + q];
        if (WHICH == 1) { Moe1 pr{&p, layer, e, mg - toff[q], nt, cnt, roff}; gemm_tile(pr, smem, opq(tid)); }
        else { Moe2 pr{&p, layer, e, mg - toff[q], nt, cnt, roff}; gemm_tile(pr, smem, opq(tid)); }
    }
}

DI void phase_combine_norm(const Params& p, int layer, int bid, int nb, int tid) {
    const int lane = tid & 63, wid = tid >> 6;
    const float* mod = (const float*)(p.ws + WS_MOD) + (size_t)layer * 8 * 6144;
    const float* modn = mod + 8 * 6144;
    const float* gam = p.norm_mix + (layer + 1) * 1024;
    const bf16_t* Y = (const bf16_t*)(p.ws + WS_Y);
    const float* ew = (const float*)(p.ws + WS_EW);
    bf16_t* H = (bf16_t*)(p.ws + WS_H);
    const bool has_next = layer + 1 < DEPTH;
    for (int item = bid; item < T / 4; item += nb) {
        const int t = item * 4 + wid, b = t >> 11;
        const float w0 = ew[2 * t], w1 = ew[2 * t + 1];
        f32x4 v[4]; float ss = 0.f;
#pragma unroll
        for (int i = 0; i < 4; ++i) {
            const int c0 = (lane + 64 * i) * 4;
            v[i] = *(const f32x4*)(p.out + (size_t)t * 1024 + c0);
            const f32x4 g = *(const f32x4*)(mod + b * 6144 + 5120 + c0);
            const u32x2 y0 = *(const u32x2*)(Y + (size_t)(2 * t) * 1024 + c0), y1 = *(const u32x2*)(Y + (size_t)(2 * t + 1) * 1024 + c0);
            v[i][0] += g[0] * (w0 * bflo(y0[0]) + w1 * bflo(y1[0])); v[i][1] += g[1] * (w0 * bfhi(y0[0]) + w1 * bfhi(y1[0]));
            v[i][2] += g[2] * (w0 * bflo(y0[1]) + w1 * bflo(y1[1])); v[i][3] += g[3] * (w0 * bfhi(y0[1]) + w1 * bfhi(y1[1]));
            *(f32x4*)(p.out + (size_t)t * 1024 + c0) = v[i];
            ss += v[i][0] * v[i][0] + v[i][1] * v[i][1] + v[i][2] * v[i][2] + v[i][3] * v[i][3];
        }
        if (has_next) {
            ss = wave_sum(ss);
            const float rstd = rsqrtf(ss * (1.f / 1024.f) + EPS);
#pragma unroll
            for (int i = 0; i < 4; ++i) {
                const int c0 = (lane + 64 * i) * 4;
                const f32x4 g = *(const f32x4*)(gam + c0), sh = *(const f32x4*)(modn + b * 6144 + c0), sc = *(const f32x4*)(modn + b * 6144 + 1024 + c0);
                const f32x4 h = v[i] * rstd * g * (sc + 1.f) + sh;
                u32x2 o = {pk2(h[0], h[1]), pk2(h[2], h[3])};
                *(u32x2*)(H + (size_t)t * 1024 + c0) = o;
            }
        }
    }
}

DI unsigned sortable(float f) { const unsigned u = __float_as_uint(f); return (u & 0x80000000u) ? ~u : (u | 0x80000000u); }
DI int half_sum_i(int v) { v += sx_i<16>(v); v += sx_i<8>(v); v += sx_i<4>(v); v += sx_i<2>(v); v += sx_i<1>(v); return v; }

struct CvTask { const float* src; bf16_t* dst; int ldb, kdim; };
DI CvTask cv_task(const Params& p, int l0, int id) {
    const int PER = 32 * 8 * 16 * 4 + 32 * 8 * 8 * 4;
    const int l = l0 + id / PER; int ci = id % PER; CvTask t;
    if (ci < 16384) {
        const int g = ci & 3, kt = (ci >> 2) & 15, nt = (ci >> 6) & 7, e = ci >> 9; int w;
        Moe1 pr{&p, l, e, 0, nt, 0, 0};
        t.ldb = DEXP; t.kdim = 1024; t.src = pr.b_col(g, w) + (size_t)(kt * 64) * DEXP;
        t.dst = (bf16_t*)(p.ws + WS_WM1) + ((size_t)((l * 32 + e) * 8 + nt) * 128 + g * 32) * 1024 + kt * 64;
    } else {
        ci -= 16384;
        const int g = ci & 3, kt = (ci >> 2) & 7, nt = (ci >> 5) & 7, e = ci >> 8; int w;
        Moe2 pr{&p, l, e, 0, nt, 0, 0};
        t.ldb = D; t.kdim = 512; t.src = pr.b_col(g, w) + (size_t)(kt * 64) * D;
        t.dst = (bf16_t*)(p.ws + WS_WM2) + ((size_t)((l * 32 + e) * 8 + nt) * 128 + g * 32) * 512 + kt * 64;
    }
    return t;
}
DI void cv_issue(const CvTask& t, int lane, f32x4 (&rb)[8]) {
    const float* s = t.src + (size_t)((lane >> 3) * 8) * t.ldb + (lane & 7) * 4;
#pragma unroll
    for (int kk = 0; kk < 8; ++kk) rb[kk] = *(const f32x4*)(s + (size_t)kk * t.ldb);
}
DI void cv_finish(const CvTask& t, int lane, const f32x4 (&rb)[8]) {
    bf16_t* d = t.dst + (size_t)((lane & 7) * 4) * t.kdim + (lane >> 3) * 8;
#pragma unroll
    for (int jx = 0; jx < 4; ++jx) {
        u32x4 v = {pk2(rb[0][jx], rb[1][jx]), pk2(rb[2][jx], rb[3][jx]), pk2(rb[4][jx], rb[5][jx]), pk2(rb[6][jx], rb[7][jx])};
        *(u32x4*)(d + (size_t)jx * t.kdim) = v;
    }
}
DI void convert_moe_waves(const Params& p, int l0, int l1, int gwave, int nwaves, int lane) {
    const int total = (l1 - l0) * 24576;
    for (int id = gwave; id < total; id += 2 * nwaves) {
        f32x4 ra[8], rb[8];
        const CvTask t0 = cv_task(p, l0, id);
        cv_issue(t0, lane, ra);
        const bool two = id + nwaves < total;
        if (two) { const CvTask t1 = cv_task(p, l0, id + nwaves); cv_issue(t1, lane, rb); cv_finish(t0, lane, ra); cv_finish(t1, lane, rb); }
        else cv_finish(t0, lane, ra);
    }
}

DI void phase_dsa(const Params& p, int j, unsigned char* smem, int bid, int nb, int tid, int cv0 = 0, int cv1 = 0) {
    if (cv1 > cv0 && (bid & 1)) convert_moe_waves(p, cv0, cv1, bid * 4 + (tid >> 6), nb * 4, tid & 63);
    const int lane = tid & 63, wid = tid >> 6, c = lane & 31, hh = lane >> 5;
    unsigned* mw = (unsigned*)smem + wid * 256;
    const bf16_t* IQ = (const bf16_t*)(p.ws + WS_IQ);
    const bf16_t* IK = (const bf16_t*)(p.ws + WS_IK);
    const float* IW = (const float*)(p.ws + WS_IW);
    const bf16_t* Q = (const bf16_t*)(p.ws + WS_Q);
    const bf16_t* K = (const bf16_t*)(p.ws + WS_K);
    const bf16_t* VT = (const bf16_t*)(p.ws + WS_V);
    bf16_t* Y = (bf16_t*)(p.ws + WS_YMIX);
    const float gq = wave_max(fabsf(p.hy_q_norm[j * 64 + lane])), gk = wave_max(fabsf(p.hy_k_norm[j * 64 + lane]));
    const float LOG2E = 1.4426950408889634f;
    const float c1 = 0.125f * LOG2E, c2 = 8.f * gq * gk * LOG2E;
    const unsigned lt = (1u << c) - 1u;
    for (int it = bid, rnd = 0; it < 1024; it += nb, ++rnd) {
        const int item = (rnd & 1) ? (rnd + 1) * nb - 1 - bid : it;
        if (item >= 1024) continue;
        const int qt = 127 - (item >> 3), b = item & 7;
        const int pos0 = qt * 16 + 4 * wid;
        const size_t tb = (size_t)b * S, t0 = tb + pos0;
        const int tmax = (pos0 + 3) >> 5;
        if (pos0 >= 256) {
            bf16x8 iqf[4];
            {
                const int i = (c & 3) + 4 * (c >> 3), rh = (c >> 2) & 1, qq = 2 * rh + (i >> 3), hd = i & 7;
                const bf16_t* ip = IQ + (t0 + qq) * 512 + hd * 64 + 8 * hh;
#pragma unroll
                for (int ks = 0; ks < 4; ++ks) iqf[ks] = *(const bf16x8*)(ip + 16 * ks);
            }
            float* wl = (float*)(smem + 4096) + wid * 32 + hh * 16;
            if (c < 4) *(f32x4*)(wl + 4 * c) = *(const f32x4*)(IW + (t0 + 2 * hh) * 8 + 4 * c);
            unsigned sk[64][2];
            const bf16_t* kpi = IK + ((tb >> 5) * 256 + hh * 32 + c) * 8;
            const int lim0 = pos0 + 2 * hh - c;
#pragma unroll
            for (int tile = 0; tile < 64; ++tile) {
                unsigned k0 = 0u, k1 = 0u;
                if (tile <= tmax) {
                    bf16x8 bk[4];
#pragma unroll
                    for (int ks = 0; ks < 4; ++ks) bk[ks] = *(const bf16x8*)(kpi + 512 * ks);
                    kpi += 32 * 64;
                    asm volatile("" : "+v"(kpi));
                    f32x16 acc;
#pragma unroll
                    for (int r = 0; r < 16; ++r) acc[r] = 0.f;
#pragma unroll
                    for (int ks = 0; ks < 4; ++ks) acc = __builtin_amdgcn_mfma_f32_32x32x16_bf16(iqf[ks], bk[ks], acc, 0, 0, 0);
                    float s0 = 0.f, s1 = 0.f;
#pragma unroll
                    for (int q4 = 0; q4 < 2; ++q4) {
                        const f32x4 wa = *(const f32x4*)(wl + 4 * q4), wb = *(const f32x4*)(wl + 8 + 4 * q4);
#pragma unroll
                        for (int e = 0; e < 4; ++e) { s0 += fmaxf(acc[4 * q4 + e], 0.f) * wa[e]; s1 += fmaxf(acc[8 + 4 * q4 + e], 0.f) * wb[e]; }
                    }
                    k0 = tile * 32 <= lim0 ? sortable(s0) : 0u;
                    k1 = tile * 32 <= lim0 + 1 ? sortable(s1) : 0u;
                }
                sk[tile][0] = k0; sk[tile][1] = k1;
            }
            unsigned v0 = 0u, v1 = 0u; bool d0 = false, d1 = false;
            const int tg = tmax >> 3;
            for (int bit = 31; bit >= 0; --bit) {
                const unsigned c0 = v0 | (1u << bit), c1b = v1 | (1u << bit);
                int n0 = 0, n1 = 0;
#pragma unroll
                for (int g = 0; g < 8; ++g) {
                    if (g <= tg) {
#pragma unroll
                        for (int u = 0; u < 8; ++u) { n0 += sk[g * 8 + u][0] >= c0 ? 1 : 0; n1 += sk[g * 8 + u][1] >= c1b ? 1 : 0; }
                    }
                }
                const int n01 = half_sum_i(n0 | (n1 << 16));
                n0 = n01 & 0xffff; n1 = n01 >> 16;
                if (!d0 && n0 >= 256) { v0 = c0; d0 = n0 == 256; }
                if (!d1 && n1 >= 256) { v1 = c1b; d1 = n1 == 256; }
                if (__all(d0 && d1)) break;
            }
            int g0 = 0, g1 = 0;
#pragma unroll
            for (int g = 0; g < 8; ++g) {
                if (g <= tg) {
#pragma unroll
                    for (int u = 0; u < 8; ++u) { g0 += sk[g * 8 + u][0] > v0 ? 1 : 0; g1 += sk[g * 8 + u][1] > v1 ? 1 : 0; }
                }
            }
            const int g01 = half_sum_i(g0 | (g1 << 16));
            const int need0 = 256 - (g01 & 0xffff), need1 = 256 - (g01 >> 16);
            int run0 = 0, run1 = 0;
#pragma unroll
            for (int tile = 0; tile < 64; ++tile) {
                if (tile <= tmax) {
                    const unsigned k0 = sk[tile][0], k1 = sk[tile][1];
                    const bool tie0 = k0 == v0, tie1 = k1 == v1;
                    const unsigned long long tb0 = __ballot(tie0), tb1 = __ballot(tie1);
                    const unsigned th0 = hh ? (unsigned)(tb0 >> 32) : (unsigned)tb0, th1 = hh ? (unsigned)(tb1 >> 32) : (unsigned)tb1;
                    const bool sel0 = k0 > v0 || (tie0 && run0 + __popc(th0 & lt) < need0);
                    const bool sel1 = k1 > v1 || (tie1 && run1 + __popc(th1 & lt) < need1);
                    run0 += __popc(th0); run1 += __popc(th1);
                    const unsigned long long sb0 = __ballot(sel0), sb1 = __ballot(sel1);
                    if (lane == 0) { u32x4 o = {(unsigned)sb0, (unsigned)sb1, (unsigned)(sb0 >> 32), (unsigned)(sb1 >> 32)}; *(u32x4*)(mw + tile * 4) = o; }
                }
            }
        } else {
            const int tile = lane >> 2, qq = lane & 3, pq = pos0 + qq;
            if (tile <= tmax) {
                unsigned m;
                if (32 * tile + 31 <= pq) m = 0xffffffffu; else if (32 * tile > pq) m = 0u; else m = (2u << (pq - 32 * tile)) - 1u;
                mw[tile * 4 + qq] = m;
            }
        }
        bf16x8 qf[4];
        {
            const bf16_t* qp = Q + (t0 + (c >> 3)) * 512 + (c & 7) * 64 + 8 * hh;
#pragma unroll
            for (int ks = 0; ks < 4; ++ks) qf[ks] = *(const bf16x8*)(qp + 16 * ks);
        }
        f32x16 o0, o1;
#pragma unroll
        for (int r = 0; r < 16; ++r) { o0[r] = 0.f; o1[r] = 0.f; }
        float lsum = 0.f;
        const bf16_t* kp = K + ((tb >> 5) * 256 + hh * 32 + c) * 8;
        const bf16_t* vp = VT + ((tb >> 5) * 256 + hh * 32 + c) * 8;
        bf16x8 kf[4], vf[4];
#pragma unroll
        for (int ks = 0; ks < 4; ++ks) { kf[ks] = *(const bf16x8*)(kp + 512 * ks); vf[ks] = *(const bf16x8*)(vp + 512 * ks); }
        for (int tile = 0; tile <= tmax; ++tile) {
            const unsigned mword = mw[tile * 4 + (c >> 3)];
            bf16x8 kc[4], vc[4];
#pragma unroll
            for (int ks = 0; ks < 4; ++ks) { kc[ks] = kf[ks]; vc[ks] = vf[ks]; }
            if (tile < tmax) {
                kp += 2048; vp += 2048;
#pragma unroll
                for (int ks = 0; ks < 4; ++ks) { kf[ks] = *(const bf16x8*)(kp + 512 * ks); vf[ks] = *(const bf16x8*)(vp + 512 * ks); }
            }
            f32x16 x;
#pragma unroll
            for (int r = 0; r < 16; ++r) x[r] = 0.f;
#pragma unroll
            for (int ks = 0; ks < 4; ++ks) x = __builtin_amdgcn_mfma_f32_32x32x16_bf16(kc[ks], qf[ks], x, 0, 0, 0);
#pragma unroll
            for (int s = 0; s < 2; ++s) {
                const unsigned bits = mword >> (16 * s + 8 * hh);
                float pr[8];
#pragma unroll
                for (int jx = 0; jx < 8; ++jx) {
                    const float e = __builtin_amdgcn_exp2f(x[8 * s + jx] * c1 - c2);
                    pr[jx] = __uint_as_float(__float_as_uint(e) & (unsigned)__builtin_amdgcn_sbfe((int)bits, jx, 1));
                    lsum += pr[jx];
                }
                u32x4 pk = {pk2(pr[0], pr[1]), pk2(pr[2], pr[3]), pk2(pr[4], pr[5]), pk2(pr[6], pr[7])};
                const bf16x8 pf = __builtin_bit_cast(bf16x8, pk);
                o0 = __builtin_amdgcn_mfma_f32_32x32x16_bf16(vc[2 * s], pf, o0, 0, 0, 0);
                o1 = __builtin_amdgcn_mfma_f32_32x32x16_bf16(vc[2 * s + 1], pf, o1, 0, 0, 0);
            }
        }
        lsum += sx_f<32>(lsum);
        const float inv = 1.f / lsum;
        bf16_t* yp = Y + (t0 + (c >> 3)) * 1024 + (c & 7) * 64 + 4 * hh;
#pragma unroll
        for (int g4 = 0; g4 < 4; ++g4) {
            u32x2 a = {pk2(o0[4 * g4] * inv, o0[4 * g4 + 1] * inv), pk2(o0[4 * g4 + 2] * inv, o0[4 * g4 + 3] * inv)};
            u32x2 bq = {pk2(o1[4 * g4] * inv, o1[4 * g4 + 1] * inv), pk2(o1[4 * g4 + 2] * inv, o1[4 * g4 + 3] * inv)};
            *(u32x2*)(yp + 8 * g4) = a;
            *(u32x2*)(yp + 32 + 8 * g4) = bq;
        }
    }
    if (cv1 > cv0 && !(bid & 1)) convert_moe_waves(p, cv0, cv1, bid * 4 + (tid >> 6), nb * 4, tid & 63);
}

DI void phase_conv(const Params& p, int j, int bid, int nb, int tid) {
    const bf16_t* Z = (const bf16_t*)(p.ws + WS_Z);
    const bf16_t* BG = (const bf16_t*)(p.ws + WS_BG);
    bf16_t* Y = (bf16_t*)(p.ws + WS_YMIX);
    const float* cw = p.hy_conv_w + (size_t)j * 3 * 512;
    for (int item = bid; item < T / 4; item += nb) {
        const int t = item * 4 + (tid >> 6), c0 = (tid & 63) * 8, pos = t & (S - 1);
        float acc[8];
#pragma unroll
        for (int e = 0; e < 8; ++e) acc[e] = 0.f;
#pragma unroll
        for (int jj = 0; jj < 3; ++jj) {
            const int dp = jj - 2;
            if (pos + dp >= 0) {
                const u32x4 z = *(const u32x4*)(Z + (size_t)(t + dp) * 512 + c0);
#pragma unroll
                for (int e = 0; e < 4; ++e) { acc[2 * e] += cw[jj * 512 + c0 + 2 * e] * bflo(z[e]); acc[2 * e + 1] += cw[jj * 512 + c0 + 2 * e + 1] * bfhi(z[e]); }
            }
        }
        const u32x4 g = *(const u32x4*)(BG + (size_t)t * 512 + c0);
        u32x4 o;
#pragma unroll
        for (int e = 0; e < 4; ++e) o[e] = pk2(acc[2 * e] * bflo(g[e]), acc[2 * e + 1] * bfhi(g[e]));
        *(u32x4*)(Y + (size_t)t * 1024 + 512 + c0) = o;
    }
}

DI float wave_incl_sum(float x, int lane) { for (int d = 1; d < 64; d <<= 1) { const float t = lane_get_f(x, lane >= d ? lane - d : lane); if (lane >= d) x += t; } return x; }
DI float wave_incl_max(float x, int lane) { for (int d = 1; d < 64; d <<= 1) { const float t = lane_get_f(x, lane >= d ? lane - d : lane); if (lane >= d) x = fmaxf(x, t); } return x; }
DI bf16x8 scale_frag(bf16x8 f, const float* w8) {
    const u32x4 u = __builtin_bit_cast(u32x4, f);
    u32x4 o;
#pragma unroll
    for (int e = 0; e < 4; ++e) o[e] = pk2(bflo(u[e]) * w8[2 * e], bfhi(u[e]) * w8[2 * e + 1]);
    return __builtin_bit_cast(bf16x8, o);
}

DI void phase_ml1(const Params& p, unsigned char* smem, int bid, int nb, int tid) {
    const int lane = tid & 63, wid = tid >> 6, c = lane & 31, hh = lane >> 5;
    float* wsl = (float*)smem + wid * 64;
    const bf16_t* KT = (const bf16_t*)(p.ws + WS_MKT);
    const bf16_t* VT = (const bf16_t*)(p.ws + WS_MV);
    const float* MIG = (const float*)(p.ws + WS_MIG);
    const float* MFG = (const float*)(p.ws + WS_MFG);
    float* UB = (float*)(p.ws + WS_UBUF);
    float* UN = (float*)(p.ws + WS_UNBUF);
    float* ML = (float*)(p.ws + WS_MLOC);
    for (int item = bid * 4 + wid; item < 2048; item += nb * 4) {
        const int bh = item >> 5, ch = item & 31, b = bh >> 3, h = bh & 7;
        const size_t tb = (size_t)b * S + ch * 64;
        const float lf = MFG[(tb + lane) * 8 + h], ig = MIG[(tb + lane) * 8 + h];
        const bf16_t* kp = KT + ((size_t)item * 512 + lane) * 8;
        const bf16_t* vp = VT + ((size_t)item * 1024 + lane) * 8;
        bf16x8 kraw[2][4];
#pragma unroll
        for (int dh = 0; dh < 2; ++dh)
#pragma unroll
            for (int ks = 0; ks < 4; ++ks) kraw[dh][ks] = *(const bf16x8*)(kp + (dh * 4 + ks) * 512);
        const float bc = wave_incl_sum(lf, lane);
        const float blast = lane_get_f(bc, 63);
        const float g = blast - bc + ig;
        const float gmax = wave_max(g);
        wsl[lane] = __expf(g - gmax);
        if (lane == 0) { ML[item * 2] = blast; ML[item * 2 + 1] = gmax; }
        bf16x8 kf[2][4];
#pragma unroll
        for (int ks = 0; ks < 4; ++ks) {
            float w8[8];
            const f32x4 wa = *(const f32x4*)(wsl + 16 * ks + 8 * hh), wb = *(const f32x4*)(wsl + 16 * ks + 8 * hh + 4);
            w8[0] = wa[0]; w8[1] = wa[1]; w8[2] = wa[2]; w8[3] = wa[3]; w8[4] = wb[0]; w8[5] = wb[1]; w8[6] = wb[2]; w8[7] = wb[3];
            kf[0][ks] = scale_frag(kraw[0][ks], w8); kf[1][ks] = scale_frag(kraw[1][ks], w8);
        }
#pragma unroll
        for (int vb = 0; vb < 4; ++vb) {
            f32x16 u0, u1;
#pragma unroll
            for (int r = 0; r < 16; ++r) { u0[r] = 0.f; u1[r] = 0.f; }
#pragma unroll
            for (int ks = 0; ks < 4; ++ks) {
                const bf16x8 va = *(const bf16x8*)(vp + (vb * 4 + ks) * 512);
                u0 = __builtin_amdgcn_mfma_f32_32x32x16_bf16(va, kf[0][ks], u0, 0, 0, 0);
                u1 = __builtin_amdgcn_mfma_f32_32x32x16_bf16(va, kf[1][ks], u1, 0, 0, 0);
            }
            float* up = UB + ((size_t)item * 128 + vb * 32) * 64 + c;
#pragma unroll
            for (int r = 0; r < 16; ++r) { const int v = crow(r, lane); up[v * 64] = u0[r]; up[v * 64 + 32] = u1[r]; }
        }
        {
            float a = 0.f;
#pragma unroll
            for (int q = 0; q < 8; ++q) { const u32x4 u = *(const u32x4*)(KT + ((size_t)item * 512 + (hh * 4 + (q >> 1)) * 64 + (q & 1) * 32 + c) * 8);
#pragma unroll
                for (int e = 0; e < 4; ++e) a += wsl[q * 8 + 2 * e] * bflo(u[e]) + wsl[q * 8 + 2 * e + 1] * bfhi(u[e]); }
            UN[(size_t)item * 64 + lane] = a;
        }
    }
}

DI void phase_ml2(const Params& p, unsigned char* smem, int bid, int nb, int tid) {
    float* dec = (float*)smem;
    float* scl = dec + 32;
    const float* UB = (const float*)(p.ws + WS_UBUF);
    const float* UN = (const float*)(p.ws + WS_UNBUF);
    const float* ML = (const float*)(p.ws + WS_MLOC);
    bf16_t* CB = (bf16_t*)(p.ws + WS_CBUF);
    float* NBF = (float*)(p.ws + WS_NBUF);
    float* MST = (float*)(p.ws + WS_MST);
    for (int item = bid; item < 512; item += nb) {
        const int bh = item >> 3, sl = item & 7;
        __syncthreads();
        if (tid == 0) {
            float m = 0.f;
            for (int ch = 0; ch < 32; ++ch) {
                const float bl = ML[(bh * 32 + ch) * 2], gm = ML[(bh * 32 + ch) * 2 + 1];
                const float mn = fmaxf(bl + m, gm);
                dec[ch] = __expf(bl + m - mn); scl[ch] = __expf(gm - mn);
                if (sl == 0) MST[bh * 32 + ch] = m;
                m = mn;
            }
        }
        __syncthreads();
        f32x4 st = {0.f, 0.f, 0.f, 0.f};
        const size_t e0 = (size_t)sl * 1024 + tid * 4;
        const int ev = (int)(e0 >> 6), ed = (int)(e0 & 63);
        const size_t ef = (size_t)((((ev >> 5) * 4 + (ed >> 4)) * 2 + ((ed >> 3) & 1)) * 32 + (ev & 31)) * 8 + (ed & 7);
        f32x4 ub[32];
#pragma unroll
        for (int ch = 0; ch < 32; ++ch) ub[ch] = *(const f32x4*)(UB + ((size_t)(bh * 32 + ch)) * 8192 + e0);
#pragma unroll
        for (int ch = 0; ch < 32; ++ch) {
            st = st * dec[ch] + ub[ch] * scl[ch];
            u32x2 o = {pk2(st[0], st[1]), pk2(st[2], st[3])};
            *(u32x2*)(CB + ((size_t)(bh * 32 + ch)) * 8192 + ef) = o;
        }
        if (sl == 0 && tid < 64) {
            float nst = 0.f, un[32];
#pragma unroll
            for (int ch = 0; ch < 32; ++ch) un[ch] = UN[(size_t)(bh * 32 + ch) * 64 + tid];
#pragma unroll
            for (int ch = 0; ch < 32; ++ch) { nst = nst * dec[ch] + un[ch] * scl[ch]; NBF[(size_t)(bh * 32 + ch) * 64 + tid] = nst; }
        }
    }
}

DI void phase_ml3(const Params& p, int j, unsigned char* smem, int bid, int nb, int tid) {
    const int lane = tid & 63, wid = tid >> 6, c = lane & 31, hh = lane >> 5;
    float* al = (float*)smem + wid * 64;
    const bf16_t* MQ = (const bf16_t*)(p.ws + WS_MQ);
    const bf16_t* MK = (const bf16_t*)(p.ws + WS_MK);
    const bf16_t* VT = (const bf16_t*)(p.ws + WS_MV);
    const float* MIG = (const float*)(p.ws + WS_MIG);
    const float* MFG = (const float*)(p.ws + WS_MFG);
    const bf16_t* MOG = (const bf16_t*)(p.ws + WS_MOG);
    const bf16_t* CB = (const bf16_t*)(p.ws + WS_CBUF);
    const float* NBF = (const float*)(p.ws + WS_NBUF);
    const float* MST = (const float*)(p.ws + WS_MST);
    bf16_t* Y = (bf16_t*)(p.ws + WS_YMIX);
    for (int item = bid * 4 + wid; item < 2048; item += nb * 4) {
        const int bh = item >> 5, ch = item & 31, b = bh >> 3, h = bh & 7;
        const size_t tb = (size_t)b * S + ch * 64;
        const float lf = MFG[(tb + lane) * 8 + h], ig = MIG[(tb + lane) * 8 + h];
        const float mprev = MST[item];
        bf16x8 kf[2][4];
        const bf16_t* kp = MK + ((size_t)item * 512 + lane) * 8;
#pragma unroll
        for (int st = 0; st < 2; ++st)
#pragma unroll
            for (int ks = 0; ks < 4; ++ks) kf[st][ks] = *(const bf16x8*)(kp + (st * 4 + ks) * 512);
        const float bc = wave_incl_sum(lf, lane);
        const float av = ig - bc;
        const float Mv = fmaxf(mprev, wave_incl_max(av, lane));
        al[lane] = av;
        const bf16_t* vp = VT + ((size_t)item * 1024 + lane) * 8;
        const bf16_t* cp = CB + ((size_t)(item - 1) * 1024 + lane) * 8;
        const float* np = NBF + (size_t)(item - 1) * 64 + 8 * hh;
#pragma unroll
        for (int tt = 0; tt < 2; ++tt) {
            const float Mt = lane_get_f(Mv, 32 * tt + c), wint = __expf(mprev - Mt), emt = __expf(-(lane_get_f(bc, 32 * tt + c) + Mt));
            bf16x8 qf[4];
#pragma unroll
            for (int ks = 0; ks < 4; ++ks) qf[ks] = *(const bf16x8*)(MQ + ((size_t)item * 512 + (tt * 4 + ks) * 64 + lane) * 8);
            bf16x8 pf[2][2]; float csum = 0.f;
#pragma unroll
            for (int st = 0; st <= tt; ++st) {
                f32x16 x;
#pragma unroll
                for (int r = 0; r < 16; ++r) x[r] = 0.f;
#pragma unroll
                for (int ks = 0; ks < 4; ++ks) x = __builtin_amdgcn_mfma_f32_32x32x16_bf16(kf[st][ks], qf[ks], x, 0, 0, 0);
#pragma unroll
                for (int k2 = 0; k2 < 2; ++k2) {
                    const int s0 = 32 * st + 16 * k2 + 8 * hh;
                    const f32x4 a0 = *(const f32x4*)(al + s0), a1 = *(const f32x4*)(al + s0 + 4);
                    const float a8[8] = {a0[0], a0[1], a0[2], a0[3], a1[0], a1[1], a1[2], a1[3]};
                    float pr[8];
#pragma unroll
                    for (int jx = 0; jx < 8; ++jx) {
                        const float e = __expf(a8[jx] - Mt) * x[8 * k2 + jx];
                        pr[jx] = (st < tt || s0 + jx <= 32 * tt + c) ? e : 0.f;
                        csum += pr[jx];
                    }
                    u32x4 pk = {pk2(pr[0], pr[1]), pk2(pr[2], pr[3]), pk2(pr[4], pr[5]), pk2(pr[6], pr[7])};
                    pf[st][k2] = __builtin_bit_cast(bf16x8, pk);
                }
            }
            float nq = 0.f;
            if (ch > 0) {
#pragma unroll
                for (int ks = 0; ks < 4; ++ks) {
                    const f32x4 n0 = *(const f32x4*)(np + 16 * ks), n1 = *(const f32x4*)(np + 16 * ks + 4);
                    const u32x4 uq = __builtin_bit_cast(u32x4, qf[ks]);
                    nq += n0[0] * bflo(uq[0]) + n0[1] * bfhi(uq[0]) + n0[2] * bflo(uq[1]) + n0[3] * bfhi(uq[1]) + n1[0] * bflo(uq[2]) + n1[1] * bfhi(uq[2]) + n1[2] * bflo(uq[3]) + n1[3] * bfhi(uq[3]);
                }
                nq += sx_f<32>(nq);
            }
            csum += sx_f<32>(csum);
            const float den = wint * nq + csum;
            const float rd = 1.f / fmaxf(fabsf(den), emt);
            f32x16 o[4]; float s2 = 0.f;
#pragma unroll
            for (int vb = 0; vb < 4; ++vb) {
#pragma unroll
                for (int r = 0; r < 16; ++r) o[vb][r] = 0.f;
                if (ch > 0) {
#pragma unroll
                    for (int ks = 0; ks < 4; ++ks) o[vb] = __builtin_amdgcn_mfma_f32_32x32x16_bf16(*(const bf16x8*)(cp + (vb * 4 + ks) * 512), qf[ks], o[vb], 0, 0, 0);
#pragma unroll
                    for (int r = 0; r < 16; ++r) o[vb][r] *= wint;
                }
#pragma unroll
                for (int st = 0; st <= tt; ++st)
#pragma unroll
                    for (int k2 = 0; k2 < 2; ++k2) o[vb] = __builtin_amdgcn_mfma_f32_32x32x16_bf16(*(const bf16x8*)(vp + (vb * 4 + 2 * st + k2) * 512), pf[st][k2], o[vb], 0, 0, 0);
#pragma unroll
                for (int r = 0; r < 16; ++r) { o[vb][r] *= rd; s2 += o[vb][r] * o[vb][r]; }
            }
            s2 += sx_f<32>(s2);
            const float rstd = rsqrtf(s2 * (1.f / 128.f) + EPS);
            const bf16_t* ogp = MOG + ((size_t)(item * 2 + tt) * 1024 + lane) * 4;
            bf16_t* yp = Y + (tb + 32 * tt + c) * 1024 + h * 128 + 4 * hh;
            const float* gp = p.ml_out_norm + j * 1024 + h * 128 + 4 * hh;
#pragma unroll
            for (int vb = 0; vb < 4; ++vb)
#pragma unroll
                for (int g4 = 0; g4 < 4; ++g4) {
                    const f32x4 gm = *(const f32x4*)(gp + 32 * vb + 8 * g4);
                    const u32x2 og = *(const u32x2*)(ogp + (vb * 4 + g4) * 256);
                    u32x2 ov = {pk2(o[vb][4 * g4] * rstd * gm[0] * bflo(og[0]), o[vb][4 * g4 + 1] * rstd * gm[1] * bfhi(og[0])),
                                pk2(o[vb][4 * g4 + 2] * rstd * gm[2] * bflo(og[1]), o[vb][4 * g4 + 3] * rstd * gm[3] * bfhi(og[1]))};
                    *(u32x2*)(yp + 32 * vb + 8 * g4) = ov;
                }
        }
    }
}


namespace pg8 {
#define PG8_LAS __attribute__((address_space(3)))
typedef unsigned short bf16_t;
typedef short bf16x8 __attribute__((ext_vector_type(8)));
typedef float f32x4 __attribute__((ext_vector_type(4)));
typedef unsigned u32x4 __attribute__((ext_vector_type(4)));
constexpr int BM = 256, BK = 64, HALF = 128, HTB = HALF * BK * 2  , STAGE_BYTES = 8 * HTB, NXCD = 8, WGM = 8;

__host__ __device__ __forceinline__ int lds_byte(int r, int c) { const int st = (r >> 4) * 2 + (c >> 5), rr = r & 15, cc = c & 31, ob = rr * 64 + cc * 2; return st * 1024 + (ob ^ (((ob >> 9) & 1) << 5)); }
__host__ __device__ __forceinline__ void stage_rc(int b, int& R, int& C) { const int st = b / 1024, sb = b % 1024, swz = sb ^ (((sb >> 9) & 1) << 5); R = (st >> 1) * 16 + swz / 64; C = (st & 1) * 32 + (swz % 64) / 2; }
__host__ __device__ __forceinline__ int perm32(int rho) { const int n = rho >> 4, i = rho & 15; return 8 * (i >> 2) + 4 * n + (i & 3); }

struct Unit { int pm, pn; };
struct Gemm { const bf16_t* A; const bf16_t* Bt; int M, N, K; };

struct StaticOrder {
    int nM, nN, nwg, G, c;
    __host__ __device__ void init(int M, int N, int G_, int c_) { nM = M / BM; nN = N / BM; nwg = nM * nN; G = G_; c = c_; }
    __host__ __device__ bool next(int i, Unit& u) const {
        const long L = (long)i * G + c; if (L >= nwg) return false;
        int wgid = (int)L; { const int q = nwg / NXCD, r = nwg % NXCD, xcd = wgid % NXCD, off = wgid / NXCD; wgid = (xcd < r ? xcd * (q + 1) : r * (q + 1) + (xcd - r) * q) + off; }
        const int nig = WGM * nN, gid = wgid / nig, fm = gid * WGM, gsz = (nM - fm) < WGM ? (nM - fm) : WGM;
        u.pm = fm + ((wgid % nig) % gsz); u.pn = (wgid % nig) / gsz; return true;
    }
    static constexpr bool GATHER = false;
    __device__ __forceinline__ unsigned a_off(const Unit&, int) const { return 0u; }
    __device__ __forceinline__ int rows(const Unit&) const { return BM; }
    __device__ __forceinline__ void a_ready(const Unit&) const {}
    __device__ __forceinline__ void done(const Unit&) const {}
};


template <class Epi, class Sched, bool ALIGN_EPI = false, bool SP2 = false>
__device__ __forceinline__ void gemm_phase(PG8_LAS unsigned char* lds, const Gemm g, const Sched& S, const Epi& E, int tid512) {
    const int tid = opq(tid512), wid = __builtin_amdgcn_readfirstlane(tid >> 6), lane = tid & 63, wr = wid >> 2, wc = wid & 3, fr = lane & 15, fq = lane >> 4;
    const int K = g.K, nt = K / BK;
    unsigned voffA[2], voffB[2];
    int rowA[2];
#pragma unroll
    for (int i = 0; i < 2; ++i) { int R, C; stage_rc(tid * 16 + i * 8192, R, C); const int Rb = Epi::PERM ? ((R & ~31) + perm32(R & 31)) : R;
        voffA[i] = (unsigned)(R * K + C) * 2u; voffB[i] = (unsigned)(Rb * K + C) * 2u; rowA[i] = R; if (Sched::GATHER) voffA[i] = (unsigned)C * 2u; }
    const size_t kstep = (size_t)(BK * 2);
    const size_t hstep = (size_t)HALF * K * 2;
    const size_t tstep = 2 * hstep;
    const unsigned ldsw = (unsigned)wid * 1024u;
    const int aoff = lds_byte(wr * 64 + fr, fq * 8), boff = lds_byte(wc * 32 + fr, fq * 8);
#define PG8_SA(b, h) (((b) * 2 + (h)) * HTB)
#define PG8_SB(b, h) ((4 + (b) * 2 + (h)) * HTB)
#define PG8_STAGE(bufoff, gbase, voff) do { _Pragma("unroll") for (int _i = 0; _i < 2; ++_i) \
        __builtin_amdgcn_global_load_lds((const unsigned*)((const char*)(gbase) + (voff)[_i]), (PG8_LAS unsigned*)(lds + (bufoff) + ldsw + _i * 8192), 16, 0, 0); } while (0)
#define PG8_LDA(dst, b, h) do { _Pragma("unroll") for (int m = 0; m < 4; ++m) _Pragma("unroll") for (int k = 0; k < 2; ++k) dst[m][k] = *(const PG8_LAS bf16x8*)(lds + PG8_SA(b, h) + aoff + m * 2048 + k * 1024); } while (0)
#define PG8_LDB(dst, b, h) do { _Pragma("unroll") for (int n = 0; n < 2; ++n) _Pragma("unroll") for (int k = 0; k < 2; ++k) dst[n][k] = *(const PG8_LAS bf16x8*)(lds + PG8_SB(b, h) + boff + n * 2048 + k * 1024); } while (0)
#define PG8_MMA(ai, bj, At, Bt) do { __builtin_amdgcn_s_setprio(1); _Pragma("unroll") for (int m = 0; m < 4; ++m) _Pragma("unroll") for (int n = 0; n < 2; ++n) _Pragma("unroll") for (int k = 0; k < 2; ++k) \
        acc[ai][bj][m][n] = __builtin_amdgcn_mfma_f32_16x16x32_bf16(Bt[n][k], At[m][k], acc[ai][bj][m][n], 0, 0, 0); __builtin_amdgcn_s_setprio(0); } while (0)
#define PG8_WAIT_V(n) asm volatile("s_waitcnt vmcnt(" #n ")" ::: "memory")
#define PG8_WAIT_L(n) asm volatile("s_waitcnt lgkmcnt(" #n ")" ::: "memory")
#define PG8_BAR __builtin_amdgcn_s_barrier()
#define PG8_SCHED __builtin_amdgcn_sched_barrier(0)
    unsigned oaC[2][2], oaN[2][2];
#define PG8_GOFF(dst, unit) do { _Pragma("unroll") for (int _h = 0; _h < 2; ++_h) _Pragma("unroll") for (int _i = 0; _i < 2; ++_i) dst[_h][_i] = S.a_off(unit, _h * HALF + rowA[_i]) + voffA[_i]; } while (0)
#define PG8_STAGE_G(bufoff, offs, koff) do { _Pragma("unroll") for (int _i = 0; _i < 2; ++_i) \
        __builtin_amdgcn_global_load_lds((const unsigned*)(((const char*)g.A + (koff)) + (offs)[_i]), (PG8_LAS unsigned*)(lds + (bufoff) + ldsw + _i * 8192), 16, 0, 0); } while (0)
    Unit cur, nxt; int ui = 0;
    if (!S.next(0, cur)) return;
    if constexpr (Sched::GATHER) { PG8_GOFF(oaC, cur); PG8_GOFF(oaN, cur); }
    bool mm0 = true, mm1 = true;
    if constexpr (Sched::GATHER) { const int rws = S.rows(cur); mm0 = 64 * wr < rws; mm1 = 128 + 64 * wr < rws; }
    f32x4 acc[2][2][4][2];
#pragma unroll
    for (int a = 0; a < 2; ++a)
#pragma unroll
        for (int b = 0; b < 2; ++b)
#pragma unroll
            for (int m = 0; m < 4; ++m)
#pragma unroll
                for (int n = 0; n < 2; ++n) acc[a][b][m][n] = (f32x4){0.f, 0.f, 0.f, 0.f};
    bf16x8 At[4][2], B0[2][2], B1[2][2];
    const char* cA = (const char*)g.A + (size_t)cur.pm * tstep; const char* cB = (const char*)g.Bt + (size_t)cur.pn * tstep;
    S.a_ready(cur);
    if constexpr (SP2) {
        PG8_STAGE(PG8_SB(0, 0), cB, voffB); PG8_STAGE(PG8_SB(0, 1), cB + hstep, voffB);
        if constexpr (Sched::GATHER) { PG8_STAGE_G(PG8_SA(0, 0), oaC[0], 0); PG8_STAGE_G(PG8_SA(0, 1), oaC[1], 0); } else { PG8_STAGE(PG8_SA(0, 0), cA, voffA); PG8_STAGE(PG8_SA(0, 1), cA + hstep, voffA); }
        if (wr == 1) PG8_BAR;
        PG8_WAIT_V(2); PG8_BAR;
        PG8_STAGE(PG8_SB(1, 0), cB + kstep, voffB);
        if constexpr (Sched::GATHER) PG8_STAGE_G(PG8_SA(1, 0), oaC[0], kstep); else PG8_STAGE(PG8_SA(1, 0), cA + kstep, voffA);
        PG8_STAGE(PG8_SB(1, 1), cB + hstep + kstep, voffB);
        PG8_WAIT_V(6); PG8_BAR;
    } else {
        PG8_STAGE(PG8_SB(0, 0), cB, voffB); PG8_STAGE(PG8_SA(0, 0), cA, voffA); PG8_STAGE(PG8_SB(0, 1), cB + hstep, voffB); PG8_STAGE(PG8_SA(0, 1), cA + hstep, voffA);
        if (wr == 1) PG8_BAR;
        PG8_WAIT_V(4); PG8_BAR;
        PG8_STAGE(PG8_SB(1, 0), cB + kstep, voffB); PG8_STAGE(PG8_SA(1, 0), cA + kstep, voffA); PG8_STAGE(PG8_SB(1, 1), cB + hstep + kstep, voffB);
        PG8_WAIT_V(6); PG8_BAR;
    }
    for (;;) {
        const bool has_next = S.next(ui + 1, nxt);
        const char* nA = has_next ? (const char*)g.A + (size_t)nxt.pm * tstep : cA; const char* nB = has_next ? (const char*)g.Bt + (size_t)nxt.pn * tstep : cB;
        for (int t = 0; t < nt; t += 2) {
            const bool last = (t == nt - 2);
            const char* a1 = cA + (size_t)(t + 1) * kstep;
            const char* a2 = last ? nA : cA + (size_t)(t + 2) * kstep; const char* b2 = last ? nB : cB + (size_t)(t + 2) * kstep;
            const char* a3 = a2 + kstep; const char* b3 = b2 + kstep;
            if (last && has_next) S.a_ready(nxt);
            unsigned oaS[2][2]; size_t k2 = 0;
            if constexpr (Sched::GATHER) {
                if (last && has_next) PG8_GOFF(oaN, nxt);
                const bool fromN = last && has_next;
#pragma unroll
                for (int _h = 0; _h < 2; ++_h)
#pragma unroll
                    for (int _i = 0; _i < 2; ++_i) oaS[_h][_i] = fromN ? oaN[_h][_i] : oaC[_h][_i];
                k2 = last ? (size_t)0 : (size_t)(t + 2) * kstep;
            }
            if constexpr (SP2) {
            PG8_LDB(B0, 0, 0); PG8_LDB(B1, 0, 1); PG8_SCHED; PG8_LDA(At, 0, 0);
            if constexpr (Sched::GATHER) PG8_STAGE_G(PG8_SA(1, 1), oaC[1], (size_t)(t + 1) * kstep); else PG8_STAGE(PG8_SA(1, 1), a1 + hstep, voffA);
            PG8_WAIT_V(8); PG8_WAIT_L(0); PG8_BAR; if (!Sched::GATHER || mm0) { PG8_MMA(0, 0, At, B0); PG8_MMA(0, 1, At, B1); } PG8_BAR; PG8_SCHED;
            PG8_LDA(At, 0, 1); PG8_STAGE(PG8_SB(0, 0), b2, voffB); PG8_STAGE(PG8_SB(0, 1), b2 + hstep, voffB);
            if constexpr (Sched::GATHER) PG8_STAGE_G(PG8_SA(0, 0), oaS[0], k2); else PG8_STAGE(PG8_SA(0, 0), a2, voffA);
            PG8_WAIT_V(8); PG8_WAIT_L(0); PG8_BAR; if (!Sched::GATHER || mm1) { PG8_MMA(1, 0, At, B0); PG8_MMA(1, 1, At, B1); } PG8_BAR; PG8_SCHED;
            PG8_LDB(B0, 1, 0); PG8_LDB(B1, 1, 1); PG8_SCHED; PG8_LDA(At, 1, 0);
            if constexpr (Sched::GATHER) PG8_STAGE_G(PG8_SA(0, 1), oaS[1], k2); else PG8_STAGE(PG8_SA(0, 1), a2 + hstep, voffA);
            PG8_WAIT_V(8); PG8_WAIT_L(0); PG8_BAR; if (!Sched::GATHER || mm0) { PG8_MMA(0, 0, At, B0); PG8_MMA(0, 1, At, B1); } PG8_BAR; PG8_SCHED;
            PG8_LDA(At, 1, 1); PG8_STAGE(PG8_SB(1, 0), b3, voffB); PG8_STAGE(PG8_SB(1, 1), b3 + hstep, voffB);
            if constexpr (Sched::GATHER) PG8_STAGE_G(PG8_SA(1, 0), oaS[0], k2 + kstep); else PG8_STAGE(PG8_SA(1, 0), a3, voffA);
            PG8_WAIT_V(8); PG8_WAIT_L(0); PG8_BAR; if (!Sched::GATHER || mm1) { PG8_MMA(1, 0, At, B0); PG8_MMA(1, 1, At, B1); } PG8_BAR; PG8_SCHED;
            } else {
            PG8_LDB(B0, 0, 0); PG8_SCHED; PG8_LDA(At, 0, 0); PG8_STAGE(PG8_SA(1, 1), a1 + hstep, voffA);
            PG8_WAIT_L(8); PG8_BAR; PG8_WAIT_L(0); PG8_MMA(0, 0, At, B0); PG8_BAR; PG8_SCHED;
            PG8_LDB(B1, 0, 1); PG8_STAGE(PG8_SB(0, 0), b2, voffB);
            PG8_BAR; PG8_WAIT_L(0); PG8_MMA(0, 1, At, B1); PG8_BAR;
            PG8_LDA(At, 0, 1); PG8_STAGE(PG8_SA(0, 0), a2, voffA);
            PG8_BAR; PG8_WAIT_L(0); PG8_MMA(1, 0, At, B0); PG8_BAR; PG8_SCHED;
            PG8_STAGE(PG8_SB(0, 1), b2 + hstep, voffB);
            PG8_WAIT_V(6); PG8_BAR; PG8_MMA(1, 1, At, B1); PG8_BAR;
            PG8_LDB(B0, 1, 0); PG8_SCHED; PG8_LDA(At, 1, 0); PG8_STAGE(PG8_SA(0, 1), a2 + hstep, voffA);
            PG8_WAIT_L(8); PG8_BAR; PG8_WAIT_L(0); PG8_MMA(0, 0, At, B0); PG8_BAR; PG8_SCHED;
            PG8_LDB(B1, 1, 1); PG8_STAGE(PG8_SB(1, 0), b3, voffB);
            PG8_BAR; PG8_WAIT_L(0); PG8_MMA(0, 1, At, B1); PG8_BAR;
            PG8_LDA(At, 1, 1); PG8_STAGE(PG8_SA(1, 0), a3, voffA);
            PG8_BAR; PG8_WAIT_L(0); PG8_MMA(1, 0, At, B0); PG8_BAR; PG8_SCHED;
            PG8_STAGE(PG8_SB(1, 1), b3 + hstep, voffB);
            PG8_WAIT_V(6); PG8_BAR; PG8_MMA(1, 1, At, B1); PG8_BAR;
            }
        }
        if constexpr (ALIGN_EPI) { if (wr == 0) PG8_BAR; }
        if constexpr (!Epi::AFTER_DRAIN) { E(acc, cur, wr, wc, fr, fq); S.done(cur); }
        if (!has_next) break;
#pragma unroll
        for (int a = 0; a < 2; ++a)
#pragma unroll
            for (int b = 0; b < 2; ++b)
#pragma unroll
                for (int m = 0; m < 4; ++m)
#pragma unroll
                    for (int n = 0; n < 2; ++n) acc[a][b][m][n] = (f32x4){0.f, 0.f, 0.f, 0.f};
        cur = nxt; cA = nA; cB = nB; ++ui;
        if constexpr (Sched::GATHER) { const int rws = S.rows(cur); mm0 = 64 * wr < rws; mm1 = 128 + 64 * wr < rws; }
        if constexpr (Sched::GATHER) {
#pragma unroll
            for (int _h = 0; _h < 2; ++_h)
#pragma unroll
                for (int _i = 0; _i < 2; ++_i) oaC[_h][_i] = oaN[_h][_i];
        }
        if constexpr (ALIGN_EPI) { if (wr == 1) PG8_BAR; }
    }
    PG8_WAIT_V(0);
    if constexpr (!ALIGN_EPI) { if (wr == 0) PG8_BAR; }
    PG8_BAR;
    if constexpr (Epi::AFTER_DRAIN) { E.fused(acc, cur, wr, wc, fr, fq, lds, wid, lane); S.done(cur); }
#undef PG8_GOFF
#undef PG8_STAGE_G
#undef PG8_SA
#undef PG8_SB
#undef PG8_STAGE
#undef PG8_LDA
#undef PG8_LDB
#undef PG8_MMA
#undef PG8_WAIT_V
#undef PG8_WAIT_L
#undef PG8_BAR
#undef PG8_SCHED
}
}

struct OutEpi8 {
    static constexpr bool PERM = false, AFTER_DRAIN = false;
    const float* src; float* dst; const float* gate; float* part;
    __device__ __forceinline__ void operator()(const pg8::f32x4 (&acc)[2][2][4][2], const pg8::Unit& u, int wr, int wc, int fr, int fq) const {
#pragma unroll
        for (int ai = 0; ai < 2; ++ai)
#pragma unroll
            for (int m = 0; m < 4; ++m) {
                const int t = u.pm * 256 + ai * 128 + wr * 64 + m * 16 + fr;
                const float* gp = gate + (t >> 11) * 6144;
                float ss = 0.f;
#pragma unroll
                for (int bj = 0; bj < 2; ++bj)
#pragma unroll
                    for (int n = 0; n < 2; ++n) {
                        const int col = u.pn * 256 + bj * 128 + wc * 32 + n * 16 + fq * 4;
                        const pg8::f32x4 g = *(const pg8::f32x4*)(gp + col);
                        const pg8::f32x4 o = *(const pg8::f32x4*)(src + (size_t)t * 1024 + col) + g * acc[ai][bj][m][n];
                        *(pg8::f32x4*)(dst + (size_t)t * 1024 + col) = o;
                        ss += o[0] * o[0] + o[1] * o[1] + o[2] * o[2] + o[3] * o[3];
                    }
                ss += sx_f<16>(ss); ss += sx_f<32>(ss);
                if (fq == 0) part[(size_t)t * 16 + u.pn * 4 + wc] = ss;
            }
    }
};


DI unsigned cvtpk(float lo, float hi) { return pk2(lo, hi); }
struct HybEpi8 {
    static constexpr bool PERM = true, AFTER_DRAIN = false;
    const Params* p; int j;
    __device__ __forceinline__ void operator()(const pg8::f32x4 (&acc)[2][2][4][2], const pg8::Unit& u, int wr, int wc, int fr, int fq) const {
        unsigned char* ws = p->ws;
        const int un = u.pn;
        if (un < 5 && !(un == 4 && (wc == 1 || wc == 3))) {
            const bool donorm = un < 2 || (un == 4 && wc == 0);
            bf16_t* ob; int ld, cb; const float* gam = p->hy_q_norm + j * 64;
            if (un < 2) { ob = (bf16_t*)(ws + WS_Q); ld = 512; cb = 64 * (4 * un + wc); }
            else if (un < 4) { ob = (bf16_t*)(ws + WS_IQ); ld = 512; cb = 64 * (4 * (un - 2) + wc); }
            else if (wc == 0) { ob = (bf16_t*)(ws + WS_K); ld = 64; cb = 0; gam = p->hy_k_norm + j * 64; }
            else { ob = (bf16_t*)(ws + WS_IK); ld = 64; cb = 0; }
            pg8::f32x4 g0[2], g1[2];
#pragma unroll
            for (int n = 0; n < 2; ++n) { g0[n] = donorm ? *(const pg8::f32x4*)(gam + 8 * fq + 4 * n) : (pg8::f32x4){1.f, 1.f, 1.f, 1.f}; g1[n] = donorm ? *(const pg8::f32x4*)(gam + 32 + 8 * fq + 4 * n) : (pg8::f32x4){1.f, 1.f, 1.f, 1.f}; }
            const float* ropec = (const float*)(ws + WS_ROPEC);
            const float* ropes = (const float*)(ws + WS_ROPES);
            pg8::f32x4 rc[2][2], rs[2][2];
#define HYB_ROPE_LD(buf, st) do { const int t_ = opq(u.pm * 256 + ((st) >> 2) * 128 + wr * 64 + ((st) & 3) * 16 + fr), pos_ = t_ & (S - 1); _Pragma("unroll") for (int n = 0; n < 2; ++n) { \
                rc[buf][n] = *(const pg8::f32x4*)(ropec + pos_ * 32 + 8 * fq + 4 * n); rs[buf][n] = *(const pg8::f32x4*)(ropes + pos_ * 32 + 8 * fq + 4 * n); } } while (0)
            HYB_ROPE_LD(0, 0);
#pragma unroll
            for (int ai = 0; ai < 2; ++ai)
#pragma unroll
                for (int m = 0; m < 4; ++m) {
                    const int st = ai * 4 + m, cb_ = st & 1;
                    if (st < 7) { if (cb_) HYB_ROPE_LD(0, st + 1); else HYB_ROPE_LD(1, st + 1); }
                    const int t = opq(u.pm * 256 + ai * 128 + wr * 64 + m * 16 + fr);
                    float rstd = 1.f;
                    if (donorm) {
                        float ss = 0.f;
#pragma unroll
                        for (int bj = 0; bj < 2; ++bj)
#pragma unroll
                            for (int n = 0; n < 2; ++n) { const pg8::f32x4 x = acc[ai][bj][m][n]; ss += x[0] * x[0] + x[1] * x[1] + x[2] * x[2] + x[3] * x[3]; }
                        ss += sx_f<16>(ss); ss += sx_f<32>(ss);
                        rstd = rsqrtf(ss * (1.f / 64.f) + EPS);
                    }
                    u32x4 o1, o2;
#pragma unroll
                    for (int n = 0; n < 2; ++n) {
                        const pg8::f32x4 cs = rc[cb_][n], sn = rs[cb_][n];
                        const pg8::f32x4 x1 = acc[ai][0][m][n] * rstd * g0[n], x2 = acc[ai][1][m][n] * rstd * g1[n];
                        const pg8::f32x4 y1 = x1 * cs - x2 * sn, y2 = x2 * cs + x1 * sn;
                        o1[2 * n] = cvtpk(y1[0], y1[1]); o1[2 * n + 1] = cvtpk(y1[2], y1[3]);
                        o2[2 * n] = cvtpk(y2[0], y2[1]); o2[2 * n + 1] = cvtpk(y2[2], y2[3]);
                    }
                    if (un == 4) {
                        const int kk = t & 31, cs_ = (wc == 0) ? ((kk & ~12) | ((kk & 4) << 1) | ((kk & 8) >> 1)) : kk;
                        bf16_t* fb = ob + ((size_t)(t >> 5) * 256 + (fq >> 1) * 64 + (fq & 1) * 32 + cs_) * 8;
                        *(u32x4*)fb = o1; *(u32x4*)(fb + 128 * 8) = o2;
                    } else {
                    *(u32x4*)(ob + (size_t)t * ld + cb + 8 * fq) = o1;
                    *(u32x4*)(ob + (size_t)t * ld + cb + 32 + 8 * fq) = o2;
                    }
                }
#undef HYB_ROPE_LD
        } else if (un == 4 && wc == 1) {
            bf16_t* ob = (bf16_t*)(ws + WS_V);
#pragma unroll
            for (int ai = 0; ai < 2; ++ai)
#pragma unroll
                for (int m = 0; m < 4; ++m) {
                    const int t = opq(u.pm * 256 + ai * 128 + wr * 64 + m * 16 + fr), pos = t & (S - 1);
#pragma unroll
                    for (int bj = 0; bj < 2; ++bj)
#pragma unroll
                        for (int n = 0; n < 2; ++n)
#pragma unroll
                            for (int e = 0; e < 4; ++e) ob[((((size_t)(t >> 5) * 4 + bj + ((pos >> 4) & 1) * 2) * 2 + ((pos >> 3) & 1)) * 32 + 8 * fq + 4 * n + e) * 8 + (pos & 7)] = f2bf(acc[ai][bj][m][n][e]);
                }
        } else if (un == 4) {
            float* ob = (float*)(ws + WS_IW);
            if (fq == 0) {
#pragma unroll
                for (int ai = 0; ai < 2; ++ai)
#pragma unroll
                    for (int m = 0; m < 4; ++m) {
                        const int t = u.pm * 256 + ai * 128 + wr * 64 + m * 16 + fr;
                        *(pg8::f32x4*)(ob + (size_t)t * 8) = acc[ai][0][m][0] * (0.125f * 0.35355339059327373f);
                        *(pg8::f32x4*)(ob + (size_t)t * 8 + 4) = acc[ai][0][m][1] * (0.125f * 0.35355339059327373f);
                    }
            }
        } else if (un < 7) {
            bf16_t* ob = (bf16_t*)(ws + WS_BG);
#pragma unroll
            for (int ai = 0; ai < 2; ++ai)
#pragma unroll
                for (int m = 0; m < 4; ++m) {
                    const int t = opq(u.pm * 256 + ai * 128 + wr * 64 + m * 16 + fr);
#pragma unroll
                    for (int bj = 0; bj < 2; ++bj) {
                        const pg8::f32x4 a = acc[ai][bj][m][0], b = acc[ai][bj][m][1];
                        u32x4 o = {cvtpk(a[0], a[1]), cvtpk(a[2], a[3]), cvtpk(b[0], b[1]), cvtpk(b[2], b[3])};
                        *(u32x4*)(ob + (size_t)t * 512 + (un - 5) * 256 + 128 * bj + 32 * wc + 8 * fq) = o;
                    }
                }
        } else {
            bf16_t* ob = (bf16_t*)(ws + WS_Z);
#pragma unroll
            for (int ai = 0; ai < 2; ++ai)
#pragma unroll
                for (int m = 0; m < 4; ++m) {
                    const int t = opq(u.pm * 256 + ai * 128 + wr * 64 + m * 16 + fr);
                    const pg8::f32x4 a = acc[ai][0][m][0] * acc[ai][1][m][0], b = acc[ai][0][m][1] * acc[ai][1][m][1];
                    u32x4 o = {cvtpk(a[0], a[1]), cvtpk(a[2], a[3]), cvtpk(b[0], b[1]), cvtpk(b[2], b[3])};
                    *(u32x4*)(ob + (size_t)t * 512 + (un - 7) * 128 + 32 * wc + 8 * fq) = o;
                }
        }
    }
};


struct MlEpi8 {
    static constexpr bool PERM = true, AFTER_DRAIN = false;
    const Params* p; int j;
    __device__ __forceinline__ void operator()(const pg8::f32x4 (&acc)[2][2][4][2], const pg8::Unit& u, int wr, int wc, int fr, int fq) const {
        unsigned char* ws = p->ws;
        const int un = u.pn;
        if (un < 4) {
            bf16_t* ob = (bf16_t*)(ws + (un < 2 ? WS_MQ : WS_MK));
            const int hd = 4 * (un & 1) + wc; const float sc = un < 2 ? 0.125f : 1.f;
            const int cs_ = un < 2 ? fr : ((fr & ~12) | ((fr & 4) << 1) | ((fr & 8) >> 1));
#pragma unroll
            for (int ai = 0; ai < 2; ++ai)
#pragma unroll
                for (int m = 0; m < 4; ++m) {
                    const int tq = opq(u.pm * 4 + ai * 2 + wr);
                    const int item = ((tq >> 5) * 8 + hd) * 32 + (tq & 31);
                    bf16_t* ib = ob + ((size_t)(item * 2 + (m >> 1)) * 256 + (fq & 1) * 32 + (m & 1) * 16 + cs_) * 8;
#pragma unroll
                    for (int bj = 0; bj < 2; ++bj) {
                        const pg8::f32x4 a = acc[ai][bj][m][0] * sc, b = acc[ai][bj][m][1] * sc;
                        u32x4 o = {cvtpk(a[0], a[1]), cvtpk(a[2], a[3]), cvtpk(b[0], b[1]), cvtpk(b[2], b[3])};
                        *(u32x4*)(ib + (2 * bj + (fq >> 1)) * 64 * 8) = o;
                    }
                }
        } else if (un >= 8) {
            bf16_t* ob = (bf16_t*)(ws + WS_MOG);
#pragma unroll
            for (int ai = 0; ai < 2; ++ai)
#pragma unroll
                for (int m = 0; m < 4; ++m) {
                    const int tq = opq(u.pm * 4 + ai * 2 + wr);
#pragma unroll
                    for (int bj = 0; bj < 2; ++bj) {
                        const int item = ((tq >> 5) * 8 + 2 * (un - 8) + bj) * 32 + (tq & 31);
                        pg8::f32x4 a = acc[ai][bj][m][0], b = acc[ai][bj][m][1];
#pragma unroll
                        for (int e = 0; e < 4; ++e) { a[e] = sigmoidf_(a[e]); b[e] = sigmoidf_(b[e]); }
                        bf16_t* ib = ob + ((size_t)(((item * 2 + (m >> 1)) * 4 + wc) * 4 + fq) * 64 + (m & 1) * 16 + fr) * 4;
                        u32x2 o0 = {cvtpk(a[0], a[1]), cvtpk(a[2], a[3])}, o1 = {cvtpk(b[0], b[1]), cvtpk(b[2], b[3])};
                        *(u32x2*)ib = o0; *(u32x2*)(ib + 32 * 4) = o1;
                    }
                }
        }
        if (un >= 2 && un < 8) {
            bf16_t* ob = (bf16_t*)(ws + (un < 4 ? WS_MKT : WS_MV));
#pragma unroll
            for (int ai = 0; ai < 2; ++ai)
#pragma unroll
                for (int m = 0; m < 4; ++m) {
                    const int tq = opq(u.pm * 4 + ai * 2 + wr);
#pragma unroll
                    for (int bj = 0; bj < 2; ++bj) {
                        const int hd = un < 4 ? 4 * (un - 2) + wc : 2 * (un - 4) + bj;
                        const int item = ((tq >> 5) * 8 + hd) * 32 + (tq & 31);
                        bf16_t* ib = ob + (un < 4 ? ((size_t)((item * 2 + bj) * 4 + m) * 64 + (fr >> 3) * 32 + 8 * fq) * 8 : ((size_t)((item * 4 + wc) * 4 + m) * 64 + (fr >> 3) * 32 + 8 * fq) * 8) + (fr & 7);
#pragma unroll
                        for (int n = 0; n < 2; ++n)
#pragma unroll
                            for (int e = 0; e < 4; ++e) ib[(4 * n + e) * 8] = f2bf(acc[ai][bj][m][n][e]);
                    }
                }
        }
    }
};


struct MoeOrder8 {
    static constexpr bool GATHER = true;
    const int* tab; const int* elist; int G, c, total, mode;
    __device__ __forceinline__ bool next(int i, pg8::Unit& u) const {
        const int cl = (G & 7) ? c : (c & 7) * (G >> 3) + (c >> 3);
        const int wg = i * G + cl; if (wg >= total) return false;
        u.pm = __builtin_amdgcn_readfirstlane(tab[wg >> 2]); u.pn = __builtin_amdgcn_readfirstlane((u.pm >> 8) * 4 + (wg & 3)); return true;
    }
    __device__ __forceinline__ int rows(const pg8::Unit& u) const { const int r = tab[168 + (u.pm >> 8)] - (u.pm & 255) * 256; return __builtin_amdgcn_readfirstlane(r < 256 ? r : 256); }
    __device__ __forceinline__ unsigned a_off(const pg8::Unit& u, int row) const {
        const int e = u.pm >> 8, lr = (u.pm & 255) * 256 + row;
        if (lr >= tab[168 + e]) return 0u;
        if (mode == 1) return (unsigned)(elist[e * NASG + lr] >> 1) * 2048u;
        return (unsigned)(tab[200 + e] + lr) * 1024u;
    }
    __device__ __forceinline__ void a_ready(const pg8::Unit&) const {}
    __device__ __forceinline__ void done(const pg8::Unit&) const {}
};
struct Moe1Epi8 {
    static constexpr bool PERM = true, AFTER_DRAIN = false;
    const int* tab; bf16_t* h1;
    __device__ __forceinline__ void operator()(const pg8::f32x4 (&acc)[2][2][4][2], const pg8::Unit& u, int wr, int wc, int fr, int fq) const {
        const int e = u.pm >> 8, mu = u.pm & 255, nu = u.pn & 3, cnt = tab[168 + e], roff = tab[200 + e];
#pragma unroll
        for (int ai = 0; ai < 2; ++ai)
#pragma unroll
            for (int m = 0; m < 4; ++m) {
                const int lr = opq(mu * 256 + ai * 128 + wr * 64 + m * 16 + fr);
                if (lr < cnt) {
                    u32x4 o;
#pragma unroll
                    for (int n = 0; n < 2; ++n) {
                        const pg8::f32x4 g = acc[ai][0][m][n], up = acc[ai][1][m][n]; float h[4];
#pragma unroll
                        for (int x = 0; x < 4; ++x) h[x] = g[x] * __builtin_amdgcn_rcpf(1.f + __expf(-g[x])) * up[x];
                        o[2 * n] = cvtpk(h[0], h[1]); o[2 * n + 1] = cvtpk(h[2], h[3]);
                    }
                    *(u32x4*)(h1 + (size_t)(roff + lr) * 512 + 128 * nu + 32 * wc + 8 * fq) = o;
                }
            }
    }
};
struct Moe2Epi8 {
    static constexpr bool PERM = true, AFTER_DRAIN = false;
    const int* tab; const int* elist; bf16_t* y;
    __device__ __forceinline__ void operator()(const pg8::f32x4 (&acc)[2][2][4][2], const pg8::Unit& u, int wr, int wc, int fr, int fq) const {
        const int e = u.pm >> 8, mu = u.pm & 255, nu = u.pn & 3, cnt = tab[168 + e];
#pragma unroll
        for (int ai = 0; ai < 2; ++ai)
#pragma unroll
            for (int m = 0; m < 4; ++m) {
                const int lr = opq(mu * 256 + ai * 128 + wr * 64 + m * 16 + fr);
                if (lr < cnt) {
                    const int a = elist[e * NASG + lr];
#pragma unroll
                    for (int bj = 0; bj < 2; ++bj) {
                        const pg8::f32x4 v0 = acc[ai][bj][m][0], v1 = acc[ai][bj][m][1];
                        u32x4 o = {cvtpk(v0[0], v0[1]), cvtpk(v0[2], v0[3]), cvtpk(v1[0], v1[1]), cvtpk(v1[2], v1[3])};
                        *(u32x4*)(y + (size_t)a * 1024 + 256 * nu + 128 * bj + 32 * wc + 8 * fq) = o;
                    }
                }
            }
    }
};

#define XB_TMO      128
#define XB_XCNT(j)  (256  + 64 * (j))
#define XB_XSUB(j)  (1280 + 64 * (j))
#define XB_XGEN(j)  (2304 + 64 * (j))
#define XB_TOP      3328
#define XB_TOPGEN   3392
#define XCD_BAR_WORDS 3456
#define XB_SPIN_CAP (1u << 22)
#define LAS __attribute__((address_space(3)))
DI unsigned xb_ld(unsigned* p) { return __hip_atomic_load(p, __ATOMIC_RELAXED, __HIP_MEMORY_SCOPE_AGENT); }
DI unsigned xb_add(unsigned* p, unsigned v) { return __hip_atomic_fetch_add(p, v, __ATOMIC_RELAXED, __HIP_MEMORY_SCOPE_AGENT); }
DI unsigned xb_xcc_id() { return (unsigned)__builtin_amdgcn_s_getreg((3 << 11) | 20) & 0xFu; }
#define XB_SPIN(cond, bar) do { unsigned _sp = 0; while (cond) { __builtin_amdgcn_s_sleep(1); \
    if ((++_sp & 255u) == 0u) { if (xb_ld(&(bar)[XB_TMO])) break; if (_sp > XB_SPIN_CAP) { atomicAdd(&(bar)[XB_TMO], 1u); break; } } } } while (0)
struct XcdBarrier { unsigned* bar; unsigned x; volatile LAS unsigned* st; };
DI XcdBarrier xcd_barrier_post(unsigned* bar, volatile LAS unsigned* st, bool leader) {
    XcdBarrier b; b.bar = bar; b.x = xb_xcc_id(); b.st = st;
    if (leader) (void)xb_add(&bar[XB_XCNT(b.x)], 1u);
    return b;
}
DI void xcd_barrier_complete(unsigned* bar, unsigned x, unsigned& nloc, unsigned& nx) {
    const unsigned G = gridDim.x * gridDim.y * gridDim.z;
    unsigned sum, cnt, mine, sp = 0u;
    for (;;) {
        sum = 0u; cnt = 0u; mine = 0u;
#pragma unroll
        for (unsigned j = 0; j < 16; ++j) { const unsigned c = xb_ld(&bar[XB_XCNT(j)]); sum += c; cnt += (c > 0u) ? 1u : 0u; mine = (j == x) ? c : mine; }
        if (sum == G) break;
        __builtin_amdgcn_s_sleep(1);
        if ((++sp & 255u) == 0u) { if (xb_ld(&bar[XB_TMO])) break; if (sp > XB_SPIN_CAP) { atomicAdd(&bar[XB_TMO], 1u); break; } }
    }
    nloc = mine > 0u ? mine : 1u; nx = cnt > 0u ? cnt : 1u;
}
DI void xcd_barrier(const XcdBarrier& b, bool leader) {
    asm volatile("s_waitcnt vmcnt(0)" ::: "memory");
    __syncthreads();
    if (leader) {
        unsigned* bar = b.bar;
        __builtin_amdgcn_s_waitcnt(0);
        unsigned nloc = b.st[0], nx = b.st[1];
        if (nloc == 0u) { xcd_barrier_complete(bar, b.x, nloc, nx); b.st[0] = nloc; b.st[1] = nx; }
        const unsigned old = xb_add(&bar[XB_XSUB(b.x)], 1u);
        const unsigned gen = old / nloc;
        if (old + 1u == (gen + 1u) * nloc) {
            __builtin_amdgcn_fence(__ATOMIC_RELEASE, "agent");
            asm volatile("s_waitcnt vmcnt(0)" ::: "memory");
            const unsigned og = xb_add(&bar[XB_TOP], 1u);
            const unsigned tg = og / nx;
            if (og + 1u == (tg + 1u) * nx) xb_add(&bar[XB_TOPGEN], 1u);
            else XB_SPIN(xb_ld(&bar[XB_TOPGEN]) == tg, bar);
            __builtin_amdgcn_fence(__ATOMIC_ACQUIRE, "agent");
            xb_add(&bar[XB_XGEN(b.x)], 1u);
            asm volatile("s_waitcnt vmcnt(0)" ::: "memory");
        } else {
            XB_SPIN(xb_ld(&bar[XB_XGEN(b.x)]) == gen, bar);
            __builtin_amdgcn_fence(__ATOMIC_ACQUIRE, "agent");
            asm volatile("s_waitcnt vmcnt(0)" ::: "memory");
        }
    }
    __syncthreads();
}

namespace cg = cooperative_groups;
constexpr int MEGA_LDS = 65536 + 256;

DI const Params& fresh(const Params* kp) { asm volatile("" : "+s"(kp)); return *kp; }

#ifndef PROBE_MASK
#define PROBE_MASK 0
#endif
__global__ void __launch_bounds__(512, 2) hybrid_fwd_megakernel(Params p_arg) {
    __shared__ __attribute__((aligned(16))) unsigned char smem_all[2 * MEGA_LDS + 1024];
    cg::grid_group grid = cg::this_grid();
    const Params* kp = (const Params*)__builtin_amdgcn_kernarg_segment_ptr();
    const int wave8 = __builtin_amdgcn_readfirstlane((int)(threadIdx.x >> 6));
    const int vb = wave8 >> 2;
#define tid0 ((wave8 & 3) * 64 + lane_id())
    unsigned char* smem = smem_all + vb * MEGA_LDS;
    const int bid0 = blockIdx.x * 2 + vb, nb = gridDim.x * 2;
    const int gx0 = blockIdx.x & 7, glb0 = (blockIdx.x >> 3) * 2 + vb, gnl = (gridDim.x >> 3) * 2;
#define bid opqs(bid0)
#define gx opqs(gx0)
#define glb opqs(glb0)
#define tid opq(tid0)
    volatile LAS unsigned* xst = (volatile LAS unsigned*)(smem_all + 2 * MEGA_LDS);
    if (wave8 == 0 && lane_id() == 0) { xst[0] = 0u; xst[1] = 0u; }
    __syncthreads();
    (void)xcd_barrier_post((unsigned*)(fresh(kp).ws + WS_BAR), xst, wave8 == 0 && lane_id() == 0);
    for (int rep = 0; rep < ((PROBE_MASK & 1) ? 2 : 1); ++rep) { phase_init(fresh(kp), smem, bid, nb, tid); }
#define GSYNC() do { XcdBarrier xb_; xb_.bar = (unsigned*)(fresh(kp).ws + WS_BAR); xb_.x = xb_xcc_id(); xb_.st = (volatile LAS unsigned*)(smem_all + 2 * MEGA_LDS); xcd_barrier(xb_, wave8 == 0 && lane_id() == 0); } while (0)
    if (fresh(kp).use_cg_sync) grid.sync();
    GSYNC();
#pragma unroll 1
    for (int layer = 0; layer < DEPTH; ++layer) {
        const int j = layer >> 1;
        if (layer == 0) { { const Params& p = fresh(kp); phase_norm(p, 0, p.x, bid, nb, tid); }
        GSYNC(); }
        if ((layer & 1) == 0) {
            for (int rep = 0; rep < ((PROBE_MASK & 4) ? 2 : 1); ++rep) { { const Params& p = fresh(kp);
              pg8::Gemm g8{(const pg8::bf16_t*)(p.ws + WS_H), (const pg8::bf16_t*)(p.ws + WS_WHYB) + (size_t)j * 2816 * 1024, T, 2816, 1024};
              pg8::StaticOrder S8; S8.init(T, 2816, (int)gridDim.x, (int)blockIdx.x);
              HybEpi8 E8{&p, j};
              pg8::gemm_phase<HybEpi8, pg8::StaticOrder, true, true>((PG8_LAS unsigned char*)smem_all, g8, S8, E8, wave8 * 64 + lane_id()); } }
            GSYNC();
            for (int rep = 0; rep < ((PROBE_MASK & 8) ? 2 : 1); ++rep) { phase_dsa(fresh(kp), j, smem, bid, nb, tid, layer == 0 ? 1 : 3, layer == 0 ? 3 : 4); }
            for (int rep = 0; rep < ((PROBE_MASK & 16) ? 2 : 1); ++rep) { phase_conv(fresh(kp), j, bid, nb, tid); }
            GSYNC();
            { const Params& p = fresh(kp);
              pg8::Gemm g8{(const pg8::bf16_t*)(p.ws + WS_YMIX), (const pg8::bf16_t*)(p.ws + WS_WOUT) + (size_t)layer * 1024 * 1024, T, 1024, 1024};
              pg8::StaticOrder S8; S8.init(T, 1024, (int)gridDim.x, (int)blockIdx.x);
              OutEpi8 E8{layer == 0 ? p.x : p.out, p.out, (const float*)(p.ws + WS_MOD) + (size_t)layer * 8 * 6144 + 2048, (float*)(p.ws + WS_PART)};
              pg8::gemm_phase<OutEpi8, pg8::StaticOrder, true, true>((PG8_LAS unsigned char*)smem_all, g8, S8, E8, wave8 * 64 + lane_id()); }
        } else {
            for (int rep = 0; rep < ((PROBE_MASK & 32) ? 2 : 1); ++rep) { { const Params& p = fresh(kp);
              pg8::Gemm g8{(const pg8::bf16_t*)(p.ws + WS_H), (const pg8::bf16_t*)(p.ws + WS_WML) + (size_t)j * 3200 * 1024, T, 3072, 1024};
              pg8::StaticOrder S8; S8.init(T, 3072, (int)gridDim.x, (int)blockIdx.x);
              MlEpi8 E8{&p, j};
              pg8::gemm_phase<MlEpi8, pg8::StaticOrder, true, true>((PG8_LAS unsigned char*)smem_all, g8, S8, E8, wave8 * 64 + lane_id());
              for (int gi = glb; gi < 16; gi += gnl) { MlGates pr{&p, j, gx * 16 + gi}; gemm_tile(pr, smem, tid); } } }
            GSYNC();
            for (int rep = 0; rep < ((PROBE_MASK & 64) ? 2 : 1); ++rep) { phase_ml1(fresh(kp), smem, bid, nb, tid); }
            GSYNC();
            for (int rep = 0; rep < ((PROBE_MASK & 128) ? 2 : 1); ++rep) { phase_ml2(fresh(kp), smem, bid, nb, tid); }
            GSYNC();
            for (int rep = 0; rep < ((PROBE_MASK & 256) ? 2 : 1); ++rep) { phase_ml3(fresh(kp), j, smem, bid, nb, tid); }
            GSYNC();
            { const Params& p = fresh(kp);
              pg8::Gemm g8{(const pg8::bf16_t*)(p.ws + WS_YMIX), (const pg8::bf16_t*)(p.ws + WS_WOUT) + (size_t)layer * 1024 * 1024, T, 1024, 1024};
              pg8::StaticOrder S8; S8.init(T, 1024, (int)gridDim.x, (int)blockIdx.x);
              OutEpi8 E8{p.out, p.out, (const float*)(p.ws + WS_MOD) + (size_t)layer * 8 * 6144 + 2048, (float*)(p.ws + WS_PART)};
              pg8::gemm_phase<OutEpi8, pg8::StaticOrder, true, true>((PG8_LAS unsigned char*)smem_all, g8, S8, E8, wave8 * 64 + lane_id()); }
        }
        GSYNC();
        phase_ffn_norm_router(fresh(kp), layer, smem, bid, nb, tid);
        GSYNC();
        { const Params& p = fresh(kp); unsigned char* wsu = uniform_ptr(p.ws);
          int* mtab = (int*)(smem_all + 2 * MEGA_LDS + 64);
          __syncthreads();
          if (wave8 == 0) {
              const int e = lane_id(); const int cn = e < 32 ? ((const int*)(wsu + WS_ECNT))[(layer * 32 + e) * ECS] : 0;
              const int nf = cn >> 8, r = cn & 255;
              if (e < 32) { mtab[168 + e] = cn; mtab[112 + e] = nf; }
              __builtin_amdgcn_wave_barrier();
              int fx = 0, sx = 0, nF = 0;
#pragma unroll
              for (int k = 0; k < 32; ++k) { const int ck = mtab[168 + k], fk = mtab[112 + k]; fx += k < e ? fk : 0; sx += k < e ? ck : 0; nF += fk; }
              __builtin_amdgcn_wave_barrier();
              const int cls = r == 0 ? 3 : (r > 128 ? 0 : (r > 64 ? 1 : 2));
              const unsigned long long b0 = __ballot(e < 32 && cls == 0), b1 = __ballot(e < 32 && cls == 1), b2 = __ballot(e < 32 && cls == 2);
              const unsigned long long lt = (1ull << e) - 1ull;
              const int pos = cls == 0 ? __popcll(b0 & lt) : cls == 1 ? __popcll(b0) + __popcll(b1 & lt) : __popcll(b0) + __popcll(b1) + __popcll(b2 & lt);
              if (e < 32) {
                  mtab[200 + e] = sx;
                  for (int mu = 0; mu < nf; ++mu) mtab[fx + mu] = (e << 8) | mu;
                  if (cls < 3) mtab[nF + pos] = (e << 8) | nf;
              }
              if (e == 0) mtab[160] = nF + __popcll(b0 | b1 | b2);
          }
          __syncthreads();
          MoeOrder8 S8{mtab, (const int*)(wsu + WS_ELIST), (int)gridDim.x, (int)blockIdx.x, mtab[160] * 4, 1};
          pg8::Gemm g8{(const pg8::bf16_t*)(wsu + WS_H), (const pg8::bf16_t*)(wsu + WS_WM1) + (size_t)layer * 32 * 1024 * 1024, 0, 0, 1024};
          Moe1Epi8 E8{mtab, (bf16_t*)(wsu + WS_H1)};
          pg8::gemm_phase<Moe1Epi8, MoeOrder8, true, true>((PG8_LAS unsigned char*)smem_all, g8, S8, E8, wave8 * 64 + lane_id()); }
        GSYNC();
        { const Params& p = fresh(kp); unsigned char* wsu = uniform_ptr(p.ws);
          int* mtab = (int*)(smem_all + 2 * MEGA_LDS + 64);
          MoeOrder8 S8{mtab, (const int*)(wsu + WS_ELIST), (int)gridDim.x, (int)blockIdx.x, mtab[160] * 4, 2};
          pg8::Gemm g8{(const pg8::bf16_t*)(wsu + WS_H1), (const pg8::bf16_t*)(wsu + WS_WM2) + (size_t)layer * 32 * 1024 * 512, 0, 0, 512};
          Moe2Epi8 E8{mtab, (const int*)(wsu + WS_ELIST), (bf16_t*)(wsu + WS_Y)};
          pg8::gemm_phase<Moe2Epi8, MoeOrder8, true, true>((PG8_LAS unsigned char*)smem_all, g8, S8, E8, wave8 * 64 + lane_id()); }
        GSYNC();
        phase_combine_norm(fresh(kp), layer, bid, nb, tid);
        if (layer + 1 < DEPTH) GSYNC();
    }
}
#undef tid
#undef tid0
#undef bid
#undef gx
#undef glb
#undef GSYNC

extern "C" void kernel_launch(void* const* d_in, const int* in_sizes, int n_in, void* d_out, int out_size, void* d_ws, size_t ws_size, hipStream_t stream) {
    Params p{};
    const float** f = (const float**)&p;
    for (int i = 0; i < 22; ++i) f[i] = (const float*)d_in[i];
    p.out = (float*)d_out;
    p.ws = (unsigned char*)d_ws;
    if (ws_size < WS_END) { fprintf(stderr, "workspace too small: %zu < %zu\n", ws_size, (size_t)WS_END); return; }
    static int grid_blocks = 0;
    if (!grid_blocks) {
        int dev = 0, cus = 0, per_cu = 0;
        hipGetDevice(&dev);
        hipDeviceGetAttribute(&cus, hipDeviceAttributeMultiprocessorCount, dev);
        hipOccupancyMaxActiveBlocksPerMultiprocessor(&per_cu, hybrid_fwd_megakernel, 512, 0);
        if (per_cu > 1) per_cu = 1;
        grid_blocks = cus * per_cu;
    }
    (void)hipMemsetAsync((unsigned char*)d_ws + WS_BAR, 0, XCD_BAR_WORDS_C * 4, stream);
    void* args[] = {&p};
    hipError_t e = hipLaunchCooperativeKernel((void*)hybrid_fwd_megakernel, dim3(grid_blocks), dim3(512), args, 0, stream);
    if (e != hipSuccess) fprintf(stderr, "cooperative launch failed: %s (grid %d)\n", hipGetErrorString(e), grid_blocks);
}
```

```cpp
#include <hip/hip_runtime.h>
#include <hip/hip_cooperative_groups.h>
#include <stdint.h>
#include <cstdio>

#define DI __device__ __forceinline__
typedef unsigned short bf16_t;
typedef short bf16x8 __attribute__((ext_vector_type(8)));
typedef float f32x16 __attribute__((ext_vector_type(16)));
typedef float f32x4 __attribute__((ext_vector_type(4)));
typedef float f32x2 __attribute__((ext_vector_type(2)));
typedef unsigned u32x4 __attribute__((ext_vector_type(4)));
typedef unsigned u32x2 __attribute__((ext_vector_type(2)));
typedef __bf16 bf16x2_t __attribute__((ext_vector_type(2)));

constexpr int D = 1024, NB = 8, S = 2048, T = NB * S, DEPTH = 4;
constexpr int HYB_IN = 2760, ML_IN = 3088;
constexpr int NEXP = 32, DEXP = 512, NASG = T * 2;
constexpr float EPS = 1e-6f;
constexpr int XCD_BAR_WORDS_C = 3456;

constexpr size_t al256(size_t x) { return (x + 255) & ~(size_t)255; }
constexpr size_t WS_MOD = 0;
constexpr size_t WS_ROPEC = WS_MOD + al256((size_t)4 * 8 * 6144 * 4);
constexpr size_t WS_ROPES = WS_ROPEC + al256((size_t)2048 * 32 * 4);
constexpr size_t WS_ECNT = WS_ROPES + al256((size_t)2048 * 32 * 4);
constexpr int ECS = 64;
constexpr size_t WS_H = WS_ECNT + al256(4 * 32 * ECS * 4);
constexpr size_t WS_YMIX = WS_H + al256((size_t)T * 1024 * 2);
constexpr size_t WS_Q = WS_YMIX + al256((size_t)T * 1024 * 2);
constexpr size_t WS_K = WS_Q + al256((size_t)T * 512 * 2);
constexpr size_t WS_V = WS_K + al256((size_t)T * 64 * 2);
constexpr size_t WS_IQ = WS_V + al256((size_t)T * 64 * 2);
constexpr size_t WS_IK = WS_IQ + al256((size_t)T * 512 * 2);
constexpr size_t WS_IW = WS_IK + al256((size_t)T * 64 * 2);
constexpr size_t WS_BG = WS_IW + al256((size_t)T * 8 * 4);
constexpr size_t WS_Z = WS_BG + al256((size_t)T * 512 * 2);
constexpr size_t WS_MASK = WS_Z + al256((size_t)T * 512 * 2);
constexpr size_t WS_MQ = WS_MASK + al256((size_t)T * 64 * 4);
constexpr size_t WS_MK = WS_MQ + al256((size_t)T * 512 * 2);
constexpr size_t WS_MV = WS_MK + al256((size_t)T * 512 * 2);
constexpr size_t WS_MIG = WS_MV + al256((size_t)T * 1024 * 2);
constexpr size_t WS_MFG = WS_MIG + al256((size_t)T * 8 * 4);
constexpr size_t WS_MOG = WS_MFG + al256((size_t)T * 8 * 4);
constexpr size_t WS_EW = WS_MOG + al256((size_t)T * 1024 * 2);
constexpr size_t WS_ELIST = WS_EW + al256((size_t)NASG * 4);
constexpr size_t WS_H1 = WS_ELIST + al256((size_t)NEXP * NASG * 4);
constexpr size_t WS_Y = WS_H1 + al256((size_t)NASG * 512 * 2);
constexpr size_t WS_MKT = WS_Y + al256((size_t)NASG * 1024 * 2);
constexpr size_t WS_UBUF = WS_MKT + al256((size_t)64 * 64 * S * 2);
constexpr size_t WS_UNBUF = WS_UBUF + al256((size_t)64 * 32 * 8192 * 4);
constexpr size_t WS_MLOC = WS_UNBUF + al256((size_t)64 * 32 * 64 * 4);
constexpr size_t WS_CBUF = WS_MLOC + al256((size_t)64 * 32 * 2 * 4);
constexpr size_t WS_NBUF = WS_CBUF + al256((size_t)64 * 32 * 8192 * 2);
constexpr size_t WS_MST = WS_NBUF + al256((size_t)64 * 32 * 64 * 4);
constexpr size_t WS_PART = WS_MST + al256((size_t)64 * 32 * 4);
constexpr size_t WS_WHYB = WS_PART + al256((size_t)T * 16 * 4);
constexpr size_t WS_WML = WS_WHYB + al256((size_t)2 * 2816 * 1024 * 2);
constexpr size_t WS_WOUT = WS_WML + al256((size_t)2 * 3200 * 1024 * 2);
constexpr size_t WS_WM1 = WS_WOUT + al256((size_t)4 * 1024 * 1024 * 2);
constexpr size_t WS_WM2 = WS_WM1 + al256((size_t)4 * 32 * 1024 * 1024 * 2);
constexpr size_t WS_BAR = WS_WM2 + al256((size_t)4 * 32 * 1024 * 512 * 2);
constexpr size_t WS_END = WS_BAR + al256((size_t)XCD_BAR_WORDS_C * 4);

struct Params {
    const float *x, *c, *ada_w, *ada_b, *norm_mix, *norm_ffn, *hy_w_in, *hy_q_norm, *hy_k_norm, *hy_conv_w, *hy_w_out;
    const float *ml_w_in, *ml_b_gates, *ml_out_norm, *ml_w_out, *moe_w_group, *moe_b_group, *moe_w_expert, *moe_b_expert;
    const float *moe_w_gate, *moe_w_up, *moe_w_down;
    float* out;
    unsigned char* ws;
    unsigned long long use_cg_sync;
};

DI unsigned pk2(float lo, float hi) { f32x2 v = {lo, hi}; bf16x2_t b = __builtin_convertvector(v, bf16x2_t); return __builtin_bit_cast(unsigned, b); }
DI bf16_t f2bf(float x) { return (bf16_t)(pk2(x, 0.f) & 0xffffu); }
DI float bf2f(bf16_t h) { return __uint_as_float(((unsigned)h) << 16); }
DI float bflo(unsigned u) { return __uint_as_float(u << 16); }
DI float bfhi(unsigned u) { return __uint_as_float(u & 0xffff0000u); }
DI int lane_id() { int x; asm volatile("v_mbcnt_lo_u32_b32 %0, -1, 0\n\tv_mbcnt_hi_u32_b32 %0, -1, %0" : "=v"(x)); return x; }
template <int M> DI int sx_i(int v) {
    if constexpr (M < 32) return __builtin_amdgcn_ds_swizzle(v, (M << 10) | 0x1f);
    else return __builtin_amdgcn_ds_bpermute((lane_id() ^ 32) << 2, v);
}
template <int M> DI float sx_f(float v) { return __int_as_float(sx_i<M>(__float_as_int(v))); }
DI float lane_get_f(float v, int src) { return __int_as_float(__builtin_amdgcn_ds_bpermute(src << 2, __float_as_int(v))); }
DI float wave_sum(float v) { v += sx_f<32>(v); v += sx_f<16>(v); v += sx_f<8>(v); v += sx_f<4>(v); v += sx_f<2>(v); v += sx_f<1>(v); return v; }
DI float wave_max(float v) { v = fmaxf(v, sx_f<32>(v)); v = fmaxf(v, sx_f<16>(v)); v = fmaxf(v, sx_f<8>(v)); v = fmaxf(v, sx_f<4>(v)); v = fmaxf(v, sx_f<2>(v)); v = fmaxf(v, sx_f<1>(v)); return v; }
DI float half_sum(float v) { v += sx_f<16>(v); v += sx_f<8>(v); v += sx_f<4>(v); v += sx_f<2>(v); v += sx_f<1>(v); return v; }
DI float sigmoidf_(float x) { return __builtin_amdgcn_rcpf(1.f + __expf(-x)); }
DI unsigned char* uniform_ptr(unsigned char* q) {
    const unsigned long long w = (unsigned long long)q;
    const unsigned lo = __builtin_amdgcn_readfirstlane((unsigned)w), hi = __builtin_amdgcn_readfirstlane((unsigned)(w >> 32));
    return (unsigned char*)(((unsigned long long)hi << 32) | lo);
}
DI int opqs(int x) { asm volatile("" : "+s"(x)); return x; }
DI int opq(int x) { asm volatile("" : "+v"(x)); return x; }

DI int swz(int row, int slot) { return row * 128 + ((slot ^ ((row >> 1) & 7)) << 4); }
DI int crow(int reg, int lane) { return (reg & 3) + 8 * (reg >> 2) + 4 * (lane >> 5); }

template <class P>
DI void gemm_tile(const P& pr, unsigned char* smem, int tid) {
    const int lane = tid & 63, wid = tid >> 6, wr = wid >> 1, wc = wid & 1;
    const bf16_t* abase = pr.a_base();
    const bf16_t* bbase = pr.b_base();
    const int kdim = pr.kt() * 64;
    int gao[4], gbo[4];
#pragma unroll
    for (int i = 0; i < 4; ++i) {
        const int row = (tid >> 3) + 32 * i, sl = (tid & 7) ^ ((row >> 1) & 7);
        const int o = pr.a_off(row);
        gao[i] = (o >= 0 ? o : 0) + sl * 8; gbo[i] = row * kdim + sl * 8;
    }
#define GLDS(buf, kt) do { _Pragma("unroll") for (int i = 0; i < 4; ++i) { \
        __builtin_amdgcn_global_load_lds((const unsigned*)(abase + gao[i] + (kt) * 64), (__attribute__((address_space(3))) unsigned*)(smem + (buf) * 32768 + (i * 256 + wid * 64) * 16), 16, 0, 0); \
        __builtin_amdgcn_global_load_lds((const unsigned*)(bbase + gbo[i] + (kt) * 64), (__attribute__((address_space(3))) unsigned*)(smem + (buf) * 32768 + 16384 + (i * 256 + wid * 64) * 16), 16, 0, 0); } } while (0)
#define DMA_WAIT_SYNC() do { asm volatile("s_waitcnt vmcnt(0)" ::: "memory"); __syncthreads(); } while (0)
#define COMPUTE(buf) do { const unsigned char* As = smem + (buf) * 32768; const unsigned char* Bs = As + 16384; \
        _Pragma("unroll") for (int ks = 0; ks < 4; ++ks) { const int slot = ks * 2 + (lane >> 5); \
            const bf16x8 a0 = *(const bf16x8*)(As + swz(wr * 64 + (lane & 31), slot)); const bf16x8 a1 = *(const bf16x8*)(As + swz(wr * 64 + 32 + (lane & 31), slot)); \
            const bf16x8 b0 = *(const bf16x8*)(Bs + swz(wc * 64 + (lane & 31), slot)); const bf16x8 b1 = *(const bf16x8*)(Bs + swz(wc * 64 + 32 + (lane & 31), slot)); \
            acc[0][0] = __builtin_amdgcn_mfma_f32_32x32x16_bf16(a0, b0, acc[0][0], 0, 0, 0); acc[0][1] = __builtin_amdgcn_mfma_f32_32x32x16_bf16(a0, b1, acc[0][1], 0, 0, 0); \
            acc[1][0] = __builtin_amdgcn_mfma_f32_32x32x16_bf16(a1, b0, acc[1][0], 0, 0, 0); acc[1][1] = __builtin_amdgcn_mfma_f32_32x32x16_bf16(a1, b1, acc[1][1], 0, 0, 0); } } while (0)
    f32x16 acc[2][2];
#pragma unroll
    for (int a = 0; a < 2; ++a)
#pragma unroll
        for (int b = 0; b < 2; ++b)
#pragma unroll
            for (int r = 0; r < 16; ++r) acc[a][b][r] = 0.f;
    const int KT = pr.kt();
    __syncthreads();
    GLDS(0, 0);
    DMA_WAIT_SYNC();
    for (int kt = 0; kt < KT; kt += 2) {
        GLDS(1, kt + 1);
        COMPUTE(0);
        DMA_WAIT_SYNC();
        if (kt + 2 < KT) GLDS(0, kt + 2);
        COMPUTE(1);
        DMA_WAIT_SYNC();
    }
#undef GLDS
#undef DMA_WAIT_SYNC
#undef COMPUTE
    pr.epi(acc, wr, wc, lane, smem + wid * 8192);
}

template <class P>
DI void convert_tile(const P& pr, bf16_t* dst, int kdim, int kt, unsigned char* smem, int tid) {
    unsigned char* Bs = smem;
    const int ng = tid & 31, kg = tid >> 5;
    int width = 0;
    const float* bp = pr.b_col(ng >> 3, width);
    const int cig = (ng & 7) * 4;
    const bool bvalid = cig < width;
    const int ldb = pr.ldb();
    bp += cig + (size_t)(kt * 64 + kg * 8) * ldb;
    f32x4 rb[8];
#pragma unroll
    for (int kk = 0; kk < 8; ++kk) rb[kk] = bvalid ? *(const f32x4*)(bp + (size_t)kk * ldb) : (f32x4){0.f, 0.f, 0.f, 0.f};
    __syncthreads();
#pragma unroll
    for (int j = 0; j < 4; ++j) {
        u32x4 v = {pk2(rb[0][j], rb[1][j]), pk2(rb[2][j], rb[3][j]), pk2(rb[4][j], rb[5][j]), pk2(rb[6][j], rb[7][j])};
        *(u32x4*)(Bs + swz(ng * 4 + j, kg)) = v;
    }
    __syncthreads();
#pragma unroll
    for (int i = 0; i < 4; ++i) {
        const int n = (tid >> 3) + 32 * i;
        *(u32x4*)(dst + (size_t)n * kdim + kt * 64 + (tid & 7) * 8) = *(const u32x4*)(Bs + swz(n, tid & 7));
    }
}

template <int NC> DI void stage_put(unsigned char* wl, int mi, int ni, int r, int lane, float v) { *(bf16_t*)(wl + ((mi * 32 + crow(r, lane)) * NC + ni * 32 + (lane & 31)) * 2) = f2bf(v); }
template <int NC, class RowPtr> DI void stage_flush(unsigned char* wl, int lane, RowPtr rp) {
    constexpr int CH = NC / 8, RPI = 64 / CH, NIT = 64 / RPI;
#pragma unroll
    for (int i = 0; i < NIT; ++i) {
        const int row = lane / CH + RPI * i, ch = lane % CH;
        const u32x4 d = *(const u32x4*)(wl + (row * NC + ch * 8) * 2);
        bf16_t* dst = rp(row);
        if (dst) *(u32x4*)(dst + ch * 8) = d;
    }
}

struct HybIn {
    const Params* p; int j, tm, tn;
    DI int kt() const { return 16; }
    DI int ldb() const { return HYB_IN; }
    DI const bf16_t* a_base() const { return (const bf16_t*)(p->ws + WS_H); }
    DI int a_off(int r) const { return (tm * 128 + r) * 1024; }
    DI static void pair_cols(int pr, int ni, int& base, int& width) {
        width = 32;
        if (pr < 8) base = 64 * pr + 32 * ni;
        else if (pr == 8) base = 512 + 32 * ni;
        else if (pr == 9) base = 576 + 32 * ni;
        else if (pr < 18) base = 640 + 64 * (pr - 10) + 32 * ni;
        else if (pr == 18) base = 1152 + 32 * ni;
        else if (pr == 19) { base = 1216; width = ni == 0 ? 8 : 0; }
        else if (pr < 28) base = 1224 + 64 * (pr - 20) + 32 * ni;
        else base = (ni == 0 ? 1736 : 2248) + 32 * (pr - 28);
    }
    DI const float* b_col(int g, int& width) const { int base; pair_cols(tn * 2 + (g >> 1), g & 1, base, width); return p->hy_w_in + (size_t)j * 1024 * HYB_IN + base; }
    DI const bf16_t* b_base() const { return (const bf16_t*)(p->ws + WS_WHYB) + (size_t)(j * 22 + tn) * 128 * 1024; }
    DI void epi(f32x16 (&acc)[2][2], int wr, int wc, int lane, unsigned char* wl) const {
        const int pr = tn * 2 + wc, c = lane & 31;
        const int t0 = tm * 128 + wr * 64;
        unsigned char* ws = p->ws;
        const float* ropec = (const float*)(ws + WS_ROPEC);
        const float* ropes = (const float*)(ws + WS_ROPES);
        if (pr < 9 || (pr >= 10 && pr < 19)) {
            const bool donorm = pr < 9;
            const float* gam = pr < 8 ? p->hy_q_norm + j * 64 : p->hy_k_norm + j * 64;
            bf16_t* ob; int ld, cb;
            if (pr < 8) { ob = (bf16_t*)(ws + WS_Q); ld = 512; cb = 64 * pr; }
            else if (pr == 8) { ob = (bf16_t*)(ws + WS_K); ld = 64; cb = 0; }
            else if (pr < 18) { ob = (bf16_t*)(ws + WS_IQ); ld = 512; cb = 64 * (pr - 10); }
            else { ob = (bf16_t*)(ws + WS_IK); ld = 64; cb = 0; }
            float g1 = 1.f, g2 = 1.f;
            if (donorm) { g1 = gam[c]; g2 = gam[c + 32]; }
#pragma unroll
            for (int mi = 0; mi < 2; ++mi)
#pragma unroll
                for (int r = 0; r < 16; ++r) {
                    float x1 = acc[mi][0][r], x2 = acc[mi][1][r];
                    const int t = t0 + mi * 32 + crow(r, lane), pos = t & (S - 1);
                    if (donorm) { float ss = half_sum(x1 * x1 + x2 * x2); float rstd = rsqrtf(ss * (1.f / 64.f) + EPS); x1 *= rstd * g1; x2 *= rstd * g2; }
                    const float cs = ropec[pos * 32 + c], sn = ropes[pos * 32 + c];
                    stage_put<64>(wl, mi, 0, r, lane, x1 * cs - x2 * sn);
                    stage_put<64>(wl, mi, 1, r, lane, x2 * cs + x1 * sn);
                }
            stage_flush<64>(wl, lane, [&](int row) { return ob + (size_t)(t0 + row) * ld + cb; });
        } else if (pr == 9) {
            bf16_t* ob = (bf16_t*)(ws + WS_V);
#pragma unroll
            for (int mi = 0; mi < 2; ++mi)
#pragma unroll
                for (int ni = 0; ni < 2; ++ni)
#pragma unroll
                    for (int g4 = 0; g4 < 4; ++g4) {
                        const int t = t0 + mi * 32 + 8 * g4 + 4 * (lane >> 5), pos = t & (S - 1), bb = t >> 11;
                        u32x2 o = {pk2(acc[mi][ni][4 * g4], acc[mi][ni][4 * g4 + 1]), pk2(acc[mi][ni][4 * g4 + 2], acc[mi][ni][4 * g4 + 3])};
                        *(u32x2*)(ob + ((size_t)(bb * 64 + ni * 32 + c)) * S + pos) = o;
                    }
        } else if (pr == 19) {
            float* ob = (float*)(ws + WS_IW);
            if (c < 8) {
#pragma unroll
                for (int mi = 0; mi < 2; ++mi)
#pragma unroll
                    for (int r = 0; r < 16; ++r) { const int t = t0 + mi * 32 + crow(r, lane); ob[(size_t)t * 8 + c] = acc[mi][0][r] * (0.125f * 0.35355339059327373f); }
            }
        } else if (pr < 28) {
            bf16_t* ob = (bf16_t*)(ws + WS_BG); const int cb = 64 * (pr - 20);
#pragma unroll
            for (int mi = 0; mi < 2; ++mi)
#pragma unroll
                for (int r = 0; r < 16; ++r) { stage_put<64>(wl, mi, 0, r, lane, acc[mi][0][r]); stage_put<64>(wl, mi, 1, r, lane, acc[mi][1][r]); }
            stage_flush<64>(wl, lane, [&](int row) { return ob + (size_t)(t0 + row) * 512 + cb; });
        } else {
            bf16_t* ob = (bf16_t*)(ws + WS_Z); const int cb = 32 * (pr - 28);
#pragma unroll
            for (int mi = 0; mi < 2; ++mi)
#pragma unroll
                for (int r = 0; r < 16; ++r) stage_put<32>(wl, mi, 0, r, lane, acc[mi][0][r] * acc[mi][1][r]);
            stage_flush<32>(wl, lane, [&](int row) { return ob + (size_t)(t0 + row) * 512 + cb; });
        }
    }
};


struct HybCols8 {
    const Params* p; int j, tm, tn;
    DI int ldb() const { return HYB_IN; }
    DI const float* b_col(int g, int& width) const {
        const int u = tn >> 1, bj = tn & 1; int base; width = 32;
        if (u < 2) base = 64 * (4 * u + g) + 32 * bj;
        else if (u < 4) base = 640 + 64 * (4 * (u - 2) + g) + 32 * bj;
        else if (u == 4) { if (g == 0) base = 512 + 32 * bj; else if (g == 1) base = 576 + 32 * bj; else if (g == 2) base = 1152 + 32 * bj; else { base = 1216; width = bj == 0 ? 8 : 0; } }
        else if (u < 7) base = 1224 + (u - 5) * 256 + 128 * bj + 32 * g;
        else base = (bj == 0 ? 1736 : 2248) + (u - 7) * 128 + 32 * g;
        return p->hy_w_in + (size_t)j * 1024 * HYB_IN + base;
    }
};

struct MlIn {
    const Params* p; int j, tm, tn;
    DI int kt() const { return 16; }
    DI int ldb() const { return ML_IN; }
    DI const bf16_t* a_base() const { return (const bf16_t*)(p->ws + WS_H); }
    DI int a_off(int r) const { return (tm * 128 + r) * 1024; }
    DI const float* b_col(int g, int& width) const {
        const int pr = tn * 2 + (g >> 1), ni = g & 1; int base; width = 32;
        if (pr < 32) base = 64 * pr + 32 * ni;
        else if (pr == 32) { base = 2048 + 8 * ni; width = 8; }
        else if (pr < 49) base = 2064 + 64 * (pr - 33) + 32 * ni;
        else { base = 0; width = 0; }
        return p->ml_w_in + (size_t)j * 1024 * ML_IN + base;
    }
    DI const bf16_t* b_base() const { return (const bf16_t*)(p->ws + WS_WML) + (size_t)(j * 25 + tn) * 128 * 1024; }
    DI void epi(f32x16 (&acc)[2][2], int wr, int wc, int lane, unsigned char* wl) const {
        const int pr = tn * 2 + wc, c = lane & 31;
        const int t0 = tm * 128 + wr * 64;
        unsigned char* ws = p->ws;
        if (pr < 16) {
            bf16_t* ob; int cb; float sc = 1.f;
            if (pr < 8) { ob = (bf16_t*)(ws + WS_MQ); cb = 64 * pr; sc = 0.125f; }
            else { ob = (bf16_t*)(ws + WS_MK); cb = 64 * (pr - 8); }
#pragma unroll
            for (int mi = 0; mi < 2; ++mi)
#pragma unroll
                for (int r = 0; r < 16; ++r) { stage_put<64>(wl, mi, 0, r, lane, acc[mi][0][r] * sc); stage_put<64>(wl, mi, 1, r, lane, acc[mi][1][r] * sc); }
            stage_flush<64>(wl, lane, [&](int row) { return ob + (size_t)(t0 + row) * 512 + cb; });
        }
        if (pr >= 8 && pr < 32) {
            bf16_t* ob; int nrow, hd, r0;
            if (pr < 16) { ob = (bf16_t*)(ws + WS_MKT); nrow = 64; hd = pr - 8; r0 = 0; }
            else { ob = (bf16_t*)(ws + WS_MV); nrow = 128; hd = (pr - 16) >> 1; r0 = 64 * ((pr - 16) & 1); }
#pragma unroll
            for (int mi = 0; mi < 2; ++mi)
#pragma unroll
                for (int ni = 0; ni < 2; ++ni)
#pragma unroll
                    for (int g4 = 0; g4 < 4; ++g4) {
                        const int t = t0 + mi * 32 + 8 * g4 + 4 * (lane >> 5), pos = t & (S - 1), bb = t >> 11;
                        u32x2 o = {pk2(acc[mi][ni][4 * g4], acc[mi][ni][4 * g4 + 1]), pk2(acc[mi][ni][4 * g4 + 2], acc[mi][ni][4 * g4 + 3])};
                        *(u32x2*)(ob + ((size_t)((bb * 8 + hd) * nrow + r0 + ni * 32 + c)) * S + pos) = o;
                    }
        } else if (pr == 32) {
            if (c < 8) {
                float* oi = (float*)(ws + WS_MIG); float* of = (float*)(ws + WS_MFG);
                const float bi = p->ml_b_gates[j * 16 + c], bfg = p->ml_b_gates[j * 16 + 8 + c];
#pragma unroll
                for (int mi = 0; mi < 2; ++mi)
#pragma unroll
                    for (int r = 0; r < 16; ++r) {
                        const int t = t0 + mi * 32 + crow(r, lane);
                        oi[(size_t)t * 8 + c] = acc[mi][0][r] + bi;
                        const float f = acc[mi][1][r] + bfg;
                        of[(size_t)t * 8 + c] = fminf(f, 0.f) - log1pf(__expf(-fabsf(f)));
                    }
            }
        } else if (pr >= 33 && pr < 49) {
            bf16_t* ob = (bf16_t*)(ws + WS_MOG); const int cb = 64 * (pr - 33);
#pragma unroll
            for (int mi = 0; mi < 2; ++mi)
#pragma unroll
                for (int r = 0; r < 16; ++r) { stage_put<64>(wl, mi, 0, r, lane, sigmoidf_(acc[mi][0][r])); stage_put<64>(wl, mi, 1, r, lane, sigmoidf_(acc[mi][1][r])); }
            stage_flush<64>(wl, lane, [&](int row) { return ob + (size_t)(t0 + row) * 1024 + cb; });
        }
    }
};


struct MlCols8 {
    const Params* p; int j, tm, tn;
    DI int ldb() const { return ML_IN; }
    DI const float* b_col(int g, int& width) const {
        const int u = tn >> 1, bj = tn & 1; int base; width = 32;
        if (tn == 24) { base = 2048 + 8 * (g & 1); width = g < 2 ? 8 : 0; }
        else if (u < 2) base = 64 * (4 * u + g) + 32 * bj;
        else if (u < 4) base = 512 + 64 * (4 * (u - 2) + g) + 32 * bj;
        else if (u < 8) base = 1024 + (2 * (u - 4) + bj) * 128 + 32 * g;
        else base = 2064 + (u - 8) * 256 + 128 * bj + 32 * g;
        return p->ml_w_in + (size_t)j * 1024 * ML_IN + base;
    }
};
struct MlGates {
    const Params* p; int j, tm;
    DI int kt() const { return 16; }
    DI const bf16_t* a_base() const { return (const bf16_t*)(p->ws + WS_H); }
    DI int a_off(int r) const { return (tm * 128 + r) * 1024; }
    DI const bf16_t* b_base() const { return (const bf16_t*)(p->ws + WS_WML) + (size_t)(j * 25 + 24) * 128 * 1024; }
    DI void epi(f32x16 (&acc)[2][2], int wr, int wc, int lane, unsigned char* wl) const {
        const int c = lane & 31, t0 = tm * 128 + wr * 64;
        if (wc == 0 && c < 8) {
            float* oi = (float*)(p->ws + WS_MIG); float* of = (float*)(p->ws + WS_MFG);
            const float bi = p->ml_b_gates[j * 16 + c], bfg = p->ml_b_gates[j * 16 + 8 + c];
#pragma unroll
            for (int mi = 0; mi < 2; ++mi)
#pragma unroll
                for (int r = 0; r < 16; ++r) {
                    const int t = t0 + mi * 32 + crow(r, lane);
                    oi[(size_t)t * 8 + c] = acc[mi][0][r] + bi;
                    const float f = acc[mi][1][r] + bfg;
                    of[(size_t)t * 8 + c] = fminf(f, 0.f) - log1pf(__expf(-fabsf(f)));
                }
        }
    }
};

struct OutProj {
    const Params* p; const float* W; const float* src; int layer, tm, tn;
    DI int kt() const { return 16; }
    DI int ldb() const { return 1024; }
    DI const bf16_t* a_base() const { return (const bf16_t*)(p->ws + WS_YMIX); }
    DI int a_off(int r) const { return (tm * 128 + r) * 1024; }
    DI const float* b_col(int g, int& width) const { width = 32; return W + tn * 128 + g * 32; }
    DI const bf16_t* b_base() const { return (const bf16_t*)(p->ws + WS_WOUT) + (size_t)(layer * 8 + tn) * 128 * 1024; }
    DI void epi(f32x16 (&acc)[2][2], int wr, int wc, int lane, unsigned char* wl) const {
        const int c = lane & 31, t0 = tm * 128 + wr * 64, wid = wr * 2 + wc;
        float* fl = (float*)(wl + wid * 8192);
#pragma unroll
        for (int mi = 0; mi < 2; ++mi)
#pragma unroll
            for (int ni = 0; ni < 2; ++ni)
#pragma unroll
                for (int r = 0; r < 16; ++r) fl[(mi * 32 + crow(r, lane)) * 64 + ni * 32 + c] = acc[mi][ni][r];
        const float* mod = (const float*)(p->ws + WS_MOD) + (size_t)layer * 8 * 6144;
        const int ch = lane & 15, n = tn * 128 + wc * 64 + ch * 4;
        const f32x4 g = *(const f32x4*)(mod + (t0 >> 11) * 6144 + 2048 + n);
        float* part = (float*)(p->ws + WS_PART);
#pragma unroll 4
        for (int i = 0; i < 16; ++i) {
            const int row = (lane >> 4) + 4 * i, t = t0 + row;
            const f32x4 a = *(const f32x4*)(fl + row * 64 + ch * 4);
            const f32x4 o = *(const f32x4*)(src + (size_t)t * 1024 + n) + g * a;
            *(f32x4*)(p->out + (size_t)t * 1024 + n) = o;
            float ss = o[0] * o[0] + o[1] * o[1] + o[2] * o[2] + o[3] * o[3];
            ss += sx_f<1>(ss); ss += sx_f<2>(ss); ss += sx_f<4>(ss); ss += sx_f<8>(ss);
            if (ch == 0) part[(size_t)t * 16 + tn * 2 + wc] = ss;
        }
    }
};

struct Moe1 {
    const Params* p; int layer, e, mt, nt, cnt, roff;
    DI int kt() const { return 16; }
    DI int ldb() const { return DEXP; }
    DI const bf16_t* a_base() const { return (const bf16_t*)(p->ws + WS_H); }
    DI int a_off(int r) const {
        const int rr = mt * 128 + r; if (rr >= cnt) return -1;
        const int a = ((const int*)(p->ws + WS_ELIST))[(size_t)e * NASG + rr];
        return (a >> 1) * 1024;
    }
    DI const float* b_col(int g, int& width) const {
        width = 32;
        const float* base = (nt & 1) ? p->moe_w_up : p->moe_w_gate;
        return base + ((size_t)layer * NEXP + e) * (size_t)(D * DEXP) + 128 * (nt >> 1) + 32 * g;
    }
    DI const bf16_t* b_base() const { return (const bf16_t*)(p->ws + WS_WM1) + (size_t)((layer * NEXP + e) * 8 + nt) * 128 * 1024; }
    DI void epi(f32x16 (&acc)[2][2], int wr, int wc, int lane, unsigned char* wl) const {
        const int c = lane & 31, pr = nt * 2 + wc;
        bf16_t* ob = (bf16_t*)(p->ws + WS_H1);
#pragma unroll
        for (int mi = 0; mi < 2; ++mi)
#pragma unroll
            for (int r = 0; r < 16; ++r) {
                const float g = acc[mi][0][r], u = acc[mi][1][r];
                stage_put<32>(wl, mi, 0, r, lane, g / (1.f + __expf(-g)) * u);
            }
        const int rb = mt * 128 + wr * 64;
        stage_flush<32>(wl, lane, [&](int row) { return rb + row < cnt ? ob + (size_t)(roff + rb + row) * 512 + 32 * pr : (bf16_t*)nullptr; });
    }
};

struct Moe2 {
    const Params* p; int layer, e, mt, nt, cnt, roff;
    DI int kt() const { return 8; }
    DI int ldb() const { return D; }
    DI const bf16_t* a_base() const { return (const bf16_t*)(p->ws + WS_H1); }
    DI int a_off(int r) const { const int rr = mt * 128 + r; if (rr >= cnt) return -1; return (roff + rr) * 512; }
    DI const float* b_col(int g, int& width) const { width = 32; return p->moe_w_down + ((size_t)layer * NEXP + e) * (size_t)(DEXP * D) + nt * 128 + g * 32; }
    DI const bf16_t* b_base() const { return (const bf16_t*)(p->ws + WS_WM2) + (size_t)((layer * NEXP + e) * 8 + nt) * 128 * 512; }
    DI void epi(f32x16 (&acc)[2][2], int wr, int wc, int lane, unsigned char* wl) const {
        const int c = lane & 31;
        bf16_t* ob = (bf16_t*)(p->ws + WS_Y);
        const int* el = (const int*)(p->ws + WS_ELIST) + (size_t)e * NASG;
#pragma unroll
        for (int mi = 0; mi < 2; ++mi)
#pragma unroll
            for (int r = 0; r < 16; ++r) { stage_put<64>(wl, mi, 0, r, lane, acc[mi][0][r]); stage_put<64>(wl, mi, 1, r, lane, acc[mi][1][r]); }
        const int rb = mt * 128 + wr * 64;
        stage_flush<64>(wl, lane, [&](int row) { return rb + row < cnt ? ob + (size_t)el[rb + row] * 1024 + nt * 128 + wc * 64 : (bf16_t*)nullptr; });
    }
};

DI void convert_moe_layers(const Params& p, int l0, int l1, unsigned char* smem, int bid, int nb, int tid) {
    const int PER = 32 * 8 * 16 + 32 * 8 * 8, total = (l1 - l0) * PER;
    for (int item = bid; item < total; item += nb) {
        const int l = l0 + item / PER; int ci = item % PER;
        if (ci < 4096) { const int kt = ci & 15, nt = (ci >> 4) & 7, e = ci >> 7; Moe1 pr{&p, l, e, 0, nt, 0, 0}; convert_tile(pr, (bf16_t*)(p.ws + WS_WM1) + (size_t)((l * 32 + e) * 8 + nt) * 128 * 1024, 1024, kt, smem, tid); }
        else { ci -= 4096; const int kt = ci & 7, nt = (ci >> 3) & 7, e = ci >> 6; Moe2 pr{&p, l, e, 0, nt, 0, 0}; convert_tile(pr, (bf16_t*)(p.ws + WS_WM2) + (size_t)((l * 32 + e) * 8 + nt) * 128 * 512, 512, kt, smem, tid); }
    }
    __syncthreads();
}

DI void phase_init(const Params& p, unsigned char* smem, int bid, int nb, int tid) {
    float* sc = (float*)smem;
    float* red = (float*)(smem + 32768);
    const int NMOD = DEPTH * 96, NROPE = 256;
    const int C_HYB = 2 * 22 * 16, C_ML = 2 * 25 * 16, C_OUT = 4 * 8 * 16;
    for (int ci = bid; ci < C_HYB + C_ML + C_OUT; ci += nb) {
        int c2 = ci;
        if (c2 < C_HYB) { const int kt = c2 & 15, tn = (c2 >> 4) % 22, j = (c2 >> 4) / 22; HybCols8 pr{&p, j, 0, tn}; convert_tile(pr, (bf16_t*)(p.ws + WS_WHYB) + (size_t)(j * 22 + tn) * 128 * 1024, 1024, kt, smem, tid); continue; }
        c2 -= C_HYB;
        if (c2 < C_ML) { const int kt = c2 & 15, tn = (c2 >> 4) % 25, j = (c2 >> 4) / 25; MlCols8 pr{&p, j, 0, tn}; convert_tile(pr, (bf16_t*)(p.ws + WS_WML) + (size_t)(j * 25 + tn) * 128 * 1024, 1024, kt, smem, tid); continue; }
        c2 -= C_ML;
        { const int kt = c2 & 15, tn = (c2 >> 4) & 7, l = c2 >> 7; const float* W = ((l & 1) ? p.ml_w_out : p.hy_w_out) + (size_t)(l >> 1) * 1024 * 1024;
            OutProj pr{&p, W, nullptr, l, 0, tn}; convert_tile(pr, (bf16_t*)(p.ws + WS_WOUT) + (size_t)(l * 8 + tn) * 128 * 1024, 1024, kt, smem, tid); }
    }
    for (int item = bid; item < NMOD; item += nb) {
        __syncthreads();
        for (int i = tid; i < 8 * 1024; i += 256) { const float v = p.c[i]; sc[i] = v / (1.f + __expf(-v)); }
        __syncthreads();
        const int l = item / 96, jb = item % 96, cq = tid & 15, ksl = tid >> 4;
        const float* w = p.ada_w + (size_t)l * 1024 * 6144 + jb * 64 + cq * 4;
        f32x4 acc[8];
#pragma unroll
        for (int b = 0; b < 8; ++b) acc[b] = (f32x4){0.f, 0.f, 0.f, 0.f};
        for (int ii = 0; ii < 64; ++ii) {
            const int i = ksl * 64 + ii;
            const f32x4 wv = *(const f32x4*)(w + (size_t)i * 6144);
#pragma unroll
            for (int b = 0; b < 8; ++b) acc[b] += wv * sc[b * 1024 + i];
        }
#pragma unroll
        for (int b = 0; b < 8; ++b) *(f32x4*)(red + (ksl * 8 + b) * 64 + cq * 4) = acc[b];
        __syncthreads();
        for (int o = tid; o < 512; o += 256) {
            const int b = o >> 6, cc = o & 63; float s = 0.f;
            for (int k = 0; k < 16; ++k) s += red[(k * 8 + b) * 64 + cc];
            ((float*)(p.ws + WS_MOD))[((size_t)l * 8 + b) * 6144 + jb * 64 + cc] = s + p.ada_b[l * 6144 + jb * 64 + cc];
        }
    }
    for (int item = bid; item < NROPE + 1; item += nb) {
        if (item < NROPE) {
            const int idx = item * 256 + tid;
            const int pos = idx >> 5, i = idx & 31;
            const float inv = 1.0f / powf(10000.0f, (float)(2 * i) / 64.0f);
            const float ang = (float)pos * inv;
            ((float*)(p.ws + WS_ROPEC))[idx] = cosf(ang);
            ((float*)(p.ws + WS_ROPES))[idx] = sinf(ang);
        } else {
            if (tid < DEPTH * 32) ((int*)(p.ws + WS_ECNT))[tid * ECS] = 0;
        }
    }
    __syncthreads();
    convert_moe_layers(p, 0, 1, smem, bid, nb, tid);
}

DI void phase_norm(const Params& p, int layer, const float* src, int bid, int nb, int tid) {
    const int lane = tid & 63, wid = tid >> 6;
    const float* mod = (const float*)(p.ws + WS_MOD) + (size_t)layer * 8 * 6144;
    const float* gam = p.norm_mix + layer * 1024;
    bf16_t* H = (bf16_t*)(p.ws + WS_H);
    for (int item = bid; item < T / 4; item += nb) {
        const int t = item * 4 + wid, b = t >> 11;
        const float* xr = src + (size_t)t * 1024;
        f32x4 v[4]; float ss = 0.f;
#pragma unroll
        for (int i = 0; i < 4; ++i) { v[i] = *(const f32x4*)(xr + (lane + 64 * i) * 4); ss += v[i][0] * v[i][0] + v[i][1] * v[i][1] + v[i][2] * v[i][2] + v[i][3] * v[i][3]; }
        ss = wave_sum(ss);
        const float rstd = rsqrtf(ss * (1.f / 1024.f) + EPS);
#pragma unroll
        for (int i = 0; i < 4; ++i) {
            const int c0 = (lane + 64 * i) * 4;
            const f32x4 g = *(const f32x4*)(gam + c0), sh = *(const f32x4*)(mod + b * 6144 + c0), sc = *(const f32x4*)(mod + b * 6144 + 1024 + c0);
            f32x4 h = v[i] * rstd * g * (sc + 1.f) + sh;
            u32x2 o = {pk2(h[0], h[1]), pk2(h[2], h[3])};
            *(u32x2*)(H + (size_t)t * 1024 + c0) = o;
        }
    }
}

DI void phase_ffn_norm_router(const Params& p, int layer, unsigned char* smem, int bid, int nb, int tid) {
    float* rstd_s = (float*)smem;
    float* lg = (float*)(smem + 512);
    float* hs = (float*)(smem + 512 + 32 * 37 * 4);
    float* wcs = (float*)(smem + 5248 + 2 * 32 * 65 * 4);
    float* part = (float*)(smem + 42368);
    float* gpart = (float*)(smem + 59264);
    const int lane = tid & 63, og = __builtin_amdgcn_readfirstlane(tid >> 6), tok = lane & 31, kh = lane >> 5;
    const float* mod = (const float*)(p.ws + WS_MOD) + (size_t)layer * 8 * 6144;
    const float* gam = p.norm_ffn + layer * 1024;
    const float* wg = p.moe_w_group + (size_t)layer * 1024 * 4;
    const float* we = p.moe_w_expert + (size_t)layer * 1024 * 32;
    bf16_t* H = (bf16_t*)(p.ws + WS_H);
    int* ecnt = (int*)(p.ws + WS_ECNT) + layer * 32 * ECS;
    int* elist = (int*)(p.ws + WS_ELIST);
    float* ew = (float*)(p.ws + WS_EW);
    for (int item = bid; item < T / 32; item += nb) {
        const int t0 = item * 32, b = t0 >> 11;
        __syncthreads();
        if (tid < 32) {
            const f32x4* pp = (const f32x4*)((const float*)(p.ws + WS_PART) + (size_t)(t0 + tid) * 16);
            const f32x4 a = pp[0], b4 = pp[1], c4 = pp[2], d4 = pp[3];
            const float ss = ((a[0] + a[1]) + (a[2] + a[3])) + ((b4[0] + b4[1]) + (b4[2] + b4[3])) + ((c4[0] + c4[1]) + (c4[2] + c4[3])) + ((d4[0] + d4[1]) + (d4[2] + d4[3]));
            rstd_s[tid] = rsqrtf(ss * (1.f / 1024.f) + EPS);
        }
        const int stok = tid >> 3, sk0 = (tid & 7) * 8;
        const float* xrow = p.out + (size_t)(t0 + stok) * 1024 + sk0;
        const float* mrow = mod + b * 6144 + sk0;
        f32x4 xa[2], ga[2], sha[2], sca[2], wa[3], xb[2], gb2[2], shb[2], scb[2], wb2[3];
#define FFN_LOAD(xv, gv, shv, scv, wv, k0) do { _Pragma("unroll") for (int q = 0; q < 2; ++q) { xv[q] = *(const f32x4*)(xrow + (k0) + 4 * q); gv[q] = *(const f32x4*)(gam + sk0 + (k0) + 4 * q); \
            shv[q] = *(const f32x4*)(mrow + 3072 + (k0) + 4 * q); scv[q] = *(const f32x4*)(mrow + 4096 + (k0) + 4 * q); } \
            wv[0] = *(const f32x4*)(we + (k0) * 32 + tid * 4); wv[1] = *(const f32x4*)(we + (k0) * 32 + 1024 + tid * 4); wv[2] = *(const f32x4*)(wg + (k0) * 4 + (tid & 63) * 4); } while (0)
#define FFN_STEP(xv, gv, shv, scv, wv, kc) do { const int k0 = (kc) * 64; float* hb = hs + ((kc) & 1) * (32 * 65); float* wb = wcs + ((kc) & 1) * (64 * 40); u32x4 ho; \
            _Pragma("unroll") for (int q = 0; q < 2; ++q) { const f32x4 h = xv[q] * srstd * gv[q] * (scv[q] + 1.f) + shv[q]; ho[2 * q] = pk2(h[0], h[1]); ho[2 * q + 1] = pk2(h[2], h[3]); \
                float* hp = hb + stok * 65 + sk0 + 4 * q; hp[0] = h[0]; hp[1] = h[1]; hp[2] = h[2]; hp[3] = h[3]; } \
            *(u32x4*)(H + (size_t)(t0 + stok) * 1024 + k0 + sk0) = ho; \
            *(f32x4*)(wb + (tid >> 3) * 40 + 4 + (tid & 7) * 4) = wv[0]; *(f32x4*)(wb + (32 + (tid >> 3)) * 40 + 4 + (tid & 7) * 4) = wv[1]; if (tid < 64) *(f32x4*)(wb + tid * 40) = wv[2]; \
            if ((kc) + 2 < 16) FFN_LOAD(xv, gv, shv, scv, wv, k0 + 128); \
            __syncthreads(); \
            { const float* ha = hb + tok * 65 + og * 16 + kh; const float* wbp = wb + (og * 16 + kh) * 40 + 4 + tok; float av[8], bv[8]; \
              _Pragma("unroll") for (int m = 0; m < 8; ++m) { av[m] = ha[2 * m]; bv[m] = wbp[2 * m * 40]; } \
              const float* hg = hb + tok * 65 + og * 16 + kh * 8; const float* wgp = wb + (og * 16 + kh * 8) * 40; \
              _Pragma("unroll") for (int i = 0; i < 8; ++i) { const float hv = hg[i]; gacc += *(const f32x4*)(wgp + i * 40) * hv; } \
              _Pragma("unroll") for (int m = 0; m < 8; ++m) eacc = __builtin_amdgcn_mfma_f32_32x32x2f32(av[m], bv[m], eacc, 0, 0, 0); } } while (0)
        FFN_LOAD(xa, ga, sha, sca, wa, 0);
        FFN_LOAD(xb, gb2, shb, scb, wb2, 64);
        __syncthreads();
        const float srstd = rstd_s[stok];
        f32x16 eacc; f32x4 gacc = {0.f, 0.f, 0.f, 0.f};
#pragma unroll
        for (int r = 0; r < 16; ++r) eacc[r] = 0.f;
        for (int kc = 0; kc < 16; kc += 2) {
            FFN_STEP(xa, ga, sha, sca, wa, kc);
            FFN_STEP(xb, gb2, shb, scb, wb2, kc + 1);
        }
#undef FFN_STEP
#undef FFN_LOAD
#pragma unroll
        for (int r = 0; r < 16; ++r) part[(og * 32 + crow(r, lane)) * 33 + tok] = eacc[r];
#pragma unroll
        for (int e = 0; e < 4; ++e) { const float v = gacc[e] + sx_f<32>(gacc[e]); if (kh == 0) gpart[(og * 32 + tok) * 4 + e] = v; }
        __syncthreads();
        { const int tk = tid >> 3, c4 = (tid & 7) * 4;
#pragma unroll
          for (int e = 0; e < 4; ++e) lg[tk * 37 + 4 + c4 + e] = (part[tk * 33 + c4 + e] + part[(32 + tk) * 33 + c4 + e]) + (part[(64 + tk) * 33 + c4 + e] + part[(96 + tk) * 33 + c4 + e]);
          if (tid < 128) lg[(tid >> 2) * 37 + (tid & 3)] = (gpart[tid] + gpart[128 + tid]) + (gpart[256 + tid] + gpart[384 + tid]); }
        __syncthreads();
        if (tid < 32) {
            const int t = t0 + tid;
            float gl[4]; float gmax = -INFINITY; int gsel = 0;
#pragma unroll
            for (int g = 0; g < 4; ++g) { gl[g] = lg[tid * 37 + g] + p.moe_b_group[layer * 4 + g]; if (gl[g] > gmax) { gmax = gl[g]; gsel = g; } }
            float gsum = 0.f;
#pragma unroll
            for (int g = 0; g < 4; ++g) gsum += __expf(gl[g] - gmax);
            const float pg = 1.f / gsum;
            float v1 = -INFINITY, v2 = -INFINITY; int i1 = 0, i2 = 0;
            for (int jx = 0; jx < 8; ++jx) {
                const float v = lg[tid * 37 + 4 + gsel * 8 + jx] + p.moe_b_expert[layer * 32 + gsel * 8 + jx];
                if (v > v1) { v2 = v1; i2 = i1; v1 = v; i1 = jx; } else if (v > v2) { v2 = v; i2 = jx; }
            }
            const float e2 = __expf(v2 - v1), den = 1.f / (1.f + e2);
            const float w1 = pg * den, w2 = pg * e2 * den;
            const int ea = gsel * 8 + i1, eb = gsel * 8 + i2;
            int* cl = (int*)rstd_s + 32;
            cl[tid] = 0;
            const int la = atomicAdd(&cl[ea], 1);
            const int lb = atomicAdd(&cl[eb], 1);
            { const int n = cl[tid]; cl[32 + tid] = n > 0 ? atomicAdd(&ecnt[tid * ECS], n) : 0; }
            const int ra = cl[32 + ea] + la, rb = cl[32 + eb] + lb;
            elist[(size_t)ea * NASG + ra] = t * 2; ew[t * 2] = w1;
            elist[(size_t)eb * NASG + rb] = t * 2 + 1; ew[t * 2 + 1] = w2;
        }
    }
}

DI bool dense_item(int i, int NT, int xcd, int& tm, int& tn) {
    if (i >= 16 * NT) return false;
    const int mg = i / (8 * NT), r = i % (8 * NT);
    tn = r >> 3; tm = xcd * 16 + mg * 8 + (r & 7);
    return true;
}
template <class PR> DI void phase_hyb_in(const Params& p, int j, unsigned char* smem, int xcd, int lb, int nlb, int tid) {
    int tm, tn;
    for (int i = lb; dense_item(i, 22, xcd, tm, tn); i += nlb) { HybIn pr{&p, j, tm, tn}; gemm_tile(pr, smem, opq(tid)); }
}
DI void phase_ml_in(const Params& p, int j, unsigned char* smem, int xcd, int lb, int nlb, int tid) {
    int tm, tn;
    for (int i = lb; dense_item(i, 25, xcd, tm, tn); i += nlb) { MlIn pr{&p, j, tm, tn}; gemm_tile(pr, smem, opq(tid)); }
}
DI void phase_out_proj(const Params& p, int layer, const float* W, const float* src, unsigned char* smem, int xcd, int lb, int nlb, int tid) {
    int tm, tn;
    for (int i = lb; dense_item(i, 8, xcd, tm, tn); i += nlb) { OutProj pr{&p, W, src, layer, tm, tn}; gemm_tile(pr, smem, opq(tid)); }
}
template <int WHICH> DI void phase_moe(const Params& p, int layer, unsigned char* smem, int xcd, int lb, int nlb, int tid) {
    int* toff = (int*)(smem + 65600);
    __syncthreads();
    if (tid == 0) {
        const int* ecnt = (const int*)(p.ws + WS_ECNT) + layer * 32 * ECS;
        int ta = 0, ra = 0;
        for (int e = 0; e < 32; ++e) {
            const int c = ecnt[e * ECS];
            if ((e & 7) == xcd) { const int q = e >> 3; toff[q] = ta; toff[8 + q] = ra; toff[16 + q] = c; ta += (c + 127) >> 7; }
            ra += c;
        }
        toff[4] = ta;
    }
    __syncthreads();
    const int total = toff[4] * 8;
    for (int item = lb; item < total; item += nlb) {
        const int mg = item >> 3, nt = item & 7;
        int q = 0;
        while (q < 3 && toff[q + 1] <= mg) ++q;
        const int e = q * 8 + xcd, cnt = toff[16 + q], roff = toff[8 + q];
        if (WHICH == 1) { Moe1 pr{&p, layer, e, mg - toff[q], nt, cnt, roff}; gemm_tile(pr, smem, opq(tid)); }
        else { Moe2 pr{&p, layer, e, mg - toff[q], nt, cnt, roff}; gemm_tile(pr, smem, opq(tid)); }
    }
}

DI void phase_combine_norm(const Params& p, int layer, int bid, int nb, int tid) {
    const int lane = tid & 63, wid = tid >> 6;
    const float* mod = (const float*)(p.ws + WS_MOD) + (size_t)layer * 8 * 6144;
    const float* modn = mod + 8 * 6144;
    const float* gam = p.norm_mix + (layer + 1) * 1024;
    const bf16_t* Y = (const bf16_t*)(p.ws + WS_Y);
    const float* ew = (const float*)(p.ws + WS_EW);
    bf16_t* H = (bf16_t*)(p.ws + WS_H);
    const bool has_next = layer + 1 < DEPTH;
    for (int item = bid; item < T / 4; item += nb) {
        const int t = item * 4 + wid, b = t >> 11;
        const float w0 = ew[2 * t], w1 = ew[2 * t + 1];
        f32x4 v[4]; float ss = 0.f;
#pragma unroll
        for (int i = 0; i < 4; ++i) {
            const int c0 = (lane + 64 * i) * 4;
            v[i] = *(const f32x4*)(p.out + (size_t)t * 1024 + c0);
            const f32x4 g = *(const f32x4*)(mod + b * 6144 + 5120 + c0);
            const u32x2 y0 = *(const u32x2*)(Y + (size_t)(2 * t) * 1024 + c0), y1 = *(const u32x2*)(Y + (size_t)(2 * t + 1) * 1024 + c0);
            v[i][0] += g[0] * (w0 * bflo(y0[0]) + w1 * bflo(y1[0])); v[i][1] += g[1] * (w0 * bfhi(y0[0]) + w1 * bfhi(y1[0]));
            v[i][2] += g[2] * (w0 * bflo(y0[1]) + w1 * bflo(y1[1])); v[i][3] += g[3] * (w0 * bfhi(y0[1]) + w1 * bfhi(y1[1]));
            *(f32x4*)(p.out + (size_t)t * 1024 + c0) = v[i];
            ss += v[i][0] * v[i][0] + v[i][1] * v[i][1] + v[i][2] * v[i][2] + v[i][3] * v[i][3];
        }
        if (has_next) {
            ss = wave_sum(ss);
            const float rstd = rsqrtf(ss * (1.f / 1024.f) + EPS);
#pragma unroll
            for (int i = 0; i < 4; ++i) {
                const int c0 = (lane + 64 * i) * 4;
                const f32x4 g = *(const f32x4*)(gam + c0), sh = *(const f32x4*)(modn + b * 6144 + c0), sc = *(const f32x4*)(modn + b * 6144 + 1024 + c0);
                const f32x4 h = v[i] * rstd * g * (sc + 1.f) + sh;
                u32x2 o = {pk2(h[0], h[1]), pk2(h[2], h[3])};
                *(u32x2*)(H + (size_t)t * 1024 + c0) = o;
            }
        }
    }
}

DI unsigned sortable(float f) { const unsigned u = __float_as_uint(f); return (u & 0x80000000u) ? ~u : (u | 0x80000000u); }
DI int half_sum_i(int v) { v += sx_i<16>(v); v += sx_i<8>(v); v += sx_i<4>(v); v += sx_i<2>(v); v += sx_i<1>(v); return v; }

struct CvTask { const float* src; bf16_t* dst; int ldb, kdim; };
DI CvTask cv_task(const Params& p, int l0, int id) {
    const int PER = 32 * 8 * 16 * 4 + 32 * 8 * 8 * 4;
    const int l = l0 + id / PER; int ci = id % PER; CvTask t;
    if (ci < 16384) {
        const int g = ci & 3, kt = (ci >> 2) & 15, nt = (ci >> 6) & 7, e = ci >> 9; int w;
        Moe1 pr{&p, l, e, 0, nt, 0, 0};
        t.ldb = DEXP; t.kdim = 1024; t.src = pr.b_col(g, w) + (size_t)(kt * 64) * DEXP;
        t.dst = (bf16_t*)(p.ws + WS_WM1) + ((size_t)((l * 32 + e) * 8 + nt) * 128 + g * 32) * 1024 + kt * 64;
    } else {
        ci -= 16384;
        const int g = ci & 3, kt = (ci >> 2) & 7, nt = (ci >> 5) & 7, e = ci >> 8; int w;
        Moe2 pr{&p, l, e, 0, nt, 0, 0};
        t.ldb = D; t.kdim = 512; t.src = pr.b_col(g, w) + (size_t)(kt * 64) * D;
        t.dst = (bf16_t*)(p.ws + WS_WM2) + ((size_t)((l * 32 + e) * 8 + nt) * 128 + g * 32) * 512 + kt * 64;
    }
    return t;
}
DI void cv_issue(const CvTask& t, int lane, f32x4 (&rb)[8]) {
    const float* s = t.src + (size_t)((lane >> 3) * 8) * t.ldb + (lane & 7) * 4;
#pragma unroll
    for (int kk = 0; kk < 8; ++kk) rb[kk] = *(const f32x4*)(s + (size_t)kk * t.ldb);
}
DI void cv_finish(const CvTask& t, int lane, const f32x4 (&rb)[8]) {
    bf16_t* d = t.dst + (size_t)((lane & 7) * 4) * t.kdim + (lane >> 3) * 8;
#pragma unroll
    for (int jx = 0; jx < 4; ++jx) {
        u32x4 v = {pk2(rb[0][jx], rb[1][jx]), pk2(rb[2][jx], rb[3][jx]), pk2(rb[4][jx], rb[5][jx]), pk2(rb[6][jx], rb[7][jx])};
        *(u32x4*)(d + (size_t)jx * t.kdim) = v;
    }
}
DI void convert_moe_waves(const Params& p, int l0, int l1, int gwave, int nwaves, int lane) {
    const int total = (l1 - l0) * 24576;
    for (int id = gwave; id < total; id += 2 * nwaves) {
        f32x4 ra[8], rb[8];
        const CvTask t0 = cv_task(p, l0, id);
        cv_issue(t0, lane, ra);
        const bool two = id + nwaves < total;
        if (two) { const CvTask t1 = cv_task(p, l0, id + nwaves); cv_issue(t1, lane, rb); cv_finish(t0, lane, ra); cv_finish(t1, lane, rb); }
        else cv_finish(t0, lane, ra);
    }
}

DI void phase_dsa(const Params& p, int j, unsigned char* smem, int bid, int nb, int tid, int cv0 = 0, int cv1 = 0) {
    if (cv1 > cv0 && (bid & 1)) convert_moe_waves(p, cv0, cv1, bid * 4 + (tid >> 6), nb * 4, tid & 63);
    const int lane = tid & 63, wid = tid >> 6, c = lane & 31, hh = lane >> 5;
    unsigned* mw = (unsigned*)smem + wid * 256;
    const bf16_t* IQ = (const bf16_t*)(p.ws + WS_IQ);
    const bf16_t* IK = (const bf16_t*)(p.ws + WS_IK);
    const float* IW = (const float*)(p.ws + WS_IW);
    const bf16_t* Q = (const bf16_t*)(p.ws + WS_Q);
    const bf16_t* K = (const bf16_t*)(p.ws + WS_K);
    const bf16_t* VT = (const bf16_t*)(p.ws + WS_V);
    bf16_t* Y = (bf16_t*)(p.ws + WS_YMIX);
    const float gq = wave_max(fabsf(p.hy_q_norm[j * 64 + lane])), gk = wave_max(fabsf(p.hy_k_norm[j * 64 + lane]));
    const float LOG2E = 1.4426950408889634f;
    const float c1 = 0.125f * LOG2E, c2 = 8.f * gq * gk * LOG2E;
    const unsigned lt = (1u << c) - 1u;
    for (int it = bid, rnd = 0; it < 1024; it += nb, ++rnd) {
        const int item = (rnd & 1) ? (rnd + 1) * nb - 1 - bid : it;
        if (item >= 1024) continue;
        const int qt = 127 - (item >> 3), b = item & 7;
        const int pos0 = qt * 16 + 4 * wid;
        const size_t tb = (size_t)b * S, t0 = tb + pos0;
        const int tmax = (pos0 + 3) >> 5;
        if (pos0 >= 256) {
            bf16x8 iqf[4];
            {
                const int i = (c & 3) + 4 * (c >> 3), rh = (c >> 2) & 1, qq = 2 * rh + (i >> 3), hd = i & 7;
                const bf16_t* ip = IQ + (t0 + qq) * 512 + hd * 64 + 8 * hh;
#pragma unroll
                for (int ks = 0; ks < 4; ++ks) iqf[ks] = *(const bf16x8*)(ip + 16 * ks);
            }
            float* wl = (float*)(smem + 4096) + wid * 32 + hh * 16;
            if (c < 4) *(f32x4*)(wl + 4 * c) = *(const f32x4*)(IW + (t0 + 2 * hh) * 8 + 4 * c);
            unsigned sk[64][2];
            const bf16_t* kpi = IK + ((tb >> 5) * 256 + hh * 32 + c) * 8;
            const int lim0 = pos0 + 2 * hh - c;
#pragma unroll
            for (int tile = 0; tile < 64; ++tile) {
                unsigned k0 = 0u, k1 = 0u;
                if (tile <= tmax) {
                    bf16x8 bk[4];
#pragma unroll
                    for (int ks = 0; ks < 4; ++ks) bk[ks] = *(const bf16x8*)(kpi + 512 * ks);
                    kpi += 32 * 64;
                    asm volatile("" : "+v"(kpi));
                    f32x16 acc;
#pragma unroll
                    for (int r = 0; r < 16; ++r) acc[r] = 0.f;
#pragma unroll
                    for (int ks = 0; ks < 4; ++ks) acc = __builtin_amdgcn_mfma_f32_32x32x16_bf16(iqf[ks], bk[ks], acc, 0, 0, 0);
                    float s0 = 0.f, s1 = 0.f;
#pragma unroll
                    for (int q4 = 0; q4 < 2; ++q4) {
                        const f32x4 wa = *(const f32x4*)(wl + 4 * q4), wb = *(const f32x4*)(wl + 8 + 4 * q4);
#pragma unroll
                        for (int e = 0; e < 4; ++e) { s0 += fmaxf(acc[4 * q4 + e], 0.f) * wa[e]; s1 += fmaxf(acc[8 + 4 * q4 + e], 0.f) * wb[e]; }
                    }
                    k0 = tile * 32 <= lim0 ? sortable(s0) : 0u;
                    k1 = tile * 32 <= lim0 + 1 ? sortable(s1) : 0u;
                }
                sk[tile][0] = k0; sk[tile][1] = k1;
            }
            unsigned v0 = 0u, v1 = 0u; bool d0 = false, d1 = false;
            const int tg = tmax >> 3;
            for (int bit = 31; bit >= 0; --bit) {
                const unsigned c0 = v0 | (1u << bit), c1b = v1 | (1u << bit);
                int n0 = 0, n1 = 0;
#pragma unroll
                for (int g = 0; g < 8; ++g) {
                    if (g <= tg) {
#pragma unroll
                        for (int u = 0; u < 8; ++u) { n0 += sk[g * 8 + u][0] >= c0 ? 1 : 0; n1 += sk[g * 8 + u][1] >= c1b ? 1 : 0; }
                    }
                }
                const int n01 = half_sum_i(n0 | (n1 << 16));
                n0 = n01 & 0xffff; n1 = n01 >> 16;
                if (!d0 && n0 >= 256) { v0 = c0; d0 = n0 == 256; }
                if (!d1 && n1 >= 256) { v1 = c1b; d1 = n1 == 256; }
                if (__all(d0 && d1)) break;
            }
            int g0 = 0, g1 = 0;
#pragma unroll
            for (int g = 0; g < 8; ++g) {
                if (g <= tg) {
#pragma unroll
                    for (int u = 0; u < 8; ++u) { g0 += sk[g * 8 + u][0] > v0 ? 1 : 0; g1 += sk[g * 8 + u][1] > v1 ? 1 : 0; }
                }
            }
            const int g01 = half_sum_i(g0 | (g1 << 16));
            const int need0 = 256 - (g01 & 0xffff), need1 = 256 - (g01 >> 16);
            int run0 = 0, run1 = 0;
#pragma unroll
            for (int tile = 0; tile < 64; ++tile) {
                if (tile <= tmax) {
                    const unsigned k0 = sk[tile][0], k1 = sk[tile][1];
                    const bool tie0 = k0 == v0, tie1 = k1 == v1;
                    const unsigned long long tb0 = __ballot(tie0), tb1 = __ballot(tie1);
                    const unsigned th0 = hh ? (unsigned)(tb0 >> 32) : (unsigned)tb0, th1 = hh ? (unsigned)(tb1 >> 32) : (unsigned)tb1;
                    const bool sel0 = k0 > v0 || (tie0 && run0 + __popc(th0 & lt) < need0);
                    const bool sel1 = k1 > v1 || (tie1 && run1 + __popc(th1 & lt) < need1);
                    run0 += __popc(th0); run1 += __popc(th1);
                    const unsigned long long sb0 = __ballot(sel0), sb1 = __ballot(sel1);
                    if (lane == 0) { u32x4 o = {(unsigned)sb0, (unsigned)sb1, (unsigned)(sb0 >> 32), (unsigned)(sb1 >> 32)}; *(u32x4*)(mw + tile * 4) = o; }
                }
            }
        } else {
            const int tile = lane >> 2, qq = lane & 3, pq = pos0 + qq;
            if (tile <= tmax) {
                unsigned m;
                if (32 * tile + 31 <= pq) m = 0xffffffffu; else if (32 * tile > pq) m = 0u; else m = (2u << (pq - 32 * tile)) - 1u;
                mw[tile * 4 + qq] = m;
            }
        }
        bf16x8 qf[4];
        {
            const bf16_t* qp = Q + (t0 + (c >> 3)) * 512 + (c & 7) * 64 + 8 * hh;
#pragma unroll
            for (int ks = 0; ks < 4; ++ks) qf[ks] = *(const bf16x8*)(qp + 16 * ks);
        }
        f32x16 o0, o1;
#pragma unroll
        for (int r = 0; r < 16; ++r) { o0[r] = 0.f; o1[r] = 0.f; }
        float lsum = 0.f;
        const bf16_t* kp = K + ((tb >> 5) * 256 + hh * 32 + c) * 8;
        const bf16_t* vp = VT + ((tb >> 5) * 256 + hh * 32 + c) * 8;
        bf16x8 kf[4], vf[4];
#pragma unroll
        for (int ks = 0; ks < 4; ++ks) { kf[ks] = *(const bf16x8*)(kp + 512 * ks); vf[ks] = *(const bf16x8*)(vp + 512 * ks); }
        for (int tile = 0; tile <= tmax; ++tile) {
            const unsigned mword = mw[tile * 4 + (c >> 3)];
            bf16x8 kc[4], vc[4];
#pragma unroll
            for (int ks = 0; ks < 4; ++ks) { kc[ks] = kf[ks]; vc[ks] = vf[ks]; }
            if (tile < tmax) {
                kp += 2048; vp += 2048;
#pragma unroll
                for (int ks = 0; ks < 4; ++ks) { kf[ks] = *(const bf16x8*)(kp + 512 * ks); vf[ks] = *(const bf16x8*)(vp + 512 * ks); }
            }
            f32x16 x;
#pragma unroll
            for (int r = 0; r < 16; ++r) x[r] = 0.f;
#pragma unroll
            for (int ks = 0; ks < 4; ++ks) x = __builtin_amdgcn_mfma_f32_32x32x16_bf16(kc[ks], qf[ks], x, 0, 0, 0);
#pragma unroll
            for (int s = 0; s < 2; ++s) {
                const unsigned bits = mword >> (16 * s + 8 * hh);
                float pr[8];
#pragma unroll
                for (int jx = 0; jx < 8; ++jx) {
                    const float e = __builtin_amdgcn_exp2f(x[8 * s + jx] * c1 - c2);
                    pr[jx] = __uint_as_float(__float_as_uint(e) & (unsigned)__builtin_amdgcn_sbfe((int)bits, jx, 1));
                    lsum += pr[jx];
                }
                u32x4 pk = {pk2(pr[0], pr[1]), pk2(pr[2], pr[3]), pk2(pr[4], pr[5]), pk2(pr[6], pr[7])};
                const bf16x8 pf = __builtin_bit_cast(bf16x8, pk);
                o0 = __builtin_amdgcn_mfma_f32_32x32x16_bf16(vc[2 * s], pf, o0, 0, 0, 0);
                o1 = __builtin_amdgcn_mfma_f32_32x32x16_bf16(vc[2 * s + 1], pf, o1, 0, 0, 0);
            }
        }
        lsum += sx_f<32>(lsum);
        const float inv = 1.f / lsum;
        bf16_t* yp = Y + (t0 + (c >> 3)) * 1024 + (c & 7) * 64 + 4 * hh;
#pragma unroll
        for (int g4 = 0; g4 < 4; ++g4) {
            u32x2 a = {pk2(o0[4 * g4] * inv, o0[4 * g4 + 1] * inv), pk2(o0[4 * g4 + 2] * inv, o0[4 * g4 + 3] * inv)};
            u32x2 bq = {pk2(o1[4 * g4] * inv, o1[4 * g4 + 1] * inv), pk2(o1[4 * g4 + 2] * inv, o1[4 * g4 + 3] * inv)};
            *(u32x2*)(yp + 8 * g4) = a;
            *(u32x2*)(yp + 32 + 8 * g4) = bq;
        }
    }
    if (cv1 > cv0 && !(bid & 1)) convert_moe_waves(p, cv0, cv1, bid * 4 + (tid >> 6), nb * 4, tid & 63);
}

DI void phase_conv(const Params& p, int j, int bid, int nb, int tid) {
    const bf16_t* Z = (const bf16_t*)(p.ws + WS_Z);
    const bf16_t* BG = (const bf16_t*)(p.ws + WS_BG);
    bf16_t* Y = (bf16_t*)(p.ws + WS_YMIX);
    const float* cw = p.hy_conv_w + (size_t)j * 3 * 512;
    for (int item = bid; item < T / 4; item += nb) {
        const int t = item * 4 + (tid >> 6), c0 = (tid & 63) * 8, pos = t & (S - 1);
        float acc[8];
#pragma unroll
        for (int e = 0; e < 8; ++e) acc[e] = 0.f;
#pragma unroll
        for (int jj = 0; jj < 3; ++jj) {
            const int dp = jj - 2;
            if (pos + dp >= 0) {
                const u32x4 z = *(const u32x4*)(Z + (size_t)(t + dp) * 512 + c0);
#pragma unroll
                for (int e = 0; e < 4; ++e) { acc[2 * e] += cw[jj * 512 + c0 + 2 * e] * bflo(z[e]); acc[2 * e + 1] += cw[jj * 512 + c0 + 2 * e + 1] * bfhi(z[e]); }
            }
        }
        const u32x4 g = *(const u32x4*)(BG + (size_t)t * 512 + c0);
        u32x4 o;
#pragma unroll
        for (int e = 0; e < 4; ++e) o[e] = pk2(acc[2 * e] * bflo(g[e]), acc[2 * e + 1] * bfhi(g[e]));
        *(u32x4*)(Y + (size_t)t * 1024 + 512 + c0) = o;
    }
}

DI float wave_incl_sum(float x, int lane) { for (int d = 1; d < 64; d <<= 1) { const float t = lane_get_f(x, lane >= d ? lane - d : lane); if (lane >= d) x += t; } return x; }
DI float wave_incl_max(float x, int lane) { for (int d = 1; d < 64; d <<= 1) { const float t = lane_get_f(x, lane >= d ? lane - d : lane); if (lane >= d) x = fmaxf(x, t); } return x; }
DI bf16x8 scale_frag(bf16x8 f, const float* w8) {
    const u32x4 u = __builtin_bit_cast(u32x4, f);
    u32x4 o;
#pragma unroll
    for (int e = 0; e < 4; ++e) o[e] = pk2(bflo(u[e]) * w8[2 * e], bfhi(u[e]) * w8[2 * e + 1]);
    return __builtin_bit_cast(bf16x8, o);
}

DI void phase_ml12(const Params& p, unsigned char* smem, int bid, int nb, int tid) {
    const int lane = tid & 63, wid = tid >> 6, c = lane & 31, hh = lane >> 5;
    float* wl = (float*)smem;
    float* bg = wl + 2048;
    const bf16_t* KT = (const bf16_t*)(p.ws + WS_MKT);
    const bf16_t* VT = (const bf16_t*)(p.ws + WS_MV);
    const float* MIG = (const float*)(p.ws + WS_MIG);
    const float* MFG = (const float*)(p.ws + WS_MFG);
    bf16_t* CB = (bf16_t*)(p.ws + WS_CBUF);
    float* NBF = (float*)(p.ws + WS_NBUF);
    float* MST = (float*)(p.ws + WS_MST);
    for (int wi = bid; wi < 512; wi += nb) {
        const int bh = wi >> 3, vb = (wi >> 1) & 3, dh = wi & 1, b = bh >> 3, h = bh & 7;
        __syncthreads();
        {
            const float* gf = MFG + ((size_t)b * S + wid * 64 + lane) * 8 + h;
            const float* gi = MIG + ((size_t)b * S + wid * 64 + lane) * 8 + h;
            float lfv[8], igv[8];
#pragma unroll
            for (int i = 0; i < 8; ++i) { lfv[i] = gf[(size_t)i * 2048]; igv[i] = gi[(size_t)i * 2048]; }
#pragma unroll
            for (int i = 0; i < 8; ++i) {
                const int ch = wid + 4 * i;
                const float bc = wave_incl_sum(lfv[i], lane);
                const float blast = lane_get_f(bc, 63);
                const float g = blast - bc + igv[i];
                const float gmax = wave_max(g);
                wl[ch * 64 + lane] = __expf(g - gmax);
                if (lane == 0) { bg[2 * ch] = blast; bg[2 * ch + 1] = gmax; }
            }
        }
        __syncthreads();
        if (wid == 0) {
            const bf16_t* kp = KT + ((size_t)(bh * 32) * 512 + dh * 256 + lane) * 8;
            const bf16_t* vp = VT + ((size_t)(bh * 32) * 1024 + vb * 256 + lane) * 8;
            float m = 0.f;
            f32x16 Cst;
#pragma unroll
            for (int r = 0; r < 16; ++r) Cst[r] = 0.f;
            bf16x8 kb[2][4], vbuf[2][4];
#define ML12_LD(bi, chx) do { _Pragma("unroll") for (int ks = 0; ks < 4; ++ks) { kb[bi][ks] = *(const bf16x8*)(kp + (size_t)(chx) * 4096 + ks * 512); vbuf[bi][ks] = *(const bf16x8*)(vp + (size_t)(chx) * 8192 + ks * 512); } } while (0)
            ML12_LD(0, 0); ML12_LD(1, 1);
            for (int ch4 = 0; ch4 < 32; ch4 += 2) {
#pragma unroll
                for (int bi = 0; bi < 2; ++bi) {
                    const int ch = ch4 + bi, item = bh * 32 + ch;
                    const float blast = bg[2 * ch], gmax = bg[2 * ch + 1];
                    const float mn = fmaxf(blast + m, gmax);
                    const float dec = __expf(blast + m - mn), scl = __expf(gmax - mn);
                    f32x16 u0, u1;
#pragma unroll
                    for (int r = 0; r < 16; ++r) { u0[r] = 0.f; u1[r] = 0.f; }
                    const float* wsl = wl + ch * 64 + 8 * hh;
#pragma unroll
                    for (int ks = 0; ks < 4; ++ks) {
                        float w8[8];
                        const f32x4 wa = *(const f32x4*)(wsl + 16 * ks), wb = *(const f32x4*)(wsl + 16 * ks + 4);
                        w8[0] = wa[0]; w8[1] = wa[1]; w8[2] = wa[2]; w8[3] = wa[3]; w8[4] = wb[0]; w8[5] = wb[1]; w8[6] = wb[2]; w8[7] = wb[3];
                        if (ks & 1) u1 = __builtin_amdgcn_mfma_f32_32x32x16_bf16(scale_frag(kb[bi][ks], w8), vbuf[bi][ks], u1, 0, 0, 0);
                        else u0 = __builtin_amdgcn_mfma_f32_32x32x16_bf16(scale_frag(kb[bi][ks], w8), vbuf[bi][ks], u0, 0, 0, 0);
                    }
                    if (ch4 + 2 < 32) ML12_LD(bi, ch + 2);
#pragma unroll
                    for (int r = 0; r < 16; ++r) Cst[r] = Cst[r] * dec + (u0[r] + u1[r]) * scl;
                    bf16_t* cb = CB + ((size_t)item * 1024 + (vb * 4 + 2 * dh) * 64 + c) * 8 + 4 * hh;
#pragma unroll
                    for (int g4 = 0; g4 < 4; ++g4) {
                        u32x2 o = {pk2(Cst[4 * g4], Cst[4 * g4 + 1]), pk2(Cst[4 * g4 + 2], Cst[4 * g4 + 3])};
                        *(u32x2*)(cb + ((g4 >> 1) * 64 + (g4 & 1) * 32) * 8) = o;
                    }
                    m = mn;
                }
            }
#undef ML12_LD
        } else if (wid == 1 && (wi & 7) == 0) {
            const bf16_t* kr = KT + ((size_t)(bh * 32) * 512 + hh * 256 + c) * 8;
            float m = 0.f, nst = 0.f;
            u32x4 kc[2][8];
#define ML12_LDN(bi, chx) do { _Pragma("unroll") for (int q = 0; q < 8; ++q) kc[bi][q] = *(const u32x4*)(kr + (size_t)(chx) * 4096 + ((q >> 1) * 64 + (q & 1) * 32) * 8); } while (0)
            ML12_LDN(0, 0); ML12_LDN(1, 1);
            for (int ch4 = 0; ch4 < 32; ch4 += 2) {
#pragma unroll
                for (int bi = 0; bi < 2; ++bi) {
                    const int ch = ch4 + bi, item = bh * 32 + ch;
                    const float blast = bg[2 * ch], gmax = bg[2 * ch + 1];
                    const float mn = fmaxf(blast + m, gmax);
                    const float dec = __expf(blast + m - mn), scl = __expf(gmax - mn);
                    const float* wsl = wl + ch * 64;
                    float a = 0.f;
#pragma unroll
                    for (int q = 0; q < 8; ++q)
#pragma unroll
                        for (int e = 0; e < 4; ++e) a += wsl[q * 8 + 2 * e] * bflo(kc[bi][q][e]) + wsl[q * 8 + 2 * e + 1] * bfhi(kc[bi][q][e]);
                    if (ch4 + 2 < 32) ML12_LDN(bi, ch + 2);
                    nst = nst * dec + a * scl;
                    NBF[(size_t)item * 64 + lane] = nst;
                    if (lane == 0) MST[item] = m;
                    m = mn;
                }
            }
#undef ML12_LDN
        }
    }
}

DI void phase_ml3(const Params& p, int j, unsigned char* smem, int bid, int nb, int tid) {
    const int lane = tid & 63, wid = tid >> 6, c = lane & 31, hh = lane >> 5;
    float* al = (float*)smem + wid * 64;
    const bf16_t* MQ = (const bf16_t*)(p.ws + WS_MQ);
    const bf16_t* MK = (const bf16_t*)(p.ws + WS_MK);
    const bf16_t* VT = (const bf16_t*)(p.ws + WS_MV);
    const float* MIG = (const float*)(p.ws + WS_MIG);
    const float* MFG = (const float*)(p.ws + WS_MFG);
    const bf16_t* MOG = (const bf16_t*)(p.ws + WS_MOG);
    const bf16_t* CB = (const bf16_t*)(p.ws + WS_CBUF);
    const float* NBF = (const float*)(p.ws + WS_NBUF);
    const float* MST = (const float*)(p.ws + WS_MST);
    bf16_t* Y = (bf16_t*)(p.ws + WS_YMIX);
    for (int item = bid * 4 + wid; item < 2048; item += nb * 4) {
        const int bh = item >> 5, ch = item & 31, b = bh >> 3, h = bh & 7;
        const size_t tb = (size_t)b * S + ch * 64;
        const float lf = MFG[(tb + lane) * 8 + h], ig = MIG[(tb + lane) * 8 + h];
        const float mprev = MST[item];
        bf16x8 kf[2][4];
        const bf16_t* kp = MK + ((size_t)item * 512 + lane) * 8;
#pragma unroll
        for (int st = 0; st < 2; ++st)
#pragma unroll
            for (int ks = 0; ks < 4; ++ks) kf[st][ks] = *(const bf16x8*)(kp + (st * 4 + ks) * 512);
        const float bc = wave_incl_sum(lf, lane);
        const float av = ig - bc;
        const float Mv = fmaxf(mprev, wave_incl_max(av, lane));
        al[lane] = av;
        const bf16_t* vp = VT + ((size_t)item * 1024 + lane) * 8;
        const bf16_t* cp = CB + ((size_t)(item - 1) * 1024 + lane) * 8;
        const float* np = NBF + (size_t)(item - 1) * 64 + 8 * hh;
#pragma unroll
        for (int tt = 0; tt < 2; ++tt) {
            const float Mt = lane_get_f(Mv, 32 * tt + c), wint = __expf(mprev - Mt), emt = __expf(-(lane_get_f(bc, 32 * tt + c) + Mt));
            bf16x8 qf[4];
#pragma unroll
            for (int ks = 0; ks < 4; ++ks) qf[ks] = *(const bf16x8*)(MQ + ((size_t)item * 512 + (tt * 4 + ks) * 64 + lane) * 8);
            bf16x8 pf[2][2]; float csum = 0.f;
#pragma unroll
            for (int st = 0; st <= tt; ++st) {
                f32x16 x;
#pragma unroll
                for (int r = 0; r < 16; ++r) x[r] = 0.f;
#pragma unroll
                for (int ks = 0; ks < 4; ++ks) x = __builtin_amdgcn_mfma_f32_32x32x16_bf16(kf[st][ks], qf[ks], x, 0, 0, 0);
#pragma unroll
                for (int k2 = 0; k2 < 2; ++k2) {
                    const int s0 = 32 * st + 16 * k2 + 8 * hh;
                    const f32x4 a0 = *(const f32x4*)(al + s0), a1 = *(const f32x4*)(al + s0 + 4);
                    const float a8[8] = {a0[0], a0[1], a0[2], a0[3], a1[0], a1[1], a1[2], a1[3]};
                    float pr[8];
#pragma unroll
                    for (int jx = 0; jx < 8; ++jx) {
                        const float e = __expf(a8[jx] - Mt) * x[8 * k2 + jx];
                        pr[jx] = (st < tt || s0 + jx <= 32 * tt + c) ? e : 0.f;
                        csum += pr[jx];
                    }
                    u32x4 pk = {pk2(pr[0], pr[1]), pk2(pr[2], pr[3]), pk2(pr[4], pr[5]), pk2(pr[6], pr[7])};
                    pf[st][k2] = __builtin_bit_cast(bf16x8, pk);
                }
            }
            float nq = 0.f;
            if (ch > 0) {
#pragma unroll
                for (int ks = 0; ks < 4; ++ks) {
                    const f32x4 n0 = *(const f32x4*)(np + 16 * ks), n1 = *(const f32x4*)(np + 16 * ks + 4);
                    const u32x4 uq = __builtin_bit_cast(u32x4, qf[ks]);
                    nq += n0[0] * bflo(uq[0]) + n0[1] * bfhi(uq[0]) + n0[2] * bflo(uq[1]) + n0[3] * bfhi(uq[1]) + n1[0] * bflo(uq[2]) + n1[1] * bfhi(uq[2]) + n1[2] * bflo(uq[3]) + n1[3] * bfhi(uq[3]);
                }
                nq += sx_f<32>(nq);
            }
            csum += sx_f<32>(csum);
            const float den = wint * nq + csum;
            const float rd = 1.f / fmaxf(fabsf(den), emt);
            f32x16 o[4]; float s2 = 0.f;
#pragma unroll
            for (int vb = 0; vb < 4; ++vb) {
#pragma unroll
                for (int r = 0; r < 16; ++r) o[vb][r] = 0.f;
                if (ch > 0) {
#pragma unroll
                    for (int ks = 0; ks < 4; ++ks) o[vb] = __builtin_amdgcn_mfma_f32_32x32x16_bf16(*(const bf16x8*)(cp + (vb * 4 + ks) * 512), qf[ks], o[vb], 0, 0, 0);
#pragma unroll
                    for (int r = 0; r < 16; ++r) o[vb][r] *= wint;
                }
#pragma unroll
                for (int st = 0; st <= tt; ++st)
#pragma unroll
                    for (int k2 = 0; k2 < 2; ++k2) o[vb] = __builtin_amdgcn_mfma_f32_32x32x16_bf16(*(const bf16x8*)(vp + (vb * 4 + 2 * st + k2) * 512), pf[st][k2], o[vb], 0, 0, 0);
#pragma unroll
                for (int r = 0; r < 16; ++r) { o[vb][r] *= rd; s2 += o[vb][r] * o[vb][r]; }
            }
            s2 += sx_f<32>(s2);
            const float rstd = rsqrtf(s2 * (1.f / 128.f) + EPS);
            const bf16_t* ogp = MOG + ((size_t)(item * 2 + tt) * 1024 + lane) * 4;
            bf16_t* yp = Y + (tb + 32 * tt + c) * 1024 + h * 128 + 4 * hh;
            const float* gp = p.ml_out_norm + j * 1024 + h * 128 + 4 * hh;
#pragma unroll
            for (int vb = 0; vb < 4; ++vb)
#pragma unroll
                for (int g4 = 0; g4 < 4; ++g4) {
                    const f32x4 gm = *(const f32x4*)(gp + 32 * vb + 8 * g4);
                    const u32x2 og = *(const u32x2*)(ogp + (vb * 4 + g4) * 256);
                    u32x2 ov = {pk2(o[vb][4 * g4] * rstd * gm[0] * bflo(og[0]), o[vb][4 * g4 + 1] * rstd * gm[1] * bfhi(og[0])),
                                pk2(o[vb][4 * g4 + 2] * rstd * gm[2] * bflo(og[1]), o[vb][4 * g4 + 3] * rstd * gm[3] * bfhi(og[1]))};
                    *(u32x2*)(yp + 32 * vb + 8 * g4) = ov;
                }
        }
    }
}


namespace pg8 {
#define PG8_LAS __attribute__((address_space(3)))
typedef unsigned short bf16_t;
typedef short bf16x8 __attribute__((ext_vector_type(8)));
typedef float f32x4 __attribute__((ext_vector_type(4)));
typedef unsigned u32x4 __attribute__((ext_vector_type(4)));
constexpr int BM = 256, BK = 64, HALF = 128, HTB = HALF * BK * 2  , STAGE_BYTES = 8 * HTB, NXCD = 8, WGM = 8;

__host__ __device__ __forceinline__ int lds_byte(int r, int c) { const int st = (r >> 4) * 2 + (c >> 5), rr = r & 15, cc = c & 31, ob = rr * 64 + cc * 2; return st * 1024 + (ob ^ (((ob >> 9) & 1) << 5)); }
__host__ __device__ __forceinline__ void stage_rc(int b, int& R, int& C) { const int st = b / 1024, sb = b % 1024, swz = sb ^ (((sb >> 9) & 1) << 5); R = (st >> 1) * 16 + swz / 64; C = (st & 1) * 32 + (swz % 64) / 2; }
__host__ __device__ __forceinline__ int perm32(int rho) { const int n = rho >> 4, i = rho & 15; return 8 * (i >> 2) + 4 * n + (i & 3); }

struct Unit { int pm, pn; };
struct Gemm { const bf16_t* A; const bf16_t* Bt; int M, N, K; };

struct StaticOrder {
    int nM, nN, nwg, G, c;
    __host__ __device__ void init(int M, int N, int G_, int c_) { nM = M / BM; nN = N / BM; nwg = nM * nN; G = G_; c = c_; }
    __host__ __device__ bool next(int i, Unit& u) const {
        const long L = (long)i * G + c; if (L >= nwg) return false;
        int wgid = (int)L; { const int q = nwg / NXCD, r = nwg % NXCD, xcd = wgid % NXCD, off = wgid / NXCD; wgid = (xcd < r ? xcd * (q + 1) : r * (q + 1) + (xcd - r) * q) + off; }
        const int nig = WGM * nN, gid = wgid / nig, fm = gid * WGM, gsz = (nM - fm) < WGM ? (nM - fm) : WGM;
        u.pm = fm + ((wgid % nig) % gsz); u.pn = (wgid % nig) / gsz; return true;
    }
    static constexpr bool GATHER = false;
    __device__ __forceinline__ unsigned a_off(const Unit&, int) const { return 0u; }
    __device__ __forceinline__ int rows(const Unit&) const { return BM; }
    __device__ __forceinline__ void a_ready(const Unit&) const {}
    __device__ __forceinline__ void done(const Unit&) const {}
};


template <class Epi, class Sched, bool ALIGN_EPI = false, bool SP2 = false>
__device__ __forceinline__ void gemm_phase(PG8_LAS unsigned char* lds, const Gemm g, const Sched& S, const Epi& E, int tid512) {
    const int tid = opq(tid512), wid = __builtin_amdgcn_readfirstlane(tid >> 6), lane = tid & 63, wr = wid >> 2, wc = wid & 3, fr = lane & 15, fq = lane >> 4;
    const int K = g.K, nt = K / BK;
    unsigned voffA[2], voffB[2];
    int rowA[2];
#pragma unroll
    for (int i = 0; i < 2; ++i) { int R, C; stage_rc(tid * 16 + i * 8192, R, C); const int Rb = Epi::PERM ? ((R & ~31) + perm32(R & 31)) : R;
        voffA[i] = (unsigned)(R * K + C) * 2u; voffB[i] = (unsigned)(Rb * K + C) * 2u; rowA[i] = R; if (Sched::GATHER) voffA[i] = (unsigned)C * 2u; }
    const size_t kstep = (size_t)(BK * 2);
    const size_t hstep = (size_t)HALF * K * 2;
    const size_t tstep = 2 * hstep;
    const unsigned ldsw = (unsigned)wid * 1024u;
    const int aoff = lds_byte(wr * 64 + fr, fq * 8), boff = lds_byte(wc * 32 + fr, fq * 8);
#define PG8_SA(b, h) (((b) * 2 + (h)) * HTB)
#define PG8_SB(b, h) ((4 + (b) * 2 + (h)) * HTB)
#define PG8_STAGE(bufoff, gbase, voff) do { _Pragma("unroll") for (int _i = 0; _i < 2; ++_i) \
        __builtin_amdgcn_global_load_lds((const unsigned*)((const char*)(gbase) + (voff)[_i]), (PG8_LAS unsigned*)(lds + (bufoff) + ldsw + _i * 8192), 16, 0, 0); } while (0)
#define PG8_LDA(dst, b, h) do { _Pragma("unroll") for (int m = 0; m < 4; ++m) _Pragma("unroll") for (int k = 0; k < 2; ++k) dst[m][k] = *(const PG8_LAS bf16x8*)(lds + PG8_SA(b, h) + aoff + m * 2048 + k * 1024); } while (0)
#define PG8_LDB(dst, b, h) do { _Pragma("unroll") for (int n = 0; n < 2; ++n) _Pragma("unroll") for (int k = 0; k < 2; ++k) dst[n][k] = *(const PG8_LAS bf16x8*)(lds + PG8_SB(b, h) + boff + n * 2048 + k * 1024); } while (0)
#define PG8_MMA(ai, bj, At, Bt) do { __builtin_amdgcn_s_setprio(1); _Pragma("unroll") for (int m = 0; m < 4; ++m) _Pragma("unroll") for (int n = 0; n < 2; ++n) _Pragma("unroll") for (int k = 0; k < 2; ++k) \
        acc[ai][bj][m][n] = __builtin_amdgcn_mfma_f32_16x16x32_bf16(Bt[n][k], At[m][k], acc[ai][bj][m][n], 0, 0, 0); __builtin_amdgcn_s_setprio(0); } while (0)
#define PG8_WAIT_V(n) asm volatile("s_waitcnt vmcnt(" #n ")" ::: "memory")
#define PG8_WAIT_L(n) asm volatile("s_waitcnt lgkmcnt(" #n ")" ::: "memory")
#define PG8_BAR __builtin_amdgcn_s_barrier()
#define PG8_SCHED __builtin_amdgcn_sched_barrier(0)
    unsigned oaC[2][2], oaN[2][2];
#define PG8_GOFF(dst, unit) do { _Pragma("unroll") for (int _h = 0; _h < 2; ++_h) _Pragma("unroll") for (int _i = 0; _i < 2; ++_i) dst[_h][_i] = S.a_off(unit, _h * HALF + rowA[_i]) + voffA[_i]; } while (0)
#define PG8_STAGE_G(bufoff, offs, koff) do { _Pragma("unroll") for (int _i = 0; _i < 2; ++_i) \
        __builtin_amdgcn_global_load_lds((const unsigned*)(((const char*)g.A + (koff)) + (offs)[_i]), (PG8_LAS unsigned*)(lds + (bufoff) + ldsw + _i * 8192), 16, 0, 0); } while (0)
    Unit cur, nxt; int ui = 0;
    if (!S.next(0, cur)) return;
    if constexpr (Sched::GATHER) { PG8_GOFF(oaC, cur); PG8_GOFF(oaN, cur); }
    bool mm0 = true, mm1 = true;
    if constexpr (Sched::GATHER) { const int rws = S.rows(cur); mm0 = 64 * wr < rws; mm1 = 128 + 64 * wr < rws; }
    f32x4 acc[2][2][4][2];
#pragma unroll
    for (int a = 0; a < 2; ++a)
#pragma unroll
        for (int b = 0; b < 2; ++b)
#pragma unroll
            for (int m = 0; m < 4; ++m)
#pragma unroll
                for (int n = 0; n < 2; ++n) acc[a][b][m][n] = (f32x4){0.f, 0.f, 0.f, 0.f};
    bf16x8 At[4][2], B0[2][2], B1[2][2];
    const char* cA = (const char*)g.A + (size_t)cur.pm * tstep; const char* cB = (const char*)g.Bt + (size_t)cur.pn * tstep;
    S.a_ready(cur);
    if constexpr (SP2) {
        PG8_STAGE(PG8_SB(0, 0), cB, voffB); PG8_STAGE(PG8_SB(0, 1), cB + hstep, voffB);
        if constexpr (Sched::GATHER) { PG8_STAGE_G(PG8_SA(0, 0), oaC[0], 0); PG8_STAGE_G(PG8_SA(0, 1), oaC[1], 0); } else { PG8_STAGE(PG8_SA(0, 0), cA, voffA); PG8_STAGE(PG8_SA(0, 1), cA + hstep, voffA); }
        if (wr == 1) PG8_BAR;
        PG8_WAIT_V(2); PG8_BAR;
        PG8_STAGE(PG8_SB(1, 0), cB + kstep, voffB);
        if constexpr (Sched::GATHER) PG8_STAGE_G(PG8_SA(1, 0), oaC[0], kstep); else PG8_STAGE(PG8_SA(1, 0), cA + kstep, voffA);
        PG8_STAGE(PG8_SB(1, 1), cB + hstep + kstep, voffB);
        PG8_WAIT_V(6); PG8_BAR;
    } else {
        PG8_STAGE(PG8_SB(0, 0), cB, voffB); PG8_STAGE(PG8_SA(0, 0), cA, voffA); PG8_STAGE(PG8_SB(0, 1), cB + hstep, voffB); PG8_STAGE(PG8_SA(0, 1), cA + hstep, voffA);
        if (wr == 1) PG8_BAR;
        PG8_WAIT_V(4); PG8_BAR;
        PG8_STAGE(PG8_SB(1, 0), cB + kstep, voffB); PG8_STAGE(PG8_SA(1, 0), cA + kstep, voffA); PG8_STAGE(PG8_SB(1, 1), cB + hstep + kstep, voffB);
        PG8_WAIT_V(6); PG8_BAR;
    }
    for (;;) {
        const bool has_next = S.next(ui + 1, nxt);
        const char* nA = has_next ? (const char*)g.A + (size_t)nxt.pm * tstep : cA; const char* nB = has_next ? (const char*)g.Bt + (size_t)nxt.pn * tstep : cB;
        for (int t = 0; t < nt; t += 2) {
            const bool last = (t == nt - 2);
            const char* a1 = cA + (size_t)(t + 1) * kstep;
            const char* a2 = last ? nA : cA + (size_t)(t + 2) * kstep; const char* b2 = last ? nB : cB + (size_t)(t + 2) * kstep;
            const char* a3 = a2 + kstep; const char* b3 = b2 + kstep;
            if (last && has_next) S.a_ready(nxt);
            unsigned oaS[2][2]; size_t k2 = 0;
            if constexpr (Sched::GATHER) {
                if (last && has_next) PG8_GOFF(oaN, nxt);
                const bool fromN = last && has_next;
#pragma unroll
                for (int _h = 0; _h < 2; ++_h)
#pragma unroll
                    for (int _i = 0; _i < 2; ++_i) oaS[_h][_i] = fromN ? oaN[_h][_i] : oaC[_h][_i];
                k2 = last ? (size_t)0 : (size_t)(t + 2) * kstep;
            }
            if constexpr (SP2) {
            PG8_LDB(B0, 0, 0); PG8_LDB(B1, 0, 1); PG8_SCHED; PG8_LDA(At, 0, 0);
            if constexpr (Sched::GATHER) PG8_STAGE_G(PG8_SA(1, 1), oaC[1], (size_t)(t + 1) * kstep); else PG8_STAGE(PG8_SA(1, 1), a1 + hstep, voffA);
            PG8_WAIT_V(8); PG8_WAIT_L(0); PG8_BAR; if (!Sched::GATHER || mm0) { PG8_MMA(0, 0, At, B0); PG8_MMA(0, 1, At, B1); } PG8_BAR; PG8_SCHED;
            PG8_LDA(At, 0, 1); PG8_STAGE(PG8_SB(0, 0), b2, voffB); PG8_STAGE(PG8_SB(0, 1), b2 + hstep, voffB);
            if constexpr (Sched::GATHER) PG8_STAGE_G(PG8_SA(0, 0), oaS[0], k2); else PG8_STAGE(PG8_SA(0, 0), a2, voffA);
            PG8_WAIT_V(8); PG8_WAIT_L(0); PG8_BAR; if (!Sched::GATHER || mm1) { PG8_MMA(1, 0, At, B0); PG8_MMA(1, 1, At, B1); } PG8_BAR; PG8_SCHED;
            PG8_LDB(B0, 1, 0); PG8_LDB(B1, 1, 1); PG8_SCHED; PG8_LDA(At, 1, 0);
            if constexpr (Sched::GATHER) PG8_STAGE_G(PG8_SA(0, 1), oaS[1], k2); else PG8_STAGE(PG8_SA(0, 1), a2 + hstep, voffA);
            PG8_WAIT_V(8); PG8_WAIT_L(0); PG8_BAR; if (!Sched::GATHER || mm0) { PG8_MMA(0, 0, At, B0); PG8_MMA(0, 1, At, B1); } PG8_BAR; PG8_SCHED;
            PG8_LDA(At, 1, 1); PG8_STAGE(PG8_SB(1, 0), b3, voffB); PG8_STAGE(PG8_SB(1, 1), b3 + hstep, voffB);
            if constexpr (Sched::GATHER) PG8_STAGE_G(PG8_SA(1, 0), oaS[0], k2 + kstep); else PG8_STAGE(PG8_SA(1, 0), a3, voffA);
            PG8_WAIT_V(8); PG8_WAIT_L(0); PG8_BAR; if (!Sched::GATHER || mm1) { PG8_MMA(1, 0, At, B0); PG8_MMA(1, 1, At, B1); } PG8_BAR; PG8_SCHED;
            } else {
            PG8_LDB(B0, 0, 0); PG8_SCHED; PG8_LDA(At, 0, 0); PG8_STAGE(PG8_SA(1, 1), a1 + hstep, voffA);
            PG8_WAIT_L(8); PG8_BAR; PG8_WAIT_L(0); PG8_MMA(0, 0, At, B0); PG8_BAR; PG8_SCHED;
            PG8_LDB(B1, 0, 1); PG8_STAGE(PG8_SB(0, 0), b2, voffB);
            PG8_BAR; PG8_WAIT_L(0); PG8_MMA(0, 1, At, B1); PG8_BAR;
            PG8_LDA(At, 0, 1); PG8_STAGE(PG8_SA(0, 0), a2, voffA);
            PG8_BAR; PG8_WAIT_L(0); PG8_MMA(1, 0, At, B0); PG8_BAR; PG8_SCHED;
            PG8_STAGE(PG8_SB(0, 1), b2 + hstep, voffB);
            PG8_WAIT_V(6); PG8_BAR; PG8_MMA(1, 1, At, B1); PG8_BAR;
            PG8_LDB(B0, 1, 0); PG8_SCHED; PG8_LDA(At, 1, 0); PG8_STAGE(PG8_SA(0, 1), a2 + hstep, voffA);
            PG8_WAIT_L(8); PG8_BAR; PG8_WAIT_L(0); PG8_MMA(0, 0, At, B0); PG8_BAR; PG8_SCHED;
            PG8_LDB(B1, 1, 1); PG8_STAGE(PG8_SB(1, 0), b3, voffB);
            PG8_BAR; PG8_WAIT_L(0); PG8_MMA(0, 1, At, B1); PG8_BAR;
            PG8_LDA(At, 1, 1); PG8_STAGE(PG8_SA(1, 0), a3, voffA);
            PG8_BAR; PG8_WAIT_L(0); PG8_MMA(1, 0, At, B0); PG8_BAR; PG8_SCHED;
            PG8_STAGE(PG8_SB(1, 1), b3 + hstep, voffB);
            PG8_WAIT_V(6); PG8_BAR; PG8_MMA(1, 1, At, B1); PG8_BAR;
            }
        }
        if constexpr (ALIGN_EPI) { if (wr == 0) PG8_BAR; }
        if constexpr (!Epi::AFTER_DRAIN) { E(acc, cur, wr, wc, fr, fq); S.done(cur); }
        if (!has_next) break;
#pragma unroll
        for (int a = 0; a < 2; ++a)
#pragma unroll
            for (int b = 0; b < 2; ++b)
#pragma unroll
                for (int m = 0; m < 4; ++m)
#pragma unroll
                    for (int n = 0; n < 2; ++n) acc[a][b][m][n] = (f32x4){0.f, 0.f, 0.f, 0.f};
        cur = nxt; cA = nA; cB = nB; ++ui;
        if constexpr (Sched::GATHER) { const int rws = S.rows(cur); mm0 = 64 * wr < rws; mm1 = 128 + 64 * wr < rws; }
        if constexpr (Sched::GATHER) {
#pragma unroll
            for (int _h = 0; _h < 2; ++_h)
#pragma unroll
                for (int _i = 0; _i < 2; ++_i) oaC[_h][_i] = oaN[_h][_i];
        }
        if constexpr (ALIGN_EPI) { if (wr == 1) PG8_BAR; }
    }
    PG8_WAIT_V(0);
    if constexpr (!ALIGN_EPI) { if (wr == 0) PG8_BAR; }
    PG8_BAR;
    if constexpr (Epi::AFTER_DRAIN) { E.fused(acc, cur, wr, wc, fr, fq, lds, wid, lane); S.done(cur); }
#undef PG8_GOFF
#undef PG8_STAGE_G
#undef PG8_SA
#undef PG8_SB
#undef PG8_STAGE
#undef PG8_LDA
#undef PG8_LDB
#undef PG8_MMA
#undef PG8_WAIT_V
#undef PG8_WAIT_L
#undef PG8_BAR
#undef PG8_SCHED
}
}

struct OutEpi8 {
    static constexpr bool PERM = false, AFTER_DRAIN = false;
    const float* src; float* dst; const float* gate; float* part;
    __device__ __forceinline__ void operator()(const pg8::f32x4 (&acc)[2][2][4][2], const pg8::Unit& u, int wr, int wc, int fr, int fq) const {
#pragma unroll
        for (int ai = 0; ai < 2; ++ai)
#pragma unroll
            for (int m = 0; m < 4; ++m) {
                const int t = u.pm * 256 + ai * 128 + wr * 64 + m * 16 + fr;
                const float* gp = gate + (t >> 11) * 6144;
                float ss = 0.f;
#pragma unroll
                for (int bj = 0; bj < 2; ++bj)
#pragma unroll
                    for (int n = 0; n < 2; ++n) {
                        const int col = u.pn * 256 + bj * 128 + wc * 32 + n * 16 + fq * 4;
                        const pg8::f32x4 g = *(const pg8::f32x4*)(gp + col);
                        const pg8::f32x4 o = *(const pg8::f32x4*)(src + (size_t)t * 1024 + col) + g * acc[ai][bj][m][n];
                        *(pg8::f32x4*)(dst + (size_t)t * 1024 + col) = o;
                        ss += o[0] * o[0] + o[1] * o[1] + o[2] * o[2] + o[3] * o[3];
                    }
                ss += sx_f<16>(ss); ss += sx_f<32>(ss);
                if (fq == 0) part[(size_t)t * 16 + u.pn * 4 + wc] = ss;
            }
    }
};


DI unsigned cvtpk(float lo, float hi) { return pk2(lo, hi); }
struct HybEpi8 {
    static constexpr bool PERM = true, AFTER_DRAIN = false;
    const Params* p; int j;
    __device__ __forceinline__ void operator()(const pg8::f32x4 (&acc)[2][2][4][2], const pg8::Unit& u, int wr, int wc, int fr, int fq) const {
        unsigned char* ws = p->ws;
        const int un = u.pn;
        if (un < 5 && !(un == 4 && (wc == 1 || wc == 3))) {
            const bool donorm = un < 2 || (un == 4 && wc == 0);
            bf16_t* ob; int ld, cb; const float* gam = p->hy_q_norm + j * 64;
            if (un < 2) { ob = (bf16_t*)(ws + WS_Q); ld = 512; cb = 64 * (4 * un + wc); }
            else if (un < 4) { ob = (bf16_t*)(ws + WS_IQ); ld = 512; cb = 64 * (4 * (un - 2) + wc); }
            else if (wc == 0) { ob = (bf16_t*)(ws + WS_K); ld = 64; cb = 0; gam = p->hy_k_norm + j * 64; }
            else { ob = (bf16_t*)(ws + WS_IK); ld = 64; cb = 0; }
            pg8::f32x4 g0[2], g1[2];
#pragma unroll
            for (int n = 0; n < 2; ++n) { g0[n] = donorm ? *(const pg8::f32x4*)(gam + 8 * fq + 4 * n) : (pg8::f32x4){1.f, 1.f, 1.f, 1.f}; g1[n] = donorm ? *(const pg8::f32x4*)(gam + 32 + 8 * fq + 4 * n) : (pg8::f32x4){1.f, 1.f, 1.f, 1.f}; }
            const float* ropec = (const float*)(ws + WS_ROPEC);
            const float* ropes = (const float*)(ws + WS_ROPES);
            pg8::f32x4 rc[2][2], rs[2][2];
#define HYB_ROPE_LD(buf, st) do { const int t_ = opq(u.pm * 256 + ((st) >> 2) * 128 + wr * 64 + ((st) & 3) * 16 + fr), pos_ = t_ & (S - 1); _Pragma("unroll") for (int n = 0; n < 2; ++n) { \
                rc[buf][n] = *(const pg8::f32x4*)(ropec + pos_ * 32 + 8 * fq + 4 * n); rs[buf][n] = *(const pg8::f32x4*)(ropes + pos_ * 32 + 8 * fq + 4 * n); } } while (0)
            HYB_ROPE_LD(0, 0);
#pragma unroll
            for (int ai = 0; ai < 2; ++ai)
#pragma unroll
                for (int m = 0; m < 4; ++m) {
                    const int st = ai * 4 + m, cb_ = st & 1;
                    if (st < 7) { if (cb_) HYB_ROPE_LD(0, st + 1); else HYB_ROPE_LD(1, st + 1); }
                    const int t = opq(u.pm * 256 + ai * 128 + wr * 64 + m * 16 + fr);
                    float rstd = 1.f;
                    if (donorm) {
                        float ss = 0.f;
#pragma unroll
                        for (int bj = 0; bj < 2; ++bj)
#pragma unroll
                            for (int n = 0; n < 2; ++n) { const pg8::f32x4 x = acc[ai][bj][m][n]; ss += x[0] * x[0] + x[1] * x[1] + x[2] * x[2] + x[3] * x[3]; }
                        ss += sx_f<16>(ss); ss += sx_f<32>(ss);
                        rstd = rsqrtf(ss * (1.f / 64.f) + EPS);
                    }
                    u32x4 o1, o2;
#pragma unroll
                    for (int n = 0; n < 2; ++n) {
                        const pg8::f32x4 cs = rc[cb_][n], sn = rs[cb_][n];
                        const pg8::f32x4 x1 = acc[ai][0][m][n] * rstd * g0[n], x2 = acc[ai][1][m][n] * rstd * g1[n];
                        const pg8::f32x4 y1 = x1 * cs - x2 * sn, y2 = x2 * cs + x1 * sn;
                        o1[2 * n] = cvtpk(y1[0], y1[1]); o1[2 * n + 1] = cvtpk(y1[2], y1[3]);
                        o2[2 * n] = cvtpk(y2[0], y2[1]); o2[2 * n + 1] = cvtpk(y2[2], y2[3]);
                    }
                    if (un == 4) {
                        const int kk = t & 31, cs_ = (wc == 0) ? ((kk & ~12) | ((kk & 4) << 1) | ((kk & 8) >> 1)) : kk;
                        bf16_t* fb = ob + ((size_t)(t >> 5) * 256 + (fq >> 1) * 64 + (fq & 1) * 32 + cs_) * 8;
                        *(u32x4*)fb = o1; *(u32x4*)(fb + 128 * 8) = o2;
                    } else {
                    *(u32x4*)(ob + (size_t)t * ld + cb + 8 * fq) = o1;
                    *(u32x4*)(ob + (size_t)t * ld + cb + 32 + 8 * fq) = o2;
                    }
                }
#undef HYB_ROPE_LD
        } else if (un == 4 && wc == 1) {
            bf16_t* ob = (bf16_t*)(ws + WS_V);
#pragma unroll
            for (int ai = 0; ai < 2; ++ai)
#pragma unroll
                for (int m = 0; m < 4; ++m) {
                    const int t = opq(u.pm * 256 + ai * 128 + wr * 64 + m * 16 + fr), pos = t & (S - 1);
#pragma unroll
                    for (int bj = 0; bj < 2; ++bj)
#pragma unroll
                        for (int n = 0; n < 2; ++n)
#pragma unroll
                            for (int e = 0; e < 4; ++e) ob[((((size_t)(t >> 5) * 4 + bj + ((pos >> 4) & 1) * 2) * 2 + ((pos >> 3) & 1)) * 32 + 8 * fq + 4 * n + e) * 8 + (pos & 7)] = f2bf(acc[ai][bj][m][n][e]);
                }
        } else if (un == 4) {
            float* ob = (float*)(ws + WS_IW);
            if (fq == 0) {
#pragma unroll
                for (int ai = 0; ai < 2; ++ai)
#pragma unroll
                    for (int m = 0; m < 4; ++m) {
                        const int t = u.pm * 256 + ai * 128 + wr * 64 + m * 16 + fr;
                        *(pg8::f32x4*)(ob + (size_t)t * 8) = acc[ai][0][m][0] * (0.125f * 0.35355339059327373f);
                        *(pg8::f32x4*)(ob + (size_t)t * 8 + 4) = acc[ai][0][m][1] * (0.125f * 0.35355339059327373f);
                    }
            }
        } else if (un < 7) {
            bf16_t* ob = (bf16_t*)(ws + WS_BG);
#pragma unroll
            for (int ai = 0; ai < 2; ++ai)
#pragma unroll
                for (int m = 0; m < 4; ++m) {
                    const int t = opq(u.pm * 256 + ai * 128 + wr * 64 + m * 16 + fr);
#pragma unroll
                    for (int bj = 0; bj < 2; ++bj) {
                        const pg8::f32x4 a = acc[ai][bj][m][0], b = acc[ai][bj][m][1];
                        u32x4 o = {cvtpk(a[0], a[1]), cvtpk(a[2], a[3]), cvtpk(b[0], b[1]), cvtpk(b[2], b[3])};
                        *(u32x4*)(ob + (size_t)t * 512 + (un - 5) * 256 + 128 * bj + 32 * wc + 8 * fq) = o;
                    }
                }
        } else {
            bf16_t* ob = (bf16_t*)(ws + WS_Z);
#pragma unroll
            for (int ai = 0; ai < 2; ++ai)
#pragma unroll
                for (int m = 0; m < 4; ++m) {
                    const int t = opq(u.pm * 256 + ai * 128 + wr * 64 + m * 16 + fr);
                    const pg8::f32x4 a = acc[ai][0][m][0] * acc[ai][1][m][0], b = acc[ai][0][m][1] * acc[ai][1][m][1];
                    u32x4 o = {cvtpk(a[0], a[1]), cvtpk(a[2], a[3]), cvtpk(b[0], b[1]), cvtpk(b[2], b[3])};
                    *(u32x4*)(ob + (size_t)t * 512 + (un - 7) * 128 + 32 * wc + 8 * fq) = o;
                }
        }
    }
};


struct MlEpi8 {
    static constexpr bool PERM = true, AFTER_DRAIN = false;
    const Params* p; int j;
    __device__ __forceinline__ void operator()(const pg8::f32x4 (&acc)[2][2][4][2], const pg8::Unit& u, int wr, int wc, int fr, int fq) const {
        unsigned char* ws = p->ws;
        const int un = u.pn;
        if (un < 4) {
            bf16_t* ob = (bf16_t*)(ws + (un < 2 ? WS_MQ : WS_MK));
            const int hd = 4 * (un & 1) + wc; const float sc = un < 2 ? 0.125f : 1.f;
            const int cs_ = un < 2 ? fr : ((fr & ~12) | ((fr & 4) << 1) | ((fr & 8) >> 1));
#pragma unroll
            for (int ai = 0; ai < 2; ++ai)
#pragma unroll
                for (int m = 0; m < 4; ++m) {
                    const int tq = opq(u.pm * 4 + ai * 2 + wr);
                    const int item = ((tq >> 5) * 8 + hd) * 32 + (tq & 31);
                    bf16_t* ib = ob + ((size_t)(item * 2 + (m >> 1)) * 256 + (fq & 1) * 32 + (m & 1) * 16 + cs_) * 8;
#pragma unroll
                    for (int bj = 0; bj < 2; ++bj) {
                        const pg8::f32x4 a = acc[ai][bj][m][0] * sc, b = acc[ai][bj][m][1] * sc;
                        u32x4 o = {cvtpk(a[0], a[1]), cvtpk(a[2], a[3]), cvtpk(b[0], b[1]), cvtpk(b[2], b[3])};
                        *(u32x4*)(ib + (2 * bj + (fq >> 1)) * 64 * 8) = o;
                    }
                }
        } else if (un >= 8) {
            bf16_t* ob = (bf16_t*)(ws + WS_MOG);
#pragma unroll
            for (int ai = 0; ai < 2; ++ai)
#pragma unroll
                for (int m = 0; m < 4; ++m) {
                    const int tq = opq(u.pm * 4 + ai * 2 + wr);
#pragma unroll
                    for (int bj = 0; bj < 2; ++bj) {
                        const int item = ((tq >> 5) * 8 + 2 * (un - 8) + bj) * 32 + (tq & 31);
                        pg8::f32x4 a = acc[ai][bj][m][0], b = acc[ai][bj][m][1];
#pragma unroll
                        for (int e = 0; e < 4; ++e) { a[e] = sigmoidf_(a[e]); b[e] = sigmoidf_(b[e]); }
                        bf16_t* ib = ob + ((size_t)(((item * 2 + (m >> 1)) * 4 + wc) * 4 + fq) * 64 + (m & 1) * 16 + fr) * 4;
                        u32x2 o0 = {cvtpk(a[0], a[1]), cvtpk(a[2], a[3])}, o1 = {cvtpk(b[0], b[1]), cvtpk(b[2], b[3])};
                        *(u32x2*)ib = o0; *(u32x2*)(ib + 32 * 4) = o1;
                    }
                }
        }
        if (un >= 2 && un < 8) {
            bf16_t* ob = (bf16_t*)(ws + (un < 4 ? WS_MKT : WS_MV));
#pragma unroll
            for (int ai = 0; ai < 2; ++ai)
#pragma unroll
                for (int m = 0; m < 4; ++m) {
                    const int tq = opq(u.pm * 4 + ai * 2 + wr);
#pragma unroll
                    for (int bj = 0; bj < 2; ++bj) {
                        const int hd = un < 4 ? 4 * (un - 2) + wc : 2 * (un - 4) + bj;
                        const int item = ((tq >> 5) * 8 + hd) * 32 + (tq & 31);
                        bf16_t* ib = ob + (un < 4 ? ((size_t)((item * 2 + bj) * 4 + m) * 64 + (fr >> 3) * 32 + 8 * fq) * 8 : ((size_t)((item * 4 + wc) * 4 + m) * 64 + (fr >> 3) * 32 + 8 * fq) * 8) + (fr & 7);
#pragma unroll
                        for (int n = 0; n < 2; ++n)
#pragma unroll
                            for (int e = 0; e < 4; ++e) ib[(4 * n + e) * 8] = f2bf(acc[ai][bj][m][n][e]);
                    }
                }
        }
    }
};


struct MoeOrder8 {
    static constexpr bool GATHER = true;
    const int* tab; const int* elist; int G, c, total, mode;
    __device__ __forceinline__ bool next(int i, pg8::Unit& u) const {
        const int cl = (G & 7) ? c : (c & 7) * (G >> 3) + (c >> 3);
        const int wg = i * G + cl; if (wg >= total) return false;
        u.pm = __builtin_amdgcn_readfirstlane(tab[wg >> 2]); u.pn = __builtin_amdgcn_readfirstlane((u.pm >> 8) * 4 + (wg & 3)); return true;
    }
    __device__ __forceinline__ int rows(const pg8::Unit& u) const { const int r = tab[168 + (u.pm >> 8)] - (u.pm & 255) * 256; return __builtin_amdgcn_readfirstlane(r < 256 ? r : 256); }
    __device__ __forceinline__ unsigned a_off(const pg8::Unit& u, int row) const {
        const int e = u.pm >> 8, lr = (u.pm & 255) * 256 + row;
        if (lr >= tab[168 + e]) return 0u;
        if (mode == 1) return (unsigned)(elist[e * NASG + lr] >> 1) * 2048u;
        return (unsigned)(tab[200 + e] + lr) * 1024u;
    }
    __device__ __forceinline__ void a_ready(const pg8::Unit&) const {}
    __device__ __forceinline__ void done(const pg8::Unit&) const {}
};
struct Moe1Epi8 {
    static constexpr bool PERM = true, AFTER_DRAIN = false;
    const int* tab; bf16_t* h1;
    __device__ __forceinline__ void operator()(const pg8::f32x4 (&acc)[2][2][4][2], const pg8::Unit& u, int wr, int wc, int fr, int fq) const {
        const int e = u.pm >> 8, mu = u.pm & 255, nu = u.pn & 3, cnt = tab[168 + e], roff = tab[200 + e];
#pragma unroll
        for (int ai = 0; ai < 2; ++ai)
#pragma unroll
            for (int m = 0; m < 4; ++m) {
                const int lr = opq(mu * 256 + ai * 128 + wr * 64 + m * 16 + fr);
                if (lr < cnt) {
                    u32x4 o;
#pragma unroll
                    for (int n = 0; n < 2; ++n) {
                        const pg8::f32x4 g = acc[ai][0][m][n], up = acc[ai][1][m][n]; float h[4];
#pragma unroll
                        for (int x = 0; x < 4; ++x) h[x] = g[x] * __builtin_amdgcn_rcpf(1.f + __expf(-g[x])) * up[x];
                        o[2 * n] = cvtpk(h[0], h[1]); o[2 * n + 1] = cvtpk(h[2], h[3]);
                    }
                    *(u32x4*)(h1 + (size_t)(roff + lr) * 512 + 128 * nu + 32 * wc + 8 * fq) = o;
                }
            }
    }
};
struct Moe2Epi8 {
    static constexpr bool PERM = true, AFTER_DRAIN = false;
    const int* tab; const int* elist; bf16_t* y;
    __device__ __forceinline__ void operator()(const pg8::f32x4 (&acc)[2][2][4][2], const pg8::Unit& u, int wr, int wc, int fr, int fq) const {
        const int e = u.pm >> 8, mu = u.pm & 255, nu = u.pn & 3, cnt = tab[168 + e];
#pragma unroll
        for (int ai = 0; ai < 2; ++ai)
#pragma unroll
            for (int m = 0; m < 4; ++m) {
                const int lr = opq(mu * 256 + ai * 128 + wr * 64 + m * 16 + fr);
                if (lr < cnt) {
                    const int a = elist[e * NASG + lr];
#pragma unroll
                    for (int bj = 0; bj < 2; ++bj) {
                        const pg8::f32x4 v0 = acc[ai][bj][m][0], v1 = acc[ai][bj][m][1];
                        u32x4 o = {cvtpk(v0[0], v0[1]), cvtpk(v0[2], v0[3]), cvtpk(v1[0], v1[1]), cvtpk(v1[2], v1[3])};
                        *(u32x4*)(y + (size_t)a * 1024 + 256 * nu + 128 * bj + 32 * wc + 8 * fq) = o;
                    }
                }
            }
    }
};

#define XB_TMO      128
#define XB_XCNT(j)  (256  + 64 * (j))
#define XB_XSUB(j)  (1280 + 64 * (j))
#define XB_XGEN(j)  (2304 + 64 * (j))
#define XB_TOP      3328
#define XB_TOPGEN   3392
#define XCD_BAR_WORDS 3456
#define XB_SPIN_CAP (1u << 22)
#define LAS __attribute__((address_space(3)))
DI unsigned xb_ld(unsigned* p) { return __hip_atomic_load(p, __ATOMIC_RELAXED, __HIP_MEMORY_SCOPE_AGENT); }
DI unsigned xb_add(unsigned* p, unsigned v) { return __hip_atomic_fetch_add(p, v, __ATOMIC_RELAXED, __HIP_MEMORY_SCOPE_AGENT); }
DI unsigned xb_xcc_id() { return (unsigned)__builtin_amdgcn_s_getreg((3 << 11) | 20) & 0xFu; }
#define XB_SPIN(cond, bar) do { unsigned _sp = 0; while (cond) { __builtin_amdgcn_s_sleep(1); \
    if ((++_sp & 255u) == 0u) { if (xb_ld(&(bar)[XB_TMO])) break; if (_sp > XB_SPIN_CAP) { atomicAdd(&(bar)[XB_TMO], 1u); break; } } } } while (0)
struct XcdBarrier { unsigned* bar; unsigned x; volatile LAS unsigned* st; };
DI XcdBarrier xcd_barrier_post(unsigned* bar, volatile LAS unsigned* st, bool leader) {
    XcdBarrier b; b.bar = bar; b.x = xb_xcc_id(); b.st = st;
    if (leader) (void)xb_add(&bar[XB_XCNT(b.x)], 1u);
    return b;
}
DI void xcd_barrier_complete(unsigned* bar, unsigned x, unsigned& nloc, unsigned& nx) {
    const unsigned G = gridDim.x * gridDim.y * gridDim.z;
    unsigned sum, cnt, mine, sp = 0u;
    for (;;) {
        sum = 0u; cnt = 0u; mine = 0u;
#pragma unroll
        for (unsigned j = 0; j < 16; ++j) { const unsigned c = xb_ld(&bar[XB_XCNT(j)]); sum += c; cnt += (c > 0u) ? 1u : 0u; mine = (j == x) ? c : mine; }
        if (sum == G) break;
        __builtin_amdgcn_s_sleep(1);
        if ((++sp & 255u) == 0u) { if (xb_ld(&bar[XB_TMO])) break; if (sp > XB_SPIN_CAP) { atomicAdd(&bar[XB_TMO], 1u); break; } }
    }
    nloc = mine > 0u ? mine : 1u; nx = cnt > 0u ? cnt : 1u;
}
DI void xcd_barrier(const XcdBarrier& b, bool leader) {
    asm volatile("s_waitcnt vmcnt(0)" ::: "memory");
    __syncthreads();
    if (leader) {
        unsigned* bar = b.bar;
        __builtin_amdgcn_s_waitcnt(0);
        unsigned nloc = b.st[0], nx = b.st[1];
        if (nloc == 0u) { xcd_barrier_complete(bar, b.x, nloc, nx); b.st[0] = nloc; b.st[1] = nx; }
        const unsigned old = xb_add(&bar[XB_XSUB(b.x)], 1u);
        const unsigned gen = old / nloc;
        if (old + 1u == (gen + 1u) * nloc) {
            __builtin_amdgcn_fence(__ATOMIC_RELEASE, "agent");
            asm volatile("s_waitcnt vmcnt(0)" ::: "memory");
            const unsigned og = xb_add(&bar[XB_TOP], 1u);
            const unsigned tg = og / nx;
            if (og + 1u == (tg + 1u) * nx) xb_add(&bar[XB_TOPGEN], 1u);
            else XB_SPIN(xb_ld(&bar[XB_TOPGEN]) == tg, bar);
            __builtin_amdgcn_fence(__ATOMIC_ACQUIRE, "agent");
            xb_add(&bar[XB_XGEN(b.x)], 1u);
            asm volatile("s_waitcnt vmcnt(0)" ::: "memory");
        } else {
            XB_SPIN(xb_ld(&bar[XB_XGEN(b.x)]) == gen, bar);
            __builtin_amdgcn_fence(__ATOMIC_ACQUIRE, "agent");
            asm volatile("s_waitcnt vmcnt(0)" ::: "memory");
        }
    }
    __syncthreads();
}

namespace cg = cooperative_groups;
constexpr int MEGA_LDS = 65536 + 256;

DI const Params& fresh(const Params* kp) { asm volatile("" : "+s"(kp)); return *kp; }

#ifndef PROBE_MASK
#define PROBE_MASK 0
#endif
__global__ void __launch_bounds__(512, 2) hybrid_fwd_megakernel(Params p_arg) {
    __shared__ __attribute__((aligned(16))) unsigned char smem_all[2 * MEGA_LDS + 1024];
    cg::grid_group grid = cg::this_grid();
    const Params* kp = (const Params*)__builtin_amdgcn_kernarg_segment_ptr();
    const int wave8 = __builtin_amdgcn_readfirstlane((int)(threadIdx.x >> 6));
    const int vb = wave8 >> 2;
#define tid0 ((wave8 & 3) * 64 + lane_id())
    unsigned char* smem = smem_all + vb * MEGA_LDS;
    const int bid0 = blockIdx.x * 2 + vb, nb = gridDim.x * 2;
    const int gx0 = blockIdx.x & 7, glb0 = (blockIdx.x >> 3) * 2 + vb, gnl = (gridDim.x >> 3) * 2;
#define bid opqs(bid0)
#define gx opqs(gx0)
#define glb opqs(glb0)
#define tid opq(tid0)
    volatile LAS unsigned* xst = (volatile LAS unsigned*)(smem_all + 2 * MEGA_LDS);
    if (wave8 == 0 && lane_id() == 0) { xst[0] = 0u; xst[1] = 0u; }
    __syncthreads();
    (void)xcd_barrier_post((unsigned*)(fresh(kp).ws + WS_BAR), xst, wave8 == 0 && lane_id() == 0);
    for (int rep = 0; rep < ((PROBE_MASK & 1) ? 2 : 1); ++rep) { phase_init(fresh(kp), smem, bid, nb, tid); }
#define GSYNC() do { XcdBarrier xb_; xb_.bar = (unsigned*)(fresh(kp).ws + WS_BAR); xb_.x = xb_xcc_id(); xb_.st = (volatile LAS unsigned*)(smem_all + 2 * MEGA_LDS); xcd_barrier(xb_, wave8 == 0 && lane_id() == 0); } while (0)
    if (fresh(kp).use_cg_sync) grid.sync();
    GSYNC();
#pragma unroll 1
    for (int layer = 0; layer < DEPTH; ++layer) {
        const int j = layer >> 1;
        if (layer == 0) { { const Params& p = fresh(kp); phase_norm(p, 0, p.x, bid, nb, tid); }
        GSYNC(); }
        if ((layer & 1) == 0) {
            for (int rep = 0; rep < ((PROBE_MASK & 4) ? 2 : 1); ++rep) { { const Params& p = fresh(kp);
              pg8::Gemm g8{(const pg8::bf16_t*)(p.ws + WS_H), (const pg8::bf16_t*)(p.ws + WS_WHYB) + (size_t)j * 2816 * 1024, T, 2816, 1024};
              pg8::StaticOrder S8; S8.init(T, 2816, (int)gridDim.x, (int)blockIdx.x);
              HybEpi8 E8{&p, j};
              pg8::gemm_phase<HybEpi8, pg8::StaticOrder, true, true>((PG8_LAS unsigned char*)smem_all, g8, S8, E8, wave8 * 64 + lane_id()); } }
            GSYNC();
            for (int rep = 0; rep < ((PROBE_MASK & 8) ? 2 : 1); ++rep) { phase_dsa(fresh(kp), j, smem, bid, nb, tid, layer == 0 ? 1 : 3, layer == 0 ? 3 : 4); }
            for (int rep = 0; rep < ((PROBE_MASK & 16) ? 2 : 1); ++rep) { phase_conv(fresh(kp), j, bid, nb, tid); }
            GSYNC();
            { const Params& p = fresh(kp);
              pg8::Gemm g8{(const pg8::bf16_t*)(p.ws + WS_YMIX), (const pg8::bf16_t*)(p.ws + WS_WOUT) + (size_t)layer * 1024 * 1024, T, 1024, 1024};
              pg8::StaticOrder S8; S8.init(T, 1024, (int)gridDim.x, (int)blockIdx.x);
              OutEpi8 E8{layer == 0 ? p.x : p.out, p.out, (const float*)(p.ws + WS_MOD) + (size_t)layer * 8 * 6144 + 2048, (float*)(p.ws + WS_PART)};
              pg8::gemm_phase<OutEpi8, pg8::StaticOrder, true, true>((PG8_LAS unsigned char*)smem_all, g8, S8, E8, wave8 * 64 + lane_id()); }
        } else {
            for (int rep = 0; rep < ((PROBE_MASK & 32) ? 2 : 1); ++rep) { { const Params& p = fresh(kp);
              pg8::Gemm g8{(const pg8::bf16_t*)(p.ws + WS_H), (const pg8::bf16_t*)(p.ws + WS_WML) + (size_t)j * 3200 * 1024, T, 3072, 1024};
              pg8::StaticOrder S8; S8.init(T, 3072, (int)gridDim.x, (int)blockIdx.x);
              MlEpi8 E8{&p, j};
              pg8::gemm_phase<MlEpi8, pg8::StaticOrder, true, true>((PG8_LAS unsigned char*)smem_all, g8, S8, E8, wave8 * 64 + lane_id());
              for (int gi = glb; gi < 16; gi += gnl) { MlGates pr{&p, j, gx * 16 + gi}; gemm_tile(pr, smem, tid); } } }
            GSYNC();
            for (int rep = 0; rep < ((PROBE_MASK & 64) ? 2 : 1); ++rep) { phase_ml12(fresh(kp), smem, bid, nb, tid); }
            GSYNC();
            for (int rep = 0; rep < ((PROBE_MASK & 256) ? 2 : 1); ++rep) { phase_ml3(fresh(kp), j, smem, bid, nb, tid); }
            GSYNC();
            { const Params& p = fresh(kp);
              pg8::Gemm g8{(const pg8::bf16_t*)(p.ws + WS_YMIX), (const pg8::bf16_t*)(p.ws + WS_WOUT) + (size_t)layer * 1024 * 1024, T, 1024, 1024};
              pg8::StaticOrder S8; S8.init(T, 1024, (int)gridDim.x, (int)blockIdx.x);
              OutEpi8 E8{p.out, p.out, (const float*)(p.ws + WS_MOD) + (size_t)layer * 8 * 6144 + 2048, (float*)(p.ws + WS_PART)};
              pg8::gemm_phase<OutEpi8, pg8::StaticOrder, true, true>((PG8_LAS unsigned char*)smem_all, g8, S8, E8, wave8 * 64 + lane_id()); }
        }
        GSYNC();
        phase_ffn_norm_router(fresh(kp), layer, smem, bid, nb, tid);
        GSYNC();
        { const Params& p = fresh(kp); unsigned char* wsu = uniform_ptr(p.ws);
          int* mtab = (int*)(smem_all + 2 * MEGA_LDS + 64);
          __syncthreads();
          if (wave8 == 0) {
              const int e = lane_id(); const int cn = e < 32 ? ((const int*)(wsu + WS_ECNT))[(layer * 32 + e) * ECS] : 0;
              const int nf = cn >> 8, r = cn & 255;
              if (e < 32) { mtab[168 + e] = cn; mtab[112 + e] = nf; }
              __builtin_amdgcn_wave_barrier();
              int fx = 0, sx = 0, nF = 0;
#pragma unroll
              for (int k = 0; k < 32; ++k) { const int ck = mtab[168 + k], fk = mtab[112 + k]; fx += k < e ? fk : 0; sx += k < e ? ck : 0; nF += fk; }
              __builtin_amdgcn_wave_barrier();
              const int cls = r == 0 ? 3 : (r > 128 ? 0 : (r > 64 ? 1 : 2));
              const unsigned long long b0 = __ballot(e < 32 && cls == 0), b1 = __ballot(e < 32 && cls == 1), b2 = __ballot(e < 32 && cls == 2);
              const unsigned long long lt = (1ull << e) - 1ull;
              const int pos = cls == 0 ? __popcll(b0 & lt) : cls == 1 ? __popcll(b0) + __popcll(b1 & lt) : __popcll(b0) + __popcll(b1) + __popcll(b2 & lt);
              if (e < 32) {
                  mtab[200 + e] = sx;
                  for (int mu = 0; mu < nf; ++mu) mtab[fx + mu] = (e << 8) | mu;
                  if (cls < 3) mtab[nF + pos] = (e << 8) | nf;
              }
              if (e == 0) mtab[160] = nF + __popcll(b0 | b1 | b2);
          }
          __syncthreads();
          MoeOrder8 S8{mtab, (const int*)(wsu + WS_ELIST), (int)gridDim.x, (int)blockIdx.x, mtab[160] * 4, 1};
          pg8::Gemm g8{(const pg8::bf16_t*)(wsu + WS_H), (const pg8::bf16_t*)(wsu + WS_WM1) + (size_t)layer * 32 * 1024 * 1024, 0, 0, 1024};
          Moe1Epi8 E8{mtab, (bf16_t*)(wsu + WS_H1)};
          pg8::gemm_phase<Moe1Epi8, MoeOrder8, true, true>((PG8_LAS unsigned char*)smem_all, g8, S8, E8, wave8 * 64 + lane_id()); }
        GSYNC();
        { const Params& p = fresh(kp); unsigned char* wsu = uniform_ptr(p.ws);
          int* mtab = (int*)(smem_all + 2 * MEGA_LDS + 64);
          MoeOrder8 S8{mtab, (const int*)(wsu + WS_ELIST), (int)gridDim.x, (int)blockIdx.x, mtab[160] * 4, 2};
          pg8::Gemm g8{(const pg8::bf16_t*)(wsu + WS_H1), (const pg8::bf16_t*)(wsu + WS_WM2) + (size_t)layer * 32 * 1024 * 512, 0, 0, 512};
          Moe2Epi8 E8{mtab, (const int*)(wsu + WS_ELIST), (bf16_t*)(wsu + WS_Y)};
          pg8::gemm_phase<Moe2Epi8, MoeOrder8, true, true>((PG8_LAS unsigned char*)smem_all, g8, S8, E8, wave8 * 64 + lane_id()); }
        GSYNC();
        phase_combine_norm(fresh(kp), layer, bid, nb, tid);
        if (layer + 1 < DEPTH) GSYNC();
    }
}
#undef tid
#undef tid0
#undef bid
#undef gx
#undef glb
#undef GSYNC

extern "C" void kernel_launch(void* const* d_in, const int* in_sizes, int n_in, void* d_out, int out_size, void* d_ws, size_t ws_size, hipStream_t stream) {
    Params p{};
    const float** f = (const float**)&p;
    for (int i = 0; i < 22; ++i) f[i] = (const float*)d_in[i];
    p.out = (float*)d_out;
    p.ws = (unsigned char*)d_ws;
    if (ws_size < WS_END) { fprintf(stderr, "workspace too small: %zu < %zu\n", ws_size, (size_t)WS_END); return; }
    static int grid_blocks = 0;
    if (!grid_blocks) {
        int dev = 0, cus = 0, per_cu = 0;
        hipGetDevice(&dev);
        hipDeviceGetAttribute(&cus, hipDeviceAttributeMultiprocessorCount, dev);
        hipOccupancyMaxActiveBlocksPerMultiprocessor(&per_cu, hybrid_fwd_megakernel, 512, 0);
        if (per_cu > 1) per_cu = 1;
        grid_blocks = cus * per_cu;
    }
    (void)hipMemsetAsync((unsigned char*)d_ws + WS_BAR, 0, XCD_BAR_WORDS_C * 4, stream);
    void* args[] = {&p};
    hipError_t e = hipLaunchCooperativeKernel((void*)hybrid_fwd_megakernel, dim3(grid_blocks), dim3(512), args, 0, stream);
    if (e != hipSuccess) fprintf(stderr, "cooperative launch failed: %s (grid %d)\n", hipGetErrorString(e), grid_blocks);
}
```

```cpp
#include <hip/hip_runtime.h>
#include <hip/hip_cooperative_groups.h>
#include <stdint.h>
#include <cstdio>

#define DI __device__ __forceinline__
#define GAS __attribute__((address_space(1)))
#define LAS __attribute__((address_space(3)))
typedef unsigned short bf16_t;
typedef short bf16x8 __attribute__((ext_vector_type(8)));
typedef float f32x16 __attribute__((ext_vector_type(16)));
typedef float f32x4 __attribute__((ext_vector_type(4)));
typedef float f32x2 __attribute__((ext_vector_type(2)));
typedef unsigned u32x4 __attribute__((ext_vector_type(4)));
typedef unsigned u32x2 __attribute__((ext_vector_type(2)));
typedef __bf16 bf16x2_t __attribute__((ext_vector_type(2)));

constexpr int D = 1024, NB = 8, S = 2048, T = NB * S, DEPTH = 4;
constexpr int HYB_IN = 2760, ML_IN = 3088;
constexpr int NEXP = 32, DEXP = 512, NASG = T * 2;
constexpr float EPS = 1e-6f;
constexpr int XCD_BAR_WORDS_C = 9 * 3456;

constexpr size_t al256(size_t x) { return (x + 255) & ~(size_t)255; }
constexpr size_t WS_MOD = 0;
constexpr size_t WS_ROPEC = WS_MOD + al256((size_t)4 * 8 * 6144 * 4);
constexpr size_t WS_ROPES = WS_ROPEC + al256((size_t)2048 * 32 * 4);
constexpr size_t WS_ECNT = WS_ROPES + al256((size_t)2048 * 32 * 4);
constexpr int ECS = 64;
constexpr size_t WS_H = WS_ECNT + al256(4 * 32 * ECS * 4);
constexpr size_t WS_YMIX = WS_H + al256((size_t)T * 1024 * 2);
constexpr size_t WS_Q = WS_YMIX + al256((size_t)T * 1024 * 2);
constexpr size_t WS_K = WS_Q + al256((size_t)T * 512 * 2);
constexpr size_t WS_V = WS_K + al256((size_t)T * 64 * 2);
constexpr size_t WS_IQ = WS_V + al256((size_t)T * 64 * 2);
constexpr size_t WS_IK = WS_IQ + al256((size_t)T * 512 * 2);
constexpr size_t WS_IW = WS_IK + al256((size_t)T * 64 * 2);
constexpr size_t WS_BG = WS_IW + al256((size_t)T * 8 * 4);
constexpr size_t WS_Z = WS_BG + al256((size_t)T * 512 * 2);
constexpr size_t WS_MASK = WS_Z + al256((size_t)T * 512 * 2);
constexpr size_t WS_MQ = WS_MASK + al256((size_t)T * 64 * 4);
constexpr size_t WS_MK = WS_MQ + al256((size_t)T * 512 * 2);
constexpr size_t WS_MV = WS_MK + al256((size_t)T * 512 * 2);
constexpr size_t WS_MIG = WS_MV + al256((size_t)T * 1024 * 2);
constexpr size_t WS_MFG = WS_MIG + al256((size_t)T * 8 * 4);
constexpr size_t WS_MOG = WS_MFG + al256((size_t)T * 8 * 4);
constexpr size_t WS_EW = WS_MOG + al256((size_t)T * 1024 * 2);
constexpr size_t WS_ELIST = WS_EW + al256((size_t)NASG * 4);
constexpr size_t WS_H1 = WS_ELIST + al256((size_t)NEXP * NASG * 4);
constexpr size_t WS_Y = WS_H1 + al256((size_t)NASG * 512 * 2);
constexpr size_t WS_MKT = WS_Y + al256((size_t)NASG * 1024 * 2);
constexpr size_t WS_UBUF = WS_MKT + al256((size_t)64 * 64 * S * 2);
constexpr size_t WS_UNBUF = WS_UBUF + al256((size_t)64 * 32 * 8192 * 4);
constexpr size_t WS_MLOC = WS_UNBUF + al256((size_t)64 * 32 * 64 * 4);
constexpr size_t WS_CBUF = WS_MLOC + al256((size_t)64 * 32 * 2 * 4);
constexpr size_t WS_NBUF = WS_CBUF + al256((size_t)64 * 32 * 8192 * 2);
constexpr size_t WS_MST = WS_NBUF + al256((size_t)64 * 32 * 64 * 4);
constexpr size_t WS_PART = WS_MST + al256((size_t)64 * 32 * 4);
constexpr size_t WS_WHYB = WS_PART + al256((size_t)T * 16 * 4);
constexpr size_t WS_WML = WS_WHYB + al256((size_t)2 * 2816 * 1024 * 2);
constexpr size_t WS_WOUT = WS_WML + al256((size_t)2 * 3200 * 1024 * 2);
constexpr size_t WS_WM1 = WS_WOUT + al256((size_t)4 * 1024 * 1024 * 2);
constexpr size_t WS_WM2 = WS_WM1 + al256((size_t)4 * 32 * 1024 * 1024 * 2);
constexpr size_t WS_BAR = WS_WM2 + al256((size_t)4 * 32 * 1024 * 512 * 2);
constexpr size_t WS_END = WS_BAR + al256((size_t)XCD_BAR_WORDS_C * 4);

struct Params {
    const float *x, *c, *ada_w, *ada_b, *norm_mix, *norm_ffn, *hy_w_in, *hy_q_norm, *hy_k_norm, *hy_conv_w, *hy_w_out;
    const float *ml_w_in, *ml_b_gates, *ml_out_norm, *ml_w_out, *moe_w_group, *moe_b_group, *moe_w_expert, *moe_b_expert;
    const float *moe_w_gate, *moe_w_up, *moe_w_down;
    float* out;
    unsigned char* ws;
    unsigned long long use_cg_sync;
};

DI unsigned pk2(float lo, float hi) { f32x2 v = {lo, hi}; bf16x2_t b = __builtin_convertvector(v, bf16x2_t); return __builtin_bit_cast(unsigned, b); }
DI bf16_t f2bf(float x) { return (bf16_t)(pk2(x, 0.f) & 0xffffu); }
DI float bf2f(bf16_t h) { return __uint_as_float(((unsigned)h) << 16); }
DI float bflo(unsigned u) { return __uint_as_float(u << 16); }
DI float bfhi(unsigned u) { return __uint_as_float(u & 0xffff0000u); }
DI int lane_id() { int x; asm volatile("v_mbcnt_lo_u32_b32 %0, -1, 0\n\tv_mbcnt_hi_u32_b32 %0, -1, %0" : "=v"(x)); return x; }
template <int M> DI int sx_i(int v) {
    if constexpr (M < 32) return __builtin_amdgcn_ds_swizzle(v, (M << 10) | 0x1f);
    else return __builtin_amdgcn_ds_bpermute((lane_id() ^ 32) << 2, v);
}
template <int M> DI float sx_f(float v) { return __int_as_float(sx_i<M>(__float_as_int(v))); }
DI float lane_get_f(float v, int src) { return __int_as_float(__builtin_amdgcn_ds_bpermute(src << 2, __float_as_int(v))); }
DI float wave_sum(float v) { v += sx_f<32>(v); v += sx_f<16>(v); v += sx_f<8>(v); v += sx_f<4>(v); v += sx_f<2>(v); v += sx_f<1>(v); return v; }
DI float wave_max(float v) { v = fmaxf(v, sx_f<32>(v)); v = fmaxf(v, sx_f<16>(v)); v = fmaxf(v, sx_f<8>(v)); v = fmaxf(v, sx_f<4>(v)); v = fmaxf(v, sx_f<2>(v)); v = fmaxf(v, sx_f<1>(v)); return v; }
DI float half_sum(float v) { v += sx_f<16>(v); v += sx_f<8>(v); v += sx_f<4>(v); v += sx_f<2>(v); v += sx_f<1>(v); return v; }
DI float sigmoidf_(float x) { return __builtin_amdgcn_rcpf(1.f + __expf(-x)); }
DI unsigned char* uniform_ptr(unsigned char* q) {
    const unsigned long long w = (unsigned long long)q;
    const unsigned lo = __builtin_amdgcn_readfirstlane((unsigned)w), hi = __builtin_amdgcn_readfirstlane((unsigned)(w >> 32));
    return (unsigned char*)(((unsigned long long)hi << 32) | lo);
}
DI int opqs(int x) { asm volatile("" : "+s"(x)); return x; }
DI int opq(int x) { asm volatile("" : "+v"(x)); return x; }

DI int swz(int row, int slot) { return row * 128 + ((slot ^ ((row >> 1) & 7)) << 4); }
DI int crow(int reg, int lane) { return (reg & 3) + 8 * (reg >> 2) + 4 * (lane >> 5); }

template <class P>
DI void gemm_tile(const P& pr, unsigned char* smem, int tid) {
    const int lane = tid & 63, wid = tid >> 6, wr = wid >> 1, wc = wid & 1;
    const bf16_t* abase = pr.a_base();
    const bf16_t* bbase = pr.b_base();
    const int kdim = pr.kt() * 64;
    int gao[4], gbo[4];
#pragma unroll
    for (int i = 0; i < 4; ++i) {
        const int row = (tid >> 3) + 32 * i, sl = (tid & 7) ^ ((row >> 1) & 7);
        const int o = pr.a_off(row);
        gao[i] = (o >= 0 ? o : 0) + sl * 8; gbo[i] = row * kdim + sl * 8;
    }
#define GLDS(buf, kt) do { _Pragma("unroll") for (int i = 0; i < 4; ++i) { \
        __builtin_amdgcn_global_load_lds((const unsigned*)(abase + gao[i] + (kt) * 64), (__attribute__((address_space(3))) unsigned*)(smem + (buf) * 32768 + (i * 256 + wid * 64) * 16), 16, 0, 0); \
        __builtin_amdgcn_global_load_lds((const unsigned*)(bbase + gbo[i] + (kt) * 64), (__attribute__((address_space(3))) unsigned*)(smem + (buf) * 32768 + 16384 + (i * 256 + wid * 64) * 16), 16, 0, 0); } } while (0)
#define DMA_WAIT_SYNC() do { asm volatile("s_waitcnt vmcnt(0)" ::: "memory"); __syncthreads(); } while (0)
#define COMPUTE(buf) do { const unsigned char* As = smem + (buf) * 32768; const unsigned char* Bs = As + 16384; \
        _Pragma("unroll") for (int ks = 0; ks < 4; ++ks) { const int slot = ks * 2 + (lane >> 5); \
            const bf16x8 a0 = *(const bf16x8*)(As + swz(wr * 64 + (lane & 31), slot)); const bf16x8 a1 = *(const bf16x8*)(As + swz(wr * 64 + 32 + (lane & 31), slot)); \
            const bf16x8 b0 = *(const bf16x8*)(Bs + swz(wc * 64 + (lane & 31), slot)); const bf16x8 b1 = *(const bf16x8*)(Bs + swz(wc * 64 + 32 + (lane & 31), slot)); \
            acc[0][0] = __builtin_amdgcn_mfma_f32_32x32x16_bf16(a0, b0, acc[0][0], 0, 0, 0); acc[0][1] = __builtin_amdgcn_mfma_f32_32x32x16_bf16(a0, b1, acc[0][1], 0, 0, 0); \
            acc[1][0] = __builtin_amdgcn_mfma_f32_32x32x16_bf16(a1, b0, acc[1][0], 0, 0, 0); acc[1][1] = __builtin_amdgcn_mfma_f32_32x32x16_bf16(a1, b1, acc[1][1], 0, 0, 0); } } while (0)
    f32x16 acc[2][2];
#pragma unroll
    for (int a = 0; a < 2; ++a)
#pragma unroll
        for (int b = 0; b < 2; ++b)
#pragma unroll
            for (int r = 0; r < 16; ++r) acc[a][b][r] = 0.f;
    const int KT = pr.kt();
    __syncthreads();
    GLDS(0, 0);
    DMA_WAIT_SYNC();
    for (int kt = 0; kt < KT; kt += 2) {
        GLDS(1, kt + 1);
        COMPUTE(0);
        DMA_WAIT_SYNC();
        if (kt + 2 < KT) GLDS(0, kt + 2);
        COMPUTE(1);
        DMA_WAIT_SYNC();
    }
#undef GLDS
#undef DMA_WAIT_SYNC
#undef COMPUTE
    pr.epi(acc, wr, wc, lane, smem + wid * 8192);
}

template <class P>
DI void convert_tile(const P& pr, bf16_t* dst, int kdim, int kt, unsigned char* smem, int tid) {
    unsigned char* Bs = smem;
    const int ng = tid & 31, kg = tid >> 5;
    int width = 0;
    const float* bp = pr.b_col(ng >> 3, width);
    const int cig = (ng & 7) * 4;
    const bool bvalid = cig < width;
    const int ldb = pr.ldb();
    bp += cig + (size_t)(kt * 64 + kg * 8) * ldb;
    f32x4 rb[8];
#pragma unroll
    for (int kk = 0; kk < 8; ++kk) rb[kk] = bvalid ? *(const f32x4*)(bp + (size_t)kk * ldb) : (f32x4){0.f, 0.f, 0.f, 0.f};
    __syncthreads();
#pragma unroll
    for (int j = 0; j < 4; ++j) {
        u32x4 v = {pk2(rb[0][j], rb[1][j]), pk2(rb[2][j], rb[3][j]), pk2(rb[4][j], rb[5][j]), pk2(rb[6][j], rb[7][j])};
        *(u32x4*)(Bs + swz(ng * 4 + j, kg)) = v;
    }
    __syncthreads();
#pragma unroll
    for (int i = 0; i < 4; ++i) {
        const int n = (tid >> 3) + 32 * i;
        *(u32x4*)(dst + (size_t)n * kdim + kt * 64 + (tid & 7) * 8) = *(const u32x4*)(Bs + swz(n, tid & 7));
    }
}

template <int NC> DI void stage_put(unsigned char* wl, int mi, int ni, int r, int lane, float v) { *(bf16_t*)(wl + ((mi * 32 + crow(r, lane)) * NC + ni * 32 + (lane & 31)) * 2) = f2bf(v); }
template <int NC, class RowPtr> DI void stage_flush(unsigned char* wl, int lane, RowPtr rp) {
    constexpr int CH = NC / 8, RPI = 64 / CH, NIT = 64 / RPI;
#pragma unroll
    for (int i = 0; i < NIT; ++i) {
        const int row = lane / CH + RPI * i, ch = lane % CH;
        const u32x4 d = *(const u32x4*)(wl + (row * NC + ch * 8) * 2);
        bf16_t* dst = rp(row);
        if (dst) *(u32x4*)(dst + ch * 8) = d;
    }
}

struct HybIn {
    const Params* p; int j, tm, tn;
    DI int kt() const { return 16; }
    DI int ldb() const { return HYB_IN; }
    DI const bf16_t* a_base() const { return (const bf16_t*)(p->ws + WS_H); }
    DI int a_off(int r) const { return (tm * 128 + r) * 1024; }
    DI static void pair_cols(int pr, int ni, int& base, int& width) {
        width = 32;
        if (pr < 8) base = 64 * pr + 32 * ni;
        else if (pr == 8) base = 512 + 32 * ni;
        else if (pr == 9) base = 576 + 32 * ni;
        else if (pr < 18) base = 640 + 64 * (pr - 10) + 32 * ni;
        else if (pr == 18) base = 1152 + 32 * ni;
        else if (pr == 19) { base = 1216; width = ni == 0 ? 8 : 0; }
        else if (pr < 28) base = 1224 + 64 * (pr - 20) + 32 * ni;
        else base = (ni == 0 ? 1736 : 2248) + 32 * (pr - 28);
    }
    DI const float* b_col(int g, int& width) const { int base; pair_cols(tn * 2 + (g >> 1), g & 1, base, width); return p->hy_w_in + (size_t)j * 1024 * HYB_IN + base; }
    DI const bf16_t* b_base() const { return (const bf16_t*)(p->ws + WS_WHYB) + (size_t)(j * 22 + tn) * 128 * 1024; }
    DI void epi(f32x16 (&acc)[2][2], int wr, int wc, int lane, unsigned char* wl) const {
        const int pr = tn * 2 + wc, c = lane & 31;
        const int t0 = tm * 128 + wr * 64;
        unsigned char* ws = p->ws;
        const float* ropec = (const float*)(ws + WS_ROPEC);
        const float* ropes = (const float*)(ws + WS_ROPES);
        if (pr < 9 || (pr >= 10 && pr < 19)) {
            const bool donorm = pr < 9;
            const float* gam = pr < 8 ? p->hy_q_norm + j * 64 : p->hy_k_norm + j * 64;
            bf16_t* ob; int ld, cb;
            if (pr < 8) { ob = (bf16_t*)(ws + WS_Q); ld = 512; cb = 64 * pr; }
            else if (pr == 8) { ob = (bf16_t*)(ws + WS_K); ld = 64; cb = 0; }
            else if (pr < 18) { ob = (bf16_t*)(ws + WS_IQ); ld = 512; cb = 64 * (pr - 10); }
            else { ob = (bf16_t*)(ws + WS_IK); ld = 64; cb = 0; }
            float g1 = 1.f, g2 = 1.f;
            if (donorm) { g1 = gam[c]; g2 = gam[c + 32]; }
#pragma unroll
            for (int mi = 0; mi < 2; ++mi)
#pragma unroll
                for (int r = 0; r < 16; ++r) {
                    float x1 = acc[mi][0][r], x2 = acc[mi][1][r];
                    const int t = t0 + mi * 32 + crow(r, lane), pos = t & (S - 1);
                    if (donorm) { float ss = half_sum(x1 * x1 + x2 * x2); float rstd = rsqrtf(ss * (1.f / 64.f) + EPS); x1 *= rstd * g1; x2 *= rstd * g2; }
                    const float cs = ropec[pos * 32 + c], sn = ropes[pos * 32 + c];
                    stage_put<64>(wl, mi, 0, r, lane, x1 * cs - x2 * sn);
                    stage_put<64>(wl, mi, 1, r, lane, x2 * cs + x1 * sn);
                }
            stage_flush<64>(wl, lane, [&](int row) { return ob + (size_t)(t0 + row) * ld + cb; });
        } else if (pr == 9) {
            bf16_t* ob = (bf16_t*)(ws + WS_V);
#pragma unroll
            for (int mi = 0; mi < 2; ++mi)
#pragma unroll
                for (int ni = 0; ni < 2; ++ni)
#pragma unroll
                    for (int g4 = 0; g4 < 4; ++g4) {
                        const int t = t0 + mi * 32 + 8 * g4 + 4 * (lane >> 5), pos = t & (S - 1), bb = t >> 11;
                        u32x2 o = {pk2(acc[mi][ni][4 * g4], acc[mi][ni][4 * g4 + 1]), pk2(acc[mi][ni][4 * g4 + 2], acc[mi][ni][4 * g4 + 3])};
                        *(u32x2*)(ob + ((size_t)(bb * 64 + ni * 32 + c)) * S + pos) = o;
                    }
        } else if (pr == 19) {
            float* ob = (float*)(ws + WS_IW);
            if (c < 8) {
#pragma unroll
                for (int mi = 0; mi < 2; ++mi)
#pragma unroll
                    for (int r = 0; r < 16; ++r) { const int t = t0 + mi * 32 + crow(r, lane); ob[(size_t)t * 8 + c] = acc[mi][0][r] * (0.125f * 0.35355339059327373f); }
            }
        } else if (pr < 28) {
            bf16_t* ob = (bf16_t*)(ws + WS_BG); const int cb = 64 * (pr - 20);
#pragma unroll
            for (int mi = 0; mi < 2; ++mi)
#pragma unroll
                for (int r = 0; r < 16; ++r) { stage_put<64>(wl, mi, 0, r, lane, acc[mi][0][r]); stage_put<64>(wl, mi, 1, r, lane, acc[mi][1][r]); }
            stage_flush<64>(wl, lane, [&](int row) { return ob + (size_t)(t0 + row) * 512 + cb; });
        } else {
            bf16_t* ob = (bf16_t*)(ws + WS_Z); const int cb = 32 * (pr - 28);
#pragma unroll
            for (int mi = 0; mi < 2; ++mi)
#pragma unroll
                for (int r = 0; r < 16; ++r) stage_put<32>(wl, mi, 0, r, lane, acc[mi][0][r] * acc[mi][1][r]);
            stage_flush<32>(wl, lane, [&](int row) { return ob + (size_t)(t0 + row) * 512 + cb; });
        }
    }
};


struct HybCols8 {
    const Params* p; int j, tm, tn;
    DI int ldb() const { return HYB_IN; }
    DI const float* b_col(int g, int& width) const {
        const int u = tn >> 1, bj = tn & 1; int base; width = 32;
        if (u < 2) base = 64 * (4 * u + g) + 32 * bj;
        else if (u < 4) base = 640 + 64 * (4 * (u - 2) + g) + 32 * bj;
        else if (u == 4) { if (g == 0) base = 512 + 32 * bj; else if (g == 1) base = 576 + 32 * bj; else if (g == 2) base = 1152 + 32 * bj; else { base = 1216; width = bj == 0 ? 8 : 0; } }
        else if (u < 7) base = 1224 + (u - 5) * 256 + 128 * bj + 32 * g;
        else base = (bj == 0 ? 1736 : 2248) + (u - 7) * 128 + 32 * g;
        return p->hy_w_in + (size_t)j * 1024 * HYB_IN + base;
    }
};

struct MlIn {
    const Params* p; int j, tm, tn;
    DI int kt() const { return 16; }
    DI int ldb() const { return ML_IN; }
    DI const bf16_t* a_base() const { return (const bf16_t*)(p->ws + WS_H); }
    DI int a_off(int r) const { return (tm * 128 + r) * 1024; }
    DI const float* b_col(int g, int& width) const {
        const int pr = tn * 2 + (g >> 1), ni = g & 1; int base; width = 32;
        if (pr < 32) base = 64 * pr + 32 * ni;
        else if (pr == 32) { base = 2048 + 8 * ni; width = 8; }
        else if (pr < 49) base = 2064 + 64 * (pr - 33) + 32 * ni;
        else { base = 0; width = 0; }
        return p->ml_w_in + (size_t)j * 1024 * ML_IN + base;
    }
    DI const bf16_t* b_base() const { return (const bf16_t*)(p->ws + WS_WML) + (size_t)(j * 25 + tn) * 128 * 1024; }
    DI void epi(f32x16 (&acc)[2][2], int wr, int wc, int lane, unsigned char* wl) const {
        const int pr = tn * 2 + wc, c = lane & 31;
        const int t0 = tm * 128 + wr * 64;
        unsigned char* ws = p->ws;
        if (pr < 16) {
            bf16_t* ob; int cb; float sc = 1.f;
            if (pr < 8) { ob = (bf16_t*)(ws + WS_MQ); cb = 64 * pr; sc = 0.125f; }
            else { ob = (bf16_t*)(ws + WS_MK); cb = 64 * (pr - 8); }
#pragma unroll
            for (int mi = 0; mi < 2; ++mi)
#pragma unroll
                for (int r = 0; r < 16; ++r) { stage_put<64>(wl, mi, 0, r, lane, acc[mi][0][r] * sc); stage_put<64>(wl, mi, 1, r, lane, acc[mi][1][r] * sc); }
            stage_flush<64>(wl, lane, [&](int row) { return ob + (size_t)(t0 + row) * 512 + cb; });
        }
        if (pr >= 8 && pr < 32) {
            bf16_t* ob; int nrow, hd, r0;
            if (pr < 16) { ob = (bf16_t*)(ws + WS_MKT); nrow = 64; hd = pr - 8; r0 = 0; }
            else { ob = (bf16_t*)(ws + WS_MV); nrow = 128; hd = (pr - 16) >> 1; r0 = 64 * ((pr - 16) & 1); }
#pragma unroll
            for (int mi = 0; mi < 2; ++mi)
#pragma unroll
                for (int ni = 0; ni < 2; ++ni)
#pragma unroll
                    for (int g4 = 0; g4 < 4; ++g4) {
                        const int t = t0 + mi * 32 + 8 * g4 + 4 * (lane >> 5), pos = t & (S - 1), bb = t >> 11;
                        u32x2 o = {pk2(acc[mi][ni][4 * g4], acc[mi][ni][4 * g4 + 1]), pk2(acc[mi][ni][4 * g4 + 2], acc[mi][ni][4 * g4 + 3])};
                        *(u32x2*)(ob + ((size_t)((bb * 8 + hd) * nrow + r0 + ni * 32 + c)) * S + pos) = o;
                    }
        } else if (pr == 32) {
            if (c < 8) {
                float* oi = (float*)(ws + WS_MIG); float* of = (float*)(ws + WS_MFG);
                const float bi = p->ml_b_gates[j * 16 + c], bfg = p->ml_b_gates[j * 16 + 8 + c];
#pragma unroll
                for (int mi = 0; mi < 2; ++mi)
#pragma unroll
                    for (int r = 0; r < 16; ++r) {
                        const int t = t0 + mi * 32 + crow(r, lane);
                        oi[(size_t)t * 8 + c] = acc[mi][0][r] + bi;
                        const float f = acc[mi][1][r] + bfg;
                        of[(size_t)t * 8 + c] = fminf(f, 0.f) - log1pf(__expf(-fabsf(f)));
                    }
            }
        } else if (pr >= 33 && pr < 49) {
            bf16_t* ob = (bf16_t*)(ws + WS_MOG); const int cb = 64 * (pr - 33);
#pragma unroll
            for (int mi = 0; mi < 2; ++mi)
#pragma unroll
                for (int r = 0; r < 16; ++r) { stage_put<64>(wl, mi, 0, r, lane, sigmoidf_(acc[mi][0][r])); stage_put<64>(wl, mi, 1, r, lane, sigmoidf_(acc[mi][1][r])); }
            stage_flush<64>(wl, lane, [&](int row) { return ob + (size_t)(t0 + row) * 1024 + cb; });
        }
    }
};


struct MlCols8 {
    const Params* p; int j, tm, tn;
    DI int ldb() const { return ML_IN; }
    DI const float* b_col(int g, int& width) const {
        const int u = tn >> 1, bj = tn & 1; int base; width = 32;
        if (tn == 24) { base = 2048 + 8 * (g & 1); width = g < 2 ? 8 : 0; }
        else if (u < 2) base = 64 * (4 * u + g) + 32 * bj;
        else if (u < 4) base = 512 + 64 * (4 * (u - 2) + g) + 32 * bj;
        else if (u < 8) base = 1024 + (2 * (u - 4) + bj) * 128 + 32 * g;
        else base = 2064 + (u - 8) * 256 + 128 * bj + 32 * g;
        return p->ml_w_in + (size_t)j * 1024 * ML_IN + base;
    }
};
struct MlGates {
    const Params* p; int j, tm;
    DI int kt() const { return 16; }
    DI const bf16_t* a_base() const { return (const bf16_t*)(p->ws + WS_H); }
    DI int a_off(int r) const { return (tm * 128 + r) * 1024; }
    DI const bf16_t* b_base() const { return (const bf16_t*)(p->ws + WS_WML) + (size_t)(j * 25 + 24) * 128 * 1024; }
    DI void epi(f32x16 (&acc)[2][2], int wr, int wc, int lane, unsigned char* wl) const {
        const int c = lane & 31, t0 = tm * 128 + wr * 64;
        if (wc == 0 && c < 8) {
            float* oi = (float*)(p->ws + WS_MIG); float* of = (float*)(p->ws + WS_MFG);
            const float bi = p->ml_b_gates[j * 16 + c], bfg = p->ml_b_gates[j * 16 + 8 + c];
#pragma unroll
            for (int mi = 0; mi < 2; ++mi)
#pragma unroll
                for (int r = 0; r < 16; ++r) {
                    const int t = t0 + mi * 32 + crow(r, lane);
                    oi[(size_t)t * 8 + c] = acc[mi][0][r] + bi;
                    const float f = acc[mi][1][r] + bfg;
                    of[(size_t)t * 8 + c] = fminf(f, 0.f) - log1pf(__expf(-fabsf(f)));
                }
        }
    }
};

struct OutProj {
    const Params* p; const float* W; const float* src; int layer, tm, tn;
    DI int kt() const { return 16; }
    DI int ldb() const { return 1024; }
    DI const bf16_t* a_base() const { return (const bf16_t*)(p->ws + WS_YMIX); }
    DI int a_off(int r) const { return (tm * 128 + r) * 1024; }
    DI const float* b_col(int g, int& width) const { width = 32; return W + tn * 128 + g * 32; }
    DI const bf16_t* b_base() const { return (const bf16_t*)(p->ws + WS_WOUT) + (size_t)(layer * 8 + tn) * 128 * 1024; }
    DI void epi(f32x16 (&acc)[2][2], int wr, int wc, int lane, unsigned char* wl) const {
        const int c = lane & 31, t0 = tm * 128 + wr * 64, wid = wr * 2 + wc;
        float* fl = (float*)(wl + wid * 8192);
#pragma unroll
        for (int mi = 0; mi < 2; ++mi)
#pragma unroll
            for (int ni = 0; ni < 2; ++ni)
#pragma unroll
                for (int r = 0; r < 16; ++r) fl[(mi * 32 + crow(r, lane)) * 64 + ni * 32 + c] = acc[mi][ni][r];
        const float* mod = (const float*)(p->ws + WS_MOD) + (size_t)layer * 8 * 6144;
        const int ch = lane & 15, n = tn * 128 + wc * 64 + ch * 4;
        const f32x4 g = *(const f32x4*)(mod + (t0 >> 11) * 6144 + 2048 + n);
        float* part = (float*)(p->ws + WS_PART);
#pragma unroll 4
        for (int i = 0; i < 16; ++i) {
            const int row = (lane >> 4) + 4 * i, t = t0 + row;
            const f32x4 a = *(const f32x4*)(fl + row * 64 + ch * 4);
            const f32x4 o = *(const f32x4*)(src + (size_t)t * 1024 + n) + g * a;
            *(f32x4*)(p->out + (size_t)t * 1024 + n) = o;
            float ss = o[0] * o[0] + o[1] * o[1] + o[2] * o[2] + o[3] * o[3];
            ss += sx_f<1>(ss); ss += sx_f<2>(ss); ss += sx_f<4>(ss); ss += sx_f<8>(ss);
            if (ch == 0) part[(size_t)t * 16 + tn * 2 + wc] = ss;
        }
    }
};

struct Moe1 {
    const Params* p; int layer, e, mt, nt, cnt, roff;
    DI int kt() const { return 16; }
    DI int ldb() const { return DEXP; }
    DI const bf16_t* a_base() const { return (const bf16_t*)(p->ws + WS_H); }
    DI int a_off(int r) const {
        const int rr = mt * 128 + r; if (rr >= cnt) return -1;
        const int a = ((const int*)(p->ws + WS_ELIST))[(size_t)e * NASG + rr];
        return (a >> 1) * 1024;
    }
    DI const float* b_col(int g, int& width) const {
        width = 32;
        const float* base = (nt & 1) ? p->moe_w_up : p->moe_w_gate;
        return base + ((size_t)layer * NEXP + e) * (size_t)(D * DEXP) + 128 * (nt >> 1) + 32 * g;
    }
    DI const bf16_t* b_base() const { return (const bf16_t*)(p->ws + WS_WM1) + (size_t)((layer * NEXP + e) * 8 + nt) * 128 * 1024; }
    DI void epi(f32x16 (&acc)[2][2], int wr, int wc, int lane, unsigned char* wl) const {
        const int c = lane & 31, pr = nt * 2 + wc;
        bf16_t* ob = (bf16_t*)(p->ws + WS_H1);
#pragma unroll
        for (int mi = 0; mi < 2; ++mi)
#pragma unroll
            for (int r = 0; r < 16; ++r) {
                const float g = acc[mi][0][r], u = acc[mi][1][r];
                stage_put<32>(wl, mi, 0, r, lane, g / (1.f + __expf(-g)) * u);
            }
        const int rb = mt * 128 + wr * 64;
        stage_flush<32>(wl, lane, [&](int row) { return rb + row < cnt ? ob + (size_t)(roff + rb + row) * 512 + 32 * pr : (bf16_t*)nullptr; });
    }
};

struct Moe2 {
    const Params* p; int layer, e, mt, nt, cnt, roff;
    DI int kt() const { return 8; }
    DI int ldb() const { return D; }
    DI const bf16_t* a_base() const { return (const bf16_t*)(p->ws + WS_H1); }
    DI int a_off(int r) const { const int rr = mt * 128 + r; if (rr >= cnt) return -1; return (roff + rr) * 512; }
    DI const float* b_col(int g, int& width) const { width = 32; return p->moe_w_down + ((size_t)layer * NEXP + e) * (size_t)(DEXP * D) + nt * 128 + g * 32; }
    DI const bf16_t* b_base() const { return (const bf16_t*)(p->ws + WS_WM2) + (size_t)((layer * NEXP + e) * 8 + nt) * 128 * 512; }
    DI void epi(f32x16 (&acc)[2][2], int wr, int wc, int lane, unsigned char* wl) const {
        const int c = lane & 31;
        bf16_t* ob = (bf16_t*)(p->ws + WS_Y);
        const int* el = (const int*)(p->ws + WS_ELIST) + (size_t)e * NASG;
#pragma unroll
        for (int mi = 0; mi < 2; ++mi)
#pragma unroll
            for (int r = 0; r < 16; ++r) { stage_put<64>(wl, mi, 0, r, lane, acc[mi][0][r]); stage_put<64>(wl, mi, 1, r, lane, acc[mi][1][r]); }
        const int rb = mt * 128 + wr * 64;
        stage_flush<64>(wl, lane, [&](int row) { return rb + row < cnt ? ob + (size_t)el[rb + row] * 1024 + nt * 128 + wc * 64 : (bf16_t*)nullptr; });
    }
};

DI void convert_moe_layers(const Params& p, int l0, int l1, unsigned char* smem, int bid, int nb, int tid) {
    const int PER = 32 * 8 * 16 + 32 * 8 * 8, total = (l1 - l0) * PER;
    for (int item = bid; item < total; item += nb) {
        const int l = l0 + item / PER; int ci = item % PER;
        if (ci < 4096) { const int kt = ci & 15, nt = (ci >> 4) & 7, e = ci >> 7; Moe1 pr{&p, l, e, 0, nt, 0, 0}; convert_tile(pr, (bf16_t*)(p.ws + WS_WM1) + (size_t)((l * 32 + e) * 8 + nt) * 128 * 1024, 1024, kt, smem, tid); }
        else { ci -= 4096; const int kt = ci & 7, nt = (ci >> 3) & 7, e = ci >> 6; Moe2 pr{&p, l, e, 0, nt, 0, 0}; convert_tile(pr, (bf16_t*)(p.ws + WS_WM2) + (size_t)((l * 32 + e) * 8 + nt) * 128 * 512, 512, kt, smem, tid); }
    }
    __syncthreads();
}

DI void phase_init(const Params& p, unsigned char* smem, int bid, int nb, int tid) {
    float* sc = (float*)smem;
    float* red = (float*)(smem + 32768);
    const int NMOD = DEPTH * 96, NROPE = 256;
    const int C_HYB = 2 * 22 * 16, C_ML = 2 * 25 * 16, C_OUT = 4 * 8 * 16;
    for (int ci = bid; ci < C_HYB + C_ML + C_OUT; ci += nb) {
        int c2 = ci;
        if (c2 < C_HYB) { const int kt = c2 & 15, tn = (c2 >> 4) % 22, j = (c2 >> 4) / 22; HybCols8 pr{&p, j, 0, tn}; convert_tile(pr, (bf16_t*)(p.ws + WS_WHYB) + (size_t)(j * 22 + tn) * 128 * 1024, 1024, kt, smem, tid); continue; }
        c2 -= C_HYB;
        if (c2 < C_ML) { const int kt = c2 & 15, tn = (c2 >> 4) % 25, j = (c2 >> 4) / 25; MlCols8 pr{&p, j, 0, tn}; convert_tile(pr, (bf16_t*)(p.ws + WS_WML) + (size_t)(j * 25 + tn) * 128 * 1024, 1024, kt, smem, tid); continue; }
        c2 -= C_ML;
        { const int kt = c2 & 15, tn = (c2 >> 4) & 7, l = c2 >> 7; const float* W = ((l & 1) ? p.ml_w_out : p.hy_w_out) + (size_t)(l >> 1) * 1024 * 1024;
            OutProj pr{&p, W, nullptr, l, 0, tn}; convert_tile(pr, (bf16_t*)(p.ws + WS_WOUT) + (size_t)(l * 8 + tn) * 128 * 1024, 1024, kt, smem, tid); }
    }
    for (int item = bid; item < NMOD; item += nb) {
        __syncthreads();
        for (int i = tid; i < 8 * 1024; i += 256) { const float v = p.c[i]; sc[i] = v / (1.f + __expf(-v)); }
        __syncthreads();
        const int l = item / 96, jb = item % 96, cq = tid & 15, ksl = tid >> 4;
        const float* w = p.ada_w + (size_t)l * 1024 * 6144 + jb * 64 + cq * 4;
        f32x4 acc[8];
#pragma unroll
        for (int b = 0; b < 8; ++b) acc[b] = (f32x4){0.f, 0.f, 0.f, 0.f};
        for (int ii = 0; ii < 64; ++ii) {
            const int i = ksl * 64 + ii;
            const f32x4 wv = *(const f32x4*)(w + (size_t)i * 6144);
#pragma unroll
            for (int b = 0; b < 8; ++b) acc[b] += wv * sc[b * 1024 + i];
        }
#pragma unroll
        for (int b = 0; b < 8; ++b) *(f32x4*)(red + (ksl * 8 + b) * 64 + cq * 4) = acc[b];
        __syncthreads();
        for (int o = tid; o < 512; o += 256) {
            const int b = o >> 6, cc = o & 63; float s = 0.f;
            for (int k = 0; k < 16; ++k) s += red[(k * 8 + b) * 64 + cc];
            ((float*)(p.ws + WS_MOD))[((size_t)l * 8 + b) * 6144 + jb * 64 + cc] = s + p.ada_b[l * 6144 + jb * 64 + cc];
        }
    }
    for (int item = bid; item < NROPE + 1; item += nb) {
        if (item < NROPE) {
            const int idx = item * 256 + tid;
            const int pos = idx >> 5, i = idx & 31;
            const float inv = 1.0f / powf(10000.0f, (float)(2 * i) / 64.0f);
            const float ang = (float)pos * inv;
            ((float*)(p.ws + WS_ROPEC))[idx] = cosf(ang);
            ((float*)(p.ws + WS_ROPES))[idx] = sinf(ang);
        } else {
            if (tid < DEPTH * 32) ((int*)(p.ws + WS_ECNT))[tid * ECS] = 0;
        }
    }
    __syncthreads();
}

DI bool aff_ok(int nb, int per) { return (nb & (nb - 1)) == 0 && nb >= 16 && (nb >> 3) <= per; }
DI int aff_div(int g, int nb) { return g >> (31 - __builtin_clz(nb)); }
DI int aff_x(int bid) { return (bid >> 1) & 7; }
DI int aff_r(int bid) { return ((bid >> 4) << 1) | (bid & 1); }
DI int amap(int g, int bid, int nb, int per) { return aff_ok(nb, per) ? aff_x(bid) * per + aff_r(bid) + aff_div(g, nb) * (nb >> 3) : g; }

DI void phase_norm(const Params& p, int layer, const float* src, int bid, int nb, int tid) {
    const int lane = tid & 63, wid = tid >> 6;
    const GAS float* mod = (const GAS float*)(p.ws + WS_MOD) + (size_t)layer * 8 * 6144;
    const GAS float* gam = (const GAS float*)p.norm_mix + layer * 1024;
    const GAS float* X = (const GAS float*)src;
    GAS bf16_t* H = (GAS bf16_t*)(p.ws + WS_H);
    for (int item = bid; item < T / 4; item += 2 * nb) {
        f32x4 v[2][4]; bool ok[2];
#pragma unroll
        for (int x = 0; x < 2; ++x) {
            const int it = item + x * nb; ok[x] = it < T / 4;
            const GAS float* xr = X + (size_t)(amap(ok[x] ? it : item, bid, nb, 512) * 4 + wid) * 1024;
#pragma unroll
            for (int i = 0; i < 4; ++i) v[x][i] = *(const GAS f32x4*)(xr + (lane + 64 * i) * 4);
        }
#pragma unroll
        for (int x = 0; x < 2; ++x) {
            if (!ok[x]) continue;
            const int t = amap(item + x * nb, bid, nb, 512) * 4 + wid, b = t >> 11;
            float ss = 0.f;
#pragma unroll
            for (int i = 0; i < 4; ++i) ss += v[x][i][0] * v[x][i][0] + v[x][i][1] * v[x][i][1] + v[x][i][2] * v[x][i][2] + v[x][i][3] * v[x][i][3];
            ss = wave_sum(ss);
            const float rstd = rsqrtf(ss * (1.f / 1024.f) + EPS);
#pragma unroll
            for (int i = 0; i < 4; ++i) {
                const int c0 = (lane + 64 * i) * 4;
                const f32x4 g = *(const GAS f32x4*)(gam + c0), sh = *(const GAS f32x4*)(mod + b * 6144 + c0), sc = *(const GAS f32x4*)(mod + b * 6144 + 1024 + c0);
                f32x4 h = v[x][i] * rstd * g * (sc + 1.f) + sh;
                u32x2 o = {pk2(h[0], h[1]), pk2(h[2], h[3])};
                *(GAS u32x2*)(H + (size_t)t * 1024 + c0) = o;
            }
        }
    }
}

DI void phase_ffn_norm_router(const Params& p, int layer, unsigned char* smem, int bid, int nb, int tid) {
    LAS float* rstd_s = (LAS float*)smem;
    LAS float* lg = (LAS float*)(smem + 512);
    LAS float* hs = (LAS float*)(smem + 512 + 32 * 37 * 4);
    LAS float* wcs = (LAS float*)(smem + 5248 + 2 * 32 * 65 * 4);
    LAS float* part = (LAS float*)(smem + 42368);
    LAS float* gpart = (LAS float*)(smem + 59264);
    const int lane = tid & 63, og = __builtin_amdgcn_readfirstlane(tid >> 6), tok = lane & 31, kh = lane >> 5;
    const GAS float* mod = (const GAS float*)(p.ws + WS_MOD) + (size_t)layer * 8 * 6144;
    const GAS float* gam = (const GAS float*)p.norm_ffn + layer * 1024;
    const GAS float* wg = (const GAS float*)p.moe_w_group + (size_t)layer * 1024 * 4;
    const GAS float* we = (const GAS float*)p.moe_w_expert + (size_t)layer * 1024 * 32;
    GAS bf16_t* H = (GAS bf16_t*)(p.ws + WS_H);
    int* ecnt = (int*)(p.ws + WS_ECNT) + layer * 32 * ECS;
    int* elist = (int*)(p.ws + WS_ELIST);
    float* ew = (float*)(p.ws + WS_EW);
    for (int item = bid; item < T / 32; item += nb) {
        const int t0 = __builtin_amdgcn_readfirstlane(amap(item, bid, nb, 64) * 32), b = t0 >> 11;
        __syncthreads();
        if (tid < 32) {
            const f32x4* pp = (const f32x4*)((const float*)(p.ws + WS_PART) + (size_t)(t0 + tid) * 16);
            const f32x4 a = pp[0], b4 = pp[1], c4 = pp[2], d4 = pp[3];
            const float ss = ((a[0] + a[1]) + (a[2] + a[3])) + ((b4[0] + b4[1]) + (b4[2] + b4[3])) + ((c4[0] + c4[1]) + (c4[2] + c4[3])) + ((d4[0] + d4[1]) + (d4[2] + d4[3]));
            rstd_s[tid] = rsqrtf(ss * (1.f / 1024.f) + EPS);
        }
        const int stok = tid >> 3, sk0 = (tid & 7) * 8;
        const GAS float* xrow = (const GAS float*)p.out + (size_t)(t0 + stok) * 1024 + sk0;
        const GAS float* mrow = mod + b * 6144 + sk0;
        f32x4 xa[2], ga[2], sha[2], sca[2], wa[3], xb[2], gb2[2], shb[2], scb[2], wb2[3];
#define FFN_LOAD(xv, gv, shv, scv, wv, k0) do { _Pragma("unroll") for (int q = 0; q < 2; ++q) { xv[q] = *(const GAS f32x4*)(xrow + (k0) + 4 * q); gv[q] = *(const GAS f32x4*)(gam + sk0 + (k0) + 4 * q); \
            shv[q] = *(const GAS f32x4*)(mrow + 3072 + (k0) + 4 * q); scv[q] = *(const GAS f32x4*)(mrow + 4096 + (k0) + 4 * q); } \
            wv[0] = *(const GAS f32x4*)(we + (k0) * 32 + tid * 4); wv[1] = *(const GAS f32x4*)(we + (k0) * 32 + 1024 + tid * 4); wv[2] = *(const GAS f32x4*)(wg + (k0) * 4 + (tid & 63) * 4); } while (0)
#define FFN_STEP(xv, gv, shv, scv, wv, kc) do { const int k0 = (kc) * 64; LAS float* hb = hs + ((kc) & 1) * (32 * 65); LAS float* wb = wcs + ((kc) & 1) * (64 * 40); u32x4 ho; \
            _Pragma("unroll") for (int q = 0; q < 2; ++q) { const f32x4 h = xv[q] * srstd * gv[q] * (scv[q] + 1.f) + shv[q]; ho[2 * q] = pk2(h[0], h[1]); ho[2 * q + 1] = pk2(h[2], h[3]); \
                LAS float* hp = hb + stok * 65 + sk0 + 4 * q; hp[0] = h[0]; hp[1] = h[1]; hp[2] = h[2]; hp[3] = h[3]; } \
            *(GAS u32x4*)(H + (size_t)(t0 + stok) * 1024 + k0 + sk0) = ho; \
            *(LAS f32x4*)(wb + (tid >> 3) * 40 + 4 + (tid & 7) * 4) = wv[0]; *(LAS f32x4*)(wb + (32 + (tid >> 3)) * 40 + 4 + (tid & 7) * 4) = wv[1]; if (tid < 64) *(LAS f32x4*)(wb + tid * 40) = wv[2]; \
            if ((kc) + 2 < 16) FFN_LOAD(xv, gv, shv, scv, wv, k0 + 128); \
            __syncthreads(); \
            { const LAS float* ha = hb + tok * 65 + og * 16 + kh; const LAS float* wbp = wb + (og * 16 + kh) * 40 + 4 + tok; float av[8], bv[8]; \
              _Pragma("unroll") for (int m = 0; m < 8; ++m) { av[m] = ha[2 * m]; bv[m] = wbp[2 * m * 40]; } \
              const LAS float* hg = hb + tok * 65 + og * 16 + kh * 8; const LAS float* wgp = wb + (og * 16 + kh * 8) * 40; \
              _Pragma("unroll") for (int i = 0; i < 8; ++i) { const float hv = hg[i]; gacc += *(const LAS f32x4*)(wgp + i * 40) * hv; } \
              _Pragma("unroll") for (int m = 0; m < 8; ++m) eacc = __builtin_amdgcn_mfma_f32_32x32x2f32(av[m], bv[m], eacc, 0, 0, 0); } } while (0)
        FFN_LOAD(xa, ga, sha, sca, wa, 0);
        FFN_LOAD(xb, gb2, shb, scb, wb2, 64);
        __syncthreads();
        const float srstd = rstd_s[stok];
        f32x16 eacc; f32x4 gacc = {0.f, 0.f, 0.f, 0.f};
#pragma unroll
        for (int r = 0; r < 16; ++r) eacc[r] = 0.f;
        for (int kc = 0; kc < 16; kc += 2) {
            FFN_STEP(xa, ga, sha, sca, wa, kc);
            FFN_STEP(xb, gb2, shb, scb, wb2, kc + 1);
        }
#undef FFN_STEP
#undef FFN_LOAD
#pragma unroll
        for (int r = 0; r < 16; ++r) part[(og * 32 + crow(r, lane)) * 33 + tok] = eacc[r];
#pragma unroll
        for (int e = 0; e < 4; ++e) { const float v = gacc[e] + sx_f<32>(gacc[e]); if (kh == 0) gpart[(og * 32 + tok) * 4 + e] = v; }
        __syncthreads();
        { const int tk = tid >> 3, c4 = (tid & 7) * 4;
#pragma unroll
          for (int e = 0; e < 4; ++e) lg[tk * 37 + 4 + c4 + e] = (part[tk * 33 + c4 + e] + part[(32 + tk) * 33 + c4 + e]) + (part[(64 + tk) * 33 + c4 + e] + part[(96 + tk) * 33 + c4 + e]);
          if (tid < 128) lg[(tid >> 2) * 37 + (tid & 3)] = (gpart[tid] + gpart[128 + tid]) + (gpart[256 + tid] + gpart[384 + tid]); }
        __syncthreads();
        if (tid < 32) {
            const int t = t0 + tid;
            float gl[4]; float gmax = -INFINITY; int gsel = 0;
#pragma unroll
            for (int g = 0; g < 4; ++g) { gl[g] = lg[tid * 37 + g] + p.moe_b_group[layer * 4 + g]; if (gl[g] > gmax) { gmax = gl[g]; gsel = g; } }
            float gsum = 0.f;
#pragma unroll
            for (int g = 0; g < 4; ++g) gsum += __expf(gl[g] - gmax);
            const float pg = __builtin_amdgcn_rcpf(gsum);
            float v1 = -INFINITY, v2 = -INFINITY; int i1 = 0, i2 = 0;
            for (int jx = 0; jx < 8; ++jx) {
                const float v = lg[tid * 37 + 4 + gsel * 8 + jx] + p.moe_b_expert[layer * 32 + gsel * 8 + jx];
                if (v > v1) { v2 = v1; i2 = i1; v1 = v; i1 = jx; } else if (v > v2) { v2 = v; i2 = jx; }
            }
            const float e2 = __expf(v2 - v1), den = __builtin_amdgcn_rcpf(1.f + e2);
            const float w1 = pg * den, w2 = pg * e2 * den;
            const int ea = gsel * 8 + i1, eb = gsel * 8 + i2;
            int* cl = (int*)smem + 32;
            cl[tid] = 0;
            const int la = atomicAdd(&cl[ea], 1);
            const int lb = atomicAdd(&cl[eb], 1);
            { const int n = cl[tid]; cl[32 + tid] = n > 0 ? atomicAdd(&ecnt[tid * ECS], n) : 0; }
            const int ra = cl[32 + ea] + la, rb = cl[32 + eb] + lb;
            elist[(size_t)ea * NASG + ra] = t * 2; ew[t * 2] = w1;
            elist[(size_t)eb * NASG + rb] = t * 2 + 1; ew[t * 2 + 1] = w2;
        }
    }
}

DI bool dense_item(int i, int NT, int xcd, int& tm, int& tn) {
    if (i >= 16 * NT) return false;
    const int mg = i / (8 * NT), r = i % (8 * NT);
    tn = r >> 3; tm = xcd * 16 + mg * 8 + (r & 7);
    return true;
}
template <class PR> DI void phase_hyb_in(const Params& p, int j, unsigned char* smem, int xcd, int lb, int nlb, int tid) {
    int tm, tn;
    for (int i = lb; dense_item(i, 22, xcd, tm, tn); i += nlb) { HybIn pr{&p, j, tm, tn}; gemm_tile(pr, smem, opq(tid)); }
}
DI void phase_ml_in(const Params& p, int j, unsigned char* smem, int xcd, int lb, int nlb, int tid) {
    int tm, tn;
    for (int i = lb; dense_item(i, 25, xcd, tm, tn); i += nlb) { MlIn pr{&p, j, tm, tn}; gemm_tile(pr, smem, opq(tid)); }
}
DI void phase_out_proj(const Params& p, int layer, const float* W, const float* src, unsigned char* smem, int xcd, int lb, int nlb, int tid) {
    int tm, tn;
    for (int i = lb; dense_item(i, 8, xcd, tm, tn); i += nlb) { OutProj pr{&p, W, src, layer, tm, tn}; gemm_tile(pr, smem, opq(tid)); }
}
template <int WHICH> DI void phase_moe(const Params& p, int layer, unsigned char* smem, int xcd, int lb, int nlb, int tid) {
    int* toff = (int*)(smem + 65600);
    __syncthreads();
    if (tid == 0) {
        const int* ecnt = (const int*)(p.ws + WS_ECNT) + layer * 32 * ECS;
        int ta = 0, ra = 0;
        for (int e = 0; e < 32; ++e) {
            const int c = ecnt[e * ECS];
            if ((e & 7) == xcd) { const int q = e >> 3; toff[q] = ta; toff[8 + q] = ra; toff[16 + q] = c; ta += (c + 127) >> 7; }
            ra += c;
        }
        toff[4] = ta;
    }
    __syncthreads();
    const int total = toff[4] * 8;
    for (int item = lb; item < total; item += nlb) {
        const int mg = item >> 3, nt = item & 7;
        int q = 0;
        while (q < 3 && toff[q + 1] <= mg) ++q;
        const int e = q * 8 + xcd, cnt = toff[16 + q], roff = toff[8 + q];
        if (WHICH == 1) { Moe1 pr{&p, layer, e, mg - toff[q], nt, cnt, roff}; gemm_tile(pr, smem, opq(tid)); }
        else { Moe2 pr{&p, layer, e, mg - toff[q], nt, cnt, roff}; gemm_tile(pr, smem, opq(tid)); }
    }
}

DI void phase_combine_norm(const Params& p, int layer, int bid, int nb, int tid) {
    const int lane = tid & 63, wid = tid >> 6;
    const GAS float* mod = (const GAS float*)(p.ws + WS_MOD) + (size_t)layer * 8 * 6144;
    const GAS float* modn = mod + 8 * 6144;
    const GAS float* gam = (const GAS float*)p.norm_mix + (layer + 1) * 1024;
    const GAS bf16_t* Y = (const GAS bf16_t*)(p.ws + WS_Y);
    const GAS float* ew = (const GAS float*)(p.ws + WS_EW);
    GAS bf16_t* H = (GAS bf16_t*)(p.ws + WS_H);
    GAS float* X = (GAS float*)p.out;
    const bool has_next = layer + 1 < DEPTH;
    f32x4 xa[4], xb[4]; u32x2 ya0[4], ya1[4], yb0[4], yb1[4]; float wa0, wa1, wb0, wb1;
#define CMB_LD(xv, y0v, y1v, w0, w1, it) do { const int t_ = amap(it, bid, nb, 512) * 4 + wid; w0 = ew[2 * t_]; w1 = ew[2 * t_ + 1]; \
        _Pragma("unroll") for (int i = 0; i < 4; ++i) { const int c0 = (lane + 64 * i) * 4; xv[i] = *(const GAS f32x4*)(X + (size_t)t_ * 1024 + c0); \
            y0v[i] = __builtin_nontemporal_load((const GAS u32x2*)(Y + (size_t)(2 * t_) * 1024 + c0)); y1v[i] = __builtin_nontemporal_load((const GAS u32x2*)(Y + (size_t)(2 * t_ + 1) * 1024 + c0)); } } while (0)
#define CMB_DO(xv, y0v, y1v, w0, w1, it) do { const int t = amap(it, bid, nb, 512) * 4 + wid, b = t >> 11; float ss = 0.f; \
        _Pragma("unroll") for (int i = 0; i < 4; ++i) { const int c0 = (lane + 64 * i) * 4; \
            const f32x4 g = *(const GAS f32x4*)(mod + b * 6144 + 5120 + c0); const u32x2 y0 = y0v[i], y1 = y1v[i]; \
            xv[i][0] += g[0] * (w0 * bflo(y0[0]) + w1 * bflo(y1[0])); xv[i][1] += g[1] * (w0 * bfhi(y0[0]) + w1 * bfhi(y1[0])); \
            xv[i][2] += g[2] * (w0 * bflo(y0[1]) + w1 * bflo(y1[1])); xv[i][3] += g[3] * (w0 * bfhi(y0[1]) + w1 * bfhi(y1[1])); \
            *(GAS f32x4*)(X + (size_t)t * 1024 + c0) = xv[i]; \
            ss += xv[i][0] * xv[i][0] + xv[i][1] * xv[i][1] + xv[i][2] * xv[i][2] + xv[i][3] * xv[i][3]; } \
        if (has_next) { ss = wave_sum(ss); const float rstd = rsqrtf(ss * (1.f / 1024.f) + EPS); \
            _Pragma("unroll") for (int i = 0; i < 4; ++i) { const int c0 = (lane + 64 * i) * 4; \
                const f32x4 g = *(const GAS f32x4*)(gam + c0), sh = *(const GAS f32x4*)(modn + b * 6144 + c0), sc = *(const GAS f32x4*)(modn + b * 6144 + 1024 + c0); \
                const f32x4 h = xv[i] * rstd * g * (sc + 1.f) + sh; \
                u32x2 o = {pk2(h[0], h[1]), pk2(h[2], h[3])}; \
                *(GAS u32x2*)(H + (size_t)t * 1024 + c0) = o; } } } while (0)
    int item = bid;
    if (item < T / 4) CMB_LD(xa, ya0, ya1, wa0, wa1, item);
    while (item < T / 4) {
        int nxt = item + nb;
        if (nxt < T / 4) CMB_LD(xb, yb0, yb1, wb0, wb1, nxt);
        CMB_DO(xa, ya0, ya1, wa0, wa1, item);
        item = nxt; if (item >= T / 4) break;
        nxt = item + nb;
        if (nxt < T / 4) CMB_LD(xa, ya0, ya1, wa0, wa1, nxt);
        CMB_DO(xb, yb0, yb1, wb0, wb1, item);
        item = nxt;
    }
#undef CMB_LD
#undef CMB_DO
}

DI unsigned sortable(float f) { const unsigned u = __float_as_uint(f); return u ^ ((unsigned)((int)u >> 31) | 0x80000000u); }
DI float relu_bits(float x) { const int b = __float_as_int(x); return __int_as_float(b > 0 ? b : 0); }
DI void cnt4(int& n, unsigned a, unsigned b, unsigned c, unsigned d, unsigned t) {
    unsigned long long m0, m1, m2, m3;
    asm volatile("v_cmp_ge_u32_e64 %1, %5, %9\n\t"
                 "v_cmp_ge_u32_e64 %2, %6, %9\n\t"
                 "v_cmp_ge_u32_e64 %3, %7, %9\n\t"
                 "v_cmp_ge_u32_e64 %4, %8, %9\n\t"
                 "v_addc_co_u32_e64 %0, vcc, %0, 0, %1\n\t"
                 "v_addc_co_u32_e64 %0, vcc, %0, 0, %2\n\t"
                 "v_addc_co_u32_e64 %0, vcc, %0, 0, %3\n\t"
                 "v_addc_co_u32_e64 %0, vcc, %0, 0, %4"
                 : "+v"(n), "=&s"(m0), "=&s"(m1), "=&s"(m2), "=&s"(m3) : "v"(a), "v"(b), "v"(c), "v"(d), "v"(t) : "vcc");
}
DI int half_sum_i(int v) { v += sx_i<16>(v); v += sx_i<8>(v); v += sx_i<4>(v); v += sx_i<2>(v); v += sx_i<1>(v); return v; }

struct CvTask { const float* src; bf16_t* dst; int ldb, kdim, far; };
DI CvTask cv_task(const Params& p, int l0, int id, int near_layer = -1) {
    const int PER = 32 * 8 * 16 * 4 + 32 * 8 * 8 * 4;
    const int l = l0 + id / PER; int ci = id % PER; CvTask t; t.far = l != (near_layer < 0 ? l0 : near_layer);
    if (ci < 16384) {
        const int g = ci & 3, kt = (ci >> 2) & 15, nt = (ci >> 6) & 7, e = ci >> 9; int w;
        Moe1 pr{&p, l, e, 0, nt, 0, 0};
        t.ldb = DEXP; t.kdim = 1024; t.src = pr.b_col(g, w) + (size_t)(kt * 64) * DEXP;
        t.dst = (bf16_t*)(p.ws + WS_WM1) + ((size_t)((l * 32 + e) * 8 + nt) * 128 + g * 32) * 1024 + kt * 64;
    } else {
        ci -= 16384;
        const int g = ci & 3, kt = (ci >> 2) & 7, nt = (ci >> 5) & 7, e = ci >> 8; int w;
        Moe2 pr{&p, l, e, 0, nt, 0, 0};
        t.ldb = D; t.kdim = 512; t.src = pr.b_col(g, w) + (size_t)(kt * 64) * D;
        t.dst = (bf16_t*)(p.ws + WS_WM2) + ((size_t)((l * 32 + e) * 8 + nt) * 128 + g * 32) * 512 + kt * 64;
    }
    return t;
}
DI void cv_issue(const CvTask& t, int lane, f32x4 (&rb)[8]) {
    const float* s = t.src + (size_t)((lane >> 3) * 8) * t.ldb + (lane & 7) * 4;
#pragma unroll
    for (int kk = 0; kk < 8; ++kk) rb[kk] = __builtin_nontemporal_load((const f32x4*)(s + (size_t)kk * t.ldb));
}
DI void cv_finish(const CvTask& t, int lane, const f32x4 (&rb)[8]) {
    bf16_t* d = t.dst + (size_t)((lane & 7) * 4) * t.kdim + (lane >> 3) * 8;
#pragma unroll
    for (int jx = 0; jx < 4; ++jx) {
        u32x4 v = {pk2(rb[0][jx], rb[1][jx]), pk2(rb[2][jx], rb[3][jx]), pk2(rb[4][jx], rb[5][jx]), pk2(rb[6][jx], rb[7][jx])};
        if (t.far) __builtin_nontemporal_store(v, (u32x4*)(d + (size_t)jx * t.kdim)); else *(u32x4*)(d + (size_t)jx * t.kdim) = v;
    }
}
DI void convert_moe_waves(const Params& p, int l0, int l1, int gwave, int nwaves, int lane, int near_layer = -1) {
    const int total = (l1 - l0) * 24576;
    for (int id = gwave; id < total; id += 2 * nwaves) {
        f32x4 ra[8], rb[8];
        const CvTask t0 = cv_task(p, l0, id, near_layer);
        cv_issue(t0, lane, ra);
        const bool two = id + nwaves < total;
        if (two) { const CvTask t1 = cv_task(p, l0, id + nwaves, near_layer); cv_issue(t1, lane, rb); cv_finish(t0, lane, ra); cv_finish(t1, lane, rb); }
        else cv_finish(t0, lane, ra);
    }
}

DI void phase_dsa(const Params& p, int j, unsigned char* smem, int bid, int nb, int tid, int cv0 = 0, int cv1 = 0) {
    if (cv1 == cv0 + 2 && (bid & 1)) convert_moe_waves(p, cv0 + 1, cv0 + 2, (bid >> 1) * 4 + (tid >> 6), (nb >> 1) * 4, tid & 63, cv0);
    const int lane = tid & 63, wid = tid >> 6, c = lane & 31, hh = lane >> 5;
    LAS unsigned* mw = (LAS unsigned*)smem + wid * 256;
    unsigned char* wsu = uniform_ptr(p.ws);
    const GAS bf16_t* IQ = (const GAS bf16_t*)(wsu + WS_IQ);
    const GAS bf16_t* IK = (const GAS bf16_t*)(wsu + WS_IK);
    const GAS float* IW = (const GAS float*)(wsu + WS_IW);
    const GAS bf16_t* Q = (const GAS bf16_t*)(wsu + WS_Q);
    const GAS bf16_t* K = (const GAS bf16_t*)(wsu + WS_K);
    const GAS bf16_t* VT = (const GAS bf16_t*)(wsu + WS_V);
    GAS bf16_t* Y = (GAS bf16_t*)(wsu + WS_YMIX);
    const float gq = wave_max(fabsf(p.hy_q_norm[j * 64 + lane])), gk = wave_max(fabsf(p.hy_k_norm[j * 64 + lane]));
    const float LOG2E = 1.4426950408889634f;
    const float c1 = 0.125f * LOG2E, c2 = 8.f * gq * gk * LOG2E;
    const unsigned lt = (1u << c) - 1u;
    __builtin_amdgcn_s_setprio(2);
    for (int it = bid, rnd = 0; it < 1024; it += nb, ++rnd) {
        int item = (rnd & 1) ? (rnd + 1) * nb - 1 - bid : it;
        if (item >= 1024) continue;
        int qt = 127 - (item >> 3), b = item & 7;
        if (aff_ok(nb, 128)) {
            const int nr = nb >> 3, r = aff_r(bid), l = (rnd & 1) ? (rnd + 1) * nr - 1 - r : r + rnd * nr;
            qt = 127 - l; b = aff_x(bid);
        }
        const int pos0 = qt * 16 + 4 * wid;
        const size_t tb = (size_t)b * S, t0 = tb + pos0;
        const int tmax = (pos0 + 3) >> 5;
        if (pos0 >= 256) {
            bf16x8 iqf[4];
            {
                const int i = (c & 3) + 4 * (c >> 3), rh = (c >> 2) & 1, qq = 2 * rh + (i >> 3), hd = i & 7;
                const GAS bf16_t* ip = IQ + (t0 + qq) * 512 + hd * 64 + 8 * hh;
#pragma unroll
                for (int ks = 0; ks < 4; ++ks) iqf[ks] = *(const GAS bf16x8*)(ip + 16 * ks);
            }
            LAS float* wl = (LAS float*)(smem + 4096) + wid * 32 + hh * 16;
            { const int c_ = opq(c); if (c_ < 4) { const f32x4 wv = *(const GAS f32x4*)(IW + t0 * 8 + 16 * hh + 4 * c_);
                  LAS float* wd = wl + 8 * (c_ & 1) + (c_ >> 1);
                  wd[0] = wv[0]; wd[2] = wv[1]; wd[4] = wv[2]; wd[6] = wv[3]; } }
            unsigned sk[64][2];
            const GAS bf16_t* kpi = IK + ((tb >> 5) * 256 + hh * 32 + c) * 8;
            const int lim0 = pos0 + 2 * hh - c;
#pragma unroll
            for (int tile = 0; tile < 64; ++tile) {
                unsigned k0 = 0u, k1 = 0u;
                if (tile <= tmax) {
                    bf16x8 bk[4];
#pragma unroll
                    for (int ks = 0; ks < 4; ++ks) bk[ks] = *(const GAS bf16x8*)(kpi + 512 * ks);
                    kpi += 32 * 64;
                    asm volatile("" : "+v"(kpi));
                    f32x16 acc;
#pragma unroll
                    for (int r = 0; r < 16; ++r) acc[r] = 0.f;
#pragma unroll
                    for (int ks = 0; ks < 4; ++ks) acc = __builtin_amdgcn_mfma_f32_32x32x16_bf16(iqf[ks], bk[ks], acc, 0, 0, 0);
                    f32x2 s01 = {0.f, 0.f};
#pragma unroll
                    for (int i2 = 0; i2 < 4; ++i2) {
                        const f32x4 wp = *(const LAS f32x4*)(wl + 4 * i2);
                        s01 += (f32x2){relu_bits(acc[2 * i2]), relu_bits(acc[8 + 2 * i2])} * (f32x2){wp[0], wp[1]};
                        s01 += (f32x2){relu_bits(acc[2 * i2 + 1]), relu_bits(acc[8 + 2 * i2 + 1])} * (f32x2){wp[2], wp[3]};
                    }
                    k0 = sortable(s01[0]); k1 = sortable(s01[1]);
                    if (tile + 2 > tmax) {
                        k0 = tile * 32 <= lim0 ? k0 : 0u;
                        k1 = tile * 32 <= lim0 + 1 ? k1 : 0u;
                    }
                }
                sk[tile][0] = k0; sk[tile][1] = k1;
            }
            unsigned v0 = 0u, v1 = 0u; bool d0 = false, d1 = false;
            const int tg = tmax >> 3;
            for (int bit = 31; bit >= 0; --bit) {
                const unsigned c0 = v0 | (1u << bit), c1b = v1 | (1u << bit);
                int n0 = 0, n1 = 0;
#pragma unroll
                for (int g = 0; g < 8; ++g) {
                    if (g <= tg) {
#pragma unroll
                        for (int u = 0; u < 8; u += 4) { cnt4(n0, sk[g * 8 + u][0], sk[g * 8 + u + 1][0], sk[g * 8 + u + 2][0], sk[g * 8 + u + 3][0], c0); cnt4(n1, sk[g * 8 + u][1], sk[g * 8 + u + 1][1], sk[g * 8 + u + 2][1], sk[g * 8 + u + 3][1], c1b); }
                    }
                }
                const int n01 = half_sum_i(n0 | (n1 << 16));
                n0 = n01 & 0xffff; n1 = n01 >> 16;
                if (!d0 && n0 >= 256) { v0 = c0; d0 = n0 == 256; }
                if (!d1 && n1 >= 256) { v1 = c1b; d1 = n1 == 256; }
                if (__all(d0 && d1)) break;
            }
            int g0 = 0, g1 = 0;
#pragma unroll
            for (int g = 0; g < 8; ++g) {
                if (g <= tg) {
#pragma unroll
                    for (int u = 0; u < 8; ++u) { g0 += sk[g * 8 + u][0] > v0 ? 1 : 0; g1 += sk[g * 8 + u][1] > v1 ? 1 : 0; }
                }
            }
            const int g01 = half_sum_i(g0 | (g1 << 16));
            const int need0 = 256 - (g01 & 0xffff), need1 = 256 - (g01 >> 16);
            int run0 = 0, run1 = 0;
#pragma unroll
            for (int tile = 0; tile < 64; ++tile) {
                if (tile <= tmax) {
                    const unsigned k0 = sk[tile][0], k1 = sk[tile][1];
                    const bool tie0 = k0 == v0, tie1 = k1 == v1;
                    const unsigned long long tb0 = __ballot(tie0), tb1 = __ballot(tie1);
                    const unsigned th0 = hh ? (unsigned)(tb0 >> 32) : (unsigned)tb0, th1 = hh ? (unsigned)(tb1 >> 32) : (unsigned)tb1;
                    const bool sel0 = k0 > v0 || (tie0 && run0 + __popc(th0 & lt) < need0);
                    const bool sel1 = k1 > v1 || (tie1 && run1 + __popc(th1 & lt) < need1);
                    run0 += __popc(th0); run1 += __popc(th1);
                    const unsigned long long sb0 = __ballot(sel0), sb1 = __ballot(sel1);
                    if (lane == 0) { u32x4 o = {(unsigned)sb0, (unsigned)sb1, (unsigned)(sb0 >> 32), (unsigned)(sb1 >> 32)}; *(LAS u32x4*)(mw + tile * 4) = o; }
                }
            }
        } else {
            const int tile = lane >> 2, qq = lane & 3, pq = pos0 + qq;
            if (tile <= tmax) {
                unsigned m;
                if (32 * tile + 31 <= pq) m = 0xffffffffu; else if (32 * tile > pq) m = 0u; else m = (2u << (pq - 32 * tile)) - 1u;
                mw[tile * 4 + qq] = m;
            }
        }
        bf16x8 qf[4];
        {
            const GAS bf16_t* qp = Q + (t0 + (c >> 3)) * 512 + (c & 7) * 64 + 8 * hh;
#pragma unroll
            for (int ks = 0; ks < 4; ++ks) qf[ks] = *(const GAS bf16x8*)(qp + 16 * ks);
        }
        f32x16 o0, o1, o2;
#pragma unroll
        for (int r = 0; r < 16; ++r) { o0[r] = 0.f; o1[r] = 0.f; o2[r] = 0.f; }
        const unsigned nc2b = __float_as_uint(-c2), nbigb = __float_as_uint(-16384.f);
        const u32x4 ones4 = {0x3F803F80u, 0x3F803F80u, 0x3F803F80u, 0x3F803F80u};
        const bf16x8 onesf = __builtin_bit_cast(bf16x8, ones4);
        const GAS bf16_t* kp = K + ((tb >> 5) * 256 + hh * 32 + c) * 8;
        const GAS bf16_t* vp = VT + ((tb >> 5) * 256 + hh * 32 + c) * 8;
        bf16x8 kfa[4], vfa[4], kfb[4], vfb[4];
#define DSA_LD(kf_, vf_) do { _Pragma("unroll") for (int ks = 0; ks < 4; ++ks) { kf_[ks] = *(const GAS bf16x8*)(kp + 512 * ks); vf_[ks] = *(const GAS bf16x8*)(vp + 512 * ks); } kp += 2048; vp += 2048; } while (0)
#define DSA_TILE(tile_, kc, vc) do { \
            const unsigned mword = mw[(tile_) * 4 + (c >> 3)]; \
            f32x16 x; \
            _Pragma("unroll") for (int r = 0; r < 16; ++r) x[r] = 0.f; \
            _Pragma("unroll") for (int ks = 0; ks < 4; ++ks) x = __builtin_amdgcn_mfma_f32_32x32x16_bf16(kc[ks], qf[ks], x, 0, 0, 0); \
            _Pragma("unroll") for (int s = 0; s < 2; ++s) { \
                const unsigned bits = mword >> (16 * s + 8 * hh); \
                float pr[8]; \
                _Pragma("unroll") for (int jx = 0; jx < 8; ++jx) { \
                    const unsigned sel = (unsigned)__builtin_amdgcn_sbfe((int)bits, jx, 1);                                    \
                    const float bias = __uint_as_float((sel & nc2b) | (~sel & nbigb));                                        \
                    pr[jx] = __builtin_amdgcn_exp2f(__builtin_fmaf(x[8 * s + jx], c1, bias)); \
                } \
                u32x4 pk = {pk2(pr[0], pr[1]), pk2(pr[2], pr[3]), pk2(pr[4], pr[5]), pk2(pr[6], pr[7])}; \
                const bf16x8 pf = __builtin_bit_cast(bf16x8, pk); \
                o0 = __builtin_amdgcn_mfma_f32_32x32x16_bf16(vc[2 * s], pf, o0, 0, 0, 0); \
                o1 = __builtin_amdgcn_mfma_f32_32x32x16_bf16(vc[2 * s + 1], pf, o1, 0, 0, 0); \
                o2 = __builtin_amdgcn_mfma_f32_32x32x16_bf16(onesf, pf, o2, 0, 0, 0);            \
            } } while (0)
        DSA_LD(kfa, vfa);
#pragma unroll 1
        for (int tile = 0; tile <= tmax; tile += 2) {
            if (tile < tmax) DSA_LD(kfb, vfb);
            DSA_TILE(tile, kfa, vfa);
            if (tile < tmax) {
                if (tile + 1 < tmax) DSA_LD(kfa, vfa);
                DSA_TILE(tile + 1, kfb, vfb);
            }
        }
#undef DSA_LD
#undef DSA_TILE
        const float inv = 1.f / o2[0];
        GAS bf16_t* yp = Y + (t0 + (c >> 3)) * 1024 + (c & 7) * 64 + 4 * hh;
#pragma unroll
        for (int g4 = 0; g4 < 4; ++g4) {
            u32x2 a = {pk2(o0[4 * g4] * inv, o0[4 * g4 + 1] * inv), pk2(o0[4 * g4 + 2] * inv, o0[4 * g4 + 3] * inv)};
            u32x2 bq = {pk2(o1[4 * g4] * inv, o1[4 * g4 + 1] * inv), pk2(o1[4 * g4 + 2] * inv, o1[4 * g4 + 3] * inv)};
            *(GAS u32x2*)(yp + 8 * g4) = a;
            *(GAS u32x2*)(yp + 32 + 8 * g4) = bq;
        }
    }
    __builtin_amdgcn_s_setprio(0);
    if (cv1 == cv0 + 2 && !(bid & 1)) convert_moe_waves(p, cv0, cv0 + 1, (bid >> 1) * 4 + (tid >> 6), (nb >> 1) * 4, tid & 63, cv0);
}

DI void phase_conv(const Params& p, int j, int bid, int nb, int tid) {
    const GAS bf16_t* Z = (const GAS bf16_t*)(p.ws + WS_Z);
    const GAS bf16_t* BG = (const GAS bf16_t*)(p.ws + WS_BG);
    GAS bf16_t* Y = (GAS bf16_t*)(p.ws + WS_YMIX);
    const int wid = tid >> 6, c0 = (tid & 63) * 8;
    const GAS float* cw = (const GAS float*)p.hy_conv_w + (size_t)j * 3 * 512 + c0;
    f32x4 cwv[3][2];
#pragma unroll
    for (int jj = 0; jj < 3; ++jj) { cwv[jj][0] = *(const GAS f32x4*)(cw + jj * 512); cwv[jj][1] = *(const GAS f32x4*)(cw + jj * 512 + 4); }
    for (int item = bid; item < T / 4; item += 2 * nb) {
        u32x4 z[2][3], g[2]; bool ok[2];
#pragma unroll
        for (int x = 0; x < 2; ++x) {
            const int it = item + x * nb; ok[x] = it < T / 4;
            const int t = amap(ok[x] ? it : item, bid, nb, 512) * 4 + wid, pos = t & (S - 1);
#pragma unroll
            for (int jj = 0; jj < 3; ++jj) { const int dp = jj - 2; z[x][jj] = (u32x4){0u, 0u, 0u, 0u}; if (pos + dp >= 0) z[x][jj] = *(const GAS u32x4*)(Z + (size_t)(t + dp) * 512 + c0); }
            g[x] = *(const GAS u32x4*)(BG + (size_t)t * 512 + c0);
        }
#pragma unroll
        for (int x = 0; x < 2; ++x) {
            if (!ok[x]) continue;
            const int t = amap(item + x * nb, bid, nb, 512) * 4 + wid;
            float acc[8];
#pragma unroll
            for (int e = 0; e < 8; ++e) acc[e] = 0.f;
#pragma unroll
            for (int jj = 0; jj < 3; ++jj)
#pragma unroll
                for (int e = 0; e < 4; ++e) { acc[2 * e] += cwv[jj][e >> 1][2 * (e & 1)] * bflo(z[x][jj][e]); acc[2 * e + 1] += cwv[jj][e >> 1][2 * (e & 1) + 1] * bfhi(z[x][jj][e]); }
            u32x4 o;
#pragma unroll
            for (int e = 0; e < 4; ++e) o[e] = pk2(acc[2 * e] * bflo(g[x][e]), acc[2 * e + 1] * bfhi(g[x][e]));
            *(GAS u32x4*)(Y + (size_t)t * 1024 + 512 + c0) = o;
        }
    }
}

DI float wave_incl_sum(float x, int lane) { for (int d = 1; d < 64; d <<= 1) { const float t = lane_get_f(x, lane >= d ? lane - d : lane); if (lane >= d) x += t; } return x; }
DI float wave_incl_max(float x, int lane) { for (int d = 1; d < 64; d <<= 1) { const float t = lane_get_f(x, lane >= d ? lane - d : lane); if (lane >= d) x = fmaxf(x, t); } return x; }
DI bf16x8 scale_frag(bf16x8 f, const float* w8) {
    const u32x4 u = __builtin_bit_cast(u32x4, f);
    u32x4 o;
#pragma unroll
    for (int e = 0; e < 4; ++e) o[e] = pk2(bflo(u[e]) * w8[2 * e], bfhi(u[e]) * w8[2 * e + 1]);
    return __builtin_bit_cast(bf16x8, o);
}

DI void phase_ml_gates(const Params& p, int j, int bid, int nb, int tid) {
    const int lane = tid & 63, wid = tid >> 6, fr = lane & 15, fq = lane >> 4;
    typedef float f32x4_ __attribute__((ext_vector_type(4)));
    if (wid >= 2) return;
    const GAS bf16_t* H = (const GAS bf16_t*)(p.ws + WS_H);
    const GAS bf16_t* WG = (const GAS bf16_t*)(p.ws + WS_WML) + (size_t)(j * 25 + 24) * 128 * 1024;
    for (int tile0 = bid * 2 + wid; tile0 < T / 16; tile0 += nb * 2) {
        const int tile = aff_ok(nb, 64) ? aff_x(bid) * 128 + (aff_r(bid) + aff_div(tile0, nb * 2) * (nb >> 3)) * 2 + wid : tile0;
        const GAS bf16_t* ap = H + (size_t)(tile * 16 + fr) * 1024 + 8 * fq;
        const GAS bf16_t* bp = WG + (size_t)(fr < 8 ? fr : 24 + fr) * 1024 + 8 * fq;
        f32x4_ a0 = {0.f, 0.f, 0.f, 0.f}, a1 = {0.f, 0.f, 0.f, 0.f};
#pragma unroll 4
        for (int kk = 0; kk < 32; kk += 2) {
            const bf16x8 x0 = *(const GAS bf16x8*)(ap + 32 * kk), w0 = *(const GAS bf16x8*)(bp + 32 * kk);
            const bf16x8 x1 = *(const GAS bf16x8*)(ap + 32 * kk + 32), w1 = *(const GAS bf16x8*)(bp + 32 * kk + 32);
            a0 = __builtin_amdgcn_mfma_f32_16x16x32_bf16(w0, x0, a0, 0, 0, 0);
            a1 = __builtin_amdgcn_mfma_f32_16x16x32_bf16(w1, x1, a1, 0, 0, 0);
        }
        const f32x4_ bias = *(const f32x4_*)(p.ml_b_gates + j * 16 + 4 * fq);
        f32x4_ g = a0 + a1 + bias;
        const size_t t = (size_t)tile * 16 + fr;
        if (fq < 2) *(GAS f32x4_*)((GAS float*)(p.ws + WS_MIG) + t * 8 + 4 * fq) = g;
        else {
#pragma unroll
            for (int e = 0; e < 4; ++e) g[e] = fminf(g[e], 0.f) - log1pf(__expf(-fabsf(g[e])));
            *(GAS f32x4_*)((GAS float*)(p.ws + WS_MFG) + t * 8 + 4 * (fq - 2)) = g;
        }
    }
}

DI void phase_ml12(const Params& p, unsigned char* smem, int bid, int nb, int tid) {
    const int lane = tid & 63, wid = tid >> 6, fr = lane & 15, fq = lane >> 4;
    typedef float f32x4_ __attribute__((ext_vector_type(4)));
    LAS float* wl = (LAS float*)smem;
    LAS float* bg = wl + 2048;
    const GAS bf16_t* KT = (const GAS bf16_t*)(p.ws + WS_MKT);
    const GAS bf16_t* VT = (const GAS bf16_t*)(p.ws + WS_MV);
    const GAS float* MIG = (const GAS float*)(p.ws + WS_MIG);
    const GAS float* MFG = (const GAS float*)(p.ws + WS_MFG);
    GAS bf16_t* CB = (GAS bf16_t*)(p.ws + WS_CBUF);
    GAS float* NBF = (GAS float*)(p.ws + WS_NBUF);
    GAS float* MST = (GAS float*)(p.ws + WS_MST);
    for (int wi = bid; wi < 512; wi += nb) {
        const int wl_ = aff_ok(nb, 64) ? aff_r(bid) + aff_div(wi, nb) * (nb >> 3) : (wi & 63), wx_ = aff_ok(nb, 64) ? aff_x(bid) : (wi >> 6);
        const int dh = wl_ & 1, vb = (wl_ >> 1) & 3, bh = wx_ * 8 + (wl_ >> 3), b = bh >> 3, h = bh & 7;
        const int dsub = wid & 1, vsub = wid >> 1;
        const bool carry_n = vb == 0 && vsub == 0;
        __syncthreads();
        {
            const GAS float* gf = MFG + ((size_t)b * S + wid * 64 + lane) * 8 + h;
            const GAS float* gi = MIG + ((size_t)b * S + wid * 64 + lane) * 8 + h;
            float lfv[8], igv[8];
#pragma unroll
            for (int i = 0; i < 8; ++i) { lfv[i] = gf[(size_t)i * 2048]; igv[i] = gi[(size_t)i * 2048]; }
#pragma unroll
            for (int i = 0; i < 8; ++i) {
                const int ch = wid + 4 * i;
                const float bc = wave_incl_sum(lfv[i], lane);
                const float blast = lane_get_f(bc, 63);
                const float g = blast - bc + igv[i];
                const float gmax = wave_max(g);
                wl[ch * 64 + lane] = __expf(g - gmax);
                if (lane == 0) { bg[2 * ch] = blast; bg[2 * ch + 1] = gmax; }
            }
        }
        __syncthreads();
        const GAS bf16_t* kp = KT + ((size_t)(bh * 32) * 512 + dh * 256 + (fq >> 1) * 64 + (fq & 1) * 32 + 16 * dsub + fr) * 8;
        const GAS bf16_t* vp = VT + ((size_t)(bh * 32) * 1024 + vb * 256 + (fq >> 1) * 64 + (fq & 1) * 32 + 16 * vsub + fr) * 8;
        float m = 0.f;
        f32x4_ Cst = {0.f, 0.f, 0.f, 0.f}, nst = {0.f, 0.f, 0.f, 0.f};
        bf16x8 kb[4][2], vbuf[4][2];
#define ML12_LD(bi, chx) do { _Pragma("unroll") for (int kk = 0; kk < 2; ++kk) { kb[bi][kk] = *(const GAS bf16x8*)(kp + (size_t)(chx) * 4096 + kk * 1024); vbuf[bi][kk] = *(const GAS bf16x8*)(vp + (size_t)(chx) * 8192 + kk * 1024); } } while (0)
        ML12_LD(0, 0); ML12_LD(1, 1); ML12_LD(2, 2); ML12_LD(3, 3);
        for (int ch2 = 0; ch2 < 32; ch2 += 4) {
#pragma unroll
            for (int bi = 0; bi < 4; ++bi) {
                const int ch = ch2 + bi, item = bh * 32 + ch;
                const float blast = bg[2 * ch], gmax = bg[2 * ch + 1];
                const float mn = fmaxf(blast + m, gmax);
                const float dec = __expf(blast + m - mn), scl = __expf(gmax - mn);
                f32x4_ u = {0.f, 0.f, 0.f, 0.f}, un = {0.f, 0.f, 0.f, 0.f};
                const LAS float* wsl = wl + ch * 64 + 8 * fq;
#pragma unroll
                for (int kk = 0; kk < 2; ++kk) {
                    float w8[8];
                    const f32x4 wa = *(const LAS f32x4*)(wsl + 32 * kk), wb = *(const LAS f32x4*)(wsl + 32 * kk + 4);
                    w8[0] = wa[0]; w8[1] = wa[1]; w8[2] = wa[2]; w8[3] = wa[3]; w8[4] = wb[0]; w8[5] = wb[1]; w8[6] = wb[2]; w8[7] = wb[3];
                    const bf16x8 ks_ = scale_frag(kb[bi][kk], w8);
                    u = __builtin_amdgcn_mfma_f32_16x16x32_bf16(ks_, vbuf[bi][kk], u, 0, 0, 0);
                    if (carry_n) { const u32x4 ones4 = {0x3F803F80u, 0x3F803F80u, 0x3F803F80u, 0x3F803F80u}; un = __builtin_amdgcn_mfma_f32_16x16x32_bf16(ks_, __builtin_bit_cast(bf16x8, ones4), un, 0, 0, 0); }
                }
                if (ch2 + 4 < 32) ML12_LD(bi, ch + 4);
                Cst = Cst * dec + u * scl;
                u32x2 o = {pk2(Cst[0], Cst[1]), pk2(Cst[2], Cst[3])};
                *(GAS u32x2*)(CB + ((size_t)item * 1024 + ((vb * 4 + 2 * dh + dsub) * 2 + (fq >> 1)) * 32 + 16 * vsub + fr) * 8 + 4 * (fq & 1)) = o;
                if (carry_n) {
                    nst = nst * dec + un * scl;
                    if (fr == 0) *(GAS f32x4_*)(NBF + (size_t)item * 64 + 32 * dh + 16 * dsub + 4 * fq) = nst;
                    if (dh == 0 && wid == 0 && lane == 0) MST[item] = m;
                }
                m = mn;
            }
        }
#undef ML12_LD
    }
}

DI void phase_ml3(const Params& p, int j, unsigned char* smem, int bid, int nb, int tid) {
    const int lane = tid & 63, wid = tid >> 6, c = lane & 31, hh = lane >> 5;
    LAS float* al = (LAS float*)(smem + wid * 16384);
    LAS unsigned char* stg = (LAS unsigned char*)(smem + wid * 16384 + 512);
    const GAS bf16_t* MQ = (const GAS bf16_t*)(p.ws + WS_MQ);
    const GAS bf16_t* MK = (const GAS bf16_t*)(p.ws + WS_MK);
    const GAS bf16_t* VT = (const GAS bf16_t*)(p.ws + WS_MV);
    const GAS float* MIG = (const GAS float*)(p.ws + WS_MIG);
    const GAS float* MFG = (const GAS float*)(p.ws + WS_MFG);
    const GAS bf16_t* MOG = (const GAS bf16_t*)(p.ws + WS_MOG);
    const GAS bf16_t* CB = (const GAS bf16_t*)(p.ws + WS_CBUF);
    const GAS float* NBF = (const GAS float*)(p.ws + WS_NBUF);
    const GAS float* MST = (const GAS float*)(p.ws + WS_MST);
    GAS bf16_t* Y = (GAS bf16_t*)(p.ws + WS_YMIX);
    for (int item0 = bid * 4 + wid; item0 < 2048; item0 += nb * 4) {
        const int item = aff_ok(nb, 64) ? aff_x(bid) * 256 + (aff_r(bid) + aff_div(item0, nb * 4) * (nb >> 3)) * 4 + wid : item0;
        const int bh = item >> 5, ch = item & 31, b = bh >> 3, h = bh & 7;
        const size_t tb = (size_t)b * S + ch * 64;
        const float lf = MFG[(tb + lane) * 8 + h], ig = MIG[(tb + lane) * 8 + h];
        const float mprev = MST[item];
        float gm8[8];
        { const GAS float* gp = (const GAS float*)p.ml_out_norm + j * 1024 + h * 128 + (lane & 15) * 8; const f32x4 ga = *(const GAS f32x4*)gp, gb = *(const GAS f32x4*)(gp + 4);
          gm8[0] = ga[0]; gm8[1] = ga[1]; gm8[2] = ga[2]; gm8[3] = ga[3]; gm8[4] = gb[0]; gm8[5] = gb[1]; gm8[6] = gb[2]; gm8[7] = gb[3]; }
        bf16x8 kf[2][4];
        const GAS bf16_t* kp = MK + ((size_t)item * 512 + lane) * 8;
#pragma unroll
        for (int st = 0; st < 2; ++st)
#pragma unroll
            for (int ks = 0; ks < 4; ++ks) kf[st][ks] = *(const GAS bf16x8*)(kp + (st * 4 + ks) * 512);
        const float bc = wave_incl_sum(lf, lane);
        const float av = ig - bc;
        const float Mv = fmaxf(mprev, wave_incl_max(av, lane));
        al[lane] = av;
        const GAS bf16_t* vp = VT + ((size_t)item * 1024 + lane) * 8;
        const GAS bf16_t* cp = CB + ((size_t)(item - 1) * 1024 + lane) * 8;
        const GAS float* np = NBF + (size_t)(item - 1) * 64 + 8 * hh;
#pragma unroll
        for (int tt = 0; tt < 2; ++tt) {
            const float Mt = lane_get_f(Mv, 32 * tt + c), wint = __expf(mprev - Mt), emt = __expf(-(lane_get_f(bc, 32 * tt + c) + Mt));
            bf16x8 qf[4];
#pragma unroll
            for (int ks = 0; ks < 4; ++ks) qf[ks] = *(const GAS bf16x8*)(MQ + ((size_t)item * 512 + (tt * 4 + ks) * 64 + lane) * 8);
            bf16x8 pf[2][2]; float csum = 0.f;
#pragma unroll
            for (int st = 0; st <= tt; ++st) {
                f32x16 x;
#pragma unroll
                for (int r = 0; r < 16; ++r) x[r] = 0.f;
#pragma unroll
                for (int ks = 0; ks < 4; ++ks) x = __builtin_amdgcn_mfma_f32_32x32x16_bf16(kf[st][ks], qf[ks], x, 0, 0, 0);
#pragma unroll
                for (int k2 = 0; k2 < 2; ++k2) {
                    const int s0 = 32 * st + 16 * k2 + 8 * hh;
                    const f32x4 a0 = *(const LAS f32x4*)(al + s0), a1 = *(const LAS f32x4*)(al + s0 + 4);
                    const float a8[8] = {a0[0], a0[1], a0[2], a0[3], a1[0], a1[1], a1[2], a1[3]};
                    float pr[8];
#pragma unroll
                    for (int jx = 0; jx < 8; ++jx) {
                        const float e = __expf(a8[jx] - Mt) * x[8 * k2 + jx];
                        pr[jx] = (st < tt || s0 + jx <= 32 * tt + c) ? e : 0.f;
                        csum += pr[jx];
                    }
                    u32x4 pk = {pk2(pr[0], pr[1]), pk2(pr[2], pr[3]), pk2(pr[4], pr[5]), pk2(pr[6], pr[7])};
                    pf[st][k2] = __builtin_bit_cast(bf16x8, pk);
                }
            }
            float nq = 0.f;
            if (ch > 0) {
#pragma unroll
                for (int ks = 0; ks < 4; ++ks) {
                    const f32x4 n0 = *(const GAS f32x4*)(np + 16 * ks), n1 = *(const GAS f32x4*)(np + 16 * ks + 4);
                    const u32x4 uq = __builtin_bit_cast(u32x4, qf[ks]);
                    nq += n0[0] * bflo(uq[0]) + n0[1] * bfhi(uq[0]) + n0[2] * bflo(uq[1]) + n0[3] * bfhi(uq[1]) + n1[0] * bflo(uq[2]) + n1[1] * bfhi(uq[2]) + n1[2] * bflo(uq[3]) + n1[3] * bfhi(uq[3]);
                }
                nq += sx_f<32>(nq);
            }
            csum += sx_f<32>(csum);
            const float den = wint * nq + csum;
            const float rd = 1.f / fmaxf(fabsf(den), emt);
            f32x16 o[4]; float s2 = 0.f;
#pragma unroll
            for (int vb = 0; vb < 4; ++vb) {
#pragma unroll
                for (int r = 0; r < 16; ++r) o[vb][r] = 0.f;
                if (ch > 0) {
#pragma unroll
                    for (int ks = 0; ks < 4; ++ks) o[vb] = __builtin_amdgcn_mfma_f32_32x32x16_bf16(*(const GAS bf16x8*)(cp + (vb * 4 + ks) * 512), qf[ks], o[vb], 0, 0, 0);
#pragma unroll
                    for (int r = 0; r < 16; ++r) o[vb][r] *= wint;
                }
#pragma unroll
                for (int st = 0; st <= tt; ++st)
#pragma unroll
                    for (int k2 = 0; k2 < 2; ++k2) o[vb] = __builtin_amdgcn_mfma_f32_32x32x16_bf16(*(const GAS bf16x8*)(vp + (vb * 4 + 2 * st + k2) * 512), pf[st][k2], o[vb], 0, 0, 0);
#pragma unroll
                for (int r = 0; r < 16; ++r) { o[vb][r] *= rd; s2 += o[vb][r] * o[vb][r]; }
            }
            s2 += sx_f<32>(s2);
            const float rstd = rsqrtf(s2 * (1.f / 128.f) + EPS);
#pragma unroll
            for (int vb = 0; vb < 4; ++vb)
#pragma unroll
                for (int g4 = 0; g4 < 4; ++g4) {
                    u32x2 sv = {pk2(o[vb][4 * g4] * rstd, o[vb][4 * g4 + 1] * rstd), pk2(o[vb][4 * g4 + 2] * rstd, o[vb][4 * g4 + 3] * rstd)};
                    *(LAS u32x2*)(stg + c * 272 + (32 * vb + 8 * g4 + 4 * hh) * 2) = sv;
                }
            const int orow = lane >> 4, ocol = (lane & 15) * 8;
            const GAS bf16_t* ogp = MOG + (tb + 32 * tt + orow) * 1024 + h * 128 + ocol;
            GAS bf16_t* yp = Y + (tb + 32 * tt + orow) * 1024 + h * 128 + ocol;
#pragma unroll
            for (int i = 0; i < 8; ++i) {
                const u32x4 sv = *(const LAS u32x4*)(stg + (4 * i + orow) * 272 + ocol * 2);
                const u32x4 og = __builtin_nontemporal_load((const GAS u32x4*)(ogp + (size_t)i * 4096));
                u32x4 ov;
#pragma unroll
                for (int e = 0; e < 4; ++e) ov[e] = pk2(bflo(sv[e]) * gm8[2 * e] * bflo(og[e]), bfhi(sv[e]) * gm8[2 * e + 1] * bfhi(og[e]));
                *(GAS u32x4*)(yp + (size_t)i * 4096) = ov;
            }
        }
    }
}


namespace pg8 {
#define PG8_LAS __attribute__((address_space(3)))
typedef unsigned short bf16_t;
typedef short bf16x8 __attribute__((ext_vector_type(8)));
typedef float f32x4 __attribute__((ext_vector_type(4)));
typedef unsigned u32x4 __attribute__((ext_vector_type(4)));
constexpr int BM = 256, BK = 64, HALF = 128, HTB = HALF * BK * 2  , STAGE_BYTES = 8 * HTB, NXCD = 8, WGM = 8;

__host__ __device__ __forceinline__ int lds_byte(int r, int c) { const int st = (r >> 4) * 2 + (c >> 5), rr = r & 15, cc = c & 31, ob = rr * 64 + cc * 2; return st * 1024 + (ob ^ (((ob >> 9) & 1) << 5)); }
__host__ __device__ __forceinline__ void stage_rc(int b, int& R, int& C) { const int st = b / 1024, sb = b % 1024, swz = sb ^ (((sb >> 9) & 1) << 5); R = (st >> 1) * 16 + swz / 64; C = (st & 1) * 32 + (swz % 64) / 2; }
__host__ __device__ __forceinline__ int perm32(int rho) { const int n = rho >> 4, i = rho & 15; return 8 * (i >> 2) + 4 * n + (i & 3); }

struct Unit { int pm, pn; };
struct Gemm { const bf16_t* A; const bf16_t* Bt; int M, N, K; };

struct StaticOrder {
    int nM, nN, nwg, G, c;
    __host__ __device__ void init(int M, int N, int G_, int c_) { nM = M / BM; nN = N / BM; nwg = nM * nN; G = G_; c = c_; }
    __host__ __device__ bool next(int i, Unit& u) const {
        const long L = (long)i * G + c; if (L >= nwg) return false;
        int wgid = (int)L; { const int q = nwg / NXCD, r = nwg % NXCD, xcd = wgid % NXCD, off = wgid / NXCD; wgid = (xcd < r ? xcd * (q + 1) : r * (q + 1) + (xcd - r) * q) + off; }
        const int nig = WGM * nN, gid = wgid / nig, fm = gid * WGM, gsz = (nM - fm) < WGM ? (nM - fm) : WGM;
        u.pm = fm + ((wgid % nig) % gsz); u.pn = (wgid % nig) / gsz; return true;
    }
    static constexpr bool GATHER = false;
    __device__ __forceinline__ unsigned a_off(const Unit&, int) const { return 0u; }
    __device__ __forceinline__ int rows(const Unit&) const { return BM; }
    __device__ __forceinline__ void a_ready(const Unit&) const {}
    __device__ __forceinline__ void done(const Unit&) const {}
};


template <class Epi, class Sched, bool ALIGN_EPI = false, bool SP2 = false>
__device__ __forceinline__ void gemm_phase(PG8_LAS unsigned char* lds, const Gemm g, const Sched& S, const Epi& E, int tid512) {
    const int tid = opq(tid512), wid = __builtin_amdgcn_readfirstlane(tid >> 6), lane = tid & 63, wr = wid >> 2, wc = wid & 3, fr = lane & 15, fq = lane >> 4;
    const int K = g.K, nt = K / BK;
    unsigned voffA[2], voffB[2];
    int rowA[2];
#pragma unroll
    for (int i = 0; i < 2; ++i) { int R, C; stage_rc(tid * 16 + i * 8192, R, C); const int Rb = Epi::PERM ? ((R & ~31) + perm32(R & 31)) : R;
        voffA[i] = (unsigned)(R * K + C) * 2u; voffB[i] = (unsigned)(Rb * K + C) * 2u; rowA[i] = R; if (Sched::GATHER) voffA[i] = (unsigned)C * 2u; }
    const size_t kstep = (size_t)(BK * 2);
    const size_t hstep = (size_t)HALF * K * 2;
    const size_t tstep = 2 * hstep;
    const unsigned ldsw = (unsigned)wid * 1024u;
    const int aoff = lds_byte(wr * 64 + fr, fq * 8), boff = lds_byte(wc * 32 + fr, fq * 8);
#define PG8_SA(b, h) (((b) * 2 + (h)) * HTB)
#define PG8_SB(b, h) ((4 + (b) * 2 + (h)) * HTB)
#define PG8_STAGE(bufoff, gbase, voff) do { _Pragma("unroll") for (int _i = 0; _i < 2; ++_i) \
        __builtin_amdgcn_global_load_lds((const unsigned*)((const char*)(gbase) + (voff)[_i]), (PG8_LAS unsigned*)(lds + (bufoff) + ldsw + _i * 8192), 16, 0, 0); } while (0)
#define PG8_LDA(dst, b, h) do { _Pragma("unroll") for (int m = 0; m < 4; ++m) _Pragma("unroll") for (int k = 0; k < 2; ++k) dst[m][k] = *(const PG8_LAS bf16x8*)(lds + PG8_SA(b, h) + aoff + m * 2048 + k * 1024); } while (0)
#define PG8_LDB(dst, b, h) do { _Pragma("unroll") for (int n = 0; n < 2; ++n) _Pragma("unroll") for (int k = 0; k < 2; ++k) dst[n][k] = *(const PG8_LAS bf16x8*)(lds + PG8_SB(b, h) + boff + n * 2048 + k * 1024); } while (0)
#define PG8_MMA(ai, bj, At, Bt) do { __builtin_amdgcn_s_setprio(1); _Pragma("unroll") for (int m = 0; m < 4; ++m) _Pragma("unroll") for (int n = 0; n < 2; ++n) _Pragma("unroll") for (int k = 0; k < 2; ++k) \
        acc[ai][bj][m][n] = __builtin_amdgcn_mfma_f32_16x16x32_bf16(Bt[n][k], At[m][k], acc[ai][bj][m][n], 0, 0, 0); __builtin_amdgcn_s_setprio(0); } while (0)
#define PG8_WAIT_V(n) asm volatile("s_waitcnt vmcnt(" #n ")" ::: "memory")
#define PG8_WAIT_L(n) asm volatile("s_waitcnt lgkmcnt(" #n ")" ::: "memory")
#define PG8_BAR __builtin_amdgcn_s_barrier()
#define PG8_SCHED __builtin_amdgcn_sched_barrier(0)
    unsigned oaC[2][2], oaN[2][2];
#define PG8_GOFF(dst, unit) do { _Pragma("unroll") for (int _h = 0; _h < 2; ++_h) _Pragma("unroll") for (int _i = 0; _i < 2; ++_i) dst[_h][_i] = S.a_off(unit, _h * HALF + rowA[_i]) + voffA[_i]; } while (0)
#define PG8_STAGE_G(bufoff, offs, koff) do { _Pragma("unroll") for (int _i = 0; _i < 2; ++_i) \
        __builtin_amdgcn_global_load_lds((const unsigned*)(((const char*)g.A + (koff)) + (offs)[_i]), (PG8_LAS unsigned*)(lds + (bufoff) + ldsw + _i * 8192), 16, 0, 0); } while (0)
    Unit cur, nxt; int ui = 0;
    if (!S.next(0, cur)) return;
    if constexpr (Sched::GATHER) { PG8_GOFF(oaC, cur); PG8_GOFF(oaN, cur); }
    bool mm0 = true, mm1 = true;
    if constexpr (Sched::GATHER) { const int rws = S.rows(cur); mm0 = 64 * wr < rws; mm1 = 128 + 64 * wr < rws; }
    f32x4 acc[2][2][4][2];
#pragma unroll
    for (int a = 0; a < 2; ++a)
#pragma unroll
        for (int b = 0; b < 2; ++b)
#pragma unroll
            for (int m = 0; m < 4; ++m)
#pragma unroll
                for (int n = 0; n < 2; ++n) acc[a][b][m][n] = (f32x4){0.f, 0.f, 0.f, 0.f};
    bf16x8 At[4][2], B0[2][2], B1[2][2];
    const char* cA = (const char*)g.A + (size_t)cur.pm * tstep; const char* cB = (const char*)g.Bt + (size_t)cur.pn * tstep;
    S.a_ready(cur);
    if constexpr (SP2) {
        PG8_STAGE(PG8_SB(0, 0), cB, voffB); PG8_STAGE(PG8_SB(0, 1), cB + hstep, voffB);
        if constexpr (Sched::GATHER) { PG8_STAGE_G(PG8_SA(0, 0), oaC[0], 0); PG8_STAGE_G(PG8_SA(0, 1), oaC[1], 0); } else { PG8_STAGE(PG8_SA(0, 0), cA, voffA); PG8_STAGE(PG8_SA(0, 1), cA + hstep, voffA); }
        if (wr == 1) PG8_BAR;
        PG8_WAIT_V(2); PG8_BAR;
        PG8_STAGE(PG8_SB(1, 0), cB + kstep, voffB);
        if constexpr (Sched::GATHER) PG8_STAGE_G(PG8_SA(1, 0), oaC[0], kstep); else PG8_STAGE(PG8_SA(1, 0), cA + kstep, voffA);
        PG8_STAGE(PG8_SB(1, 1), cB + hstep + kstep, voffB);
        PG8_WAIT_V(6); PG8_BAR;
    } else {
        PG8_STAGE(PG8_SB(0, 0), cB, voffB); PG8_STAGE(PG8_SA(0, 0), cA, voffA); PG8_STAGE(PG8_SB(0, 1), cB + hstep, voffB); PG8_STAGE(PG8_SA(0, 1), cA + hstep, voffA);
        if (wr == 1) PG8_BAR;
        PG8_WAIT_V(4); PG8_BAR;
        PG8_STAGE(PG8_SB(1, 0), cB + kstep, voffB); PG8_STAGE(PG8_SA(1, 0), cA + kstep, voffA); PG8_STAGE(PG8_SB(1, 1), cB + hstep + kstep, voffB);
        PG8_WAIT_V(6); PG8_BAR;
    }
    for (;;) {
        const bool has_next = S.next(ui + 1, nxt);
        const char* nA = has_next ? (const char*)g.A + (size_t)nxt.pm * tstep : cA; const char* nB = has_next ? (const char*)g.Bt + (size_t)nxt.pn * tstep : cB;
        if constexpr (Sched::GATHER) { if (has_next) PG8_GOFF(oaN, nxt); }
        for (int t = 0; t < nt; t += 2) {
            const bool last = (t == nt - 2);
            const char* a1 = cA + (size_t)(t + 1) * kstep;
            const char* a2 = last ? nA : cA + (size_t)(t + 2) * kstep; const char* b2 = last ? nB : cB + (size_t)(t + 2) * kstep;
            const char* a3 = a2 + kstep; const char* b3 = b2 + kstep;
            if (last && has_next) S.a_ready(nxt);
            unsigned oaS[2][2]; size_t k2 = 0;
            if constexpr (Sched::GATHER) {
                const bool fromN = last && has_next;
#pragma unroll
                for (int _h = 0; _h < 2; ++_h)
#pragma unroll
                    for (int _i = 0; _i < 2; ++_i) oaS[_h][_i] = fromN ? oaN[_h][_i] : oaC[_h][_i];
                k2 = last ? (size_t)0 : (size_t)(t + 2) * kstep;
            }
            if constexpr (SP2) {
            PG8_LDB(B0, 0, 0); PG8_LDB(B1, 0, 1); PG8_SCHED; PG8_LDA(At, 0, 0);
            if constexpr (Sched::GATHER) PG8_STAGE_G(PG8_SA(1, 1), oaC[1], (size_t)(t + 1) * kstep); else PG8_STAGE(PG8_SA(1, 1), a1 + hstep, voffA);
            PG8_WAIT_V(8); PG8_WAIT_L(0); PG8_BAR; if (!Sched::GATHER || mm0) { PG8_MMA(0, 0, At, B0); PG8_MMA(0, 1, At, B1); } PG8_BAR; PG8_SCHED;
            PG8_LDA(At, 0, 1); PG8_STAGE(PG8_SB(0, 0), b2, voffB); PG8_STAGE(PG8_SB(0, 1), b2 + hstep, voffB);
            if constexpr (Sched::GATHER) PG8_STAGE_G(PG8_SA(0, 0), oaS[0], k2); else PG8_STAGE(PG8_SA(0, 0), a2, voffA);
            PG8_WAIT_V(8); PG8_WAIT_L(0); PG8_BAR; if (!Sched::GATHER || mm1) { PG8_MMA(1, 0, At, B0); PG8_MMA(1, 1, At, B1); } PG8_BAR; PG8_SCHED;
            PG8_LDB(B0, 1, 0); PG8_LDB(B1, 1, 1); PG8_SCHED; PG8_LDA(At, 1, 0);
            if constexpr (Sched::GATHER) PG8_STAGE_G(PG8_SA(0, 1), oaS[1], k2); else PG8_STAGE(PG8_SA(0, 1), a2 + hstep, voffA);
            PG8_WAIT_V(8); PG8_WAIT_L(0); PG8_BAR; if (!Sched::GATHER || mm0) { PG8_MMA(0, 0, At, B0); PG8_MMA(0, 1, At, B1); } PG8_BAR; PG8_SCHED;
            PG8_LDA(At, 1, 1); PG8_STAGE(PG8_SB(1, 0), b3, voffB); PG8_STAGE(PG8_SB(1, 1), b3 + hstep, voffB);
            if constexpr (Sched::GATHER) PG8_STAGE_G(PG8_SA(1, 0), oaS[0], k2 + kstep); else PG8_STAGE(PG8_SA(1, 0), a3, voffA);
            PG8_WAIT_V(8); PG8_WAIT_L(0); PG8_BAR; if (!Sched::GATHER || mm1) { PG8_MMA(1, 0, At, B0); PG8_MMA(1, 1, At, B1); } PG8_BAR; PG8_SCHED;
            } else {
            PG8_LDB(B0, 0, 0); PG8_SCHED; PG8_LDA(At, 0, 0); PG8_STAGE(PG8_SA(1, 1), a1 + hstep, voffA);
            PG8_WAIT_L(8); PG8_BAR; PG8_WAIT_L(0); PG8_MMA(0, 0, At, B0); PG8_BAR; PG8_SCHED;
            PG8_LDB(B1, 0, 1); PG8_STAGE(PG8_SB(0, 0), b2, voffB);
            PG8_BAR; PG8_WAIT_L(0); PG8_MMA(0, 1, At, B1); PG8_BAR;
            PG8_LDA(At, 0, 1); PG8_STAGE(PG8_SA(0, 0), a2, voffA);
            PG8_BAR; PG8_WAIT_L(0); PG8_MMA(1, 0, At, B0); PG8_BAR; PG8_SCHED;
            PG8_STAGE(PG8_SB(0, 1), b2 + hstep, voffB);
            PG8_WAIT_V(6); PG8_BAR; PG8_MMA(1, 1, At, B1); PG8_BAR;
            PG8_LDB(B0, 1, 0); PG8_SCHED; PG8_LDA(At, 1, 0); PG8_STAGE(PG8_SA(0, 1), a2 + hstep, voffA);
            PG8_WAIT_L(8); PG8_BAR; PG8_WAIT_L(0); PG8_MMA(0, 0, At, B0); PG8_BAR; PG8_SCHED;
            PG8_LDB(B1, 1, 1); PG8_STAGE(PG8_SB(1, 0), b3, voffB);
            PG8_BAR; PG8_WAIT_L(0); PG8_MMA(0, 1, At, B1); PG8_BAR;
            PG8_LDA(At, 1, 1); PG8_STAGE(PG8_SA(1, 0), a3, voffA);
            PG8_BAR; PG8_WAIT_L(0); PG8_MMA(1, 0, At, B0); PG8_BAR; PG8_SCHED;
            PG8_STAGE(PG8_SB(1, 1), b3 + hstep, voffB);
            PG8_WAIT_V(6); PG8_BAR; PG8_MMA(1, 1, At, B1); PG8_BAR;
            }
        }
        if constexpr (ALIGN_EPI) { if (wr == 0) PG8_BAR; }
        if constexpr (!Epi::AFTER_DRAIN) { E(acc, cur, wr, wc, fr, fq); S.done(cur); }
        if (!has_next) break;
#pragma unroll
        for (int a = 0; a < 2; ++a)
#pragma unroll
            for (int b = 0; b < 2; ++b)
#pragma unroll
                for (int m = 0; m < 4; ++m)
#pragma unroll
                    for (int n = 0; n < 2; ++n) acc[a][b][m][n] = (f32x4){0.f, 0.f, 0.f, 0.f};
        cur = nxt; cA = nA; cB = nB; ++ui;
        if constexpr (Sched::GATHER) { const int rws = S.rows(cur); mm0 = 64 * wr < rws; mm1 = 128 + 64 * wr < rws; }
        if constexpr (Sched::GATHER) {
#pragma unroll
            for (int _h = 0; _h < 2; ++_h)
#pragma unroll
                for (int _i = 0; _i < 2; ++_i) oaC[_h][_i] = oaN[_h][_i];
        }
        if constexpr (ALIGN_EPI) { if (wr == 1) PG8_BAR; }
    }
    PG8_WAIT_V(0);
    if constexpr (!ALIGN_EPI) { if (wr == 0) PG8_BAR; }
    PG8_BAR;
    if constexpr (Epi::AFTER_DRAIN) { E.fused(acc, cur, wr, wc, fr, fq, lds, wid, lane); S.done(cur); }
#undef PG8_GOFF
#undef PG8_STAGE_G
#undef PG8_SA
#undef PG8_SB
#undef PG8_STAGE
#undef PG8_LDA
#undef PG8_LDB
#undef PG8_MMA
#undef PG8_WAIT_V
#undef PG8_WAIT_L
#undef PG8_BAR
#undef PG8_SCHED
}
}

struct OutEpi8 {
    static constexpr bool PERM = false, AFTER_DRAIN = false;
    const float* src; float* dst; const float* gate; float* part;
    __device__ __forceinline__ void operator()(const pg8::f32x4 (&acc)[2][2][4][2], const pg8::Unit& u, int wr, int wc, int fr, int fq) const {
#pragma unroll
        for (int ai = 0; ai < 2; ++ai)
#pragma unroll
            for (int m = 0; m < 4; ++m) {
                const int t = u.pm * 256 + ai * 128 + wr * 64 + m * 16 + fr;
                const float* gp = gate + (t >> 11) * 6144;
                float ss = 0.f;
#pragma unroll
                for (int bj = 0; bj < 2; ++bj)
#pragma unroll
                    for (int n = 0; n < 2; ++n) {
                        const int col = u.pn * 256 + bj * 128 + wc * 32 + n * 16 + fq * 4;
                        const pg8::f32x4 g = *(const pg8::f32x4*)(gp + col);
                        const pg8::f32x4 o = *(const pg8::f32x4*)(src + (size_t)t * 1024 + col) + g * acc[ai][bj][m][n];
                        *(pg8::f32x4*)(dst + (size_t)t * 1024 + col) = o;
                        ss += o[0] * o[0] + o[1] * o[1] + o[2] * o[2] + o[3] * o[3];
                    }
                ss += sx_f<16>(ss); ss += sx_f<32>(ss);
                if (fq == 0) part[(size_t)t * 16 + u.pn * 4 + wc] = ss;
            }
    }
};


DI unsigned cvtpk(float lo, float hi) { return pk2(lo, hi); }
struct HybEpi8 {
    static constexpr bool PERM = true, AFTER_DRAIN = false;
    const Params* p; int j;
    __device__ __forceinline__ void operator()(const pg8::f32x4 (&acc)[2][2][4][2], const pg8::Unit& u, int wr, int wc, int fr, int fq) const {
        unsigned char* ws = p->ws;
        const int un = u.pn;
        if (un < 5 && !(un == 4 && (wc == 1 || wc == 3))) {
            const bool donorm = un < 2 || (un == 4 && wc == 0);
            bf16_t* ob; int ld, cb; const float* gam = p->hy_q_norm + j * 64;
            if (un < 2) { ob = (bf16_t*)(ws + WS_Q); ld = 512; cb = 64 * (4 * un + wc); }
            else if (un < 4) { ob = (bf16_t*)(ws + WS_IQ); ld = 512; cb = 64 * (4 * (un - 2) + wc); }
            else if (wc == 0) { ob = (bf16_t*)(ws + WS_K); ld = 64; cb = 0; gam = p->hy_k_norm + j * 64; }
            else { ob = (bf16_t*)(ws + WS_IK); ld = 64; cb = 0; }
            pg8::f32x4 g0[2], g1[2];
#pragma unroll
            for (int n = 0; n < 2; ++n) { g0[n] = donorm ? *(const pg8::f32x4*)(gam + 8 * fq + 4 * n) : (pg8::f32x4){1.f, 1.f, 1.f, 1.f}; g1[n] = donorm ? *(const pg8::f32x4*)(gam + 32 + 8 * fq + 4 * n) : (pg8::f32x4){1.f, 1.f, 1.f, 1.f}; }
            const float* ropec = (const float*)(ws + WS_ROPEC);
            const float* ropes = (const float*)(ws + WS_ROPES);
            pg8::f32x4 rc[2][2], rs[2][2];
#define HYB_ROPE_LD(buf, st) do { const int t_ = opq(u.pm * 256 + ((st) >> 2) * 128 + wr * 64 + ((st) & 3) * 16 + fr), pos_ = t_ & (S - 1); _Pragma("unroll") for (int n = 0; n < 2; ++n) { \
                rc[buf][n] = *(const pg8::f32x4*)(ropec + pos_ * 32 + 8 * fq + 4 * n); rs[buf][n] = *(const pg8::f32x4*)(ropes + pos_ * 32 + 8 * fq + 4 * n); } } while (0)
            HYB_ROPE_LD(0, 0);
#pragma unroll
            for (int ai = 0; ai < 2; ++ai)
#pragma unroll
                for (int m = 0; m < 4; ++m) {
                    const int st = ai * 4 + m, cb_ = st & 1;
                    if (st < 7) { if (cb_) HYB_ROPE_LD(0, st + 1); else HYB_ROPE_LD(1, st + 1); }
                    const int t = opq(u.pm * 256 + ai * 128 + wr * 64 + m * 16 + fr);
                    float rstd = 1.f;
                    if (donorm) {
                        float ss = 0.f;
#pragma unroll
                        for (int bj = 0; bj < 2; ++bj)
#pragma unroll
                            for (int n = 0; n < 2; ++n) { const pg8::f32x4 x = acc[ai][bj][m][n]; ss += x[0] * x[0] + x[1] * x[1] + x[2] * x[2] + x[3] * x[3]; }
                        ss += sx_f<16>(ss); ss += sx_f<32>(ss);
                        rstd = rsqrtf(ss * (1.f / 64.f) + EPS);
                    }
                    u32x4 o1, o2;
#pragma unroll
                    for (int n = 0; n < 2; ++n) {
                        const pg8::f32x4 cs = rc[cb_][n], sn = rs[cb_][n];
                        const pg8::f32x4 x1 = acc[ai][0][m][n] * rstd * g0[n], x2 = acc[ai][1][m][n] * rstd * g1[n];
                        const pg8::f32x4 y1 = x1 * cs - x2 * sn, y2 = x2 * cs + x1 * sn;
                        o1[2 * n] = cvtpk(y1[0], y1[1]); o1[2 * n + 1] = cvtpk(y1[2], y1[3]);
                        o2[2 * n] = cvtpk(y2[0], y2[1]); o2[2 * n + 1] = cvtpk(y2[2], y2[3]);
                    }
                    if (un == 4) {
                        const int kk = t & 31, cs_ = (wc == 0) ? ((kk & ~12) | ((kk & 4) << 1) | ((kk & 8) >> 1)) : kk;
                        bf16_t* fb = ob + ((size_t)(t >> 5) * 256 + (fq >> 1) * 64 + (fq & 1) * 32 + cs_) * 8;
                        *(u32x4*)fb = o1; *(u32x4*)(fb + 128 * 8) = o2;
                    } else {
                    *(u32x4*)(ob + (size_t)t * ld + cb + 8 * fq) = o1;
                    *(u32x4*)(ob + (size_t)t * ld + cb + 32 + 8 * fq) = o2;
                    }
                }
#undef HYB_ROPE_LD
        } else if (un == 4 && wc == 1) {
            bf16_t* ob = (bf16_t*)(ws + WS_V);
#pragma unroll
            for (int ai = 0; ai < 2; ++ai)
#pragma unroll
                for (int m = 0; m < 4; ++m) {
                    const int t = opq(u.pm * 256 + ai * 128 + wr * 64 + m * 16 + fr), pos = t & (S - 1);
#pragma unroll
                    for (int bj = 0; bj < 2; ++bj)
#pragma unroll
                        for (int n = 0; n < 2; ++n)
#pragma unroll
                            for (int e = 0; e < 4; ++e) ob[((((size_t)(t >> 5) * 4 + bj + ((pos >> 4) & 1) * 2) * 2 + ((pos >> 3) & 1)) * 32 + 8 * fq + 4 * n + e) * 8 + (pos & 7)] = f2bf(acc[ai][bj][m][n][e]);
                }
        } else if (un == 4) {
            float* ob = (float*)(ws + WS_IW);
            if (fq == 0) {
#pragma unroll
                for (int ai = 0; ai < 2; ++ai)
#pragma unroll
                    for (int m = 0; m < 4; ++m) {
                        const int t = u.pm * 256 + ai * 128 + wr * 64 + m * 16 + fr;
                        *(pg8::f32x4*)(ob + (size_t)t * 8) = acc[ai][0][m][0] * (0.125f * 0.35355339059327373f);
                        *(pg8::f32x4*)(ob + (size_t)t * 8 + 4) = acc[ai][0][m][1] * (0.125f * 0.35355339059327373f);
                    }
            }
        } else if (un < 7) {
            bf16_t* ob = (bf16_t*)(ws + WS_BG);
#pragma unroll
            for (int ai = 0; ai < 2; ++ai)
#pragma unroll
                for (int m = 0; m < 4; ++m) {
                    const int t = opq(u.pm * 256 + ai * 128 + wr * 64 + m * 16 + fr);
#pragma unroll
                    for (int bj = 0; bj < 2; ++bj) {
                        const pg8::f32x4 a = acc[ai][bj][m][0], b = acc[ai][bj][m][1];
                        u32x4 o = {cvtpk(a[0], a[1]), cvtpk(a[2], a[3]), cvtpk(b[0], b[1]), cvtpk(b[2], b[3])};
                        *(u32x4*)(ob + (size_t)t * 512 + (un - 5) * 256 + 128 * bj + 32 * wc + 8 * fq) = o;
                    }
                }
        } else {
            bf16_t* ob = (bf16_t*)(ws + WS_Z);
#pragma unroll
            for (int ai = 0; ai < 2; ++ai)
#pragma unroll
                for (int m = 0; m < 4; ++m) {
                    const int t = opq(u.pm * 256 + ai * 128 + wr * 64 + m * 16 + fr);
                    const pg8::f32x4 a = acc[ai][0][m][0] * acc[ai][1][m][0], b = acc[ai][0][m][1] * acc[ai][1][m][1];
                    u32x4 o = {cvtpk(a[0], a[1]), cvtpk(a[2], a[3]), cvtpk(b[0], b[1]), cvtpk(b[2], b[3])};
                    *(u32x4*)(ob + (size_t)t * 512 + (un - 7) * 128 + 32 * wc + 8 * fq) = o;
                }
        }
    }
};


struct MlEpi8 {
    static constexpr bool PERM = true, AFTER_DRAIN = false;
    const Params* p; int j;
    __device__ __forceinline__ void operator()(const pg8::f32x4 (&acc)[2][2][4][2], const pg8::Unit& u, int wr, int wc, int fr, int fq) const {
        unsigned char* ws = p->ws;
        const int un = u.pn;
        if (un < 4) {
            bf16_t* ob = (bf16_t*)(ws + (un < 2 ? WS_MQ : WS_MK));
            const int hd = 4 * (un & 1) + wc; const float sc = un < 2 ? 0.125f : 1.f;
            const int cs_ = un < 2 ? fr : ((fr & ~12) | ((fr & 4) << 1) | ((fr & 8) >> 1));
#pragma unroll
            for (int ai = 0; ai < 2; ++ai)
#pragma unroll
                for (int m = 0; m < 4; ++m) {
                    const int tq = opq(u.pm * 4 + ai * 2 + wr);
                    const int item = ((tq >> 5) * 8 + hd) * 32 + (tq & 31);
                    bf16_t* ib = ob + ((size_t)(item * 2 + (m >> 1)) * 256 + (fq & 1) * 32 + (m & 1) * 16 + cs_) * 8;
#pragma unroll
                    for (int bj = 0; bj < 2; ++bj) {
                        const pg8::f32x4 a = acc[ai][bj][m][0] * sc, b = acc[ai][bj][m][1] * sc;
                        u32x4 o = {cvtpk(a[0], a[1]), cvtpk(a[2], a[3]), cvtpk(b[0], b[1]), cvtpk(b[2], b[3])};
                        *(u32x4*)(ib + (2 * bj + (fq >> 1)) * 64 * 8) = o;
                    }
                }
        } else if (un >= 8) {
            bf16_t* ob = (bf16_t*)(ws + WS_MOG);
#pragma unroll
            for (int ai = 0; ai < 2; ++ai)
#pragma unroll
                for (int m = 0; m < 4; ++m) {
                    const int t = opq(u.pm * 256 + ai * 128 + wr * 64 + m * 16 + fr);
#pragma unroll
                    for (int bj = 0; bj < 2; ++bj) {
                        pg8::f32x4 a = acc[ai][bj][m][0], b = acc[ai][bj][m][1];
#pragma unroll
                        for (int e = 0; e < 4; ++e) { a[e] = sigmoidf_(a[e]); b[e] = sigmoidf_(b[e]); }
                        u32x4 o = {cvtpk(a[0], a[1]), cvtpk(a[2], a[3]), cvtpk(b[0], b[1]), cvtpk(b[2], b[3])};
                        *(u32x4*)(ob + (size_t)t * 1024 + (un - 8) * 256 + 128 * bj + 32 * wc + 8 * fq) = o;
                    }
                }
        }
        if (un >= 2 && un < 8) {
            bf16_t* ob = (bf16_t*)(ws + (un < 4 ? WS_MKT : WS_MV));
#pragma unroll
            for (int ai = 0; ai < 2; ++ai)
#pragma unroll
                for (int m = 0; m < 4; ++m) {
                    const int tq = opq(u.pm * 4 + ai * 2 + wr);
#pragma unroll
                    for (int bj = 0; bj < 2; ++bj) {
                        const int hd = un < 4 ? 4 * (un - 2) + wc : 2 * (un - 4) + bj;
                        const int item = ((tq >> 5) * 8 + hd) * 32 + (tq & 31);
                        bf16_t* ib = ob + (un < 4 ? ((size_t)((item * 2 + bj) * 4 + m) * 64 + (fr >> 3) * 32 + 8 * fq) * 8 : ((size_t)((item * 4 + wc) * 4 + m) * 64 + (fr >> 3) * 32 + 8 * fq) * 8) + (fr & 7);
#pragma unroll
                        for (int n = 0; n < 2; ++n)
#pragma unroll
                            for (int e = 0; e < 4; ++e) ib[(4 * n + e) * 8] = f2bf(acc[ai][bj][m][n][e]);
                    }
                }
        }
    }
};


struct MoeOrder8 {
    static constexpr bool GATHER = true;
    const int* tab; const int* elist; int G, c, total, mode;
    __device__ __forceinline__ bool next(int i, pg8::Unit& u) const {
        const int cl = (G & 7) ? c : (c & 7) * (G >> 3) + (c >> 3);
        const int wg = i * G + cl; if (wg >= total) return false;
        u.pm = __builtin_amdgcn_readfirstlane(tab[wg >> 2]); u.pn = __builtin_amdgcn_readfirstlane((u.pm >> 8) * 4 + (wg & 3)); return true;
    }
    __device__ __forceinline__ int rows(const pg8::Unit& u) const { const int r = tab[168 + (u.pm >> 8)] - (u.pm & 255) * 256; return __builtin_amdgcn_readfirstlane(r < 256 ? r : 256); }
    __device__ __forceinline__ unsigned a_off(const pg8::Unit& u, int row) const {
        const int e = u.pm >> 8, lr = (u.pm & 255) * 256 + row;
        if (lr >= tab[168 + e]) return 0u;
        if (mode == 1) return (unsigned)(elist[e * NASG + lr] >> 1) * 2048u;
        return (unsigned)(tab[200 + e] + lr) * 1024u;
    }
    __device__ __forceinline__ void a_ready(const pg8::Unit&) const {}
    __device__ __forceinline__ void done(const pg8::Unit&) const {}
};
struct Moe1Epi8 {
    static constexpr bool PERM = true, AFTER_DRAIN = false;
    const int* tab; bf16_t* h1;
    __device__ __forceinline__ void operator()(const pg8::f32x4 (&acc)[2][2][4][2], const pg8::Unit& u, int wr, int wc, int fr, int fq) const {
        const int e = u.pm >> 8, mu = u.pm & 255, nu = u.pn & 3, cnt = tab[168 + e], roff = tab[200 + e];
#pragma unroll
        for (int ai = 0; ai < 2; ++ai)
#pragma unroll
            for (int m = 0; m < 4; ++m) {
                const int lr = opq(mu * 256 + ai * 128 + wr * 64 + m * 16 + fr);
                if (lr < cnt) {
                    u32x4 o;
#pragma unroll
                    for (int n = 0; n < 2; ++n) {
                        const pg8::f32x4 g = acc[ai][0][m][n], up = acc[ai][1][m][n]; float h[4];
#pragma unroll
                        for (int x = 0; x < 4; ++x) h[x] = g[x] * __builtin_amdgcn_rcpf(1.f + __expf(-g[x])) * up[x];
                        o[2 * n] = cvtpk(h[0], h[1]); o[2 * n + 1] = cvtpk(h[2], h[3]);
                    }
                    *(u32x4*)(h1 + (size_t)(roff + lr) * 512 + 128 * nu + 32 * wc + 8 * fq) = o;
                }
            }
    }
};
struct Moe2Epi8 {
    static constexpr bool PERM = true, AFTER_DRAIN = false;
    const int* tab; const int* elist; bf16_t* y;
    __device__ __forceinline__ void operator()(const pg8::f32x4 (&acc)[2][2][4][2], const pg8::Unit& u, int wr, int wc, int fr, int fq) const {
        const int e = u.pm >> 8, mu = u.pm & 255, nu = u.pn & 3, cnt = tab[168 + e];
        int av[8];
#pragma unroll
        for (int st = 0; st < 8; ++st) { const int lr = mu * 256 + (st >> 2) * 128 + wr * 64 + (st & 3) * 16 + fr; av[st] = lr < cnt ? elist[e * NASG + lr] : 0; }
#pragma unroll
        for (int ai = 0; ai < 2; ++ai)
#pragma unroll
            for (int m = 0; m < 4; ++m) {
                const int lr = opq(mu * 256 + ai * 128 + wr * 64 + m * 16 + fr);
                if (lr < cnt) {
                    const int a = av[ai * 4 + m];
#pragma unroll
                    for (int bj = 0; bj < 2; ++bj) {
                        const pg8::f32x4 v0 = acc[ai][bj][m][0], v1 = acc[ai][bj][m][1];
                        u32x4 o = {cvtpk(v0[0], v0[1]), cvtpk(v0[2], v0[3]), cvtpk(v1[0], v1[1]), cvtpk(v1[2], v1[3])};
                        *(u32x4*)(y + (size_t)a * 1024 + 256 * nu + 128 * bj + 32 * wc + 8 * fq) = o;
                    }
                }
            }
    }
};

#define XB_TMO      128
#define XB_XCNT(j)  (256  + 64 * (j))
#define XB_XSUB(j)  (1280 + 64 * (j))
#define XB_XGEN(j)  (2304 + 64 * (j))
#define XB_TOP      3328
#define XB_TOPGEN   3392
#define XCD_BAR_WORDS 3456
#define XB_SPIN_CAP (1u << 22)
DI unsigned xb_ld(unsigned* p) { return __hip_atomic_load(p, __ATOMIC_RELAXED, __HIP_MEMORY_SCOPE_AGENT); }
DI unsigned xb_add(unsigned* p, unsigned v) { return __hip_atomic_fetch_add(p, v, __ATOMIC_RELAXED, __HIP_MEMORY_SCOPE_AGENT); }
DI unsigned xb_xcc_id() { return (unsigned)__builtin_amdgcn_s_getreg((3 << 11) | 20) & 0xFu; }
#define XB_SPIN(cond, bar) do { unsigned _sp = 0; while (cond) { __builtin_amdgcn_s_sleep(1); \
    if ((++_sp & 255u) == 0u) { if (xb_ld(&(bar)[XB_TMO])) break; if (_sp > XB_SPIN_CAP) { atomicAdd(&(bar)[XB_TMO], 1u); break; } } } } while (0)
struct XcdBarrier { unsigned* bar; unsigned x; volatile LAS unsigned* st; };
DI XcdBarrier xcd_barrier_post(unsigned* bar, volatile LAS unsigned* st, bool leader) {
    XcdBarrier b; b.bar = bar; b.x = xb_xcc_id(); b.st = st;
    if (leader) (void)xb_add(&bar[XB_XCNT(b.x)], 1u);
    return b;
}
DI void xcd_barrier_complete(unsigned* bar, unsigned x, unsigned& nloc, unsigned& nx, unsigned G) {
    unsigned sum, cnt, mine, sp = 0u;
    for (;;) {
        sum = 0u; cnt = 0u; mine = 0u;
#pragma unroll
        for (unsigned j = 0; j < 16; ++j) { const unsigned c = xb_ld(&bar[XB_XCNT(j)]); sum += c; cnt += (c > 0u) ? 1u : 0u; mine = (j == x) ? c : mine; }
        if (sum == G) break;
        __builtin_amdgcn_s_sleep(1);
        if ((++sp & 255u) == 0u) { if (xb_ld(&bar[XB_TMO])) break; if (sp > XB_SPIN_CAP) { atomicAdd(&bar[XB_TMO], 1u); break; } }
    }
    nloc = mine > 0u ? mine : 1u; nx = cnt > 0u ? cnt : 1u;
}
DI void xcd_barrier(const XcdBarrier& b, bool leader, unsigned nparts, bool one_l2_ok = false) {
    asm volatile("s_waitcnt vmcnt(0)" ::: "memory");
    __syncthreads();
    if (leader) {
        unsigned* bar = b.bar;
        __builtin_amdgcn_s_waitcnt(0);
        unsigned nloc = b.st[0], nx = b.st[1];
        if (nloc == 0u) { xcd_barrier_complete(bar, b.x, nloc, nx, nparts); b.st[0] = nloc; b.st[1] = nx; }
        const unsigned old = xb_add(&bar[XB_XSUB(b.x)], 1u);
        const unsigned gen = old / nloc;
        if (old + 1u == (gen + 1u) * nloc) {
            if (!(one_l2_ok && nx == 1u)) __builtin_amdgcn_fence(__ATOMIC_RELEASE, "agent");
            asm volatile("s_waitcnt vmcnt(0)" ::: "memory");
            const unsigned og = xb_add(&bar[XB_TOP], 1u);
            const unsigned tg = og / nx;
            if (og + 1u == (tg + 1u) * nx) xb_add(&bar[XB_TOPGEN], 1u);
            else XB_SPIN(xb_ld(&bar[XB_TOPGEN]) == tg, bar);
            __builtin_amdgcn_fence(__ATOMIC_ACQUIRE, "agent");
            xb_add(&bar[XB_XGEN(b.x)], 1u);
            asm volatile("s_waitcnt vmcnt(0)" ::: "memory");
        } else {
            XB_SPIN(xb_ld(&bar[XB_XGEN(b.x)]) == gen, bar);
            __builtin_amdgcn_fence(__ATOMIC_ACQUIRE, "agent");
            asm volatile("s_waitcnt vmcnt(0)" ::: "memory");
        }
    }
    __syncthreads();
}

namespace cg = cooperative_groups;
constexpr int MEGA_LDS = 65536 + 256;

DI const Params& fresh(const Params* kp) { asm volatile("" : "+s"(kp)); return *kp; }

#ifndef PROBE_MASK
#define PROBE_MASK 0
#endif
__global__ void __launch_bounds__(512, 2) hybrid_fwd_megakernel(Params p_arg) {
    __shared__ __attribute__((aligned(16))) unsigned char smem_all[2 * MEGA_LDS + 1024];
    cg::grid_group grid = cg::this_grid();
    const Params* kp = (const Params*)__builtin_amdgcn_kernarg_segment_ptr();
    const int wave8 = __builtin_amdgcn_readfirstlane((int)(threadIdx.x >> 6));
    const int vb = wave8 >> 2;
#define tid0 ((wave8 & 3) * 64 + lane_id())
    unsigned char* smem = smem_all + vb * MEGA_LDS;
    const int bid0 = blockIdx.x * 2 + vb, nb0 = gridDim.x * 2;
    const int gx0 = blockIdx.x & 7, glb0 = (blockIdx.x >> 3) * 2 + vb, gnl = (gridDim.x >> 3) * 2;
#define bid opqs(bid0)
#define nb opqs(nb0)
#define gx opqs(gx0)
#define glb opqs(glb0)
#define tid opq(tid0)
    volatile LAS unsigned* xst = (volatile LAS unsigned*)(smem_all + 2 * MEGA_LDS);
    if (wave8 == 0 && lane_id() == 0) { xst[0] = 0u; xst[1] = 0u; xst[2] = 0u; xst[3] = 0u; }
    __syncthreads();
    (void)xcd_barrier_post((unsigned*)(fresh(kp).ws + WS_BAR), xst, wave8 == 0 && lane_id() == 0);
    (void)xcd_barrier_post((unsigned*)(fresh(kp).ws + WS_BAR) + 3456 * (1 + (blockIdx.x & 7)), xst + 2, wave8 == 0 && lane_id() == 0);
    for (int rep = 0; rep < ((PROBE_MASK & 1) ? 2 : 1); ++rep) { phase_init(fresh(kp), smem, bid, nb, tid); }
#define GSYNC() do { XcdBarrier xb_; xb_.bar = (unsigned*)(fresh(kp).ws + WS_BAR); xb_.x = xb_xcc_id(); xb_.st = (volatile LAS unsigned*)(smem_all + 2 * MEGA_LDS); xcd_barrier(xb_, wave8 == 0 && lane_id() == 0, gridDim.x); } while (0)
    const bool grpbar = (gridDim.x & 7) == 0 && aff_ok(nb0, 64);
    const unsigned gsel_b = blockIdx.x & 7, nloc_b = gridDim.x >> 3;
#define GSYNC_B() do { if (!grpbar) { GSYNC(); } else { XcdBarrier xb_; xb_.bar = (unsigned*)(fresh(kp).ws + WS_BAR) + 3456 * (1 + gsel_b); xb_.x = xb_xcc_id(); \
        xb_.st = (volatile LAS unsigned*)(smem_all + 2 * MEGA_LDS) + 2; xcd_barrier(xb_, wave8 == 0 && lane_id() == 0, nloc_b, true); } } while (0)
    if (fresh(kp).use_cg_sync) grid.sync();
    GSYNC();
#pragma unroll 1
    for (int layer = 0; layer < DEPTH; ++layer) {
        const int j = layer >> 1;
        if (layer == 0) { { const Params& p = fresh(kp); phase_norm(p, 0, p.x, bid, nb, tid); }
        GSYNC_B(); }
        if ((layer & 1) == 0) {
            for (int rep = 0; rep < ((PROBE_MASK & 4) ? 2 : 1); ++rep) { { const Params& p = fresh(kp);
              pg8::Gemm g8{(const pg8::bf16_t*)(p.ws + WS_H), (const pg8::bf16_t*)(p.ws + WS_WHYB) + (size_t)j * 2816 * 1024, T, 2816, 1024};
              pg8::StaticOrder S8; S8.init(T, 2816, (int)gridDim.x, (int)blockIdx.x);
              HybEpi8 E8{&p, j};
              pg8::gemm_phase<HybEpi8, pg8::StaticOrder, true, true>((PG8_LAS unsigned char*)smem_all, g8, S8, E8, wave8 * 64 + lane_id()); } }
            GSYNC_B();
            for (int rep = 0; rep < ((PROBE_MASK & 8) ? 2 : 1); ++rep) { phase_dsa(fresh(kp), j, smem, bid, nb, tid, layer, layer + 2);        }
            for (int rep = 0; rep < ((PROBE_MASK & 16) ? 2 : 1); ++rep) { phase_conv(fresh(kp), j, bid, nb, tid); }
            GSYNC_B();
            { const Params& p = fresh(kp);
              pg8::Gemm g8{(const pg8::bf16_t*)(p.ws + WS_YMIX), (const pg8::bf16_t*)(p.ws + WS_WOUT) + (size_t)layer * 1024 * 1024, T, 1024, 1024};
              pg8::StaticOrder S8; S8.init(T, 1024, (int)gridDim.x, (int)blockIdx.x);
              OutEpi8 E8{layer == 0 ? p.x : p.out, p.out, (const float*)(p.ws + WS_MOD) + (size_t)layer * 8 * 6144 + 2048, (float*)(p.ws + WS_PART)};
              pg8::gemm_phase<OutEpi8, pg8::StaticOrder, true, true>((PG8_LAS unsigned char*)smem_all, g8, S8, E8, wave8 * 64 + lane_id()); }
        } else {
            for (int rep = 0; rep < ((PROBE_MASK & 32) ? 2 : 1); ++rep) { { const Params& p = fresh(kp);
              pg8::Gemm g8{(const pg8::bf16_t*)(p.ws + WS_H), (const pg8::bf16_t*)(p.ws + WS_WML) + (size_t)j * 3200 * 1024, T, 3072, 1024};
              pg8::StaticOrder S8; S8.init(T, 3072, (int)gridDim.x, (int)blockIdx.x);
              MlEpi8 E8{&p, j};
              pg8::gemm_phase<MlEpi8, pg8::StaticOrder, true, true>((PG8_LAS unsigned char*)smem_all, g8, S8, E8, wave8 * 64 + lane_id());
              phase_ml_gates(p, j, bid, nb, tid); } }
            GSYNC_B();
            for (int rep = 0; rep < ((PROBE_MASK & 64) ? 2 : 1); ++rep) { phase_ml12(fresh(kp), smem, bid, nb, tid); }
            GSYNC_B();
            for (int rep = 0; rep < ((PROBE_MASK & 256) ? 2 : 1); ++rep) { phase_ml3(fresh(kp), j, smem, bid, nb, tid); }
            GSYNC_B();
            { const Params& p = fresh(kp);
              pg8::Gemm g8{(const pg8::bf16_t*)(p.ws + WS_YMIX), (const pg8::bf16_t*)(p.ws + WS_WOUT) + (size_t)layer * 1024 * 1024, T, 1024, 1024};
              pg8::StaticOrder S8; S8.init(T, 1024, (int)gridDim.x, (int)blockIdx.x);
              OutEpi8 E8{p.out, p.out, (const float*)(p.ws + WS_MOD) + (size_t)layer * 8 * 6144 + 2048, (float*)(p.ws + WS_PART)};
              pg8::gemm_phase<OutEpi8, pg8::StaticOrder, true, true>((PG8_LAS unsigned char*)smem_all, g8, S8, E8, wave8 * 64 + lane_id()); }
        }
        GSYNC_B();
        phase_ffn_norm_router(fresh(kp), layer, smem, bid, nb, tid);
        GSYNC();
        { const Params& p = fresh(kp); unsigned char* wsu = uniform_ptr(p.ws);
          int* mtab = (int*)(smem_all + 2 * MEGA_LDS + 64);
          __syncthreads();
          if (wave8 == 0) {
              const int e = lane_id(); const int cn = e < 32 ? ((const int*)(wsu + WS_ECNT))[(layer * 32 + e) * ECS] : 0;
              const int nf = cn >> 8, r = cn & 255;
              if (e < 32) { mtab[168 + e] = cn; mtab[112 + e] = nf; }
              __builtin_amdgcn_wave_barrier();
              int fx = 0, sx = 0, nF = 0;
#pragma unroll
              for (int k = 0; k < 32; ++k) { const int ck = mtab[168 + k], fk = mtab[112 + k]; fx += k < e ? fk : 0; sx += k < e ? ck : 0; nF += fk; }
              __builtin_amdgcn_wave_barrier();
              const int cls = r == 0 ? 3 : (r > 128 ? 0 : (r > 64 ? 1 : 2));
              const unsigned long long b0 = __ballot(e < 32 && cls == 0), b1 = __ballot(e < 32 && cls == 1), b2 = __ballot(e < 32 && cls == 2);
              const unsigned long long lt = (1ull << e) - 1ull;
              const int pos = cls == 0 ? __popcll(b0 & lt) : cls == 1 ? __popcll(b0) + __popcll(b1 & lt) : __popcll(b0) + __popcll(b1) + __popcll(b2 & lt);
              if (e < 32) {
                  mtab[200 + e] = sx;
                  for (int mu = 0; mu < nf; ++mu) mtab[fx + mu] = (e << 8) | mu;
                  if (cls < 3) mtab[nF + pos] = (e << 8) | nf;
              }
              if (e == 0) mtab[160] = nF + __popcll(b0 | b1 | b2);
          }
          __syncthreads();
          MoeOrder8 S8{mtab, (const int*)(wsu + WS_ELIST), (int)gridDim.x, (int)blockIdx.x, mtab[160] * 4, 1};
          pg8::Gemm g8{(const pg8::bf16_t*)(wsu + WS_H), (const pg8::bf16_t*)(wsu + WS_WM1) + (size_t)layer * 32 * 1024 * 1024, 0, 0, 1024};
          Moe1Epi8 E8{mtab, (bf16_t*)(wsu + WS_H1)};
          pg8::gemm_phase<Moe1Epi8, MoeOrder8, true, true>((PG8_LAS unsigned char*)smem_all, g8, S8, E8, wave8 * 64 + lane_id()); }
        GSYNC_B();
        { const Params& p = fresh(kp); unsigned char* wsu = uniform_ptr(p.ws);
          int* mtab = (int*)(smem_all + 2 * MEGA_LDS + 64);
          MoeOrder8 S8{mtab, (const int*)(wsu + WS_ELIST), (int)gridDim.x, (int)blockIdx.x, mtab[160] * 4, 2};
          pg8::Gemm g8{(const pg8::bf16_t*)(wsu + WS_H1), (const pg8::bf16_t*)(wsu + WS_WM2) + (size_t)layer * 32 * 1024 * 512, 0, 0, 512};
          Moe2Epi8 E8{mtab, (const int*)(wsu + WS_ELIST), (bf16_t*)(wsu + WS_Y)};
          pg8::gemm_phase<Moe2Epi8, MoeOrder8, true, true>((PG8_LAS unsigned char*)smem_all, g8, S8, E8, wave8 * 64 + lane_id()); }
        GSYNC();
        phase_combine_norm(fresh(kp), layer, bid, nb, tid);
        if (layer + 1 < DEPTH) GSYNC_B();
    }
}
#undef tid
#undef tid0
#undef bid
#undef nb
#undef gx
#undef glb
#undef GSYNC
#undef GSYNC_B

extern "C" void kernel_launch(void* const* d_in, const int* in_sizes, int n_in, void* d_out, int out_size, void* d_ws, size_t ws_size, hipStream_t stream) {
    Params p{};
    const float** f = (const float**)&p;
    for (int i = 0; i < 22; ++i) f[i] = (const float*)d_in[i];
    p.out = (float*)d_out;
    p.ws = (unsigned char*)d_ws;
    if (ws_size < WS_END) { fprintf(stderr, "workspace too small: %zu < %zu\n", ws_size, (size_t)WS_END); return; }
    static int grid_blocks = 0;
    if (!grid_blocks) {
        int dev = 0, cus = 0, per_cu = 0;
        hipGetDevice(&dev);
        hipDeviceGetAttribute(&cus, hipDeviceAttributeMultiprocessorCount, dev);
        hipOccupancyMaxActiveBlocksPerMultiprocessor(&per_cu, hybrid_fwd_megakernel, 512, 0);
        if (per_cu > 1) per_cu = 1;
        grid_blocks = cus * per_cu;
    }
    (void)hipMemsetAsync((unsigned char*)d_ws + WS_BAR, 0, XCD_BAR_WORDS_C * 4, stream);
    void* args[] = {&p};
    hipError_t e = hipLaunchCooperativeKernel((void*)hybrid_fwd_megakernel, dim3(grid_blocks), dim3(512), args, 0, stream);
    if (e != hipSuccess) fprintf(stderr, "cooperative launch failed: %s (grid %d)\n", hipGetErrorString(e), grid_blocks);
}
```
